# Optimizing an MI355X kernel written in HIP

```python
import math
import jax, jax.numpy as jnp
from jax import lax
import numpy as np


D_MODEL = 1024
BATCH = 4
SEQ = 4096
DEPTH = 2

GRID_W = 64
CTX_LEN = 256
N_MIXERS = 2
EPS = 1e-6
D_RNN = 1024
RG_BLOCKS = 8
RG_BLOCK = D_RNN // RG_BLOCKS
CONV_W = 4
CONV_LEFT = 2
RG_C = 8.0
DA_HEADS = 8
DA_HEAD_DIM = D_MODEL // DA_HEADS // 2
ROPE_THETA = 10000.0
Q_BLOCK = 128
N_EXPERTS = 32
N_GROUPS = 4
EXPERTS_PER_GROUP = N_EXPERTS // N_GROUPS
TOP_K = 2
D_EXPERT = 512
MOE_BLOCK = 128

kernel_name = 'hybrid_rglru_diffattn_groupmoe_block'


def rms_norm(x, g):
    xf = x.astype(jnp.float32)
    y = xf * lax.rsqrt(jnp.mean(xf * xf, axis=-1, keepdims=True) + EPS)
    return y.astype(x.dtype) * g


def modulate(h, shift, scale):
    return h * (1.0 + scale) + shift


def adaln_chunks(cond, w_mod, b_mod):
    return jnp.split(jax.nn.silu(cond) @ w_mod + b_mod, 6, axis=-1)


def centred_dwconv(x, w, b):
    T = x.shape[1]
    xp = jnp.pad(x, ((0, 0), (CONV_LEFT, CONV_W - 1 - CONV_LEFT), (0, 0)))
    y = xp[:, 0:T] * w[0]
    for k in range(1, CONV_W):
        y = y + xp[:, k:k + T] * w[k]
    return y + b


def rglru_coeffs(u, wa, ba, wi, bi, lam):
    B_, T, _ = u.shape
    ur = u.reshape(B_, T, RG_BLOCKS, RG_BLOCK)
    r = jax.nn.sigmoid(jnp.einsum('btnk,nkj->btnj', ur, wa).reshape(B_, T, D_RNN) + ba)
    i = jax.nn.sigmoid(jnp.einsum('btnk,nkj->btnj', ur, wi).reshape(B_, T, D_RNN) + bi)
    log_a = -RG_C * r.astype(jnp.float32) * jax.nn.softplus(-lam.astype(jnp.float32))
    a = jnp.exp(log_a)
    b = jnp.sqrt(-jnp.expm1(2.0 * log_a)) * (i * u).astype(jnp.float32)
    return a, b


def _combine(left, right):
    a1, b1 = left
    a2, b2 = right
    return a1 * a2, a2 * b1 + b2


def linear_scan(a, b, h0, reverse):
    A, H = lax.associative_scan(_combine, (a, b), axis=1, reverse=reverse)
    if h0 is None:
        return H
    return H + A * h0[:, None, :]


def rglru_mixer(hx, hc, w_in, conv_w, conv_b, ga_w, ga_b, gx_w, gx_b, lam, w_out, need_ctx):
    def branches(h):
        y, u = jnp.split(h @ w_in, 2, axis=-1)
        return jax.nn.gelu(y), centred_dwconv(u, conv_w, conv_b)
    yx, ux = branches(hx)
    yc, uc = branches(hc)
    hs_x = None
    hs_c = None
    for d in range(2):
        rev = d == 1
        a_c, b_c = rglru_coeffs(uc, ga_w[d], ga_b[d], gx_w[d], gx_b[d], lam[d])
        h_c = linear_scan(a_c, b_c, None, rev)
        h0 = h_c[:, 0] if rev else h_c[:, -1]
        a_x, b_x = rglru_coeffs(ux, ga_w[d], ga_b[d], gx_w[d], gx_b[d], lam[d])
        h_x = linear_scan(a_x, b_x, h0, rev)
        hs_x = h_x if hs_x is None else hs_x + h_x
        hs_c = h_c if hs_c is None else hs_c + h_c
    out_x = (hs_x.astype(hx.dtype) * yx) @ w_out
    out_c = (hs_c.astype(hc.dtype) * yc) @ w_out if need_ctx else None
    return out_x, out_c


def rope_tables(n_tokens):
    n_rows = n_tokens // GRID_W
    row = jnp.repeat(jnp.arange(n_rows), GRID_W).astype(jnp.float32)
    col = jnp.tile(jnp.arange(GRID_W), n_rows).astype(jnp.float32)
    n_freq = DA_HEAD_DIM // 4
    inv = 1.0 / (ROPE_THETA ** (jnp.arange(n_freq, dtype=jnp.float32) / n_freq))
    ang = jnp.stack([row, col], axis=-1)[:, :, None] * inv
    ang = jnp.broadcast_to(ang[:, :, None, :], (n_tokens, 2, 2, n_freq)).reshape(n_tokens, DA_HEAD_DIM)
    return jnp.cos(ang), jnp.sin(ang)


def apply_rope(x, cos, sin):
    xr = x.reshape(x.shape[:-1] + (2, 2, DA_HEAD_DIM // 4))
    rot = jnp.concatenate([-xr[..., 1:2, :], xr[..., 0:1, :]], axis=-2).reshape(x.shape)
    c = cos[:, None, None, :].astype(x.dtype)
    s = sin[:, None, None, :].astype(x.dtype)
    return x * c + rot * s


def diff_softmax_attend(q, k, v, lam, subln_g, lambda_init):
    s = jnp.einsum('bhiqd,bhikd->bhiqk', q, k).astype(jnp.float32)
    p = jax.nn.softmax(s, axis=-1)
    w = p[:, :, 0] - lam * p[:, :, 1]
    o = jnp.einsum('bhqk,bhkv->bhqv', w.astype(v.dtype), v)
    return rms_norm(o, subln_g) * (1.0 - lambda_init)


def diff_attn_mixer(hx, hc, w_qkv, lam_vecs, subln_g, w_o, lambda_init, need_ctx):
    B_, S, _ = hx.shape
    C = hc.shape[1]

    def project(h):
        T = h.shape[1]
        q, k, v = jnp.split(h @ w_qkv, 3, axis=-1)
        return (q.reshape(B_, T, DA_HEADS, 2, DA_HEAD_DIM),
                k.reshape(B_, T, DA_HEADS, 2, DA_HEAD_DIM),
                v.reshape(B_, T, DA_HEADS, 2 * DA_HEAD_DIM))

    qx, kx, vx = project(hx)
    qc, kc, vc = project(hc)
    cos, sin = rope_tables(S)
    qx = apply_rope(qx, cos, sin)
    kx = apply_rope(kx, cos, sin)
    scale = DA_HEAD_DIM ** -0.5
    qk_heads = lambda t: jnp.transpose(t, (0, 2, 3, 1, 4))
    v_heads = lambda t: jnp.transpose(t, (0, 2, 1, 3))
    lf = lam_vecs.astype(jnp.float32)
    lam = jnp.exp(jnp.sum(lf[0] * lf[1])) - jnp.exp(jnp.sum(lf[2] * lf[3])) + lambda_init
    kc_h = qk_heads(kc)
    vc_h = v_heads(vc)
    k_all = jnp.concatenate([qk_heads(kx), kc_h], axis=3)
    v_all = jnp.concatenate([v_heads(vx), vc_h], axis=2)
    qx_h = qk_heads(qx) * scale
    nb = S // Q_BLOCK
    q_blocks = jnp.moveaxis(qx_h.reshape(B_, DA_HEADS, 2, nb, Q_BLOCK, DA_HEAD_DIM), 3, 0)
    o = lax.map(lambda qb: diff_softmax_attend(qb, k_all, v_all, lam, subln_g, lambda_init), q_blocks)
    o = jnp.transpose(o, (1, 0, 3, 2, 4)).reshape(B_, S, D_MODEL)
    out_x = o @ w_o
    out_c = None
    if need_ctx:
        oc = diff_softmax_attend(qk_heads(qc) * scale, kc_h, vc_h, lam, subln_g, lambda_init)
        out_c = jnp.transpose(oc, (0, 2, 1, 3)).reshape(B_, C, D_MODEL) @ w_o
    return out_x, out_c


def moe_ffn(h, router_w, router_bias, w_gate, w_up, w_down):
    N, D = h.shape
    s = jax.nn.sigmoid((h @ router_w).astype(jnp.float32))
    s_sel = s + router_bias.astype(jnp.float32)
    grp_score = lax.top_k(s_sel.reshape(N, N_GROUPS, EXPERTS_PER_GROUP), 2)[0].sum(-1)
    grp = jnp.argmax(grp_score, axis=-1)
    in_grp = (jnp.arange(N_EXPERTS) // EXPERTS_PER_GROUP)[None, :] == grp[:, None]
    _, idx = lax.top_k(jnp.where(in_grp, s_sel, -jnp.inf), TOP_K)
    wts = jnp.take_along_axis(s, idx, axis=-1)
    wts = wts / jnp.sum(wts, axis=-1, keepdims=True)
    e_flat = idx.reshape(-1)
    t_flat = jnp.repeat(jnp.arange(N), TOP_K)
    w_flat = wts.reshape(-1)
    order = jnp.argsort(e_flat)
    e_s, t_s, w_s = e_flat[order], t_flat[order], w_flat[order]
    counts = jnp.bincount(e_flat, length=N_EXPERTS)
    starts = jnp.cumsum(counts) - counts
    padded = ((counts + MOE_BLOCK - 1) // MOE_BLOCK) * MOE_BLOCK
    p_ends = jnp.cumsum(padded)
    p_starts = p_ends - padded
    dest = p_starts[e_s] + jnp.arange(N * TOP_K) - starts[e_s]
    n_blocks = -(-(N * TOP_K) // MOE_BLOCK) + N_EXPERTS
    P = n_blocks * MOE_BLOCK
    buf_tok = jnp.zeros((P,), jnp.int32).at[dest].set(t_s.astype(jnp.int32))
    buf_w = jnp.zeros((P,), jnp.float32).at[dest].set(w_s)
    blk_exp = jnp.minimum(jnp.searchsorted(p_ends, jnp.arange(n_blocks) * MOE_BLOCK, side='right'), N_EXPERTS - 1)
    xb = h[buf_tok].reshape(n_blocks, MOE_BLOCK, D)

    def expert_block(args):
        xblk, e = args
        return (jax.nn.silu(xblk @ w_gate[e]) * (xblk @ w_up[e])) @ w_down[e]

    yb = lax.map(expert_block, (xb, blk_exp)).reshape(P, D)
    return jnp.zeros_like(h).at[buf_tok].add(yb * buf_w[:, None].astype(yb.dtype))


def setup_inputs(seed: int = 0) -> dict:
    key = jax.random.key(seed)
    ks = iter(jax.random.split(key, 40))
    f32 = jnp.float32
    nrm = lambda shape, sc: jax.random.normal(next(ks), shape, f32) * sc
    n_rg = (DEPTH + N_MIXERS - 1) // N_MIXERS
    n_da = DEPTH // N_MIXERS
    D = D_MODEL
    a8 = jax.random.uniform(next(ks), (n_rg, 2, D_RNN), f32, 0.9, 0.999)
    p = a8 ** (1.0 / RG_C)
    rg_lambda = jnp.log(p) - jnp.log1p(-p)
    return {
        'x': nrm((BATCH, SEQ, D), 1.0),
        'c': nrm((BATCH, D), 1.0),
        'ctx': nrm((BATCH, CTX_LEN, D), 1.0),
        'c_ctx': nrm((D,), 1.0),
        'w_mod': nrm((DEPTH, D, 6 * D), 0.5 * D ** -0.5),
        'b_mod': nrm((DEPTH, 6 * D), 0.02),
        'norm1_g': 1.0 + nrm((DEPTH, D), 0.05),
        'norm2_g': 1.0 + nrm((DEPTH, D), 0.05),
        'rg_w_in': nrm((n_rg, D, 2 * D_RNN), D ** -0.5),
        'rg_conv_w': nrm((n_rg, CONV_W, D_RNN), CONV_W ** -0.5),
        'rg_conv_b': nrm((n_rg, D_RNN), 0.02),
        'rg_gate_a_w': nrm((n_rg, 2, RG_BLOCKS, RG_BLOCK, RG_BLOCK), RG_BLOCK ** -0.5),
        'rg_gate_a_b': nrm((n_rg, 2, D_RNN), 0.02),
        'rg_gate_x_w': nrm((n_rg, 2, RG_BLOCKS, RG_BLOCK, RG_BLOCK), RG_BLOCK ** -0.5),
        'rg_gate_x_b': nrm((n_rg, 2, D_RNN), 0.02),
        'rg_lambda': rg_lambda,
        'rg_w_out': nrm((n_rg, D_RNN, D), D_RNN ** -0.5),
        'da_w_qkv': nrm((n_da, D, 3 * D), D ** -0.5),
        'da_lambda': nrm((n_da, 4, DA_HEAD_DIM), 0.1),
        'da_subln_g': 1.0 + nrm((n_da, 2 * DA_HEAD_DIM), 0.05),
        'da_w_o': nrm((n_da, D, D), D ** -0.5),
        'router_w': nrm((D, N_EXPERTS), D ** -0.5),
        'router_bias': nrm((N_EXPERTS,), 0.01),
        'moe_w_gate': nrm((DEPTH, N_EXPERTS, D, D_EXPERT), D ** -0.5),
        'moe_w_up': nrm((DEPTH, N_EXPERTS, D, D_EXPERT), D ** -0.5),
        'moe_w_down': nrm((DEPTH, N_EXPERTS, D_EXPERT, D), D_EXPERT ** -0.5),
        'final_g': 1.0 + nrm((D,), 0.05),
    }


def reference(x, c, ctx, c_ctx, w_mod, b_mod, norm1_g, norm2_g, rg_w_in, rg_conv_w, rg_conv_b,
              rg_gate_a_w, rg_gate_a_b, rg_gate_x_w, rg_gate_x_b, rg_lambda, rg_w_out,
              da_w_qkv, da_lambda, da_subln_g, da_w_o, router_w, router_bias,
              moe_w_gate, moe_w_up, moe_w_down, final_g):
    B_, S, D = x.shape
    C = ctx.shape[1]
    cond_x = c[:, None, :]
    cond_c = c_ctx[None, None, :]
    i_rg = 0
    i_da = 0
    for layer in range(DEPTH):
        need_ctx = layer < DEPTH - 1
        shx1, scx1, gx1, shx2, scx2, gx2 = adaln_chunks(cond_x, w_mod[layer], b_mod[layer])
        shc1, scc1, gc1, shc2, scc2, gc2 = adaln_chunks(cond_c, w_mod[layer], b_mod[layer])
        hx = modulate(rms_norm(x, norm1_g[layer]), shx1, scx1)
        hc = modulate(rms_norm(ctx, norm1_g[layer]), shc1, scc1)
        if layer % N_MIXERS == 0:
            ox, oc = rglru_mixer(hx, hc, rg_w_in[i_rg], rg_conv_w[i_rg], rg_conv_b[i_rg],
                                 rg_gate_a_w[i_rg], rg_gate_a_b[i_rg], rg_gate_x_w[i_rg],
                                 rg_gate_x_b[i_rg], rg_lambda[i_rg], rg_w_out[i_rg], need_ctx)
            i_rg += 1
        else:
            lambda_init = 0.8 - 0.6 * math.exp(-0.3 * layer)
            ox, oc = diff_attn_mixer(hx, hc, da_w_qkv[i_da], da_lambda[i_da], da_subln_g[i_da],
                                     da_w_o[i_da], lambda_init, need_ctx)
            i_da += 1
        x = x + gx1 * ox
        hx2 = modulate(rms_norm(x, norm2_g[layer]), shx2, scx2)
        if need_ctx:
            ctx = ctx + gc1 * oc
            hc2 = modulate(rms_norm(ctx, norm2_g[layer]), shc2, scc2)
            tokens = jnp.concatenate([hx2.reshape(-1, D), hc2.reshape(-1, D)], axis=0)
            y = moe_ffn(tokens, router_w, router_bias, moe_w_gate[layer], moe_w_up[layer], moe_w_down[layer])
            x = x + gx2 * y[:B_ * S].reshape(B_, S, D)
            ctx = ctx + gc2 * y[B_ * S:].reshape(B_, C, D)
        else:
            y = moe_ffn(hx2.reshape(-1, D), router_w, router_bias, moe_w_gate[layer], moe_w_up[layer], moe_w_down[layer])
            x = x + gx2 * y.reshape(B_, S, D)
    return rms_norm(x, final_g)
```

```cpp
#include <hip/hip_runtime.h>
#include <cstdio>
#include <cstdint>

#ifndef MK_N_LAUNCHES
#define MK_N_LAUNCHES 1
#endif

#ifndef DBG_NPH
#define DBG_NPH 18
#endif
#define LAS __attribute__((address_space(3)))
typedef unsigned short bf16;
typedef short bf16x8 __attribute__((ext_vector_type(8)));
typedef float f32x4 __attribute__((ext_vector_type(4)));
typedef float f32x16 __attribute__((ext_vector_type(16)));
typedef unsigned u32x4 __attribute__((ext_vector_type(4)));
typedef unsigned u32x2 __attribute__((ext_vector_type(2)));

constexpr int D = 1024, NB = 4, S = 4096, CL = 256;
constexpr int NX = NB * S, NC = NB * CL, NTOK = NX + NC;
constexpr int NEXP = 32, DEXP = 512;
constexpr int NWAVES = 8, NTHREADS = 512;
constexpr int KEYS = S + CL;
constexpr float EPS = 1e-6f;
constexpr int PMAX = 43008;
constexpr int NPHASES = 18;

constexpr size_t MiB = 1u << 20;
constexpr size_t WS_CTL = 0, CTL_ZERO_BYTES = 64 * 1024;
constexpr size_t WS_MOD = 1 * MiB;
constexpr size_t WS_SEL = 2 * MiB;
constexpr size_t WS_WT = WS_SEL + 256 * 1024;
constexpr size_t WS_LRANK = WS_WT + 256 * 1024;
constexpr size_t WS_TOKSLOT = WS_LRANK + 256 * 1024;
constexpr size_t WS_BLKCNT = WS_TOKSLOT + 256 * 1024;
constexpr size_t WS_PSTART = WS_BLKCNT + 64 * 1024;
constexpr size_t WS_SLOTTOK = 3 * MiB + 512 * 1024;
constexpr size_t WS_SLOTW = WS_SLOTTOK + 256 * 1024;
constexpr size_t WS_WIN = 4 * MiB;
constexpr size_t WS_WOUT = 8 * MiB;
constexpr size_t WS_GATE = 10 * MiB;
constexpr size_t WS_WQKV = 11 * MiB;
constexpr size_t WS_WO = 17 * MiB;
constexpr size_t WS_WUP = 20 * MiB;
constexpr size_t WS_WDN = 148 * MiB;
constexpr size_t WS_XA = 212 * MiB;
constexpr size_t WS_H = 280 * MiB;
constexpr size_t WS_R = 314 * MiB;
constexpr size_t WS_YG = WS_R, WS_U = WS_R + 34 * MiB, WS_HF = WS_R + 68 * MiB, WS_HB = WS_R + 102 * MiB;
constexpr size_t WS_G = WS_R, WS_Y = WS_R + 42 * MiB;
constexpr size_t WS_Q = WS_R, WS_K = WS_R + 32 * MiB, WS_VT = WS_R + 66 * MiB, WS_AO = WS_R + 100 * MiB;
constexpr size_t WS_END = 450 * MiB;
static_assert(WS_Y + (size_t)PMAX * 1024 * 2 <= WS_END && WS_HB + 34 * MiB <= WS_END && WS_AO + 32 * MiB <= WS_END, "ws map");
static_assert(WS_K + (size_t)NB * 8 * 2 * KEYS * 64 * 2 <= WS_VT && WS_VT + (size_t)NB * 8 * 128 * KEYS * 2 <= WS_AO, "attn map");

constexpr int LDS_BYTES = 147456;
constexpr int LDS_XB = LDS_BYTES - 64;
constexpr int LDS_AUX = 131072;

__device__ __forceinline__ unsigned f2bf(float f) { unsigned u = __builtin_bit_cast(unsigned, f); return (u + 0x7fffu + ((u >> 16) & 1u)) >> 16; }
__device__ __forceinline__ unsigned pk2(float lo, float hi) { return f2bf(lo) | (f2bf(hi) << 16); }
__device__ __forceinline__ float bflo(unsigned w) { return __builtin_bit_cast(float, w << 16); }
__device__ __forceinline__ float bfhi(unsigned w) { return __builtin_bit_cast(float, w & 0xffff0000u); }
__device__ __forceinline__ float wave_sum(float v) {
#pragma unroll
    for (int o = 1; o < 64; o <<= 1) v += __shfl_xor(v, o);
    return v;
}
__device__ __forceinline__ float sigmoidf_(float x) { return 1.0f / (1.0f + __expf(-x)); }
#define LDS_WAIT() asm volatile("s_waitcnt lgkmcnt(0)" ::: "memory")

#define XB_TMO      128
#define XB_XCNT(j)  (256  + 64 * (j))
#define XB_XSUB(j)  (1280 + 64 * (j))
#define XB_XGEN(j)  (2304 + 64 * (j))
#define XB_TOP      3328
#define XB_TOPGEN   3392
#define XCD_BAR_WORDS 3456
#define XB_SPIN_CAP (1u << 18)
__device__ __forceinline__ unsigned xb_ld(unsigned* p)              { return __hip_atomic_load(p, __ATOMIC_RELAXED, __HIP_MEMORY_SCOPE_AGENT); }
__device__ __forceinline__ unsigned xb_add(unsigned* p, unsigned v) { return __hip_atomic_fetch_add(p, v, __ATOMIC_RELAXED, __HIP_MEMORY_SCOPE_AGENT); }
__device__ __forceinline__ unsigned xb_xcc_id() { return (unsigned)__builtin_amdgcn_s_getreg((3 << 11) | 20) & 0xFu; }
#define XB_SPIN(cond, bar) do { unsigned _sp = 0; while (cond) { __builtin_amdgcn_s_sleep(1); \
    if ((++_sp & 255u) == 0u) { if (xb_ld(&(bar)[XB_TMO])) break; if (_sp > XB_SPIN_CAP) { atomicAdd(&(bar)[XB_TMO], 1u); break; } } } } while (0)
struct XcdBarrier { unsigned* bar; unsigned x; volatile LAS unsigned* st; };
__device__ __forceinline__ XcdBarrier xcd_barrier_post(unsigned* bar, volatile LAS unsigned* st) {
    XcdBarrier b; b.bar = bar; b.x = xb_xcc_id(); b.st = st;
    if (threadIdx.x == 0) (void)xb_add(&bar[XB_XCNT(b.x)], 1u);
    return b;
}
__device__ __forceinline__ void xcd_barrier_complete(unsigned* bar, unsigned x, unsigned& nloc, unsigned& nx) {
    const unsigned G = gridDim.x * gridDim.y * gridDim.z;
    unsigned sum, cnt, mine, sp = 0u;
    for (;;) {
        sum = 0u; cnt = 0u; mine = 0u;
#pragma unroll
        for (unsigned j = 0; j < 16; ++j) { const unsigned c = xb_ld(&bar[XB_XCNT(j)]); sum += c; cnt += (c > 0u) ? 1u : 0u; mine = (j == x) ? c : mine; }
        if (sum == G) break;
        __builtin_amdgcn_s_sleep(1);
        if ((++sp & 255u) == 0u) { if (xb_ld(&bar[XB_TMO])) break; if (sp > XB_SPIN_CAP) { atomicAdd(&bar[XB_TMO], 1u); break; } }
    }
    nloc = mine > 0u ? mine : 1u; nx = cnt > 0u ? cnt : 1u;
}
__device__ __forceinline__ void xcd_barrier(const XcdBarrier& b) {
    asm volatile("s_waitcnt vmcnt(0)" ::: "memory");
    __syncthreads();
    if (threadIdx.x == 0) {
        unsigned* bar = b.bar;
        __builtin_amdgcn_s_waitcnt(0);
        unsigned nloc = b.st[0], nx = b.st[1];
        if (nloc == 0u) { xcd_barrier_complete(bar, b.x, nloc, nx); b.st[0] = nloc; b.st[1] = nx; }
        const unsigned old = xb_add(&bar[XB_XSUB(b.x)], 1u);
        const unsigned gen = old / nloc;
        if (old + 1u == (gen + 1u) * nloc) {
            __builtin_amdgcn_fence(__ATOMIC_RELEASE, "agent");
            asm volatile("s_waitcnt vmcnt(0)" ::: "memory");
            const unsigned og = xb_add(&bar[XB_TOP], 1u);
            const unsigned tg = og / nx;
            if (og + 1u == (tg + 1u) * nx) xb_add(&bar[XB_TOPGEN], 1u);
            else XB_SPIN(xb_ld(&bar[XB_TOPGEN]) == tg, bar);
            __builtin_amdgcn_fence(__ATOMIC_ACQUIRE, "agent");
            xb_add(&bar[XB_XGEN(b.x)], 1u);
            asm volatile("s_waitcnt vmcnt(0)" ::: "memory");
        } else {
            XB_SPIN(xb_ld(&bar[XB_XGEN(b.x)]) == gen, bar);
            __builtin_amdgcn_fence(__ATOMIC_ACQUIRE, "agent");
            asm volatile("s_waitcnt vmcnt(0)" ::: "memory");
        }
    }
    __syncthreads();
}

struct Args { const float* in[27]; float* out; unsigned char* ws; int ph_lo, ph_hi; };
enum { I_X = 0, I_C, I_CTX, I_CCTX, I_WMOD, I_BMOD, I_N1G, I_N2G, I_WIN, I_CONVW, I_CONVB, I_GAW, I_GAB, I_GXW, I_GXB, I_LAM, I_WOUT,
       I_WQKV, I_DALAM, I_SUBLN, I_WO, I_RW, I_RB, I_MG, I_MU, I_MD, I_FG };

struct Frame {
    LAS char* lds;
    int tid, lane, wave, vcu, G;
    const Args* a;
    unsigned char* ws;
};

__device__ __forceinline__ const float* modp(const Frame& F, int l, int c, int k) { return (const float*)(F.ws + WS_MOD) + (size_t)(l * 5 + c) * 6144 + k * 1024; }
__device__ __forceinline__ int cond_of(int row) { return row < NX ? (row >> 12) : 4; }

__device__ __forceinline__ int moe_up_row(int n) { return ((n >> 7) << 8) + (((n >> 5) & 3) << 6) + (((n >> 4) & 1) << 5) + (n & 15); }

template <int MODE>
__device__ __forceinline__ void transpose_item(const float* __restrict__ W, int N, bf16* __restrict__ WT, int ldT, LAS float* scr, int item, int lane) {
    const int nblk = N / 32, kb = item / nblk, nb = item % nblk, k0 = 64 * kb, n0 = 32 * nb;
#pragma unroll 8
    for (int i = 0; i < 32; ++i) { const int kk = 2 * i + (lane >> 5); scr[kk * 33 + (lane & 31)] = W[(size_t)(k0 + kk) * N + n0 + (lane & 31)]; }
    LDS_WAIT();
    const int c = lane & 7;
#pragma unroll
    for (int j = 0; j < 4; ++j) {
        const int n = (lane >> 3) + 8 * j; const LAS float* s = scr + (8 * c) * 33 + n;
        u32x4 o; o.x = pk2(s[0 * 33], s[1 * 33]); o.y = pk2(s[2 * 33], s[3 * 33]); o.z = pk2(s[4 * 33], s[5 * 33]); o.w = pk2(s[6 * 33], s[7 * 33]);
        const int nn = n0 + n;
        const int drow = (MODE == 0) ? nn : (moe_up_row(nn) + (MODE == 2 ? 16 : 0));
        *(u32x4*)(WT + (size_t)drow * ldT + k0 + 8 * c) = o;
    }
    LDS_WAIT();
}

__device__ __forceinline__ void phase_convert(Frame& F) {
    const Args& A = *F.a;
    LAS float* scr = (LAS float*)(F.lds + F.wave * 8448);
    LAS float* sil = (LAS float*)(F.lds + 69632);
    for (int i = F.tid; i < 5 * 1024; i += NTHREADS) { const int c = i >> 10, k = i & 1023; const float v = (c < 4) ? A.in[I_C][c * 1024 + k] : A.in[I_CCTX][k]; sil[i] = v / (1.0f + __expf(-v)); }
    __syncthreads();
    const int gw = F.vcu * NWAVES + F.wave, NGW = F.G * NWAVES;
    constexpr int N_MOD = 192, N_WIN = 16 * 64, N_WOUT = 16 * 32, N_WQKV = 16 * 96, N_WO = 16 * 32, N_GATE = 32 * 8, N_MOE = 64 * 256;
    constexpr int NITEMS = N_MOD + N_WIN + N_WOUT + N_WQKV + N_WO + N_GATE + 3 * N_MOE;
    for (int it = gw; it < NITEMS; it += NGW) {
        int r = it;
#if defined(DBG_SUB) && DBG_SUB == 1
        if (r >= N_MOD) break;
#endif
#if defined(DBG_SUB) && DBG_SUB == 2
        if (r < N_MOD) continue;
#endif
        if (r < N_MOD) {
            const int l = r / 96, col = (r % 96) * 64 + F.lane;
            const float* wp = A.in[I_WMOD] + (size_t)l * 1024 * 6144 + col;
            float acc[5] = {0.f, 0.f, 0.f, 0.f, 0.f};
#pragma unroll 4
            for (int k = 0; k < 1024; k += 4) {
                const float w0 = wp[(size_t)k * 6144], w1 = wp[(size_t)(k + 1) * 6144], w2 = wp[(size_t)(k + 2) * 6144], w3 = wp[(size_t)(k + 3) * 6144];
#pragma unroll
                for (int c = 0; c < 5; ++c) { const f32x4 s4 = *(const LAS f32x4*)(sil + c * 1024 + k); acc[c] += s4.x * w0 + s4.y * w1 + s4.z * w2 + s4.w * w3; }
            }
            const float bm = A.in[I_BMOD][l * 6144 + col];
            float* mo = (float*)(F.ws + WS_MOD);
#pragma unroll
            for (int c = 0; c < 5; ++c) mo[(size_t)(l * 5 + c) * 6144 + col] = acc[c] + bm;
            continue;
        }
        r -= N_MOD;
        if (r < N_WIN) { transpose_item<0>(A.in[I_WIN], 2048, (bf16*)(F.ws + WS_WIN), 1024, scr, r, F.lane); continue; } r -= N_WIN;
        if (r < N_WOUT) { transpose_item<0>(A.in[I_WOUT], 1024, (bf16*)(F.ws + WS_WOUT), 1024, scr, r, F.lane); continue; } r -= N_WOUT;
        if (r < N_WQKV) { transpose_item<0>(A.in[I_WQKV], 3072, (bf16*)(F.ws + WS_WQKV), 1024, scr, r, F.lane); continue; } r -= N_WQKV;
        if (r < N_WO) { transpose_item<0>(A.in[I_WO], 1024, (bf16*)(F.ws + WS_WO), 1024, scr, r, F.lane); continue; } r -= N_WO;
        if (r < N_GATE) {
            const int m = r >> 3, it8 = r & 7, d = m >> 4, g = (m >> 3) & 1, n = m & 7;
            const float* src = (g == 0 ? A.in[I_GAW] : A.in[I_GXW]) + (size_t)(d * 8 + n) * 128 * 128;
            transpose_item<0>(src, 128, (bf16*)(F.ws + WS_GATE) + (size_t)m * 128 * 128, 128, scr, it8, F.lane); continue;
        }
        r -= N_GATE;
        if (r < N_MOE) { const int le = r >> 8; transpose_item<1>(A.in[I_MG] + (size_t)le * 1024 * 512, 512, (bf16*)(F.ws + WS_WUP) + (size_t)le * 1024 * 1024, 1024, scr, r & 255, F.lane); continue; } r -= N_MOE;
        if (r < N_MOE) { const int le = r >> 8; transpose_item<2>(A.in[I_MU] + (size_t)le * 1024 * 512, 512, (bf16*)(F.ws + WS_WUP) + (size_t)le * 1024 * 1024, 1024, scr, r & 255, F.lane); continue; } r -= N_MOE;
        { const int le = r >> 8; transpose_item<0>(A.in[I_MD] + (size_t)le * 512 * 1024, 1024, (bf16*)(F.ws + WS_WDN) + (size_t)le * 1024 * 512, 512, scr, r & 255, F.lane); }
    }
}

__device__ __forceinline__ float row_rstd(const f32x4 (&v)[4]) {
    float s = 0.f;
#pragma unroll
    for (int j = 0; j < 4; ++j) s += (v[j].x * v[j].x + v[j].y * v[j].y) + (v[j].z * v[j].z + v[j].w * v[j].w);
    return rsqrtf(wave_sum(s) * (1.0f / D) + EPS);
}
__device__ __forceinline__ void row_modulate_store(f32x4 (&v)[4], float rstd, const float* g, const float* sc, const float* sh, bf16* dst, int lane) {
#pragma unroll
    for (int j = 0; j < 4; ++j) {
        const int c0 = 4 * lane + 256 * j;
        const f32x4 gg = *(const f32x4*)(g + c0), s1 = *(const f32x4*)(sc + c0), s0 = *(const f32x4*)(sh + c0);
        v[j] = (v[j] * rstd) * gg * (1.0f + s1) + s0;
        u32x2 o; o.x = pk2(v[j].x, v[j].y); o.y = pk2(v[j].z, v[j].w);
        *(u32x2*)(dst + c0) = o;
    }
}

__device__ __forceinline__ void phase_prep0(Frame& F) {
    const Args& A = *F.a;
    const int gw = F.vcu * NWAVES + F.wave, NGW = F.G * NWAVES;
    bf16* H = (bf16*)(F.ws + WS_H);
    for (int row = gw; row < NTOK; row += NGW) {
        const float* src = row < NX ? A.in[I_X] + (size_t)row * D : A.in[I_CTX] + (size_t)(row - NX) * D;
        const int c = cond_of(row);
        f32x4 v[4];
#pragma unroll
        for (int j = 0; j < 4; ++j) v[j] = *(const f32x4*)(src + 4 * F.lane + 256 * j);
        const float rstd = row_rstd(v);
        row_modulate_store(v, rstd, A.in[I_N1G], modp(F, 0, c, 1), modp(F, 0, c, 0), H + (size_t)row * D, F.lane);
    }
}

constexpr int GEMM_STAGE = 49152;
__device__ __forceinline__ int swz128(int row, int chunk) { return row * 128 + ((chunk ^ ((row >> 1) & 7)) << 4); }

struct ALDense {
    const bf16* p0; const bf16* p1;
    __device__ __forceinline__ void init(const bf16* A, int lda, int m0, int r0, int r1, int kc) { p0 = A + (size_t)(m0 + r0) * lda + kc; p1 = A + (size_t)(m0 + r1) * lda + kc; }
    __device__ __forceinline__ u32x4 load(int i, int k0) const { return *(const u32x4*)((i ? p1 : p0) + k0); }
};
struct ALGather {
    const bf16* p0; const bf16* p1;
    __device__ __forceinline__ void init(const bf16* A, int lda, const int* idx, int m0, int r0, int r1, int kc) { p0 = A + (size_t)idx[m0 + r0] * lda + kc; p1 = A + (size_t)idx[m0 + r1] * lda + kc; }
    __device__ __forceinline__ u32x4 load(int i, int k0) const { return *(const u32x4*)((i ? p1 : p0) + k0); }
};
struct ALCombine {
    size_t o0, o1; const bf16 *hf, *hb, *yg;
    __device__ __forceinline__ void init(const bf16* hf_, const bf16* hb_, const bf16* yg_, int m0, int r0, int r1, int kc) { hf = hf_; hb = hb_; yg = yg_; o0 = (size_t)(m0 + r0) * D + kc; o1 = (size_t)(m0 + r1) * D + kc; }
    __device__ __forceinline__ u32x4 load(int i, int k0) const {
        const size_t o = (i ? o1 : o0) + k0;
        const u32x4 a = *(const u32x4*)(hf + o), b = *(const u32x4*)(hb + o), y = *(const u32x4*)(yg + o);
        u32x4 r;
#pragma unroll
        for (int q = 0; q < 4; ++q) r[q] = pk2((bflo(a[q]) + bflo(b[q])) * bflo(y[q]), (bfhi(a[q]) + bfhi(b[q])) * bfhi(y[q]));
        return r;
    }
};

template <bool SWAP, class AL>
__device__ __forceinline__ void gemm_tile(const Frame& F, const AL& al, const bf16* __restrict__ Bt  , int K, f32x4 (&acc)[4][4]) {
    const int tid = F.tid, lane = F.lane, wid = F.wave, wr = wid >> 2, wc = wid & 3, fr = lane & 15, fq = lane >> 4;
    const int sc = tid & 7, sr = tid >> 3;
    LAS char* lds = F.lds;
    const bf16* bp = Bt + (size_t)sr * K + sc * 8;
    const size_t bstep = (size_t)64 * K;
    int wa[2], wb[4];
#pragma unroll
    for (int i = 0; i < 2; ++i) wa[i] = swz128(sr + 64 * i, sc);
#pragma unroll
    for (int i = 0; i < 4; ++i) wb[i] = 16384 + swz128(sr + 64 * i, sc);
    const int key = (fr >> 1) & 7;
    const int ra = (wr * 64 + fr) * 128, rb = 16384 + (wc * 64 + fr) * 128;
#pragma unroll
    for (int mi = 0; mi < 4; ++mi)
#pragma unroll
        for (int ni = 0; ni < 4; ++ni) acc[mi][ni] = (f32x4){0.f, 0.f, 0.f, 0.f};
    u32x4 ga[2], gb[4];
    ga[0] = al.load(0, 0); ga[1] = al.load(1, 0);
#pragma unroll
    for (int i = 0; i < 4; ++i) gb[i] = *(const u32x4*)(bp + i * bstep);
#pragma unroll
    for (int i = 0; i < 2; ++i) *(LAS u32x4*)(lds + wa[i]) = ga[i];
#pragma unroll
    for (int i = 0; i < 4; ++i) *(LAS u32x4*)(lds + wb[i]) = gb[i];
    __syncthreads();
    const int nk = K / 64;
    for (int kt = 0; kt < nk; ++kt) {
        const int cur = (kt & 1) * GEMM_STAGE, nxt = GEMM_STAGE - cur;
        if (kt + 1 < nk) {
            const int k1 = (kt + 1) * 64;
            ga[0] = al.load(0, k1); ga[1] = al.load(1, k1);
#pragma unroll
            for (int i = 0; i < 4; ++i) gb[i] = *(const u32x4*)(bp + i * bstep + k1);
        }
#pragma unroll
        for (int ks = 0; ks < 2; ++ks) {
            const int co = ((ks * 4 + fq) ^ key) << 4;
            bf16x8 af[4], bfr[4];
#pragma unroll
            for (int mi = 0; mi < 4; ++mi) af[mi] = *(const LAS bf16x8*)(lds + cur + ra + mi * 2048 + co);
#pragma unroll
            for (int ni = 0; ni < 4; ++ni) bfr[ni] = *(const LAS bf16x8*)(lds + cur + rb + ni * 2048 + co);
#pragma unroll
            for (int mi = 0; mi < 4; ++mi)
#pragma unroll
                for (int ni = 0; ni < 4; ++ni)
                    acc[mi][ni] = SWAP ? __builtin_amdgcn_mfma_f32_16x16x32_bf16(bfr[ni], af[mi], acc[mi][ni], 0, 0, 0)
                                       : __builtin_amdgcn_mfma_f32_16x16x32_bf16(af[mi], bfr[ni], acc[mi][ni], 0, 0, 0);
        }
        if (kt + 1 < nk) {
#pragma unroll
            for (int i = 0; i < 2; ++i) *(LAS u32x4*)(lds + nxt + wa[i]) = ga[i];
#pragma unroll
            for (int i = 0; i < 4; ++i) *(LAS u32x4*)(lds + nxt + wb[i]) = gb[i];
        }
        __syncthreads();
    }
}

__device__ __forceinline__ float gelu_tanh(float x) {
    const float z = 0.7978845608028654f * (x + 0.044715f * x * x * x);
    const float t = 1.0f - 2.0f / (1.0f + __expf(2.0f * z));
    return 0.5f * x * (1.0f + t);
}

__device__ __forceinline__ void phase_gemm_in(Frame& F) {
    const bf16* H = (const bf16*)(F.ws + WS_H); const bf16* W = (const bf16*)(F.ws + WS_WIN);
    bf16* YG = (bf16*)(F.ws + WS_YG); bf16* U = (bf16*)(F.ws + WS_U);
    const int wr = F.wave >> 2, wc = F.wave & 3, fr = F.lane & 15, fq = F.lane >> 4;
    constexpr int NTN = 8, NUNITS = (NTOK / 128) * NTN;
    for (int u = F.vcu; u < NUNITS; u += F.G) {
        const int mt = u / NTN, nt = u % NTN, m0 = mt * 128, n0 = nt * 256;
        ALDense al; al.init(H, D, m0, F.tid >> 3, (F.tid >> 3) + 64, (F.tid & 7) * 8);
        f32x4 acc[4][4];
        gemm_tile<true>(F, al, W + (size_t)n0 * D, D, acc);
        const bool isy = n0 < 1024;
        bf16* dst = isy ? YG : U; const int nb = isy ? n0 : n0 - 1024;
#pragma unroll
        for (int mi = 0; mi < 4; ++mi) {
            const int row = m0 + wr * 64 + mi * 16 + fr;
#pragma unroll
            for (int ni = 0; ni < 4; ++ni) {
                f32x4 v = acc[mi][ni];
                if (isy) { v.x = gelu_tanh(v.x); v.y = gelu_tanh(v.y); v.z = gelu_tanh(v.z); v.w = gelu_tanh(v.w); }
                u32x2 o; o.x = pk2(v.x, v.y); o.y = pk2(v.z, v.w);
                *(u32x2*)(dst + (size_t)row * D + nb + wc * 64 + ni * 16 + fq * 4) = o;
            }
        }
    }
}

__device__ __forceinline__ float neg_expm1(float x) {
    const float p = 1.0f + x * (0.5f + x * (0.16666667f + x * (0.041666668f + x * (0.0083333338f + x * 0.0013888889f))));
    const float ser = -x * p, big = 1.0f - __expf(x);
    return x > -0.5f ? ser : big;
}
__device__ __forceinline__ void phase_scan(Frame& F) {
    const Args& A = *F.a;
    const int wi = F.vcu;
    if (wi >= 256) return;
    const int b = wi >> 6, n = (wi >> 3) & 7, d = (wi >> 2) & 1, q = wi & 3;
    const int tid = F.tid, lane = F.lane, w = F.wave, fr = lane & 15, fq = lane >> 4;
    LAS char* RAW = F.lds;
    LAS char* AT = F.lds + 33792;
    LAS float* AGG = (LAS float*)(F.lds + 66560);
    LAS float* CIN = (LAS float*)(F.lds + 74752);
    const bf16* U = (const bf16*)(F.ws + WS_U);
    bf16* HO = (bf16*)(F.ws + (d ? WS_HB : WS_HF));
    const int chbase = n * 128, och = chbase + q * 32;
    const bf16* GT = (const bf16*)(F.ws + WS_GATE);
    LAS char* BT = F.lds + 81920;
#pragma unroll
    for (int i = 0; i < 2; ++i) {
        const int idx = tid + 512 * i, jrow = idx >> 4, c = idx & 15, nb = jrow >> 4, f2 = jrow & 15;
        *(LAS u32x4*)(BT + jrow * 256 + ((c ^ f2) << 4)) = *(const u32x4*)(GT + ((size_t)(((d * 2 + (nb >> 1)) * 8 + n) * 128 + q * 32 + (nb & 1) * 16 + f2)) * 128 + c * 8);
    }
    float ba[2], bi[2], sp8[2];
#pragma unroll
    for (int h = 0; h < 2; ++h) {
        const int ch = och + h * 16 + fr;
        ba[h] = A.in[I_GAB][d * 1024 + ch]; bi[h] = A.in[I_GXB][d * 1024 + ch];
        sp8[h] = 8.0f * log1pf(expf(-A.in[I_LAM][d * 1024 + ch]));
    }
    const int c8 = tid & 15, r0 = tid >> 4;
    LAS float* CW = (LAS float*)(F.lds + 78848);
    for (int i = tid; i < 640; i += NTHREADS) CW[i] = (i < 512) ? A.in[I_CONVW][(i >> 7) * 1024 + chbase + (i & 127)] : A.in[I_CONVB][chbase + (i - 512)];

    float hcar = 0.f;
    u32x4 pre[5];
    for (int step = 0; step < 34; ++step) {
        int segbase, seglen, tile;
        if (step < 2) { segbase = NX + b * CL; seglen = CL; tile = d ? (1 - step) : step; }
        else { segbase = b * S; seglen = S; tile = d ? (33 - step) : (step - 2); }
        const int t0 = tile * 128;
        if (step == 0) {
#pragma unroll
            for (int i = 0; i < 5; ++i) {
                const int idx = tid + 512 * i; const int row = idx >> 4, c = idx & 15; const int t = t0 - 2 + row;
                u32x4 v = (u32x4){0u, 0u, 0u, 0u};
                if (idx < 2112 && t >= 0 && t < seglen) v = *(const u32x4*)(U + (size_t)(segbase + t) * D + chbase + c * 8);
                pre[i] = v;
            }
        }
#pragma unroll
        for (int i = 0; i < 5; ++i) { const int idx = tid + 512 * i; if (idx < 2112) *(LAS u32x4*)(RAW + idx * 16) = pre[i]; }
        __syncthreads();
        if (step + 1 < 34) {
            const int s1 = step + 1; int sb1, sl1, tl1;
            if (s1 < 2) { sb1 = NX + b * CL; sl1 = CL; tl1 = d ? (1 - s1) : s1; }
            else { sb1 = b * S; sl1 = S; tl1 = d ? (33 - s1) : (s1 - 2); }
            const int t1 = tl1 * 128;
#pragma unroll
            for (int i = 0; i < 5; ++i) {
                const int idx = tid + 512 * i; const int row = idx >> 4, c = idx & 15; const int t = t1 - 2 + row;
                u32x4 v = (u32x4){0u, 0u, 0u, 0u};
                if (idx < 2112 && t >= 0 && t < sl1) v = *(const u32x4*)(U + (size_t)(sb1 + t) * D + chbase + c * 8);
                pre[i] = v;
            }
        }
#pragma unroll 1
        for (int i = 0; i < 4; ++i) {
            const int r = r0 + 32 * i;
            float o[8];
            { const f32x4 b0 = *(const LAS f32x4*)(CW + 512 + c8 * 8), b1 = *(const LAS f32x4*)(CW + 512 + c8 * 8 + 4);
              o[0] = b0.x; o[1] = b0.y; o[2] = b0.z; o[3] = b0.w; o[4] = b1.x; o[5] = b1.y; o[6] = b1.z; o[7] = b1.w; }
#pragma unroll
            for (int k = 0; k < 4; ++k) {
                const u32x4 x = *(const LAS u32x4*)(RAW + (r + k) * 256 + c8 * 16);
                const f32x4 w0 = *(const LAS f32x4*)(CW + k * 128 + c8 * 8), w1 = *(const LAS f32x4*)(CW + k * 128 + c8 * 8 + 4);
                o[0] += w0.x * bflo(x[0]); o[1] += w0.y * bfhi(x[0]); o[2] += w0.z * bflo(x[1]); o[3] += w0.w * bfhi(x[1]);
                o[4] += w1.x * bflo(x[2]); o[5] += w1.y * bfhi(x[2]); o[6] += w1.z * bflo(x[3]); o[7] += w1.w * bfhi(x[3]);
            }
            u32x4 ov; ov.x = pk2(o[0], o[1]); ov.y = pk2(o[2], o[3]); ov.z = pk2(o[4], o[5]); ov.w = pk2(o[6], o[7]);
            *(LAS u32x4*)(AT + r * 256 + ((c8 ^ (r & 15)) << 4)) = ov;
        }
        __syncthreads();
        f32x4 acc[4];
#pragma unroll
        for (int nb = 0; nb < 4; ++nb) acc[nb] = (f32x4){0.f, 0.f, 0.f, 0.f};
#pragma unroll
        for (int ks = 0; ks < 4; ++ks) {
            const int row = 16 * w + fr;
            const bf16x8 af = *(const LAS bf16x8*)(AT + row * 256 + (((4 * ks + fq) ^ fr) << 4));
#pragma unroll
            for (int nb = 0; nb < 4; ++nb) {
                const bf16x8 bq = *(const LAS bf16x8*)(BT + (nb * 16 + fr) * 256 + (((4 * ks + fq) ^ fr) << 4));
                acc[nb] = __builtin_amdgcn_mfma_f32_16x16x32_bf16(af, bq, acc[nb], 0, 0, 0);
            }
        }
        float av[2][4], bv[2][4];
#pragma unroll
        for (int h = 0; h < 2; ++h) {
            const int col = q * 32 + h * 16 + fr, chunk = col >> 3, within = col & 7;
#pragma unroll
            for (int reg = 0; reg < 4; ++reg) {
                const int tr = 16 * w + 4 * fq + reg;
                const float r_ = sigmoidf_(acc[h][reg] + ba[h]);
                const float i_ = sigmoidf_(acc[2 + h][reg] + bi[h]);
                const float la = -sp8[h] * r_;
                const float a_ = __expf(la);
                const unsigned short ub = *(const LAS unsigned short*)(AT + tr * 256 + ((chunk ^ (tr & 15)) << 4) + within * 2);
                const float uval = __builtin_bit_cast(float, (unsigned)ub << 16);
                av[h][reg] = a_;
                bv[h][reg] = sqrtf(neg_expm1(2.0f * la)) * (i_ * uval);
            }
        }
        const int g = 4 * w + fq;
#pragma unroll
        for (int h = 0; h < 2; ++h) {
            float P = 1.f, Hh = 0.f;
#pragma unroll
            for (int s = 0; s < 4; ++s) { const int reg = d ? (3 - s) : s; Hh = av[h][reg] * Hh + bv[h][reg]; P *= av[h][reg]; }
            AGG[(g * 32 + h * 16 + fr) * 2 + 0] = P; AGG[(g * 32 + h * 16 + fr) * 2 + 1] = Hh;
        }
        __syncthreads();
        if (tid < 32) {
            float hh = hcar;
            for (int gi = 0; gi < 32; ++gi) {
                const int gg = d ? (31 - gi) : gi;
                CIN[gg * 32 + tid] = hh;
                hh = AGG[(gg * 32 + tid) * 2] * hh + AGG[(gg * 32 + tid) * 2 + 1];
            }
            hcar = hh;
        }
        __syncthreads();
#pragma unroll
        for (int h = 0; h < 2; ++h) {
            float hh = CIN[g * 32 + h * 16 + fr];
            float outv[4];
#pragma unroll
            for (int s = 0; s < 4; ++s) { const int reg = d ? (3 - s) : s; hh = av[h][reg] * hh + bv[h][reg]; outv[reg] = hh; }
#pragma unroll
            for (int reg = 0; reg < 4; ++reg) {
                const int tr = 16 * w + 4 * fq + reg;
                HO[(size_t)(segbase + t0 + tr) * D + och + h * 16 + fr] = (bf16)f2bf(outv[reg]);
            }
        }
    }
}

__device__ __forceinline__ void phase_gemm_out0(Frame& F) {
    const Args& A = *F.a;
    const bf16* W = (const bf16*)(F.ws + WS_WOUT);
    float* XA = (float*)(F.ws + WS_XA);
    const int wr = F.wave >> 2, wc = F.wave & 3, fr = F.lane & 15, fq = F.lane >> 4;
    constexpr int NTN = 4, NUNITS = (NTOK / 128) * NTN;
    for (int u = F.vcu; u < NUNITS; u += F.G) {
        const int mt = u / NTN, nt = u % NTN, m0 = mt * 128, n0 = nt * 256;
        ALCombine al; al.init((const bf16*)(F.ws + WS_HF), (const bf16*)(F.ws + WS_HB), (const bf16*)(F.ws + WS_YG), m0, F.tid >> 3, (F.tid >> 3) + 64, (F.tid & 7) * 8);
        f32x4 acc[4][4];
        gemm_tile<true>(F, al, W + (size_t)n0 * D, D, acc);
#pragma unroll
        for (int mi = 0; mi < 4; ++mi) {
            const int row = m0 + wr * 64 + mi * 16 + fr;
            const float* src = row < NX ? A.in[I_X] + (size_t)row * D : A.in[I_CTX] + (size_t)(row - NX) * D;
            const float* gate = modp(F, 0, cond_of(row), 2);
#pragma unroll
            for (int ni = 0; ni < 4; ++ni) {
                const int col = n0 + wc * 64 + ni * 16 + fq * 4;
                const f32x4 s = *(const f32x4*)(src + col), gt = *(const f32x4*)(gate + col);
                *(f32x4*)(XA + (size_t)row * D + col) = s + gt * acc[mi][ni];
            }
        }
    }
}

template <int LAYER>
__device__ __forceinline__ void phase_route(Frame& F) {
    const Args& A = *F.a;
    constexpr int NT = LAYER == 0 ? NTOK : NX;
    constexpr int PER = NT / 256;
    LAS char* RW = F.lds;
    LAS int* selL = (LAS int*)(F.lds + LDS_AUX);
    LAS int* rankL = selL + 2 * 68;
    LAS int* cntL = rankL + 2 * 68;
    const int tid = F.tid, lane = F.lane;
    for (int i = 0; i < 16; ++i) {
        const int idx = tid + 512 * i, k = idx >> 3, e4 = idx & 7;
        const int rho = (((k >> 8) * 4 + (k & 3)) << 6) + ((k >> 2) & 63);
        *(LAS f32x4*)(RW + rho * 128 + ((e4 ^ ((rho >> 1) & 7)) << 4)) = *(const f32x4*)(A.in[I_RW] + (size_t)k * 32 + e4 * 4);
    }
    __syncthreads();
    const int blk = F.vcu;
    if (blk < 256) {
        const float* XA = (const float*)(F.ws + WS_XA);
        bf16* H = (bf16*)(F.ws + WS_H);
        const float rbias = A.in[I_RB][lane & 31];
        for (int li = F.wave; li < PER; li += NWAVES) {
            const int row = blk * PER + li;
            const int c = cond_of(row);
            f32x4 v[4];
#pragma unroll
            for (int j = 0; j < 4; ++j) v[j] = *(const f32x4*)(XA + (size_t)row * D + 4 * lane + 256 * j);
            const float rstd = row_rstd(v);
            row_modulate_store(v, rstd, A.in[I_N2G] + LAYER * D, modp(F, LAYER, c, 4), modp(F, LAYER, c, 3), H + (size_t)row * D, lane);
            float acc[32];
#pragma unroll
            for (int e = 0; e < 32; ++e) acc[e] = 0.f;
#pragma unroll 1
            for (int jc = 0; jc < 16; ++jc) {
                const int j = jc >> 2, c = jc & 3;
                f32x4 hv4 = v[0];
                if (j == 1) hv4 = v[1];
                if (j == 2) hv4 = v[2];
                if (j == 3) hv4 = v[3];
                float hv = hv4.x;
                if (c == 1) hv = hv4.y;
                if (c == 2) hv = hv4.z;
                if (c == 3) hv = hv4.w;
                const int rho = jc * 64 + lane;
                const LAS char* rp = RW + rho * 128; const int key = (rho >> 1) & 7;
#pragma unroll
                for (int e4 = 0; e4 < 8; ++e4) {
                    const f32x4 w4 = *(const LAS f32x4*)(rp + ((e4 ^ key) << 4));
                    acc[e4 * 4 + 0] += hv * w4.x; acc[e4 * 4 + 1] += hv * w4.y; acc[e4 * 4 + 2] += hv * w4.z; acc[e4 * 4 + 3] += hv * w4.w;
                }
            }
#pragma unroll
            for (int s = 0; s < 5; ++s) {
                const int half = 16 >> s; const bool up = (lane >> s) & 1;
#pragma unroll
                for (int i = 0; i < half; ++i) { const float keep = up ? acc[i + half] : acc[i]; const float send = up ? acc[i] : acc[i + half]; acc[i] = keep + __shfl_xor(send, 1 << s); }
            }
            float tot = acc[0] + __shfl_xor(acc[0], 32);
            const int e = lane & 31;
            const float logit = __shfl(tot, (int)(__builtin_bitreverse32((unsigned)e) >> 27));
            const float sc = 1.0f / (1.0f + expf(-logit));
            const float ss = sc + rbias;
            float m1 = ss;
#pragma unroll
            for (int o = 1; o < 8; o <<= 1) m1 = fmaxf(m1, __shfl_xor(m1, o));
            int i1 = (ss == m1) ? e : 64;
#pragma unroll
            for (int o = 1; o < 8; o <<= 1) i1 = min(i1, __shfl_xor(i1, o));
            const float s2 = (e == i1) ? -INFINITY : ss;
            float m2 = s2;
#pragma unroll
            for (int o = 1; o < 8; o <<= 1) m2 = fmaxf(m2, __shfl_xor(m2, o));
            int i2 = (s2 == m2 && e != i1) ? e : 64;
#pragma unroll
            for (int o = 1; o < 8; o <<= 1) i2 = min(i2, __shfl_xor(i2, o));
            const float gs = m1 + m2;
            float gbest = gs;
            gbest = fmaxf(gbest, __shfl_xor(gbest, 8)); gbest = fmaxf(gbest, __shfl_xor(gbest, 16));
            int gsel = (gs == gbest) ? (e >> 3) : 64;
            gsel = min(gsel, __shfl_xor(gsel, 8)); gsel = min(gsel, __shfl_xor(gsel, 16));
            const int e0 = __shfl(i1, gsel * 8), e1 = __shfl(i2, gsel * 8);
            const float w0 = __shfl(sc, e0), w1 = __shfl(sc, e1);
            if (lane == 0) {
                const float inv = 1.0f / (w0 + w1);
                selL[li * 2] = e0; selL[li * 2 + 1] = e1;
                ((float2*)(F.ws + WS_WT))[row] = make_float2(w0 * inv, w1 * inv);
                ((int2*)(F.ws + WS_SEL))[row] = make_int2(e0, e1);
            }
        }
        __syncthreads();
        if (tid < 32) {
            int cnt = 0;
            for (int i = 0; i < 2 * PER; ++i) { if (selL[i] == tid) { rankL[i] = cnt; ++cnt; } }
            ((int*)(F.ws + WS_BLKCNT))[blk * 32 + tid] = cnt;
        }
        __syncthreads();
        for (int i = tid; i < PER; i += NTHREADS) ((int2*)(F.ws + WS_LRANK))[blk * PER + i] = make_int2(rankL[2 * i], rankL[2 * i + 1]);
    }
}

template <int LAYER>
__device__ __forceinline__ void phase_slots(Frame& F) {
    constexpr int NT = LAYER == 0 ? NTOK : NX;
    constexpr int PER = NT / 256;
    LAS int* part = (LAS int*)F.lds;
    LAS int* tot = part + 1024;
    LAS int* base = tot + 32;
    LAS int* pst = base + 32;
    const int tid = F.tid, blk = F.vcu;
    const int* bc = (const int*)(F.ws + WS_BLKCNT);
    {
        const int e = tid & 31, p = tid >> 5;
        int st = 0, sb = 0;
        for (int b2 = p; b2 < 256; b2 += 16) { const int c = bc[b2 * 32 + e]; st += c; sb += (b2 < blk) ? c : 0; }
        part[p * 32 + e] = st; part[512 + p * 32 + e] = sb;
    }
    __syncthreads();
    if (tid < 32) { int st = 0, sb = 0; for (int p = 0; p < 16; ++p) { st += part[p * 32 + tid]; sb += part[512 + p * 32 + tid]; } tot[tid] = st; base[tid] = sb; }
    __syncthreads();
    if (tid == 0) { int s = 0; for (int e = 0; e < 32; ++e) { pst[e] = s; s += (tot[e] + 127) & ~127; } pst[32] = s; }
    __syncthreads();
    int* slot_tok = (int*)(F.ws + WS_SLOTTOK); float* slot_w = (float*)(F.ws + WS_SLOTW);
    if (blk == 0 && tid < 33) ((int*)(F.ws + WS_PSTART))[tid] = pst[tid];
    if (blk < 256) {
        for (int i = tid; i < PER; i += NTHREADS) {
            const int t = blk * PER + i;
            const int2 se = ((const int2*)(F.ws + WS_SEL))[t]; const int2 lr = ((const int2*)(F.ws + WS_LRANK))[t]; const float2 wt = ((const float2*)(F.ws + WS_WT))[t];
            const int s0 = pst[se.x] + base[se.x] + lr.x, s1 = pst[se.y] + base[se.y] + lr.y;
            slot_tok[s0] = t; slot_w[s0] = wt.x; slot_tok[s1] = t; slot_w[s1] = wt.y;
            ((int2*)(F.ws + WS_TOKSLOT))[t] = make_int2(s0, s1);
        }
    }
    if (blk < 32) {
        const int lo = pst[blk] + tot[blk], hi = pst[blk + 1];
        for (int s = lo + tid; s < hi; s += NTHREADS) { slot_tok[s] = 0; slot_w[s] = 0.f; }
    }
}

template <int LAYER>
__device__ __forceinline__ void phase_moe_up(Frame& F) {
    LAS int* pst = (LAS int*)(F.lds + LDS_AUX);
    if (F.tid < 33) pst[F.tid] = ((const int*)(F.ws + WS_PSTART))[F.tid];
    __syncthreads();
    const int ntiles = pst[32] >> 7, nunits = ntiles * 4;
    const bf16* H = (const bf16*)(F.ws + WS_H);
    const bf16* W = (const bf16*)(F.ws + WS_WUP) + (size_t)LAYER * 32 * 1024 * 1024;
    const int* slot_tok = (const int*)(F.ws + WS_SLOTTOK); const float* slot_w = (const float*)(F.ws + WS_SLOTW);
    bf16* G = (bf16*)(F.ws + WS_G);
    const int wr = F.wave >> 2, wc = F.wave & 3, fr = F.lane & 15, fq = F.lane >> 4;
    for (int u = F.vcu; u < nunits; u += F.G) {
        const int mt = u >> 2, j = u & 3, m0 = mt * 128;
        int e = 0;
        for (int x = 1; x < 32; ++x) e = (pst[x] <= m0) ? x : e;
        ALGather al; al.init(H, D, slot_tok, m0, F.tid >> 3, (F.tid >> 3) + 64, (F.tid & 7) * 8);
        f32x4 acc[4][4];
        gemm_tile<true>(F, al, W + ((size_t)e * 1024 + j * 256) * D, D, acc);
#pragma unroll
        for (int mi = 0; mi < 4; ++mi) {
            const int row = m0 + wr * 64 + mi * 16 + fr;
            const float wgt = slot_w[row];
#pragma unroll
            for (int p = 0; p < 2; ++p) {
                const f32x4 g = acc[mi][2 * p], uu = acc[mi][2 * p + 1];
                float o[4];
#pragma unroll
                for (int c = 0; c < 4; ++c) o[c] = g[c] / (1.0f + __expf(-g[c])) * uu[c] * wgt;
                u32x2 ov; ov.x = pk2(o[0], o[1]); ov.y = pk2(o[2], o[3]);
                *(u32x2*)(G + (size_t)row * DEXP + j * 128 + wc * 32 + p * 16 + fq * 4) = ov;
            }
        }
    }
}

template <int LAYER>
__device__ __forceinline__ void phase_moe_down(Frame& F) {
    LAS int* pst = (LAS int*)(F.lds + LDS_AUX);
    if (F.tid < 33) pst[F.tid] = ((const int*)(F.ws + WS_PSTART))[F.tid];
    __syncthreads();
    const int ntiles = pst[32] >> 7, nunits = ntiles * 4;
    const bf16* G = (const bf16*)(F.ws + WS_G);
    const bf16* W = (const bf16*)(F.ws + WS_WDN) + (size_t)LAYER * 32 * 1024 * 512;
    bf16* Y = (bf16*)(F.ws + WS_Y);
    const int wr = F.wave >> 2, wc = F.wave & 3, fr = F.lane & 15, fq = F.lane >> 4;
    for (int u = F.vcu; u < nunits; u += F.G) {
        const int mt = u >> 2, j = u & 3, m0 = mt * 128, n0 = j * 256;
        int e = 0;
        for (int x = 1; x < 32; ++x) e = (pst[x] <= m0) ? x : e;
        ALDense al; al.init(G, DEXP, m0, F.tid >> 3, (F.tid >> 3) + 64, (F.tid & 7) * 8);
        f32x4 acc[4][4];
        gemm_tile<true>(F, al, W + ((size_t)e * 1024 + n0) * DEXP, DEXP, acc);
#pragma unroll
        for (int mi = 0; mi < 4; ++mi) {
            const int row = m0 + wr * 64 + mi * 16 + fr;
#pragma unroll
            for (int ni = 0; ni < 4; ++ni) {
                const f32x4 v = acc[mi][ni];
                u32x2 o; o.x = pk2(v.x, v.y); o.y = pk2(v.z, v.w);
                *(u32x2*)(Y + (size_t)row * D + n0 + wc * 64 + ni * 16 + fq * 4) = o;
            }
        }
    }
}

__device__ __forceinline__ void combine_row(const Frame& F, int row, const float* gate, f32x4 (&v)[4]) {
    const float* XA = (const float*)(F.ws + WS_XA); const bf16* Y = (const bf16*)(F.ws + WS_Y);
    const int2 ts = ((const int2*)(F.ws + WS_TOKSLOT))[row];
#pragma unroll
    for (int j = 0; j < 4; ++j) {
        const int c0 = 4 * F.lane + 256 * j;
        const f32x4 x = *(const f32x4*)(XA + (size_t)row * D + c0), gt = *(const f32x4*)(gate + c0);
        const u32x2 y0 = *(const u32x2*)(Y + (size_t)ts.x * D + c0), y1 = *(const u32x2*)(Y + (size_t)ts.y * D + c0);
        f32x4 y; y.x = bflo(y0.x) + bflo(y1.x); y.y = bfhi(y0.x) + bfhi(y1.x); y.z = bflo(y0.y) + bflo(y1.y); y.w = bfhi(y0.y) + bfhi(y1.y);
        v[j] = x + gt * y;
    }
}

__device__ __forceinline__ void phase_combine0(Frame& F) {
    const Args& A = *F.a;
    const int gw = F.vcu * NWAVES + F.wave, NGW = F.G * NWAVES;
    float* XA = (float*)(F.ws + WS_XA); bf16* H = (bf16*)(F.ws + WS_H);
    for (int row = gw; row < NTOK; row += NGW) {
        const int c = cond_of(row);
        f32x4 v[4];
        combine_row(F, row, modp(F, 0, c, 5), v);
#pragma unroll
        for (int j = 0; j < 4; ++j) *(f32x4*)(XA + (size_t)row * D + 4 * F.lane + 256 * j) = v[j];
        const float rstd = row_rstd(v);
        row_modulate_store(v, rstd, A.in[I_N1G] + D, modp(F, 1, c, 1), modp(F, 1, c, 0), H + (size_t)row * D, F.lane);
    }
}

constexpr float QSCALE = 0.125f * 1.4426950408889634f;
__device__ __forceinline__ void phase_qkv(Frame& F) {
    LAS float* CS = (LAS float*)(F.lds + LDS_AUX);
    for (int i = F.tid; i < 1024; i += NTHREADS) {
        const int p = i >> 4, f = i & 15;
        const float inv = 1.0f / powf(10000.0f, (float)f / 16.0f);
        const float ang = (float)p * inv;
        const double rev = (double)ang * 0.15915494309189535;
        const float fr_ = (float)(rev - floor(rev));
        CS[i * 2] = __builtin_amdgcn_cosf(fr_); CS[i * 2 + 1] = __builtin_amdgcn_sinf(fr_);
    }
    __syncthreads();
    const bf16* H = (const bf16*)(F.ws + WS_H); const bf16* W = (const bf16*)(F.ws + WS_WQKV);
    bf16* Q = (bf16*)(F.ws + WS_Q); bf16* Kb = (bf16*)(F.ws + WS_K); bf16* VT = (bf16*)(F.ws + WS_VT);
    const int wr = F.wave >> 2, wc = F.wave & 3, fr = F.lane & 15, fq = F.lane >> 4;
    constexpr int NTN = 12, NUNITS = (NTOK / 128) * NTN;
    for (int u = F.vcu; u < NUNITS; u += F.G) {
        const int mt = u / NTN, nt = u % NTN, m0 = mt * 128, n0 = nt * 256;
        const bool isctx = m0 >= NX;
        if (isctx && nt < 4) continue;
        ALDense al; al.init(H, D, m0, F.tid >> 3, (F.tid >> 3) + 64, (F.tid & 7) * 8);
        f32x4 acc[4][4];
        if (nt < 8) {
            gemm_tile<true>(F, al, W + (size_t)n0 * D, D, acc);
            const int hi2 = ((n0 & 1023) >> 6) + wc;
            const bool isq = nt < 4;
#pragma unroll
            for (int mi = 0; mi < 4; ++mi) {
                const int row = m0 + wr * 64 + mi * 16 + fr;
                int b, pos;
                if (!isctx) { b = row >> 12; pos = row & 4095; } else { b = (row - NX) >> 8; pos = S + ((row - NX) & 255); }
                f32x4 o[4];
                if (!isctx) {
                    const int rp = pos >> 6, cp = pos & 63;
#pragma unroll
                    for (int ni = 0; ni < 4; ++ni) {
                        const int p = (ni >> 1) ? cp : rp;
                        const f32x4 xv = acc[mi][ni], pv = acc[mi][ni ^ 1];
#pragma unroll
                        for (int c = 0; c < 4; ++c) {
                            const float cs = CS[(p * 16 + fq * 4 + c) * 2], sn = CS[(p * 16 + fq * 4 + c) * 2 + 1];
                            o[ni][c] = xv[c] * cs + ((ni & 1) ? pv[c] : -pv[c]) * sn;
                        }
                    }
                } else {
#pragma unroll
                    for (int ni = 0; ni < 4; ++ni) o[ni] = acc[mi][ni];
                }
                bf16* dst = isq ? Q + ((size_t)(b * 16 + hi2) * S + pos) * 64 : Kb + ((size_t)(b * 16 + hi2) * KEYS + pos) * 64;
                const float scl = isq ? QSCALE : 1.0f;
#pragma unroll
                for (int ni = 0; ni < 4; ++ni) {
                    u32x2 ov; ov.x = pk2(o[ni].x * scl, o[ni].y * scl); ov.y = pk2(o[ni].z * scl, o[ni].w * scl);
                    *(u32x2*)(dst + ni * 16 + fq * 4) = ov;
                }
            }
        } else {
            gemm_tile<false>(F, al, W + (size_t)n0 * D, D, acc);
#pragma unroll
            for (int mi = 0; mi < 4; ++mi) {
                const int row = m0 + wr * 64 + mi * 16 + fq * 4;
                int b, pos;
                if (!isctx) { b = row >> 12; pos = row & 4095; } else { b = (row - NX) >> 8; pos = S + ((row - NX) & 255); }
#pragma unroll
                for (int ni = 0; ni < 4; ++ni) {
                    const int col = (n0 - 2048) + wc * 64 + ni * 16 + fr, h = col >> 7, vd = col & 127;
                    const f32x4 v = acc[mi][ni];
                    u32x2 ov; ov.x = pk2(v.x, v.y); ov.y = pk2(v.z, v.w);
                    *(u32x2*)(VT + ((size_t)(b * 8 + h) * 128 + vd) * KEYS + pos) = ov;
                }
            }
        }
    }
}

constexpr int ATT_STAGE = 32768;
__device__ __forceinline__ int crow(int r, int hi) { return (r & 3) + 8 * (r >> 2) + 4 * hi; }
__device__ __forceinline__ void phase_attn(Frame& F) {
    const Args& A = *F.a;
    const int tid = F.tid, lane = F.lane, w = F.wave, r32 = lane & 31, hi = lane >> 5;
    const int mp = w >> 2, wq = w & 3;
    LAS char* lds = F.lds;
    float lam;
    { const float* dl = A.in[I_DALAM]; const float s1 = wave_sum(dl[lane] * dl[64 + lane]), s2 = wave_sum(dl[128 + lane] * dl[192 + lane]);
      lam = expf(s1) - expf(s2) + (0.8f - 0.6f * expf(-0.3f)); }
    const float oscale = 1.0f - (0.8f - 0.6f * expf(-0.3f));
    const bf16* Q = (const bf16*)(F.ws + WS_Q); const bf16* Kb = (const bf16*)(F.ws + WS_K); const bf16* VT = (const bf16*)(F.ws + WS_VT);
    bf16* AO = (bf16*)(F.ws + WS_AO);
    constexpr int NUNITS = NB * 8 * (S / 128), NTILES = KEYS / 64;
    for (int u = F.vcu; u < NUNITS; u += F.G) {
        const int bh = u >> 5, qb = u & 31, q0 = qb * 128;
        const bf16* Kg[2]; Kg[0] = Kb + (size_t)(bh * 2 + 0) * KEYS * 64; Kg[1] = Kb + (size_t)(bh * 2 + 1) * KEYS * 64;
        const bf16* Vg = VT + (size_t)bh * 128 * KEYS;
        bf16x8 qf[4];
        { const bf16* qp = Q + ((size_t)(bh * 2 + mp) * S + q0 + wq * 32 + r32) * 64;
#pragma unroll
          for (int ks = 0; ks < 4; ++ks) qf[ks] = *(const bf16x8*)(qp + ks * 16 + hi * 8); }
        f32x16 o[4];
#pragma unroll
        for (int vb = 0; vb < 4; ++vb)
#pragma unroll
            for (int r = 0; r < 16; ++r) o[vb][r] = 0.f;
        float mrun = -1e30f, lrun = 0.f;
        u32x4 pre[4];
        auto gload = [&](int t) {
#pragma unroll
            for (int i = 0; i < 4; ++i) {
                const int idx = tid + 512 * i;
                if (i < 2) { const int row = (idx & 511) >> 3, c = idx & 7; pre[i] = *(const u32x4*)(Kg[i] + (size_t)(t * 64 + row) * 64 + c * 8); }
                else { const int row = (idx - 1024) >> 3, c = idx & 7; pre[i] = *(const u32x4*)(Vg + (size_t)row * KEYS + t * 64 + c * 8); }
            }
        };
        auto lstore = [&](int st) {
#pragma unroll
            for (int i = 0; i < 4; ++i) {
                const int idx = tid + 512 * i;
                if (i < 2) { const int row = (idx & 511) >> 3, c = idx & 7; *(LAS u32x4*)(lds + st * ATT_STAGE + i * 8192 + swz128(row, c)) = pre[i]; }
                else { const int row = (idx - 1024) >> 3, c = idx & 7; *(LAS u32x4*)(lds + st * ATT_STAGE + 16384 + swz128(row, c)) = pre[i]; }
            }
        };
        gload(0); lstore(0);
        __syncthreads();
        for (int t = 0; t < NTILES; ++t) {
            const int st = t & 1;
            if (t + 1 < NTILES) gload(t + 1);
            const LAS char* Kt = lds + st * ATT_STAGE + mp * 8192;
            const LAS char* Vt = lds + st * ATT_STAGE + 16384;
            f32x16 s0, s1;
#pragma unroll
            for (int r = 0; r < 16; ++r) { s0[r] = 0.f; s1[r] = 0.f; }
#pragma unroll
            for (int ks = 0; ks < 4; ++ks) {
                const bf16x8 k0 = *(const LAS bf16x8*)(Kt + swz128(r32, 2 * ks + hi));
                const bf16x8 k1 = *(const LAS bf16x8*)(Kt + swz128(32 + r32, 2 * ks + hi));
                s0 = __builtin_amdgcn_mfma_f32_32x32x16_bf16(k0, qf[ks], s0, 0, 0, 0);
                s1 = __builtin_amdgcn_mfma_f32_32x32x16_bf16(k1, qf[ks], s1, 0, 0, 0);
            }
            float mx = s0[0];
#pragma unroll
            for (int r = 1; r < 16; ++r) mx = fmaxf(mx, s0[r]);
#pragma unroll
            for (int r = 0; r < 16; ++r) mx = fmaxf(mx, s1[r]);
            mx = fmaxf(mx, __shfl_xor(mx, 32));
            const float mnew = fmaxf(mrun, mx);
            const float alpha = __builtin_amdgcn_exp2f(mrun - mnew);
            mrun = mnew;
            float psum = 0.f;
#pragma unroll
            for (int r = 0; r < 16; ++r) { s0[r] = __builtin_amdgcn_exp2f(s0[r] - mnew); s1[r] = __builtin_amdgcn_exp2f(s1[r] - mnew); psum += s0[r] + s1[r]; }
            lrun = lrun * alpha + psum;
#pragma unroll
            for (int vb = 0; vb < 4; ++vb)
#pragma unroll
                for (int r = 0; r < 16; ++r) o[vb][r] *= alpha;
            bf16x8 pf[4];
#pragma unroll
            for (int s = 0; s < 2; ++s) {
                u32x4 a, b2;
                a.x = pk2(s0[8 * s + 0], s0[8 * s + 1]); a.y = pk2(s0[8 * s + 2], s0[8 * s + 3]); a.z = pk2(s0[8 * s + 4], s0[8 * s + 5]); a.w = pk2(s0[8 * s + 6], s0[8 * s + 7]);
                b2.x = pk2(s1[8 * s + 0], s1[8 * s + 1]); b2.y = pk2(s1[8 * s + 2], s1[8 * s + 3]); b2.z = pk2(s1[8 * s + 4], s1[8 * s + 5]); b2.w = pk2(s1[8 * s + 6], s1[8 * s + 7]);
                pf[s] = __builtin_bit_cast(bf16x8, a); pf[2 + s] = __builtin_bit_cast(bf16x8, b2);
            }
#pragma unroll
            for (int vb = 0; vb < 4; ++vb) {
                const int vrow = vb * 32 + r32;
#pragma unroll
                for (int kk = 0; kk < 4; ++kk) {
                    const u32x2 lo = *(const LAS u32x2*)(Vt + swz128(vrow, 2 * kk) + 8 * hi);
                    const u32x2 hi2 = *(const LAS u32x2*)(Vt + swz128(vrow, 2 * kk + 1) + 8 * hi);
                    u32x4 av; av.x = lo.x; av.y = lo.y; av.z = hi2.x; av.w = hi2.y;
                    o[vb] = __builtin_amdgcn_mfma_f32_32x32x16_bf16(__builtin_bit_cast(bf16x8, av), pf[kk], o[vb], 0, 0, 0);
                }
            }
            if (t + 1 < NTILES) lstore(st ^ 1);
            __syncthreads();
        }
        lrun += __shfl_xor(lrun, 32);
        const float linv = 1.0f / lrun;
        LAS float* XO = (LAS float*)lds;
        if (mp == 1) {
#pragma unroll
            for (int vb = 0; vb < 4; ++vb)
#pragma unroll
                for (int r = 0; r < 16; ++r) XO[(wq * 64 + vb * 16 + r) * 64 + lane] = o[vb][r] * linv;
        }
        __syncthreads();
        if (mp == 0) {
            float ssq = 0.f;
#pragma unroll
            for (int vb = 0; vb < 4; ++vb)
#pragma unroll
                for (int r = 0; r < 16; ++r) { const float v = o[vb][r] * linv - lam * XO[(wq * 64 + vb * 16 + r) * 64 + lane]; o[vb][r] = v; ssq += v * v; }
            ssq += __shfl_xor(ssq, 32);
            const float rstd = rsqrtf(ssq * (1.0f / 128.0f) + EPS) * oscale;
            const int b = bh >> 3, h = bh & 7;
            bf16* dst = AO + (size_t)(b * S + q0 + wq * 32 + r32) * D + h * 128;
            const float* sg = A.in[I_SUBLN];
#pragma unroll
            for (int vb = 0; vb < 4; ++vb)
#pragma unroll
                for (int rq = 0; rq < 4; ++rq) {
                    const int v0 = vb * 32 + 8 * rq + 4 * hi;
                    const f32x4 g4 = *(const f32x4*)(sg + v0);
                    u32x2 ov; ov.x = pk2(o[vb][4 * rq] * rstd * g4.x, o[vb][4 * rq + 1] * rstd * g4.y); ov.y = pk2(o[vb][4 * rq + 2] * rstd * g4.z, o[vb][4 * rq + 3] * rstd * g4.w);
                    *(u32x2*)(dst + v0) = ov;
                }
        }
        __syncthreads();
    }
}

__device__ __forceinline__ void phase_gemm_wo(Frame& F) {
    const bf16* AO = (const bf16*)(F.ws + WS_AO); const bf16* W = (const bf16*)(F.ws + WS_WO);
    float* XA = (float*)(F.ws + WS_XA);
    const int wr = F.wave >> 2, wc = F.wave & 3, fr = F.lane & 15, fq = F.lane >> 4;
    constexpr int NTN = 4, NUNITS = (NX / 128) * NTN;
    for (int u = F.vcu; u < NUNITS; u += F.G) {
        const int mt = u / NTN, nt = u % NTN, m0 = mt * 128, n0 = nt * 256;
        ALDense al; al.init(AO, D, m0, F.tid >> 3, (F.tid >> 3) + 64, (F.tid & 7) * 8);
        f32x4 acc[4][4];
        gemm_tile<true>(F, al, W + (size_t)n0 * D, D, acc);
#pragma unroll
        for (int mi = 0; mi < 4; ++mi) {
            const int row = m0 + wr * 64 + mi * 16 + fr;
            const float* gate = modp(F, 1, row >> 12, 2);
#pragma unroll
            for (int ni = 0; ni < 4; ++ni) {
                const int col = n0 + wc * 64 + ni * 16 + fq * 4;
                float* xp = XA + (size_t)row * D + col;
                const f32x4 s = *(const f32x4*)xp, gt = *(const f32x4*)(gate + col);
                *(f32x4*)xp = s + gt * acc[mi][ni];
            }
        }
    }
}

__device__ __forceinline__ void phase_final(Frame& F) {
    const Args& A = *F.a;
    const int gw = F.vcu * NWAVES + F.wave, NGW = F.G * NWAVES;
    for (int row = gw; row < NX; row += NGW) {
        f32x4 v[4];
        combine_row(F, row, modp(F, 1, row >> 12, 5), v);
        const float rstd = row_rstd(v);
#pragma unroll
        for (int j = 0; j < 4; ++j) {
            const int c0 = 4 * F.lane + 256 * j;
            const f32x4 g = *(const f32x4*)(A.in[I_FG] + c0);
            *(f32x4*)(A.out + (size_t)row * D + c0) = (v[j] * rstd) * g;
        }
    }
}

__global__ void __launch_bounds__(NTHREADS) fwd_kernel(Args args) {
    extern __shared__ __attribute__((aligned(16))) unsigned char smem[];
    Frame F;
    F.lds = (LAS char*)smem;
    F.tid = threadIdx.x; F.lane = F.tid & 63; F.wave = __builtin_amdgcn_readfirstlane(F.tid >> 6);
    F.G = gridDim.x; { const int bx = blockIdx.x; F.vcu = (F.G % 8 == 0) ? (bx % 8) * (F.G / 8) + bx / 8 : bx; }
    F.a = &args; F.ws = args.ws;
    volatile LAS unsigned* xbw = (volatile LAS unsigned*)(F.lds + LDS_XB);
    if (F.tid < 4) xbw[F.tid] = 0u;
    __syncthreads();
    XcdBarrier bar; bar.bar = (unsigned*)(F.ws + WS_CTL); bar.x = 0; bar.st = xbw;
    const int lo = args.ph_lo, hi = args.ph_hi;
    const bool multi = (hi - lo) > 1;
    if (multi) bar = xcd_barrier_post((unsigned*)(F.ws + WS_CTL), xbw);
#define RUN_PHASE(k, call) do { if (lo <= (k) && (k) < hi) { call; if ((k) + 1 < hi) xcd_barrier(bar); } } while (0)
    RUN_PHASE(0, phase_convert(F));
    RUN_PHASE(1, phase_prep0(F));
    RUN_PHASE(2, phase_gemm_in(F));
    RUN_PHASE(3, phase_scan(F));
    RUN_PHASE(4, phase_gemm_out0(F));
    RUN_PHASE(5, phase_route<0>(F));
    RUN_PHASE(6, phase_slots<0>(F));
    RUN_PHASE(7, phase_moe_up<0>(F));
    RUN_PHASE(8, phase_moe_down<0>(F));
    RUN_PHASE(9, phase_combine0(F));
    RUN_PHASE(10, phase_qkv(F));
    RUN_PHASE(11, phase_attn(F));
    RUN_PHASE(12, phase_gemm_wo(F));
    RUN_PHASE(13, phase_route<1>(F));
    RUN_PHASE(14, phase_slots<1>(F));
    RUN_PHASE(15, phase_moe_up<1>(F));
    RUN_PHASE(16, phase_moe_down<1>(F));
    RUN_PHASE(17, phase_final(F));
#undef RUN_PHASE
}

extern "C" void kernel_launch(void* const* d_in, const int* in_sizes, int n_in, void* d_out, int out_size, void* d_ws, size_t ws_size, hipStream_t stream) {
    static int grid = 0;
    if (grid == 0) {
        if (n_in != 27 || out_size != NX * D || ws_size < WS_END) { fprintf(stderr, "kernel_launch: unexpected shapes (n_in %d out %d ws %zu)\n", n_in, out_size, ws_size); grid = -1; return; }
        int dev = 0, cus = 0;
        if (hipGetDevice(&dev) != hipSuccess || hipDeviceGetAttribute(&cus, hipDeviceAttributeMultiprocessorCount, dev) != hipSuccess) { grid = -1; return; }
        if (hipFuncSetAttribute((const void*)fwd_kernel, hipFuncAttributeMaxDynamicSharedMemorySize, LDS_BYTES) != hipSuccess) { fprintf(stderr, "kernel_launch: hipFuncSetAttribute failed\n"); grid = -1; return; }
        (void)hipGetLastError();
        grid = cus < 256 ? cus : 256;
    }
    if (grid < 0) return;
    (void)hipMemsetAsync((char*)d_ws + WS_CTL, 0, CTL_ZERO_BYTES, stream);
    Args a{};
    for (int i = 0; i < 27; ++i) a.in[i] = (const float*)d_in[i];
    a.out = (float*)d_out; a.ws = (unsigned char*)d_ws;
    if (MK_N_LAUNCHES == 1) {
        a.ph_lo = 0; a.ph_hi = NPHASES;
        hipLaunchKernelGGL(fwd_kernel, dim3(grid), dim3(NTHREADS), LDS_BYTES, stream, a);
    } else {
        if (DBG_NPH == 0) { a.ph_lo = 0; a.ph_hi = 0; hipLaunchKernelGGL(fwd_kernel, dim3(grid), dim3(NTHREADS), LDS_BYTES, stream, a); }
        for (int p = 0; p < DBG_NPH; ++p) { a.ph_lo = p; a.ph_hi = p + 1; hipLaunchKernelGGL(fwd_kernel, dim3(grid), dim3(NTHREADS), LDS_BYTES, stream, a); }
    }
}
```

```cpp
#include <hip/hip_runtime.h>
#include <cstdio>
#include <cstdint>

#ifndef MK_N_LAUNCHES
#define MK_N_LAUNCHES 1
#endif

#ifndef DBG_NPH
#define DBG_NPH 18
#endif
#define LAS __attribute__((address_space(3)))
typedef unsigned short bf16;
typedef short bf16x8 __attribute__((ext_vector_type(8)));
typedef float f32x4 __attribute__((ext_vector_type(4)));
typedef float f32x16 __attribute__((ext_vector_type(16)));
typedef unsigned u32x4 __attribute__((ext_vector_type(4)));
typedef unsigned u32x2 __attribute__((ext_vector_type(2)));
typedef float f32x2 __attribute__((ext_vector_type(2)));

constexpr int D = 1024, NB = 4, S = 4096, CL = 256;
constexpr int NX = NB * S, NC = NB * CL, NTOK = NX + NC;
constexpr int NEXP = 32, DEXP = 512;
constexpr int NWAVES = 8, NTHREADS = 512;
constexpr int KEYS = S + CL;
constexpr float EPS = 1e-6f;
constexpr int PMAX = 43008;
constexpr int NPHASES = 18;

constexpr size_t MiB = 1u << 20;
constexpr size_t WS_CTL = 0, CTL_ZERO_BYTES = 64 * 1024;
constexpr size_t WS_MOD = 1 * MiB;
constexpr size_t WS_SEL = 2 * MiB;
constexpr size_t WS_WT = WS_SEL + 256 * 1024;
constexpr size_t WS_LRANK = WS_WT + 256 * 1024;
constexpr size_t WS_TOKSLOT = WS_LRANK + 256 * 1024;
constexpr size_t WS_BLKCNT = WS_TOKSLOT + 256 * 1024;
constexpr size_t WS_PSTART = WS_BLKCNT + 64 * 1024;
constexpr size_t WS_SLOTTOK = 3 * MiB + 512 * 1024;
constexpr size_t WS_SLOTW = WS_SLOTTOK + 256 * 1024;
constexpr size_t WS_WIN = 4 * MiB;
constexpr size_t WS_WOUT = 8 * MiB;
constexpr size_t WS_GATE = 10 * MiB;
constexpr size_t WS_WQKV = 11 * MiB;
constexpr size_t WS_WO = 17 * MiB;
constexpr size_t WS_WUP = 20 * MiB;
constexpr size_t WS_WDN = 148 * MiB;
constexpr size_t WS_XA = 212 * MiB;
constexpr size_t WS_H = 280 * MiB;
constexpr size_t WS_R = 314 * MiB;
constexpr size_t WS_YG = WS_R, WS_U = WS_R + 34 * MiB, WS_HF = WS_R + 68 * MiB, WS_HB = WS_R + 102 * MiB;
constexpr size_t WS_G = WS_R, WS_Y = WS_R + 42 * MiB;
constexpr size_t WS_Q = WS_R, WS_K = WS_R + 32 * MiB, WS_VT = WS_R + 66 * MiB, WS_AO = WS_R + 100 * MiB;
constexpr size_t WS_END = 450 * MiB;
static_assert(WS_Y + (size_t)PMAX * 1024 * 2 <= WS_END && WS_HB + 34 * MiB <= WS_END && WS_AO + 32 * MiB <= WS_END, "ws map");
static_assert(WS_K + (size_t)NB * 8 * 2 * KEYS * 64 * 2 <= WS_VT && WS_VT + (size_t)NB * 8 * 128 * KEYS * 2 <= WS_AO, "attn map");

constexpr int LDS_BYTES = 147456;
constexpr int LDS_XB = LDS_BYTES - 64;
constexpr int LDS_AUX = 131072;

__device__ __forceinline__ unsigned f2bf(float f) { unsigned u = __builtin_bit_cast(unsigned, f); return (u + 0x7fffu + ((u >> 16) & 1u)) >> 16; }
__device__ __forceinline__ unsigned pk2(float lo, float hi) { return f2bf(lo) | (f2bf(hi) << 16); }
__device__ __forceinline__ float bflo(unsigned w) { return __builtin_bit_cast(float, w << 16); }
__device__ __forceinline__ float bfhi(unsigned w) { return __builtin_bit_cast(float, w & 0xffff0000u); }
__device__ __forceinline__ float wave_sum(float v) {
#pragma unroll
    for (int o = 1; o < 64; o <<= 1) v += __shfl_xor(v, o);
    return v;
}
__device__ __forceinline__ float sigmoidf_(float x) { return 1.0f / (1.0f + __expf(-x)); }
#define LDS_WAIT() asm volatile("s_waitcnt lgkmcnt(0)" ::: "memory")

#define XB_TMO      128
#define XB_XCNT(j)  (256  + 64 * (j))
#define XB_XSUB(j)  (1280 + 64 * (j))
#define XB_XGEN(j)  (2304 + 64 * (j))
#define XB_TOP      3328
#define XB_TOPGEN   3392
#define XCD_BAR_WORDS 3456
#define XB_SPIN_CAP (1u << 18)
__device__ __forceinline__ unsigned xb_ld(unsigned* p)              { return __hip_atomic_load(p, __ATOMIC_RELAXED, __HIP_MEMORY_SCOPE_AGENT); }
__device__ __forceinline__ unsigned xb_add(unsigned* p, unsigned v) { return __hip_atomic_fetch_add(p, v, __ATOMIC_RELAXED, __HIP_MEMORY_SCOPE_AGENT); }
__device__ __forceinline__ unsigned xb_xcc_id() { return (unsigned)__builtin_amdgcn_s_getreg((3 << 11) | 20) & 0xFu; }
#define XB_SPIN(cond, bar) do { unsigned _sp = 0; while (cond) { __builtin_amdgcn_s_sleep(1); \
    if ((++_sp & 255u) == 0u) { if (xb_ld(&(bar)[XB_TMO])) break; if (_sp > XB_SPIN_CAP) { atomicAdd(&(bar)[XB_TMO], 1u); break; } } } } while (0)
struct XcdBarrier { unsigned* bar; unsigned x; volatile LAS unsigned* st; };
__device__ __forceinline__ XcdBarrier xcd_barrier_post(unsigned* bar, volatile LAS unsigned* st) {
    XcdBarrier b; b.bar = bar; b.x = xb_xcc_id(); b.st = st;
    if (threadIdx.x == 0) (void)xb_add(&bar[XB_XCNT(b.x)], 1u);
    return b;
}
__device__ __forceinline__ void xcd_barrier_complete(unsigned* bar, unsigned x, unsigned& nloc, unsigned& nx) {
    const unsigned G = gridDim.x * gridDim.y * gridDim.z;
    unsigned sum, cnt, mine, sp = 0u;
    for (;;) {
        sum = 0u; cnt = 0u; mine = 0u;
#pragma unroll
        for (unsigned j = 0; j < 16; ++j) { const unsigned c = xb_ld(&bar[XB_XCNT(j)]); sum += c; cnt += (c > 0u) ? 1u : 0u; mine = (j == x) ? c : mine; }
        if (sum == G) break;
        __builtin_amdgcn_s_sleep(1);
        if ((++sp & 255u) == 0u) { if (xb_ld(&bar[XB_TMO])) break; if (sp > XB_SPIN_CAP) { atomicAdd(&bar[XB_TMO], 1u); break; } }
    }
    nloc = mine > 0u ? mine : 1u; nx = cnt > 0u ? cnt : 1u;
}
__device__ __forceinline__ void xcd_barrier(const XcdBarrier& b) {
    asm volatile("s_waitcnt vmcnt(0)" ::: "memory");
    __syncthreads();
    if (threadIdx.x == 0) {
        unsigned* bar = b.bar;
        __builtin_amdgcn_s_waitcnt(0);
        unsigned nloc = b.st[0], nx = b.st[1];
        if (nloc == 0u) { xcd_barrier_complete(bar, b.x, nloc, nx); b.st[0] = nloc; b.st[1] = nx; }
        const unsigned old = xb_add(&bar[XB_XSUB(b.x)], 1u);
        const unsigned gen = old / nloc;
        if (old + 1u == (gen + 1u) * nloc) {
            __builtin_amdgcn_fence(__ATOMIC_RELEASE, "agent");
            asm volatile("s_waitcnt vmcnt(0)" ::: "memory");
            const unsigned og = xb_add(&bar[XB_TOP], 1u);
            const unsigned tg = og / nx;
            if (og + 1u == (tg + 1u) * nx) xb_add(&bar[XB_TOPGEN], 1u);
            else XB_SPIN(xb_ld(&bar[XB_TOPGEN]) == tg, bar);
            __builtin_amdgcn_fence(__ATOMIC_ACQUIRE, "agent");
            xb_add(&bar[XB_XGEN(b.x)], 1u);
            asm volatile("s_waitcnt vmcnt(0)" ::: "memory");
        } else {
            XB_SPIN(xb_ld(&bar[XB_XGEN(b.x)]) == gen, bar);
            __builtin_amdgcn_fence(__ATOMIC_ACQUIRE, "agent");
            asm volatile("s_waitcnt vmcnt(0)" ::: "memory");
        }
    }
    __syncthreads();
}

struct Args { const float* in[27]; float* out; unsigned char* ws; int ph_lo, ph_hi; };
enum { I_X = 0, I_C, I_CTX, I_CCTX, I_WMOD, I_BMOD, I_N1G, I_N2G, I_WIN, I_CONVW, I_CONVB, I_GAW, I_GAB, I_GXW, I_GXB, I_LAM, I_WOUT,
       I_WQKV, I_DALAM, I_SUBLN, I_WO, I_RW, I_RB, I_MG, I_MU, I_MD, I_FG };

struct Frame {
    LAS char* lds;
    int tid, lane, wave, vcu, G;
    const Args* a;
    unsigned char* ws;
};

__device__ __forceinline__ const float* modp(const Frame& F, int l, int c, int k) { return (const float*)(F.ws + WS_MOD) + (size_t)(l * 5 + c) * 6144 + k * 1024; }
__device__ __forceinline__ int cond_of(int row) { return row < NX ? (row >> 12) : 4; }

__device__ __forceinline__ int moe_up_row(int n) { return ((n >> 7) << 8) + (((n >> 5) & 3) << 6) + (((n >> 4) & 1) << 5) + (n & 15); }

template <int MODE>
__device__ __forceinline__ void transpose_item(const float* __restrict__ W, int N, bf16* __restrict__ WT, int ldT, LAS float* scr, int item, int lane) {
    const int nblk = N / 32, kb = item / nblk, nb = item % nblk, k0 = 64 * kb, n0 = 32 * nb;
#pragma unroll 8
    for (int i = 0; i < 32; ++i) { const int kk = 2 * i + (lane >> 5); scr[kk * 33 + (lane & 31)] = W[(size_t)(k0 + kk) * N + n0 + (lane & 31)]; }
    LDS_WAIT();
    const int c = lane & 7;
#pragma unroll
    for (int j = 0; j < 4; ++j) {
        const int n = (lane >> 3) + 8 * j; const LAS float* s = scr + (8 * c) * 33 + n;
        u32x4 o; o.x = pk2(s[0 * 33], s[1 * 33]); o.y = pk2(s[2 * 33], s[3 * 33]); o.z = pk2(s[4 * 33], s[5 * 33]); o.w = pk2(s[6 * 33], s[7 * 33]);
        const int nn = n0 + n;
        const int drow = (MODE == 0) ? nn : (moe_up_row(nn) + (MODE == 2 ? 16 : 0));
        *(u32x4*)(WT + (size_t)drow * ldT + k0 + 8 * c) = o;
    }
    LDS_WAIT();
}

__device__ __forceinline__ void phase_convert(Frame& F) {
    const Args& A = *F.a;
    LAS float* scr = (LAS float*)(F.lds + F.wave * 8448);
    LAS float* sil = (LAS float*)(F.lds + 69632);
    for (int i = F.tid; i < 5 * 1024; i += NTHREADS) { const int c = i >> 10, k = i & 1023; const float v = (c < 4) ? A.in[I_C][c * 1024 + k] : A.in[I_CCTX][k]; sil[i] = v / (1.0f + __expf(-v)); }
    __syncthreads();
    const int gw = F.vcu * NWAVES + F.wave, NGW = F.G * NWAVES;
    constexpr int N_MOD = 192, N_WIN = 16 * 64, N_WOUT = 16 * 32, N_WQKV = 16 * 96, N_WO = 16 * 32, N_GATE = 32 * 8, N_MOE = 64 * 256;
    constexpr int NITEMS = N_MOD + N_WIN + N_WOUT + N_WQKV + N_WO + N_GATE + 3 * N_MOE;
    for (int it = gw; it < NITEMS; it += NGW) {
        int r = it;
#if defined(DBG_SUB) && DBG_SUB == 1
        if (r >= N_MOD) break;
#endif
#if defined(DBG_SUB) && DBG_SUB == 2
        if (r < N_MOD) continue;
#endif
        if (r < N_MOD) {
            const int l = r / 96, col = (r % 96) * 64 + F.lane;
            const float* wp = A.in[I_WMOD] + (size_t)l * 1024 * 6144 + col;
            float acc[5] = {0.f, 0.f, 0.f, 0.f, 0.f};
#pragma unroll 4
            for (int k = 0; k < 1024; k += 4) {
                const float w0 = wp[(size_t)k * 6144], w1 = wp[(size_t)(k + 1) * 6144], w2 = wp[(size_t)(k + 2) * 6144], w3 = wp[(size_t)(k + 3) * 6144];
#pragma unroll
                for (int c = 0; c < 5; ++c) { const f32x4 s4 = *(const LAS f32x4*)(sil + c * 1024 + k); acc[c] += s4.x * w0 + s4.y * w1 + s4.z * w2 + s4.w * w3; }
            }
            const float bm = A.in[I_BMOD][l * 6144 + col];
            float* mo = (float*)(F.ws + WS_MOD);
#pragma unroll
            for (int c = 0; c < 5; ++c) mo[(size_t)(l * 5 + c) * 6144 + col] = acc[c] + bm;
            continue;
        }
        r -= N_MOD;
        if (r < N_WIN) { transpose_item<0>(A.in[I_WIN], 2048, (bf16*)(F.ws + WS_WIN), 1024, scr, r, F.lane); continue; } r -= N_WIN;
        if (r < N_WOUT) { transpose_item<0>(A.in[I_WOUT], 1024, (bf16*)(F.ws + WS_WOUT), 1024, scr, r, F.lane); continue; } r -= N_WOUT;
        if (r < N_WQKV) { transpose_item<0>(A.in[I_WQKV], 3072, (bf16*)(F.ws + WS_WQKV), 1024, scr, r, F.lane); continue; } r -= N_WQKV;
        if (r < N_WO) { transpose_item<0>(A.in[I_WO], 1024, (bf16*)(F.ws + WS_WO), 1024, scr, r, F.lane); continue; } r -= N_WO;
        if (r < N_GATE) {
            const int m = r >> 3, it8 = r & 7, d = m >> 4, g = (m >> 3) & 1, n = m & 7;
            const float* src = (g == 0 ? A.in[I_GAW] : A.in[I_GXW]) + (size_t)(d * 8 + n) * 128 * 128;
            transpose_item<0>(src, 128, (bf16*)(F.ws + WS_GATE) + (size_t)m * 128 * 128, 128, scr, it8, F.lane); continue;
        }
        r -= N_GATE;
        if (r < N_MOE) { const int le = r >> 8; transpose_item<1>(A.in[I_MG] + (size_t)le * 1024 * 512, 512, (bf16*)(F.ws + WS_WUP) + (size_t)le * 1024 * 1024, 1024, scr, r & 255, F.lane); continue; } r -= N_MOE;
        if (r < N_MOE) { const int le = r >> 8; transpose_item<2>(A.in[I_MU] + (size_t)le * 1024 * 512, 512, (bf16*)(F.ws + WS_WUP) + (size_t)le * 1024 * 1024, 1024, scr, r & 255, F.lane); continue; } r -= N_MOE;
        { const int le = r >> 8; transpose_item<0>(A.in[I_MD] + (size_t)le * 512 * 1024, 1024, (bf16*)(F.ws + WS_WDN) + (size_t)le * 1024 * 512, 512, scr, r & 255, F.lane); }
    }
}

__device__ __forceinline__ float row_rstd(const f32x4 (&v)[4]) {
    float s = 0.f;
#pragma unroll
    for (int j = 0; j < 4; ++j) s += (v[j].x * v[j].x + v[j].y * v[j].y) + (v[j].z * v[j].z + v[j].w * v[j].w);
    return rsqrtf(wave_sum(s) * (1.0f / D) + EPS);
}
__device__ __forceinline__ void row_modulate_store(f32x4 (&v)[4], float rstd, const float* g, const float* sc, const float* sh, bf16* dst, int lane) {
#pragma unroll
    for (int j = 0; j < 4; ++j) {
        const int c0 = 4 * lane + 256 * j;
        const f32x4 gg = *(const f32x4*)(g + c0), s1 = *(const f32x4*)(sc + c0), s0 = *(const f32x4*)(sh + c0);
        v[j] = (v[j] * rstd) * gg * (1.0f + s1) + s0;
        u32x2 o; o.x = pk2(v[j].x, v[j].y); o.y = pk2(v[j].z, v[j].w);
        *(u32x2*)(dst + c0) = o;
    }
}

__device__ __forceinline__ void phase_prep0(Frame& F) {
    const Args& A = *F.a;
    const int gw = F.vcu * NWAVES + F.wave, NGW = F.G * NWAVES;
    bf16* H = (bf16*)(F.ws + WS_H);
    for (int row = gw; row < NTOK; row += NGW) {
        const float* src = row < NX ? A.in[I_X] + (size_t)row * D : A.in[I_CTX] + (size_t)(row - NX) * D;
        const int c = cond_of(row);
        f32x4 v[4];
#pragma unroll
        for (int j = 0; j < 4; ++j) v[j] = *(const f32x4*)(src + 4 * F.lane + 256 * j);
        const float rstd = row_rstd(v);
        row_modulate_store(v, rstd, A.in[I_N1G], modp(F, 0, c, 1), modp(F, 0, c, 0), H + (size_t)row * D, F.lane);
    }
}

constexpr int GEMM_STAGE = 49152;
__device__ __forceinline__ int swz128(int row, int chunk) { return row * 128 + ((chunk ^ ((row >> 1) & 7)) << 4); }

struct ALDense {
    const bf16* p0; const bf16* p1;
    __device__ __forceinline__ void init(const bf16* A, int lda, int m0, int r0, int r1, int kc) { p0 = A + (size_t)(m0 + r0) * lda + kc; p1 = A + (size_t)(m0 + r1) * lda + kc; }
    __device__ __forceinline__ u32x4 load(int i, int k0) const { return *(const u32x4*)((i ? p1 : p0) + k0); }
};
struct ALGather {
    const bf16* p0; const bf16* p1;
    __device__ __forceinline__ void init(const bf16* A, int lda, const int* idx, int m0, int r0, int r1, int kc) { p0 = A + (size_t)idx[m0 + r0] * lda + kc; p1 = A + (size_t)idx[m0 + r1] * lda + kc; }
    __device__ __forceinline__ u32x4 load(int i, int k0) const { return *(const u32x4*)((i ? p1 : p0) + k0); }
};
struct ALCombine {
    size_t o0, o1; const bf16 *hf, *hb, *yg;
    __device__ __forceinline__ void init(const bf16* hf_, const bf16* hb_, const bf16* yg_, int m0, int r0, int r1, int kc) { hf = hf_; hb = hb_; yg = yg_; o0 = (size_t)(m0 + r0) * D + kc; o1 = (size_t)(m0 + r1) * D + kc; }
    __device__ __forceinline__ u32x4 load(int i, int k0) const {
        const size_t o = (i ? o1 : o0) + k0;
        const u32x4 a = *(const u32x4*)(hf + o), b = *(const u32x4*)(hb + o), y = *(const u32x4*)(yg + o);
        u32x4 r;
#pragma unroll
        for (int q = 0; q < 4; ++q) r[q] = pk2((bflo(a[q]) + bflo(b[q])) * bflo(y[q]), (bfhi(a[q]) + bfhi(b[q])) * bfhi(y[q]));
        return r;
    }
};

template <bool SWAP, class AL>
__device__ __forceinline__ void gemm_tile(const Frame& F, const AL& al, const bf16* __restrict__ Bt  , int K, f32x4 (&acc)[4][4]) {
    const int tid = F.tid, lane = F.lane, wid = F.wave, wr = wid >> 2, wc = wid & 3, fr = lane & 15, fq = lane >> 4;
    const int sc = tid & 7, sr = tid >> 3;
    LAS char* lds = F.lds;
    const bf16* bp = Bt + (size_t)sr * K + sc * 8;
    const size_t bstep = (size_t)64 * K;
    int wa[2], wb[4];
#pragma unroll
    for (int i = 0; i < 2; ++i) wa[i] = swz128(sr + 64 * i, sc);
#pragma unroll
    for (int i = 0; i < 4; ++i) wb[i] = 16384 + swz128(sr + 64 * i, sc);
    const int key = (fr >> 1) & 7;
    const int ra = (wr * 64 + fr) * 128, rb = 16384 + (wc * 64 + fr) * 128;
#pragma unroll
    for (int mi = 0; mi < 4; ++mi)
#pragma unroll
        for (int ni = 0; ni < 4; ++ni) acc[mi][ni] = (f32x4){0.f, 0.f, 0.f, 0.f};
    u32x4 ga[2], gb[4];
    ga[0] = al.load(0, 0); ga[1] = al.load(1, 0);
#pragma unroll
    for (int i = 0; i < 4; ++i) gb[i] = *(const u32x4*)(bp + i * bstep);
#pragma unroll
    for (int i = 0; i < 2; ++i) *(LAS u32x4*)(lds + wa[i]) = ga[i];
#pragma unroll
    for (int i = 0; i < 4; ++i) *(LAS u32x4*)(lds + wb[i]) = gb[i];
    __syncthreads();
    const int nk = K / 64;
    for (int kt = 0; kt < nk; ++kt) {
        const int cur = (kt & 1) * GEMM_STAGE, nxt = GEMM_STAGE - cur;
        if (kt + 1 < nk) {
            const int k1 = (kt + 1) * 64;
            ga[0] = al.load(0, k1); ga[1] = al.load(1, k1);
#pragma unroll
            for (int i = 0; i < 4; ++i) gb[i] = *(const u32x4*)(bp + i * bstep + k1);
        }
#pragma unroll
        for (int ks = 0; ks < 2; ++ks) {
            const int co = ((ks * 4 + fq) ^ key) << 4;
            bf16x8 af[4], bfr[4];
#pragma unroll
            for (int mi = 0; mi < 4; ++mi) af[mi] = *(const LAS bf16x8*)(lds + cur + ra + mi * 2048 + co);
#pragma unroll
            for (int ni = 0; ni < 4; ++ni) bfr[ni] = *(const LAS bf16x8*)(lds + cur + rb + ni * 2048 + co);
#pragma unroll
            for (int mi = 0; mi < 4; ++mi)
#pragma unroll
                for (int ni = 0; ni < 4; ++ni)
                    acc[mi][ni] = SWAP ? __builtin_amdgcn_mfma_f32_16x16x32_bf16(bfr[ni], af[mi], acc[mi][ni], 0, 0, 0)
                                       : __builtin_amdgcn_mfma_f32_16x16x32_bf16(af[mi], bfr[ni], acc[mi][ni], 0, 0, 0);
        }
        if (kt + 1 < nk) {
#pragma unroll
            for (int i = 0; i < 2; ++i) *(LAS u32x4*)(lds + nxt + wa[i]) = ga[i];
#pragma unroll
            for (int i = 0; i < 4; ++i) *(LAS u32x4*)(lds + nxt + wb[i]) = gb[i];
        }
        __syncthreads();
    }
}

__device__ __forceinline__ float gelu_tanh(float x) {
    const float z = 0.7978845608028654f * (x + 0.044715f * x * x * x);
    const float t = 1.0f - 2.0f / (1.0f + __expf(2.0f * z));
    return 0.5f * x * (1.0f + t);
}

__device__ __forceinline__ void phase_gemm_in(Frame& F) {
    const bf16* H = (const bf16*)(F.ws + WS_H); const bf16* W = (const bf16*)(F.ws + WS_WIN);
    bf16* YG = (bf16*)(F.ws + WS_YG); bf16* U = (bf16*)(F.ws + WS_U);
    const int wr = F.wave >> 2, wc = F.wave & 3, fr = F.lane & 15, fq = F.lane >> 4;
    constexpr int NTN = 8, NUNITS = (NTOK / 128) * NTN;
    for (int u = F.vcu; u < NUNITS; u += F.G) {
        const int mt = u / NTN, nt = u % NTN, m0 = mt * 128, n0 = nt * 256;
        ALDense al; al.init(H, D, m0, F.tid >> 3, (F.tid >> 3) + 64, (F.tid & 7) * 8);
        f32x4 acc[4][4];
        gemm_tile<true>(F, al, W + (size_t)n0 * D, D, acc);
        const bool isy = n0 < 1024;
        bf16* dst = isy ? YG : U; const int nb = isy ? n0 : n0 - 1024;
#pragma unroll
        for (int mi = 0; mi < 4; ++mi) {
            const int row = m0 + wr * 64 + mi * 16 + fr;
#pragma unroll
            for (int ni = 0; ni < 4; ++ni) {
                f32x4 v = acc[mi][ni];
                if (isy) { v.x = gelu_tanh(v.x); v.y = gelu_tanh(v.y); v.z = gelu_tanh(v.z); v.w = gelu_tanh(v.w); }
                u32x2 o; o.x = pk2(v.x, v.y); o.y = pk2(v.z, v.w);
                *(u32x2*)(dst + (size_t)row * D + nb + wc * 64 + ni * 16 + fq * 4) = o;
            }
        }
    }
}

__device__ __forceinline__ float neg_expm1(float x) {
    const float p = 1.0f + x * (0.5f + x * (0.16666667f + x * (0.041666668f + x * (0.0083333338f + x * 0.0013888889f))));
    const float ser = -x * p, big = 1.0f - __expf(x);
    return x > -0.5f ? ser : big;
}
__device__ __forceinline__ void phase_scan(Frame& F) {
    const Args& A = *F.a;
    const int wi = F.vcu;
    if (wi >= 256) return;
    const int b = wi >> 6, n = (wi >> 3) & 7, d = (wi >> 2) & 1, q = wi & 3;
    const int tid = F.tid, lane = F.lane, w = F.wave, fr = lane & 15, fq = lane >> 4;
    LAS char* RAW = F.lds;
    LAS char* AT = F.lds + 33792;
    LAS float* AGG = (LAS float*)(F.lds + 66560);
    LAS float* CIN = (LAS float*)(F.lds + 74752);
    const bf16* U = (const bf16*)(F.ws + WS_U);
    bf16* HO = (bf16*)(F.ws + (d ? WS_HB : WS_HF));
    const int chbase = n * 128, och = chbase + q * 32;
    const bf16* GT = (const bf16*)(F.ws + WS_GATE);
    LAS char* BT = F.lds + 81920;
#pragma unroll
    for (int i = 0; i < 2; ++i) {
        const int idx = tid + 512 * i, jrow = idx >> 4, c = idx & 15, nb = jrow >> 4, f2 = jrow & 15;
        *(LAS u32x4*)(BT + jrow * 256 + ((c ^ f2) << 4)) = *(const u32x4*)(GT + ((size_t)(((d * 2 + (nb >> 1)) * 8 + n) * 128 + q * 32 + (nb & 1) * 16 + f2)) * 128 + c * 8);
    }
    float ba[2], bi[2], sp8[2];
#pragma unroll
    for (int h = 0; h < 2; ++h) {
        const int ch = och + h * 16 + fr;
        ba[h] = A.in[I_GAB][d * 1024 + ch]; bi[h] = A.in[I_GXB][d * 1024 + ch];
        sp8[h] = 8.0f * log1pf(expf(-A.in[I_LAM][d * 1024 + ch]));
    }
    const int c8 = tid & 15, r0 = tid >> 4;
    LAS float* CW = (LAS float*)(F.lds + 78848);
    for (int i = tid; i < 640; i += NTHREADS) CW[i] = (i < 512) ? A.in[I_CONVW][(i >> 7) * 1024 + chbase + (i & 127)] : A.in[I_CONVB][chbase + (i - 512)];

    float hcar = 0.f;
    u32x4 pre[5];
    for (int step = 0; step < 34; ++step) {
        int segbase, seglen, tile;
        if (step < 2) { segbase = NX + b * CL; seglen = CL; tile = d ? (1 - step) : step; }
        else { segbase = b * S; seglen = S; tile = d ? (33 - step) : (step - 2); }
        const int t0 = tile * 128;
        if (step == 0) {
#pragma unroll
            for (int i = 0; i < 5; ++i) {
                const int idx = tid + 512 * i; const int row = idx >> 4, c = idx & 15; const int t = t0 - 2 + row;
                u32x4 v = (u32x4){0u, 0u, 0u, 0u};
                if (idx < 2112 && t >= 0 && t < seglen) v = *(const u32x4*)(U + (size_t)(segbase + t) * D + chbase + c * 8);
                pre[i] = v;
            }
        }
#pragma unroll
        for (int i = 0; i < 5; ++i) { const int idx = tid + 512 * i; if (idx < 2112) *(LAS u32x4*)(RAW + idx * 16) = pre[i]; }
        __syncthreads();
        if (step + 1 < 34) {
            const int s1 = step + 1; int sb1, sl1, tl1;
            if (s1 < 2) { sb1 = NX + b * CL; sl1 = CL; tl1 = d ? (1 - s1) : s1; }
            else { sb1 = b * S; sl1 = S; tl1 = d ? (33 - s1) : (s1 - 2); }
            const int t1 = tl1 * 128;
#pragma unroll
            for (int i = 0; i < 5; ++i) {
                const int idx = tid + 512 * i; const int row = idx >> 4, c = idx & 15; const int t = t1 - 2 + row;
                u32x4 v = (u32x4){0u, 0u, 0u, 0u};
                if (idx < 2112 && t >= 0 && t < sl1) v = *(const u32x4*)(U + (size_t)(sb1 + t) * D + chbase + c * 8);
                pre[i] = v;
            }
        }
#pragma unroll 1
        for (int i = 0; i < 4; ++i) {
            const int r = r0 + 32 * i;
            float o[8];
            { const f32x4 b0 = *(const LAS f32x4*)(CW + 512 + c8 * 8), b1 = *(const LAS f32x4*)(CW + 512 + c8 * 8 + 4);
              o[0] = b0.x; o[1] = b0.y; o[2] = b0.z; o[3] = b0.w; o[4] = b1.x; o[5] = b1.y; o[6] = b1.z; o[7] = b1.w; }
#pragma unroll
            for (int k = 0; k < 4; ++k) {
                const u32x4 x = *(const LAS u32x4*)(RAW + (r + k) * 256 + c8 * 16);
                const f32x4 w0 = *(const LAS f32x4*)(CW + k * 128 + c8 * 8), w1 = *(const LAS f32x4*)(CW + k * 128 + c8 * 8 + 4);
                o[0] += w0.x * bflo(x[0]); o[1] += w0.y * bfhi(x[0]); o[2] += w0.z * bflo(x[1]); o[3] += w0.w * bfhi(x[1]);
                o[4] += w1.x * bflo(x[2]); o[5] += w1.y * bfhi(x[2]); o[6] += w1.z * bflo(x[3]); o[7] += w1.w * bfhi(x[3]);
            }
            u32x4 ov; ov.x = pk2(o[0], o[1]); ov.y = pk2(o[2], o[3]); ov.z = pk2(o[4], o[5]); ov.w = pk2(o[6], o[7]);
            *(LAS u32x4*)(AT + r * 256 + ((c8 ^ (r & 15)) << 4)) = ov;
        }
        __syncthreads();
        f32x4 acc[4];
#pragma unroll
        for (int nb = 0; nb < 4; ++nb) acc[nb] = (f32x4){0.f, 0.f, 0.f, 0.f};
#pragma unroll
        for (int ks = 0; ks < 4; ++ks) {
            const int row = 16 * w + fr;
            const bf16x8 af = *(const LAS bf16x8*)(AT + row * 256 + (((4 * ks + fq) ^ fr) << 4));
#pragma unroll
            for (int nb = 0; nb < 4; ++nb) {
                const bf16x8 bq = *(const LAS bf16x8*)(BT + (nb * 16 + fr) * 256 + (((4 * ks + fq) ^ fr) << 4));
                acc[nb] = __builtin_amdgcn_mfma_f32_16x16x32_bf16(af, bq, acc[nb], 0, 0, 0);
            }
        }
        float av[2][4], bv[2][4];
#pragma unroll
        for (int h = 0; h < 2; ++h) {
            const int col = q * 32 + h * 16 + fr, chunk = col >> 3, within = col & 7;
#pragma unroll
            for (int reg = 0; reg < 4; ++reg) {
                const int tr = 16 * w + 4 * fq + reg;
                const float r_ = sigmoidf_(acc[h][reg] + ba[h]);
                const float i_ = sigmoidf_(acc[2 + h][reg] + bi[h]);
                const float la = -sp8[h] * r_;
                const float a_ = __expf(la);
                const unsigned short ub = *(const LAS unsigned short*)(AT + tr * 256 + ((chunk ^ (tr & 15)) << 4) + within * 2);
                const float uval = __builtin_bit_cast(float, (unsigned)ub << 16);
                av[h][reg] = a_;
                bv[h][reg] = sqrtf(neg_expm1(2.0f * la)) * (i_ * uval);
            }
        }
        const int g = 4 * w + fq;
#pragma unroll
        for (int h = 0; h < 2; ++h) {
            float P = 1.f, Hh = 0.f;
#pragma unroll
            for (int s = 0; s < 4; ++s) { const int reg = d ? (3 - s) : s; Hh = av[h][reg] * Hh + bv[h][reg]; P *= av[h][reg]; }
            AGG[(g * 32 + h * 16 + fr) * 2 + 0] = P; AGG[(g * 32 + h * 16 + fr) * 2 + 1] = Hh;
        }
        __syncthreads();
        if (tid < 32) {
            f32x2 ag[32];
#pragma unroll
            for (int gi = 0; gi < 32; ++gi) ag[gi] = *(const LAS f32x2*)(AGG + (gi * 32 + tid) * 2);
            float hh = hcar;
            if (d == 0) {
#pragma unroll
                for (int gi = 0; gi < 32; ++gi) { CIN[gi * 32 + tid] = hh; hh = ag[gi].x * hh + ag[gi].y; }
            } else {
#pragma unroll
                for (int gi = 31; gi >= 0; --gi) { CIN[gi * 32 + tid] = hh; hh = ag[gi].x * hh + ag[gi].y; }
            }
            hcar = hh;
        }
        __syncthreads();
#pragma unroll
        for (int h = 0; h < 2; ++h) {
            float hh = CIN[g * 32 + h * 16 + fr];
            float outv[4];
#pragma unroll
            for (int s = 0; s < 4; ++s) { const int reg = d ? (3 - s) : s; hh = av[h][reg] * hh + bv[h][reg]; outv[reg] = hh; }
#pragma unroll
            for (int reg = 0; reg < 4; ++reg) {
                const int tr = 16 * w + 4 * fq + reg;
                HO[(size_t)(segbase + t0 + tr) * D + och + h * 16 + fr] = (bf16)f2bf(outv[reg]);
            }
        }
    }
}

__device__ __forceinline__ void phase_gemm_out0(Frame& F) {
    const Args& A = *F.a;
    const bf16* W = (const bf16*)(F.ws + WS_WOUT);
    float* XA = (float*)(F.ws + WS_XA);
    const int wr = F.wave >> 2, wc = F.wave & 3, fr = F.lane & 15, fq = F.lane >> 4;
    constexpr int NTN = 4, NUNITS = (NTOK / 128) * NTN;
    for (int u = F.vcu; u < NUNITS; u += F.G) {
        const int mt = u / NTN, nt = u % NTN, m0 = mt * 128, n0 = nt * 256;
        ALCombine al; al.init((const bf16*)(F.ws + WS_HF), (const bf16*)(F.ws + WS_HB), (const bf16*)(F.ws + WS_YG), m0, F.tid >> 3, (F.tid >> 3) + 64, (F.tid & 7) * 8);
        f32x4 acc[4][4];
        gemm_tile<true>(F, al, W + (size_t)n0 * D, D, acc);
#pragma unroll
        for (int mi = 0; mi < 4; ++mi) {
            const int row = m0 + wr * 64 + mi * 16 + fr;
            const float* src = row < NX ? A.in[I_X] + (size_t)row * D : A.in[I_CTX] + (size_t)(row - NX) * D;
            const float* gate = modp(F, 0, cond_of(row), 2);
#pragma unroll
            for (int ni = 0; ni < 4; ++ni) {
                const int col = n0 + wc * 64 + ni * 16 + fq * 4;
                const f32x4 s = *(const f32x4*)(src + col), gt = *(const f32x4*)(gate + col);
                *(f32x4*)(XA + (size_t)row * D + col) = s + gt * acc[mi][ni];
            }
        }
    }
}

template <int LAYER>
__device__ __forceinline__ void phase_route(Frame& F) {
    const Args& A = *F.a;
    constexpr int NT = LAYER == 0 ? NTOK : NX;
    constexpr int PER = NT / 256;
    LAS char* RW = F.lds;
    LAS int* selL = (LAS int*)(F.lds + LDS_AUX);
    LAS int* rankL = selL + 2 * 68;
    LAS int* cntL = rankL + 2 * 68;
    const int tid = F.tid, lane = F.lane;
    for (int i = 0; i < 16; ++i) {
        const int idx = tid + 512 * i, k = idx >> 3, e4 = idx & 7;
        const int rho = (((k >> 8) * 4 + (k & 3)) << 6) + ((k >> 2) & 63);
        *(LAS f32x4*)(RW + rho * 128 + ((e4 ^ ((rho >> 1) & 7)) << 4)) = *(const f32x4*)(A.in[I_RW] + (size_t)k * 32 + e4 * 4);
    }
    __syncthreads();
    const int blk = F.vcu;
    if (blk < 256) {
        const float* XA = (const float*)(F.ws + WS_XA);
        bf16* H = (bf16*)(F.ws + WS_H);
        const float rbias = A.in[I_RB][lane & 31];
        for (int li = F.wave; li < PER; li += NWAVES) {
            const int row = blk * PER + li;
            const int c = cond_of(row);
            f32x4 v[4];
#pragma unroll
            for (int j = 0; j < 4; ++j) v[j] = *(const f32x4*)(XA + (size_t)row * D + 4 * lane + 256 * j);
            const float rstd = row_rstd(v);
            row_modulate_store(v, rstd, A.in[I_N2G] + LAYER * D, modp(F, LAYER, c, 4), modp(F, LAYER, c, 3), H + (size_t)row * D, lane);
            float acc[32];
#pragma unroll
            for (int e = 0; e < 32; ++e) acc[e] = 0.f;
#pragma unroll 1
            for (int jc = 0; jc < 16; ++jc) {
                const int j = jc >> 2, c = jc & 3;
                f32x4 hv4 = v[0];
                if (j == 1) hv4 = v[1];
                if (j == 2) hv4 = v[2];
                if (j == 3) hv4 = v[3];
                float hv = hv4.x;
                if (c == 1) hv = hv4.y;
                if (c == 2) hv = hv4.z;
                if (c == 3) hv = hv4.w;
                const int rho = jc * 64 + lane;
                const LAS char* rp = RW + rho * 128; const int key = (rho >> 1) & 7;
#pragma unroll
                for (int e4 = 0; e4 < 8; ++e4) {
                    const f32x4 w4 = *(const LAS f32x4*)(rp + ((e4 ^ key) << 4));
                    acc[e4 * 4 + 0] += hv * w4.x; acc[e4 * 4 + 1] += hv * w4.y; acc[e4 * 4 + 2] += hv * w4.z; acc[e4 * 4 + 3] += hv * w4.w;
                }
            }
#define BFLY(S, HALF) { const bool up = (lane >> (S)) & 1; _Pragma("unroll") for (int i = 0; i < (HALF); ++i) { \
                const float keep = up ? acc[i + (HALF)] : acc[i]; const float send = up ? acc[i] : acc[i + (HALF)]; acc[i] = keep + __shfl_xor(send, 1 << (S)); } }
            BFLY(0, 16) BFLY(1, 8) BFLY(2, 4) BFLY(3, 2) BFLY(4, 1)
#undef BFLY
            float tot = acc[0] + __shfl_xor(acc[0], 32);
            const int e = lane & 31;
            const float logit = __shfl(tot, (int)(__builtin_bitreverse32((unsigned)e) >> 27));
            const float sc = 1.0f / (1.0f + expf(-logit));
            const float ss = sc + rbias;
            float m1 = ss;
#pragma unroll
            for (int o = 1; o < 8; o <<= 1) m1 = fmaxf(m1, __shfl_xor(m1, o));
            int i1 = (ss == m1) ? e : 64;
#pragma unroll
            for (int o = 1; o < 8; o <<= 1) i1 = min(i1, __shfl_xor(i1, o));
            const float s2 = (e == i1) ? -INFINITY : ss;
            float m2 = s2;
#pragma unroll
            for (int o = 1; o < 8; o <<= 1) m2 = fmaxf(m2, __shfl_xor(m2, o));
            int i2 = (s2 == m2 && e != i1) ? e : 64;
#pragma unroll
            for (int o = 1; o < 8; o <<= 1) i2 = min(i2, __shfl_xor(i2, o));
            const float gs = m1 + m2;
            float gbest = gs;
            gbest = fmaxf(gbest, __shfl_xor(gbest, 8)); gbest = fmaxf(gbest, __shfl_xor(gbest, 16));
            int gsel = (gs == gbest) ? (e >> 3) : 64;
            gsel = min(gsel, __shfl_xor(gsel, 8)); gsel = min(gsel, __shfl_xor(gsel, 16));
            const int e0 = __shfl(i1, gsel * 8), e1 = __shfl(i2, gsel * 8);
            const float w0 = __shfl(sc, e0), w1 = __shfl(sc, e1);
            if (lane == 0) {
                const float inv = 1.0f / (w0 + w1);
                selL[li * 2] = e0; selL[li * 2 + 1] = e1;
                ((float2*)(F.ws + WS_WT))[row] = make_float2(w0 * inv, w1 * inv);
                ((int2*)(F.ws + WS_SEL))[row] = make_int2(e0, e1);
            }
        }
        __syncthreads();
        if (tid < 32) {
            int cnt = 0;
            for (int i = 0; i < 2 * PER; ++i) { if (selL[i] == tid) { rankL[i] = cnt; ++cnt; } }
            ((int*)(F.ws + WS_BLKCNT))[blk * 32 + tid] = cnt;
        }
        __syncthreads();
        for (int i = tid; i < PER; i += NTHREADS) ((int2*)(F.ws + WS_LRANK))[blk * PER + i] = make_int2(rankL[2 * i], rankL[2 * i + 1]);
    }
}

template <int LAYER>
__device__ __forceinline__ void phase_slots(Frame& F) {
    constexpr int NT = LAYER == 0 ? NTOK : NX;
    constexpr int PER = NT / 256;
    LAS int* part = (LAS int*)F.lds;
    LAS int* tot = part + 1024;
    LAS int* base = tot + 32;
    LAS int* pst = base + 32;
    const int tid = F.tid, blk = F.vcu;
    const int* bc = (const int*)(F.ws + WS_BLKCNT);
    {
        const int e = tid & 31, p = tid >> 5;
        int st = 0, sb = 0;
        for (int b2 = p; b2 < 256; b2 += 16) { const int c = bc[b2 * 32 + e]; st += c; sb += (b2 < blk) ? c : 0; }
        part[p * 32 + e] = st; part[512 + p * 32 + e] = sb;
    }
    __syncthreads();
    if (tid < 32) { int st = 0, sb = 0; for (int p = 0; p < 16; ++p) { st += part[p * 32 + tid]; sb += part[512 + p * 32 + tid]; } tot[tid] = st; base[tid] = sb; }
    __syncthreads();
    if (tid == 0) { int s = 0; for (int e = 0; e < 32; ++e) { pst[e] = s; s += (tot[e] + 127) & ~127; } pst[32] = s; }
    __syncthreads();
    int* slot_tok = (int*)(F.ws + WS_SLOTTOK); float* slot_w = (float*)(F.ws + WS_SLOTW);
    if (blk == 0 && tid < 33) ((int*)(F.ws + WS_PSTART))[tid] = pst[tid];
    if (blk < 256) {
        for (int i = tid; i < PER; i += NTHREADS) {
            const int t = blk * PER + i;
            const int2 se = ((const int2*)(F.ws + WS_SEL))[t]; const int2 lr = ((const int2*)(F.ws + WS_LRANK))[t]; const float2 wt = ((const float2*)(F.ws + WS_WT))[t];
            const int s0 = pst[se.x] + base[se.x] + lr.x, s1 = pst[se.y] + base[se.y] + lr.y;
            slot_tok[s0] = t; slot_w[s0] = wt.x; slot_tok[s1] = t; slot_w[s1] = wt.y;
            ((int2*)(F.ws + WS_TOKSLOT))[t] = make_int2(s0, s1);
        }
    }
    if (blk < 32) {
        const int lo = pst[blk] + tot[blk], hi = pst[blk + 1];
        for (int s = lo + tid; s < hi; s += NTHREADS) { slot_tok[s] = 0; slot_w[s] = 0.f; }
    }
}

template <int LAYER>
__device__ __forceinline__ void phase_moe_up(Frame& F) {
    LAS int* pst = (LAS int*)(F.lds + LDS_AUX);
    if (F.tid < 33) pst[F.tid] = ((const int*)(F.ws + WS_PSTART))[F.tid];
    __syncthreads();
    const int ntiles = pst[32] >> 7, nunits = ntiles * 4;
    const bf16* H = (const bf16*)(F.ws + WS_H);
    const bf16* W = (const bf16*)(F.ws + WS_WUP) + (size_t)LAYER * 32 * 1024 * 1024;
    const int* slot_tok = (const int*)(F.ws + WS_SLOTTOK); const float* slot_w = (const float*)(F.ws + WS_SLOTW);
    bf16* G = (bf16*)(F.ws + WS_G);
    const int wr = F.wave >> 2, wc = F.wave & 3, fr = F.lane & 15, fq = F.lane >> 4;
    for (int u = F.vcu; u < nunits; u += F.G) {
        const int mt = u >> 2, j = u & 3, m0 = mt * 128;
        int e = 0;
        for (int x = 1; x < 32; ++x) e = (pst[x] <= m0) ? x : e;
        ALGather al; al.init(H, D, slot_tok, m0, F.tid >> 3, (F.tid >> 3) + 64, (F.tid & 7) * 8);
        f32x4 acc[4][4];
        gemm_tile<true>(F, al, W + ((size_t)e * 1024 + j * 256) * D, D, acc);
#pragma unroll
        for (int mi = 0; mi < 4; ++mi) {
            const int row = m0 + wr * 64 + mi * 16 + fr;
            const float wgt = slot_w[row];
#pragma unroll
            for (int p = 0; p < 2; ++p) {
                const f32x4 g = acc[mi][2 * p], uu = acc[mi][2 * p + 1];
                float o[4];
#pragma unroll
                for (int c = 0; c < 4; ++c) o[c] = g[c] / (1.0f + __expf(-g[c])) * uu[c] * wgt;
                u32x2 ov; ov.x = pk2(o[0], o[1]); ov.y = pk2(o[2], o[3]);
                *(u32x2*)(G + (size_t)row * DEXP + j * 128 + wc * 32 + p * 16 + fq * 4) = ov;
            }
        }
    }
}

template <int LAYER>
__device__ __forceinline__ void phase_moe_down(Frame& F) {
    LAS int* pst = (LAS int*)(F.lds + LDS_AUX);
    if (F.tid < 33) pst[F.tid] = ((const int*)(F.ws + WS_PSTART))[F.tid];
    __syncthreads();
    const int ntiles = pst[32] >> 7, nunits = ntiles * 4;
    const bf16* G = (const bf16*)(F.ws + WS_G);
    const bf16* W = (const bf16*)(F.ws + WS_WDN) + (size_t)LAYER * 32 * 1024 * 512;
    bf16* Y = (bf16*)(F.ws + WS_Y);
    const int wr = F.wave >> 2, wc = F.wave & 3, fr = F.lane & 15, fq = F.lane >> 4;
    for (int u = F.vcu; u < nunits; u += F.G) {
        const int mt = u >> 2, j = u & 3, m0 = mt * 128, n0 = j * 256;
        int e = 0;
        for (int x = 1; x < 32; ++x) e = (pst[x] <= m0) ? x : e;
        ALDense al; al.init(G, DEXP, m0, F.tid >> 3, (F.tid >> 3) + 64, (F.tid & 7) * 8);
        f32x4 acc[4][4];
        gemm_tile<true>(F, al, W + ((size_t)e * 1024 + n0) * DEXP, DEXP, acc);
#pragma unroll
        for (int mi = 0; mi < 4; ++mi) {
            const int row = m0 + wr * 64 + mi * 16 + fr;
#pragma unroll
            for (int ni = 0; ni < 4; ++ni) {
                const f32x4 v = acc[mi][ni];
                u32x2 o; o.x = pk2(v.x, v.y); o.y = pk2(v.z, v.w);
                *(u32x2*)(Y + (size_t)row * D + n0 + wc * 64 + ni * 16 + fq * 4) = o;
            }
        }
    }
}

__device__ __forceinline__ void combine_row(const Frame& F, int row, const float* gate, f32x4 (&v)[4]) {
    const float* XA = (const float*)(F.ws + WS_XA); const bf16* Y = (const bf16*)(F.ws + WS_Y);
    const int2 ts = ((const int2*)(F.ws + WS_TOKSLOT))[row];
#pragma unroll
    for (int j = 0; j < 4; ++j) {
        const int c0 = 4 * F.lane + 256 * j;
        const f32x4 x = *(const f32x4*)(XA + (size_t)row * D + c0), gt = *(const f32x4*)(gate + c0);
        const u32x2 y0 = *(const u32x2*)(Y + (size_t)ts.x * D + c0), y1 = *(const u32x2*)(Y + (size_t)ts.y * D + c0);
        f32x4 y; y.x = bflo(y0.x) + bflo(y1.x); y.y = bfhi(y0.x) + bfhi(y1.x); y.z = bflo(y0.y) + bflo(y1.y); y.w = bfhi(y0.y) + bfhi(y1.y);
        v[j] = x + gt * y;
    }
}

__device__ __forceinline__ void phase_combine0(Frame& F) {
    const Args& A = *F.a;
    const int gw = F.vcu * NWAVES + F.wave, NGW = F.G * NWAVES;
    float* XA = (float*)(F.ws + WS_XA); bf16* H = (bf16*)(F.ws + WS_H);
    for (int row = gw; row < NTOK; row += NGW) {
        const int c = cond_of(row);
        f32x4 v[4];
        combine_row(F, row, modp(F, 0, c, 5), v);
#pragma unroll
        for (int j = 0; j < 4; ++j) *(f32x4*)(XA + (size_t)row * D + 4 * F.lane + 256 * j) = v[j];
        const float rstd = row_rstd(v);
        row_modulate_store(v, rstd, A.in[I_N1G] + D, modp(F, 1, c, 1), modp(F, 1, c, 0), H + (size_t)row * D, F.lane);
    }
}

constexpr float QSCALE = 0.125f * 1.4426950408889634f;
__device__ __forceinline__ void phase_qkv(Frame& F) {
    LAS float* CS = (LAS float*)(F.lds + LDS_AUX);
    for (int i = F.tid; i < 1024; i += NTHREADS) {
        const int p = i >> 4, f = i & 15;
        const float inv = 1.0f / powf(10000.0f, (float)f / 16.0f);
        const float ang = (float)p * inv;
        const double rev = (double)ang * 0.15915494309189535;
        const float fr_ = (float)(rev - floor(rev));
        CS[i * 2] = __builtin_amdgcn_cosf(fr_); CS[i * 2 + 1] = __builtin_amdgcn_sinf(fr_);
    }
    __syncthreads();
    const bf16* H = (const bf16*)(F.ws + WS_H); const bf16* W = (const bf16*)(F.ws + WS_WQKV);
    bf16* Q = (bf16*)(F.ws + WS_Q); bf16* Kb = (bf16*)(F.ws + WS_K); bf16* VT = (bf16*)(F.ws + WS_VT);
    const int wr = F.wave >> 2, wc = F.wave & 3, fr = F.lane & 15, fq = F.lane >> 4;
    constexpr int NTN = 12, NUNITS = (NTOK / 128) * NTN;
    for (int u = F.vcu; u < NUNITS; u += F.G) {
        const int mt = u / NTN, nt = u % NTN, m0 = mt * 128, n0 = nt * 256;
        const bool isctx = m0 >= NX;
        if (isctx && nt < 4) continue;
        ALDense al; al.init(H, D, m0, F.tid >> 3, (F.tid >> 3) + 64, (F.tid & 7) * 8);
        f32x4 acc[4][4];
        if (nt < 8) {
            gemm_tile<true>(F, al, W + (size_t)n0 * D, D, acc);
            const int hi2 = ((n0 & 1023) >> 6) + wc;
            const bool isq = nt < 4;
#pragma unroll
            for (int mi = 0; mi < 4; ++mi) {
                const int row = m0 + wr * 64 + mi * 16 + fr;
                int b, pos;
                if (!isctx) { b = row >> 12; pos = row & 4095; } else { b = (row - NX) >> 8; pos = S + ((row - NX) & 255); }
                f32x4 o[4];
                if (!isctx) {
                    const int rp = pos >> 6, cp = pos & 63;
#pragma unroll
                    for (int ni = 0; ni < 4; ++ni) {
                        const int p = (ni >> 1) ? cp : rp;
                        const f32x4 xv = acc[mi][ni], pv = acc[mi][ni ^ 1];
#pragma unroll
                        for (int c = 0; c < 4; ++c) {
                            const float cs = CS[(p * 16 + fq * 4 + c) * 2], sn = CS[(p * 16 + fq * 4 + c) * 2 + 1];
                            o[ni][c] = xv[c] * cs + ((ni & 1) ? pv[c] : -pv[c]) * sn;
                        }
                    }
                } else {
#pragma unroll
                    for (int ni = 0; ni < 4; ++ni) o[ni] = acc[mi][ni];
                }
                bf16* dst = isq ? Q + ((size_t)(b * 16 + hi2) * S + pos) * 64 : Kb + ((size_t)(b * 16 + hi2) * KEYS + pos) * 64;
                const float scl = isq ? QSCALE : 1.0f;
#pragma unroll
                for (int ni = 0; ni < 4; ++ni) {
                    u32x2 ov; ov.x = pk2(o[ni].x * scl, o[ni].y * scl); ov.y = pk2(o[ni].z * scl, o[ni].w * scl);
                    *(u32x2*)(dst + ni * 16 + fq * 4) = ov;
                }
            }
        } else {
            gemm_tile<false>(F, al, W + (size_t)n0 * D, D, acc);
#pragma unroll
            for (int mi = 0; mi < 4; ++mi) {
                const int row = m0 + wr * 64 + mi * 16 + fq * 4;
                int b, pos;
                if (!isctx) { b = row >> 12; pos = row & 4095; } else { b = (row - NX) >> 8; pos = S + ((row - NX) & 255); }
#pragma unroll
                for (int ni = 0; ni < 4; ++ni) {
                    const int col = (n0 - 2048) + wc * 64 + ni * 16 + fr, h = col >> 7, vd = col & 127;
                    const f32x4 v = acc[mi][ni];
                    u32x2 ov; ov.x = pk2(v.x, v.y); ov.y = pk2(v.z, v.w);
                    *(u32x2*)(VT + ((size_t)(b * 8 + h) * 128 + vd) * KEYS + pos) = ov;
                }
            }
        }
    }
}

constexpr int ATT_STAGE = 32768;
__device__ __forceinline__ int crow(int r, int hi) { return (r & 3) + 8 * (r >> 2) + 4 * hi; }
__device__ __forceinline__ void phase_attn(Frame& F) {
    const Args& A = *F.a;
    const int tid = F.tid, lane = F.lane, w = F.wave, r32 = lane & 31, hi = lane >> 5;
    const int mp = w >> 2, wq = w & 3;
    LAS char* lds = F.lds;
    float lam;
    { const float* dl = A.in[I_DALAM]; const float s1 = wave_sum(dl[lane] * dl[64 + lane]), s2 = wave_sum(dl[128 + lane] * dl[192 + lane]);
      lam = expf(s1) - expf(s2) + (0.8f - 0.6f * expf(-0.3f)); }
    const float oscale = 1.0f - (0.8f - 0.6f * expf(-0.3f));
    const bf16* Q = (const bf16*)(F.ws + WS_Q); const bf16* Kb = (const bf16*)(F.ws + WS_K); const bf16* VT = (const bf16*)(F.ws + WS_VT);
    bf16* AO = (bf16*)(F.ws + WS_AO);
    constexpr int NUNITS = NB * 8 * (S / 128), NTILES = KEYS / 64;
    for (int u = F.vcu; u < NUNITS; u += F.G) {
        const int bh = u >> 5, qb = u & 31, q0 = qb * 128;
        const bf16* Kg[2]; Kg[0] = Kb + (size_t)(bh * 2 + 0) * KEYS * 64; Kg[1] = Kb + (size_t)(bh * 2 + 1) * KEYS * 64;
        const bf16* Vg = VT + (size_t)bh * 128 * KEYS;
        bf16x8 qf[4];
        { const bf16* qp = Q + ((size_t)(bh * 2 + mp) * S + q0 + wq * 32 + r32) * 64;
#pragma unroll
          for (int ks = 0; ks < 4; ++ks) qf[ks] = *(const bf16x8*)(qp + ks * 16 + hi * 8); }
        f32x16 o[4];
#pragma unroll
        for (int vb = 0; vb < 4; ++vb)
#pragma unroll
            for (int r = 0; r < 16; ++r) o[vb][r] = 0.f;
        float mrun = -1e30f, lrun = 0.f;
        u32x4 pre[4];
        auto gload = [&](int t) {
#pragma unroll
            for (int i = 0; i < 4; ++i) {
                const int idx = tid + 512 * i;
                if (i < 2) { const int row = (idx & 511) >> 3, c = idx & 7; pre[i] = *(const u32x4*)(Kg[i] + (size_t)(t * 64 + row) * 64 + c * 8); }
                else { const int row = (idx - 1024) >> 3, c = idx & 7; pre[i] = *(const u32x4*)(Vg + (size_t)row * KEYS + t * 64 + c * 8); }
            }
        };
        auto lstore = [&](int st) {
#pragma unroll
            for (int i = 0; i < 4; ++i) {
                const int idx = tid + 512 * i;
                if (i < 2) { const int row = (idx & 511) >> 3, c = idx & 7; *(LAS u32x4*)(lds + st * ATT_STAGE + i * 8192 + swz128(row, c)) = pre[i]; }
                else { const int row = (idx - 1024) >> 3, c = idx & 7; *(LAS u32x4*)(lds + st * ATT_STAGE + 16384 + swz128(row, c)) = pre[i]; }
            }
        };
        gload(0); lstore(0);
        __syncthreads();
        for (int t = 0; t < NTILES; ++t) {
            const int st = t & 1;
            if (t + 1 < NTILES) gload(t + 1);
            const LAS char* Kt = lds + st * ATT_STAGE + mp * 8192;
            const LAS char* Vt = lds + st * ATT_STAGE + 16384;
            f32x16 s0, s1;
#pragma unroll
            for (int r = 0; r < 16; ++r) { s0[r] = 0.f; s1[r] = 0.f; }
#pragma unroll
            for (int ks = 0; ks < 4; ++ks) {
                const bf16x8 k0 = *(const LAS bf16x8*)(Kt + swz128(r32, 2 * ks + hi));
                const bf16x8 k1 = *(const LAS bf16x8*)(Kt + swz128(32 + r32, 2 * ks + hi));
                s0 = __builtin_amdgcn_mfma_f32_32x32x16_bf16(k0, qf[ks], s0, 0, 0, 0);
                s1 = __builtin_amdgcn_mfma_f32_32x32x16_bf16(k1, qf[ks], s1, 0, 0, 0);
            }
            float mx = s0[0];
#pragma unroll
            for (int r = 1; r < 16; ++r) mx = fmaxf(mx, s0[r]);
#pragma unroll
            for (int r = 0; r < 16; ++r) mx = fmaxf(mx, s1[r]);
            mx = fmaxf(mx, __shfl_xor(mx, 32));
            const float mnew = fmaxf(mrun, mx);
            const float alpha = __builtin_amdgcn_exp2f(mrun - mnew);
            mrun = mnew;
            float psum = 0.f;
#pragma unroll
            for (int r = 0; r < 16; ++r) { s0[r] = __builtin_amdgcn_exp2f(s0[r] - mnew); s1[r] = __builtin_amdgcn_exp2f(s1[r] - mnew); psum += s0[r] + s1[r]; }
            lrun = lrun * alpha + psum;
#pragma unroll
            for (int vb = 0; vb < 4; ++vb)
#pragma unroll
                for (int r = 0; r < 16; ++r) o[vb][r] *= alpha;
            bf16x8 pf[4];
#pragma unroll
            for (int s = 0; s < 2; ++s) {
                u32x4 a, b2;
                a.x = pk2(s0[8 * s + 0], s0[8 * s + 1]); a.y = pk2(s0[8 * s + 2], s0[8 * s + 3]); a.z = pk2(s0[8 * s + 4], s0[8 * s + 5]); a.w = pk2(s0[8 * s + 6], s0[8 * s + 7]);
                b2.x = pk2(s1[8 * s + 0], s1[8 * s + 1]); b2.y = pk2(s1[8 * s + 2], s1[8 * s + 3]); b2.z = pk2(s1[8 * s + 4], s1[8 * s + 5]); b2.w = pk2(s1[8 * s + 6], s1[8 * s + 7]);
                pf[s] = __builtin_bit_cast(bf16x8, a); pf[2 + s] = __builtin_bit_cast(bf16x8, b2);
            }
#pragma unroll
            for (int vb = 0; vb < 4; ++vb) {
                const int vrow = vb * 32 + r32;
#pragma unroll
                for (int kk = 0; kk < 4; ++kk) {
                    const u32x2 lo = *(const LAS u32x2*)(Vt + swz128(vrow, 2 * kk) + 8 * hi);
                    const u32x2 hi2 = *(const LAS u32x2*)(Vt + swz128(vrow, 2 * kk + 1) + 8 * hi);
                    u32x4 av; av.x = lo.x; av.y = lo.y; av.z = hi2.x; av.w = hi2.y;
                    o[vb] = __builtin_amdgcn_mfma_f32_32x32x16_bf16(__builtin_bit_cast(bf16x8, av), pf[kk], o[vb], 0, 0, 0);
                }
            }
            if (t + 1 < NTILES) lstore(st ^ 1);
            __syncthreads();
        }
        lrun += __shfl_xor(lrun, 32);
        const float linv = 1.0f / lrun;
        LAS float* XO = (LAS float*)lds;
        if (mp == 1) {
#pragma unroll
            for (int vb = 0; vb < 4; ++vb)
#pragma unroll
                for (int r = 0; r < 16; ++r) XO[(wq * 64 + vb * 16 + r) * 64 + lane] = o[vb][r] * linv;
        }
        __syncthreads();
        if (mp == 0) {
            float ssq = 0.f;
#pragma unroll
            for (int vb = 0; vb < 4; ++vb)
#pragma unroll
                for (int r = 0; r < 16; ++r) { const float v = o[vb][r] * linv - lam * XO[(wq * 64 + vb * 16 + r) * 64 + lane]; o[vb][r] = v; ssq += v * v; }
            ssq += __shfl_xor(ssq, 32);
            const float rstd = rsqrtf(ssq * (1.0f / 128.0f) + EPS) * oscale;
            const int b = bh >> 3, h = bh & 7;
            bf16* dst = AO + (size_t)(b * S + q0 + wq * 32 + r32) * D + h * 128;
            const float* sg = A.in[I_SUBLN];
#pragma unroll
            for (int vb = 0; vb < 4; ++vb)
#pragma unroll
                for (int rq = 0; rq < 4; ++rq) {
                    const int v0 = vb * 32 + 8 * rq + 4 * hi;
                    const f32x4 g4 = *(const f32x4*)(sg + v0);
                    u32x2 ov; ov.x = pk2(o[vb][4 * rq] * rstd * g4.x, o[vb][4 * rq + 1] * rstd * g4.y); ov.y = pk2(o[vb][4 * rq + 2] * rstd * g4.z, o[vb][4 * rq + 3] * rstd * g4.w);
                    *(u32x2*)(dst + v0) = ov;
                }
        }
        __syncthreads();
    }
}

__device__ __forceinline__ void phase_gemm_wo(Frame& F) {
    const bf16* AO = (const bf16*)(F.ws + WS_AO); const bf16* W = (const bf16*)(F.ws + WS_WO);
    float* XA = (float*)(F.ws + WS_XA);
    const int wr = F.wave >> 2, wc = F.wave & 3, fr = F.lane & 15, fq = F.lane >> 4;
    constexpr int NTN = 4, NUNITS = (NX / 128) * NTN;
    for (int u = F.vcu; u < NUNITS; u += F.G) {
        const int mt = u / NTN, nt = u % NTN, m0 = mt * 128, n0 = nt * 256;
        ALDense al; al.init(AO, D, m0, F.tid >> 3, (F.tid >> 3) + 64, (F.tid & 7) * 8);
        f32x4 acc[4][4];
        gemm_tile<true>(F, al, W + (size_t)n0 * D, D, acc);
#pragma unroll
        for (int mi = 0; mi < 4; ++mi) {
            const int row = m0 + wr * 64 + mi * 16 + fr;
            const float* gate = modp(F, 1, row >> 12, 2);
#pragma unroll
            for (int ni = 0; ni < 4; ++ni) {
                const int col = n0 + wc * 64 + ni * 16 + fq * 4;
                float* xp = XA + (size_t)row * D + col;
                const f32x4 s = *(const f32x4*)xp, gt = *(const f32x4*)(gate + col);
                *(f32x4*)xp = s + gt * acc[mi][ni];
            }
        }
    }
}

__device__ __forceinline__ void phase_final(Frame& F) {
    const Args& A = *F.a;
    const int gw = F.vcu * NWAVES + F.wave, NGW = F.G * NWAVES;
    for (int row = gw; row < NX; row += NGW) {
        f32x4 v[4];
        combine_row(F, row, modp(F, 1, row >> 12, 5), v);
        const float rstd = row_rstd(v);
#pragma unroll
        for (int j = 0; j < 4; ++j) {
            const int c0 = 4 * F.lane + 256 * j;
            const f32x4 g = *(const f32x4*)(A.in[I_FG] + c0);
            *(f32x4*)(A.out + (size_t)row * D + c0) = (v[j] * rstd) * g;
        }
    }
}

__global__ void __launch_bounds__(NTHREADS) fwd_kernel(Args args) {
    extern __shared__ __attribute__((aligned(16))) unsigned char smem[];
    Frame F;
    F.lds = (LAS char*)smem;
    F.tid = threadIdx.x; F.lane = F.tid & 63; F.wave = __builtin_amdgcn_readfirstlane(F.tid >> 6);
    F.G = gridDim.x; { const int bx = blockIdx.x; F.vcu = (F.G % 8 == 0) ? (bx % 8) * (F.G / 8) + bx / 8 : bx; }
    F.a = &args; F.ws = args.ws;
    volatile LAS unsigned* xbw = (volatile LAS unsigned*)(F.lds + LDS_XB);
    if (F.tid < 4) xbw[F.tid] = 0u;
    __syncthreads();
    XcdBarrier bar; bar.bar = (unsigned*)(F.ws + WS_CTL); bar.x = 0; bar.st = xbw;
    const int lo = args.ph_lo, hi = args.ph_hi;
    const bool multi = (hi - lo) > 1;
    if (multi) bar = xcd_barrier_post((unsigned*)(F.ws + WS_CTL), xbw);
#define RUN_PHASE(k, call) do { if (lo <= (k) && (k) < hi) { call; if ((k) + 1 < hi) xcd_barrier(bar); } } while (0)
    RUN_PHASE(0, phase_convert(F));
    RUN_PHASE(1, phase_prep0(F));
    RUN_PHASE(2, phase_gemm_in(F));
    RUN_PHASE(3, phase_scan(F));
    RUN_PHASE(4, phase_gemm_out0(F));
    RUN_PHASE(5, phase_route<0>(F));
    RUN_PHASE(6, phase_slots<0>(F));
    RUN_PHASE(7, phase_moe_up<0>(F));
    RUN_PHASE(8, phase_moe_down<0>(F));
    RUN_PHASE(9, phase_combine0(F));
    RUN_PHASE(10, phase_qkv(F));
    RUN_PHASE(11, phase_attn(F));
    RUN_PHASE(12, phase_gemm_wo(F));
    RUN_PHASE(13, phase_route<1>(F));
    RUN_PHASE(14, phase_slots<1>(F));
    RUN_PHASE(15, phase_moe_up<1>(F));
    RUN_PHASE(16, phase_moe_down<1>(F));
    RUN_PHASE(17, phase_final(F));
#undef RUN_PHASE
}

extern "C" void kernel_launch(void* const* d_in, const int* in_sizes, int n_in, void* d_out, int out_size, void* d_ws, size_t ws_size, hipStream_t stream) {
    static int grid = 0;
    if (grid == 0) {
        if (n_in != 27 || out_size != NX * D || ws_size < WS_END) { fprintf(stderr, "kernel_launch: unexpected shapes (n_in %d out %d ws %zu)\n", n_in, out_size, ws_size); grid = -1; return; }
        int dev = 0, cus = 0;
        if (hipGetDevice(&dev) != hipSuccess || hipDeviceGetAttribute(&cus, hipDeviceAttributeMultiprocessorCount, dev) != hipSuccess) { grid = -1; return; }
        if (hipFuncSetAttribute((const void*)fwd_kernel, hipFuncAttributeMaxDynamicSharedMemorySize, LDS_BYTES) != hipSuccess) { fprintf(stderr, "kernel_launch: hipFuncSetAttribute failed\n"); grid = -1; return; }
        (void)hipGetLastError();
        grid = cus < 256 ? cus : 256;
    }
    if (grid < 0) return;
    (void)hipMemsetAsync((char*)d_ws + WS_CTL, 0, CTL_ZERO_BYTES, stream);
    Args a{};
    for (int i = 0; i < 27; ++i) a.in[i] = (const float*)d_in[i];
    a.out = (float*)d_out; a.ws = (unsigned char*)d_ws;
    if (MK_N_LAUNCHES == 1) {
        a.ph_lo = 0; a.ph_hi = NPHASES;
        hipLaunchKernelGGL(fwd_kernel, dim3(grid), dim3(NTHREADS), LDS_BYTES, stream, a);
    } else {
        if (DBG_NPH == 0) { a.ph_lo = 0; a.ph_hi = 0; hipLaunchKernelGGL(fwd_kernel, dim3(grid), dim3(NTHREADS), LDS_BYTES, stream, a); }
        for (int p = 0; p < DBG_NPH; ++p) { a.ph_lo = p; a.ph_hi = p + 1; hipLaunchKernelGGL(fwd_kernel, dim3(grid), dim3(NTHREADS), LDS_BYTES, stream, a); }
    }
}
```

```cpp
#include <hip/hip_runtime.h>
#include <cstdio>
#include <cstdint>

#ifndef MK_N_LAUNCHES
#define MK_N_LAUNCHES 1
#endif

#ifndef DBG_NPH
#define DBG_NPH 18
#endif
#define LAS __attribute__((address_space(3)))
typedef unsigned short bf16;
typedef short bf16x8 __attribute__((ext_vector_type(8)));
typedef float f32x4 __attribute__((ext_vector_type(4)));
typedef float f32x16 __attribute__((ext_vector_type(16)));
typedef unsigned u32x4 __attribute__((ext_vector_type(4)));
typedef unsigned u32x2 __attribute__((ext_vector_type(2)));
typedef float f32x2 __attribute__((ext_vector_type(2)));

constexpr int D = 1024, NB = 4, S = 4096, CL = 256;
constexpr int NX = NB * S, NC = NB * CL, NTOK = NX + NC;
constexpr int NEXP = 32, DEXP = 512;
constexpr int NWAVES = 8, NTHREADS = 512;
constexpr int KEYS = S + CL;
constexpr float EPS = 1e-6f;
constexpr int PMAX = 43008;
constexpr int NPHASES = 18;

constexpr size_t MiB = 1u << 20;
constexpr size_t WS_CTL = 0, CTL_ZERO_BYTES = 64 * 1024;
constexpr size_t WS_MOD = 1 * MiB;
constexpr size_t WS_SEL = 2 * MiB;
constexpr size_t WS_WT = WS_SEL + 256 * 1024;
constexpr size_t WS_LRANK = WS_WT + 256 * 1024;
constexpr size_t WS_TOKSLOT = WS_LRANK + 256 * 1024;
constexpr size_t WS_BLKCNT = WS_TOKSLOT + 256 * 1024;
constexpr size_t WS_PSTART = WS_BLKCNT + 64 * 1024;
constexpr size_t WS_SLOTTOK = 3 * MiB + 512 * 1024;
constexpr size_t WS_SLOTW = WS_SLOTTOK + 256 * 1024;
constexpr size_t WS_WIN = 4 * MiB;
constexpr size_t WS_WOUT = 8 * MiB;
constexpr size_t WS_GATE = 10 * MiB;
constexpr size_t WS_WQKV = 11 * MiB;
constexpr size_t WS_WO = 17 * MiB;
constexpr size_t WS_WUP = 20 * MiB;
constexpr size_t WS_WDN = 148 * MiB;
constexpr size_t WS_XA = 212 * MiB;
constexpr size_t WS_H = 280 * MiB;
constexpr size_t WS_R = 314 * MiB;
constexpr size_t WS_YG = WS_R, WS_U = WS_R + 34 * MiB, WS_HF = WS_R + 68 * MiB, WS_HB = WS_R + 102 * MiB;
constexpr size_t WS_G = WS_R, WS_Y = WS_R + 42 * MiB;
constexpr size_t WS_Q = WS_R, WS_K = WS_R + 32 * MiB, WS_VT = WS_R + 66 * MiB, WS_AO = WS_R + 100 * MiB;
constexpr size_t WS_END = 450 * MiB;
static_assert(WS_Y + (size_t)PMAX * 1024 * 2 <= WS_END && WS_HB + 34 * MiB <= WS_END && WS_AO + 32 * MiB <= WS_END, "ws map");
static_assert(WS_K + (size_t)NB * 8 * 2 * KEYS * 64 * 2 <= WS_VT && WS_VT + (size_t)NB * 8 * 128 * KEYS * 2 <= WS_AO, "attn map");

constexpr int LDS_BYTES = 147456;
constexpr int LDS_XB = LDS_BYTES - 64;
constexpr int LDS_AUX = 131072;

__device__ __forceinline__ unsigned f2bf(float f) { unsigned u = __builtin_bit_cast(unsigned, f); return (u + 0x7fffu + ((u >> 16) & 1u)) >> 16; }
typedef __bf16 bf16x2_t __attribute__((ext_vector_type(2)));
__device__ __forceinline__ unsigned pk2(float lo, float hi) { const f32x2 v = {lo, hi}; const bf16x2_t b = __builtin_convertvector(v, bf16x2_t); return __builtin_bit_cast(unsigned, b); }
__device__ __forceinline__ float bflo(unsigned w) { return __builtin_bit_cast(float, w << 16); }
__device__ __forceinline__ float bfhi(unsigned w) { return __builtin_bit_cast(float, w & 0xffff0000u); }
__device__ __forceinline__ float wave_sum(float v) {
#pragma unroll
    for (int o = 1; o < 64; o <<= 1) v += __shfl_xor(v, o);
    return v;
}
__device__ __forceinline__ float sigmoidf_(float x) { return 1.0f / (1.0f + __expf(-x)); }
#define LDS_WAIT() asm volatile("s_waitcnt lgkmcnt(0)" ::: "memory")

#define XB_TMO      128
#define XB_XCNT(j)  (256  + 64 * (j))
#define XB_XSUB(j)  (1280 + 64 * (j))
#define XB_XGEN(j)  (2304 + 64 * (j))
#define XB_TOP      3328
#define XB_TOPGEN   3392
#define XCD_BAR_WORDS 3456
#define XB_SPIN_CAP (1u << 18)
__device__ __forceinline__ unsigned xb_ld(unsigned* p)              { return __hip_atomic_load(p, __ATOMIC_RELAXED, __HIP_MEMORY_SCOPE_AGENT); }
__device__ __forceinline__ unsigned xb_add(unsigned* p, unsigned v) { return __hip_atomic_fetch_add(p, v, __ATOMIC_RELAXED, __HIP_MEMORY_SCOPE_AGENT); }
__device__ __forceinline__ unsigned xb_xcc_id() { return (unsigned)__builtin_amdgcn_s_getreg((3 << 11) | 20) & 0xFu; }
#define XB_SPIN(cond, bar) do { unsigned _sp = 0; while (cond) { __builtin_amdgcn_s_sleep(1); \
    if ((++_sp & 255u) == 0u) { if (xb_ld(&(bar)[XB_TMO])) break; if (_sp > XB_SPIN_CAP) { atomicAdd(&(bar)[XB_TMO], 1u); break; } } } } while (0)
struct XcdBarrier { unsigned* bar; unsigned x; volatile LAS unsigned* st; };
__device__ __forceinline__ XcdBarrier xcd_barrier_post(unsigned* bar, volatile LAS unsigned* st) {
    XcdBarrier b; b.bar = bar; b.x = xb_xcc_id(); b.st = st;
    if (threadIdx.x == 0) (void)xb_add(&bar[XB_XCNT(b.x)], 1u);
    return b;
}
__device__ __forceinline__ void xcd_barrier_complete(unsigned* bar, unsigned x, unsigned& nloc, unsigned& nx) {
    const unsigned G = gridDim.x * gridDim.y * gridDim.z;
    unsigned sum, cnt, mine, sp = 0u;
    for (;;) {
        sum = 0u; cnt = 0u; mine = 0u;
#pragma unroll
        for (unsigned j = 0; j < 16; ++j) { const unsigned c = xb_ld(&bar[XB_XCNT(j)]); sum += c; cnt += (c > 0u) ? 1u : 0u; mine = (j == x) ? c : mine; }
        if (sum == G) break;
        __builtin_amdgcn_s_sleep(1);
        if ((++sp & 255u) == 0u) { if (xb_ld(&bar[XB_TMO])) break; if (sp > XB_SPIN_CAP) { atomicAdd(&bar[XB_TMO], 1u); break; } }
    }
    nloc = mine > 0u ? mine : 1u; nx = cnt > 0u ? cnt : 1u;
}
__device__ __forceinline__ void xcd_barrier(const XcdBarrier& b) {
    asm volatile("s_waitcnt vmcnt(0)" ::: "memory");
    __syncthreads();
    if (threadIdx.x == 0) {
        unsigned* bar = b.bar;
        __builtin_amdgcn_s_waitcnt(0);
        unsigned nloc = b.st[0], nx = b.st[1];
        if (nloc == 0u) { xcd_barrier_complete(bar, b.x, nloc, nx); b.st[0] = nloc; b.st[1] = nx; }
        const unsigned old = xb_add(&bar[XB_XSUB(b.x)], 1u);
        const unsigned gen = old / nloc;
        if (old + 1u == (gen + 1u) * nloc) {
            __builtin_amdgcn_fence(__ATOMIC_RELEASE, "agent");
            asm volatile("s_waitcnt vmcnt(0)" ::: "memory");
            const unsigned og = xb_add(&bar[XB_TOP], 1u);
            const unsigned tg = og / nx;
            if (og + 1u == (tg + 1u) * nx) xb_add(&bar[XB_TOPGEN], 1u);
            else XB_SPIN(xb_ld(&bar[XB_TOPGEN]) == tg, bar);
            __builtin_amdgcn_fence(__ATOMIC_ACQUIRE, "agent");
            xb_add(&bar[XB_XGEN(b.x)], 1u);
            asm volatile("s_waitcnt vmcnt(0)" ::: "memory");
        } else {
            XB_SPIN(xb_ld(&bar[XB_XGEN(b.x)]) == gen, bar);
            __builtin_amdgcn_fence(__ATOMIC_ACQUIRE, "agent");
            asm volatile("s_waitcnt vmcnt(0)" ::: "memory");
        }
    }
    __syncthreads();
}

struct Args { const float* in[27]; float* out; unsigned char* ws; int ph_lo, ph_hi; };
enum { I_X = 0, I_C, I_CTX, I_CCTX, I_WMOD, I_BMOD, I_N1G, I_N2G, I_WIN, I_CONVW, I_CONVB, I_GAW, I_GAB, I_GXW, I_GXB, I_LAM, I_WOUT,
       I_WQKV, I_DALAM, I_SUBLN, I_WO, I_RW, I_RB, I_MG, I_MU, I_MD, I_FG };

struct Frame {
    LAS char* lds;
    int tid, lane, wave, vcu, G;
    const Args* a;
    unsigned char* ws;
};

__device__ __forceinline__ const float* modp(const Frame& F, int l, int c, int k) { return (const float*)(F.ws + WS_MOD) + (size_t)(l * 5 + c) * 6144 + k * 1024; }
__device__ __forceinline__ int cond_of(int row) { return row < NX ? (row >> 12) : 4; }

__device__ __forceinline__ int moe_up_row(int n) { return ((n >> 7) << 8) + (((n >> 5) & 3) << 6) + (((n >> 4) & 1) << 5) + (n & 15); }

template <int MODE>
__device__ __forceinline__ void transpose_item(const float* __restrict__ W, int N, bf16* __restrict__ WT, int ldT, LAS float* scr, int item, int lane) {
    const int nblk = N / 32, kb = item / nblk, nb = item % nblk, k0 = 64 * kb, n0 = 32 * nb;
#pragma unroll 8
    for (int i = 0; i < 32; ++i) { const int kk = 2 * i + (lane >> 5); scr[kk * 33 + (lane & 31)] = W[(size_t)(k0 + kk) * N + n0 + (lane & 31)]; }
    LDS_WAIT();
    const int c = lane & 7;
#pragma unroll
    for (int j = 0; j < 4; ++j) {
        const int n = (lane >> 3) + 8 * j; const LAS float* s = scr + (8 * c) * 33 + n;
        u32x4 o; o.x = pk2(s[0 * 33], s[1 * 33]); o.y = pk2(s[2 * 33], s[3 * 33]); o.z = pk2(s[4 * 33], s[5 * 33]); o.w = pk2(s[6 * 33], s[7 * 33]);
        const int nn = n0 + n;
        const int drow = (MODE == 0) ? nn : (moe_up_row(nn) + (MODE == 2 ? 16 : 0));
        *(u32x4*)(WT + (size_t)drow * ldT + k0 + 8 * c) = o;
    }
    LDS_WAIT();
}

__device__ __forceinline__ void phase_convert(Frame& F) {
    const Args& A = *F.a;
    LAS float* scr = (LAS float*)(F.lds + F.wave * 8448);
    LAS float* sil = (LAS float*)(F.lds + 69632);
    for (int i = F.tid; i < 5 * 1024; i += NTHREADS) { const int c = i >> 10, k = i & 1023; const float v = (c < 4) ? A.in[I_C][c * 1024 + k] : A.in[I_CCTX][k]; sil[i] = v / (1.0f + __expf(-v)); }
    __syncthreads();
    const int gw = F.vcu * NWAVES + F.wave, NGW = F.G * NWAVES;
    constexpr int N_MOD = 192, N_WIN = 16 * 64, N_WOUT = 16 * 32, N_WQKV = 16 * 96, N_WO = 16 * 32, N_GATE = 32 * 8, N_MOE = 64 * 256;
    constexpr int NITEMS = N_MOD + N_WIN + N_WOUT + N_WQKV + N_WO + N_GATE + 3 * N_MOE;
    for (int it = gw; it < NITEMS; it += NGW) {
        int r = it;
#if defined(DBG_SUB) && DBG_SUB == 1
        if (r >= N_MOD) break;
#endif
#if defined(DBG_SUB) && DBG_SUB == 2
        if (r < N_MOD) continue;
#endif
        if (r < N_MOD) {
            const int l = r / 96, col = (r % 96) * 64 + F.lane;
            const float* wp = A.in[I_WMOD] + (size_t)l * 1024 * 6144 + col;
            float acc[5] = {0.f, 0.f, 0.f, 0.f, 0.f};
#pragma unroll 4
            for (int k = 0; k < 1024; k += 4) {
                const float w0 = wp[(size_t)k * 6144], w1 = wp[(size_t)(k + 1) * 6144], w2 = wp[(size_t)(k + 2) * 6144], w3 = wp[(size_t)(k + 3) * 6144];
#pragma unroll
                for (int c = 0; c < 5; ++c) { const f32x4 s4 = *(const LAS f32x4*)(sil + c * 1024 + k); acc[c] += s4.x * w0 + s4.y * w1 + s4.z * w2 + s4.w * w3; }
            }
            const float bm = A.in[I_BMOD][l * 6144 + col];
            float* mo = (float*)(F.ws + WS_MOD);
#pragma unroll
            for (int c = 0; c < 5; ++c) mo[(size_t)(l * 5 + c) * 6144 + col] = acc[c] + bm;
            continue;
        }
        r -= N_MOD;
        if (r < N_WIN) { transpose_item<0>(A.in[I_WIN], 2048, (bf16*)(F.ws + WS_WIN), 1024, scr, r, F.lane); continue; } r -= N_WIN;
        if (r < N_WOUT) { transpose_item<0>(A.in[I_WOUT], 1024, (bf16*)(F.ws + WS_WOUT), 1024, scr, r, F.lane); continue; } r -= N_WOUT;
        if (r < N_WQKV) { transpose_item<0>(A.in[I_WQKV], 3072, (bf16*)(F.ws + WS_WQKV), 1024, scr, r, F.lane); continue; } r -= N_WQKV;
        if (r < N_WO) { transpose_item<0>(A.in[I_WO], 1024, (bf16*)(F.ws + WS_WO), 1024, scr, r, F.lane); continue; } r -= N_WO;
        if (r < N_GATE) {
            const int m = r >> 3, it8 = r & 7, d = m >> 4, g = (m >> 3) & 1, n = m & 7;
            const float* src = (g == 0 ? A.in[I_GAW] : A.in[I_GXW]) + (size_t)(d * 8 + n) * 128 * 128;
            transpose_item<0>(src, 128, (bf16*)(F.ws + WS_GATE) + (size_t)m * 128 * 128, 128, scr, it8, F.lane); continue;
        }
        r -= N_GATE;
        if (r < N_MOE) { const int le = r >> 8; transpose_item<1>(A.in[I_MG] + (size_t)le * 1024 * 512, 512, (bf16*)(F.ws + WS_WUP) + (size_t)le * 1024 * 1024, 1024, scr, r & 255, F.lane); continue; } r -= N_MOE;
        if (r < N_MOE) { const int le = r >> 8; transpose_item<2>(A.in[I_MU] + (size_t)le * 1024 * 512, 512, (bf16*)(F.ws + WS_WUP) + (size_t)le * 1024 * 1024, 1024, scr, r & 255, F.lane); continue; } r -= N_MOE;
        { const int le = r >> 8; transpose_item<0>(A.in[I_MD] + (size_t)le * 512 * 1024, 1024, (bf16*)(F.ws + WS_WDN) + (size_t)le * 1024 * 512, 512, scr, r & 255, F.lane); }
    }
}

__device__ __forceinline__ float row_rstd(const f32x4 (&v)[4]) {
    float s = 0.f;
#pragma unroll
    for (int j = 0; j < 4; ++j) s += (v[j].x * v[j].x + v[j].y * v[j].y) + (v[j].z * v[j].z + v[j].w * v[j].w);
    return rsqrtf(wave_sum(s) * (1.0f / D) + EPS);
}
__device__ __forceinline__ void row_modulate_store(f32x4 (&v)[4], float rstd, const float* g, const float* sc, const float* sh, bf16* dst, int lane) {
#pragma unroll
    for (int j = 0; j < 4; ++j) {
        const int c0 = 4 * lane + 256 * j;
        const f32x4 gg = *(const f32x4*)(g + c0), s1 = *(const f32x4*)(sc + c0), s0 = *(const f32x4*)(sh + c0);
        v[j] = (v[j] * rstd) * gg * (1.0f + s1) + s0;
        u32x2 o; o.x = pk2(v[j].x, v[j].y); o.y = pk2(v[j].z, v[j].w);
        *(u32x2*)(dst + c0) = o;
    }
}

__device__ __forceinline__ void phase_prep0(Frame& F) {
    const Args& A = *F.a;
    const int gw = F.vcu * NWAVES + F.wave, NGW = F.G * NWAVES;
    bf16* H = (bf16*)(F.ws + WS_H);
    for (int row = gw; row < NTOK; row += NGW) {
        const float* src = row < NX ? A.in[I_X] + (size_t)row * D : A.in[I_CTX] + (size_t)(row - NX) * D;
        const int c = cond_of(row);
        f32x4 v[4];
#pragma unroll
        for (int j = 0; j < 4; ++j) v[j] = *(const f32x4*)(src + 4 * F.lane + 256 * j);
        const float rstd = row_rstd(v);
        row_modulate_store(v, rstd, A.in[I_N1G], modp(F, 0, c, 1), modp(F, 0, c, 0), H + (size_t)row * D, F.lane);
    }
}

constexpr int GEMM_STAGE = 49152;
__device__ __forceinline__ int swz128(int row, int chunk) { return row * 128 + ((chunk ^ ((row >> 1) & 7)) << 4); }
__device__ __forceinline__ int dma_kc(int tid) { return ((tid & 7) ^ ((tid >> 4) & 7)) * 8; }

struct ALDense {
    static constexpr bool DMA = true;
    const bf16* p0; const bf16* p1;
    __device__ __forceinline__ const bf16* ptr(int i) const { return i ? p1 : p0; }
    __device__ __forceinline__ void init(const bf16* A, int lda, int m0, int r0, int r1, int kc) { p0 = A + (size_t)(m0 + r0) * lda + kc; p1 = A + (size_t)(m0 + r1) * lda + kc; }
    __device__ __forceinline__ u32x4 load(int i, int k0) const { return *(const u32x4*)((i ? p1 : p0) + k0); }
};
struct ALGather {
    static constexpr bool DMA = true;
    const bf16* p0; const bf16* p1;
    __device__ __forceinline__ const bf16* ptr(int i) const { return i ? p1 : p0; }
    __device__ __forceinline__ void init(const bf16* A, int lda, const int* idx, int m0, int r0, int r1, int kc) { p0 = A + (size_t)idx[m0 + r0] * lda + kc; p1 = A + (size_t)idx[m0 + r1] * lda + kc; }
    __device__ __forceinline__ u32x4 load(int i, int k0) const { return *(const u32x4*)((i ? p1 : p0) + k0); }
};
struct ALCombine {
    static constexpr bool DMA = false;
    size_t o0, o1; const bf16 *hf, *hb, *yg;
    __device__ __forceinline__ const bf16* ptr(int) const { return nullptr; }
    __device__ __forceinline__ void init(const bf16* hf_, const bf16* hb_, const bf16* yg_, int m0, int r0, int r1, int kc) { hf = hf_; hb = hb_; yg = yg_; o0 = (size_t)(m0 + r0) * D + kc; o1 = (size_t)(m0 + r1) * D + kc; }
    __device__ __forceinline__ u32x4 load(int i, int k0) const {
        const size_t o = (i ? o1 : o0) + k0;
        const u32x4 a = *(const u32x4*)(hf + o), b = *(const u32x4*)(hb + o), y = *(const u32x4*)(yg + o);
        u32x4 r;
#pragma unroll
        for (int q = 0; q < 4; ++q) r[q] = pk2((bflo(a[q]) + bflo(b[q])) * bflo(y[q]), (bfhi(a[q]) + bfhi(b[q])) * bfhi(y[q]));
        return r;
    }
};

template <bool SWAP, class AL>
__device__ __forceinline__ void gemm_tile(const Frame& F, const AL& al, const bf16* __restrict__ Bt  , int K, f32x4 (&acc)[4][4]) {
    const int tid = F.tid, lane = F.lane, wid = F.wave, wr = wid >> 2, wc = wid & 3, fr = lane & 15, fq = lane >> 4;
    const int sr = tid >> 3;
    const int sc = AL::DMA ? ((tid & 7) ^ ((sr >> 1) & 7)) : (tid & 7);
    LAS char* lds = F.lds;
    const bf16* bp = Bt + (size_t)sr * K + sc * 8;
    const size_t bstep = (size_t)64 * K;
    int wa[2], wb[4];
#pragma unroll
    for (int i = 0; i < 2; ++i) wa[i] = swz128(sr + 64 * i, sc);
#pragma unroll
    for (int i = 0; i < 4; ++i) wb[i] = 16384 + swz128(sr + 64 * i, sc);
    const int key = (fr >> 1) & 7;
    const int ra = (wr * 64 + fr) * 128, rb = 16384 + (wc * 64 + fr) * 128;
#pragma unroll
    for (int mi = 0; mi < 4; ++mi)
#pragma unroll
        for (int ni = 0; ni < 4; ++ni) acc[mi][ni] = (f32x4){0.f, 0.f, 0.f, 0.f};
    u32x4 ga[2], gb[4];
    const int wl = wid * 1024;
#define GT_DMA(stage_, k_) do { \
        __builtin_amdgcn_global_load_lds((const unsigned*)(al.ptr(0) + (k_)), (LAS unsigned*)(lds + (stage_) + wl), 16, 0, 0); \
        __builtin_amdgcn_global_load_lds((const unsigned*)(al.ptr(1) + (k_)), (LAS unsigned*)(lds + (stage_) + 8192 + wl), 16, 0, 0); \
        _Pragma("unroll") for (int i_ = 0; i_ < 4; ++i_) \
            __builtin_amdgcn_global_load_lds((const unsigned*)(bp + i_ * bstep + (k_)), (LAS unsigned*)(lds + (stage_) + 16384 + i_ * 8192 + wl), 16, 0, 0); } while (0)
    if constexpr (AL::DMA) { GT_DMA(0, 0); }
    else {
        ga[0] = al.load(0, 0); ga[1] = al.load(1, 0);
#pragma unroll
        for (int i = 0; i < 4; ++i) gb[i] = *(const u32x4*)(bp + i * bstep);
#pragma unroll
        for (int i = 0; i < 2; ++i) *(LAS u32x4*)(lds + wa[i]) = ga[i];
#pragma unroll
        for (int i = 0; i < 4; ++i) *(LAS u32x4*)(lds + wb[i]) = gb[i];
    }
    __syncthreads();
    const int nk = K / 64;
    for (int kt = 0; kt < nk; ++kt) {
        const int cur = (kt & 1) * GEMM_STAGE, nxt = GEMM_STAGE - cur;
        if (kt + 1 < nk) {
            const int k1 = (kt + 1) * 64;
            if constexpr (AL::DMA) { GT_DMA(nxt, k1); }
            else {
                ga[0] = al.load(0, k1); ga[1] = al.load(1, k1);
#pragma unroll
                for (int i = 0; i < 4; ++i) gb[i] = *(const u32x4*)(bp + i * bstep + k1);
            }
        }
#pragma unroll
        for (int ks = 0; ks < 2; ++ks) {
            const int co = ((ks * 4 + fq) ^ key) << 4;
            bf16x8 af[4], bfr[4];
#pragma unroll
            for (int mi = 0; mi < 4; ++mi) af[mi] = *(const LAS bf16x8*)(lds + cur + ra + mi * 2048 + co);
#pragma unroll
            for (int ni = 0; ni < 4; ++ni) bfr[ni] = *(const LAS bf16x8*)(lds + cur + rb + ni * 2048 + co);
#pragma unroll
            for (int mi = 0; mi < 4; ++mi)
#pragma unroll
                for (int ni = 0; ni < 4; ++ni)
                    acc[mi][ni] = SWAP ? __builtin_amdgcn_mfma_f32_16x16x32_bf16(bfr[ni], af[mi], acc[mi][ni], 0, 0, 0)
                                       : __builtin_amdgcn_mfma_f32_16x16x32_bf16(af[mi], bfr[ni], acc[mi][ni], 0, 0, 0);
        }
        if constexpr (!AL::DMA) {
            if (kt + 1 < nk) {
#pragma unroll
                for (int i = 0; i < 2; ++i) *(LAS u32x4*)(lds + nxt + wa[i]) = ga[i];
#pragma unroll
                for (int i = 0; i < 4; ++i) *(LAS u32x4*)(lds + nxt + wb[i]) = gb[i];
            }
        }
        __syncthreads();
    }
#undef GT_DMA
}

__device__ __forceinline__ float gelu_tanh(float x) {
    const float z = 0.7978845608028654f * (x + 0.044715f * x * x * x);
    const float t = 1.0f - 2.0f / (1.0f + __expf(2.0f * z));
    return 0.5f * x * (1.0f + t);
}

__device__ __forceinline__ void phase_gemm_in(Frame& F) {
    const bf16* H = (const bf16*)(F.ws + WS_H); const bf16* W = (const bf16*)(F.ws + WS_WIN);
    bf16* YG = (bf16*)(F.ws + WS_YG); bf16* U = (bf16*)(F.ws + WS_U);
    const int wr = F.wave >> 2, wc = F.wave & 3, fr = F.lane & 15, fq = F.lane >> 4;
    constexpr int NTN = 8, NUNITS = (NTOK / 128) * NTN;
    for (int u = F.vcu; u < NUNITS; u += F.G) {
        const int mt = u / NTN, nt = u % NTN, m0 = mt * 128, n0 = nt * 256;
        ALDense al; al.init(H, D, m0, F.tid >> 3, (F.tid >> 3) + 64, dma_kc(F.tid));
        f32x4 acc[4][4];
        gemm_tile<true>(F, al, W + (size_t)n0 * D, D, acc);
        const bool isy = n0 < 1024;
        bf16* dst = isy ? YG : U; const int nb = isy ? n0 : n0 - 1024;
#pragma unroll
        for (int mi = 0; mi < 4; ++mi) {
            const int row = m0 + wr * 64 + mi * 16 + fr;
#pragma unroll
            for (int ni = 0; ni < 4; ++ni) {
                f32x4 v = acc[mi][ni];
                if (isy) { v.x = gelu_tanh(v.x); v.y = gelu_tanh(v.y); v.z = gelu_tanh(v.z); v.w = gelu_tanh(v.w); }
                u32x2 o; o.x = pk2(v.x, v.y); o.y = pk2(v.z, v.w);
                *(u32x2*)(dst + (size_t)row * D + nb + wc * 64 + ni * 16 + fq * 4) = o;
            }
        }
    }
}

__device__ __forceinline__ float neg_expm1(float x) {
    const float p = 1.0f + x * (0.5f + x * (0.16666667f + x * (0.041666668f + x * (0.0083333338f + x * 0.0013888889f))));
    const float ser = -x * p, big = 1.0f - __expf(x);
    return x > -0.5f ? ser : big;
}
__device__ __forceinline__ void phase_scan(Frame& F) {
    const Args& A = *F.a;
    const int wi = F.vcu;
    if (wi >= 256) return;
    const int b = wi >> 6, n = (wi >> 3) & 7, d = (wi >> 2) & 1, q = wi & 3;
    const int tid = F.tid, lane = F.lane, w = F.wave, fr = lane & 15, fq = lane >> 4;
    LAS char* RAW = F.lds;
    LAS char* AT = F.lds + 33792;
    LAS float* AGG = (LAS float*)(F.lds + 66560);
    LAS float* CIN = (LAS float*)(F.lds + 74752);
    const bf16* U = (const bf16*)(F.ws + WS_U);
    bf16* HO = (bf16*)(F.ws + (d ? WS_HB : WS_HF));
    const int chbase = n * 128, och = chbase + q * 32;
    const bf16* GT = (const bf16*)(F.ws + WS_GATE);
    LAS char* BT = F.lds + 81920;
#pragma unroll
    for (int i = 0; i < 2; ++i) {
        const int idx = tid + 512 * i, jrow = idx >> 4, c = idx & 15, nb = jrow >> 4, f2 = jrow & 15;
        *(LAS u32x4*)(BT + jrow * 256 + ((c ^ f2) << 4)) = *(const u32x4*)(GT + ((size_t)(((d * 2 + (nb >> 1)) * 8 + n) * 128 + q * 32 + (nb & 1) * 16 + f2)) * 128 + c * 8);
    }
    float ba[2], bi[2], sp8[2];
#pragma unroll
    for (int h = 0; h < 2; ++h) {
        const int ch = och + h * 16 + fr;
        ba[h] = A.in[I_GAB][d * 1024 + ch]; bi[h] = A.in[I_GXB][d * 1024 + ch];
        sp8[h] = 8.0f * log1pf(expf(-A.in[I_LAM][d * 1024 + ch]));
    }
    const int c8 = tid & 15, r0 = tid >> 4;
    LAS float* CW = (LAS float*)(F.lds + 78848);
    for (int i = tid; i < 640; i += NTHREADS) CW[i] = (i < 512) ? A.in[I_CONVW][(i >> 7) * 1024 + chbase + (i & 127)] : A.in[I_CONVB][chbase + (i - 512)];

    float hcar = 0.f;
    u32x4 pre[5];
    for (int step = 0; step < 34; ++step) {
        int segbase, seglen, tile;
        if (step < 2) { segbase = NX + b * CL; seglen = CL; tile = d ? (1 - step) : step; }
        else { segbase = b * S; seglen = S; tile = d ? (33 - step) : (step - 2); }
        const int t0 = tile * 128;
        if (step == 0) {
#pragma unroll
            for (int i = 0; i < 5; ++i) {
                const int idx = tid + 512 * i; const int row = idx >> 4, c = idx & 15; const int t = t0 - 2 + row;
                u32x4 v = (u32x4){0u, 0u, 0u, 0u};
                if (idx < 2112 && t >= 0 && t < seglen) v = *(const u32x4*)(U + (size_t)(segbase + t) * D + chbase + c * 8);
                pre[i] = v;
            }
        }
#pragma unroll
        for (int i = 0; i < 5; ++i) { const int idx = tid + 512 * i; if (idx < 2112) *(LAS u32x4*)(RAW + idx * 16) = pre[i]; }
        __syncthreads();
        if (step + 1 < 34) {
            const int s1 = step + 1; int sb1, sl1, tl1;
            if (s1 < 2) { sb1 = NX + b * CL; sl1 = CL; tl1 = d ? (1 - s1) : s1; }
            else { sb1 = b * S; sl1 = S; tl1 = d ? (33 - s1) : (s1 - 2); }
            const int t1 = tl1 * 128;
#pragma unroll
            for (int i = 0; i < 5; ++i) {
                const int idx = tid + 512 * i; const int row = idx >> 4, c = idx & 15; const int t = t1 - 2 + row;
                u32x4 v = (u32x4){0u, 0u, 0u, 0u};
                if (idx < 2112 && t >= 0 && t < sl1) v = *(const u32x4*)(U + (size_t)(sb1 + t) * D + chbase + c * 8);
                pre[i] = v;
            }
        }
#pragma unroll 1
        for (int i = 0; i < 4; ++i) {
            const int r = r0 + 32 * i;
            float o[8];
            { const f32x4 b0 = *(const LAS f32x4*)(CW + 512 + c8 * 8), b1 = *(const LAS f32x4*)(CW + 512 + c8 * 8 + 4);
              o[0] = b0.x; o[1] = b0.y; o[2] = b0.z; o[3] = b0.w; o[4] = b1.x; o[5] = b1.y; o[6] = b1.z; o[7] = b1.w; }
#pragma unroll
            for (int k = 0; k < 4; ++k) {
                const u32x4 x = *(const LAS u32x4*)(RAW + (r + k) * 256 + c8 * 16);
                const f32x4 w0 = *(const LAS f32x4*)(CW + k * 128 + c8 * 8), w1 = *(const LAS f32x4*)(CW + k * 128 + c8 * 8 + 4);
                o[0] += w0.x * bflo(x[0]); o[1] += w0.y * bfhi(x[0]); o[2] += w0.z * bflo(x[1]); o[3] += w0.w * bfhi(x[1]);
                o[4] += w1.x * bflo(x[2]); o[5] += w1.y * bfhi(x[2]); o[6] += w1.z * bflo(x[3]); o[7] += w1.w * bfhi(x[3]);
            }
            u32x4 ov; ov.x = pk2(o[0], o[1]); ov.y = pk2(o[2], o[3]); ov.z = pk2(o[4], o[5]); ov.w = pk2(o[6], o[7]);
            *(LAS u32x4*)(AT + r * 256 + ((c8 ^ (r & 15)) << 4)) = ov;
        }
        __syncthreads();
        f32x4 acc[4];
#pragma unroll
        for (int nb = 0; nb < 4; ++nb) acc[nb] = (f32x4){0.f, 0.f, 0.f, 0.f};
#pragma unroll
        for (int ks = 0; ks < 4; ++ks) {
            const int row = 16 * w + fr;
            const bf16x8 af = *(const LAS bf16x8*)(AT + row * 256 + (((4 * ks + fq) ^ fr) << 4));
#pragma unroll
            for (int nb = 0; nb < 4; ++nb) {
                const bf16x8 bq = *(const LAS bf16x8*)(BT + (nb * 16 + fr) * 256 + (((4 * ks + fq) ^ fr) << 4));
                acc[nb] = __builtin_amdgcn_mfma_f32_16x16x32_bf16(af, bq, acc[nb], 0, 0, 0);
            }
        }
        float av[2][4], bv[2][4];
#pragma unroll
        for (int h = 0; h < 2; ++h) {
            const int col = q * 32 + h * 16 + fr, chunk = col >> 3, within = col & 7;
#pragma unroll
            for (int reg = 0; reg < 4; ++reg) {
                const int tr = 16 * w + 4 * fq + reg;
                const float r_ = sigmoidf_(acc[h][reg] + ba[h]);
                const float i_ = sigmoidf_(acc[2 + h][reg] + bi[h]);
                const float la = -sp8[h] * r_;
                const float a_ = __expf(la);
                const unsigned short ub = *(const LAS unsigned short*)(AT + tr * 256 + ((chunk ^ (tr & 15)) << 4) + within * 2);
                const float uval = __builtin_bit_cast(float, (unsigned)ub << 16);
                av[h][reg] = a_;
                bv[h][reg] = sqrtf(neg_expm1(2.0f * la)) * (i_ * uval);
            }
        }
        const int g = 4 * w + fq;
#pragma unroll
        for (int h = 0; h < 2; ++h) {
            float P = 1.f, Hh = 0.f;
#pragma unroll
            for (int s = 0; s < 4; ++s) { const int reg = d ? (3 - s) : s; Hh = av[h][reg] * Hh + bv[h][reg]; P *= av[h][reg]; }
            AGG[(g * 32 + h * 16 + fr) * 2 + 0] = P; AGG[(g * 32 + h * 16 + fr) * 2 + 1] = Hh;
        }
        __syncthreads();
        if (tid < 32) {
            f32x2 ag[32];
#pragma unroll
            for (int gi = 0; gi < 32; ++gi) ag[gi] = *(const LAS f32x2*)(AGG + (gi * 32 + tid) * 2);
            float hh = hcar;
            if (d == 0) {
#pragma unroll
                for (int gi = 0; gi < 32; ++gi) { CIN[gi * 32 + tid] = hh; hh = ag[gi].x * hh + ag[gi].y; }
            } else {
#pragma unroll
                for (int gi = 31; gi >= 0; --gi) { CIN[gi * 32 + tid] = hh; hh = ag[gi].x * hh + ag[gi].y; }
            }
            hcar = hh;
        }
        __syncthreads();
#pragma unroll
        for (int h = 0; h < 2; ++h) {
            float hh = CIN[g * 32 + h * 16 + fr];
            float outv[4];
#pragma unroll
            for (int s = 0; s < 4; ++s) { const int reg = d ? (3 - s) : s; hh = av[h][reg] * hh + bv[h][reg]; outv[reg] = hh; }
#pragma unroll
            for (int reg = 0; reg < 4; ++reg) {
                const int tr = 16 * w + 4 * fq + reg;
                HO[(size_t)(segbase + t0 + tr) * D + och + h * 16 + fr] = (bf16)f2bf(outv[reg]);
            }
        }
    }
}

__device__ __forceinline__ void phase_gemm_out0(Frame& F) {
    const Args& A = *F.a;
    const bf16* W = (const bf16*)(F.ws + WS_WOUT);
    float* XA = (float*)(F.ws + WS_XA);
    const int wr = F.wave >> 2, wc = F.wave & 3, fr = F.lane & 15, fq = F.lane >> 4;
    constexpr int NTN = 4, NUNITS = (NTOK / 128) * NTN;
    for (int u = F.vcu; u < NUNITS; u += F.G) {
        const int mt = u / NTN, nt = u % NTN, m0 = mt * 128, n0 = nt * 256;
        ALCombine al; al.init((const bf16*)(F.ws + WS_HF), (const bf16*)(F.ws + WS_HB), (const bf16*)(F.ws + WS_YG), m0, F.tid >> 3, (F.tid >> 3) + 64, (F.tid & 7) * 8);
        f32x4 acc[4][4];
        gemm_tile<true>(F, al, W + (size_t)n0 * D, D, acc);
#pragma unroll
        for (int mi = 0; mi < 4; ++mi) {
            const int row = m0 + wr * 64 + mi * 16 + fr;
            const float* src = row < NX ? A.in[I_X] + (size_t)row * D : A.in[I_CTX] + (size_t)(row - NX) * D;
            const float* gate = modp(F, 0, cond_of(row), 2);
#pragma unroll
            for (int ni = 0; ni < 4; ++ni) {
                const int col = n0 + wc * 64 + ni * 16 + fq * 4;
                const f32x4 s = *(const f32x4*)(src + col), gt = *(const f32x4*)(gate + col);
                *(f32x4*)(XA + (size_t)row * D + col) = s + gt * acc[mi][ni];
            }
        }
    }
}

template <int LAYER>
__device__ __forceinline__ void phase_route(Frame& F) {
    const Args& A = *F.a;
    constexpr int NT = LAYER == 0 ? NTOK : NX;
    constexpr int PER = NT / 256;
    LAS char* RW = F.lds;
    LAS int* selL = (LAS int*)(F.lds + LDS_AUX);
    LAS int* rankL = selL + 2 * 68;
    LAS int* cntL = rankL + 2 * 68;
    const int tid = F.tid, lane = F.lane;
    for (int i = 0; i < 16; ++i) {
        const int idx = tid + 512 * i, k = idx >> 3, e4 = idx & 7;
        const int rho = (((k >> 8) * 4 + (k & 3)) << 6) + ((k >> 2) & 63);
        *(LAS f32x4*)(RW + rho * 128 + ((e4 ^ ((rho >> 1) & 7)) << 4)) = *(const f32x4*)(A.in[I_RW] + (size_t)k * 32 + e4 * 4);
    }
    __syncthreads();
    const int blk = F.vcu;
    if (blk < 256) {
        const float* XA = (const float*)(F.ws + WS_XA);
        bf16* H = (bf16*)(F.ws + WS_H);
        const float rbias = A.in[I_RB][lane & 31];
        for (int li = F.wave; li < PER; li += NWAVES) {
            const int row = blk * PER + li;
            const int c = cond_of(row);
            f32x4 v[4];
#pragma unroll
            for (int j = 0; j < 4; ++j) v[j] = *(const f32x4*)(XA + (size_t)row * D + 4 * lane + 256 * j);
            const float rstd = row_rstd(v);
            row_modulate_store(v, rstd, A.in[I_N2G] + LAYER * D, modp(F, LAYER, c, 4), modp(F, LAYER, c, 3), H + (size_t)row * D, lane);
            float acc[32];
#pragma unroll
            for (int e = 0; e < 32; ++e) acc[e] = 0.f;
#pragma unroll 1
            for (int jc = 0; jc < 16; ++jc) {
                const int j = jc >> 2, c = jc & 3;
                f32x4 hv4 = v[0];
                if (j == 1) hv4 = v[1];
                if (j == 2) hv4 = v[2];
                if (j == 3) hv4 = v[3];
                float hv = hv4.x;
                if (c == 1) hv = hv4.y;
                if (c == 2) hv = hv4.z;
                if (c == 3) hv = hv4.w;
                const int rho = jc * 64 + lane;
                const LAS char* rp = RW + rho * 128; const int key = (rho >> 1) & 7;
#pragma unroll
                for (int e4 = 0; e4 < 8; ++e4) {
                    const f32x4 w4 = *(const LAS f32x4*)(rp + ((e4 ^ key) << 4));
                    acc[e4 * 4 + 0] += hv * w4.x; acc[e4 * 4 + 1] += hv * w4.y; acc[e4 * 4 + 2] += hv * w4.z; acc[e4 * 4 + 3] += hv * w4.w;
                }
            }
#define BFLY(S, HALF) { const bool up = (lane >> (S)) & 1; _Pragma("unroll") for (int i = 0; i < (HALF); ++i) { \
                const float keep = up ? acc[i + (HALF)] : acc[i]; const float send = up ? acc[i] : acc[i + (HALF)]; acc[i] = keep + __shfl_xor(send, 1 << (S)); } }
            BFLY(0, 16) BFLY(1, 8) BFLY(2, 4) BFLY(3, 2) BFLY(4, 1)
#undef BFLY
            float tot = acc[0] + __shfl_xor(acc[0], 32);
            const int e = lane & 31;
            const float logit = __shfl(tot, (int)(__builtin_bitreverse32((unsigned)e) >> 27));
            const float sc = 1.0f / (1.0f + expf(-logit));
            const float ss = sc + rbias;
            float m1 = ss;
#pragma unroll
            for (int o = 1; o < 8; o <<= 1) m1 = fmaxf(m1, __shfl_xor(m1, o));
            int i1 = (ss == m1) ? e : 64;
#pragma unroll
            for (int o = 1; o < 8; o <<= 1) i1 = min(i1, __shfl_xor(i1, o));
            const float s2 = (e == i1) ? -INFINITY : ss;
            float m2 = s2;
#pragma unroll
            for (int o = 1; o < 8; o <<= 1) m2 = fmaxf(m2, __shfl_xor(m2, o));
            int i2 = (s2 == m2 && e != i1) ? e : 64;
#pragma unroll
            for (int o = 1; o < 8; o <<= 1) i2 = min(i2, __shfl_xor(i2, o));
            const float gs = m1 + m2;
            float gbest = gs;
            gbest = fmaxf(gbest, __shfl_xor(gbest, 8)); gbest = fmaxf(gbest, __shfl_xor(gbest, 16));
            int gsel = (gs == gbest) ? (e >> 3) : 64;
            gsel = min(gsel, __shfl_xor(gsel, 8)); gsel = min(gsel, __shfl_xor(gsel, 16));
            const int e0 = __shfl(i1, gsel * 8), e1 = __shfl(i2, gsel * 8);
            const float w0 = __shfl(sc, e0), w1 = __shfl(sc, e1);
            if (lane == 0) {
                const float inv = 1.0f / (w0 + w1);
                selL[li * 2] = e0; selL[li * 2 + 1] = e1;
                ((float2*)(F.ws + WS_WT))[row] = make_float2(w0 * inv, w1 * inv);
                ((int2*)(F.ws + WS_SEL))[row] = make_int2(e0, e1);
            }
        }
        __syncthreads();
        if (tid < 32) {
            int cnt = 0;
            for (int i = 0; i < 2 * PER; ++i) { if (selL[i] == tid) { rankL[i] = cnt; ++cnt; } }
            ((int*)(F.ws + WS_BLKCNT))[blk * 32 + tid] = cnt;
        }
        __syncthreads();
        for (int i = tid; i < PER; i += NTHREADS) ((int2*)(F.ws + WS_LRANK))[blk * PER + i] = make_int2(rankL[2 * i], rankL[2 * i + 1]);
    }
}

template <int LAYER>
__device__ __forceinline__ void phase_slots(Frame& F) {
    constexpr int NT = LAYER == 0 ? NTOK : NX;
    constexpr int PER = NT / 256;
    LAS int* part = (LAS int*)F.lds;
    LAS int* tot = part + 1024;
    LAS int* base = tot + 32;
    LAS int* pst = base + 32;
    const int tid = F.tid, blk = F.vcu;
    const int* bc = (const int*)(F.ws + WS_BLKCNT);
    {
        const int e = tid & 31, p = tid >> 5;
        int st = 0, sb = 0;
        for (int b2 = p; b2 < 256; b2 += 16) { const int c = bc[b2 * 32 + e]; st += c; sb += (b2 < blk) ? c : 0; }
        part[p * 32 + e] = st; part[512 + p * 32 + e] = sb;
    }
    __syncthreads();
    if (tid < 32) { int st = 0, sb = 0; for (int p = 0; p < 16; ++p) { st += part[p * 32 + tid]; sb += part[512 + p * 32 + tid]; } tot[tid] = st; base[tid] = sb; }
    __syncthreads();
    if (tid == 0) { int s = 0; for (int e = 0; e < 32; ++e) { pst[e] = s; s += (tot[e] + 127) & ~127; } pst[32] = s; }
    __syncthreads();
    int* slot_tok = (int*)(F.ws + WS_SLOTTOK); float* slot_w = (float*)(F.ws + WS_SLOTW);
    if (blk == 0 && tid < 33) ((int*)(F.ws + WS_PSTART))[tid] = pst[tid];
    if (blk < 256) {
        for (int i = tid; i < PER; i += NTHREADS) {
            const int t = blk * PER + i;
            const int2 se = ((const int2*)(F.ws + WS_SEL))[t]; const int2 lr = ((const int2*)(F.ws + WS_LRANK))[t]; const float2 wt = ((const float2*)(F.ws + WS_WT))[t];
            const int s0 = pst[se.x] + base[se.x] + lr.x, s1 = pst[se.y] + base[se.y] + lr.y;
            slot_tok[s0] = t; slot_w[s0] = wt.x; slot_tok[s1] = t; slot_w[s1] = wt.y;
            ((int2*)(F.ws + WS_TOKSLOT))[t] = make_int2(s0, s1);
        }
    }
    if (blk < 32) {
        const int lo = pst[blk] + tot[blk], hi = pst[blk + 1];
        for (int s = lo + tid; s < hi; s += NTHREADS) { slot_tok[s] = 0; slot_w[s] = 0.f; }
    }
}

template <int LAYER>
__device__ __forceinline__ void phase_moe_up(Frame& F) {
    LAS int* pst = (LAS int*)(F.lds + LDS_AUX);
    if (F.tid < 33) pst[F.tid] = ((const int*)(F.ws + WS_PSTART))[F.tid];
    __syncthreads();
    const int ntiles = pst[32] >> 7, nunits = ntiles * 4;
    const bf16* H = (const bf16*)(F.ws + WS_H);
    const bf16* W = (const bf16*)(F.ws + WS_WUP) + (size_t)LAYER * 32 * 1024 * 1024;
    const int* slot_tok = (const int*)(F.ws + WS_SLOTTOK); const float* slot_w = (const float*)(F.ws + WS_SLOTW);
    bf16* G = (bf16*)(F.ws + WS_G);
    const int wr = F.wave >> 2, wc = F.wave & 3, fr = F.lane & 15, fq = F.lane >> 4;
    for (int u = F.vcu; u < nunits; u += F.G) {
        const int mt = u >> 2, j = u & 3, m0 = mt * 128;
        int e = 0;
        for (int x = 1; x < 32; ++x) e = (pst[x] <= m0) ? x : e;
        ALGather al; al.init(H, D, slot_tok, m0, F.tid >> 3, (F.tid >> 3) + 64, dma_kc(F.tid));
        f32x4 acc[4][4];
        gemm_tile<true>(F, al, W + ((size_t)e * 1024 + j * 256) * D, D, acc);
#pragma unroll
        for (int mi = 0; mi < 4; ++mi) {
            const int row = m0 + wr * 64 + mi * 16 + fr;
            const float wgt = slot_w[row];
#pragma unroll
            for (int p = 0; p < 2; ++p) {
                const f32x4 g = acc[mi][2 * p], uu = acc[mi][2 * p + 1];
                float o[4];
#pragma unroll
                for (int c = 0; c < 4; ++c) o[c] = g[c] / (1.0f + __expf(-g[c])) * uu[c] * wgt;
                u32x2 ov; ov.x = pk2(o[0], o[1]); ov.y = pk2(o[2], o[3]);
                *(u32x2*)(G + (size_t)row * DEXP + j * 128 + wc * 32 + p * 16 + fq * 4) = ov;
            }
        }
    }
}

template <int LAYER>
__device__ __forceinline__ void phase_moe_down(Frame& F) {
    LAS int* pst = (LAS int*)(F.lds + LDS_AUX);
    if (F.tid < 33) pst[F.tid] = ((const int*)(F.ws + WS_PSTART))[F.tid];
    __syncthreads();
    const int ntiles = pst[32] >> 7, nunits = ntiles * 4;
    const bf16* G = (const bf16*)(F.ws + WS_G);
    const bf16* W = (const bf16*)(F.ws + WS_WDN) + (size_t)LAYER * 32 * 1024 * 512;
    bf16* Y = (bf16*)(F.ws + WS_Y);
    const int wr = F.wave >> 2, wc = F.wave & 3, fr = F.lane & 15, fq = F.lane >> 4;
    for (int u = F.vcu; u < nunits; u += F.G) {
        const int mt = u >> 2, j = u & 3, m0 = mt * 128, n0 = j * 256;
        int e = 0;
        for (int x = 1; x < 32; ++x) e = (pst[x] <= m0) ? x : e;
        ALDense al; al.init(G, DEXP, m0, F.tid >> 3, (F.tid >> 3) + 64, dma_kc(F.tid));
        f32x4 acc[4][4];
        gemm_tile<true>(F, al, W + ((size_t)e * 1024 + n0) * DEXP, DEXP, acc);
#pragma unroll
        for (int mi = 0; mi < 4; ++mi) {
            const int row = m0 + wr * 64 + mi * 16 + fr;
#pragma unroll
            for (int ni = 0; ni < 4; ++ni) {
                const f32x4 v = acc[mi][ni];
                u32x2 o; o.x = pk2(v.x, v.y); o.y = pk2(v.z, v.w);
                *(u32x2*)(Y + (size_t)row * D + n0 + wc * 64 + ni * 16 + fq * 4) = o;
            }
        }
    }
}

__device__ __forceinline__ void combine_row(const Frame& F, int row, const float* gate, f32x4 (&v)[4]) {
    const float* XA = (const float*)(F.ws + WS_XA); const bf16* Y = (const bf16*)(F.ws + WS_Y);
    const int2 ts = ((const int2*)(F.ws + WS_TOKSLOT))[row];
#pragma unroll
    for (int j = 0; j < 4; ++j) {
        const int c0 = 4 * F.lane + 256 * j;
        const f32x4 x = *(const f32x4*)(XA + (size_t)row * D + c0), gt = *(const f32x4*)(gate + c0);
        const u32x2 y0 = *(const u32x2*)(Y + (size_t)ts.x * D + c0), y1 = *(const u32x2*)(Y + (size_t)ts.y * D + c0);
        f32x4 y; y.x = bflo(y0.x) + bflo(y1.x); y.y = bfhi(y0.x) + bfhi(y1.x); y.z = bflo(y0.y) + bflo(y1.y); y.w = bfhi(y0.y) + bfhi(y1.y);
        v[j] = x + gt * y;
    }
}

__device__ __forceinline__ void phase_combine0(Frame& F) {
    const Args& A = *F.a;
    const int gw = F.vcu * NWAVES + F.wave, NGW = F.G * NWAVES;
    float* XA = (float*)(F.ws + WS_XA); bf16* H = (bf16*)(F.ws + WS_H);
    for (int row = gw; row < NTOK; row += NGW) {
        const int c = cond_of(row);
        f32x4 v[4];
        combine_row(F, row, modp(F, 0, c, 5), v);
#pragma unroll
        for (int j = 0; j < 4; ++j) *(f32x4*)(XA + (size_t)row * D + 4 * F.lane + 256 * j) = v[j];
        const float rstd = row_rstd(v);
        row_modulate_store(v, rstd, A.in[I_N1G] + D, modp(F, 1, c, 1), modp(F, 1, c, 0), H + (size_t)row * D, F.lane);
    }
}

constexpr float QSCALE = 0.125f * 1.4426950408889634f;
__device__ __forceinline__ void phase_qkv(Frame& F) {
    LAS float* CS = (LAS float*)(F.lds + LDS_AUX);
    for (int i = F.tid; i < 1024; i += NTHREADS) {
        const int p = i >> 4, f = i & 15;
        const float inv = 1.0f / powf(10000.0f, (float)f / 16.0f);
        const float ang = (float)p * inv;
        const double rev = (double)ang * 0.15915494309189535;
        const float fr_ = (float)(rev - floor(rev));
        CS[i * 2] = __builtin_amdgcn_cosf(fr_); CS[i * 2 + 1] = __builtin_amdgcn_sinf(fr_);
    }
    __syncthreads();
    const bf16* H = (const bf16*)(F.ws + WS_H); const bf16* W = (const bf16*)(F.ws + WS_WQKV);
    bf16* Q = (bf16*)(F.ws + WS_Q); bf16* Kb = (bf16*)(F.ws + WS_K); bf16* VT = (bf16*)(F.ws + WS_VT);
    const int wr = F.wave >> 2, wc = F.wave & 3, fr = F.lane & 15, fq = F.lane >> 4;
    constexpr int NTN = 12, NUNITS = (NTOK / 128) * NTN;
    for (int u = F.vcu; u < NUNITS; u += F.G) {
        const int mt = u / NTN, nt = u % NTN, m0 = mt * 128, n0 = nt * 256;
        const bool isctx = m0 >= NX;
        if (isctx && nt < 4) continue;
        ALDense al; al.init(H, D, m0, F.tid >> 3, (F.tid >> 3) + 64, dma_kc(F.tid));
        f32x4 acc[4][4];
        if (nt < 8) {
            gemm_tile<true>(F, al, W + (size_t)n0 * D, D, acc);
            const int hi2 = ((n0 & 1023) >> 6) + wc;
            const bool isq = nt < 4;
#pragma unroll
            for (int mi = 0; mi < 4; ++mi) {
                const int row = m0 + wr * 64 + mi * 16 + fr;
                int b, pos;
                if (!isctx) { b = row >> 12; pos = row & 4095; } else { b = (row - NX) >> 8; pos = S + ((row - NX) & 255); }
                f32x4 o[4];
                if (!isctx) {
                    const int rp = pos >> 6, cp = pos & 63;
#pragma unroll
                    for (int ni = 0; ni < 4; ++ni) {
                        const int p = (ni >> 1) ? cp : rp;
                        const f32x4 xv = acc[mi][ni], pv = acc[mi][ni ^ 1];
#pragma unroll
                        for (int c = 0; c < 4; ++c) {
                            const float cs = CS[(p * 16 + fq * 4 + c) * 2], sn = CS[(p * 16 + fq * 4 + c) * 2 + 1];
                            o[ni][c] = xv[c] * cs + ((ni & 1) ? pv[c] : -pv[c]) * sn;
                        }
                    }
                } else {
#pragma unroll
                    for (int ni = 0; ni < 4; ++ni) o[ni] = acc[mi][ni];
                }
                bf16* dst = isq ? Q + ((size_t)(b * 16 + hi2) * S + pos) * 64 : Kb + ((size_t)(b * 16 + hi2) * KEYS + pos) * 64;
                const float scl = isq ? QSCALE : 1.0f;
#pragma unroll
                for (int ni = 0; ni < 4; ++ni) {
                    u32x2 ov; ov.x = pk2(o[ni].x * scl, o[ni].y * scl); ov.y = pk2(o[ni].z * scl, o[ni].w * scl);
                    *(u32x2*)(dst + ni * 16 + fq * 4) = ov;
                }
            }
        } else {
            gemm_tile<false>(F, al, W + (size_t)n0 * D, D, acc);
#pragma unroll
            for (int mi = 0; mi < 4; ++mi) {
                const int row = m0 + wr * 64 + mi * 16 + fq * 4;
                int b, pos;
                if (!isctx) { b = row >> 12; pos = row & 4095; } else { b = (row - NX) >> 8; pos = S + ((row - NX) & 255); }
#pragma unroll
                for (int ni = 0; ni < 4; ++ni) {
                    const int col = (n0 - 2048) + wc * 64 + ni * 16 + fr, h = col >> 7, vd = col & 127;
                    const f32x4 v = acc[mi][ni];
                    u32x2 ov; ov.x = pk2(v.x, v.y); ov.y = pk2(v.z, v.w);
                    *(u32x2*)(VT + ((size_t)(b * 8 + h) * 128 + vd) * KEYS + pos) = ov;
                }
            }
        }
    }
}

constexpr int ATT_STAGE = 32768;
__device__ __forceinline__ int crow(int r, int hi) { return (r & 3) + 8 * (r >> 2) + 4 * hi; }
__device__ __forceinline__ void phase_attn(Frame& F) {
    const Args& A = *F.a;
    const int tid = F.tid, lane = F.lane, w = F.wave, r32 = lane & 31, hi = lane >> 5;
    const int mp = w >> 2, wq = w & 3;
    LAS char* lds = F.lds;
    float lam;
    { const float* dl = A.in[I_DALAM]; const float s1 = wave_sum(dl[lane] * dl[64 + lane]), s2 = wave_sum(dl[128 + lane] * dl[192 + lane]);
      lam = expf(s1) - expf(s2) + (0.8f - 0.6f * expf(-0.3f)); }
    const float oscale = 1.0f - (0.8f - 0.6f * expf(-0.3f));
    const bf16* Q = (const bf16*)(F.ws + WS_Q); const bf16* Kb = (const bf16*)(F.ws + WS_K); const bf16* VT = (const bf16*)(F.ws + WS_VT);
    bf16* AO = (bf16*)(F.ws + WS_AO);
    constexpr int NUNITS = NB * 8 * (S / 128), NTILES = KEYS / 64;
    for (int u = F.vcu; u < NUNITS; u += F.G) {
        const int bh = u >> 5, qb = u & 31, q0 = qb * 128;
        const bf16* Kg[2]; Kg[0] = Kb + (size_t)(bh * 2 + 0) * KEYS * 64; Kg[1] = Kb + (size_t)(bh * 2 + 1) * KEYS * 64;
        const bf16* Vg = VT + (size_t)bh * 128 * KEYS;
        bf16x8 qf[4];
        { const bf16* qp = Q + ((size_t)(bh * 2 + mp) * S + q0 + wq * 32 + r32) * 64;
#pragma unroll
          for (int ks = 0; ks < 4; ++ks) qf[ks] = *(const bf16x8*)(qp + ks * 16 + hi * 8); }
        f32x16 o[4];
#pragma unroll
        for (int vb = 0; vb < 4; ++vb)
#pragma unroll
            for (int r = 0; r < 16; ++r) o[vb][r] = 0.f;
        float mrun = 0.f, lrun = 0.f;
        const int drow = w * 8 + (lane >> 3), dch = ((lane & 7) ^ ((drow >> 1) & 7)) * 8;
        const bf16* gk0 = Kg[0] + (size_t)drow * 64 + dch; const bf16* gk1 = Kg[1] + (size_t)drow * 64 + dch;
        const bf16* gv0 = Vg + (size_t)drow * KEYS + dch; const bf16* gv1 = Vg + (size_t)(64 + drow) * KEYS + dch;
#define ATT_DMA(t_, st_) do { LAS char* sb_ = lds + (st_) * ATT_STAGE + w * 1024; \
            __builtin_amdgcn_global_load_lds((const unsigned*)(gk0 + (size_t)(t_) * 64 * 64), (LAS unsigned*)(sb_), 16, 0, 0); \
            __builtin_amdgcn_global_load_lds((const unsigned*)(gk1 + (size_t)(t_) * 64 * 64), (LAS unsigned*)(sb_ + 8192), 16, 0, 0); \
            __builtin_amdgcn_global_load_lds((const unsigned*)(gv0 + (t_) * 64), (LAS unsigned*)(sb_ + 16384), 16, 0, 0); \
            __builtin_amdgcn_global_load_lds((const unsigned*)(gv1 + (t_) * 64), (LAS unsigned*)(sb_ + 16384 + 8192), 16, 0, 0); } while (0)
        ATT_DMA(0, 0);
        __syncthreads();
        for (int t = 0; t < NTILES; ++t) {
            const int st = t & 1;
            if (t + 1 < NTILES) ATT_DMA(t + 1, st ^ 1);
            const LAS char* Kt = lds + st * ATT_STAGE + mp * 8192;
            const LAS char* Vt = lds + st * ATT_STAGE + 16384;
            f32x16 s0, s1;
            { const float nm = -mrun;
#pragma unroll
              for (int r = 0; r < 16; ++r) { s0[r] = nm; s1[r] = nm; } }
#pragma unroll
            for (int ks = 0; ks < 4; ++ks) {
                const bf16x8 k0 = *(const LAS bf16x8*)(Kt + swz128(r32, 2 * ks + hi));
                const bf16x8 k1 = *(const LAS bf16x8*)(Kt + swz128(32 + r32, 2 * ks + hi));
                s0 = __builtin_amdgcn_mfma_f32_32x32x16_bf16(k0, qf[ks], s0, 0, 0, 0);
                s1 = __builtin_amdgcn_mfma_f32_32x32x16_bf16(k1, qf[ks], s1, 0, 0, 0);
            }
            float mx = fmaxf(s0[0], s1[0]);
#pragma unroll
            for (int r = 1; r < 16; ++r) mx = fmaxf(mx, fmaxf(s0[r], s1[r]));
            { const auto rr = __builtin_amdgcn_permlane32_swap(__builtin_bit_cast(unsigned, mx), __builtin_bit_cast(unsigned, mx), false, false);
              mx = fmaxf(__builtin_bit_cast(float, rr[0]), __builtin_bit_cast(float, rr[1])); }
            if (t == 0 || __any(mx > 8.0f)) {
                const float dl = (t == 0) ? mx : fmaxf(mx, 0.f);
                mrun += dl;
#pragma unroll
                for (int r = 0; r < 16; ++r) { s0[r] -= dl; s1[r] -= dl; }
                if (t > 0) {
                    const float f = __builtin_amdgcn_exp2f(-dl);
                    lrun *= f;
#pragma unroll
                    for (int vb = 0; vb < 4; ++vb)
#pragma unroll
                        for (int r = 0; r < 16; ++r) o[vb][r] *= f;
                }
            }
            float psum = 0.f;
#pragma unroll
            for (int r = 0; r < 16; ++r) { s0[r] = __builtin_amdgcn_exp2f(s0[r]); s1[r] = __builtin_amdgcn_exp2f(s1[r]); psum += s0[r] + s1[r]; }
            lrun += psum;
            bf16x8 pf[4];
#pragma unroll
            for (int s = 0; s < 2; ++s) {
                u32x4 a, b2;
                a.x = pk2(s0[8 * s + 0], s0[8 * s + 1]); a.y = pk2(s0[8 * s + 2], s0[8 * s + 3]); a.z = pk2(s0[8 * s + 4], s0[8 * s + 5]); a.w = pk2(s0[8 * s + 6], s0[8 * s + 7]);
                b2.x = pk2(s1[8 * s + 0], s1[8 * s + 1]); b2.y = pk2(s1[8 * s + 2], s1[8 * s + 3]); b2.z = pk2(s1[8 * s + 4], s1[8 * s + 5]); b2.w = pk2(s1[8 * s + 6], s1[8 * s + 7]);
                pf[s] = __builtin_bit_cast(bf16x8, a); pf[2 + s] = __builtin_bit_cast(bf16x8, b2);
            }
#pragma unroll
            for (int vb = 0; vb < 4; ++vb) {
                const int vrow = vb * 32 + r32;
#pragma unroll
                for (int kk = 0; kk < 4; ++kk) {
                    const u32x2 lo = *(const LAS u32x2*)(Vt + swz128(vrow, 2 * kk) + 8 * hi);
                    const u32x2 hi2 = *(const LAS u32x2*)(Vt + swz128(vrow, 2 * kk + 1) + 8 * hi);
                    u32x4 av; av.x = lo.x; av.y = lo.y; av.z = hi2.x; av.w = hi2.y;
                    o[vb] = __builtin_amdgcn_mfma_f32_32x32x16_bf16(__builtin_bit_cast(bf16x8, av), pf[kk], o[vb], 0, 0, 0);
                }
            }
            __syncthreads();
        }
#undef ATT_DMA
        lrun += __shfl_xor(lrun, 32);
        const float linv = 1.0f / lrun;
        LAS float* XO = (LAS float*)lds;
        if (mp == 1) {
#pragma unroll
            for (int vb = 0; vb < 4; ++vb)
#pragma unroll
                for (int r = 0; r < 16; ++r) XO[(wq * 64 + vb * 16 + r) * 64 + lane] = o[vb][r] * linv;
        }
        __syncthreads();
        if (mp == 0) {
            float ssq = 0.f;
#pragma unroll
            for (int vb = 0; vb < 4; ++vb)
#pragma unroll
                for (int r = 0; r < 16; ++r) { const float v = o[vb][r] * linv - lam * XO[(wq * 64 + vb * 16 + r) * 64 + lane]; o[vb][r] = v; ssq += v * v; }
            ssq += __shfl_xor(ssq, 32);
            const float rstd = rsqrtf(ssq * (1.0f / 128.0f) + EPS) * oscale;
            const int b = bh >> 3, h = bh & 7;
            bf16* dst = AO + (size_t)(b * S + q0 + wq * 32 + r32) * D + h * 128;
            const float* sg = A.in[I_SUBLN];
#pragma unroll
            for (int vb = 0; vb < 4; ++vb)
#pragma unroll
                for (int rq = 0; rq < 4; ++rq) {
                    const int v0 = vb * 32 + 8 * rq + 4 * hi;
                    const f32x4 g4 = *(const f32x4*)(sg + v0);
                    u32x2 ov; ov.x = pk2(o[vb][4 * rq] * rstd * g4.x, o[vb][4 * rq + 1] * rstd * g4.y); ov.y = pk2(o[vb][4 * rq + 2] * rstd * g4.z, o[vb][4 * rq + 3] * rstd * g4.w);
                    *(u32x2*)(dst + v0) = ov;
                }
        }
        __syncthreads();
    }
}

__device__ __forceinline__ void phase_gemm_wo(Frame& F) {
    const bf16* AO = (const bf16*)(F.ws + WS_AO); const bf16* W = (const bf16*)(F.ws + WS_WO);
    float* XA = (float*)(F.ws + WS_XA);
    const int wr = F.wave >> 2, wc = F.wave & 3, fr = F.lane & 15, fq = F.lane >> 4;
    constexpr int NTN = 4, NUNITS = (NX / 128) * NTN;
    for (int u = F.vcu; u < NUNITS; u += F.G) {
        const int mt = u / NTN, nt = u % NTN, m0 = mt * 128, n0 = nt * 256;
        ALDense al; al.init(AO, D, m0, F.tid >> 3, (F.tid >> 3) + 64, dma_kc(F.tid));
        f32x4 acc[4][4];
        gemm_tile<true>(F, al, W + (size_t)n0 * D, D, acc);
#pragma unroll
        for (int mi = 0; mi < 4; ++mi) {
            const int row = m0 + wr * 64 + mi * 16 + fr;
            const float* gate = modp(F, 1, row >> 12, 2);
#pragma unroll
            for (int ni = 0; ni < 4; ++ni) {
                const int col = n0 + wc * 64 + ni * 16 + fq * 4;
                float* xp = XA + (size_t)row * D + col;
                const f32x4 s = *(const f32x4*)xp, gt = *(const f32x4*)(gate + col);
                *(f32x4*)xp = s + gt * acc[mi][ni];
            }
        }
    }
}

__device__ __forceinline__ void phase_final(Frame& F) {
    const Args& A = *F.a;
    const int gw = F.vcu * NWAVES + F.wave, NGW = F.G * NWAVES;
    for (int row = gw; row < NX; row += NGW) {
        f32x4 v[4];
        combine_row(F, row, modp(F, 1, row >> 12, 5), v);
        const float rstd = row_rstd(v);
#pragma unroll
        for (int j = 0; j < 4; ++j) {
            const int c0 = 4 * F.lane + 256 * j;
            const f32x4 g = *(const f32x4*)(A.in[I_FG] + c0);
            *(f32x4*)(A.out + (size_t)row * D + c0) = (v[j] * rstd) * g;
        }
    }
}

__global__ void __launch_bounds__(NTHREADS) fwd_kernel(Args args) {
    extern __shared__ __attribute__((aligned(16))) unsigned char smem[];
    Frame F;
    F.lds = (LAS char*)smem;
    F.tid = threadIdx.x; F.lane = F.tid & 63; F.wave = __builtin_amdgcn_readfirstlane(F.tid >> 6);
    F.G = gridDim.x; { const int bx = blockIdx.x; F.vcu = (F.G % 8 == 0) ? (bx % 8) * (F.G / 8) + bx / 8 : bx; }
    F.a = &args; F.ws = args.ws;
    volatile LAS unsigned* xbw = (volatile LAS unsigned*)(F.lds + LDS_XB);
    if (F.tid < 4) xbw[F.tid] = 0u;
    __syncthreads();
    XcdBarrier bar; bar.bar = (unsigned*)(F.ws + WS_CTL); bar.x = 0; bar.st = xbw;
    const int lo = args.ph_lo, hi = args.ph_hi;
    const bool multi = (hi - lo) > 1;
    if (multi) bar = xcd_barrier_post((unsigned*)(F.ws + WS_CTL), xbw);
#define RUN_PHASE(k, call) do { if (lo <= (k) && (k) < hi) { call; if ((k) + 1 < hi) xcd_barrier(bar); } } while (0)
    RUN_PHASE(0, phase_convert(F));
    RUN_PHASE(1, phase_prep0(F));
    RUN_PHASE(2, phase_gemm_in(F));
    RUN_PHASE(3, phase_scan(F));
    RUN_PHASE(4, phase_gemm_out0(F));
    RUN_PHASE(5, phase_route<0>(F));
    RUN_PHASE(6, phase_slots<0>(F));
    RUN_PHASE(7, phase_moe_up<0>(F));
    RUN_PHASE(8, phase_moe_down<0>(F));
    RUN_PHASE(9, phase_combine0(F));
    RUN_PHASE(10, phase_qkv(F));
    RUN_PHASE(11, phase_attn(F));
    RUN_PHASE(12, phase_gemm_wo(F));
    RUN_PHASE(13, phase_route<1>(F));
    RUN_PHASE(14, phase_slots<1>(F));
    RUN_PHASE(15, phase_moe_up<1>(F));
    RUN_PHASE(16, phase_moe_down<1>(F));
    RUN_PHASE(17, phase_final(F));
#undef RUN_PHASE
}

extern "C" void kernel_launch(void* const* d_in, const int* in_sizes, int n_in, void* d_out, int out_size, void* d_ws, size_t ws_size, hipStream_t stream) {
    static int grid = 0;
    if (grid == 0) {
        if (n_in != 27 || out_size != NX * D || ws_size < WS_END) { fprintf(stderr, "kernel_launch: unexpected shapes (n_in %d out %d ws %zu)\n", n_in, out_size, ws_size); grid = -1; return; }
        int dev = 0, cus = 0;
        if (hipGetDevice(&dev) != hipSuccess || hipDeviceGetAttribute(&cus, hipDeviceAttributeMultiprocessorCount, dev) != hipSuccess) { grid = -1; return; }
        if (hipFuncSetAttribute((const void*)fwd_kernel, hipFuncAttributeMaxDynamicSharedMemorySize, LDS_BYTES) != hipSuccess) { fprintf(stderr, "kernel_launch: hipFuncSetAttribute failed\n"); grid = -1; return; }
        (void)hipGetLastError();
        grid = cus < 256 ? cus : 256;
    }
    if (grid < 0) return;
    (void)hipMemsetAsync((char*)d_ws + WS_CTL, 0, CTL_ZERO_BYTES, stream);
    Args a{};
    for (int i = 0; i < 27; ++i) a.in[i] = (const float*)d_in[i];
    a.out = (float*)d_out; a.ws = (unsigned char*)d_ws;
    if (MK_N_LAUNCHES == 1) {
        a.ph_lo = 0; a.ph_hi = NPHASES;
        hipLaunchKernelGGL(fwd_kernel, dim3(grid), dim3(NTHREADS), LDS_BYTES, stream, a);
    } else {
        if (DBG_NPH == 0) { a.ph_lo = 0; a.ph_hi = 0; hipLaunchKernelGGL(fwd_kernel, dim3(grid), dim3(NTHREADS), LDS_BYTES, stream, a); }
        for (int p = 0; p < DBG_NPH; ++p) { a.ph_lo = p; a.ph_hi = p + 1; hipLaunchKernelGGL(fwd_kernel, dim3(grid), dim3(NTHREADS), LDS_BYTES, stream, a); }
    }
}
```

```cpp
#include <hip/hip_runtime.h>
#include <cstdio>
#include <cstdint>

#ifndef MK_N_LAUNCHES
#define MK_N_LAUNCHES 1
#endif

#ifndef DBG_NPH
#define DBG_NPH 18
#endif
#define LAS __attribute__((address_space(3)))
typedef unsigned short bf16;
typedef short bf16x8 __attribute__((ext_vector_type(8)));
typedef float f32x4 __attribute__((ext_vector_type(4)));
typedef float f32x16 __attribute__((ext_vector_type(16)));
typedef unsigned u32x4 __attribute__((ext_vector_type(4)));
typedef unsigned u32x2 __attribute__((ext_vector_type(2)));
typedef float f32x2 __attribute__((ext_vector_type(2)));

constexpr int D = 1024, NB = 4, S = 4096, CL = 256;
constexpr int NX = NB * S, NC = NB * CL, NTOK = NX + NC;
constexpr int NEXP = 32, DEXP = 512;
constexpr int NWAVES = 8, NTHREADS = 512;
constexpr int KEYS = S + CL;
constexpr float EPS = 1e-6f;
constexpr int PMAX = 43008;
constexpr int NPHASES = 18;

constexpr size_t MiB = 1u << 20;
constexpr size_t WS_CTL = 0, CTL_ZERO_BYTES = 64 * 1024;
constexpr size_t WS_MOD = 1 * MiB;
constexpr size_t WS_SEL = 2 * MiB;
constexpr size_t WS_WT = WS_SEL + 256 * 1024;
constexpr size_t WS_LRANK = WS_WT + 256 * 1024;
constexpr size_t WS_TOKSLOT = WS_LRANK + 256 * 1024;
constexpr size_t WS_BLKCNT = WS_TOKSLOT + 256 * 1024;
constexpr size_t WS_PSTART = WS_BLKCNT + 64 * 1024;
constexpr size_t WS_SLOTTOK = 3 * MiB + 512 * 1024;
constexpr size_t WS_SLOTW = WS_SLOTTOK + 256 * 1024;
constexpr size_t WS_WIN = 4 * MiB;
constexpr size_t WS_WOUT = 8 * MiB;
constexpr size_t WS_GATE = 10 * MiB;
constexpr size_t WS_WQKV = 11 * MiB;
constexpr size_t WS_WO = 17 * MiB;
constexpr size_t WS_WUP = 20 * MiB;
constexpr size_t WS_WDN = 148 * MiB;
constexpr size_t WS_XA = 212 * MiB;
constexpr size_t WS_H = 280 * MiB;
constexpr size_t WS_R = 314 * MiB;
constexpr size_t WS_YG = WS_R, WS_U = WS_R + 34 * MiB, WS_HF = WS_R + 68 * MiB, WS_HB = WS_R + 102 * MiB;
constexpr size_t WS_G = WS_R, WS_Y = WS_R + 42 * MiB;
constexpr size_t WS_Q = WS_R, WS_K = WS_R + 32 * MiB, WS_VT = WS_R + 66 * MiB, WS_AO = WS_R + 100 * MiB;
constexpr size_t WS_END = 450 * MiB;
static_assert(WS_Y + (size_t)PMAX * 1024 * 2 <= WS_END && WS_HB + 34 * MiB <= WS_END && WS_AO + 32 * MiB <= WS_END, "ws map");
static_assert(WS_K + (size_t)NB * 8 * 2 * KEYS * 64 * 2 <= WS_VT && WS_VT + (size_t)NB * 8 * 128 * KEYS * 2 <= WS_AO, "attn map");

constexpr int LDS_BYTES = 147456;
constexpr int LDS_XB = LDS_BYTES - 64;
constexpr int LDS_AUX = 131072;

__device__ __forceinline__ unsigned f2bf(float f) { unsigned u = __builtin_bit_cast(unsigned, f); return (u + 0x7fffu + ((u >> 16) & 1u)) >> 16; }
typedef __bf16 bf16x2_t __attribute__((ext_vector_type(2)));
__device__ __forceinline__ unsigned pk2(float lo, float hi) { const f32x2 v = {lo, hi}; const bf16x2_t b = __builtin_convertvector(v, bf16x2_t); return __builtin_bit_cast(unsigned, b); }
__device__ __forceinline__ float bflo(unsigned w) { return __builtin_bit_cast(float, w << 16); }
__device__ __forceinline__ float bfhi(unsigned w) { return __builtin_bit_cast(float, w & 0xffff0000u); }
__device__ __forceinline__ float wave_sum(float v) {
#pragma unroll
    for (int o = 1; o < 64; o <<= 1) v += __shfl_xor(v, o);
    return v;
}
__device__ __forceinline__ float sigmoidf_(float x) { return 1.0f / (1.0f + __expf(-x)); }
#define LDS_WAIT() asm volatile("s_waitcnt lgkmcnt(0)" ::: "memory")

#define XB_TMO      128
#define XB_XCNT(j)  (256  + 64 * (j))
#define XB_XSUB(j)  (1280 + 64 * (j))
#define XB_XGEN(j)  (2304 + 64 * (j))
#define XB_TOP      3328
#define XB_TOPGEN   3392
#define XCD_BAR_WORDS 3456
#define XB_SPIN_CAP (1u << 18)
__device__ __forceinline__ unsigned xb_ld(unsigned* p)              { return __hip_atomic_load(p, __ATOMIC_RELAXED, __HIP_MEMORY_SCOPE_AGENT); }
__device__ __forceinline__ unsigned xb_add(unsigned* p, unsigned v) { return __hip_atomic_fetch_add(p, v, __ATOMIC_RELAXED, __HIP_MEMORY_SCOPE_AGENT); }
__device__ __forceinline__ unsigned xb_xcc_id() { return (unsigned)__builtin_amdgcn_s_getreg((3 << 11) | 20) & 0xFu; }
#define XB_SPIN(cond, bar) do { unsigned _sp = 0; while (cond) { __builtin_amdgcn_s_sleep(1); \
    if ((++_sp & 255u) == 0u) { if (xb_ld(&(bar)[XB_TMO])) break; if (_sp > XB_SPIN_CAP) { atomicAdd(&(bar)[XB_TMO], 1u); break; } } } } while (0)
struct XcdBarrier { unsigned* bar; unsigned x; volatile LAS unsigned* st; };
__device__ __forceinline__ XcdBarrier xcd_barrier_post(unsigned* bar, volatile LAS unsigned* st) {
    XcdBarrier b; b.bar = bar; b.x = xb_xcc_id(); b.st = st;
    if (threadIdx.x == 0) (void)xb_add(&bar[XB_XCNT(b.x)], 1u);
    return b;
}
__device__ __forceinline__ void xcd_barrier_complete(unsigned* bar, unsigned x, unsigned& nloc, unsigned& nx) {
    const unsigned G = gridDim.x * gridDim.y * gridDim.z;
    unsigned sum, cnt, mine, sp = 0u;
    for (;;) {
        sum = 0u; cnt = 0u; mine = 0u;
#pragma unroll
        for (unsigned j = 0; j < 16; ++j) { const unsigned c = xb_ld(&bar[XB_XCNT(j)]); sum += c; cnt += (c > 0u) ? 1u : 0u; mine = (j == x) ? c : mine; }
        if (sum == G) break;
        __builtin_amdgcn_s_sleep(1);
        if ((++sp & 255u) == 0u) { if (xb_ld(&bar[XB_TMO])) break; if (sp > XB_SPIN_CAP) { atomicAdd(&bar[XB_TMO], 1u); break; } }
    }
    nloc = mine > 0u ? mine : 1u; nx = cnt > 0u ? cnt : 1u;
}
__device__ __forceinline__ void xcd_barrier(const XcdBarrier& b) {
    asm volatile("s_waitcnt vmcnt(0)" ::: "memory");
    __syncthreads();
    if (threadIdx.x == 0) {
        unsigned* bar = b.bar;
        __builtin_amdgcn_s_waitcnt(0);
        unsigned nloc = b.st[0], nx = b.st[1];
        if (nloc == 0u) { xcd_barrier_complete(bar, b.x, nloc, nx); b.st[0] = nloc; b.st[1] = nx; }
        const unsigned old = xb_add(&bar[XB_XSUB(b.x)], 1u);
        const unsigned gen = old / nloc;
        if (old + 1u == (gen + 1u) * nloc) {
            __builtin_amdgcn_fence(__ATOMIC_RELEASE, "agent");
            asm volatile("s_waitcnt vmcnt(0)" ::: "memory");
            const unsigned og = xb_add(&bar[XB_TOP], 1u);
            const unsigned tg = og / nx;
            if (og + 1u == (tg + 1u) * nx) xb_add(&bar[XB_TOPGEN], 1u);
            else XB_SPIN(xb_ld(&bar[XB_TOPGEN]) == tg, bar);
            __builtin_amdgcn_fence(__ATOMIC_ACQUIRE, "agent");
            xb_add(&bar[XB_XGEN(b.x)], 1u);
            asm volatile("s_waitcnt vmcnt(0)" ::: "memory");
        } else {
            XB_SPIN(xb_ld(&bar[XB_XGEN(b.x)]) == gen, bar);
            __builtin_amdgcn_fence(__ATOMIC_ACQUIRE, "agent");
            asm volatile("s_waitcnt vmcnt(0)" ::: "memory");
        }
    }
    __syncthreads();
}

struct Args { const float* in[27]; float* out; unsigned char* ws; int ph_lo, ph_hi; };
enum { I_X = 0, I_C, I_CTX, I_CCTX, I_WMOD, I_BMOD, I_N1G, I_N2G, I_WIN, I_CONVW, I_CONVB, I_GAW, I_GAB, I_GXW, I_GXB, I_LAM, I_WOUT,
       I_WQKV, I_DALAM, I_SUBLN, I_WO, I_RW, I_RB, I_MG, I_MU, I_MD, I_FG };

struct Frame {
    LAS char* lds;
    int tid, lane, wave, vcu, G;
    const Args* a;
    unsigned char* ws;
};

__device__ __forceinline__ const float* modp(const Frame& F, int l, int c, int k) { return (const float*)(F.ws + WS_MOD) + (size_t)(l * 5 + c) * 6144 + k * 1024; }
__device__ __forceinline__ int cond_of(int row) { return row < NX ? (row >> 12) : 4; }

__device__ __forceinline__ int moe_up_row(int n) { return ((n >> 7) << 8) + (((n >> 5) & 3) << 6) + (((n >> 4) & 1) << 5) + (n & 15); }

struct TDesc { const float* W; bf16* WT; int N, ldT, mode, k0, n0; };
__device__ __forceinline__ void tr_load(const TDesc& t, int lane, f32x4 (&rg)[8]) {
    const float* p = t.W + (size_t)(t.k0 + (lane >> 3)) * t.N + t.n0 + 4 * (lane & 7);
#pragma unroll
    for (int i = 0; i < 8; ++i) rg[i] = *(const f32x4*)(p + (size_t)(8 * i) * t.N);
}
__device__ __forceinline__ void tr_finish(const TDesc& t, int lane, const f32x4 (&rg)[8], LAS float* scr) {
#pragma unroll
    for (int i = 0; i < 8; ++i) { LAS float* d = scr + ((lane >> 3) + 8 * i) * 33 + 4 * (lane & 7); d[0] = rg[i].x; d[1] = rg[i].y; d[2] = rg[i].z; d[3] = rg[i].w; }
    LDS_WAIT();
    const int c = lane & 7;
#pragma unroll
    for (int j = 0; j < 4; ++j) {
        const int n = (lane >> 3) + 8 * j; const LAS float* s = scr + (8 * c) * 33 + n;
        u32x4 o; o.x = pk2(s[0 * 33], s[1 * 33]); o.y = pk2(s[2 * 33], s[3 * 33]); o.z = pk2(s[4 * 33], s[5 * 33]); o.w = pk2(s[6 * 33], s[7 * 33]);
        const int nn = t.n0 + n;
        const int drow = (t.mode == 0) ? nn : (moe_up_row(nn) + (t.mode == 2 ? 16 : 0));
        *(u32x4*)(t.WT + (size_t)drow * t.ldT + t.k0 + 8 * c) = o;
    }
    LDS_WAIT();
}

__device__ __forceinline__ void phase_convert(Frame& F) {
    const Args& A = *F.a;
    LAS float* scr = (LAS float*)(F.lds + F.wave * 8448);
    LAS float* sil = (LAS float*)(F.lds + 69632);
    for (int i = F.tid; i < 5 * 1024; i += NTHREADS) { const int c = i >> 10, k = i & 1023; const float v = (c < 4) ? A.in[I_C][c * 1024 + k] : A.in[I_CCTX][k]; sil[i] = v / (1.0f + __expf(-v)); }
    __syncthreads();
    const int gw = F.vcu * NWAVES + F.wave, NGW = F.G * NWAVES;
    constexpr int N_MOD = 192, N_WIN = 16 * 64, N_WOUT = 16 * 32, N_WQKV = 16 * 96, N_WO = 16 * 32, N_GATE = 32 * 8, N_MOE = 64 * 256;
    if (gw < N_MOD) {
        const int l = gw / 96, col = (gw % 96) * 64 + F.lane;
        const float* wp = A.in[I_WMOD] + (size_t)l * 1024 * 6144 + col;
        float acc[5] = {0.f, 0.f, 0.f, 0.f, 0.f};
#pragma unroll 4
        for (int k = 0; k < 1024; k += 4) {
            const float w0 = wp[(size_t)k * 6144], w1 = wp[(size_t)(k + 1) * 6144], w2 = wp[(size_t)(k + 2) * 6144], w3 = wp[(size_t)(k + 3) * 6144];
#pragma unroll
            for (int c = 0; c < 5; ++c) { const f32x4 s4 = *(const LAS f32x4*)(sil + c * 1024 + k); acc[c] += s4.x * w0 + s4.y * w1 + s4.z * w2 + s4.w * w3; }
        }
        const float bm = A.in[I_BMOD][l * 6144 + col];
        float* mo = (float*)(F.ws + WS_MOD);
#pragma unroll
        for (int c = 0; c < 5; ++c) mo[(size_t)(l * 5 + c) * 6144 + col] = acc[c] + bm;
    }
    auto decode = [&](int r) -> TDesc {
        TDesc t; t.mode = 0;
        int item;
        if (r < N_WIN) { t.W = A.in[I_WIN]; t.N = 2048; t.WT = (bf16*)(F.ws + WS_WIN); t.ldT = 1024; item = r; }
        else if ((r -= N_WIN) < N_WOUT) { t.W = A.in[I_WOUT]; t.N = 1024; t.WT = (bf16*)(F.ws + WS_WOUT); t.ldT = 1024; item = r; }
        else {
            r -= N_WOUT;
            const int m = r >> 3, d = m >> 4, g = (m >> 3) & 1, n = m & 7;
            t.W = (g == 0 ? A.in[I_GAW] : A.in[I_GXW]) + (size_t)(d * 8 + n) * 128 * 128; t.N = 128;
            t.WT = (bf16*)(F.ws + WS_GATE) + (size_t)m * 128 * 128; t.ldT = 128; item = r & 7;
        }
        const int nblk = t.N >> 5; t.k0 = 64 * (item / nblk); t.n0 = 32 * (item % nblk);
        return t;
    };
    constexpr int NTR0 = N_WIN + N_WOUT + N_GATE;
    for (int it = gw; it < NTR0; it += NGW) {
        const TDesc cur = decode(it); f32x4 rg[8]; tr_load(cur, F.lane, rg);
        tr_finish(cur, F.lane, rg, scr);
    }
}

constexpr int ND_WQKV = 32 * 96, ND_WO = 32 * 32, ND_MOE = 64 * 512, ND_TOTAL = ND_WQKV + ND_WO + 3 * ND_MOE;
__device__ __forceinline__ TDesc decode_deferred(const Frame& F, int r) {
    const Args& A = *F.a;
    TDesc t; t.mode = 0;
    int item;
    if (r < ND_WQKV) { t.W = A.in[I_WQKV]; t.N = 3072; t.WT = (bf16*)(F.ws + WS_WQKV); t.ldT = 1024; item = r; }
    else if ((r -= ND_WQKV) < ND_WO) { t.W = A.in[I_WO]; t.N = 1024; t.WT = (bf16*)(F.ws + WS_WO); t.ldT = 1024; item = r; }
    else if ((r -= ND_WO) < ND_MOE) { const int le = r >> 9; t.W = A.in[I_MG] + (size_t)le * 1024 * 512; t.N = 512; t.WT = (bf16*)(F.ws + WS_WUP) + (size_t)le * 1024 * 1024; t.ldT = 1024; t.mode = 1; item = r & 511; }
    else if ((r -= ND_MOE) < ND_MOE) { const int le = r >> 9; t.W = A.in[I_MU] + (size_t)le * 1024 * 512; t.N = 512; t.WT = (bf16*)(F.ws + WS_WUP) + (size_t)le * 1024 * 1024; t.ldT = 1024; t.mode = 2; item = r & 511; }
    else { r -= ND_MOE; const int le = r >> 9; t.W = A.in[I_MD] + (size_t)le * 512 * 1024; t.N = 1024; t.WT = (bf16*)(F.ws + WS_WDN) + (size_t)le * 1024 * 512; t.ldT = 512; item = r & 511; }
    const int nblk = t.N >> 5; t.k0 = 32 * (item / nblk); t.n0 = 32 * (item % nblk);
    return t;
}
__device__ __forceinline__ void tr2_load(const TDesc& t, int lane, f32x4 (&rg)[4]) {
    const float* p = t.W + (size_t)(t.k0 + (lane >> 3)) * t.N + t.n0 + 4 * (lane & 7);
#pragma unroll
    for (int i = 0; i < 4; ++i) rg[i] = *(const f32x4*)(p + (size_t)(8 * i) * t.N);
}
__device__ __forceinline__ void tr2_finish(const TDesc& t, int lane, const f32x4 (&rg)[4], LAS float* scr  ) {
#pragma unroll
    for (int i = 0; i < 4; ++i) { LAS float* d = scr + ((lane >> 3) + 8 * i) * 33 + 4 * (lane & 7); d[0] = rg[i].x; d[1] = rg[i].y; d[2] = rg[i].z; d[3] = rg[i].w; }
    LDS_WAIT();
    const int c = lane & 3;
#pragma unroll
    for (int j = 0; j < 2; ++j) {
        const int n = (lane >> 2) + 16 * j; const LAS float* s = scr + (8 * c) * 33 + n;
        u32x4 o; o.x = pk2(s[0 * 33], s[1 * 33]); o.y = pk2(s[2 * 33], s[3 * 33]); o.z = pk2(s[4 * 33], s[5 * 33]); o.w = pk2(s[6 * 33], s[7 * 33]);
        const int nn = t.n0 + n;
        const int drow = (t.mode == 0) ? nn : (moe_up_row(nn) + (t.mode == 2 ? 16 : 0));
        *(u32x4*)(t.WT + (size_t)drow * t.ldT + t.k0 + 8 * c) = o;
    }
    LDS_WAIT();
}

__device__ __forceinline__ float row_rstd(const f32x4 (&v)[4]) {
    float s = 0.f;
#pragma unroll
    for (int j = 0; j < 4; ++j) s += (v[j].x * v[j].x + v[j].y * v[j].y) + (v[j].z * v[j].z + v[j].w * v[j].w);
    return rsqrtf(wave_sum(s) * (1.0f / D) + EPS);
}
__device__ __forceinline__ void row_modulate_store(f32x4 (&v)[4], float rstd, const float* g, const float* sc, const float* sh, bf16* dst, int lane) {
#pragma unroll
    for (int j = 0; j < 4; ++j) {
        const int c0 = 4 * lane + 256 * j;
        const f32x4 gg = *(const f32x4*)(g + c0), s1 = *(const f32x4*)(sc + c0), s0 = *(const f32x4*)(sh + c0);
        v[j] = (v[j] * rstd) * gg * (1.0f + s1) + s0;
        u32x2 o; o.x = pk2(v[j].x, v[j].y); o.y = pk2(v[j].z, v[j].w);
        *(u32x2*)(dst + c0) = o;
    }
}

__device__ __forceinline__ void load_row4(const float* src, int lane, f32x4 (&v)[4]) {
#pragma unroll
    for (int j = 0; j < 4; ++j) v[j] = *(const f32x4*)(src + 4 * lane + 256 * j);
}
__device__ __forceinline__ void phase_prep0(Frame& F) {
    const Args& A = *F.a;
    const int gw = F.vcu * NWAVES + F.wave, NGW = F.G * NWAVES;
    bf16* H = (bf16*)(F.ws + WS_H);
    f32x4 vn[4];
    if (gw < NTOK) load_row4(gw < NX ? A.in[I_X] + (size_t)gw * D : A.in[I_CTX] + (size_t)(gw - NX) * D, F.lane, vn);
    for (int row = gw; row < NTOK; row += NGW) {
        const int c = cond_of(row);
        f32x4 v[4];
#pragma unroll
        for (int j = 0; j < 4; ++j) v[j] = vn[j];
        const int nr = row + NGW;
        if (nr < NTOK) load_row4(nr < NX ? A.in[I_X] + (size_t)nr * D : A.in[I_CTX] + (size_t)(nr - NX) * D, F.lane, vn);
        const float rstd = row_rstd(v);
        row_modulate_store(v, rstd, A.in[I_N1G], modp(F, 0, c, 1), modp(F, 0, c, 0), H + (size_t)row * D, F.lane);
    }
}

constexpr int GEMM_STAGE = 49152;
__device__ __forceinline__ int swz128(int row, int chunk) { return row * 128 + ((chunk ^ ((row >> 1) & 7)) << 4); }
__device__ __forceinline__ int dma_kc(int tid) { return ((tid & 7) ^ ((tid >> 4) & 7)) * 8; }

struct ALDense {
    static constexpr bool DMA = true;
    const bf16* p0; const bf16* p1;
    __device__ __forceinline__ const bf16* ptr(int i) const { return i ? p1 : p0; }
    __device__ __forceinline__ void init(const bf16* A, int lda, int m0, int r0, int r1, int kc) { p0 = A + (size_t)(m0 + r0) * lda + kc; p1 = A + (size_t)(m0 + r1) * lda + kc; }
    __device__ __forceinline__ u32x4 load(int i, int k0) const { return *(const u32x4*)((i ? p1 : p0) + k0); }
};
struct ALGather {
    static constexpr bool DMA = true;
    const bf16* p0; const bf16* p1;
    __device__ __forceinline__ const bf16* ptr(int i) const { return i ? p1 : p0; }
    __device__ __forceinline__ void init(const bf16* A, int lda, const int* idx, int m0, int r0, int r1, int kc) { p0 = A + (size_t)idx[m0 + r0] * lda + kc; p1 = A + (size_t)idx[m0 + r1] * lda + kc; }
    __device__ __forceinline__ u32x4 load(int i, int k0) const { return *(const u32x4*)((i ? p1 : p0) + k0); }
};
struct ALCombine {
    static constexpr bool DMA = false;
    size_t o0, o1; const bf16 *hf, *hb, *yg;
    __device__ __forceinline__ const bf16* ptr(int) const { return nullptr; }
    __device__ __forceinline__ void init(const bf16* hf_, const bf16* hb_, const bf16* yg_, int m0, int r0, int r1, int kc) { hf = hf_; hb = hb_; yg = yg_; o0 = (size_t)(m0 + r0) * D + kc; o1 = (size_t)(m0 + r1) * D + kc; }
    __device__ __forceinline__ u32x4 load(int i, int k0) const {
        const size_t o = (i ? o1 : o0) + k0;
        const u32x4 a = *(const u32x4*)(hf + o), b = *(const u32x4*)(hb + o), y = *(const u32x4*)(yg + o);
        u32x4 r;
#pragma unroll
        for (int q = 0; q < 4; ++q) r[q] = pk2((bflo(a[q]) + bflo(b[q])) * bflo(y[q]), (bfhi(a[q]) + bfhi(b[q])) * bfhi(y[q]));
        return r;
    }
};

template <bool SWAP, class AL>
__device__ __forceinline__ void gemm_tile(const Frame& F, const AL& al, const bf16* __restrict__ Bt  , int K, f32x4 (&acc)[4][4]) {
    const int tid = F.tid, lane = F.lane, wid = F.wave, wr = wid >> 2, wc = wid & 3, fr = lane & 15, fq = lane >> 4;
    const int sr = tid >> 3;
    const int sc = AL::DMA ? ((tid & 7) ^ ((sr >> 1) & 7)) : (tid & 7);
    LAS char* lds = F.lds;
    const bf16* bp = Bt + (size_t)sr * K + sc * 8;
    const size_t bstep = (size_t)64 * K;
    int wa[2], wb[4];
#pragma unroll
    for (int i = 0; i < 2; ++i) wa[i] = swz128(sr + 64 * i, sc);
#pragma unroll
    for (int i = 0; i < 4; ++i) wb[i] = 16384 + swz128(sr + 64 * i, sc);
    const int key = (fr >> 1) & 7;
    const int ra = (wr * 64 + fr) * 128, rb = 16384 + (wc * 64 + fr) * 128;
#pragma unroll
    for (int mi = 0; mi < 4; ++mi)
#pragma unroll
        for (int ni = 0; ni < 4; ++ni) acc[mi][ni] = (f32x4){0.f, 0.f, 0.f, 0.f};
    u32x4 ga[2], gb[4];
    const int wl = wid * 1024;
#define GT_DMA(stage_, k_) do { \
        __builtin_amdgcn_global_load_lds((const unsigned*)(al.ptr(0) + (k_)), (LAS unsigned*)(lds + (stage_) + wl), 16, 0, 0); \
        __builtin_amdgcn_global_load_lds((const unsigned*)(al.ptr(1) + (k_)), (LAS unsigned*)(lds + (stage_) + 8192 + wl), 16, 0, 0); \
        _Pragma("unroll") for (int i_ = 0; i_ < 4; ++i_) \
            __builtin_amdgcn_global_load_lds((const unsigned*)(bp + i_ * bstep + (k_)), (LAS unsigned*)(lds + (stage_) + 16384 + i_ * 8192 + wl), 16, 0, 0); } while (0)
    if constexpr (AL::DMA) { GT_DMA(0, 0); }
    else {
        ga[0] = al.load(0, 0); ga[1] = al.load(1, 0);
#pragma unroll
        for (int i = 0; i < 4; ++i) gb[i] = *(const u32x4*)(bp + i * bstep);
#pragma unroll
        for (int i = 0; i < 2; ++i) *(LAS u32x4*)(lds + wa[i]) = ga[i];
#pragma unroll
        for (int i = 0; i < 4; ++i) *(LAS u32x4*)(lds + wb[i]) = gb[i];
    }
    __syncthreads();
    const int nk = K / 64;
    for (int kt = 0; kt < nk; ++kt) {
        const int cur = (kt & 1) * GEMM_STAGE, nxt = GEMM_STAGE - cur;
        if (kt + 1 < nk) {
            const int k1 = (kt + 1) * 64;
            if constexpr (AL::DMA) { GT_DMA(nxt, k1); }
            else {
                ga[0] = al.load(0, k1); ga[1] = al.load(1, k1);
#pragma unroll
                for (int i = 0; i < 4; ++i) gb[i] = *(const u32x4*)(bp + i * bstep + k1);
            }
        }
#pragma unroll
        for (int ks = 0; ks < 2; ++ks) {
            const int co = ((ks * 4 + fq) ^ key) << 4;
            bf16x8 af[4], bfr[4];
#pragma unroll
            for (int mi = 0; mi < 4; ++mi) af[mi] = *(const LAS bf16x8*)(lds + cur + ra + mi * 2048 + co);
#pragma unroll
            for (int ni = 0; ni < 4; ++ni) bfr[ni] = *(const LAS bf16x8*)(lds + cur + rb + ni * 2048 + co);
#pragma unroll
            for (int mi = 0; mi < 4; ++mi)
#pragma unroll
                for (int ni = 0; ni < 4; ++ni)
                    acc[mi][ni] = SWAP ? __builtin_amdgcn_mfma_f32_16x16x32_bf16(bfr[ni], af[mi], acc[mi][ni], 0, 0, 0)
                                       : __builtin_amdgcn_mfma_f32_16x16x32_bf16(af[mi], bfr[ni], acc[mi][ni], 0, 0, 0);
        }
        if constexpr (!AL::DMA) {
            if (kt + 1 < nk) {
#pragma unroll
                for (int i = 0; i < 2; ++i) *(LAS u32x4*)(lds + nxt + wa[i]) = ga[i];
#pragma unroll
                for (int i = 0; i < 4; ++i) *(LAS u32x4*)(lds + nxt + wb[i]) = gb[i];
            }
        }
        __syncthreads();
    }
#undef GT_DMA
}

__device__ __forceinline__ float gelu_tanh(float x) {
    const float z = 0.7978845608028654f * (x + 0.044715f * x * x * x);
    const float t = 1.0f - 2.0f / (1.0f + __expf(2.0f * z));
    return 0.5f * x * (1.0f + t);
}

__device__ __forceinline__ void phase_gemm_in(Frame& F) {
    const bf16* H = (const bf16*)(F.ws + WS_H); const bf16* W = (const bf16*)(F.ws + WS_WIN);
    bf16* YG = (bf16*)(F.ws + WS_YG); bf16* U = (bf16*)(F.ws + WS_U);
    const int wr = F.wave >> 2, wc = F.wave & 3, fr = F.lane & 15, fq = F.lane >> 4;
    constexpr int NTN = 8, NUNITS = (NTOK / 128) * NTN;
    for (int u = F.vcu; u < NUNITS; u += F.G) {
        const int mt = u / NTN, nt = u % NTN, m0 = mt * 128, n0 = nt * 256;
        ALDense al; al.init(H, D, m0, F.tid >> 3, (F.tid >> 3) + 64, dma_kc(F.tid));
        f32x4 acc[4][4];
        gemm_tile<true>(F, al, W + (size_t)n0 * D, D, acc);
        const bool isy = n0 < 1024;
        bf16* dst = isy ? YG : U; const int nb = isy ? n0 : n0 - 1024;
#pragma unroll
        for (int mi = 0; mi < 4; ++mi) {
            const int row = m0 + wr * 64 + mi * 16 + fr;
#pragma unroll
            for (int ni = 0; ni < 4; ++ni) {
                f32x4 v = acc[mi][ni];
                if (isy) { v.x = gelu_tanh(v.x); v.y = gelu_tanh(v.y); v.z = gelu_tanh(v.z); v.w = gelu_tanh(v.w); }
                u32x2 o; o.x = pk2(v.x, v.y); o.y = pk2(v.z, v.w);
                *(u32x2*)(dst + (size_t)row * D + nb + wc * 64 + ni * 16 + fq * 4) = o;
            }
        }
    }
}

__device__ __forceinline__ float neg_expm1(float x) {
    const float p = 1.0f + x * (0.5f + x * (0.16666667f + x * (0.041666668f + x * (0.0083333338f + x * 0.0013888889f))));
    const float ser = -x * p, big = 1.0f - __expf(x);
    return x > -0.5f ? ser : big;
}
__device__ __forceinline__ void phase_scan(Frame& F) {
    const Args& A = *F.a;
    const int wi = F.vcu;
    if (wi >= 256) return;
    const int b = wi >> 6, n = (wi >> 3) & 7, d = (wi >> 2) & 1, q = wi & 3;
    const int tid = F.tid, lane = F.lane, w = F.wave, fr = lane & 15, fq = lane >> 4;
    LAS char* RAW = F.lds;
    LAS char* AT = F.lds + 33792;
    LAS float* AGG = (LAS float*)(F.lds + 66560);
    LAS float* CIN = (LAS float*)(F.lds + 74752);
    const bf16* U = (const bf16*)(F.ws + WS_U);
    bf16* HO = (bf16*)(F.ws + (d ? WS_HB : WS_HF));
    const int chbase = n * 128, och = chbase + q * 32;
    const bf16* GT = (const bf16*)(F.ws + WS_GATE);
    LAS char* BT = F.lds + 81920;
#pragma unroll
    for (int i = 0; i < 2; ++i) {
        const int idx = tid + 512 * i, jrow = idx >> 4, c = idx & 15, nb = jrow >> 4, f2 = jrow & 15;
        *(LAS u32x4*)(BT + jrow * 256 + ((c ^ f2) << 4)) = *(const u32x4*)(GT + ((size_t)(((d * 2 + (nb >> 1)) * 8 + n) * 128 + q * 32 + (nb & 1) * 16 + f2)) * 128 + c * 8);
    }
    float ba[2], bi[2], sp8[2];
#pragma unroll
    for (int h = 0; h < 2; ++h) {
        const int ch = och + h * 16 + fr;
        ba[h] = A.in[I_GAB][d * 1024 + ch]; bi[h] = A.in[I_GXB][d * 1024 + ch];
        sp8[h] = 8.0f * log1pf(expf(-A.in[I_LAM][d * 1024 + ch]));
    }
    const int c8 = tid & 15, r0 = tid >> 4;
    LAS float* CW = (LAS float*)(F.lds + 78848);
    (void)CW;
    float cw[4][8], cb[8];
#pragma unroll
    for (int k = 0; k < 4; ++k) {
        const f32x4 a0 = *(const f32x4*)(A.in[I_CONVW] + k * 1024 + chbase + c8 * 8), a1 = *(const f32x4*)(A.in[I_CONVW] + k * 1024 + chbase + c8 * 8 + 4);
        cw[k][0] = a0.x; cw[k][1] = a0.y; cw[k][2] = a0.z; cw[k][3] = a0.w; cw[k][4] = a1.x; cw[k][5] = a1.y; cw[k][6] = a1.z; cw[k][7] = a1.w;
    }
    { const f32x4 a0 = *(const f32x4*)(A.in[I_CONVB] + chbase + c8 * 8), a1 = *(const f32x4*)(A.in[I_CONVB] + chbase + c8 * 8 + 4);
      cb[0] = a0.x; cb[1] = a0.y; cb[2] = a0.z; cb[3] = a0.w; cb[4] = a1.x; cb[5] = a1.y; cb[6] = a1.z; cb[7] = a1.w; }

    float hcar = 0.f;
    u32x4 pre[5];
    LAS float* cscr = (LAS float*)(F.lds + 98304 + w * 4224);
    const int cgw = F.vcu * NWAVES + w, CNGW = F.G * NWAVES;
    int cit = cgw;
    TDesc cd2; f32x4 crg2[4]; bool chas2 = false;
    for (int step = 0; step < 34; ++step) {
        TDesc cd; f32x4 crg[4]; const bool chas = cit < ND_TOTAL;
        if (chas) { cd = decode_deferred(F, cit); tr2_load(cd, lane, crg); cit += CNGW; }
        int segbase, seglen, tile;
        if (step < 2) { segbase = NX + b * CL; seglen = CL; tile = d ? (1 - step) : step; }
        else { segbase = b * S; seglen = S; tile = d ? (33 - step) : (step - 2); }
        const int t0 = tile * 128;
        if (step == 0) {
#pragma unroll
            for (int i = 0; i < 5; ++i) {
                const int idx = tid + 512 * i; const int row = idx >> 4, c = idx & 15; const int t = t0 - 2 + row;
                u32x4 v = (u32x4){0u, 0u, 0u, 0u};
                if (idx < 2112 && t >= 0 && t < seglen) v = *(const u32x4*)(U + (size_t)(segbase + t) * D + chbase + c * 8);
                pre[i] = v;
            }
        }
#pragma unroll
        for (int i = 0; i < 5; ++i) { const int idx = tid + 512 * i; if (idx < 2112) *(LAS u32x4*)(RAW + idx * 16) = pre[i]; }
        __syncthreads();
        if (step + 1 < 34) {
            const int s1 = step + 1; int sb1, sl1, tl1;
            if (s1 < 2) { sb1 = NX + b * CL; sl1 = CL; tl1 = d ? (1 - s1) : s1; }
            else { sb1 = b * S; sl1 = S; tl1 = d ? (33 - s1) : (s1 - 2); }
            const int t1 = tl1 * 128;
#pragma unroll
            for (int i = 0; i < 5; ++i) {
                const int idx = tid + 512 * i; const int row = idx >> 4, c = idx & 15; const int t = t1 - 2 + row;
                u32x4 v = (u32x4){0u, 0u, 0u, 0u};
                if (idx < 2112 && t >= 0 && t < sl1) v = *(const u32x4*)(U + (size_t)(sb1 + t) * D + chbase + c * 8);
                pre[i] = v;
            }
        }
#pragma unroll
        for (int i = 0; i < 4; ++i) {
            const int r = r0 + 32 * i;
            float o[8];
#pragma unroll
            for (int j = 0; j < 8; ++j) o[j] = cb[j];
#pragma unroll
            for (int k = 0; k < 4; ++k) {
                const u32x4 x = *(const LAS u32x4*)(RAW + (r + k) * 256 + c8 * 16);
#pragma unroll
                for (int p = 0; p < 4; ++p) { o[2 * p] += cw[k][2 * p] * bflo(x[p]); o[2 * p + 1] += cw[k][2 * p + 1] * bfhi(x[p]); }
            }
            u32x4 ov; ov.x = pk2(o[0], o[1]); ov.y = pk2(o[2], o[3]); ov.z = pk2(o[4], o[5]); ov.w = pk2(o[6], o[7]);
            *(LAS u32x4*)(AT + r * 256 + ((c8 ^ (r & 15)) << 4)) = ov;
        }
        __syncthreads();
        f32x4 acc[4];
#pragma unroll
        for (int nb = 0; nb < 4; ++nb) acc[nb] = (f32x4){0.f, 0.f, 0.f, 0.f};
#pragma unroll
        for (int ks = 0; ks < 4; ++ks) {
            const int row = 16 * w + fr;
            const bf16x8 af = *(const LAS bf16x8*)(AT + row * 256 + (((4 * ks + fq) ^ fr) << 4));
#pragma unroll
            for (int nb = 0; nb < 4; ++nb) {
                const bf16x8 bq = *(const LAS bf16x8*)(BT + (nb * 16 + fr) * 256 + (((4 * ks + fq) ^ fr) << 4));
                acc[nb] = __builtin_amdgcn_mfma_f32_16x16x32_bf16(af, bq, acc[nb], 0, 0, 0);
            }
        }
        float av[2][4], bv[2][4];
#pragma unroll
        for (int h = 0; h < 2; ++h) {
            const int col = q * 32 + h * 16 + fr, chunk = col >> 3, within = col & 7;
#pragma unroll
            for (int reg = 0; reg < 4; ++reg) {
                const int tr = 16 * w + 4 * fq + reg;
                const float r_ = __builtin_amdgcn_rcpf(1.0f + __builtin_amdgcn_exp2f(-1.4426950408889634f * (acc[h][reg] + ba[h])));
                const float i_ = __builtin_amdgcn_rcpf(1.0f + __builtin_amdgcn_exp2f(-1.4426950408889634f * (acc[2 + h][reg] + bi[h])));
                const float la = -sp8[h] * r_;
                const float a_ = __builtin_amdgcn_exp2f(1.4426950408889634f * la);
                const unsigned short ub = *(const LAS unsigned short*)(AT + tr * 256 + ((chunk ^ (tr & 15)) << 4) + within * 2);
                const float uval = __builtin_bit_cast(float, (unsigned)ub << 16);
                av[h][reg] = a_;
                bv[h][reg] = __builtin_amdgcn_sqrtf(neg_expm1(2.0f * la)) * (i_ * uval);
            }
        }
        const int g = 4 * w + fq;
#pragma unroll
        for (int h = 0; h < 2; ++h) {
            float P = 1.f, Hh = 0.f;
#pragma unroll
            for (int s = 0; s < 4; ++s) { const int reg = d ? (3 - s) : s; Hh = av[h][reg] * Hh + bv[h][reg]; P *= av[h][reg]; }
            AGG[(g * 32 + h * 16 + fr) * 2 + 0] = P; AGG[(g * 32 + h * 16 + fr) * 2 + 1] = Hh;
        }
        if (chas2) tr2_finish(cd2, lane, crg2, cscr);
        chas2 = cit < ND_TOTAL;
        if (chas2) { cd2 = decode_deferred(F, cit); tr2_load(cd2, lane, crg2); cit += CNGW; }
        __syncthreads();
        if (tid < 32) {
            f32x2 ag[32];
#pragma unroll
            for (int gi = 0; gi < 32; ++gi) ag[gi] = *(const LAS f32x2*)(AGG + (gi * 32 + tid) * 2);
            float hh = hcar;
            if (d == 0) {
#pragma unroll
                for (int gi = 0; gi < 32; ++gi) { CIN[gi * 32 + tid] = hh; hh = ag[gi].x * hh + ag[gi].y; }
            } else {
#pragma unroll
                for (int gi = 31; gi >= 0; --gi) { CIN[gi * 32 + tid] = hh; hh = ag[gi].x * hh + ag[gi].y; }
            }
            hcar = hh;
        }
        __syncthreads();
#pragma unroll
        for (int h = 0; h < 2; ++h) {
            float hh = CIN[g * 32 + h * 16 + fr];
            float outv[4];
#pragma unroll
            for (int s = 0; s < 4; ++s) { const int reg = d ? (3 - s) : s; hh = av[h][reg] * hh + bv[h][reg]; outv[reg] = hh; }
#pragma unroll
            for (int reg = 0; reg < 4; ++reg) {
                const int tr = 16 * w + 4 * fq + reg;
                HO[(size_t)(segbase + t0 + tr) * D + och + h * 16 + fr] = (bf16)f2bf(outv[reg]);
            }
        }
        if (chas) tr2_finish(cd, lane, crg, cscr);
    }
    if (chas2) tr2_finish(cd2, lane, crg2, cscr);
}

__device__ __forceinline__ void phase_gemm_out0(Frame& F) {
    const Args& A = *F.a;
    const bf16* W = (const bf16*)(F.ws + WS_WOUT);
    float* XA = (float*)(F.ws + WS_XA);
    const int wr = F.wave >> 2, wc = F.wave & 3, fr = F.lane & 15, fq = F.lane >> 4;
    constexpr int NTN = 4, NUNITS = (NTOK / 128) * NTN;
    for (int u = F.vcu; u < NUNITS; u += F.G) {
        const int mt = u / NTN, nt = u % NTN, m0 = mt * 128, n0 = nt * 256;
        ALCombine al; al.init((const bf16*)(F.ws + WS_HF), (const bf16*)(F.ws + WS_HB), (const bf16*)(F.ws + WS_YG), m0, F.tid >> 3, (F.tid >> 3) + 64, (F.tid & 7) * 8);
        f32x4 acc[4][4];
        gemm_tile<true>(F, al, W + (size_t)n0 * D, D, acc);
#pragma unroll
        for (int mi = 0; mi < 4; ++mi) {
            const int row = m0 + wr * 64 + mi * 16 + fr;
            const float* src = row < NX ? A.in[I_X] + (size_t)row * D : A.in[I_CTX] + (size_t)(row - NX) * D;
            const float* gate = modp(F, 0, cond_of(row), 2);
#pragma unroll
            for (int ni = 0; ni < 4; ++ni) {
                const int col = n0 + wc * 64 + ni * 16 + fq * 4;
                const f32x4 s = *(const f32x4*)(src + col), gt = *(const f32x4*)(gate + col);
                *(f32x4*)(XA + (size_t)row * D + col) = s + gt * acc[mi][ni];
            }
        }
    }
}

template <int LAYER>
__device__ __forceinline__ void phase_route(Frame& F) {
    const Args& A = *F.a;
    constexpr int NT = LAYER == 0 ? NTOK : NX;
    constexpr int PER = NT / 256;
    LAS char* RW = F.lds;
    LAS int* selL = (LAS int*)(F.lds + LDS_AUX);
    LAS int* rankL = selL + 2 * 68;
    LAS int* cntL = rankL + 2 * 68;
    const int tid = F.tid, lane = F.lane;
    for (int i = 0; i < 16; ++i) {
        const int idx = tid + 512 * i, k = idx >> 3, e4 = idx & 7;
        const int rho = (((k >> 8) * 4 + (k & 3)) << 6) + ((k >> 2) & 63);
        *(LAS f32x4*)(RW + rho * 128 + ((e4 ^ ((rho >> 1) & 7)) << 4)) = *(const f32x4*)(A.in[I_RW] + (size_t)k * 32 + e4 * 4);
    }
    __syncthreads();
    const int blk = F.vcu;
    if (blk < 256) {
        const float* XA = (const float*)(F.ws + WS_XA);
        bf16* H = (bf16*)(F.ws + WS_H);
        const float rbias = A.in[I_RB][lane & 31];
        f32x4 vn[4];
        load_row4(XA + (size_t)(blk * PER + F.wave) * D, lane, vn);
        for (int li = F.wave; li < PER; li += NWAVES) {
            const int row = blk * PER + li;
            const int c = cond_of(row);
            f32x4 v[4];
#pragma unroll
            for (int j = 0; j < 4; ++j) v[j] = vn[j];
            if (li + NWAVES < PER) load_row4(XA + (size_t)(row + NWAVES) * D, lane, vn);
            const float rstd = row_rstd(v);
            row_modulate_store(v, rstd, A.in[I_N2G] + LAYER * D, modp(F, LAYER, c, 4), modp(F, LAYER, c, 3), H + (size_t)row * D, lane);
            float acc[32];
#pragma unroll
            for (int e = 0; e < 32; ++e) acc[e] = 0.f;
#pragma unroll 1
            for (int jc = 0; jc < 16; ++jc) {
                const int j = jc >> 2, c = jc & 3;
                f32x4 hv4 = v[0];
                if (j == 1) hv4 = v[1];
                if (j == 2) hv4 = v[2];
                if (j == 3) hv4 = v[3];
                float hv = hv4.x;
                if (c == 1) hv = hv4.y;
                if (c == 2) hv = hv4.z;
                if (c == 3) hv = hv4.w;
                const int rho = jc * 64 + lane;
                const LAS char* rp = RW + rho * 128; const int key = (rho >> 1) & 7;
                f32x4 w8[8];
#pragma unroll
                for (int e4 = 0; e4 < 8; ++e4) w8[e4] = *(const LAS f32x4*)(rp + ((e4 ^ key) << 4));
#pragma unroll
                for (int e4 = 0; e4 < 8; ++e4) {
                    acc[e4 * 4 + 0] += hv * w8[e4].x; acc[e4 * 4 + 1] += hv * w8[e4].y; acc[e4 * 4 + 2] += hv * w8[e4].z; acc[e4 * 4 + 3] += hv * w8[e4].w;
                }
            }
#define BFLY(S, HALF) { const bool up = (lane >> (S)) & 1; _Pragma("unroll") for (int i = 0; i < (HALF); ++i) { \
                const float keep = up ? acc[i + (HALF)] : acc[i]; const float send = up ? acc[i] : acc[i + (HALF)]; acc[i] = keep + __shfl_xor(send, 1 << (S)); } }
            BFLY(0, 16) BFLY(1, 8) BFLY(2, 4) BFLY(3, 2) BFLY(4, 1)
#undef BFLY
            float tot = acc[0] + __shfl_xor(acc[0], 32);
            const int e = lane & 31;
            const float logit = __shfl(tot, (int)(__builtin_bitreverse32((unsigned)e) >> 27));
            const float sc = 1.0f / (1.0f + expf(-logit));
            const float ss = sc + rbias;
            float m1 = ss;
#pragma unroll
            for (int o = 1; o < 8; o <<= 1) m1 = fmaxf(m1, __shfl_xor(m1, o));
            int i1 = (ss == m1) ? e : 64;
#pragma unroll
            for (int o = 1; o < 8; o <<= 1) i1 = min(i1, __shfl_xor(i1, o));
            const float s2 = (e == i1) ? -INFINITY : ss;
            float m2 = s2;
#pragma unroll
            for (int o = 1; o < 8; o <<= 1) m2 = fmaxf(m2, __shfl_xor(m2, o));
            int i2 = (s2 == m2 && e != i1) ? e : 64;
#pragma unroll
            for (int o = 1; o < 8; o <<= 1) i2 = min(i2, __shfl_xor(i2, o));
            const float gs = m1 + m2;
            float gbest = gs;
            gbest = fmaxf(gbest, __shfl_xor(gbest, 8)); gbest = fmaxf(gbest, __shfl_xor(gbest, 16));
            int gsel = (gs == gbest) ? (e >> 3) : 64;
            gsel = min(gsel, __shfl_xor(gsel, 8)); gsel = min(gsel, __shfl_xor(gsel, 16));
            const int e0 = __shfl(i1, gsel * 8), e1 = __shfl(i2, gsel * 8);
            const float w0 = __shfl(sc, e0), w1 = __shfl(sc, e1);
            if (lane == 0) {
                const float inv = 1.0f / (w0 + w1);
                selL[li * 2] = e0; selL[li * 2 + 1] = e1;
                ((float2*)(F.ws + WS_WT))[row] = make_float2(w0 * inv, w1 * inv);
                ((int2*)(F.ws + WS_SEL))[row] = make_int2(e0, e1);
            }
        }
        __syncthreads();
        if (tid < 32) {
            int cnt = 0;
            for (int i = 0; i < 2 * PER; ++i) { if (selL[i] == tid) { rankL[i] = cnt; ++cnt; } }
            ((int*)(F.ws + WS_BLKCNT))[blk * 32 + tid] = cnt;
        }
        __syncthreads();
        for (int i = tid; i < PER; i += NTHREADS) ((int2*)(F.ws + WS_LRANK))[blk * PER + i] = make_int2(rankL[2 * i], rankL[2 * i + 1]);
    }
}

template <int LAYER>
__device__ __forceinline__ void phase_slots(Frame& F) {
    constexpr int NT = LAYER == 0 ? NTOK : NX;
    constexpr int PER = NT / 256;
    LAS int* part = (LAS int*)F.lds;
    LAS int* tot = part + 1024;
    LAS int* base = tot + 32;
    LAS int* pst = base + 32;
    const int tid = F.tid, blk = F.vcu;
    const int* bc = (const int*)(F.ws + WS_BLKCNT);
    {
        const int e = tid & 31, p = tid >> 5;
        int st = 0, sb = 0;
        for (int b2 = p; b2 < 256; b2 += 16) { const int c = bc[b2 * 32 + e]; st += c; sb += (b2 < blk) ? c : 0; }
        part[p * 32 + e] = st; part[512 + p * 32 + e] = sb;
    }
    __syncthreads();
    if (tid < 32) { int st = 0, sb = 0; for (int p = 0; p < 16; ++p) { st += part[p * 32 + tid]; sb += part[512 + p * 32 + tid]; } tot[tid] = st; base[tid] = sb; }
    __syncthreads();
    if (tid == 0) { int s = 0; for (int e = 0; e < 32; ++e) { pst[e] = s; s += (tot[e] + 127) & ~127; } pst[32] = s; }
    __syncthreads();
    int* slot_tok = (int*)(F.ws + WS_SLOTTOK); float* slot_w = (float*)(F.ws + WS_SLOTW);
    if (blk == 0 && tid < 33) ((int*)(F.ws + WS_PSTART))[tid] = pst[tid];
    if (blk < 256) {
        for (int i = tid; i < PER; i += NTHREADS) {
            const int t = blk * PER + i;
            const int2 se = ((const int2*)(F.ws + WS_SEL))[t]; const int2 lr = ((const int2*)(F.ws + WS_LRANK))[t]; const float2 wt = ((const float2*)(F.ws + WS_WT))[t];
            const int s0 = pst[se.x] + base[se.x] + lr.x, s1 = pst[se.y] + base[se.y] + lr.y;
            slot_tok[s0] = t; slot_w[s0] = wt.x; slot_tok[s1] = t; slot_w[s1] = wt.y;
            ((int2*)(F.ws + WS_TOKSLOT))[t] = make_int2(s0, s1);
        }
    }
    if (blk < 32) {
        const int lo = pst[blk] + tot[blk], hi = pst[blk + 1];
        for (int s = lo + tid; s < hi; s += NTHREADS) { slot_tok[s] = 0; slot_w[s] = 0.f; }
    }
}

template <int LAYER>
__device__ __forceinline__ void phase_moe_up(Frame& F) {
    LAS int* pst = (LAS int*)(F.lds + LDS_AUX);
    if (F.tid < 33) pst[F.tid] = ((const int*)(F.ws + WS_PSTART))[F.tid];
    __syncthreads();
    const int ntiles = pst[32] >> 7, nunits = ntiles * 4;
    const bf16* H = (const bf16*)(F.ws + WS_H);
    const bf16* W = (const bf16*)(F.ws + WS_WUP) + (size_t)LAYER * 32 * 1024 * 1024;
    const int* slot_tok = (const int*)(F.ws + WS_SLOTTOK); const float* slot_w = (const float*)(F.ws + WS_SLOTW);
    bf16* G = (bf16*)(F.ws + WS_G);
    const int wr = F.wave >> 2, wc = F.wave & 3, fr = F.lane & 15, fq = F.lane >> 4;
    for (int u = F.vcu; u < nunits; u += F.G) {
        const int mt = u >> 2, j = u & 3, m0 = mt * 128;
        int e = 0;
        for (int x = 1; x < 32; ++x) e = (pst[x] <= m0) ? x : e;
        ALGather al; al.init(H, D, slot_tok, m0, F.tid >> 3, (F.tid >> 3) + 64, dma_kc(F.tid));
        f32x4 acc[4][4];
        gemm_tile<true>(F, al, W + ((size_t)e * 1024 + j * 256) * D, D, acc);
#pragma unroll
        for (int mi = 0; mi < 4; ++mi) {
            const int row = m0 + wr * 64 + mi * 16 + fr;
            const float wgt = slot_w[row];
#pragma unroll
            for (int p = 0; p < 2; ++p) {
                const f32x4 g = acc[mi][2 * p], uu = acc[mi][2 * p + 1];
                float o[4];
#pragma unroll
                for (int c = 0; c < 4; ++c) o[c] = g[c] / (1.0f + __expf(-g[c])) * uu[c] * wgt;
                u32x2 ov; ov.x = pk2(o[0], o[1]); ov.y = pk2(o[2], o[3]);
                *(u32x2*)(G + (size_t)row * DEXP + j * 128 + wc * 32 + p * 16 + fq * 4) = ov;
            }
        }
    }
}

template <int LAYER>
__device__ __forceinline__ void phase_moe_down(Frame& F) {
    LAS int* pst = (LAS int*)(F.lds + LDS_AUX);
    if (F.tid < 33) pst[F.tid] = ((const int*)(F.ws + WS_PSTART))[F.tid];
    __syncthreads();
    const int ntiles = pst[32] >> 7, nunits = ntiles * 4;
    const bf16* G = (const bf16*)(F.ws + WS_G);
    const bf16* W = (const bf16*)(F.ws + WS_WDN) + (size_t)LAYER * 32 * 1024 * 512;
    bf16* Y = (bf16*)(F.ws + WS_Y);
    const int wr = F.wave >> 2, wc = F.wave & 3, fr = F.lane & 15, fq = F.lane >> 4;
    for (int u = F.vcu; u < nunits; u += F.G) {
        const int mt = u >> 2, j = u & 3, m0 = mt * 128, n0 = j * 256;
        int e = 0;
        for (int x = 1; x < 32; ++x) e = (pst[x] <= m0) ? x : e;
        ALDense al; al.init(G, DEXP, m0, F.tid >> 3, (F.tid >> 3) + 64, dma_kc(F.tid));
        f32x4 acc[4][4];
        gemm_tile<true>(F, al, W + ((size_t)e * 1024 + n0) * DEXP, DEXP, acc);
#pragma unroll
        for (int mi = 0; mi < 4; ++mi) {
            const int row = m0 + wr * 64 + mi * 16 + fr;
#pragma unroll
            for (int ni = 0; ni < 4; ++ni) {
                const f32x4 v = acc[mi][ni];
                u32x2 o; o.x = pk2(v.x, v.y); o.y = pk2(v.z, v.w);
                *(u32x2*)(Y + (size_t)row * D + n0 + wc * 64 + ni * 16 + fq * 4) = o;
            }
        }
    }
}

struct CRow { f32x4 x[4]; u32x2 y0[4], y1[4]; };
__device__ __forceinline__ void crow_load(const Frame& F, int row, int2 ts, CRow& r) {
    const float* XA = (const float*)(F.ws + WS_XA); const bf16* Y = (const bf16*)(F.ws + WS_Y);
#pragma unroll
    for (int j = 0; j < 4; ++j) {
        const int c0 = 4 * F.lane + 256 * j;
        r.x[j] = *(const f32x4*)(XA + (size_t)row * D + c0);
        r.y0[j] = *(const u32x2*)(Y + (size_t)ts.x * D + c0); r.y1[j] = *(const u32x2*)(Y + (size_t)ts.y * D + c0);
    }
}
__device__ __forceinline__ void crow_combine(const Frame& F, const CRow& r, const float* gate, f32x4 (&v)[4]) {
#pragma unroll
    for (int j = 0; j < 4; ++j) {
        const int c0 = 4 * F.lane + 256 * j;
        const f32x4 gt = *(const f32x4*)(gate + c0);
        f32x4 y; y.x = bflo(r.y0[j].x) + bflo(r.y1[j].x); y.y = bfhi(r.y0[j].x) + bfhi(r.y1[j].x); y.z = bflo(r.y0[j].y) + bflo(r.y1[j].y); y.w = bfhi(r.y0[j].y) + bfhi(r.y1[j].y);
        v[j] = r.x[j] + gt * y;
    }
}

__device__ __forceinline__ void phase_combine0(Frame& F) {
    const Args& A = *F.a;
    const int gw = F.vcu * NWAVES + F.wave, NGW = F.G * NWAVES;
    float* XA = (float*)(F.ws + WS_XA); bf16* H = (bf16*)(F.ws + WS_H);
    const int2* TS = (const int2*)(F.ws + WS_TOKSLOT);
    CRow cn; int2 tsn = make_int2(0, 0);
    if (gw < NTOK) crow_load(F, gw, TS[gw], cn);
    if (gw + NGW < NTOK) tsn = TS[gw + NGW];
    for (int row = gw; row < NTOK; row += NGW) {
        const int c = cond_of(row);
        const CRow cr = cn;
        const int nr = row + NGW;
        if (nr < NTOK) crow_load(F, nr, tsn, cn);
        if (nr + NGW < NTOK) tsn = TS[nr + NGW];
        f32x4 v[4];
        crow_combine(F, cr, modp(F, 0, c, 5), v);
#pragma unroll
        for (int j = 0; j < 4; ++j) *(f32x4*)(XA + (size_t)row * D + 4 * F.lane + 256 * j) = v[j];
        const float rstd = row_rstd(v);
        row_modulate_store(v, rstd, A.in[I_N1G] + D, modp(F, 1, c, 1), modp(F, 1, c, 0), H + (size_t)row * D, F.lane);
    }
}

constexpr float QSCALE = 0.125f * 1.4426950408889634f;
__device__ __forceinline__ void phase_qkv(Frame& F) {
    LAS float* CS = (LAS float*)(F.lds + LDS_AUX);
    for (int i = F.tid; i < 1024; i += NTHREADS) {
        const int p = i >> 4, f = i & 15;
        const float inv = 1.0f / powf(10000.0f, (float)f / 16.0f);
        const float ang = (float)p * inv;
        const double rev = (double)ang * 0.15915494309189535;
        const float fr_ = (float)(rev - floor(rev));
        CS[i * 2] = __builtin_amdgcn_cosf(fr_); CS[i * 2 + 1] = __builtin_amdgcn_sinf(fr_);
    }
    __syncthreads();
    const bf16* H = (const bf16*)(F.ws + WS_H); const bf16* W = (const bf16*)(F.ws + WS_WQKV);
    bf16* Q = (bf16*)(F.ws + WS_Q); bf16* Kb = (bf16*)(F.ws + WS_K); bf16* VT = (bf16*)(F.ws + WS_VT);
    const int wr = F.wave >> 2, wc = F.wave & 3, fr = F.lane & 15, fq = F.lane >> 4;
    constexpr int NTN = 12, NUNITS = (NTOK / 128) * NTN;
    for (int u = F.vcu; u < NUNITS; u += F.G) {
        const int mt = u / NTN, nt = u % NTN, m0 = mt * 128, n0 = nt * 256;
        const bool isctx = m0 >= NX;
        if (isctx && nt < 4) continue;
        ALDense al; al.init(H, D, m0, F.tid >> 3, (F.tid >> 3) + 64, dma_kc(F.tid));
        f32x4 acc[4][4];
        if (nt < 8) {
            gemm_tile<true>(F, al, W + (size_t)n0 * D, D, acc);
            const int hi2 = ((n0 & 1023) >> 6) + wc;
            const bool isq = nt < 4;
#pragma unroll
            for (int mi = 0; mi < 4; ++mi) {
                const int row = m0 + wr * 64 + mi * 16 + fr;
                int b, pos;
                if (!isctx) { b = row >> 12; pos = row & 4095; } else { b = (row - NX) >> 8; pos = S + ((row - NX) & 255); }
                f32x4 o[4];
                if (!isctx) {
                    const int rp = pos >> 6, cp = pos & 63;
#pragma unroll
                    for (int ni = 0; ni < 4; ++ni) {
                        const int p = (ni >> 1) ? cp : rp;
                        const f32x4 xv = acc[mi][ni], pv = acc[mi][ni ^ 1];
#pragma unroll
                        for (int c = 0; c < 4; ++c) {
                            const float cs = CS[(p * 16 + fq * 4 + c) * 2], sn = CS[(p * 16 + fq * 4 + c) * 2 + 1];
                            o[ni][c] = xv[c] * cs + ((ni & 1) ? pv[c] : -pv[c]) * sn;
                        }
                    }
                } else {
#pragma unroll
                    for (int ni = 0; ni < 4; ++ni) o[ni] = acc[mi][ni];
                }
                bf16* dst = isq ? Q + ((size_t)(b * 16 + hi2) * S + pos) * 64 : Kb + ((size_t)(b * 16 + hi2) * KEYS + pos) * 64;
                const float scl = isq ? QSCALE : 1.0f;
#pragma unroll
                for (int ni = 0; ni < 4; ++ni) {
                    u32x2 ov; ov.x = pk2(o[ni].x * scl, o[ni].y * scl); ov.y = pk2(o[ni].z * scl, o[ni].w * scl);
                    *(u32x2*)(dst + ni * 16 + fq * 4) = ov;
                }
            }
        } else {
            gemm_tile<false>(F, al, W + (size_t)n0 * D, D, acc);
#pragma unroll
            for (int mi = 0; mi < 4; ++mi) {
                const int row = m0 + wr * 64 + mi * 16 + fq * 4;
                int b, pos;
                if (!isctx) { b = row >> 12; pos = row & 4095; } else { b = (row - NX) >> 8; pos = S + ((row - NX) & 255); }
#pragma unroll
                for (int ni = 0; ni < 4; ++ni) {
                    const int col = (n0 - 2048) + wc * 64 + ni * 16 + fr, h = col >> 7, vd = col & 127;
                    const f32x4 v = acc[mi][ni];
                    u32x2 ov; ov.x = pk2(v.x, v.y); ov.y = pk2(v.z, v.w);
                    *(u32x2*)(VT + ((size_t)(b * 8 + h) * 128 + vd) * KEYS + pos) = ov;
                }
            }
        }
    }
}

constexpr int ATT_STAGE = 32768;
__device__ __forceinline__ int crow(int r, int hi) { return (r & 3) + 8 * (r >> 2) + 4 * hi; }
__device__ __forceinline__ void phase_attn(Frame& F) {
    const Args& A = *F.a;
    const int tid = F.tid, lane = F.lane, w = F.wave, r32 = lane & 31, hi = lane >> 5;
    const int mp = w >> 2, wq = w & 3;
    LAS char* lds = F.lds;
    float lam;
    { const float* dl = A.in[I_DALAM]; const float s1 = wave_sum(dl[lane] * dl[64 + lane]), s2 = wave_sum(dl[128 + lane] * dl[192 + lane]);
      lam = expf(s1) - expf(s2) + (0.8f - 0.6f * expf(-0.3f)); }
    const float oscale = 1.0f - (0.8f - 0.6f * expf(-0.3f));
    const bf16* Q = (const bf16*)(F.ws + WS_Q); const bf16* Kb = (const bf16*)(F.ws + WS_K); const bf16* VT = (const bf16*)(F.ws + WS_VT);
    bf16* AO = (bf16*)(F.ws + WS_AO);
    constexpr int NUNITS = NB * 8 * (S / 128), NTILES = KEYS / 64;
    for (int u = F.vcu; u < NUNITS; u += F.G) {
        const int bh = u >> 5, qb = u & 31, q0 = qb * 128;
        const bf16* Kg[2]; Kg[0] = Kb + (size_t)(bh * 2 + 0) * KEYS * 64; Kg[1] = Kb + (size_t)(bh * 2 + 1) * KEYS * 64;
        const bf16* Vg = VT + (size_t)bh * 128 * KEYS;
        bf16x8 qf[4];
        { const bf16* qp = Q + ((size_t)(bh * 2 + mp) * S + q0 + wq * 32 + r32) * 64;
#pragma unroll
          for (int ks = 0; ks < 4; ++ks) qf[ks] = *(const bf16x8*)(qp + ks * 16 + hi * 8); }
        f32x16 o[4];
#pragma unroll
        for (int vb = 0; vb < 4; ++vb)
#pragma unroll
            for (int r = 0; r < 16; ++r) o[vb][r] = 0.f;
        float mrun = 0.f, lrun = 0.f;
        const int drow = w * 8 + (lane >> 3), dch = ((lane & 7) ^ ((drow >> 1) & 7)) * 8;
        const bf16* gk0 = Kg[0] + (size_t)drow * 64 + dch; const bf16* gk1 = Kg[1] + (size_t)drow * 64 + dch;
        const bf16* gv0 = Vg + (size_t)drow * KEYS + dch; const bf16* gv1 = Vg + (size_t)(64 + drow) * KEYS + dch;
#define ATT_DMA(t_, st_) do { LAS char* sb_ = lds + (st_) * ATT_STAGE + w * 1024; \
            __builtin_amdgcn_global_load_lds((const unsigned*)(gk0 + (size_t)(t_) * 64 * 64), (LAS unsigned*)(sb_), 16, 0, 0); \
            __builtin_amdgcn_global_load_lds((const unsigned*)(gk1 + (size_t)(t_) * 64 * 64), (LAS unsigned*)(sb_ + 8192), 16, 0, 0); \
            __builtin_amdgcn_global_load_lds((const unsigned*)(gv0 + (t_) * 64), (LAS unsigned*)(sb_ + 16384), 16, 0, 0); \
            __builtin_amdgcn_global_load_lds((const unsigned*)(gv1 + (t_) * 64), (LAS unsigned*)(sb_ + 16384 + 8192), 16, 0, 0); } while (0)
        ATT_DMA(0, 0);
        __syncthreads();
        for (int t = 0; t < NTILES; ++t) {
            const int st = t & 1;
            if (t + 1 < NTILES) ATT_DMA(t + 1, st ^ 1);
            const LAS char* Kt = lds + st * ATT_STAGE + mp * 8192;
            const LAS char* Vt = lds + st * ATT_STAGE + 16384;
            f32x16 s0, s1;
            { const float nm = -mrun;
#pragma unroll
              for (int r = 0; r < 16; ++r) { s0[r] = nm; s1[r] = nm; } }
            bf16x8 kf[8];
#pragma unroll
            for (int ks = 0; ks < 4; ++ks) {
                kf[2 * ks] = *(const LAS bf16x8*)(Kt + swz128(r32, 2 * ks + hi));
                kf[2 * ks + 1] = *(const LAS bf16x8*)(Kt + swz128(32 + r32, 2 * ks + hi));
            }
            u32x4 vf[2][4];
#define VLOAD(dst, vb_) do { const int vrow_ = (vb_) * 32 + r32; _Pragma("unroll") for (int kk_ = 0; kk_ < 4; ++kk_) { \
                const u32x2 lo_ = *(const LAS u32x2*)(Vt + swz128(vrow_, 2 * kk_) + 8 * hi); const u32x2 hi_ = *(const LAS u32x2*)(Vt + swz128(vrow_, 2 * kk_ + 1) + 8 * hi); \
                dst[kk_].x = lo_.x; dst[kk_].y = lo_.y; dst[kk_].z = hi_.x; dst[kk_].w = hi_.y; } } while (0)
            VLOAD(vf[0], 0);
            __builtin_amdgcn_sched_barrier(0);
#pragma unroll
            for (int ks = 0; ks < 4; ++ks) {
                s0 = __builtin_amdgcn_mfma_f32_32x32x16_bf16(kf[2 * ks], qf[ks], s0, 0, 0, 0);
                s1 = __builtin_amdgcn_mfma_f32_32x32x16_bf16(kf[2 * ks + 1], qf[ks], s1, 0, 0, 0);
            }
            float mx = fmaxf(s0[0], s1[0]);
#pragma unroll
            for (int r = 1; r < 16; ++r) mx = fmaxf(mx, fmaxf(s0[r], s1[r]));
            { const auto rr = __builtin_amdgcn_permlane32_swap(__builtin_bit_cast(unsigned, mx), __builtin_bit_cast(unsigned, mx), false, false);
              mx = fmaxf(__builtin_bit_cast(float, rr[0]), __builtin_bit_cast(float, rr[1])); }
            if (t == 0 || __any(mx > 8.0f)) {
                const float dl = (t == 0) ? mx : fmaxf(mx, 0.f);
                mrun += dl;
#pragma unroll
                for (int r = 0; r < 16; ++r) { s0[r] -= dl; s1[r] -= dl; }
                if (t > 0) {
                    const float f = __builtin_amdgcn_exp2f(-dl);
                    lrun *= f;
#pragma unroll
                    for (int vb = 0; vb < 4; ++vb)
#pragma unroll
                        for (int r = 0; r < 16; ++r) o[vb][r] *= f;
                }
            }
            float psum = 0.f;
#pragma unroll
            for (int r = 0; r < 16; ++r) { s0[r] = __builtin_amdgcn_exp2f(s0[r]); s1[r] = __builtin_amdgcn_exp2f(s1[r]); psum += s0[r] + s1[r]; }
            lrun += psum;
            bf16x8 pf[4];
#pragma unroll
            for (int s = 0; s < 2; ++s) {
                u32x4 a, b2;
                a.x = pk2(s0[8 * s + 0], s0[8 * s + 1]); a.y = pk2(s0[8 * s + 2], s0[8 * s + 3]); a.z = pk2(s0[8 * s + 4], s0[8 * s + 5]); a.w = pk2(s0[8 * s + 6], s0[8 * s + 7]);
                b2.x = pk2(s1[8 * s + 0], s1[8 * s + 1]); b2.y = pk2(s1[8 * s + 2], s1[8 * s + 3]); b2.z = pk2(s1[8 * s + 4], s1[8 * s + 5]); b2.w = pk2(s1[8 * s + 6], s1[8 * s + 7]);
                pf[s] = __builtin_bit_cast(bf16x8, a); pf[2 + s] = __builtin_bit_cast(bf16x8, b2);
            }
#pragma unroll
            for (int vb = 0; vb < 4; ++vb) {
                if (vb + 1 < 4) VLOAD(vf[(vb + 1) & 1], vb + 1);
                __builtin_amdgcn_sched_barrier(0);
#pragma unroll
                for (int kk = 0; kk < 4; ++kk)
                    o[vb] = __builtin_amdgcn_mfma_f32_32x32x16_bf16(__builtin_bit_cast(bf16x8, vf[vb & 1][kk]), pf[kk], o[vb], 0, 0, 0);
            }
#undef VLOAD
            __syncthreads();
        }
#undef ATT_DMA
        lrun += __shfl_xor(lrun, 32);
        const float linv = 1.0f / lrun;
        LAS float* XO = (LAS float*)lds;
        if (mp == 1) {
#pragma unroll
            for (int vb = 0; vb < 4; ++vb)
#pragma unroll
                for (int r = 0; r < 16; ++r) XO[(wq * 64 + vb * 16 + r) * 64 + lane] = o[vb][r] * linv;
        }
        __syncthreads();
        if (mp == 0) {
            float ssq = 0.f;
#pragma unroll
            for (int vb = 0; vb < 4; ++vb)
#pragma unroll
                for (int r = 0; r < 16; ++r) { const float v = o[vb][r] * linv - lam * XO[(wq * 64 + vb * 16 + r) * 64 + lane]; o[vb][r] = v; ssq += v * v; }
            ssq += __shfl_xor(ssq, 32);
            const float rstd = rsqrtf(ssq * (1.0f / 128.0f) + EPS) * oscale;
            const int b = bh >> 3, h = bh & 7;
            bf16* dst = AO + (size_t)(b * S + q0 + wq * 32 + r32) * D + h * 128;
            const float* sg = A.in[I_SUBLN];
#pragma unroll
            for (int vb = 0; vb < 4; ++vb)
#pragma unroll
                for (int rq = 0; rq < 4; ++rq) {
                    const int v0 = vb * 32 + 8 * rq + 4 * hi;
                    const f32x4 g4 = *(const f32x4*)(sg + v0);
                    u32x2 ov; ov.x = pk2(o[vb][4 * rq] * rstd * g4.x, o[vb][4 * rq + 1] * rstd * g4.y); ov.y = pk2(o[vb][4 * rq + 2] * rstd * g4.z, o[vb][4 * rq + 3] * rstd * g4.w);
                    *(u32x2*)(dst + v0) = ov;
                }
        }
        __syncthreads();
    }
}

__device__ __forceinline__ void phase_gemm_wo(Frame& F) {
    const bf16* AO = (const bf16*)(F.ws + WS_AO); const bf16* W = (const bf16*)(F.ws + WS_WO);
    float* XA = (float*)(F.ws + WS_XA);
    const int wr = F.wave >> 2, wc = F.wave & 3, fr = F.lane & 15, fq = F.lane >> 4;
    constexpr int NTN = 4, NUNITS = (NX / 128) * NTN;
    for (int u = F.vcu; u < NUNITS; u += F.G) {
        const int mt = u / NTN, nt = u % NTN, m0 = mt * 128, n0 = nt * 256;
        ALDense al; al.init(AO, D, m0, F.tid >> 3, (F.tid >> 3) + 64, dma_kc(F.tid));
        f32x4 acc[4][4];
        gemm_tile<true>(F, al, W + (size_t)n0 * D, D, acc);
#pragma unroll
        for (int mi = 0; mi < 4; ++mi) {
            const int row = m0 + wr * 64 + mi * 16 + fr;
            const float* gate = modp(F, 1, row >> 12, 2);
#pragma unroll
            for (int ni = 0; ni < 4; ++ni) {
                const int col = n0 + wc * 64 + ni * 16 + fq * 4;
                float* xp = XA + (size_t)row * D + col;
                const f32x4 s = *(const f32x4*)xp, gt = *(const f32x4*)(gate + col);
                *(f32x4*)xp = s + gt * acc[mi][ni];
            }
        }
    }
}

__device__ __forceinline__ void phase_final(Frame& F) {
    const Args& A = *F.a;
    const int gw = F.vcu * NWAVES + F.wave, NGW = F.G * NWAVES;
    const int2* TS = (const int2*)(F.ws + WS_TOKSLOT);
    CRow cn; int2 tsn = make_int2(0, 0);
    if (gw < NX) crow_load(F, gw, TS[gw], cn);
    if (gw + NGW < NX) tsn = TS[gw + NGW];
    for (int row = gw; row < NX; row += NGW) {
        const CRow cr = cn;
        const int nr = row + NGW;
        if (nr < NX) crow_load(F, nr, tsn, cn);
        if (nr + NGW < NX) tsn = TS[nr + NGW];
        f32x4 v[4];
        crow_combine(F, cr, modp(F, 1, row >> 12, 5), v);
        const float rstd = row_rstd(v);
#pragma unroll
        for (int j = 0; j < 4; ++j) {
            const int c0 = 4 * F.lane + 256 * j;
            const f32x4 g = *(const f32x4*)(A.in[I_FG] + c0);
            *(f32x4*)(A.out + (size_t)row * D + c0) = (v[j] * rstd) * g;
        }
    }
}

__global__ void __launch_bounds__(NTHREADS) fwd_kernel(Args args) {
    extern __shared__ __attribute__((aligned(16))) unsigned char smem[];
    Frame F;
    F.lds = (LAS char*)smem;
    F.tid = threadIdx.x; F.lane = F.tid & 63; F.wave = __builtin_amdgcn_readfirstlane(F.tid >> 6);
    F.G = gridDim.x; { const int bx = blockIdx.x; F.vcu = (F.G % 8 == 0) ? (bx % 8) * (F.G / 8) + bx / 8 : bx; }
    F.a = &args; F.ws = args.ws;
    volatile LAS unsigned* xbw = (volatile LAS unsigned*)(F.lds + LDS_XB);
    if (F.tid < 4) xbw[F.tid] = 0u;
    __syncthreads();
    XcdBarrier bar; bar.bar = (unsigned*)(F.ws + WS_CTL); bar.x = 0; bar.st = xbw;
    const int lo = args.ph_lo, hi = args.ph_hi;
    const bool multi = (hi - lo) > 1;
    if (multi) bar = xcd_barrier_post((unsigned*)(F.ws + WS_CTL), xbw);
#define RUN_PHASE(k, call) do { if (lo <= (k) && (k) < hi) { call; if ((k) + 1 < hi) xcd_barrier(bar); } } while (0)
    RUN_PHASE(0, phase_convert(F));
    RUN_PHASE(1, phase_prep0(F));
    RUN_PHASE(2, phase_gemm_in(F));
    RUN_PHASE(3, phase_scan(F));
    RUN_PHASE(4, phase_gemm_out0(F));
    RUN_PHASE(5, phase_route<0>(F));
    RUN_PHASE(6, phase_slots<0>(F));
    RUN_PHASE(7, phase_moe_up<0>(F));
    RUN_PHASE(8, phase_moe_down<0>(F));
    RUN_PHASE(9, phase_combine0(F));
    RUN_PHASE(10, phase_qkv(F));
    RUN_PHASE(11, phase_attn(F));
    RUN_PHASE(12, phase_gemm_wo(F));
    RUN_PHASE(13, phase_route<1>(F));
    RUN_PHASE(14, phase_slots<1>(F));
    RUN_PHASE(15, phase_moe_up<1>(F));
    RUN_PHASE(16, phase_moe_down<1>(F));
    RUN_PHASE(17, phase_final(F));
#undef RUN_PHASE
}

extern "C" void kernel_launch(void* const* d_in, const int* in_sizes, int n_in, void* d_out, int out_size, void* d_ws, size_t ws_size, hipStream_t stream) {
    static int grid = 0;
    if (grid == 0) {
        if (n_in != 27 || out_size != NX * D || ws_size < WS_END) { fprintf(stderr, "kernel_launch: unexpected shapes (n_in %d out %d ws %zu)\n", n_in, out_size, ws_size); grid = -1; return; }
        int dev = 0, cus = 0;
        if (hipGetDevice(&dev) != hipSuccess || hipDeviceGetAttribute(&cus, hipDeviceAttributeMultiprocessorCount, dev) != hipSuccess) { grid = -1; return; }
        if (hipFuncSetAttribute((const void*)fwd_kernel, hipFuncAttributeMaxDynamicSharedMemorySize, LDS_BYTES) != hipSuccess) { fprintf(stderr, "kernel_launch: hipFuncSetAttribute failed\n"); grid = -1; return; }
        (void)hipGetLastError();
        grid = cus < 256 ? cus : 256;
    }
    if (grid < 0) return;
    (void)hipMemsetAsync((char*)d_ws + WS_CTL, 0, CTL_ZERO_BYTES, stream);
    Args a{};
    for (int i = 0; i < 27; ++i) a.in[i] = (const float*)d_in[i];
    a.out = (float*)d_out; a.ws = (unsigned char*)d_ws;
    if (MK_N_LAUNCHES == 1) {
        a.ph_lo = 0; a.ph_hi = NPHASES;
        hipLaunchKernelGGL(fwd_kernel, dim3(grid), dim3(NTHREADS), LDS_BYTES, stream, a);
    } else {
        if (DBG_NPH == 0) { a.ph_lo = 0; a.ph_hi = 0; hipLaunchKernelGGL(fwd_kernel, dim3(grid), dim3(NTHREADS), LDS_BYTES, stream, a); }
        for (int p = 0; p < DBG_NPH; ++p) { a.ph_lo = p; a.ph_hi = p + 1; hipLaunchKernelGGL(fwd_kernel, dim3(grid), dim3(NTHREADS), LDS_BYTES, stream, a); }
    }
}
```

```cpp
#include <hip/hip_runtime.h>
#include <cstdio>
#include <cstdint>

#ifndef MK_N_LAUNCHES
#define MK_N_LAUNCHES 1
#endif

#ifndef DBG_NPH
#define DBG_NPH 18
#endif
#define LAS __attribute__((address_space(3)))
typedef unsigned short bf16;
typedef short bf16x8 __attribute__((ext_vector_type(8)));
typedef float f32x4 __attribute__((ext_vector_type(4)));
typedef float f32x16 __attribute__((ext_vector_type(16)));
typedef unsigned u32x4 __attribute__((ext_vector_type(4)));
typedef unsigned u32x2 __attribute__((ext_vector_type(2)));
typedef float f32x2 __attribute__((ext_vector_type(2)));

constexpr int D = 1024, NB = 4, S = 4096, CL = 256;
constexpr int NX = NB * S, NC = NB * CL, NTOK = NX + NC;
constexpr int NEXP = 32, DEXP = 512;
constexpr int NWAVES = 8, NTHREADS = 512;
constexpr int KEYS = S + CL;
constexpr float EPS = 1e-6f;
constexpr int PMAX = 43008;
constexpr int NPHASES = 18;

constexpr size_t MiB = 1u << 20;
constexpr size_t WS_CTL = 0, CTL_ZERO_BYTES = 64 * 1024;
constexpr size_t WS_MOD = 1 * MiB;
constexpr size_t WS_SEL = 2 * MiB;
constexpr size_t WS_WT = WS_SEL + 256 * 1024;
constexpr size_t WS_LRANK = WS_WT + 256 * 1024;
constexpr size_t WS_TOKSLOT = WS_LRANK + 256 * 1024;
constexpr size_t WS_BLKCNT = WS_TOKSLOT + 256 * 1024;
constexpr size_t WS_PSTART = WS_BLKCNT + 64 * 1024;
constexpr size_t WS_SLOTTOK = 3 * MiB + 512 * 1024;
constexpr size_t WS_SLOTW = WS_SLOTTOK + 256 * 1024;
constexpr size_t WS_WIN = 4 * MiB;
constexpr size_t WS_WOUT = 8 * MiB;
constexpr size_t WS_GATE = 10 * MiB;
constexpr size_t WS_WQKV = 11 * MiB;
constexpr size_t WS_WO = 17 * MiB;
constexpr size_t WS_WUP = 20 * MiB;
constexpr size_t WS_WDN = 148 * MiB;
constexpr size_t WS_XA = 212 * MiB;
constexpr size_t WS_H = 280 * MiB;
constexpr size_t WS_R = 314 * MiB;
constexpr size_t WS_YG = WS_R, WS_U = WS_R + 34 * MiB, WS_HF = WS_R + 68 * MiB, WS_HB = WS_R + 102 * MiB;
constexpr size_t WS_G = WS_R, WS_Y = WS_R + 42 * MiB;
constexpr size_t WS_Q = WS_R, WS_K = WS_R + 32 * MiB, WS_VT = WS_R + 66 * MiB, WS_AO = WS_R + 100 * MiB;
constexpr size_t WS_END = 450 * MiB;
static_assert(WS_Y + (size_t)PMAX * 1024 * 2 <= WS_END && WS_HB + 34 * MiB <= WS_END && WS_AO + 32 * MiB <= WS_END, "ws map");
static_assert(WS_K + (size_t)NB * 8 * 2 * KEYS * 64 * 2 <= WS_VT && WS_VT + (size_t)NB * 8 * 128 * KEYS * 2 <= WS_AO, "attn map");

constexpr int LDS_BYTES = 163840;
constexpr int LDS_XB = LDS_BYTES - 64;
constexpr int LDS_AUX = 147456;

__device__ __forceinline__ unsigned f2bf(float f) { unsigned u = __builtin_bit_cast(unsigned, f); return (u + 0x7fffu + ((u >> 16) & 1u)) >> 16; }
typedef __bf16 bf16x2_t __attribute__((ext_vector_type(2)));
__device__ __forceinline__ unsigned pk2(float lo, float hi) { const f32x2 v = {lo, hi}; const bf16x2_t b = __builtin_convertvector(v, bf16x2_t); return __builtin_bit_cast(unsigned, b); }
__device__ __forceinline__ float bflo(unsigned w) { return __builtin_bit_cast(float, w << 16); }
__device__ __forceinline__ float bfhi(unsigned w) { return __builtin_bit_cast(float, w & 0xffff0000u); }
__device__ __forceinline__ float wave_sum(float v) {
#pragma unroll
    for (int o = 1; o < 64; o <<= 1) v += __shfl_xor(v, o);
    return v;
}
__device__ __forceinline__ float sigmoidf_(float x) { return 1.0f / (1.0f + __expf(-x)); }
#define LDS_WAIT() asm volatile("s_waitcnt lgkmcnt(0)" ::: "memory")

#define XB_TMO      128
#define XB_XCNT(j)  (256  + 64 * (j))
#define XB_XSUB(j)  (1280 + 64 * (j))
#define XB_XGEN(j)  (2304 + 64 * (j))
#define XB_TOP      3328
#define XB_TOPGEN   3392
#define XCD_BAR_WORDS 3456
#define XB_SPIN_CAP (1u << 18)
__device__ __forceinline__ unsigned xb_ld(unsigned* p)              { return __hip_atomic_load(p, __ATOMIC_RELAXED, __HIP_MEMORY_SCOPE_AGENT); }
__device__ __forceinline__ unsigned xb_add(unsigned* p, unsigned v) { return __hip_atomic_fetch_add(p, v, __ATOMIC_RELAXED, __HIP_MEMORY_SCOPE_AGENT); }
__device__ __forceinline__ unsigned xb_xcc_id() { return (unsigned)__builtin_amdgcn_s_getreg((3 << 11) | 20) & 0xFu; }
#define XB_SPIN(cond, bar) do { unsigned _sp = 0; while (cond) { __builtin_amdgcn_s_sleep(1); \
    if ((++_sp & 255u) == 0u) { if (xb_ld(&(bar)[XB_TMO])) break; if (_sp > XB_SPIN_CAP) { atomicAdd(&(bar)[XB_TMO], 1u); break; } } } } while (0)
struct XcdBarrier { unsigned* bar; unsigned x; volatile LAS unsigned* st; };
__device__ __forceinline__ XcdBarrier xcd_barrier_post(unsigned* bar, volatile LAS unsigned* st) {
    XcdBarrier b; b.bar = bar; b.x = xb_xcc_id(); b.st = st;
    if (threadIdx.x == 0) (void)xb_add(&bar[XB_XCNT(b.x)], 1u);
    return b;
}
__device__ __forceinline__ void xcd_barrier_complete(unsigned* bar, unsigned x, unsigned& nloc, unsigned& nx) {
    const unsigned G = gridDim.x * gridDim.y * gridDim.z;
    unsigned sum, cnt, mine, sp = 0u;
    for (;;) {
        sum = 0u; cnt = 0u; mine = 0u;
#pragma unroll
        for (unsigned j = 0; j < 16; ++j) { const unsigned c = xb_ld(&bar[XB_XCNT(j)]); sum += c; cnt += (c > 0u) ? 1u : 0u; mine = (j == x) ? c : mine; }
        if (sum == G) break;
        __builtin_amdgcn_s_sleep(1);
        if ((++sp & 255u) == 0u) { if (xb_ld(&bar[XB_TMO])) break; if (sp > XB_SPIN_CAP) { atomicAdd(&bar[XB_TMO], 1u); break; } }
    }
    nloc = mine > 0u ? mine : 1u; nx = cnt > 0u ? cnt : 1u;
}
__device__ __forceinline__ void xcd_barrier(const XcdBarrier& b) {
    asm volatile("s_waitcnt vmcnt(0)" ::: "memory");
    __syncthreads();
    if (threadIdx.x == 0) {
        unsigned* bar = b.bar;
        __builtin_amdgcn_s_waitcnt(0);
        unsigned nloc = b.st[0], nx = b.st[1];
        if (nloc == 0u) { xcd_barrier_complete(bar, b.x, nloc, nx); b.st[0] = nloc; b.st[1] = nx; }
        const unsigned old = xb_add(&bar[XB_XSUB(b.x)], 1u);
        const unsigned gen = old / nloc;
        if (old + 1u == (gen + 1u) * nloc) {
            __builtin_amdgcn_fence(__ATOMIC_RELEASE, "agent");
            asm volatile("s_waitcnt vmcnt(0)" ::: "memory");
            const unsigned og = xb_add(&bar[XB_TOP], 1u);
            const unsigned tg = og / nx;
            if (og + 1u == (tg + 1u) * nx) xb_add(&bar[XB_TOPGEN], 1u);
            else XB_SPIN(xb_ld(&bar[XB_TOPGEN]) == tg, bar);
            __builtin_amdgcn_fence(__ATOMIC_ACQUIRE, "agent");
            xb_add(&bar[XB_XGEN(b.x)], 1u);
            asm volatile("s_waitcnt vmcnt(0)" ::: "memory");
        } else {
            XB_SPIN(xb_ld(&bar[XB_XGEN(b.x)]) == gen, bar);
            __builtin_amdgcn_fence(__ATOMIC_ACQUIRE, "agent");
            asm volatile("s_waitcnt vmcnt(0)" ::: "memory");
        }
    }
    __syncthreads();
}

struct Args { const float* in[27]; float* out; unsigned char* ws; int ph_lo, ph_hi; };
enum { I_X = 0, I_C, I_CTX, I_CCTX, I_WMOD, I_BMOD, I_N1G, I_N2G, I_WIN, I_CONVW, I_CONVB, I_GAW, I_GAB, I_GXW, I_GXB, I_LAM, I_WOUT,
       I_WQKV, I_DALAM, I_SUBLN, I_WO, I_RW, I_RB, I_MG, I_MU, I_MD, I_FG };

struct Frame {
    LAS char* lds;
    int tid, lane, wave, vcu, G;
    const Args* a;
    unsigned char* ws;
};

__device__ __forceinline__ const float* modp(const Frame& F, int l, int c, int k) { return (const float*)(F.ws + WS_MOD) + (size_t)(l * 5 + c) * 6144 + k * 1024; }
__device__ __forceinline__ int cond_of(int row) { return row < NX ? (row >> 12) : 4; }

__device__ __forceinline__ int moe_up_row(int n) { return ((n >> 7) << 8) + (((n >> 5) & 3) << 6) + (((n >> 4) & 1) << 5) + (n & 15); }

struct TDesc { const float* W; bf16* WT; int N, ldT, mode, k0, n0; };
__device__ __forceinline__ void tr_load(const TDesc& t, int lane, f32x4 (&rg)[8]) {
    const float* p = t.W + (size_t)(t.k0 + (lane >> 3)) * t.N + t.n0 + 4 * (lane & 7);
#pragma unroll
    for (int i = 0; i < 8; ++i) rg[i] = *(const f32x4*)(p + (size_t)(8 * i) * t.N);
}
__device__ __forceinline__ void tr_finish(const TDesc& t, int lane, const f32x4 (&rg)[8], LAS float* scr) {
#pragma unroll
    for (int i = 0; i < 8; ++i) { LAS float* d = scr + ((lane >> 3) + 8 * i) * 33 + 4 * (lane & 7); d[0] = rg[i].x; d[1] = rg[i].y; d[2] = rg[i].z; d[3] = rg[i].w; }
    LDS_WAIT();
    const int c = lane & 7;
#pragma unroll
    for (int j = 0; j < 4; ++j) {
        const int n = (lane >> 3) + 8 * j; const LAS float* s = scr + (8 * c) * 33 + n;
        u32x4 o; o.x = pk2(s[0 * 33], s[1 * 33]); o.y = pk2(s[2 * 33], s[3 * 33]); o.z = pk2(s[4 * 33], s[5 * 33]); o.w = pk2(s[6 * 33], s[7 * 33]);
        const int nn = t.n0 + n;
        const int drow = (t.mode == 0) ? nn : (moe_up_row(nn) + (t.mode == 2 ? 16 : 0));
        *(u32x4*)(t.WT + (size_t)drow * t.ldT + t.k0 + 8 * c) = o;
    }
    LDS_WAIT();
}

__device__ __forceinline__ void phase_convert(Frame& F) {
    const Args& A = *F.a;
    LAS float* scr = (LAS float*)(F.lds + F.wave * 8448);
    LAS float* sil = (LAS float*)(F.lds + 69632);
    for (int i = F.tid; i < 5 * 1024; i += NTHREADS) { const int c = i >> 10, k = i & 1023; const float v = (c < 4) ? A.in[I_C][c * 1024 + k] : A.in[I_CCTX][k]; sil[i] = v / (1.0f + __expf(-v)); }
    __syncthreads();
    const int gw = F.vcu * NWAVES + F.wave, NGW = F.G * NWAVES;
    constexpr int N_MOD = 192, N_WIN = 16 * 64, N_WOUT = 16 * 32, N_WQKV = 16 * 96, N_WO = 16 * 32, N_GATE = 32 * 8, N_MOE = 64 * 256;
    {
        LAS float* red = (LAS float*)(F.lds + 90112);
        for (int item = F.vcu; item < N_MOD; item += F.G) {
            const int l = item / 96, col = (item % 96) * 64 + F.lane;
            const float* wp = A.in[I_WMOD] + ((size_t)l * 1024 + F.wave * 128) * 6144 + col;
            float acc[5] = {0.f, 0.f, 0.f, 0.f, 0.f};
#pragma unroll 4
            for (int k = 0; k < 128; k += 4) {
                const float w0 = wp[(size_t)k * 6144], w1 = wp[(size_t)(k + 1) * 6144], w2 = wp[(size_t)(k + 2) * 6144], w3 = wp[(size_t)(k + 3) * 6144];
#pragma unroll
                for (int c = 0; c < 5; ++c) { const f32x4 s4 = *(const LAS f32x4*)(sil + c * 1024 + F.wave * 128 + k); acc[c] += s4.x * w0 + s4.y * w1 + s4.z * w2 + s4.w * w3; }
            }
#pragma unroll
            for (int c = 0; c < 5; ++c) red[(F.wave * 5 + c) * 64 + F.lane] = acc[c];
            __syncthreads();
            if (F.tid < 320) {
                const int c = F.tid >> 6, ln = F.tid & 63;
                float s = A.in[I_BMOD][l * 6144 + (item % 96) * 64 + ln];
#pragma unroll
                for (int w2 = 0; w2 < 8; ++w2) s += red[(w2 * 5 + c) * 64 + ln];
                ((float*)(F.ws + WS_MOD))[(size_t)(l * 5 + c) * 6144 + (item % 96) * 64 + ln] = s;
            }
            __syncthreads();
        }
    }
    auto decode = [&](int r) -> TDesc {
        TDesc t; t.mode = 0;
        int item;
        if (r < N_WIN) { t.W = A.in[I_WIN]; t.N = 2048; t.WT = (bf16*)(F.ws + WS_WIN); t.ldT = 1024; item = r; }
        else if ((r -= N_WIN) < N_WOUT) { t.W = A.in[I_WOUT]; t.N = 1024; t.WT = (bf16*)(F.ws + WS_WOUT); t.ldT = 1024; item = r; }
        else {
            r -= N_WOUT;
            const int m = r >> 3, d = m >> 4, g = (m >> 3) & 1, n = m & 7;
            t.W = (g == 0 ? A.in[I_GAW] : A.in[I_GXW]) + (size_t)(d * 8 + n) * 128 * 128; t.N = 128;
            t.WT = (bf16*)(F.ws + WS_GATE) + (size_t)m * 128 * 128; t.ldT = 128; item = r & 7;
        }
        const int nblk = t.N >> 5; t.k0 = 64 * (item / nblk); t.n0 = 32 * (item % nblk);
        return t;
    };
    constexpr int NTR0 = N_WIN + N_WOUT + N_GATE;
    for (int it = gw; it < NTR0; it += NGW) {
        const TDesc cur = decode(it); f32x4 rg[8]; tr_load(cur, F.lane, rg);
        tr_finish(cur, F.lane, rg, scr);
    }
}

constexpr int ND_WQKV = 32 * 96, ND_WO = 32 * 32, ND_MOEL = 32 * 512;
constexpr int ND_SCAN = ND_WQKV + ND_WO + 3 * ND_MOEL;
constexpr int ND_ATTN = 3 * ND_MOEL;
__device__ __forceinline__ TDesc decode_moe(const Frame& F, int r, int layer) {
    const Args& A = *F.a;
    TDesc t; t.mode = 0; int item;
    if (r < ND_MOEL) { const int le = layer * 32 + (r >> 9); t.W = A.in[I_MG] + (size_t)le * 1024 * 512; t.N = 512; t.WT = (bf16*)(F.ws + WS_WUP) + (size_t)le * 1024 * 1024; t.ldT = 1024; t.mode = 1; item = r & 511; }
    else if ((r -= ND_MOEL) < ND_MOEL) { const int le = layer * 32 + (r >> 9); t.W = A.in[I_MU] + (size_t)le * 1024 * 512; t.N = 512; t.WT = (bf16*)(F.ws + WS_WUP) + (size_t)le * 1024 * 1024; t.ldT = 1024; t.mode = 2; item = r & 511; }
    else { r -= ND_MOEL; const int le = layer * 32 + (r >> 9); t.W = A.in[I_MD] + (size_t)le * 512 * 1024; t.N = 1024; t.WT = (bf16*)(F.ws + WS_WDN) + (size_t)le * 1024 * 512; t.ldT = 512; item = r & 511; }
    const int nblk = t.N >> 5; t.k0 = 32 * (item / nblk); t.n0 = 32 * (item % nblk);
    return t;
}
__device__ __forceinline__ TDesc decode_deferred(const Frame& F, int r) {
    const Args& A = *F.a;
    if (r >= ND_WQKV + ND_WO) return decode_moe(F, r - (ND_WQKV + ND_WO), 0);
    TDesc t; t.mode = 0; int item;
    if (r < ND_WQKV) { t.W = A.in[I_WQKV]; t.N = 3072; t.WT = (bf16*)(F.ws + WS_WQKV); t.ldT = 1024; item = r; }
    else { r -= ND_WQKV; t.W = A.in[I_WO]; t.N = 1024; t.WT = (bf16*)(F.ws + WS_WO); t.ldT = 1024; item = r; }
    const int nblk = t.N >> 5; t.k0 = 32 * (item / nblk); t.n0 = 32 * (item % nblk);
    return t;
}
__device__ __forceinline__ void tr3_dma(const TDesc& t, int lane, LAS char* buf) {
    const float* p = t.W + (size_t)(t.k0 + (lane >> 3)) * t.N + t.n0;
#pragma unroll
    for (int i = 0; i < 4; ++i)
        __builtin_amdgcn_global_load_lds((const unsigned*)(p + (size_t)(8 * i) * t.N + 4 * ((lane & 7) ^ i)), (LAS unsigned*)(buf + i * 1024), 16, 0, 0);
}
__device__ __forceinline__ void tr3_finish(const TDesc& t, int lane, const LAS char* buf) {
    const int c = lane & 3;
#pragma unroll
    for (int j = 0; j < 2; ++j) {
        const int n = (lane >> 2) + 16 * j;
        const LAS char* s = buf + (8 * c) * 128 + (((n >> 2) ^ c) << 4) + (n & 3) * 4;
        float x[8];
#pragma unroll
        for (int i = 0; i < 8; ++i) x[i] = *(const LAS float*)(s + i * 128);
        u32x4 o; o.x = pk2(x[0], x[1]); o.y = pk2(x[2], x[3]); o.z = pk2(x[4], x[5]); o.w = pk2(x[6], x[7]);
        const int nn = t.n0 + n;
        const int drow = (t.mode == 0) ? nn : (moe_up_row(nn) + (t.mode == 2 ? 16 : 0));
        *(u32x4*)(t.WT + (size_t)drow * t.ldT + t.k0 + 8 * c) = o;
    }
}
__device__ __forceinline__ void tr2_load(const TDesc& t, int lane, f32x4 (&rg)[4]) {
    const float* p = t.W + (size_t)(t.k0 + (lane >> 3)) * t.N + t.n0 + 4 * (lane & 7);
#pragma unroll
    for (int i = 0; i < 4; ++i) rg[i] = *(const f32x4*)(p + (size_t)(8 * i) * t.N);
}
__device__ __forceinline__ void tr2_finish(const TDesc& t, int lane, const f32x4 (&rg)[4], LAS float* scr  ) {
#pragma unroll
    for (int i = 0; i < 4; ++i) { LAS float* d = scr + ((lane >> 3) + 8 * i) * 33 + 4 * (lane & 7); d[0] = rg[i].x; d[1] = rg[i].y; d[2] = rg[i].z; d[3] = rg[i].w; }
    LDS_WAIT();
    const int c = lane & 3;
#pragma unroll
    for (int j = 0; j < 2; ++j) {
        const int n = (lane >> 2) + 16 * j; const LAS float* s = scr + (8 * c) * 33 + n;
        u32x4 o; o.x = pk2(s[0 * 33], s[1 * 33]); o.y = pk2(s[2 * 33], s[3 * 33]); o.z = pk2(s[4 * 33], s[5 * 33]); o.w = pk2(s[6 * 33], s[7 * 33]);
        const int nn = t.n0 + n;
        const int drow = (t.mode == 0) ? nn : (moe_up_row(nn) + (t.mode == 2 ? 16 : 0));
        *(u32x4*)(t.WT + (size_t)drow * t.ldT + t.k0 + 8 * c) = o;
    }
    LDS_WAIT();
}

__device__ __forceinline__ float row_rstd(const f32x4 (&v)[4]) {
    float s = 0.f;
#pragma unroll
    for (int j = 0; j < 4; ++j) s += (v[j].x * v[j].x + v[j].y * v[j].y) + (v[j].z * v[j].z + v[j].w * v[j].w);
    return rsqrtf(wave_sum(s) * (1.0f / D) + EPS);
}
__device__ __forceinline__ void row_modulate_store(f32x4 (&v)[4], float rstd, const float* g, const float* sc, const float* sh, bf16* dst, int lane) {
#pragma unroll
    for (int j = 0; j < 4; ++j) {
        const int c0 = 4 * lane + 256 * j;
        const f32x4 gg = *(const f32x4*)(g + c0), s1 = *(const f32x4*)(sc + c0), s0 = *(const f32x4*)(sh + c0);
        v[j] = (v[j] * rstd) * gg * (1.0f + s1) + s0;
        u32x2 o; o.x = pk2(v[j].x, v[j].y); o.y = pk2(v[j].z, v[j].w);
        *(u32x2*)(dst + c0) = o;
    }
}

__device__ __forceinline__ void load_row4(const float* src, int lane, f32x4 (&v)[4]) {
#pragma unroll
    for (int j = 0; j < 4; ++j) v[j] = *(const f32x4*)(src + 4 * lane + 256 * j);
}
__device__ __forceinline__ void phase_prep0(Frame& F) {
    const Args& A = *F.a;
    const int gw = F.vcu * NWAVES + F.wave, NGW = F.G * NWAVES;
    bf16* H = (bf16*)(F.ws + WS_H);
    f32x4 vn[4];
    if (gw < NTOK) load_row4(gw < NX ? A.in[I_X] + (size_t)gw * D : A.in[I_CTX] + (size_t)(gw - NX) * D, F.lane, vn);
    for (int row = gw; row < NTOK; row += NGW) {
        const int c = cond_of(row);
        f32x4 v[4];
#pragma unroll
        for (int j = 0; j < 4; ++j) v[j] = vn[j];
        const int nr = row + NGW;
        if (nr < NTOK) load_row4(nr < NX ? A.in[I_X] + (size_t)nr * D : A.in[I_CTX] + (size_t)(nr - NX) * D, F.lane, vn);
        const float rstd = row_rstd(v);
        row_modulate_store(v, rstd, A.in[I_N1G], modp(F, 0, c, 1), modp(F, 0, c, 0), H + (size_t)row * D, F.lane);
    }
}

constexpr int GEMM_STAGE = 49152;
__device__ __forceinline__ int swz128(int row, int chunk) { return row * 128 + ((chunk ^ ((row >> 1) & 7)) << 4); }
__device__ __forceinline__ int dma_kc(int tid) { return ((tid & 7) ^ ((tid >> 4) & 7)) * 8; }

struct ALDense {
    static constexpr bool DMA = true;
    const bf16* p0; const bf16* p1;
    __device__ __forceinline__ const bf16* ptr(int i) const { return i ? p1 : p0; }
    __device__ __forceinline__ void init(const bf16* A, int lda, int m0, int r0, int r1, int kc) { p0 = A + (size_t)(m0 + r0) * lda + kc; p1 = A + (size_t)(m0 + r1) * lda + kc; }
    __device__ __forceinline__ u32x4 load(int i, int k0) const { return *(const u32x4*)((i ? p1 : p0) + k0); }
};
struct ALGather {
    static constexpr bool DMA = true;
    const bf16* p0; const bf16* p1;
    __device__ __forceinline__ const bf16* ptr(int i) const { return i ? p1 : p0; }
    __device__ __forceinline__ void init(const bf16* A, int lda, const int* idx, int m0, int r0, int r1, int kc) { p0 = A + (size_t)idx[m0 + r0] * lda + kc; p1 = A + (size_t)idx[m0 + r1] * lda + kc; }
    __device__ __forceinline__ u32x4 load(int i, int k0) const { return *(const u32x4*)((i ? p1 : p0) + k0); }
};
struct ALCombine {
    static constexpr bool DMA = false;
    size_t o0, o1; const bf16 *hf, *hb, *yg;
    __device__ __forceinline__ const bf16* ptr(int) const { return nullptr; }
    __device__ __forceinline__ void init(const bf16* hf_, const bf16* hb_, const bf16* yg_, int m0, int r0, int r1, int kc) { hf = hf_; hb = hb_; yg = yg_; o0 = (size_t)(m0 + r0) * D + kc; o1 = (size_t)(m0 + r1) * D + kc; }
    __device__ __forceinline__ u32x4 load(int i, int k0) const {
        const size_t o = (i ? o1 : o0) + k0;
        const u32x4 a = *(const u32x4*)(hf + o), b = *(const u32x4*)(hb + o), y = *(const u32x4*)(yg + o);
        u32x4 r;
#pragma unroll
        for (int q = 0; q < 4; ++q) r[q] = pk2((bflo(a[q]) + bflo(b[q])) * bflo(y[q]), (bfhi(a[q]) + bfhi(b[q])) * bfhi(y[q]));
        return r;
    }
};

template <class AL>
__device__ __forceinline__ void gemm_prefetch(const Frame& F, const AL& al, const bf16* __restrict__ Bt, int K) {
    const int tid = F.tid, sr = tid >> 3, sc = (tid & 7) ^ ((sr >> 1) & 7), wl = F.wave * 1024;
    const bf16* bp = Bt + (size_t)sr * K + sc * 8;
    const size_t bstep = (size_t)64 * K;
    LAS char* lds = F.lds;
    __builtin_amdgcn_global_load_lds((const unsigned*)(al.ptr(0)), (LAS unsigned*)(lds + wl), 16, 0, 0);
    __builtin_amdgcn_global_load_lds((const unsigned*)(al.ptr(1)), (LAS unsigned*)(lds + 8192 + wl), 16, 0, 0);
#pragma unroll
    for (int i = 0; i < 4; ++i)
        __builtin_amdgcn_global_load_lds((const unsigned*)(bp + i * bstep), (LAS unsigned*)(lds + 16384 + i * 8192 + wl), 16, 0, 0);
}
template <bool SWAP, class AL, bool PRE = false>
__device__ __forceinline__ void gemm_tile(const Frame& F, const AL& al, const bf16* __restrict__ Bt  , int K, f32x4 (&acc)[4][4]) {
    const int tid = F.tid, lane = F.lane, wid = F.wave, wr = wid >> 2, wc = wid & 3, fr = lane & 15, fq = lane >> 4;
    const int sr = tid >> 3;
    const int sc = AL::DMA ? ((tid & 7) ^ ((sr >> 1) & 7)) : (tid & 7);
    LAS char* lds = F.lds;
    const bf16* bp = Bt + (size_t)sr * K + sc * 8;
    const size_t bstep = (size_t)64 * K;
    int wa[2], wb[4];
#pragma unroll
    for (int i = 0; i < 2; ++i) wa[i] = swz128(sr + 64 * i, sc);
#pragma unroll
    for (int i = 0; i < 4; ++i) wb[i] = 16384 + swz128(sr + 64 * i, sc);
    const int key = (fr >> 1) & 7;
    const int ra = (wr * 64 + fr) * 128, rb = 16384 + (wc * 64 + fr) * 128;
#pragma unroll
    for (int mi = 0; mi < 4; ++mi)
#pragma unroll
        for (int ni = 0; ni < 4; ++ni) acc[mi][ni] = (f32x4){0.f, 0.f, 0.f, 0.f};
    u32x4 ga[2], gb[4];
    const int wl = wid * 1024;
#define GT_DMA(stage_, k_) do { \
        __builtin_amdgcn_global_load_lds((const unsigned*)(al.ptr(0) + (k_)), (LAS unsigned*)(lds + (stage_) + wl), 16, 0, 0); \
        __builtin_amdgcn_global_load_lds((const unsigned*)(al.ptr(1) + (k_)), (LAS unsigned*)(lds + (stage_) + 8192 + wl), 16, 0, 0); \
        _Pragma("unroll") for (int i_ = 0; i_ < 4; ++i_) \
            __builtin_amdgcn_global_load_lds((const unsigned*)(bp + i_ * bstep + (k_)), (LAS unsigned*)(lds + (stage_) + 16384 + i_ * 8192 + wl), 16, 0, 0); } while (0)
    if constexpr (AL::DMA) { if constexpr (!PRE) { GT_DMA(0, 0); } }
    else {
        ga[0] = al.load(0, 0); ga[1] = al.load(1, 0);
#pragma unroll
        for (int i = 0; i < 4; ++i) gb[i] = *(const u32x4*)(bp + i * bstep);
#pragma unroll
        for (int i = 0; i < 2; ++i) *(LAS u32x4*)(lds + wa[i]) = ga[i];
#pragma unroll
        for (int i = 0; i < 4; ++i) *(LAS u32x4*)(lds + wb[i]) = gb[i];
    }
    __syncthreads();
    const int nk = K / 64;
    for (int kt = 0; kt < nk; ++kt) {
        const int cur = (kt & 1) * GEMM_STAGE, nxt = GEMM_STAGE - cur;
        if (kt + 1 < nk) {
            const int k1 = (kt + 1) * 64;
            if constexpr (AL::DMA) { GT_DMA(nxt, k1); }
            else {
                ga[0] = al.load(0, k1); ga[1] = al.load(1, k1);
#pragma unroll
                for (int i = 0; i < 4; ++i) gb[i] = *(const u32x4*)(bp + i * bstep + k1);
            }
        }
        {
            bf16x8 af[2][4], bfr[2][4];
#pragma unroll
            for (int ks = 0; ks < 2; ++ks) {
                const int co = ((ks * 4 + fq) ^ key) << 4;
#pragma unroll
                for (int mi = 0; mi < 4; ++mi) af[ks][mi] = *(const LAS bf16x8*)(lds + cur + ra + mi * 2048 + co);
#pragma unroll
                for (int ni = 0; ni < 4; ++ni) bfr[ks][ni] = *(const LAS bf16x8*)(lds + cur + rb + ni * 2048 + co);
            }
            __builtin_amdgcn_sched_barrier(0);
#pragma unroll
            for (int ks = 0; ks < 2; ++ks)
#pragma unroll
                for (int mi = 0; mi < 4; ++mi)
#pragma unroll
                    for (int ni = 0; ni < 4; ++ni)
                        acc[mi][ni] = SWAP ? __builtin_amdgcn_mfma_f32_16x16x32_bf16(bfr[ks][ni], af[ks][mi], acc[mi][ni], 0, 0, 0)
                                           : __builtin_amdgcn_mfma_f32_16x16x32_bf16(af[ks][mi], bfr[ks][ni], acc[mi][ni], 0, 0, 0);
            __builtin_amdgcn_sched_barrier(0);
        }
        if constexpr (!AL::DMA) {
            if (kt + 1 < nk) {
#pragma unroll
                for (int i = 0; i < 2; ++i) *(LAS u32x4*)(lds + nxt + wa[i]) = ga[i];
#pragma unroll
                for (int i = 0; i < 4; ++i) *(LAS u32x4*)(lds + nxt + wb[i]) = gb[i];
            }
        }
        __syncthreads();
    }
#undef GT_DMA
}

#define G3_WAIT_BAR(N) asm volatile("s_waitcnt vmcnt(" #N ") lgkmcnt(0)\n\ts_barrier" ::: "memory")
template <class AL>
__device__ __forceinline__ void gemm3_issue(const Frame& F, const AL& al, const bf16* bp, size_t bstep, int stage_off, int k) {
    LAS char* lds = F.lds; const int wl = F.wave * 1024;
    __builtin_amdgcn_global_load_lds((const unsigned*)(al.ptr(0) + k), (LAS unsigned*)(lds + stage_off + wl), 16, 0, 0);
    __builtin_amdgcn_global_load_lds((const unsigned*)(al.ptr(1) + k), (LAS unsigned*)(lds + stage_off + 8192 + wl), 16, 0, 0);
#pragma unroll
    for (int i = 0; i < 4; ++i)
        __builtin_amdgcn_global_load_lds((const unsigned*)(bp + i * bstep + k), (LAS unsigned*)(lds + stage_off + 16384 + i * 8192 + wl), 16, 0, 0);
}
template <class AL>
__device__ __forceinline__ void gemm3_prefetch(const Frame& F, const AL& al, const bf16* __restrict__ Bt, int K) {
    const int tid = F.tid, sr = tid >> 3, sc = (tid & 7) ^ ((sr >> 1) & 7);
    const bf16* bp = Bt + (size_t)sr * K + sc * 8;
    gemm3_issue(F, al, bp, (size_t)64 * K, 0, 0);
    gemm3_issue(F, al, bp, (size_t)64 * K, GEMM_STAGE, 64);
}
template <bool SWAP, class AL>
__device__ __forceinline__ void gemm3_tile(const Frame& F, const AL& al, const bf16* __restrict__ Bt, int K, f32x4 (&acc)[4][4]) {
    const int tid = F.tid, lane = F.lane, wid = F.wave, wr = wid >> 2, wc = wid & 3, fr = lane & 15, fq = lane >> 4;
    const int sr = tid >> 3, sc = (tid & 7) ^ ((sr >> 1) & 7);
    LAS char* lds = F.lds;
    const bf16* bp = Bt + (size_t)sr * K + sc * 8;
    const size_t bstep = (size_t)64 * K;
    const int key = (fr >> 1) & 7;
    const int ra = (wr * 64 + fr) * 128, rb = 16384 + (wc * 64 + fr) * 128;
#pragma unroll
    for (int mi = 0; mi < 4; ++mi)
#pragma unroll
        for (int ni = 0; ni < 4; ++ni) acc[mi][ni] = (f32x4){0.f, 0.f, 0.f, 0.f};
    const int nk = K / 64;
    int cur = 0, nx2 = 2 * GEMM_STAGE;
    for (int kt = 0; kt < nk; ++kt) {
        if (kt == 0 || kt + 1 >= nk) G3_WAIT_BAR(0); else G3_WAIT_BAR(6);
        if (kt + 2 < nk) gemm3_issue(F, al, bp, bstep, nx2, (kt + 2) * 64);
#pragma unroll
        for (int ks = 0; ks < 2; ++ks) {
            const int co = ((ks * 4 + fq) ^ key) << 4;
            bf16x8 af[4], bfr[4];
#pragma unroll
            for (int mi = 0; mi < 4; ++mi) af[mi] = *(const LAS bf16x8*)(lds + cur + ra + mi * 2048 + co);
#pragma unroll
            for (int ni = 0; ni < 4; ++ni) bfr[ni] = *(const LAS bf16x8*)(lds + cur + rb + ni * 2048 + co);
#pragma unroll
            for (int mi = 0; mi < 4; ++mi)
#pragma unroll
                for (int ni = 0; ni < 4; ++ni)
                    acc[mi][ni] = SWAP ? __builtin_amdgcn_mfma_f32_16x16x32_bf16(bfr[ni], af[mi], acc[mi][ni], 0, 0, 0)
                                       : __builtin_amdgcn_mfma_f32_16x16x32_bf16(af[mi], bfr[ni], acc[mi][ni], 0, 0, 0);
        }
        nx2 = cur; cur = (cur == 2 * GEMM_STAGE) ? 0 : cur + GEMM_STAGE;
    }
    G3_WAIT_BAR(0);
}

__device__ __forceinline__ float gelu_tanh(float x) {
    const float z = 0.7978845608028654f * (x + 0.044715f * x * x * x);
    const float t = 1.0f - 2.0f / (1.0f + __expf(2.0f * z));
    return 0.5f * x * (1.0f + t);
}

__device__ __forceinline__ void phase_gemm_in(Frame& F) {
    const bf16* H = (const bf16*)(F.ws + WS_H); const bf16* W = (const bf16*)(F.ws + WS_WIN);
    bf16* YG = (bf16*)(F.ws + WS_YG); bf16* U = (bf16*)(F.ws + WS_U);
    const int wr = F.wave >> 2, wc = F.wave & 3, fr = F.lane & 15, fq = F.lane >> 4;
    constexpr int NTN = 8, NUNITS = (NTOK / 128) * NTN;
    ALDense al; const bf16* Bp = W;
    if (F.vcu < NUNITS) { al.init(H, D, (F.vcu / NTN) * 128, F.tid >> 3, (F.tid >> 3) + 64, dma_kc(F.tid)); Bp = W + (size_t)((F.vcu % NTN) * 256) * D; gemm3_prefetch(F, al, Bp, D); }
    for (int u = F.vcu; u < NUNITS; u += F.G) {
        const int mt = u / NTN, nt = u % NTN, m0 = mt * 128, n0 = nt * 256;
        f32x4 acc[4][4];
        gemm3_tile<true>(F, al, Bp, D, acc);
        { const int un = u + F.G; if (un < NUNITS) { al.init(H, D, (un / NTN) * 128, F.tid >> 3, (F.tid >> 3) + 64, dma_kc(F.tid)); Bp = W + (size_t)((un % NTN) * 256) * D; gemm3_prefetch(F, al, Bp, D); } }
        const bool isy = n0 < 1024;
        bf16* dst = isy ? YG : U; const int nb = isy ? n0 : n0 - 1024;
#pragma unroll
        for (int mi = 0; mi < 4; ++mi) {
            const int row = m0 + wr * 64 + mi * 16 + fr;
#pragma unroll
            for (int ni = 0; ni < 4; ++ni) {
                f32x4 v = acc[mi][ni];
                if (isy) { v.x = gelu_tanh(v.x); v.y = gelu_tanh(v.y); v.z = gelu_tanh(v.z); v.w = gelu_tanh(v.w); }
                u32x2 o; o.x = pk2(v.x, v.y); o.y = pk2(v.z, v.w);
                *(u32x2*)(dst + (size_t)row * D + nb + wc * 64 + ni * 16 + fq * 4) = o;
            }
        }
    }
}

__device__ __forceinline__ float neg_expm1(float x) {
    const float p = 1.0f + x * (0.5f + x * (0.16666667f + x * (0.041666668f + x * (0.0083333338f + x * 0.0013888889f))));
    const float ser = -x * p, big = 1.0f - __expf(x);
    return x > -0.5f ? ser : big;
}
__device__ __forceinline__ void phase_scan(Frame& F) {
    const Args& A = *F.a;
    const int wi = F.vcu;
    if (wi >= 256) return;
    const int b = wi >> 6, n = (wi >> 3) & 7, d = (wi >> 2) & 1, q = wi & 3;
    const int tid = F.tid, lane = F.lane, w = F.wave, fr = lane & 15, fq = lane >> 4;
    LAS char* RAW = F.lds;
    LAS char* AT = F.lds + 33792;
    LAS float* AGG = (LAS float*)(F.lds + 66560);
    LAS float* CIN = (LAS float*)(F.lds + 74752);
    const bf16* U = (const bf16*)(F.ws + WS_U);
    bf16* HO = (bf16*)(F.ws + (d ? WS_HB : WS_HF));
    const int chbase = n * 128, och = chbase + q * 32;
    const bf16* GT = (const bf16*)(F.ws + WS_GATE);
    LAS char* BT = F.lds + 81920;
#pragma unroll
    for (int i = 0; i < 2; ++i) {
        const int idx = tid + 512 * i, jrow = idx >> 4, c = idx & 15, nb = jrow >> 4, f2 = jrow & 15;
        *(LAS u32x4*)(BT + jrow * 256 + ((c ^ f2) << 4)) = *(const u32x4*)(GT + ((size_t)(((d * 2 + (nb >> 1)) * 8 + n) * 128 + q * 32 + (nb & 1) * 16 + f2)) * 128 + c * 8);
    }
    float ba[2], bi[2], sp8[2];
#pragma unroll
    for (int h = 0; h < 2; ++h) {
        const int ch = och + h * 16 + fr;
        ba[h] = A.in[I_GAB][d * 1024 + ch]; bi[h] = A.in[I_GXB][d * 1024 + ch];
        sp8[h] = 8.0f * log1pf(expf(-A.in[I_LAM][d * 1024 + ch]));
    }
    const int c8 = tid & 15, r0 = tid >> 4;
    LAS float* CW = (LAS float*)(F.lds + 78848);
    (void)CW;
    float cw[4][8], cb[8];
#pragma unroll
    for (int k = 0; k < 4; ++k) {
        const f32x4 a0 = *(const f32x4*)(A.in[I_CONVW] + k * 1024 + chbase + c8 * 8), a1 = *(const f32x4*)(A.in[I_CONVW] + k * 1024 + chbase + c8 * 8 + 4);
        cw[k][0] = a0.x; cw[k][1] = a0.y; cw[k][2] = a0.z; cw[k][3] = a0.w; cw[k][4] = a1.x; cw[k][5] = a1.y; cw[k][6] = a1.z; cw[k][7] = a1.w;
    }
    { const f32x4 a0 = *(const f32x4*)(A.in[I_CONVB] + chbase + c8 * 8), a1 = *(const f32x4*)(A.in[I_CONVB] + chbase + c8 * 8 + 4);
      cb[0] = a0.x; cb[1] = a0.y; cb[2] = a0.z; cb[3] = a0.w; cb[4] = a1.x; cb[5] = a1.y; cb[6] = a1.z; cb[7] = a1.w; }

    float hcar = 0.f;
    u32x4 pre[5];
    LAS float* cscr = (LAS float*)(F.lds + 98304 + w * 4224);
    const int cgw = F.vcu * NWAVES + w, CNGW = F.G * NWAVES;
    int cit = cgw;
    TDesc cd2; f32x4 crg2[4]; bool chas2 = false;
    for (int step = 0; step < 34; ++step) {
        TDesc cd; f32x4 crg[4]; const bool chas = cit < ND_SCAN;
        if (chas) { cd = decode_deferred(F, cit); tr2_load(cd, lane, crg); cit += CNGW; }
        int segbase, seglen, tile;
        if (step < 2) { segbase = NX + b * CL; seglen = CL; tile = d ? (1 - step) : step; }
        else { segbase = b * S; seglen = S; tile = d ? (33 - step) : (step - 2); }
        const int t0 = tile * 128;
        if (step == 0) {
#pragma unroll
            for (int i = 0; i < 5; ++i) {
                const int idx = tid + 512 * i; const int row = idx >> 4, c = idx & 15; const int t = t0 - 2 + row;
                u32x4 v = (u32x4){0u, 0u, 0u, 0u};
                if (idx < 2112 && t >= 0 && t < seglen) v = *(const u32x4*)(U + (size_t)(segbase + t) * D + chbase + c * 8);
                pre[i] = v;
            }
        }
#pragma unroll
        for (int i = 0; i < 5; ++i) { const int idx = tid + 512 * i; if (idx < 2112) *(LAS u32x4*)(RAW + idx * 16) = pre[i]; }
        __syncthreads();
        if (step + 1 < 34) {
            const int s1 = step + 1; int sb1, sl1, tl1;
            if (s1 < 2) { sb1 = NX + b * CL; sl1 = CL; tl1 = d ? (1 - s1) : s1; }
            else { sb1 = b * S; sl1 = S; tl1 = d ? (33 - s1) : (s1 - 2); }
            const int t1 = tl1 * 128;
#pragma unroll
            for (int i = 0; i < 5; ++i) {
                const int idx = tid + 512 * i; const int row = idx >> 4, c = idx & 15; const int t = t1 - 2 + row;
                u32x4 v = (u32x4){0u, 0u, 0u, 0u};
                if (idx < 2112 && t >= 0 && t < sl1) v = *(const u32x4*)(U + (size_t)(sb1 + t) * D + chbase + c * 8);
                pre[i] = v;
            }
        }
#pragma unroll
        for (int i = 0; i < 4; ++i) {
            const int r = r0 + 32 * i;
            float o[8];
#pragma unroll
            for (int j = 0; j < 8; ++j) o[j] = cb[j];
#pragma unroll
            for (int k = 0; k < 4; ++k) {
                const u32x4 x = *(const LAS u32x4*)(RAW + (r + k) * 256 + c8 * 16);
#pragma unroll
                for (int p = 0; p < 4; ++p) { o[2 * p] += cw[k][2 * p] * bflo(x[p]); o[2 * p + 1] += cw[k][2 * p + 1] * bfhi(x[p]); }
            }
            u32x4 ov; ov.x = pk2(o[0], o[1]); ov.y = pk2(o[2], o[3]); ov.z = pk2(o[4], o[5]); ov.w = pk2(o[6], o[7]);
            *(LAS u32x4*)(AT + r * 256 + ((c8 ^ (r & 15)) << 4)) = ov;
        }
        __syncthreads();
        f32x4 acc[4];
#pragma unroll
        for (int nb = 0; nb < 4; ++nb) acc[nb] = (f32x4){0.f, 0.f, 0.f, 0.f};
#pragma unroll
        for (int ks = 0; ks < 4; ++ks) {
            const int row = 16 * w + fr;
            const bf16x8 af = *(const LAS bf16x8*)(AT + row * 256 + (((4 * ks + fq) ^ fr) << 4));
#pragma unroll
            for (int nb = 0; nb < 4; ++nb) {
                const bf16x8 bq = *(const LAS bf16x8*)(BT + (nb * 16 + fr) * 256 + (((4 * ks + fq) ^ fr) << 4));
                acc[nb] = __builtin_amdgcn_mfma_f32_16x16x32_bf16(af, bq, acc[nb], 0, 0, 0);
            }
        }
        float av[2][4], bv[2][4];
#pragma unroll
        for (int h = 0; h < 2; ++h) {
            const int col = q * 32 + h * 16 + fr, chunk = col >> 3, within = col & 7;
#pragma unroll
            for (int reg = 0; reg < 4; ++reg) {
                const int tr = 16 * w + 4 * fq + reg;
                const float r_ = __builtin_amdgcn_rcpf(1.0f + __builtin_amdgcn_exp2f(-1.4426950408889634f * (acc[h][reg] + ba[h])));
                const float i_ = __builtin_amdgcn_rcpf(1.0f + __builtin_amdgcn_exp2f(-1.4426950408889634f * (acc[2 + h][reg] + bi[h])));
                const float la = -sp8[h] * r_;
                const float a_ = __builtin_amdgcn_exp2f(1.4426950408889634f * la);
                const unsigned short ub = *(const LAS unsigned short*)(AT + tr * 256 + ((chunk ^ (tr & 15)) << 4) + within * 2);
                const float uval = __builtin_bit_cast(float, (unsigned)ub << 16);
                av[h][reg] = a_;
                bv[h][reg] = __builtin_amdgcn_sqrtf(neg_expm1(2.0f * la)) * (i_ * uval);
            }
        }
        const int g = 4 * w + fq;
#pragma unroll
        for (int h = 0; h < 2; ++h) {
            float P = 1.f, Hh = 0.f;
#pragma unroll
            for (int s = 0; s < 4; ++s) { const int reg = d ? (3 - s) : s; Hh = av[h][reg] * Hh + bv[h][reg]; P *= av[h][reg]; }
            AGG[(g * 32 + h * 16 + fr) * 2 + 0] = P; AGG[(g * 32 + h * 16 + fr) * 2 + 1] = Hh;
        }
        if (chas2) tr2_finish(cd2, lane, crg2, cscr);
        chas2 = cit < ND_SCAN;
        if (chas2) { cd2 = decode_deferred(F, cit); tr2_load(cd2, lane, crg2); cit += CNGW; }
        __syncthreads();
        if (tid < 32) {
            f32x2 ag[32];
#pragma unroll
            for (int gi = 0; gi < 32; ++gi) ag[gi] = *(const LAS f32x2*)(AGG + (gi * 32 + tid) * 2);
            float hh = hcar;
            if (d == 0) {
#pragma unroll
                for (int gi = 0; gi < 32; ++gi) { CIN[gi * 32 + tid] = hh; hh = ag[gi].x * hh + ag[gi].y; }
            } else {
#pragma unroll
                for (int gi = 31; gi >= 0; --gi) { CIN[gi * 32 + tid] = hh; hh = ag[gi].x * hh + ag[gi].y; }
            }
            hcar = hh;
        }
        __syncthreads();
#pragma unroll
        for (int h = 0; h < 2; ++h) {
            float hh = CIN[g * 32 + h * 16 + fr];
            float outv[4];
#pragma unroll
            for (int s = 0; s < 4; ++s) { const int reg = d ? (3 - s) : s; hh = av[h][reg] * hh + bv[h][reg]; outv[reg] = hh; }
#pragma unroll
            for (int reg = 0; reg < 4; ++reg) {
                const int tr = 16 * w + 4 * fq + reg;
                HO[(size_t)(segbase + t0 + tr) * D + och + h * 16 + fr] = (bf16)f2bf(outv[reg]);
            }
        }
        if (chas) tr2_finish(cd, lane, crg, cscr);
    }
    if (chas2) tr2_finish(cd2, lane, crg2, cscr);
}

__device__ __forceinline__ void phase_gemm_out0(Frame& F) {
    const Args& A = *F.a;
    const bf16* W = (const bf16*)(F.ws + WS_WOUT);
    float* XA = (float*)(F.ws + WS_XA);
    const int wr = F.wave >> 2, wc = F.wave & 3, fr = F.lane & 15, fq = F.lane >> 4;
    constexpr int NTN = 4, NUNITS = (NTOK / 128) * NTN;
    for (int u = F.vcu; u < NUNITS; u += F.G) {
        const int mt = u / NTN, nt = u % NTN, m0 = mt * 128, n0 = nt * 256;
        ALCombine al; al.init((const bf16*)(F.ws + WS_HF), (const bf16*)(F.ws + WS_HB), (const bf16*)(F.ws + WS_YG), m0, F.tid >> 3, (F.tid >> 3) + 64, (F.tid & 7) * 8);
        f32x4 acc[4][4];
        gemm_tile<true>(F, al, W + (size_t)n0 * D, D, acc);
#pragma unroll
        for (int mi = 0; mi < 4; ++mi) {
            const int row = m0 + wr * 64 + mi * 16 + fr;
            const float* src = row < NX ? A.in[I_X] + (size_t)row * D : A.in[I_CTX] + (size_t)(row - NX) * D;
            const float* gate = modp(F, 0, cond_of(row), 2);
#pragma unroll
            for (int ni = 0; ni < 4; ++ni) {
                const int col = n0 + wc * 64 + ni * 16 + fq * 4;
                const f32x4 s = *(const f32x4*)(src + col), gt = *(const f32x4*)(gate + col);
                *(f32x4*)(XA + (size_t)row * D + col) = s + gt * acc[mi][ni];
            }
        }
    }
}

__device__ __forceinline__ void route_select(const Frame& F, float (&acc)[32], float rbias, int row, LAS int* selL, int li) {
    const int lane = F.lane;
#define BFLY(S, HALF) { const bool up = (lane >> (S)) & 1; _Pragma("unroll") for (int i = 0; i < (HALF); ++i) { \
        const float keep = up ? acc[i + (HALF)] : acc[i]; const float send = up ? acc[i] : acc[i + (HALF)]; acc[i] = keep + __shfl_xor(send, 1 << (S)); } }
    BFLY(0, 16) BFLY(1, 8) BFLY(2, 4) BFLY(3, 2) BFLY(4, 1)
#undef BFLY
    const float tot = acc[0] + __shfl_xor(acc[0], 32);
    const int e = lane & 31;
    const float logit = __shfl(tot, (int)(__builtin_bitreverse32((unsigned)e) >> 27));
    const float sc = 1.0f / (1.0f + expf(-logit));
    const float ss = sc + rbias;
    float m1 = ss;
#pragma unroll
    for (int o = 1; o < 8; o <<= 1) m1 = fmaxf(m1, __shfl_xor(m1, o));
    int i1 = (ss == m1) ? e : 64;
#pragma unroll
    for (int o = 1; o < 8; o <<= 1) i1 = min(i1, __shfl_xor(i1, o));
    const float s2 = (e == i1) ? -INFINITY : ss;
    float m2 = s2;
#pragma unroll
    for (int o = 1; o < 8; o <<= 1) m2 = fmaxf(m2, __shfl_xor(m2, o));
    int i2 = (s2 == m2 && e != i1) ? e : 64;
#pragma unroll
    for (int o = 1; o < 8; o <<= 1) i2 = min(i2, __shfl_xor(i2, o));
    const float gs = m1 + m2;
    float gbest = gs;
    gbest = fmaxf(gbest, __shfl_xor(gbest, 8)); gbest = fmaxf(gbest, __shfl_xor(gbest, 16));
    int gsel = (gs == gbest) ? (e >> 3) : 64;
    gsel = min(gsel, __shfl_xor(gsel, 8)); gsel = min(gsel, __shfl_xor(gsel, 16));
    const int e0 = __shfl(i1, gsel * 8) & 31, e1 = __shfl(i2, gsel * 8) & 31;
    const float w0 = __shfl(sc, e0), w1 = __shfl(sc, e1);
    if (lane == 0) {
        const float inv = 1.0f / (w0 + w1);
        selL[li * 2] = e0; selL[li * 2 + 1] = e1;
        ((float2*)(F.ws + WS_WT))[row] = make_float2(w0 * inv, w1 * inv);
        ((int2*)(F.ws + WS_SEL))[row] = make_int2(e0, e1);
    }
}

template <int LAYER>
__device__ __forceinline__ void phase_route(Frame& F) {
    const Args& A = *F.a;
    constexpr int NT = LAYER == 0 ? NTOK : NX;
    constexpr int PER = NT / 256;
    LAS char* RW = F.lds;
    LAS int* selL = (LAS int*)(F.lds + LDS_AUX);
    LAS int* rankL = selL + 2 * 68;
    const int tid = F.tid, lane = F.lane;
    {
        f32x4 t[16];
#pragma unroll
        for (int i = 0; i < 16; ++i) { const int idx = tid + 512 * i; t[i] = *(const f32x4*)(A.in[I_RW] + (size_t)(idx >> 3) * 32 + (idx & 7) * 4); }
#pragma unroll
        for (int i = 0; i < 16; ++i) {
            const int idx = tid + 512 * i, k = idx >> 3, e4 = idx & 7;
            const int rho = (((k >> 8) * 4 + (k & 3)) << 6) + ((k >> 2) & 63);
            *(LAS f32x4*)(RW + rho * 128 + ((e4 ^ ((rho >> 1) & 7)) << 4)) = t[i];
        }
    }
    __syncthreads();
    const int blk = F.vcu;
    if (blk < 256) {
        const float* XA = (const float*)(F.ws + WS_XA);
        bf16* H = (bf16*)(F.ws + WS_H);
        const float rbias = A.in[I_RB][lane & 31];
        for (int pi = F.wave; pi < PER / 2; pi += NWAVES) {
            const int li = 2 * pi, row = blk * PER + li;
            const int c = cond_of(row);
            f32x4 va[4], vb[4];
            load_row4(XA + (size_t)row * D, lane, va); load_row4(XA + (size_t)(row + 1) * D, lane, vb);
            const float ra = row_rstd(va), rb = row_rstd(vb);
            row_modulate_store(va, ra, A.in[I_N2G] + LAYER * D, modp(F, LAYER, c, 4), modp(F, LAYER, c, 3), H + (size_t)row * D, lane);
            row_modulate_store(vb, rb, A.in[I_N2G] + LAYER * D, modp(F, LAYER, c, 4), modp(F, LAYER, c, 3), H + (size_t)(row + 1) * D, lane);
            float acca[32], accb[32];
#pragma unroll
            for (int e = 0; e < 32; ++e) { acca[e] = 0.f; accb[e] = 0.f; }
#pragma unroll 1
            for (int jc = 0; jc < 16; ++jc) {
                const int j = jc >> 2, cc = jc & 3;
                f32x4 ha4 = va[0], hb4 = vb[0];
                if (j == 1) { ha4 = va[1]; hb4 = vb[1]; }
                if (j == 2) { ha4 = va[2]; hb4 = vb[2]; }
                if (j == 3) { ha4 = va[3]; hb4 = vb[3]; }
                float ha = ha4.x, hb = hb4.x;
                if (cc == 1) { ha = ha4.y; hb = hb4.y; }
                if (cc == 2) { ha = ha4.z; hb = hb4.z; }
                if (cc == 3) { ha = ha4.w; hb = hb4.w; }
                const int rho = jc * 64 + lane;
                const LAS char* rp = RW + rho * 128; const int key = (rho >> 1) & 7;
                f32x4 w8[8];
#pragma unroll
                for (int e4 = 0; e4 < 8; ++e4) w8[e4] = *(const LAS f32x4*)(rp + ((e4 ^ key) << 4));
#pragma unroll
                for (int e4 = 0; e4 < 8; ++e4) {
                    acca[e4 * 4 + 0] += ha * w8[e4].x; acca[e4 * 4 + 1] += ha * w8[e4].y; acca[e4 * 4 + 2] += ha * w8[e4].z; acca[e4 * 4 + 3] += ha * w8[e4].w;
                    accb[e4 * 4 + 0] += hb * w8[e4].x; accb[e4 * 4 + 1] += hb * w8[e4].y; accb[e4 * 4 + 2] += hb * w8[e4].z; accb[e4 * 4 + 3] += hb * w8[e4].w;
                }
            }
            route_select(F, acca, rbias, row, selL, li);
            route_select(F, accb, rbias, row + 1, selL, li + 1);
        }
        __syncthreads();
        if (tid < 32) {
            int cnt = 0;
            for (int i = 0; i < 2 * PER; ++i) { if (selL[i] == tid) { rankL[i] = cnt; ++cnt; } }
            ((int*)(F.ws + WS_BLKCNT))[blk * 32 + tid] = cnt;
        }
        __syncthreads();
        for (int i = tid; i < PER; i += NTHREADS) ((int2*)(F.ws + WS_LRANK))[blk * PER + i] = make_int2(rankL[2 * i], rankL[2 * i + 1]);
    }
}

template <int LAYER>
__device__ __forceinline__ void phase_slots(Frame& F) {
    constexpr int NT = LAYER == 0 ? NTOK : NX;
    constexpr int PER = NT / 256;
    LAS int* part = (LAS int*)F.lds;
    LAS int* tot = part + 1024;
    LAS int* base = tot + 32;
    LAS int* pst = base + 32;
    const int tid = F.tid, blk = F.vcu;
    const int* bc = (const int*)(F.ws + WS_BLKCNT);
    {
        const int e = tid & 31, p = tid >> 5;
        int st = 0, sb = 0;
        for (int b2 = p; b2 < 256; b2 += 16) { const int c = bc[b2 * 32 + e]; st += c; sb += (b2 < blk) ? c : 0; }
        part[p * 32 + e] = st; part[512 + p * 32 + e] = sb;
    }
    __syncthreads();
    if (tid < 32) { int st = 0, sb = 0; for (int p = 0; p < 16; ++p) { st += part[p * 32 + tid]; sb += part[512 + p * 32 + tid]; } tot[tid] = st; base[tid] = sb; }
    __syncthreads();
    if (tid == 0) { int s = 0; for (int e = 0; e < 32; ++e) { pst[e] = s; s += (tot[e] + 127) & ~127; } pst[32] = s; }
    __syncthreads();
    int* slot_tok = (int*)(F.ws + WS_SLOTTOK); float* slot_w = (float*)(F.ws + WS_SLOTW);
    if (blk == 0 && tid < 33) ((int*)(F.ws + WS_PSTART))[tid] = pst[tid];
    if (blk < 256) {
        for (int i = tid; i < PER; i += NTHREADS) {
            const int t = blk * PER + i;
            const int2 se = ((const int2*)(F.ws + WS_SEL))[t]; const int2 lr = ((const int2*)(F.ws + WS_LRANK))[t]; const float2 wt = ((const float2*)(F.ws + WS_WT))[t];
            const int s0 = pst[se.x] + base[se.x] + lr.x, s1 = pst[se.y] + base[se.y] + lr.y;
            slot_tok[s0] = t; slot_w[s0] = wt.x; slot_tok[s1] = t; slot_w[s1] = wt.y;
            ((int2*)(F.ws + WS_TOKSLOT))[t] = make_int2(s0, s1);
        }
    }
    if (blk < 32) {
        const int lo = pst[blk] + tot[blk], hi = pst[blk + 1];
        for (int s = lo + tid; s < hi; s += NTHREADS) { slot_tok[s] = 0; slot_w[s] = 0.f; }
    }
}

template <int LAYER>
__device__ __forceinline__ void phase_moe_up(Frame& F) {
    LAS int* pst = (LAS int*)(F.lds + LDS_AUX);
    if (F.tid < 33) pst[F.tid] = ((const int*)(F.ws + WS_PSTART))[F.tid];
    __syncthreads();
    const int ntiles = pst[32] >> 7, nunits = ntiles * 4;
    const bf16* H = (const bf16*)(F.ws + WS_H);
    const bf16* W = (const bf16*)(F.ws + WS_WUP) + (size_t)LAYER * 32 * 1024 * 1024;
    const int* slot_tok = (const int*)(F.ws + WS_SLOTTOK); const float* slot_w = (const float*)(F.ws + WS_SLOTW);
    bf16* G = (bf16*)(F.ws + WS_G);
    const int wr = F.wave >> 2, wc = F.wave & 3, fr = F.lane & 15, fq = F.lane >> 4;
    ALGather al; const bf16* Bp = W;
    auto setup = [&](int uu) {
        const int m0_ = (uu >> 2) * 128; int e = 0;
        for (int x = 1; x < 32; ++x) e = (pst[x] <= m0_) ? x : e;
        al.init(H, D, slot_tok, m0_, F.tid >> 3, (F.tid >> 3) + 64, dma_kc(F.tid));
        Bp = W + ((size_t)e * 1024 + (uu & 3) * 256) * D;
        gemm3_prefetch(F, al, Bp, D);
    };
    if (F.vcu < nunits) setup(F.vcu);
    for (int u = F.vcu; u < nunits; u += F.G) {
        const int mt = u >> 2, j = u & 3, m0 = mt * 128;
        f32x4 acc[4][4];
        gemm3_tile<true>(F, al, Bp, D, acc);
        if (u + F.G < nunits) setup(u + F.G);
#pragma unroll
        for (int mi = 0; mi < 4; ++mi) {
            const int row = m0 + wr * 64 + mi * 16 + fr;
            const float wgt = slot_w[row];
#pragma unroll
            for (int p = 0; p < 2; ++p) {
                const f32x4 g = acc[mi][2 * p], uu = acc[mi][2 * p + 1];
                float o[4];
#pragma unroll
                for (int c = 0; c < 4; ++c) o[c] = g[c] / (1.0f + __expf(-g[c])) * uu[c] * wgt;
                u32x2 ov; ov.x = pk2(o[0], o[1]); ov.y = pk2(o[2], o[3]);
                *(u32x2*)(G + (size_t)row * DEXP + j * 128 + wc * 32 + p * 16 + fq * 4) = ov;
            }
        }
    }
}

template <int LAYER>
__device__ __forceinline__ void phase_moe_down(Frame& F) {
    LAS int* pst = (LAS int*)(F.lds + LDS_AUX);
    if (F.tid < 33) pst[F.tid] = ((const int*)(F.ws + WS_PSTART))[F.tid];
    __syncthreads();
    const int ntiles = pst[32] >> 7, nunits = ntiles * 4;
    const bf16* G = (const bf16*)(F.ws + WS_G);
    const bf16* W = (const bf16*)(F.ws + WS_WDN) + (size_t)LAYER * 32 * 1024 * 512;
    bf16* Y = (bf16*)(F.ws + WS_Y);
    const int wr = F.wave >> 2, wc = F.wave & 3, fr = F.lane & 15, fq = F.lane >> 4;
    ALDense al; const bf16* Bp = W;
    auto setup = [&](int uu) {
        const int m0_ = (uu >> 2) * 128; int e = 0;
        for (int x = 1; x < 32; ++x) e = (pst[x] <= m0_) ? x : e;
        al.init(G, DEXP, m0_, F.tid >> 3, (F.tid >> 3) + 64, dma_kc(F.tid));
        Bp = W + ((size_t)e * 1024 + (uu & 3) * 256) * DEXP;
        gemm3_prefetch(F, al, Bp, DEXP);
    };
    if (F.vcu < nunits) setup(F.vcu);
    for (int u = F.vcu; u < nunits; u += F.G) {
        const int mt = u >> 2, j = u & 3, m0 = mt * 128, n0 = j * 256;
        f32x4 acc[4][4];
        gemm3_tile<true>(F, al, Bp, DEXP, acc);
        if (u + F.G < nunits) setup(u + F.G);
#pragma unroll
        for (int mi = 0; mi < 4; ++mi) {
            const int row = m0 + wr * 64 + mi * 16 + fr;
#pragma unroll
            for (int ni = 0; ni < 4; ++ni) {
                const f32x4 v = acc[mi][ni];
                u32x2 o; o.x = pk2(v.x, v.y); o.y = pk2(v.z, v.w);
                *(u32x2*)(Y + (size_t)row * D + n0 + wc * 64 + ni * 16 + fq * 4) = o;
            }
        }
    }
}

struct CRow { f32x4 x[4]; u32x2 y0[4], y1[4]; };
__device__ __forceinline__ void crow_load(const Frame& F, int row, int2 ts, CRow& r) {
    const float* XA = (const float*)(F.ws + WS_XA); const bf16* Y = (const bf16*)(F.ws + WS_Y);
#pragma unroll
    for (int j = 0; j < 4; ++j) {
        const int c0 = 4 * F.lane + 256 * j;
        r.x[j] = *(const f32x4*)(XA + (size_t)row * D + c0);
        r.y0[j] = *(const u32x2*)(Y + (size_t)ts.x * D + c0); r.y1[j] = *(const u32x2*)(Y + (size_t)ts.y * D + c0);
    }
}
__device__ __forceinline__ void crow_combine(const Frame& F, const CRow& r, const float* gate, f32x4 (&v)[4]) {
#pragma unroll
    for (int j = 0; j < 4; ++j) {
        const int c0 = 4 * F.lane + 256 * j;
        const f32x4 gt = *(const f32x4*)(gate + c0);
        f32x4 y; y.x = bflo(r.y0[j].x) + bflo(r.y1[j].x); y.y = bfhi(r.y0[j].x) + bfhi(r.y1[j].x); y.z = bflo(r.y0[j].y) + bflo(r.y1[j].y); y.w = bfhi(r.y0[j].y) + bfhi(r.y1[j].y);
        v[j] = r.x[j] + gt * y;
    }
}

__device__ __forceinline__ void phase_combine0(Frame& F) {
    const Args& A = *F.a;
    const int gw = F.vcu * NWAVES + F.wave, NGW = F.G * NWAVES;
    float* XA = (float*)(F.ws + WS_XA); bf16* H = (bf16*)(F.ws + WS_H);
    const int2* TS = (const int2*)(F.ws + WS_TOKSLOT);
    CRow cn; int2 tsn = make_int2(0, 0);
    if (gw < NTOK) crow_load(F, gw, TS[gw], cn);
    if (gw + NGW < NTOK) tsn = TS[gw + NGW];
    for (int row = gw; row < NTOK; row += NGW) {
        const int c = cond_of(row);
        const CRow cr = cn;
        const int nr = row + NGW;
        if (nr < NTOK) crow_load(F, nr, tsn, cn);
        if (nr + NGW < NTOK) tsn = TS[nr + NGW];
        f32x4 v[4];
        crow_combine(F, cr, modp(F, 0, c, 5), v);
#pragma unroll
        for (int j = 0; j < 4; ++j) *(f32x4*)(XA + (size_t)row * D + 4 * F.lane + 256 * j) = v[j];
        const float rstd = row_rstd(v);
        row_modulate_store(v, rstd, A.in[I_N1G] + D, modp(F, 1, c, 1), modp(F, 1, c, 0), H + (size_t)row * D, F.lane);
    }
}

constexpr float QSCALE = 0.125f * 1.4426950408889634f;
__device__ __forceinline__ void phase_qkv(Frame& F) {
    LAS float* CS = (LAS float*)(F.lds + LDS_AUX);
    for (int i = F.tid; i < 1024; i += NTHREADS) {
        const int p = i >> 4, f = i & 15;
        const float inv = 1.0f / powf(10000.0f, (float)f / 16.0f);
        const float ang = (float)p * inv;
        const double rev = (double)ang * 0.15915494309189535;
        const float fr_ = (float)(rev - floor(rev));
        CS[i * 2] = __builtin_amdgcn_cosf(fr_); CS[i * 2 + 1] = __builtin_amdgcn_sinf(fr_);
    }
    __syncthreads();
    const bf16* H = (const bf16*)(F.ws + WS_H); const bf16* W = (const bf16*)(F.ws + WS_WQKV);
    bf16* Q = (bf16*)(F.ws + WS_Q); bf16* Kb = (bf16*)(F.ws + WS_K); bf16* VT = (bf16*)(F.ws + WS_VT);
    const int wr = F.wave >> 2, wc = F.wave & 3, fr = F.lane & 15, fq = F.lane >> 4;
    constexpr int NTN = 12, NUX = (NX / 128) * NTN, NUNITS = NUX + (NC / 128) * 8;
    ALDense al; const bf16* Bp = W;
    auto setup = [&](int uu) {
        const int mt_ = uu < NUX ? uu / NTN : 128 + ((uu - NUX) >> 3), nt_ = uu < NUX ? uu % NTN : 4 + ((uu - NUX) & 7);
        al.init(H, D, mt_ * 128, F.tid >> 3, (F.tid >> 3) + 64, dma_kc(F.tid));
        Bp = W + (size_t)(nt_ * 256) * D;
        gemm3_prefetch(F, al, Bp, D);
    };
    if (F.vcu < NUNITS) setup(F.vcu);
    for (int u = F.vcu; u < NUNITS; u += F.G) {
        const int mt = u < NUX ? u / NTN : 128 + ((u - NUX) >> 3), nt = u < NUX ? u % NTN : 4 + ((u - NUX) & 7), m0 = mt * 128, n0 = nt * 256;
        const bool isctx = m0 >= NX;
        f32x4 acc[4][4];
        if (nt < 8) gemm3_tile<true>(F, al, Bp, D, acc); else gemm3_tile<false>(F, al, Bp, D, acc);
        if (u + F.G < NUNITS) setup(u + F.G);
        if (nt < 8) {
            const int hi2 = ((n0 & 1023) >> 6) + wc;
            const bool isq = nt < 4;
#pragma unroll
            for (int mi = 0; mi < 4; ++mi) {
                const int row = m0 + wr * 64 + mi * 16 + fr;
                int b, pos;
                if (!isctx) { b = row >> 12; pos = row & 4095; } else { b = (row - NX) >> 8; pos = S + ((row - NX) & 255); }
                f32x4 o[4];
                if (!isctx) {
                    const int rp = pos >> 6, cp = pos & 63;
#pragma unroll
                    for (int ni = 0; ni < 4; ++ni) {
                        const int p = (ni >> 1) ? cp : rp;
                        const f32x4 xv = acc[mi][ni], pv = acc[mi][ni ^ 1];
#pragma unroll
                        for (int c = 0; c < 4; ++c) {
                            const float cs = CS[(p * 16 + fq * 4 + c) * 2], sn = CS[(p * 16 + fq * 4 + c) * 2 + 1];
                            o[ni][c] = xv[c] * cs + ((ni & 1) ? pv[c] : -pv[c]) * sn;
                        }
                    }
                } else {
#pragma unroll
                    for (int ni = 0; ni < 4; ++ni) o[ni] = acc[mi][ni];
                }
                bf16* dst = isq ? Q + ((size_t)(b * 16 + hi2) * S + pos) * 64 : Kb + ((size_t)(b * 16 + hi2) * KEYS + pos) * 64;
                const float scl = isq ? QSCALE : 1.0f;
#pragma unroll
                for (int ni = 0; ni < 4; ++ni) {
                    u32x2 ov; ov.x = pk2(o[ni].x * scl, o[ni].y * scl); ov.y = pk2(o[ni].z * scl, o[ni].w * scl);
                    *(u32x2*)(dst + ni * 16 + fq * 4) = ov;
                }
            }
        } else {
#pragma unroll
            for (int mi = 0; mi < 4; ++mi) {
                const int row = m0 + wr * 64 + mi * 16 + fq * 4;
                int b, pos;
                if (!isctx) { b = row >> 12; pos = row & 4095; } else { b = (row - NX) >> 8; pos = S + ((row - NX) & 255); }
#pragma unroll
                for (int ni = 0; ni < 4; ++ni) {
                    const int col = (n0 - 2048) + wc * 64 + ni * 16 + fr, h = col >> 7, vd = col & 127;
                    const f32x4 v = acc[mi][ni];
                    u32x2 ov; ov.x = pk2(v.x, v.y); ov.y = pk2(v.z, v.w);
                    *(u32x2*)(VT + ((size_t)(b * 8 + h) * 128 + vd) * KEYS + pos) = ov;
                }
            }
        }
    }
}

constexpr int ATT_STAGE = 32768;
__device__ __forceinline__ int crow(int r, int hi) { return (r & 3) + 8 * (r >> 2) + 4 * hi; }
__device__ __forceinline__ void phase_attn(Frame& F) {
    const Args& A = *F.a;
    const int tid = F.tid, lane = F.lane, w = F.wave, r32 = lane & 31, hi = lane >> 5;
    const int mp = w >> 2, wq = w & 3;
    LAS char* lds = F.lds;
    float lam;
    { const float* dl = A.in[I_DALAM]; const float s1 = wave_sum(dl[lane] * dl[64 + lane]), s2 = wave_sum(dl[128 + lane] * dl[192 + lane]);
      lam = expf(s1) - expf(s2) + (0.8f - 0.6f * expf(-0.3f)); }
    const float oscale = 1.0f - (0.8f - 0.6f * expf(-0.3f));
    const bf16* Q = (const bf16*)(F.ws + WS_Q); const bf16* Kb = (const bf16*)(F.ws + WS_K); const bf16* VT = (const bf16*)(F.ws + WS_VT);
    bf16* AO = (bf16*)(F.ws + WS_AO);
    constexpr int NUNITS = NB * 8 * (S / 128), NTILES = KEYS / 64;
    LAS char* cbuf = lds + 65536 + w * 4096;
    const int cgw = F.vcu * NWAVES + w, CNGW = F.G * NWAVES;
    int cit = cgw; bool chas = cit < ND_ATTN;
    if (chas) { const TDesc cd = decode_moe(F, cit, 1); tr3_dma(cd, lane, cbuf); }
    for (int u = F.vcu; u < NUNITS; u += F.G) {
        const int bh = u >> 5, qb = u & 31, q0 = qb * 128;
        const bf16* Kg[2]; Kg[0] = Kb + (size_t)(bh * 2 + 0) * KEYS * 64; Kg[1] = Kb + (size_t)(bh * 2 + 1) * KEYS * 64;
        const bf16* Vg = VT + (size_t)bh * 128 * KEYS;
        LAS char* qlds = lds + 98304 + w * 4096;
        { const bf16* qp = Q + ((size_t)(bh * 2 + mp) * S + q0 + wq * 32 + r32) * 64 + hi * 8;
#pragma unroll
          for (int ks = 0; ks < 4; ++ks) __builtin_amdgcn_global_load_lds((const unsigned*)(qp + ks * 16), (LAS unsigned*)(qlds + ks * 1024), 16, 0, 0); }
        f32x16 o[4];
#pragma unroll
        for (int vb = 0; vb < 4; ++vb)
#pragma unroll
            for (int r = 0; r < 16; ++r) o[vb][r] = 0.f;
        float mrun = 0.f, lrun = 0.f;
        const int drow = w * 8 + (lane >> 3), dch = ((lane & 7) ^ ((drow >> 1) & 7)) * 8;
        const bf16* gk0 = Kg[0] + (size_t)drow * 64 + dch; const bf16* gk1 = Kg[1] + (size_t)drow * 64 + dch;
        const bf16* gv0 = Vg + (size_t)drow * KEYS + dch; const bf16* gv1 = Vg + (size_t)(64 + drow) * KEYS + dch;
#define ATT_DMA(t_, st_) do { LAS char* sb_ = lds + (st_) * ATT_STAGE + w * 1024; \
            __builtin_amdgcn_global_load_lds((const unsigned*)(gk0 + (size_t)(t_) * 64 * 64), (LAS unsigned*)(sb_), 16, 0, 0); \
            __builtin_amdgcn_global_load_lds((const unsigned*)(gk1 + (size_t)(t_) * 64 * 64), (LAS unsigned*)(sb_ + 8192), 16, 0, 0); \
            __builtin_amdgcn_global_load_lds((const unsigned*)(gv0 + (t_) * 64), (LAS unsigned*)(sb_ + 16384), 16, 0, 0); \
            __builtin_amdgcn_global_load_lds((const unsigned*)(gv1 + (t_) * 64), (LAS unsigned*)(sb_ + 16384 + 8192), 16, 0, 0); } while (0)
        ATT_DMA(0, 0);
        __syncthreads();
        for (int t = 0; t < NTILES; ++t) {
            const int st = t & 1;
            if (t + 1 < NTILES) ATT_DMA(t + 1, st ^ 1);
            const LAS char* Kt = lds + st * ATT_STAGE + mp * 8192;
            const LAS char* Vt = lds + st * ATT_STAGE + 16384;
            f32x16 s0, s1;
            { const float nm = -mrun;
#pragma unroll
              for (int r = 0; r < 16; ++r) { s0[r] = nm; s1[r] = nm; } }
            bf16x8 kf[8], qf[4];
#pragma unroll
            for (int ks = 0; ks < 4; ++ks) qf[ks] = *(const LAS bf16x8*)(qlds + ks * 1024 + lane * 16);
#pragma unroll
            for (int ks = 0; ks < 4; ++ks) {
                kf[2 * ks] = *(const LAS bf16x8*)(Kt + swz128(r32, 2 * ks + hi));
                kf[2 * ks + 1] = *(const LAS bf16x8*)(Kt + swz128(32 + r32, 2 * ks + hi));
            }
            u32x4 vf[2][4];
#define VLOAD(dst, vb_) do { const int vrow_ = (vb_) * 32 + r32; _Pragma("unroll") for (int kk_ = 0; kk_ < 4; ++kk_) { \
                const u32x2 lo_ = *(const LAS u32x2*)(Vt + swz128(vrow_, 2 * kk_) + 8 * hi); const u32x2 hi_ = *(const LAS u32x2*)(Vt + swz128(vrow_, 2 * kk_ + 1) + 8 * hi); \
                dst[kk_].x = lo_.x; dst[kk_].y = lo_.y; dst[kk_].z = hi_.x; dst[kk_].w = hi_.y; } } while (0)
            VLOAD(vf[0], 0);
            __builtin_amdgcn_sched_barrier(0);
#pragma unroll
            for (int ks = 0; ks < 4; ++ks) {
                s0 = __builtin_amdgcn_mfma_f32_32x32x16_bf16(kf[2 * ks], qf[ks], s0, 0, 0, 0);
                s1 = __builtin_amdgcn_mfma_f32_32x32x16_bf16(kf[2 * ks + 1], qf[ks], s1, 0, 0, 0);
            }
            float mx = fmaxf(s0[0], s1[0]);
#pragma unroll
            for (int r = 1; r < 16; ++r) mx = fmaxf(mx, fmaxf(s0[r], s1[r]));
            { const auto rr = __builtin_amdgcn_permlane32_swap(__builtin_bit_cast(unsigned, mx), __builtin_bit_cast(unsigned, mx), false, false);
              mx = fmaxf(__builtin_bit_cast(float, rr[0]), __builtin_bit_cast(float, rr[1])); }
            if (t == 0 || __any(mx > 8.0f)) {
                const float dl = (t == 0) ? mx : fmaxf(mx, 0.f);
                mrun += dl;
#pragma unroll
                for (int r = 0; r < 16; ++r) { s0[r] -= dl; s1[r] -= dl; }
                if (t > 0) {
                    const float f = __builtin_amdgcn_exp2f(-dl);
                    lrun *= f;
#pragma unroll
                    for (int vb = 0; vb < 4; ++vb)
#pragma unroll
                        for (int r = 0; r < 16; ++r) o[vb][r] *= f;
                }
            }
            float psum = 0.f;
#pragma unroll
            for (int r = 0; r < 16; ++r) { s0[r] = __builtin_amdgcn_exp2f(s0[r]); s1[r] = __builtin_amdgcn_exp2f(s1[r]); psum += s0[r] + s1[r]; }
            lrun += psum;
            bf16x8 pf[4];
#pragma unroll
            for (int s = 0; s < 2; ++s) {
                u32x4 a, b2;
                a.x = pk2(s0[8 * s + 0], s0[8 * s + 1]); a.y = pk2(s0[8 * s + 2], s0[8 * s + 3]); a.z = pk2(s0[8 * s + 4], s0[8 * s + 5]); a.w = pk2(s0[8 * s + 6], s0[8 * s + 7]);
                b2.x = pk2(s1[8 * s + 0], s1[8 * s + 1]); b2.y = pk2(s1[8 * s + 2], s1[8 * s + 3]); b2.z = pk2(s1[8 * s + 4], s1[8 * s + 5]); b2.w = pk2(s1[8 * s + 6], s1[8 * s + 7]);
                pf[s] = __builtin_bit_cast(bf16x8, a); pf[2 + s] = __builtin_bit_cast(bf16x8, b2);
            }
#pragma unroll
            for (int vb = 0; vb < 4; ++vb) {
                if (vb + 1 < 4) VLOAD(vf[(vb + 1) & 1], vb + 1);
                __builtin_amdgcn_sched_barrier(0);
#pragma unroll
                for (int kk = 0; kk < 4; ++kk)
                    o[vb] = __builtin_amdgcn_mfma_f32_32x32x16_bf16(__builtin_bit_cast(bf16x8, vf[vb & 1][kk]), pf[kk], o[vb], 0, 0, 0);
            }
#undef VLOAD
            __syncthreads();
            if ((t % 11) == 5 && chas) {
                asm volatile("s_waitcnt vmcnt(0)" ::: "memory");
                { const TDesc cd = decode_moe(F, cit, 1); tr3_finish(cd, lane, cbuf); }
                LDS_WAIT();
                cit += CNGW; chas = cit < ND_ATTN;
                if (chas) { const TDesc cd = decode_moe(F, cit, 1); tr3_dma(cd, lane, cbuf); }
            }
        }
#undef ATT_DMA
        lrun += __shfl_xor(lrun, 32);
        const float linv = 1.0f / lrun;
        LAS float* XO = (LAS float*)lds;
        if (mp == 1) {
#pragma unroll
            for (int vb = 0; vb < 4; ++vb)
#pragma unroll
                for (int r = 0; r < 16; ++r) XO[(wq * 64 + vb * 16 + r) * 64 + lane] = o[vb][r] * linv;
        }
        __syncthreads();
        if (mp == 0) {
            float ssq = 0.f;
#pragma unroll
            for (int vb = 0; vb < 4; ++vb)
#pragma unroll
                for (int r = 0; r < 16; ++r) { const float v = o[vb][r] * linv - lam * XO[(wq * 64 + vb * 16 + r) * 64 + lane]; o[vb][r] = v; ssq += v * v; }
            ssq += __shfl_xor(ssq, 32);
            const float rstd = rsqrtf(ssq * (1.0f / 128.0f) + EPS) * oscale;
            const int b = bh >> 3, h = bh & 7;
            bf16* dst = AO + (size_t)(b * S + q0 + wq * 32 + r32) * D + h * 128;
            const float* sg = A.in[I_SUBLN];
#pragma unroll
            for (int vb = 0; vb < 4; ++vb)
#pragma unroll
                for (int rq = 0; rq < 4; ++rq) {
                    const int v0 = vb * 32 + 8 * rq + 4 * hi;
                    const f32x4 g4 = *(const f32x4*)(sg + v0);
                    u32x2 ov; ov.x = pk2(o[vb][4 * rq] * rstd * g4.x, o[vb][4 * rq + 1] * rstd * g4.y); ov.y = pk2(o[vb][4 * rq + 2] * rstd * g4.z, o[vb][4 * rq + 3] * rstd * g4.w);
                    *(u32x2*)(dst + v0) = ov;
                }
        }
        __syncthreads();
    }
    while (chas) {
        asm volatile("s_waitcnt vmcnt(0)" ::: "memory");
        { const TDesc cd = decode_moe(F, cit, 1); tr3_finish(cd, lane, cbuf); }
        LDS_WAIT();
        cit += CNGW; chas = cit < ND_ATTN;
        if (chas) { const TDesc cd = decode_moe(F, cit, 1); tr3_dma(cd, lane, cbuf); }
    }
}

__device__ __forceinline__ void phase_gemm_wo(Frame& F) {
    const bf16* AO = (const bf16*)(F.ws + WS_AO); const bf16* W = (const bf16*)(F.ws + WS_WO);
    float* XA = (float*)(F.ws + WS_XA);
    const int wr = F.wave >> 2, wc = F.wave & 3, fr = F.lane & 15, fq = F.lane >> 4;
    constexpr int NTN = 4, NUNITS = (NX / 128) * NTN;
    ALDense al; const bf16* Bp = W;
    if (F.vcu < NUNITS) { al.init(AO, D, (F.vcu / NTN) * 128, F.tid >> 3, (F.tid >> 3) + 64, dma_kc(F.tid)); Bp = W + (size_t)((F.vcu % NTN) * 256) * D; gemm3_prefetch(F, al, Bp, D); }
    for (int u = F.vcu; u < NUNITS; u += F.G) {
        const int mt = u / NTN, nt = u % NTN, m0 = mt * 128, n0 = nt * 256;
        f32x4 acc[4][4];
        gemm3_tile<true>(F, al, Bp, D, acc);
        { const int un = u + F.G; if (un < NUNITS) { al.init(AO, D, (un / NTN) * 128, F.tid >> 3, (F.tid >> 3) + 64, dma_kc(F.tid)); Bp = W + (size_t)((un % NTN) * 256) * D; gemm3_prefetch(F, al, Bp, D); } }
#pragma unroll
        for (int mi = 0; mi < 4; ++mi) {
            const int row = m0 + wr * 64 + mi * 16 + fr;
            const float* gate = modp(F, 1, row >> 12, 2);
#pragma unroll
            for (int ni = 0; ni < 4; ++ni) {
                const int col = n0 + wc * 64 + ni * 16 + fq * 4;
                float* xp = XA + (size_t)row * D + col;
                const f32x4 s = *(const f32x4*)xp, gt = *(const f32x4*)(gate + col);
                *(f32x4*)xp = s + gt * acc[mi][ni];
            }
        }
    }
}

__device__ __forceinline__ void phase_final(Frame& F) {
    const Args& A = *F.a;
    const int gw = F.vcu * NWAVES + F.wave, NGW = F.G * NWAVES;
    const int2* TS = (const int2*)(F.ws + WS_TOKSLOT);
    CRow cn; int2 tsn = make_int2(0, 0);
    if (gw < NX) crow_load(F, gw, TS[gw], cn);
    if (gw + NGW < NX) tsn = TS[gw + NGW];
    for (int row = gw; row < NX; row += NGW) {
        const CRow cr = cn;
        const int nr = row + NGW;
        if (nr < NX) crow_load(F, nr, tsn, cn);
        if (nr + NGW < NX) tsn = TS[nr + NGW];
        f32x4 v[4];
        crow_combine(F, cr, modp(F, 1, row >> 12, 5), v);
        const float rstd = row_rstd(v);
#pragma unroll
        for (int j = 0; j < 4; ++j) {
            const int c0 = 4 * F.lane + 256 * j;
            const f32x4 g = *(const f32x4*)(A.in[I_FG] + c0);
            *(f32x4*)(A.out + (size_t)row * D + c0) = (v[j] * rstd) * g;
        }
    }
}

__global__ void __launch_bounds__(NTHREADS) fwd_kernel(Args args) {
    extern __shared__ __attribute__((aligned(16))) unsigned char smem[];
    Frame F;
    F.lds = (LAS char*)smem;
    F.tid = threadIdx.x; F.lane = F.tid & 63; F.wave = __builtin_amdgcn_readfirstlane(F.tid >> 6);
    F.G = gridDim.x; { const int bx = blockIdx.x; F.vcu = (F.G % 8 == 0) ? (bx % 8) * (F.G / 8) + bx / 8 : bx; }
    F.a = &args; F.ws = args.ws;
    volatile LAS unsigned* xbw = (volatile LAS unsigned*)(F.lds + LDS_XB);
    if (F.tid < 4) xbw[F.tid] = 0u;
    __syncthreads();
    XcdBarrier bar; bar.bar = (unsigned*)(F.ws + WS_CTL); bar.x = 0; bar.st = xbw;
    const int lo = args.ph_lo, hi = args.ph_hi;
    const bool multi = (hi - lo) > 1;
    if (multi) bar = xcd_barrier_post((unsigned*)(F.ws + WS_CTL), xbw);
#ifdef PROBE_PHASE
    unsigned long long pt0 = 0, pt1 = 0;
#define RUN_PHASE(k, call) do { if (lo <= (k) && (k) < hi) { if ((k) == PROBE_PHASE) pt0 = __builtin_amdgcn_s_memrealtime(); call; if ((k) + 1 < hi) xcd_barrier(bar); if ((k) == PROBE_PHASE) pt1 = __builtin_amdgcn_s_memrealtime(); } } while (0)
#else
#define RUN_PHASE(k, call) do { if (lo <= (k) && (k) < hi) { call; if ((k) + 1 < hi) xcd_barrier(bar); } } while (0)
#endif
    RUN_PHASE(0, phase_convert(F));
    RUN_PHASE(1, phase_prep0(F));
    RUN_PHASE(2, phase_gemm_in(F));
    RUN_PHASE(3, phase_scan(F));
    RUN_PHASE(4, phase_gemm_out0(F));
    RUN_PHASE(5, phase_route<0>(F));
    RUN_PHASE(6, phase_slots<0>(F));
    RUN_PHASE(7, phase_moe_up<0>(F));
    RUN_PHASE(8, phase_moe_down<0>(F));
    RUN_PHASE(9, phase_combine0(F));
    RUN_PHASE(10, phase_qkv(F));
    RUN_PHASE(11, phase_attn(F));
    RUN_PHASE(12, phase_gemm_wo(F));
    RUN_PHASE(13, phase_route<1>(F));
    RUN_PHASE(14, phase_slots<1>(F));
    RUN_PHASE(15, phase_moe_up<1>(F));
    RUN_PHASE(16, phase_moe_down<1>(F));
    RUN_PHASE(17, phase_final(F));
#undef RUN_PHASE
#ifdef PROBE_PHASE
    xcd_barrier(bar);
    if (blockIdx.x == 0 && F.tid == 0) args.out[0] = 40.0f + floorf((float)(pt1 - pt0) * 0.001f + 0.5f);
#endif
}

extern "C" void kernel_launch(void* const* d_in, const int* in_sizes, int n_in, void* d_out, int out_size, void* d_ws, size_t ws_size, hipStream_t stream) {
    static int grid = 0;
    if (grid == 0) {
        if (n_in != 27 || out_size != NX * D || ws_size < WS_END) { fprintf(stderr, "kernel_launch: unexpected shapes (n_in %d out %d ws %zu)\n", n_in, out_size, ws_size); grid = -1; return; }
        int dev = 0, cus = 0;
        if (hipGetDevice(&dev) != hipSuccess || hipDeviceGetAttribute(&cus, hipDeviceAttributeMultiprocessorCount, dev) != hipSuccess) { grid = -1; return; }
        if (hipFuncSetAttribute((const void*)fwd_kernel, hipFuncAttributeMaxDynamicSharedMemorySize, LDS_BYTES) != hipSuccess) { fprintf(stderr, "kernel_launch: hipFuncSetAttribute failed\n"); grid = -1; return; }
        (void)hipGetLastError();
        grid = cus < 256 ? cus : 256;
    }
    if (grid < 0) return;
    (void)hipMemsetAsync((char*)d_ws + WS_CTL, 0, CTL_ZERO_BYTES, stream);
    Args a{};
    for (int i = 0; i < 27; ++i) a.in[i] = (const float*)d_in[i];
    a.out = (float*)d_out; a.ws = (unsigned char*)d_ws;
    if (MK_N_LAUNCHES == 1) {
        a.ph_lo = 0; a.ph_hi = NPHASES;
        hipLaunchKernelGGL(fwd_kernel, dim3(grid), dim3(NTHREADS), LDS_BYTES, stream, a);
    } else {
        if (DBG_NPH == 0) { a.ph_lo = 0; a.ph_hi = 0; hipLaunchKernelGGL(fwd_kernel, dim3(grid), dim3(NTHREADS), LDS_BYTES, stream, a); }
        for (int p = 0; p < DBG_NPH; ++p) { a.ph_lo = p; a.ph_hi = p + 1; hipLaunchKernelGGL(fwd_kernel, dim3(grid), dim3(NTHREADS), LDS_BYTES, stream, a); }
    }
}
```

```cpp
#include <hip/hip_runtime.h>
#include <cstdio>
#include <cstdint>

#ifndef MK_N_LAUNCHES
#define MK_N_LAUNCHES 1
#endif

#ifndef DBG_NPH
#define DBG_NPH 18
#endif
#define LAS __attribute__((address_space(3)))
typedef unsigned short bf16;
typedef short bf16x8 __attribute__((ext_vector_type(8)));
typedef float f32x4 __attribute__((ext_vector_type(4)));
typedef float f32x16 __attribute__((ext_vector_type(16)));
typedef unsigned u32x4 __attribute__((ext_vector_type(4)));
typedef unsigned u32x2 __attribute__((ext_vector_type(2)));
typedef float f32x2 __attribute__((ext_vector_type(2)));

constexpr int D = 1024, NB = 4, S = 4096, CL = 256;
constexpr int NX = NB * S, NC = NB * CL, NTOK = NX + NC;
constexpr int NEXP = 32, DEXP = 512;
constexpr int NWAVES = 8, NTHREADS = 512;
constexpr int KEYS = S + CL;
constexpr float EPS = 1e-6f;
constexpr int PMAX = 43008;
constexpr int NPHASES = 18;

constexpr size_t MiB = 1u << 20;
constexpr size_t WS_CTL = 0, CTL_ZERO_BYTES = 64 * 1024;
constexpr size_t WS_MOD = 1 * MiB;
constexpr size_t WS_SEL = 2 * MiB;
constexpr size_t WS_WT = WS_SEL + 256 * 1024;
constexpr size_t WS_LRANK = WS_WT + 256 * 1024;
constexpr size_t WS_TOKSLOT = WS_LRANK + 256 * 1024;
constexpr size_t WS_BLKCNT = WS_TOKSLOT + 256 * 1024;
constexpr size_t WS_PSTART = WS_BLKCNT + 64 * 1024;
constexpr size_t WS_SLOTTOK = 3 * MiB + 512 * 1024;
constexpr size_t WS_SLOTW = WS_SLOTTOK + 256 * 1024;
constexpr size_t WS_WIN = 4 * MiB;
constexpr size_t WS_WOUT = 8 * MiB;
constexpr size_t WS_GATE = 10 * MiB;
constexpr size_t WS_WQKV = 11 * MiB;
constexpr size_t WS_WO = 17 * MiB;
constexpr size_t WS_WUP = 20 * MiB;
constexpr size_t WS_WDN = 148 * MiB;
constexpr size_t WS_XA = 212 * MiB;
constexpr size_t WS_H = 280 * MiB;
constexpr size_t WS_R = 314 * MiB;
constexpr size_t WS_YG = WS_R, WS_U = WS_R + 34 * MiB, WS_HF = WS_R + 68 * MiB, WS_HB = WS_R + 102 * MiB;
constexpr size_t WS_G = WS_R, WS_Y = WS_R + 42 * MiB;
constexpr size_t WS_Q = WS_R, WS_K = WS_R + 32 * MiB, WS_VT = WS_R + 66 * MiB, WS_AO = WS_R + 100 * MiB;
constexpr size_t WS_END = 450 * MiB;
static_assert(WS_Y + (size_t)PMAX * 1024 * 2 <= WS_END && WS_HB + 34 * MiB <= WS_END && WS_AO + 32 * MiB <= WS_END, "ws map");
static_assert(WS_K + (size_t)NB * 8 * 2 * KEYS * 64 * 2 <= WS_VT && WS_VT + (size_t)NB * 8 * 128 * KEYS * 2 <= WS_AO, "attn map");

constexpr int LDS_BYTES = 163840;
constexpr int LDS_XB = LDS_BYTES - 64;
constexpr int LDS_AUX = 147456;

__device__ __forceinline__ unsigned f2bf(float f) { unsigned u = __builtin_bit_cast(unsigned, f); return (u + 0x7fffu + ((u >> 16) & 1u)) >> 16; }
#ifndef L1_FP8
#define L1_FP8 1
#endif
typedef int i32x8 __attribute__((ext_vector_type(8)));
__device__ __forceinline__ unsigned pk4_fp8(float a, float b, float c, float d) { int w = 0; w = __builtin_amdgcn_cvt_pk_fp8_f32(a, b, w, false); w = __builtin_amdgcn_cvt_pk_fp8_f32(c, d, w, true); return (unsigned)w; }
constexpr int FP8_SCALE_ONE = 0x7f7f7f7f, FP8_SCALE_W = 0x7a7a7a7a  , FP8_SCALE_G = 0x7c7c7c7c  ;
typedef __bf16 bf16x2_t __attribute__((ext_vector_type(2)));
__device__ __forceinline__ unsigned pk2(float lo, float hi) { const f32x2 v = {lo, hi}; const bf16x2_t b = __builtin_convertvector(v, bf16x2_t); return __builtin_bit_cast(unsigned, b); }
__device__ __forceinline__ float bflo(unsigned w) { return __builtin_bit_cast(float, w << 16); }
__device__ __forceinline__ float bfhi(unsigned w) { return __builtin_bit_cast(float, w & 0xffff0000u); }
__device__ __forceinline__ float wave_sum(float v) {
#pragma unroll
    for (int o = 1; o < 64; o <<= 1) v += __shfl_xor(v, o);
    return v;
}
__device__ __forceinline__ float sigmoidf_(float x) { return 1.0f / (1.0f + __expf(-x)); }
#define LDS_WAIT() asm volatile("s_waitcnt lgkmcnt(0)" ::: "memory")

#define XB_TMO      128
#define XB_XCNT(j)  (256  + 64 * (j))
#define XB_XSUB(j)  (1280 + 64 * (j))
#define XB_XGEN(j)  (2304 + 64 * (j))
#define XB_TOP      3328
#define XB_TOPGEN   3392
#define XCD_BAR_WORDS 3456
#define XB_SPIN_CAP (1u << 18)
__device__ __forceinline__ unsigned xb_ld(unsigned* p)              { return __hip_atomic_load(p, __ATOMIC_RELAXED, __HIP_MEMORY_SCOPE_AGENT); }
__device__ __forceinline__ unsigned xb_add(unsigned* p, unsigned v) { return __hip_atomic_fetch_add(p, v, __ATOMIC_RELAXED, __HIP_MEMORY_SCOPE_AGENT); }
__device__ __forceinline__ unsigned xb_xcc_id() { return (unsigned)__builtin_amdgcn_s_getreg((3 << 11) | 20) & 0xFu; }
#define XB_SPIN(cond, bar) do { unsigned _sp = 0; while (cond) { __builtin_amdgcn_s_sleep(1); \
    if ((++_sp & 255u) == 0u) { if (xb_ld(&(bar)[XB_TMO])) break; if (_sp > XB_SPIN_CAP) { atomicAdd(&(bar)[XB_TMO], 1u); break; } } } } while (0)
struct XcdBarrier { unsigned* bar; unsigned x; volatile LAS unsigned* st; };
__device__ __forceinline__ XcdBarrier xcd_barrier_post(unsigned* bar, volatile LAS unsigned* st) {
    XcdBarrier b; b.bar = bar; b.x = xb_xcc_id(); b.st = st;
    if (threadIdx.x == 0) (void)xb_add(&bar[XB_XCNT(b.x)], 1u);
    return b;
}
__device__ __forceinline__ void xcd_barrier_complete(unsigned* bar, unsigned x, unsigned& nloc, unsigned& nx) {
    const unsigned G = gridDim.x * gridDim.y * gridDim.z;
    unsigned sum, cnt, mine, sp = 0u;
    for (;;) {
        sum = 0u; cnt = 0u; mine = 0u;
#pragma unroll
        for (unsigned j = 0; j < 16; ++j) { const unsigned c = xb_ld(&bar[XB_XCNT(j)]); sum += c; cnt += (c > 0u) ? 1u : 0u; mine = (j == x) ? c : mine; }
        if (sum == G) break;
        __builtin_amdgcn_s_sleep(1);
        if ((++sp & 255u) == 0u) { if (xb_ld(&bar[XB_TMO])) break; if (sp > XB_SPIN_CAP) { atomicAdd(&bar[XB_TMO], 1u); break; } }
    }
    nloc = mine > 0u ? mine : 1u; nx = cnt > 0u ? cnt : 1u;
}
__device__ __forceinline__ void xcd_barrier(const XcdBarrier& b) {
    asm volatile("s_waitcnt vmcnt(0)" ::: "memory");
    __syncthreads();
    if (threadIdx.x == 0) {
        unsigned* bar = b.bar;
        __builtin_amdgcn_s_waitcnt(0);
        unsigned nloc = b.st[0], nx = b.st[1];
        if (nloc == 0u) { xcd_barrier_complete(bar, b.x, nloc, nx); b.st[0] = nloc; b.st[1] = nx; }
        const unsigned old = xb_add(&bar[XB_XSUB(b.x)], 1u);
        const unsigned gen = old / nloc;
        if (old + 1u == (gen + 1u) * nloc) {
            __builtin_amdgcn_fence(__ATOMIC_RELEASE, "agent");
            asm volatile("s_waitcnt vmcnt(0)" ::: "memory");
            const unsigned og = xb_add(&bar[XB_TOP], 1u);
            const unsigned tg = og / nx;
            if (og + 1u == (tg + 1u) * nx) xb_add(&bar[XB_TOPGEN], 1u);
            else XB_SPIN(xb_ld(&bar[XB_TOPGEN]) == tg, bar);
            __builtin_amdgcn_fence(__ATOMIC_ACQUIRE, "agent");
            xb_add(&bar[XB_XGEN(b.x)], 1u);
            asm volatile("s_waitcnt vmcnt(0)" ::: "memory");
        } else {
            XB_SPIN(xb_ld(&bar[XB_XGEN(b.x)]) == gen, bar);
            __builtin_amdgcn_fence(__ATOMIC_ACQUIRE, "agent");
            asm volatile("s_waitcnt vmcnt(0)" ::: "memory");
        }
    }
    __syncthreads();
}

struct Args { const float* in[27]; float* out; unsigned char* ws; int ph_lo, ph_hi; };
enum { I_X = 0, I_C, I_CTX, I_CCTX, I_WMOD, I_BMOD, I_N1G, I_N2G, I_WIN, I_CONVW, I_CONVB, I_GAW, I_GAB, I_GXW, I_GXB, I_LAM, I_WOUT,
       I_WQKV, I_DALAM, I_SUBLN, I_WO, I_RW, I_RB, I_MG, I_MU, I_MD, I_FG };

struct Frame {
    LAS char* lds;
    int tid, lane, wave, vcu, G;
    const Args* a;
    unsigned char* ws;
};

__device__ __forceinline__ const float* modp(const Frame& F, int l, int c, int k) { return (const float*)(F.ws + WS_MOD) + (size_t)(l * 5 + c) * 6144 + k * 1024; }
__device__ __forceinline__ int cond_of(int row) { return row < NX ? (row >> 12) : 4; }

__device__ __forceinline__ int moe_up_row(int n) { return ((n >> 7) << 8) + (((n >> 5) & 3) << 6) + (((n >> 4) & 1) << 5) + (n & 15); }

struct TDesc { const float* W; bf16* WT; int N, ldT, mode, k0, n0; };
__device__ __forceinline__ void tr_load(const TDesc& t, int lane, f32x4 (&rg)[8]) {
    const float* p = t.W + (size_t)(t.k0 + (lane >> 3)) * t.N + t.n0 + 4 * (lane & 7);
#pragma unroll
    for (int i = 0; i < 8; ++i) rg[i] = *(const f32x4*)(p + (size_t)(8 * i) * t.N);
}
__device__ __forceinline__ void tr_finish(const TDesc& t, int lane, const f32x4 (&rg)[8], LAS float* scr) {
#pragma unroll
    for (int i = 0; i < 8; ++i) { LAS float* d = scr + ((lane >> 3) + 8 * i) * 33 + 4 * (lane & 7); d[0] = rg[i].x; d[1] = rg[i].y; d[2] = rg[i].z; d[3] = rg[i].w; }
    LDS_WAIT();
    const int c = lane & 7;
#pragma unroll
    for (int j = 0; j < 4; ++j) {
        const int n = (lane >> 3) + 8 * j; const LAS float* s = scr + (8 * c) * 33 + n;
        u32x4 o; o.x = pk2(s[0 * 33], s[1 * 33]); o.y = pk2(s[2 * 33], s[3 * 33]); o.z = pk2(s[4 * 33], s[5 * 33]); o.w = pk2(s[6 * 33], s[7 * 33]);
        const int nn = t.n0 + n;
        const int drow = (t.mode == 0) ? nn : (moe_up_row(nn) + (t.mode == 2 ? 16 : 0));
        *(u32x4*)(t.WT + (size_t)drow * t.ldT + t.k0 + 8 * c) = o;
    }
    LDS_WAIT();
}

__device__ __forceinline__ void phase_convert(Frame& F) {
    const Args& A = *F.a;
    LAS float* scr = (LAS float*)(F.lds + F.wave * 8448);
    LAS float* sil = (LAS float*)(F.lds + 69632);
    for (int i = F.tid; i < 5 * 1024; i += NTHREADS) { const int c = i >> 10, k = i & 1023; const float v = (c < 4) ? A.in[I_C][c * 1024 + k] : A.in[I_CCTX][k]; sil[i] = v / (1.0f + __expf(-v)); }
    __syncthreads();
    const int gw = F.vcu * NWAVES + F.wave, NGW = F.G * NWAVES;
    constexpr int N_MOD = 192, N_WIN = 16 * 64, N_WOUT = 16 * 32, N_WQKV = 16 * 96, N_WO = 16 * 32, N_GATE = 32 * 8, N_MOE = 64 * 256;
    {
        LAS float* red = (LAS float*)(F.lds + 90112);
        for (int item = F.vcu; item < N_MOD; item += F.G) {
            const int l = item / 96, col = (item % 96) * 64 + F.lane;
            const float* wp = A.in[I_WMOD] + ((size_t)l * 1024 + F.wave * 128) * 6144 + col;
            float acc[5] = {0.f, 0.f, 0.f, 0.f, 0.f};
#pragma unroll 4
            for (int k = 0; k < 128; k += 4) {
                const float w0 = wp[(size_t)k * 6144], w1 = wp[(size_t)(k + 1) * 6144], w2 = wp[(size_t)(k + 2) * 6144], w3 = wp[(size_t)(k + 3) * 6144];
#pragma unroll
                for (int c = 0; c < 5; ++c) { const f32x4 s4 = *(const LAS f32x4*)(sil + c * 1024 + F.wave * 128 + k); acc[c] += s4.x * w0 + s4.y * w1 + s4.z * w2 + s4.w * w3; }
            }
#pragma unroll
            for (int c = 0; c < 5; ++c) red[(F.wave * 5 + c) * 64 + F.lane] = acc[c];
            __syncthreads();
            if (F.tid < 320) {
                const int c = F.tid >> 6, ln = F.tid & 63;
                float s = A.in[I_BMOD][l * 6144 + (item % 96) * 64 + ln];
#pragma unroll
                for (int w2 = 0; w2 < 8; ++w2) s += red[(w2 * 5 + c) * 64 + ln];
                ((float*)(F.ws + WS_MOD))[(size_t)(l * 5 + c) * 6144 + (item % 96) * 64 + ln] = s;
            }
            __syncthreads();
        }
    }
    auto decode = [&](int r) -> TDesc {
        TDesc t; t.mode = 0;
        int item;
        if (r < N_WIN) { t.W = A.in[I_WIN]; t.N = 2048; t.WT = (bf16*)(F.ws + WS_WIN); t.ldT = 1024; item = r; }
        else if ((r -= N_WIN) < N_WOUT) { t.W = A.in[I_WOUT]; t.N = 1024; t.WT = (bf16*)(F.ws + WS_WOUT); t.ldT = 1024; item = r; }
        else {
            r -= N_WOUT;
            const int m = r >> 3, d = m >> 4, g = (m >> 3) & 1, n = m & 7;
            t.W = (g == 0 ? A.in[I_GAW] : A.in[I_GXW]) + (size_t)(d * 8 + n) * 128 * 128; t.N = 128;
            t.WT = (bf16*)(F.ws + WS_GATE) + (size_t)m * 128 * 128; t.ldT = 128; item = r & 7;
        }
        const int nblk = t.N >> 5; t.k0 = 64 * (item / nblk); t.n0 = 32 * (item % nblk);
        return t;
    };
    constexpr int NTR0 = N_WIN + N_WOUT + N_GATE;
    for (int it = gw; it < NTR0; it += NGW) {
        const TDesc cur = decode(it); f32x4 rg[8]; tr_load(cur, F.lane, rg);
        tr_finish(cur, F.lane, rg, scr);
    }
}

constexpr int ND_WQKV = 32 * 96, ND_WO = 32 * 32, ND_MOEL = 32 * 512;
constexpr int ND_SCAN = ND_WQKV + ND_WO + 3 * ND_MOEL;
constexpr int ND_ATTN = 3 * ND_MOEL;
__device__ __forceinline__ TDesc decode_moe(const Frame& F, int r, int layer) {
    const Args& A = *F.a;
    TDesc t; t.mode = 0; int item;
    if (r < ND_MOEL) { const int le = layer * 32 + (r >> 9); t.W = A.in[I_MG] + (size_t)le * 1024 * 512; t.N = 512; t.WT = (bf16*)(F.ws + WS_WUP) + (size_t)le * 1024 * 1024; t.ldT = 1024; t.mode = 1; item = r & 511; }
    else if ((r -= ND_MOEL) < ND_MOEL) { const int le = layer * 32 + (r >> 9); t.W = A.in[I_MU] + (size_t)le * 1024 * 512; t.N = 512; t.WT = (bf16*)(F.ws + WS_WUP) + (size_t)le * 1024 * 1024; t.ldT = 1024; t.mode = 2; item = r & 511; }
    else { r -= ND_MOEL; const int le = layer * 32 + (r >> 9); t.W = A.in[I_MD] + (size_t)le * 512 * 1024; t.N = 1024; t.WT = (bf16*)(F.ws + WS_WDN) + (size_t)le * 1024 * 512; t.ldT = 512; item = r & 511; }
    const int nblk = t.N >> 5; t.k0 = 32 * (item / nblk); t.n0 = 32 * (item % nblk);
    return t;
}
__device__ __forceinline__ TDesc decode_deferred(const Frame& F, int r) {
    const Args& A = *F.a;
    if (r >= ND_WQKV + ND_WO) return decode_moe(F, r - (ND_WQKV + ND_WO), 0);
    TDesc t; t.mode = 0; int item;
    if (r < ND_WQKV) { t.W = A.in[I_WQKV]; t.N = 3072; t.WT = (bf16*)(F.ws + WS_WQKV); t.ldT = 1024; item = r; }
    else { r -= ND_WQKV; t.W = A.in[I_WO]; t.N = 1024; t.WT = (bf16*)(F.ws + WS_WO); t.ldT = 1024; item = r; }
    const int nblk = t.N >> 5; t.k0 = 32 * (item / nblk); t.n0 = 32 * (item % nblk);
    return t;
}
__device__ __forceinline__ void tr3_dma(const TDesc& t, int lane, LAS char* buf) {
    const float* p = t.W + (size_t)(t.k0 + (lane >> 3)) * t.N + t.n0;
#pragma unroll
    for (int i = 0; i < 4; ++i)
        __builtin_amdgcn_global_load_lds((const unsigned*)(p + (size_t)(8 * i) * t.N + 4 * ((lane & 7) ^ i)), (LAS unsigned*)(buf + i * 1024), 16, 0, 0);
}
__device__ __forceinline__ void tr3_finish(const TDesc& t, int lane, const LAS char* buf) {
    const int c = lane & 3;
#pragma unroll
    for (int j = 0; j < 2; ++j) {
        const int n = (lane >> 2) + 16 * j;
        const LAS char* s = buf + (8 * c) * 128 + (((n >> 2) ^ c) << 4) + (n & 3) * 4;
        float x[8];
#pragma unroll
        for (int i = 0; i < 8; ++i) x[i] = *(const LAS float*)(s + i * 128);
        u32x4 o; o.x = pk2(x[0], x[1]); o.y = pk2(x[2], x[3]); o.z = pk2(x[4], x[5]); o.w = pk2(x[6], x[7]);
        const int nn = t.n0 + n;
        const int drow = (t.mode == 0) ? nn : (moe_up_row(nn) + (t.mode == 2 ? 16 : 0));
        *(u32x4*)(t.WT + (size_t)drow * t.ldT + t.k0 + 8 * c) = o;
    }
}
__device__ __forceinline__ void tr3_finish_fp8(const TDesc& t, int lane, const LAS char* buf) {
    const int c = lane & 1, n = lane >> 1;
    float x[16];
#pragma unroll
    for (int i = 0; i < 16; ++i) { const int r = 16 * c + i; x[i] = 32.0f * *(const LAS float*)(buf + r * 128 + (((n >> 2) ^ (r >> 3)) << 4) + (n & 3) * 4); }
    u32x4 o; o.x = pk4_fp8(x[0], x[1], x[2], x[3]); o.y = pk4_fp8(x[4], x[5], x[6], x[7]); o.z = pk4_fp8(x[8], x[9], x[10], x[11]); o.w = pk4_fp8(x[12], x[13], x[14], x[15]);
    const int nn = t.n0 + n;
    const int drow = (t.mode == 0) ? nn : (moe_up_row(nn) + (t.mode == 2 ? 16 : 0));
    *(u32x4*)((unsigned char*)t.WT + (size_t)drow * t.ldT + t.k0 + 16 * c) = o;
}
__device__ __forceinline__ TDesc decode_moe8(const Frame& F, int r) {
    const Args& A = *F.a;
    TDesc t; t.mode = 0; int item;
    unsigned char* up8 = F.ws + WS_WUP + (size_t)64 * MiB; unsigned char* dn8 = F.ws + WS_WDN + (size_t)32 * MiB;
    if (r < ND_MOEL) { const int e = r >> 9; t.W = A.in[I_MG] + (size_t)(32 + e) * 1024 * 512; t.N = 512; t.WT = (bf16*)(up8 + (size_t)e * 1024 * 1024); t.ldT = 1024; t.mode = 1; item = r & 511; }
    else if ((r -= ND_MOEL) < ND_MOEL) { const int e = r >> 9; t.W = A.in[I_MU] + (size_t)(32 + e) * 1024 * 512; t.N = 512; t.WT = (bf16*)(up8 + (size_t)e * 1024 * 1024); t.ldT = 1024; t.mode = 2; item = r & 511; }
    else { r -= ND_MOEL; const int e = r >> 9; t.W = A.in[I_MD] + (size_t)(32 + e) * 512 * 1024; t.N = 1024; t.WT = (bf16*)(dn8 + (size_t)e * 1024 * 512); t.ldT = 512; item = r & 511; }
    const int nblk = t.N >> 5; t.k0 = 32 * (item / nblk); t.n0 = 32 * (item % nblk);
    return t;
}
__device__ __forceinline__ void tr2_load(const TDesc& t, int lane, f32x4 (&rg)[4]) {
    const float* p = t.W + (size_t)(t.k0 + (lane >> 3)) * t.N + t.n0 + 4 * (lane & 7);
#pragma unroll
    for (int i = 0; i < 4; ++i) rg[i] = *(const f32x4*)(p + (size_t)(8 * i) * t.N);
}
__device__ __forceinline__ void tr2_finish(const TDesc& t, int lane, const f32x4 (&rg)[4], LAS float* scr  ) {
#pragma unroll
    for (int i = 0; i < 4; ++i) { LAS float* d = scr + ((lane >> 3) + 8 * i) * 33 + 4 * (lane & 7); d[0] = rg[i].x; d[1] = rg[i].y; d[2] = rg[i].z; d[3] = rg[i].w; }
    LDS_WAIT();
    const int c = lane & 3;
#pragma unroll
    for (int j = 0; j < 2; ++j) {
        const int n = (lane >> 2) + 16 * j; const LAS float* s = scr + (8 * c) * 33 + n;
        u32x4 o; o.x = pk2(s[0 * 33], s[1 * 33]); o.y = pk2(s[2 * 33], s[3 * 33]); o.z = pk2(s[4 * 33], s[5 * 33]); o.w = pk2(s[6 * 33], s[7 * 33]);
        const int nn = t.n0 + n;
        const int drow = (t.mode == 0) ? nn : (moe_up_row(nn) + (t.mode == 2 ? 16 : 0));
        *(u32x4*)(t.WT + (size_t)drow * t.ldT + t.k0 + 8 * c) = o;
    }
    LDS_WAIT();
}

__device__ __forceinline__ float row_rstd(const f32x4 (&v)[4]) {
    float s = 0.f;
#pragma unroll
    for (int j = 0; j < 4; ++j) s += (v[j].x * v[j].x + v[j].y * v[j].y) + (v[j].z * v[j].z + v[j].w * v[j].w);
    return rsqrtf(wave_sum(s) * (1.0f / D) + EPS);
}
__device__ __forceinline__ void row_modulate_store8(f32x4 (&v)[4], float rstd, const float* g, const float* sc, const float* sh, unsigned char* dst, int lane) {
#pragma unroll
    for (int j = 0; j < 4; ++j) {
        const int c0 = 4 * lane + 256 * j;
        const f32x4 gg = *(const f32x4*)(g + c0), s1 = *(const f32x4*)(sc + c0), s0 = *(const f32x4*)(sh + c0);
        v[j] = (v[j] * rstd) * gg * (1.0f + s1) + s0;
        *(unsigned*)(dst + c0) = pk4_fp8(v[j].x, v[j].y, v[j].z, v[j].w);
    }
}
__device__ __forceinline__ void row_modulate_store(f32x4 (&v)[4], float rstd, const float* g, const float* sc, const float* sh, bf16* dst, int lane) {
#pragma unroll
    for (int j = 0; j < 4; ++j) {
        const int c0 = 4 * lane + 256 * j;
        const f32x4 gg = *(const f32x4*)(g + c0), s1 = *(const f32x4*)(sc + c0), s0 = *(const f32x4*)(sh + c0);
        v[j] = (v[j] * rstd) * gg * (1.0f + s1) + s0;
        u32x2 o; o.x = pk2(v[j].x, v[j].y); o.y = pk2(v[j].z, v[j].w);
        *(u32x2*)(dst + c0) = o;
    }
}

__device__ __forceinline__ void load_row4(const float* src, int lane, f32x4 (&v)[4]) {
#pragma unroll
    for (int j = 0; j < 4; ++j) v[j] = *(const f32x4*)(src + 4 * lane + 256 * j);
}
__device__ __forceinline__ void phase_prep0(Frame& F) {
    const Args& A = *F.a;
    const int gw = F.vcu * NWAVES + F.wave, NGW = F.G * NWAVES;
    bf16* H = (bf16*)(F.ws + WS_H);
    f32x4 vn[4];
    if (gw < NTOK) load_row4(gw < NX ? A.in[I_X] + (size_t)gw * D : A.in[I_CTX] + (size_t)(gw - NX) * D, F.lane, vn);
    for (int row = gw; row < NTOK; row += NGW) {
        const int c = cond_of(row);
        f32x4 v[4];
#pragma unroll
        for (int j = 0; j < 4; ++j) v[j] = vn[j];
        const int nr = row + NGW;
        if (nr < NTOK) load_row4(nr < NX ? A.in[I_X] + (size_t)nr * D : A.in[I_CTX] + (size_t)(nr - NX) * D, F.lane, vn);
        const float rstd = row_rstd(v);
        row_modulate_store(v, rstd, A.in[I_N1G], modp(F, 0, c, 1), modp(F, 0, c, 0), H + (size_t)row * D, F.lane);
    }
}

constexpr int GEMM_STAGE = 49152;
__device__ __forceinline__ int swz128(int row, int chunk) { return row * 128 + ((chunk ^ ((row >> 1) & 7)) << 4); }
__device__ __forceinline__ int dma_kc(int tid) { return ((tid & 7) ^ ((tid >> 4) & 7)) * 8; }

struct ALDense {
    static constexpr bool DMA = true;
    const bf16* p0; const bf16* p1;
    __device__ __forceinline__ const bf16* ptr(int i) const { return i ? p1 : p0; }
    __device__ __forceinline__ void init(const bf16* A, int lda, int m0, int r0, int r1, int kc) { p0 = A + (size_t)(m0 + r0) * lda + kc; p1 = A + (size_t)(m0 + r1) * lda + kc; }
    __device__ __forceinline__ u32x4 load(int i, int k0) const { return *(const u32x4*)((i ? p1 : p0) + k0); }
};
struct ALGather {
    static constexpr bool DMA = true;
    const bf16* p0; const bf16* p1;
    __device__ __forceinline__ const bf16* ptr(int i) const { return i ? p1 : p0; }
    __device__ __forceinline__ void init(const bf16* A, int lda, const int* idx, int m0, int r0, int r1, int kc) { p0 = A + (size_t)idx[m0 + r0] * lda + kc; p1 = A + (size_t)idx[m0 + r1] * lda + kc; }
    __device__ __forceinline__ u32x4 load(int i, int k0) const { return *(const u32x4*)((i ? p1 : p0) + k0); }
};
struct ALCombine {
    static constexpr bool DMA = false;
    size_t o0, o1; const bf16 *hf, *hb, *yg;
    __device__ __forceinline__ const bf16* ptr(int) const { return nullptr; }
    __device__ __forceinline__ void init(const bf16* hf_, const bf16* hb_, const bf16* yg_, int m0, int r0, int r1, int kc) { hf = hf_; hb = hb_; yg = yg_; o0 = (size_t)(m0 + r0) * D + kc; o1 = (size_t)(m0 + r1) * D + kc; }
    __device__ __forceinline__ u32x4 load(int i, int k0) const {
        const size_t o = (i ? o1 : o0) + k0;
        const u32x4 a = *(const u32x4*)(hf + o), b = *(const u32x4*)(hb + o), y = *(const u32x4*)(yg + o);
        u32x4 r;
#pragma unroll
        for (int q = 0; q < 4; ++q) r[q] = pk2((bflo(a[q]) + bflo(b[q])) * bflo(y[q]), (bfhi(a[q]) + bfhi(b[q])) * bfhi(y[q]));
        return r;
    }
};

template <class AL>
__device__ __forceinline__ void gemm_prefetch(const Frame& F, const AL& al, const bf16* __restrict__ Bt, int K) {
    const int tid = F.tid, sr = tid >> 3, sc = (tid & 7) ^ ((sr >> 1) & 7), wl = F.wave * 1024;
    const bf16* bp = Bt + (size_t)sr * K + sc * 8;
    const size_t bstep = (size_t)64 * K;
    LAS char* lds = F.lds;
    __builtin_amdgcn_global_load_lds((const unsigned*)(al.ptr(0)), (LAS unsigned*)(lds + wl), 16, 0, 0);
    __builtin_amdgcn_global_load_lds((const unsigned*)(al.ptr(1)), (LAS unsigned*)(lds + 8192 + wl), 16, 0, 0);
#pragma unroll
    for (int i = 0; i < 4; ++i)
        __builtin_amdgcn_global_load_lds((const unsigned*)(bp + i * bstep), (LAS unsigned*)(lds + 16384 + i * 8192 + wl), 16, 0, 0);
}
template <bool SWAP, class AL, bool PRE = false>
__device__ __forceinline__ void gemm_tile(const Frame& F, const AL& al, const bf16* __restrict__ Bt  , int K, f32x4 (&acc)[4][4]) {
    const int tid = F.tid, lane = F.lane, wid = F.wave, wr = wid >> 2, wc = wid & 3, fr = lane & 15, fq = lane >> 4;
    const int sr = tid >> 3;
    const int sc = AL::DMA ? ((tid & 7) ^ ((sr >> 1) & 7)) : (tid & 7);
    LAS char* lds = F.lds;
    const bf16* bp = Bt + (size_t)sr * K + sc * 8;
    const size_t bstep = (size_t)64 * K;
    int wa[2], wb[4];
#pragma unroll
    for (int i = 0; i < 2; ++i) wa[i] = swz128(sr + 64 * i, sc);
#pragma unroll
    for (int i = 0; i < 4; ++i) wb[i] = 16384 + swz128(sr + 64 * i, sc);
    const int key = (fr >> 1) & 7;
    const int ra = (wr * 64 + fr) * 128, rb = 16384 + (wc * 64 + fr) * 128;
#pragma unroll
    for (int mi = 0; mi < 4; ++mi)
#pragma unroll
        for (int ni = 0; ni < 4; ++ni) acc[mi][ni] = (f32x4){0.f, 0.f, 0.f, 0.f};
    u32x4 ga[2], gb[4];
    const int wl = wid * 1024;
#define GT_DMA(stage_, k_) do { \
        __builtin_amdgcn_global_load_lds((const unsigned*)(al.ptr(0) + (k_)), (LAS unsigned*)(lds + (stage_) + wl), 16, 0, 0); \
        __builtin_amdgcn_global_load_lds((const unsigned*)(al.ptr(1) + (k_)), (LAS unsigned*)(lds + (stage_) + 8192 + wl), 16, 0, 0); \
        _Pragma("unroll") for (int i_ = 0; i_ < 4; ++i_) \
            __builtin_amdgcn_global_load_lds((const unsigned*)(bp + i_ * bstep + (k_)), (LAS unsigned*)(lds + (stage_) + 16384 + i_ * 8192 + wl), 16, 0, 0); } while (0)
    if constexpr (AL::DMA) { if constexpr (!PRE) { GT_DMA(0, 0); } }
    else {
        ga[0] = al.load(0, 0); ga[1] = al.load(1, 0);
#pragma unroll
        for (int i = 0; i < 4; ++i) gb[i] = *(const u32x4*)(bp + i * bstep);
#pragma unroll
        for (int i = 0; i < 2; ++i) *(LAS u32x4*)(lds + wa[i]) = ga[i];
#pragma unroll
        for (int i = 0; i < 4; ++i) *(LAS u32x4*)(lds + wb[i]) = gb[i];
    }
    __syncthreads();
    const int nk = K / 64;
    for (int kt = 0; kt < nk; ++kt) {
        const int cur = (kt & 1) * GEMM_STAGE, nxt = GEMM_STAGE - cur;
        if (kt + 1 < nk) {
            const int k1 = (kt + 1) * 64;
            if constexpr (AL::DMA) { GT_DMA(nxt, k1); }
            else {
                ga[0] = al.load(0, k1); ga[1] = al.load(1, k1);
#pragma unroll
                for (int i = 0; i < 4; ++i) gb[i] = *(const u32x4*)(bp + i * bstep + k1);
            }
        }
        {
            bf16x8 af[2][4], bfr[2][4];
#pragma unroll
            for (int ks = 0; ks < 2; ++ks) {
                const int co = ((ks * 4 + fq) ^ key) << 4;
#pragma unroll
                for (int mi = 0; mi < 4; ++mi) af[ks][mi] = *(const LAS bf16x8*)(lds + cur + ra + mi * 2048 + co);
#pragma unroll
                for (int ni = 0; ni < 4; ++ni) bfr[ks][ni] = *(const LAS bf16x8*)(lds + cur + rb + ni * 2048 + co);
            }
            __builtin_amdgcn_sched_barrier(0);
#pragma unroll
            for (int ks = 0; ks < 2; ++ks)
#pragma unroll
                for (int mi = 0; mi < 4; ++mi)
#pragma unroll
                    for (int ni = 0; ni < 4; ++ni)
                        acc[mi][ni] = SWAP ? __builtin_amdgcn_mfma_f32_16x16x32_bf16(bfr[ks][ni], af[ks][mi], acc[mi][ni], 0, 0, 0)
                                           : __builtin_amdgcn_mfma_f32_16x16x32_bf16(af[ks][mi], bfr[ks][ni], acc[mi][ni], 0, 0, 0);
            __builtin_amdgcn_sched_barrier(0);
        }
        if constexpr (!AL::DMA) {
            if (kt + 1 < nk) {
#pragma unroll
                for (int i = 0; i < 2; ++i) *(LAS u32x4*)(lds + nxt + wa[i]) = ga[i];
#pragma unroll
                for (int i = 0; i < 4; ++i) *(LAS u32x4*)(lds + nxt + wb[i]) = gb[i];
            }
        }
        __syncthreads();
    }
#undef GT_DMA
}

#define G3_WAIT_BAR(N) asm volatile("s_waitcnt vmcnt(" #N ") lgkmcnt(0)\n\ts_barrier" ::: "memory")
template <class AL>
__device__ __forceinline__ void gemm3_issue(const Frame& F, const AL& al, const bf16* bp, size_t bstep, int stage_off, int k) {
    LAS char* lds = F.lds; const int wl = F.wave * 1024;
    __builtin_amdgcn_global_load_lds((const unsigned*)(al.ptr(0) + k), (LAS unsigned*)(lds + stage_off + wl), 16, 0, 0);
    __builtin_amdgcn_global_load_lds((const unsigned*)(al.ptr(1) + k), (LAS unsigned*)(lds + stage_off + 8192 + wl), 16, 0, 0);
#pragma unroll
    for (int i = 0; i < 4; ++i)
        __builtin_amdgcn_global_load_lds((const unsigned*)(bp + i * bstep + k), (LAS unsigned*)(lds + stage_off + 16384 + i * 8192 + wl), 16, 0, 0);
}
template <class AL>
__device__ __forceinline__ void gemm3_prefetch(const Frame& F, const AL& al, const bf16* __restrict__ Bt, int K) {
    const int tid = F.tid, sr = tid >> 3, sc = (tid & 7) ^ ((sr >> 1) & 7);
    const bf16* bp = Bt + (size_t)sr * K + sc * 8;
    gemm3_issue(F, al, bp, (size_t)64 * K, 0, 0);
    gemm3_issue(F, al, bp, (size_t)64 * K, GEMM_STAGE, 64);
}
template <bool SWAP, int EPI_ST, class AL>
__device__ __forceinline__ void gemm3_tile(const Frame& F, const AL& al, const bf16* __restrict__ Bt, int K, f32x4 (&acc)[4][4], bool first_unit) {
    static_assert(EPI_ST == 8 || EPI_ST == 16, "EPI_ST");
    const int tid = F.tid, lane = F.lane, wid = F.wave, wr = wid >> 2, wc = wid & 3, fr = lane & 15, fq = lane >> 4;
    const int sr = tid >> 3, sc = (tid & 7) ^ ((sr >> 1) & 7);
    LAS char* lds = F.lds;
    const bf16* bp = Bt + (size_t)sr * K + sc * 8;
    const size_t bstep = (size_t)64 * K;
    const int key = (fr >> 1) & 7;
    const int ra = (wr * 64 + fr) * 128, rb = 16384 + (wc * 64 + fr) * 128;
#pragma unroll
    for (int mi = 0; mi < 4; ++mi)
#pragma unroll
        for (int ni = 0; ni < 4; ++ni) acc[mi][ni] = (f32x4){0.f, 0.f, 0.f, 0.f};
    const int nk = K / 64;
    int cur = 0, nx2 = 2 * GEMM_STAGE;
    const int wl = wid * 1024;
#pragma unroll 1
    for (int kt = 0; kt < nk; ++kt) {
        if (kt + 1 >= nk) G3_WAIT_BAR(0);
        else if (kt >= 2 || first_unit) G3_WAIT_BAR(6);
        else if (kt == 0) { if constexpr (EPI_ST == 8) G3_WAIT_BAR(8); else G3_WAIT_BAR(16); }
        else { if constexpr (EPI_ST == 8) G3_WAIT_BAR(14); else G3_WAIT_BAR(22); }
        const bool more = kt + 2 < nk;
        const int k2 = (kt + 2) * 64;
#pragma unroll
        for (int ks = 0; ks < 2; ++ks) {
            const int co = ((ks * 4 + fq) ^ key) << 4;
            bf16x8 af[4], bfr[4];
#pragma unroll
            for (int mi = 0; mi < 4; ++mi) af[mi] = *(const LAS bf16x8*)(lds + cur + ra + mi * 2048 + co);
#pragma unroll
            for (int ni = 0; ni < 4; ++ni) bfr[ni] = *(const LAS bf16x8*)(lds + cur + rb + ni * 2048 + co);
#pragma unroll
            for (int mi = 0; mi < 4; ++mi) {
                if (more && mi < 3) {
                    const int g = ks * 3 + mi;
                    if (g < 2) __builtin_amdgcn_global_load_lds((const unsigned*)(al.ptr(g) + k2), (LAS unsigned*)(lds + nx2 + g * 8192 + wl), 16, 0, 0);
                    else __builtin_amdgcn_global_load_lds((const unsigned*)(bp + (g - 2) * bstep + k2), (LAS unsigned*)(lds + nx2 + 16384 + (g - 2) * 8192 + wl), 16, 0, 0);
                }
#pragma unroll
                for (int ni = 0; ni < 4; ++ni)
                    acc[mi][ni] = SWAP ? __builtin_amdgcn_mfma_f32_16x16x32_bf16(bfr[ni], af[mi], acc[mi][ni], 0, 0, 0)
                                       : __builtin_amdgcn_mfma_f32_16x16x32_bf16(af[mi], bfr[ni], acc[mi][ni], 0, 0, 0);
            }
        }
        nx2 = cur; cur = (cur == 2 * GEMM_STAGE) ? 0 : cur + GEMM_STAGE;
    }
    G3_WAIT_BAR(0);
}

template <int EPI_ST, class AL>
__device__ __forceinline__ void gemm3_tile8(const Frame& F, const AL& al, const bf16* __restrict__ Bt, int K2, f32x4 (&acc)[4][4], bool first_unit, int sc_w, int sc_a) {
    static_assert(EPI_ST == 8 || EPI_ST == 16, "EPI_ST");
    const int tid = F.tid, lane = F.lane, wid = F.wave, wr = wid >> 2, wc = wid & 3, fr = lane & 15, fq = lane >> 4;
    const int sr = tid >> 3, sc = (tid & 7) ^ ((sr >> 1) & 7);
    LAS char* lds = F.lds;
    const bf16* bp = Bt + (size_t)sr * K2 + sc * 8;
    const size_t bstep = (size_t)64 * K2;
    const int key = (fr >> 1) & 7;
    const int ra = (wr * 64 + fr) * 128, rb = 16384 + (wc * 64 + fr) * 128;
    const int c0 = ((2 * fq) ^ key) << 4, c1 = ((2 * fq + 1) ^ key) << 4;
#pragma unroll
    for (int mi = 0; mi < 4; ++mi)
#pragma unroll
        for (int ni = 0; ni < 4; ++ni) acc[mi][ni] = (f32x4){0.f, 0.f, 0.f, 0.f};
    const int nk = K2 / 64;
    int cur = 0, nx2 = 2 * GEMM_STAGE;
    const int wl = wid * 1024;
#pragma unroll 1
    for (int kt = 0; kt < nk; ++kt) {
        if (kt + 1 >= nk) G3_WAIT_BAR(0);
        else if (kt >= 2 || first_unit) G3_WAIT_BAR(6);
        else if (kt == 0) { if constexpr (EPI_ST == 8) G3_WAIT_BAR(8); else G3_WAIT_BAR(16); }
        else { if constexpr (EPI_ST == 8) G3_WAIT_BAR(14); else G3_WAIT_BAR(22); }
        const bool more = kt + 2 < nk;
        const int k2 = (kt + 2) * 64;
        i32x8 af[4], bfr[4];
#pragma unroll
        for (int mi = 0; mi < 4; ++mi) {
            const u32x4 lo = *(const LAS u32x4*)(lds + cur + ra + mi * 2048 + c0), hi = *(const LAS u32x4*)(lds + cur + ra + mi * 2048 + c1);
            af[mi] = (i32x8){(int)lo.x, (int)lo.y, (int)lo.z, (int)lo.w, (int)hi.x, (int)hi.y, (int)hi.z, (int)hi.w};
        }
#pragma unroll
        for (int ni = 0; ni < 4; ++ni) {
            const u32x4 lo = *(const LAS u32x4*)(lds + cur + rb + ni * 2048 + c0), hi = *(const LAS u32x4*)(lds + cur + rb + ni * 2048 + c1);
            bfr[ni] = (i32x8){(int)lo.x, (int)lo.y, (int)lo.z, (int)lo.w, (int)hi.x, (int)hi.y, (int)hi.z, (int)hi.w};
        }
#define G8_PIECE(g_) do { if ((g_) < 2) __builtin_amdgcn_global_load_lds((const unsigned*)(al.ptr(g_) + k2), (LAS unsigned*)(lds + nx2 + (g_) * 8192 + wl), 16, 0, 0); \
            else __builtin_amdgcn_global_load_lds((const unsigned*)(bp + ((g_) - 2) * bstep + k2), (LAS unsigned*)(lds + nx2 + 16384 + ((g_) - 2) * 8192 + wl), 16, 0, 0); } while (0)
#define G8_MMA(mi_) do { _Pragma("unroll") for (int ni = 0; ni < 4; ++ni) \
            acc[mi_][ni] = __builtin_amdgcn_mfma_scale_f32_16x16x128_f8f6f4(bfr[ni], af[mi_], acc[mi_][ni], 0, 0, 0, sc_w, 0, sc_a); } while (0)
        if (more) { G8_PIECE(0); G8_PIECE(1); }
        G8_MMA(0);
        if (more) { G8_PIECE(2); G8_PIECE(3); }
        G8_MMA(1);
        if (more) { G8_PIECE(4); }
        G8_MMA(2);
        if (more) { G8_PIECE(5); }
        G8_MMA(3);
#undef G8_PIECE
#undef G8_MMA
        nx2 = cur; cur = (cur == 2 * GEMM_STAGE) ? 0 : cur + GEMM_STAGE;
    }
    G3_WAIT_BAR(0);
}

__device__ __forceinline__ float gelu_tanh(float x) {
    const float z = 0.7978845608028654f * (x + 0.044715f * x * x * x);
    const float t = 1.0f - 2.0f / (1.0f + __expf(2.0f * z));
    return 0.5f * x * (1.0f + t);
}

__device__ __forceinline__ void phase_gemm_in(Frame& F) {
    const bf16* H = (const bf16*)(F.ws + WS_H); const bf16* W = (const bf16*)(F.ws + WS_WIN);
    bf16* YG = (bf16*)(F.ws + WS_YG); bf16* U = (bf16*)(F.ws + WS_U);
    const int wr = F.wave >> 2, wc = F.wave & 3, fr = F.lane & 15, fq = F.lane >> 4;
    constexpr int NTN = 8, NUNITS = (NTOK / 128) * NTN;
    ALDense al; const bf16* Bp = W;
    if (F.vcu < NUNITS) { al.init(H, D, (F.vcu / NTN) * 128, F.tid >> 3, (F.tid >> 3) + 64, dma_kc(F.tid)); Bp = W + (size_t)((F.vcu % NTN) * 256) * D; gemm3_prefetch(F, al, Bp, D); }
    for (int u = F.vcu; u < NUNITS; u += F.G) {
        const int mt = u / NTN, nt = u % NTN, m0 = mt * 128, n0 = nt * 256;
        f32x4 acc[4][4];
        gemm3_tile<true, 16>(F, al, Bp, D, acc, u == F.vcu);
        { const int un = u + F.G; if (un < NUNITS) { al.init(H, D, (un / NTN) * 128, F.tid >> 3, (F.tid >> 3) + 64, dma_kc(F.tid)); Bp = W + (size_t)((un % NTN) * 256) * D; gemm3_prefetch(F, al, Bp, D); } }
        const bool isy = n0 < 1024;
        bf16* dst = isy ? YG : U; const int nb = isy ? n0 : n0 - 1024;
#pragma unroll
        for (int mi = 0; mi < 4; ++mi) {
            const int row = m0 + wr * 64 + mi * 16 + fr;
#pragma unroll
            for (int ni = 0; ni < 4; ++ni) {
                f32x4 v = acc[mi][ni];
                if (isy) { v.x = gelu_tanh(v.x); v.y = gelu_tanh(v.y); v.z = gelu_tanh(v.z); v.w = gelu_tanh(v.w); }
                u32x2 o; o.x = pk2(v.x, v.y); o.y = pk2(v.z, v.w);
                *(u32x2*)(dst + (size_t)row * D + nb + wc * 64 + ni * 16 + fq * 4) = o;
            }
        }
    }
}

__device__ __forceinline__ float neg_expm1(float x) {
    const float p = 1.0f + x * (0.5f + x * (0.16666667f + x * (0.041666668f + x * (0.0083333338f + x * 0.0013888889f))));
    const float ser = -x * p, big = 1.0f - __expf(x);
    return x > -0.5f ? ser : big;
}
__device__ __forceinline__ void phase_scan(Frame& F) {
    const Args& A = *F.a;
    const int wi = F.vcu;
    if (wi >= 256) return;
    const int b = wi >> 6, n = (wi >> 3) & 7, d = (wi >> 2) & 1, q = wi & 3;
    const int tid = F.tid, lane = F.lane, w = F.wave, fr = lane & 15, fq = lane >> 4;
    LAS char* RAW = F.lds;
    LAS char* AT = F.lds + 33792;
    LAS float* AGG = (LAS float*)(F.lds + 66560);
    LAS float* CIN = (LAS float*)(F.lds + 74752);
    const bf16* U = (const bf16*)(F.ws + WS_U);
    bf16* HO = (bf16*)(F.ws + (d ? WS_HB : WS_HF));
    const int chbase = n * 128, och = chbase + q * 32;
    const bf16* GT = (const bf16*)(F.ws + WS_GATE);
    LAS char* BT = F.lds + 81920;
#pragma unroll
    for (int i = 0; i < 2; ++i) {
        const int idx = tid + 512 * i, jrow = idx >> 4, c = idx & 15, nb = jrow >> 4, f2 = jrow & 15;
        *(LAS u32x4*)(BT + jrow * 256 + ((c ^ f2) << 4)) = *(const u32x4*)(GT + ((size_t)(((d * 2 + (nb >> 1)) * 8 + n) * 128 + q * 32 + (nb & 1) * 16 + f2)) * 128 + c * 8);
    }
    float ba[2], bi[2], sp8[2];
#pragma unroll
    for (int h = 0; h < 2; ++h) {
        const int ch = och + h * 16 + fr;
        ba[h] = A.in[I_GAB][d * 1024 + ch]; bi[h] = A.in[I_GXB][d * 1024 + ch];
        sp8[h] = 8.0f * log1pf(expf(-A.in[I_LAM][d * 1024 + ch]));
    }
    const int c8 = tid & 15, r0 = tid >> 4;
    LAS float* CW = (LAS float*)(F.lds + 78848);
    (void)CW;
    float cw[4][8], cb[8];
#pragma unroll
    for (int k = 0; k < 4; ++k) {
        const f32x4 a0 = *(const f32x4*)(A.in[I_CONVW] + k * 1024 + chbase + c8 * 8), a1 = *(const f32x4*)(A.in[I_CONVW] + k * 1024 + chbase + c8 * 8 + 4);
        cw[k][0] = a0.x; cw[k][1] = a0.y; cw[k][2] = a0.z; cw[k][3] = a0.w; cw[k][4] = a1.x; cw[k][5] = a1.y; cw[k][6] = a1.z; cw[k][7] = a1.w;
    }
    { const f32x4 a0 = *(const f32x4*)(A.in[I_CONVB] + chbase + c8 * 8), a1 = *(const f32x4*)(A.in[I_CONVB] + chbase + c8 * 8 + 4);
      cb[0] = a0.x; cb[1] = a0.y; cb[2] = a0.z; cb[3] = a0.w; cb[4] = a1.x; cb[5] = a1.y; cb[6] = a1.z; cb[7] = a1.w; }

    float hcar = 0.f;
    u32x4 pre[5];
    LAS float* cscr = (LAS float*)(F.lds + 98304 + w * 4224);
    const int cgw = F.vcu * NWAVES + w, CNGW = F.G * NWAVES;
    int cit = cgw;
    TDesc cd2; f32x4 crg2[4]; bool chas2 = false;
    for (int step = 0; step < 34; ++step) {
        TDesc cd; f32x4 crg[4]; const bool chas = cit < ND_SCAN;
        if (chas) { cd = decode_deferred(F, cit); tr2_load(cd, lane, crg); cit += CNGW; }
        int segbase, seglen, tile;
        if (step < 2) { segbase = NX + b * CL; seglen = CL; tile = d ? (1 - step) : step; }
        else { segbase = b * S; seglen = S; tile = d ? (33 - step) : (step - 2); }
        const int t0 = tile * 128;
        if (step == 0) {
#pragma unroll
            for (int i = 0; i < 5; ++i) {
                const int idx = tid + 512 * i; const int row = idx >> 4, c = idx & 15; const int t = t0 - 2 + row;
                u32x4 v = (u32x4){0u, 0u, 0u, 0u};
                if (idx < 2112 && t >= 0 && t < seglen) v = *(const u32x4*)(U + (size_t)(segbase + t) * D + chbase + c * 8);
                pre[i] = v;
            }
        }
#pragma unroll
        for (int i = 0; i < 5; ++i) { const int idx = tid + 512 * i; if (idx < 2112) *(LAS u32x4*)(RAW + idx * 16) = pre[i]; }
        __syncthreads();
        if (step + 1 < 34) {
            const int s1 = step + 1; int sb1, sl1, tl1;
            if (s1 < 2) { sb1 = NX + b * CL; sl1 = CL; tl1 = d ? (1 - s1) : s1; }
            else { sb1 = b * S; sl1 = S; tl1 = d ? (33 - s1) : (s1 - 2); }
            const int t1 = tl1 * 128;
#pragma unroll
            for (int i = 0; i < 5; ++i) {
                const int idx = tid + 512 * i; const int row = idx >> 4, c = idx & 15; const int t = t1 - 2 + row;
                u32x4 v = (u32x4){0u, 0u, 0u, 0u};
                if (idx < 2112 && t >= 0 && t < sl1) v = *(const u32x4*)(U + (size_t)(sb1 + t) * D + chbase + c * 8);
                pre[i] = v;
            }
        }
#pragma unroll
        for (int i = 0; i < 4; ++i) {
            const int r = r0 + 32 * i;
            float o[8];
#pragma unroll
            for (int j = 0; j < 8; ++j) o[j] = cb[j];
#pragma unroll
            for (int k = 0; k < 4; ++k) {
                const u32x4 x = *(const LAS u32x4*)(RAW + (r + k) * 256 + c8 * 16);
#pragma unroll
                for (int p = 0; p < 4; ++p) { o[2 * p] += cw[k][2 * p] * bflo(x[p]); o[2 * p + 1] += cw[k][2 * p + 1] * bfhi(x[p]); }
            }
            u32x4 ov; ov.x = pk2(o[0], o[1]); ov.y = pk2(o[2], o[3]); ov.z = pk2(o[4], o[5]); ov.w = pk2(o[6], o[7]);
            *(LAS u32x4*)(AT + r * 256 + ((c8 ^ (r & 15)) << 4)) = ov;
        }
        __syncthreads();
        f32x4 acc[4];
#pragma unroll
        for (int nb = 0; nb < 4; ++nb) acc[nb] = (f32x4){0.f, 0.f, 0.f, 0.f};
#pragma unroll
        for (int ks = 0; ks < 4; ++ks) {
            const int row = 16 * w + fr;
            const bf16x8 af = *(const LAS bf16x8*)(AT + row * 256 + (((4 * ks + fq) ^ fr) << 4));
#pragma unroll
            for (int nb = 0; nb < 4; ++nb) {
                const bf16x8 bq = *(const LAS bf16x8*)(BT + (nb * 16 + fr) * 256 + (((4 * ks + fq) ^ fr) << 4));
                acc[nb] = __builtin_amdgcn_mfma_f32_16x16x32_bf16(af, bq, acc[nb], 0, 0, 0);
            }
        }
        float av[2][4], bv[2][4];
#pragma unroll
        for (int h = 0; h < 2; ++h) {
            const int col = q * 32 + h * 16 + fr, chunk = col >> 3, within = col & 7;
#pragma unroll
            for (int reg = 0; reg < 4; ++reg) {
                const int tr = 16 * w + 4 * fq + reg;
                const float r_ = __builtin_amdgcn_rcpf(1.0f + __builtin_amdgcn_exp2f(-1.4426950408889634f * (acc[h][reg] + ba[h])));
                const float i_ = __builtin_amdgcn_rcpf(1.0f + __builtin_amdgcn_exp2f(-1.4426950408889634f * (acc[2 + h][reg] + bi[h])));
                const float la = -sp8[h] * r_;
                const float a_ = __builtin_amdgcn_exp2f(1.4426950408889634f * la);
                const unsigned short ub = *(const LAS unsigned short*)(AT + tr * 256 + ((chunk ^ (tr & 15)) << 4) + within * 2);
                const float uval = __builtin_bit_cast(float, (unsigned)ub << 16);
                av[h][reg] = a_;
                bv[h][reg] = __builtin_amdgcn_sqrtf(neg_expm1(2.0f * la)) * (i_ * uval);
            }
        }
        const int g = 4 * w + fq;
#pragma unroll
        for (int h = 0; h < 2; ++h) {
            float P = 1.f, Hh = 0.f;
#pragma unroll
            for (int s = 0; s < 4; ++s) { const int reg = d ? (3 - s) : s; Hh = av[h][reg] * Hh + bv[h][reg]; P *= av[h][reg]; }
            AGG[(g * 32 + h * 16 + fr) * 2 + 0] = P; AGG[(g * 32 + h * 16 + fr) * 2 + 1] = Hh;
        }
        if (chas2) tr2_finish(cd2, lane, crg2, cscr);
        chas2 = cit < ND_SCAN;
        if (chas2) { cd2 = decode_deferred(F, cit); tr2_load(cd2, lane, crg2); cit += CNGW; }
        __syncthreads();
        if (tid < 32) {
            f32x2 ag[32];
#pragma unroll
            for (int gi = 0; gi < 32; ++gi) ag[gi] = *(const LAS f32x2*)(AGG + (gi * 32 + tid) * 2);
            float hh = hcar;
            if (d == 0) {
#pragma unroll
                for (int gi = 0; gi < 32; ++gi) { CIN[gi * 32 + tid] = hh; hh = ag[gi].x * hh + ag[gi].y; }
            } else {
#pragma unroll
                for (int gi = 31; gi >= 0; --gi) { CIN[gi * 32 + tid] = hh; hh = ag[gi].x * hh + ag[gi].y; }
            }
            hcar = hh;
        }
        __syncthreads();
#pragma unroll
        for (int h = 0; h < 2; ++h) {
            float hh = CIN[g * 32 + h * 16 + fr];
            float outv[4];
#pragma unroll
            for (int s = 0; s < 4; ++s) { const int reg = d ? (3 - s) : s; hh = av[h][reg] * hh + bv[h][reg]; outv[reg] = hh; }
#pragma unroll
            for (int reg = 0; reg < 4; ++reg) {
                const int tr = 16 * w + 4 * fq + reg;
                HO[(size_t)(segbase + t0 + tr) * D + och + h * 16 + fr] = (bf16)f2bf(outv[reg]);
            }
        }
        if (chas) tr2_finish(cd, lane, crg, cscr);
    }
    if (chas2) tr2_finish(cd2, lane, crg2, cscr);
}

__device__ __forceinline__ void phase_combine_h(Frame& F) {
    const u32x4* hf = (const u32x4*)(F.ws + WS_HF); const u32x4* hb = (const u32x4*)(F.ws + WS_HB); const u32x4* yg = (const u32x4*)(F.ws + WS_YG);
    u32x4* hc = (u32x4*)(F.ws + WS_U);
    constexpr int NCH = NTOK * (D / 8);
    const int stride = F.G * NTHREADS;
    for (int i = F.vcu * NTHREADS + F.tid; i < NCH; i += 4 * stride) {
        u32x4 a[4], b[4], y[4];
#pragma unroll
        for (int j = 0; j < 4; ++j) { const int idx = i + j * stride; if (idx < NCH) { a[j] = hf[idx]; b[j] = hb[idx]; y[j] = yg[idx]; } }
#pragma unroll
        for (int j = 0; j < 4; ++j) {
            const int idx = i + j * stride;
            if (idx < NCH) {
                u32x4 r;
#pragma unroll
                for (int q = 0; q < 4; ++q) r[q] = pk2((bflo(a[j][q]) + bflo(b[j][q])) * bflo(y[j][q]), (bfhi(a[j][q]) + bfhi(b[j][q])) * bfhi(y[j][q]));
                hc[idx] = r;
            }
        }
    }
}
__device__ __forceinline__ void phase_gemm_out0(Frame& F) {
    const Args& A = *F.a;
    const bf16* W = (const bf16*)(F.ws + WS_WOUT);
    const bf16* HC = (const bf16*)(F.ws + WS_U);
    float* XA = (float*)(F.ws + WS_XA);
    const int wr = F.wave >> 2, wc = F.wave & 3, fr = F.lane & 15, fq = F.lane >> 4;
    constexpr int NTN = 4, NUNITS = (NTOK / 128) * NTN;
    ALDense al; const bf16* Bp = W;
    if (F.vcu < NUNITS) { al.init(HC, D, (F.vcu / NTN) * 128, F.tid >> 3, (F.tid >> 3) + 64, dma_kc(F.tid)); Bp = W + (size_t)((F.vcu % NTN) * 256) * D; gemm3_prefetch(F, al, Bp, D); }
    for (int u = F.vcu; u < NUNITS; u += F.G) {
        const int mt = u / NTN, nt = u % NTN, m0 = mt * 128, n0 = nt * 256;
        f32x4 acc[4][4];
        gemm3_tile<true, 16>(F, al, Bp, D, acc, u == F.vcu);
        { const int un = u + F.G; if (un < NUNITS) { al.init(HC, D, (un / NTN) * 128, F.tid >> 3, (F.tid >> 3) + 64, dma_kc(F.tid)); Bp = W + (size_t)((un % NTN) * 256) * D; gemm3_prefetch(F, al, Bp, D); } }
#pragma unroll
        for (int mi = 0; mi < 4; ++mi) {
            const int row = m0 + wr * 64 + mi * 16 + fr;
            const float* src = row < NX ? A.in[I_X] + (size_t)row * D : A.in[I_CTX] + (size_t)(row - NX) * D;
            const float* gate = modp(F, 0, cond_of(row), 2);
#pragma unroll
            for (int ni = 0; ni < 4; ++ni) {
                const int col = n0 + wc * 64 + ni * 16 + fq * 4;
                const f32x4 s = *(const f32x4*)(src + col), gt = *(const f32x4*)(gate + col);
                *(f32x4*)(XA + (size_t)row * D + col) = s + gt * acc[mi][ni];
            }
        }
    }
}

__device__ __forceinline__ void route_select(const Frame& F, float (&acc)[32], float rbias, int row, LAS int* selL, int li) {
    const int lane = F.lane;
#define BFLY(S, HALF) { const bool up = (lane >> (S)) & 1; _Pragma("unroll") for (int i = 0; i < (HALF); ++i) { \
        const float keep = up ? acc[i + (HALF)] : acc[i]; const float send = up ? acc[i] : acc[i + (HALF)]; acc[i] = keep + __shfl_xor(send, 1 << (S)); } }
    BFLY(0, 16) BFLY(1, 8) BFLY(2, 4) BFLY(3, 2) BFLY(4, 1)
#undef BFLY
    const float tot = acc[0] + __shfl_xor(acc[0], 32);
    const int e = lane & 31;
    const float logit = __shfl(tot, (int)(__builtin_bitreverse32((unsigned)e) >> 27));
    const float sc = 1.0f / (1.0f + expf(-logit));
    const float ss = sc + rbias;
    float m1 = ss;
#pragma unroll
    for (int o = 1; o < 8; o <<= 1) m1 = fmaxf(m1, __shfl_xor(m1, o));
    int i1 = (ss == m1) ? e : 64;
#pragma unroll
    for (int o = 1; o < 8; o <<= 1) i1 = min(i1, __shfl_xor(i1, o));
    const float s2 = (e == i1) ? -INFINITY : ss;
    float m2 = s2;
#pragma unroll
    for (int o = 1; o < 8; o <<= 1) m2 = fmaxf(m2, __shfl_xor(m2, o));
    int i2 = (s2 == m2 && e != i1) ? e : 64;
#pragma unroll
    for (int o = 1; o < 8; o <<= 1) i2 = min(i2, __shfl_xor(i2, o));
    const float gs = m1 + m2;
    float gbest = gs;
    gbest = fmaxf(gbest, __shfl_xor(gbest, 8)); gbest = fmaxf(gbest, __shfl_xor(gbest, 16));
    int gsel = (gs == gbest) ? (e >> 3) : 64;
    gsel = min(gsel, __shfl_xor(gsel, 8)); gsel = min(gsel, __shfl_xor(gsel, 16));
    const int e0 = __shfl(i1, gsel * 8) & 31, e1 = __shfl(i2, gsel * 8) & 31;
    const float w0 = __shfl(sc, e0), w1 = __shfl(sc, e1);
    if (lane == 0) {
        const float inv = 1.0f / (w0 + w1);
        selL[li * 2] = e0; selL[li * 2 + 1] = e1;
        ((float2*)(F.ws + WS_WT))[row] = make_float2(w0 * inv, w1 * inv);
        ((int2*)(F.ws + WS_SEL))[row] = make_int2(e0, e1);
    }
}

template <int LAYER>
__device__ __forceinline__ void phase_route(Frame& F) {
    const Args& A = *F.a;
    constexpr int NT = LAYER == 0 ? NTOK : NX;
    constexpr int PER = NT / 256;
    LAS char* RW = F.lds;
    LAS int* selL = (LAS int*)(F.lds + LDS_AUX);
    LAS int* rankL = selL + 2 * 68;
    const int tid = F.tid, lane = F.lane;
    {
        f32x4 t[16];
#pragma unroll
        for (int i = 0; i < 16; ++i) { const int idx = tid + 512 * i; t[i] = *(const f32x4*)(A.in[I_RW] + (size_t)(idx >> 3) * 32 + (idx & 7) * 4); }
#pragma unroll
        for (int i = 0; i < 16; ++i) {
            const int idx = tid + 512 * i, k = idx >> 3, e4 = idx & 7;
            const int rho = (((k >> 8) * 4 + (k & 3)) << 6) + ((k >> 2) & 63);
            *(LAS f32x4*)(RW + rho * 128 + ((e4 ^ ((rho >> 1) & 7)) << 4)) = t[i];
        }
    }
    __syncthreads();
    const int blk = F.vcu;
    if (blk < 256) {
        const float* XA = (const float*)(F.ws + WS_XA);
        bf16* H = (bf16*)(F.ws + WS_H);
        const float rbias = A.in[I_RB][lane & 31];
        for (int pi = F.wave; pi < PER / 2; pi += NWAVES) {
            const int li = 2 * pi, row = blk * PER + li;
            const int c = cond_of(row);
            f32x4 va[4], vb[4];
            load_row4(XA + (size_t)row * D, lane, va); load_row4(XA + (size_t)(row + 1) * D, lane, vb);
            const float ra = row_rstd(va), rb = row_rstd(vb);
            if constexpr (LAYER == 1 && L1_FP8) {
                row_modulate_store8(va, ra, A.in[I_N2G] + LAYER * D, modp(F, LAYER, c, 4), modp(F, LAYER, c, 3), (unsigned char*)H + (size_t)row * D, lane);
                row_modulate_store8(vb, rb, A.in[I_N2G] + LAYER * D, modp(F, LAYER, c, 4), modp(F, LAYER, c, 3), (unsigned char*)H + (size_t)(row + 1) * D, lane);
            } else {
                row_modulate_store(va, ra, A.in[I_N2G] + LAYER * D, modp(F, LAYER, c, 4), modp(F, LAYER, c, 3), H + (size_t)row * D, lane);
                row_modulate_store(vb, rb, A.in[I_N2G] + LAYER * D, modp(F, LAYER, c, 4), modp(F, LAYER, c, 3), H + (size_t)(row + 1) * D, lane);
            }
            float acca[32], accb[32];
#pragma unroll
            for (int e = 0; e < 32; ++e) { acca[e] = 0.f; accb[e] = 0.f; }
#pragma unroll 1
            for (int jc = 0; jc < 16; ++jc) {
                const int j = jc >> 2, cc = jc & 3;
                f32x4 ha4 = va[0], hb4 = vb[0];
                if (j == 1) { ha4 = va[1]; hb4 = vb[1]; }
                if (j == 2) { ha4 = va[2]; hb4 = vb[2]; }
                if (j == 3) { ha4 = va[3]; hb4 = vb[3]; }
                float ha = ha4.x, hb = hb4.x;
                if (cc == 1) { ha = ha4.y; hb = hb4.y; }
                if (cc == 2) { ha = ha4.z; hb = hb4.z; }
                if (cc == 3) { ha = ha4.w; hb = hb4.w; }
                const int rho = jc * 64 + lane;
                const LAS char* rp = RW + rho * 128; const int key = (rho >> 1) & 7;
                f32x4 w8[8];
#pragma unroll
                for (int e4 = 0; e4 < 8; ++e4) w8[e4] = *(const LAS f32x4*)(rp + ((e4 ^ key) << 4));
#pragma unroll
                for (int e4 = 0; e4 < 8; ++e4) {
                    acca[e4 * 4 + 0] += ha * w8[e4].x; acca[e4 * 4 + 1] += ha * w8[e4].y; acca[e4 * 4 + 2] += ha * w8[e4].z; acca[e4 * 4 + 3] += ha * w8[e4].w;
                    accb[e4 * 4 + 0] += hb * w8[e4].x; accb[e4 * 4 + 1] += hb * w8[e4].y; accb[e4 * 4 + 2] += hb * w8[e4].z; accb[e4 * 4 + 3] += hb * w8[e4].w;
                }
            }
            route_select(F, acca, rbias, row, selL, li);
            route_select(F, accb, rbias, row + 1, selL, li + 1);
        }
        __syncthreads();
        if (tid < 32) {
            int cnt = 0;
            for (int i = 0; i < 2 * PER; ++i) { if (selL[i] == tid) { rankL[i] = cnt; ++cnt; } }
            ((int*)(F.ws + WS_BLKCNT))[blk * 32 + tid] = cnt;
        }
        __syncthreads();
        for (int i = tid; i < PER; i += NTHREADS) ((int2*)(F.ws + WS_LRANK))[blk * PER + i] = make_int2(rankL[2 * i], rankL[2 * i + 1]);
    }
}

template <int LAYER>
__device__ __forceinline__ void phase_slots(Frame& F) {
    constexpr int NT = LAYER == 0 ? NTOK : NX;
    constexpr int PER = NT / 256;
    LAS int* part = (LAS int*)F.lds;
    LAS int* tot = part + 1024;
    LAS int* base = tot + 32;
    LAS int* pst = base + 32;
    const int tid = F.tid, blk = F.vcu;
    const int* bc = (const int*)(F.ws + WS_BLKCNT);
    {
        const int e = tid & 31, p = tid >> 5;
        int st = 0, sb = 0;
        for (int b2 = p; b2 < 256; b2 += 16) { const int c = bc[b2 * 32 + e]; st += c; sb += (b2 < blk) ? c : 0; }
        part[p * 32 + e] = st; part[512 + p * 32 + e] = sb;
    }
    __syncthreads();
    if (tid < 32) { int st = 0, sb = 0; for (int p = 0; p < 16; ++p) { st += part[p * 32 + tid]; sb += part[512 + p * 32 + tid]; } tot[tid] = st; base[tid] = sb; }
    __syncthreads();
    if (tid == 0) { int s = 0; for (int e = 0; e < 32; ++e) { pst[e] = s; s += (tot[e] + 127) & ~127; } pst[32] = s; }
    __syncthreads();
    int* slot_tok = (int*)(F.ws + WS_SLOTTOK); float* slot_w = (float*)(F.ws + WS_SLOTW);
    if (blk == 0 && tid < 33) ((int*)(F.ws + WS_PSTART))[tid] = pst[tid];
    if (blk < 256) {
        for (int i = tid; i < PER; i += NTHREADS) {
            const int t = blk * PER + i;
            const int2 se = ((const int2*)(F.ws + WS_SEL))[t]; const int2 lr = ((const int2*)(F.ws + WS_LRANK))[t]; const float2 wt = ((const float2*)(F.ws + WS_WT))[t];
            const int s0 = pst[se.x] + base[se.x] + lr.x, s1 = pst[se.y] + base[se.y] + lr.y;
            slot_tok[s0] = t; slot_w[s0] = wt.x; slot_tok[s1] = t; slot_w[s1] = wt.y;
            ((int2*)(F.ws + WS_TOKSLOT))[t] = make_int2(s0, s1);
        }
    }
    if (blk < 32) {
        const int lo = pst[blk] + tot[blk], hi = pst[blk + 1];
        for (int s = lo + tid; s < hi; s += NTHREADS) { slot_tok[s] = 0; slot_w[s] = 0.f; }
    }
}

template <int LAYER>
__device__ __forceinline__ void phase_moe_up(Frame& F) {
    constexpr bool F8 = (LAYER == 1) && L1_FP8;
    constexpr int KA = F8 ? D / 2 : D;
    LAS int* pst = (LAS int*)(F.lds + LDS_AUX);
    if (F.tid < 33) pst[F.tid] = ((const int*)(F.ws + WS_PSTART))[F.tid];
    __syncthreads();
    const int ntiles = pst[32] >> 7, nunits = ntiles * 4;
    const bf16* H = (const bf16*)(F.ws + WS_H);
    const bf16* W = F8 ? (const bf16*)(F.ws + WS_WUP + (size_t)64 * MiB) : (const bf16*)(F.ws + WS_WUP) + (size_t)LAYER * 32 * 1024 * 1024;
    const int* slot_tok = (const int*)(F.ws + WS_SLOTTOK); const float* slot_w = (const float*)(F.ws + WS_SLOTW);
    bf16* G = (bf16*)(F.ws + WS_G);
    const int wr = F.wave >> 2, wc = F.wave & 3, fr = F.lane & 15, fq = F.lane >> 4;
    ALGather al; const bf16* Bp = W;
    auto setup = [&](int uu) {
        const int m0_ = (uu >> 2) * 128; int e = 0;
        for (int x = 1; x < 32; ++x) e = (pst[x] <= m0_) ? x : e;
        al.init(H, KA, slot_tok, m0_, F.tid >> 3, (F.tid >> 3) + 64, dma_kc(F.tid));
        Bp = W + ((size_t)e * 1024 + (uu & 3) * 256) * KA;
        gemm3_prefetch(F, al, Bp, KA);
    };
    if (F.vcu < nunits) setup(F.vcu);
    for (int u = F.vcu; u < nunits; u += F.G) {
        const int mt = u >> 2, j = u & 3, m0 = mt * 128;
        f32x4 acc[4][4];
        if constexpr (F8) gemm3_tile8<8>(F, al, Bp, KA, acc, u == F.vcu, FP8_SCALE_W, FP8_SCALE_ONE);
        else gemm3_tile<true, 8>(F, al, Bp, KA, acc, u == F.vcu);
        if (u + F.G < nunits) setup(u + F.G);
#pragma unroll
        for (int mi = 0; mi < 4; ++mi) {
            const int row = m0 + wr * 64 + mi * 16 + fr;
            const float wgt = slot_w[row];
#pragma unroll
            for (int p = 0; p < 2; ++p) {
                const f32x4 g = acc[mi][2 * p], uu = acc[mi][2 * p + 1];
                float o[4];
#pragma unroll
                for (int c = 0; c < 4; ++c) o[c] = g[c] / (1.0f + __expf(-g[c])) * uu[c] * wgt;
                if constexpr (F8) {
#pragma unroll
                    for (int c = 0; c < 4; ++c) o[c] = fminf(fmaxf(o[c] * 8.0f, -448.0f), 448.0f);
                    *(unsigned*)((unsigned char*)G + (size_t)row * DEXP + j * 128 + wc * 32 + p * 16 + fq * 4) = pk4_fp8(o[0], o[1], o[2], o[3]);
                } else {
                    u32x2 ov; ov.x = pk2(o[0], o[1]); ov.y = pk2(o[2], o[3]);
                    *(u32x2*)(G + (size_t)row * DEXP + j * 128 + wc * 32 + p * 16 + fq * 4) = ov;
                }
            }
        }
    }
}

template <int LAYER>
__device__ __forceinline__ void phase_moe_down(Frame& F) {
    constexpr bool F8 = (LAYER == 1) && L1_FP8;
    constexpr int KA = F8 ? DEXP / 2 : DEXP;
    LAS int* pst = (LAS int*)(F.lds + LDS_AUX);
    if (F.tid < 33) pst[F.tid] = ((const int*)(F.ws + WS_PSTART))[F.tid];
    __syncthreads();
    const int ntiles = pst[32] >> 7, nunits = ntiles * 4;
    const bf16* G = (const bf16*)(F.ws + WS_G);
    const bf16* W = F8 ? (const bf16*)(F.ws + WS_WDN + (size_t)32 * MiB) : (const bf16*)(F.ws + WS_WDN) + (size_t)LAYER * 32 * 1024 * 512;
    bf16* Y = (bf16*)(F.ws + WS_Y);
    const int wr = F.wave >> 2, wc = F.wave & 3, fr = F.lane & 15, fq = F.lane >> 4;
    ALDense al; const bf16* Bp = W;
    auto setup = [&](int uu) {
        const int m0_ = (uu >> 2) * 128; int e = 0;
        for (int x = 1; x < 32; ++x) e = (pst[x] <= m0_) ? x : e;
        al.init(G, KA, m0_, F.tid >> 3, (F.tid >> 3) + 64, dma_kc(F.tid));
        Bp = W + ((size_t)e * 1024 + (uu & 3) * 256) * KA;
        gemm3_prefetch(F, al, Bp, KA);
    };
    if (F.vcu < nunits) setup(F.vcu);
    for (int u = F.vcu; u < nunits; u += F.G) {
        const int mt = u >> 2, j = u & 3, m0 = mt * 128, n0 = j * 256;
        f32x4 acc[4][4];
        if constexpr (F8) gemm3_tile8<16>(F, al, Bp, KA, acc, u == F.vcu, FP8_SCALE_W, FP8_SCALE_G);
        else gemm3_tile<true, 16>(F, al, Bp, KA, acc, u == F.vcu);
        if (u + F.G < nunits) setup(u + F.G);
#pragma unroll
        for (int mi = 0; mi < 4; ++mi) {
            const int row = m0 + wr * 64 + mi * 16 + fr;
#pragma unroll
            for (int ni = 0; ni < 4; ++ni) {
                const f32x4 v = acc[mi][ni];
                u32x2 o; o.x = pk2(v.x, v.y); o.y = pk2(v.z, v.w);
                *(u32x2*)(Y + (size_t)row * D + n0 + wc * 64 + ni * 16 + fq * 4) = o;
            }
        }
    }
}

struct CRow { f32x4 x[4]; u32x2 y0[4], y1[4]; };
__device__ __forceinline__ void crow_load(const Frame& F, int row, int2 ts, CRow& r) {
    const float* XA = (const float*)(F.ws + WS_XA); const bf16* Y = (const bf16*)(F.ws + WS_Y);
#pragma unroll
    for (int j = 0; j < 4; ++j) {
        const int c0 = 4 * F.lane + 256 * j;
        r.x[j] = *(const f32x4*)(XA + (size_t)row * D + c0);
        r.y0[j] = *(const u32x2*)(Y + (size_t)ts.x * D + c0); r.y1[j] = *(const u32x2*)(Y + (size_t)ts.y * D + c0);
    }
}
__device__ __forceinline__ void crow_combine(const Frame& F, const CRow& r, const float* gate, f32x4 (&v)[4]) {
#pragma unroll
    for (int j = 0; j < 4; ++j) {
        const int c0 = 4 * F.lane + 256 * j;
        const f32x4 gt = *(const f32x4*)(gate + c0);
        f32x4 y; y.x = bflo(r.y0[j].x) + bflo(r.y1[j].x); y.y = bfhi(r.y0[j].x) + bfhi(r.y1[j].x); y.z = bflo(r.y0[j].y) + bflo(r.y1[j].y); y.w = bfhi(r.y0[j].y) + bfhi(r.y1[j].y);
        v[j] = r.x[j] + gt * y;
    }
}

__device__ __forceinline__ void phase_combine0(Frame& F) {
    const Args& A = *F.a;
    const int gw = F.vcu * NWAVES + F.wave, NGW = F.G * NWAVES;
    float* XA = (float*)(F.ws + WS_XA); bf16* H = (bf16*)(F.ws + WS_H);
    const int2* TS = (const int2*)(F.ws + WS_TOKSLOT);
    CRow cn; int2 tsn = make_int2(0, 0);
    if (gw < NTOK) crow_load(F, gw, TS[gw], cn);
    if (gw + NGW < NTOK) tsn = TS[gw + NGW];
    for (int row = gw; row < NTOK; row += NGW) {
        const int c = cond_of(row);
        const CRow cr = cn;
        const int nr = row + NGW;
        if (nr < NTOK) crow_load(F, nr, tsn, cn);
        if (nr + NGW < NTOK) tsn = TS[nr + NGW];
        f32x4 v[4];
        crow_combine(F, cr, modp(F, 0, c, 5), v);
#pragma unroll
        for (int j = 0; j < 4; ++j) *(f32x4*)(XA + (size_t)row * D + 4 * F.lane + 256 * j) = v[j];
        const float rstd = row_rstd(v);
        row_modulate_store(v, rstd, A.in[I_N1G] + D, modp(F, 1, c, 1), modp(F, 1, c, 0), H + (size_t)row * D, F.lane);
    }
}

constexpr float QSCALE = 0.125f * 1.4426950408889634f;
__device__ __forceinline__ void phase_qkv(Frame& F) {
    LAS float* CS = (LAS float*)(F.lds + LDS_AUX);
    for (int i = F.tid; i < 1024; i += NTHREADS) {
        const int p = i >> 4, f = i & 15;
        const float inv = 1.0f / powf(10000.0f, (float)f / 16.0f);
        const float ang = (float)p * inv;
        const double rev = (double)ang * 0.15915494309189535;
        const float fr_ = (float)(rev - floor(rev));
        CS[i * 2] = __builtin_amdgcn_cosf(fr_); CS[i * 2 + 1] = __builtin_amdgcn_sinf(fr_);
    }
    __syncthreads();
    const bf16* H = (const bf16*)(F.ws + WS_H); const bf16* W = (const bf16*)(F.ws + WS_WQKV);
    bf16* Q = (bf16*)(F.ws + WS_Q); bf16* Kb = (bf16*)(F.ws + WS_K); bf16* VT = (bf16*)(F.ws + WS_VT);
    const int wr = F.wave >> 2, wc = F.wave & 3, fr = F.lane & 15, fq = F.lane >> 4;
    constexpr int NTN = 12, NUX = (NX / 128) * NTN, NUNITS = NUX + (NC / 128) * 8;
    ALDense al; const bf16* Bp = W;
    auto setup = [&](int uu) {
        const int mt_ = uu < NUX ? uu / NTN : 128 + ((uu - NUX) >> 3), nt_ = uu < NUX ? uu % NTN : 4 + ((uu - NUX) & 7);
        al.init(H, D, mt_ * 128, F.tid >> 3, (F.tid >> 3) + 64, dma_kc(F.tid));
        Bp = W + (size_t)(nt_ * 256) * D;
        gemm3_prefetch(F, al, Bp, D);
    };
    if (F.vcu < NUNITS) setup(F.vcu);
    for (int u = F.vcu; u < NUNITS; u += F.G) {
        const int mt = u < NUX ? u / NTN : 128 + ((u - NUX) >> 3), nt = u < NUX ? u % NTN : 4 + ((u - NUX) & 7), m0 = mt * 128, n0 = nt * 256;
        const bool isctx = m0 >= NX;
        f32x4 acc[4][4];
        gemm3_tile<true, 16>(F, al, Bp, D, acc, u == F.vcu);
        if (u + F.G < NUNITS) setup(u + F.G);
        if (nt < 8) {
            const int hi2 = ((n0 & 1023) >> 6) + wc;
            const bool isq = nt < 4;
#pragma unroll
            for (int mi = 0; mi < 4; ++mi) {
                const int row = m0 + wr * 64 + mi * 16 + fr;
                int b, pos;
                if (!isctx) { b = row >> 12; pos = row & 4095; } else { b = (row - NX) >> 8; pos = S + ((row - NX) & 255); }
                f32x4 o[4];
                if (!isctx) {
                    const int rp = pos >> 6, cp = pos & 63;
#pragma unroll
                    for (int ni = 0; ni < 4; ++ni) {
                        const int p = (ni >> 1) ? cp : rp;
                        const f32x4 xv = acc[mi][ni], pv = acc[mi][ni ^ 1];
#pragma unroll
                        for (int c = 0; c < 4; ++c) {
                            const float cs = CS[(p * 16 + fq * 4 + c) * 2], sn = CS[(p * 16 + fq * 4 + c) * 2 + 1];
                            o[ni][c] = xv[c] * cs + ((ni & 1) ? pv[c] : -pv[c]) * sn;
                        }
                    }
                } else {
#pragma unroll
                    for (int ni = 0; ni < 4; ++ni) o[ni] = acc[mi][ni];
                }
                bf16* dst = isq ? Q + ((size_t)(b * 16 + hi2) * S + pos) * 64 : Kb + ((size_t)(b * 16 + hi2) * KEYS + pos) * 64;
                const float scl = isq ? QSCALE : 1.0f;
#pragma unroll
                for (int ni = 0; ni < 4; ++ni) {
                    u32x2 ov; ov.x = pk2(o[ni].x * scl, o[ni].y * scl); ov.y = pk2(o[ni].z * scl, o[ni].w * scl);
                    *(u32x2*)(dst + ni * 16 + fq * 4) = ov;
                }
            }
        } else {
#pragma unroll
            for (int mi = 0; mi < 4; ++mi) {
                const int row = m0 + wr * 64 + mi * 16 + fr;
                int b, pos;
                if (!isctx) { b = row >> 12; pos = row & 4095; } else { b = (row - NX) >> 8; pos = S + ((row - NX) & 255); }
                const int ppos = (pos & ~12) | ((pos & 4) << 1) | ((pos & 8) >> 1);
#pragma unroll
                for (int ni = 0; ni < 4; ++ni) {
                    const int col = (n0 - 2048) + wc * 64 + ni * 16 + fq * 4, h = col >> 7, vd = col & 127;
                    bf16* vp = VT + ((size_t)(b * 8 + h) * 128 + vd) * KEYS + ppos;
                    const f32x4 v = acc[mi][ni];
                    const unsigned p01 = pk2(v.x, v.y), p23 = pk2(v.z, v.w);
                    vp[0] = (bf16)(p01 & 0xffffu); vp[KEYS] = (bf16)(p01 >> 16); vp[2 * KEYS] = (bf16)(p23 & 0xffffu); vp[3 * KEYS] = (bf16)(p23 >> 16);
                }
            }
        }
    }
}

constexpr int ATT_STAGE = 32768;
__device__ __forceinline__ int crow(int r, int hi) { return (r & 3) + 8 * (r >> 2) + 4 * hi; }
__device__ __forceinline__ void phase_attn(Frame& F) {
    const Args& A = *F.a;
    const int tid = F.tid, lane = F.lane, w = F.wave, r32 = lane & 31, hi = lane >> 5;
    const int mp = w >> 2, wq = w & 3;
    LAS char* lds = F.lds;
    float lam;
    { const float* dl = A.in[I_DALAM]; const float s1 = wave_sum(dl[lane] * dl[64 + lane]), s2 = wave_sum(dl[128 + lane] * dl[192 + lane]);
      lam = expf(s1) - expf(s2) + (0.8f - 0.6f * expf(-0.3f)); }
    const float oscale = 1.0f - (0.8f - 0.6f * expf(-0.3f));
    const bf16* Q = (const bf16*)(F.ws + WS_Q); const bf16* Kb = (const bf16*)(F.ws + WS_K); const bf16* VT = (const bf16*)(F.ws + WS_VT);
    bf16* AO = (bf16*)(F.ws + WS_AO);
    constexpr int NUNITS = NB * 8 * (S / 128), NTILES = KEYS / 64;
    LAS char* cbuf = lds + 65536 + w * 4096;
    const int cgw = F.vcu * NWAVES + w, CNGW = F.G * NWAVES;
    int cit = cgw; bool chas = cit < ND_ATTN;
    if (chas) { const TDesc cd = L1_FP8 ? decode_moe8(F, cit) : decode_moe(F, cit, 1); tr3_dma(cd, lane, cbuf); }
    for (int u = F.vcu; u < NUNITS; u += F.G) {
        const int bh = u >> 5, qb = u & 31, q0 = qb * 128;
        const bf16* Kg[2]; Kg[0] = Kb + (size_t)(bh * 2 + 0) * KEYS * 64; Kg[1] = Kb + (size_t)(bh * 2 + 1) * KEYS * 64;
        const bf16* Vg = VT + (size_t)bh * 128 * KEYS;
        LAS char* qlds = lds + 98304 + w * 4096;
        { const bf16* qp = Q + ((size_t)(bh * 2 + mp) * S + q0 + wq * 32 + r32) * 64 + hi * 8;
#pragma unroll
          for (int ks = 0; ks < 4; ++ks) __builtin_amdgcn_global_load_lds((const unsigned*)(qp + ks * 16), (LAS unsigned*)(qlds + ks * 1024), 16, 0, 0); }
        f32x16 o[4];
#pragma unroll
        for (int vb = 0; vb < 4; ++vb)
#pragma unroll
            for (int r = 0; r < 16; ++r) o[vb][r] = 0.f;
        float mrun = 0.f, lrun = 0.f;
        const int drow = w * 8 + (lane >> 3), dch = ((lane & 7) ^ ((drow >> 1) & 7)) * 8;
        const bf16* gk0 = Kg[0] + (size_t)drow * 64 + dch; const bf16* gk1 = Kg[1] + (size_t)drow * 64 + dch;
        const bf16* gv0 = Vg + (size_t)drow * KEYS + dch; const bf16* gv1 = Vg + (size_t)(64 + drow) * KEYS + dch;
#define ATT_DMA(t_, st_) do { LAS char* sb_ = lds + (st_) * ATT_STAGE + w * 1024; \
            __builtin_amdgcn_global_load_lds((const unsigned*)(gk0 + (size_t)(t_) * 64 * 64), (LAS unsigned*)(sb_), 16, 0, 0); \
            __builtin_amdgcn_global_load_lds((const unsigned*)(gk1 + (size_t)(t_) * 64 * 64), (LAS unsigned*)(sb_ + 8192), 16, 0, 0); \
            __builtin_amdgcn_global_load_lds((const unsigned*)(gv0 + (t_) * 64), (LAS unsigned*)(sb_ + 16384), 16, 0, 0); \
            __builtin_amdgcn_global_load_lds((const unsigned*)(gv1 + (t_) * 64), (LAS unsigned*)(sb_ + 16384 + 8192), 16, 0, 0); } while (0)
        ATT_DMA(0, 0);
        __syncthreads();
        for (int t = 0; t < NTILES; ++t) {
            const int st = t & 1;
            if (t + 1 < NTILES) ATT_DMA(t + 1, st ^ 1);
            const LAS char* Kt = lds + st * ATT_STAGE + mp * 8192;
            const LAS char* Vt = lds + st * ATT_STAGE + 16384;
            f32x16 s0, s1;
            { const float nm = -mrun;
#pragma unroll
              for (int r = 0; r < 16; ++r) { s0[r] = nm; s1[r] = nm; } }
            bf16x8 kf[8], qf[4];
#pragma unroll
            for (int ks = 0; ks < 4; ++ks) qf[ks] = *(const LAS bf16x8*)(qlds + ks * 1024 + lane * 16);
#pragma unroll
            for (int ks = 0; ks < 4; ++ks) {
                kf[2 * ks] = *(const LAS bf16x8*)(Kt + swz128(r32, 2 * ks + hi));
                kf[2 * ks + 1] = *(const LAS bf16x8*)(Kt + swz128(32 + r32, 2 * ks + hi));
            }
            u32x4 vf[2][4];
#define VLOAD(dst, vb_) do { const int vrow_ = (vb_) * 32 + r32; _Pragma("unroll") for (int kk_ = 0; kk_ < 4; ++kk_) \
                dst[kk_] = *(const LAS u32x4*)(Vt + swz128(vrow_, 2 * kk_ + hi)); } while (0)
            VLOAD(vf[0], 0);
            __builtin_amdgcn_sched_barrier(0);

#pragma unroll
            for (int ks = 0; ks < 4; ++ks) {
                s0 = __builtin_amdgcn_mfma_f32_32x32x16_bf16(kf[2 * ks], qf[ks], s0, 0, 0, 0);
                s1 = __builtin_amdgcn_mfma_f32_32x32x16_bf16(kf[2 * ks + 1], qf[ks], s1, 0, 0, 0);
            }

            float mx = fmaxf(s0[0], s1[0]);
#pragma unroll
            for (int r = 1; r < 16; ++r) mx = fmaxf(mx, fmaxf(s0[r], s1[r]));
            { const auto rr = __builtin_amdgcn_permlane32_swap(__builtin_bit_cast(unsigned, mx), __builtin_bit_cast(unsigned, mx), false, false);
              mx = fmaxf(__builtin_bit_cast(float, rr[0]), __builtin_bit_cast(float, rr[1])); }
            if (t == 0 || __any(mx > 8.0f)) {
                const float dl = (t == 0) ? mx : fmaxf(mx, 0.f);
                mrun += dl;
#pragma unroll
                for (int r = 0; r < 16; ++r) { s0[r] -= dl; s1[r] -= dl; }
                if (t > 0) {
                    const float f = __builtin_amdgcn_exp2f(-dl);
                    lrun *= f;
#pragma unroll
                    for (int vb = 0; vb < 4; ++vb)
#pragma unroll
                        for (int r = 0; r < 16; ++r) o[vb][r] *= f;
                }
            }
            float psum = 0.f;
#pragma unroll
            for (int r = 0; r < 16; ++r) { s0[r] = __builtin_amdgcn_exp2f(s0[r]); s1[r] = __builtin_amdgcn_exp2f(s1[r]); psum += s0[r] + s1[r]; }
            lrun += psum;
            bf16x8 pf[4];
#pragma unroll
            for (int s = 0; s < 2; ++s) {
                u32x4 a, b2;
                a.x = pk2(s0[8 * s + 0], s0[8 * s + 1]); a.y = pk2(s0[8 * s + 2], s0[8 * s + 3]); a.z = pk2(s0[8 * s + 4], s0[8 * s + 5]); a.w = pk2(s0[8 * s + 6], s0[8 * s + 7]);
                b2.x = pk2(s1[8 * s + 0], s1[8 * s + 1]); b2.y = pk2(s1[8 * s + 2], s1[8 * s + 3]); b2.z = pk2(s1[8 * s + 4], s1[8 * s + 5]); b2.w = pk2(s1[8 * s + 6], s1[8 * s + 7]);
                pf[s] = __builtin_bit_cast(bf16x8, a); pf[2 + s] = __builtin_bit_cast(bf16x8, b2);
            }
#pragma unroll
            for (int vb = 0; vb < 4; ++vb) {
                if (vb + 1 < 4) VLOAD(vf[(vb + 1) & 1], vb + 1);
                __builtin_amdgcn_sched_barrier(0);

#pragma unroll
                for (int kk = 0; kk < 4; ++kk)
                    o[vb] = __builtin_amdgcn_mfma_f32_32x32x16_bf16(__builtin_bit_cast(bf16x8, vf[vb & 1][kk]), pf[kk], o[vb], 0, 0, 0);

            }
#undef VLOAD
            __syncthreads();
            if ((t % 11) == 5 && chas) {
                asm volatile("s_waitcnt vmcnt(0)" ::: "memory");
                { if (L1_FP8) { const TDesc cd = decode_moe8(F, cit); tr3_finish_fp8(cd, lane, cbuf); } else { const TDesc cd = decode_moe(F, cit, 1); tr3_finish(cd, lane, cbuf); } }
                LDS_WAIT();
                cit += CNGW; chas = cit < ND_ATTN;
                if (chas) { const TDesc cd = L1_FP8 ? decode_moe8(F, cit) : decode_moe(F, cit, 1); tr3_dma(cd, lane, cbuf); }
            }
        }
#undef ATT_DMA
        lrun += __shfl_xor(lrun, 32);
        const float linv = 1.0f / lrun;
        LAS float* XO = (LAS float*)lds;
        if (mp == 1) {
#pragma unroll
            for (int vb = 0; vb < 4; ++vb)
#pragma unroll
                for (int r = 0; r < 16; ++r) XO[(wq * 64 + vb * 16 + r) * 64 + lane] = o[vb][r] * linv;
        }
        __syncthreads();
        if (mp == 0) {
            float ssq = 0.f;
#pragma unroll
            for (int vb = 0; vb < 4; ++vb)
#pragma unroll
                for (int r = 0; r < 16; ++r) { const float v = o[vb][r] * linv - lam * XO[(wq * 64 + vb * 16 + r) * 64 + lane]; o[vb][r] = v; ssq += v * v; }
            ssq += __shfl_xor(ssq, 32);
            const float rstd = rsqrtf(ssq * (1.0f / 128.0f) + EPS) * oscale;
            const int b = bh >> 3, h = bh & 7;
            bf16* dst = AO + (size_t)(b * S + q0 + wq * 32 + r32) * D + h * 128;
            const float* sg = A.in[I_SUBLN];
#pragma unroll
            for (int vb = 0; vb < 4; ++vb)
#pragma unroll
                for (int rq = 0; rq < 4; ++rq) {
                    const int v0 = vb * 32 + 8 * rq + 4 * hi;
                    const f32x4 g4 = *(const f32x4*)(sg + v0);
                    u32x2 ov; ov.x = pk2(o[vb][4 * rq] * rstd * g4.x, o[vb][4 * rq + 1] * rstd * g4.y); ov.y = pk2(o[vb][4 * rq + 2] * rstd * g4.z, o[vb][4 * rq + 3] * rstd * g4.w);
                    *(u32x2*)(dst + v0) = ov;
                }
        }
        __syncthreads();
    }
    while (chas) {
        asm volatile("s_waitcnt vmcnt(0)" ::: "memory");
        { if (L1_FP8) { const TDesc cd = decode_moe8(F, cit); tr3_finish_fp8(cd, lane, cbuf); } else { const TDesc cd = decode_moe(F, cit, 1); tr3_finish(cd, lane, cbuf); } }
        LDS_WAIT();
        cit += CNGW; chas = cit < ND_ATTN;
        if (chas) { const TDesc cd = L1_FP8 ? decode_moe8(F, cit) : decode_moe(F, cit, 1); tr3_dma(cd, lane, cbuf); }
    }
}

__device__ __forceinline__ void phase_gemm_wo(Frame& F) {
    const bf16* AO = (const bf16*)(F.ws + WS_AO); const bf16* W = (const bf16*)(F.ws + WS_WO);
    float* XA = (float*)(F.ws + WS_XA);
    const int wr = F.wave >> 2, wc = F.wave & 3, fr = F.lane & 15, fq = F.lane >> 4;
    constexpr int NTN = 4, NUNITS = (NX / 128) * NTN;
    ALDense al; const bf16* Bp = W;
    if (F.vcu < NUNITS) { al.init(AO, D, (F.vcu / NTN) * 128, F.tid >> 3, (F.tid >> 3) + 64, dma_kc(F.tid)); Bp = W + (size_t)((F.vcu % NTN) * 256) * D; gemm3_prefetch(F, al, Bp, D); }
    for (int u = F.vcu; u < NUNITS; u += F.G) {
        const int mt = u / NTN, nt = u % NTN, m0 = mt * 128, n0 = nt * 256;
        f32x4 acc[4][4];
        gemm3_tile<true, 16>(F, al, Bp, D, acc, u == F.vcu);
        { const int un = u + F.G; if (un < NUNITS) { al.init(AO, D, (un / NTN) * 128, F.tid >> 3, (F.tid >> 3) + 64, dma_kc(F.tid)); Bp = W + (size_t)((un % NTN) * 256) * D; gemm3_prefetch(F, al, Bp, D); } }
#pragma unroll
        for (int mi = 0; mi < 4; ++mi) {
            const int row = m0 + wr * 64 + mi * 16 + fr;
            const float* gate = modp(F, 1, row >> 12, 2);
#pragma unroll
            for (int ni = 0; ni < 4; ++ni) {
                const int col = n0 + wc * 64 + ni * 16 + fq * 4;
                float* xp = XA + (size_t)row * D + col;
                const f32x4 s = *(const f32x4*)xp, gt = *(const f32x4*)(gate + col);
                *(f32x4*)xp = s + gt * acc[mi][ni];
            }
        }
    }
}

__device__ __forceinline__ void phase_final(Frame& F) {
    const Args& A = *F.a;
    const int gw = F.vcu * NWAVES + F.wave, NGW = F.G * NWAVES;
    const int2* TS = (const int2*)(F.ws + WS_TOKSLOT);
    CRow cn; int2 tsn = make_int2(0, 0);
    if (gw < NX) crow_load(F, gw, TS[gw], cn);
    if (gw + NGW < NX) tsn = TS[gw + NGW];
    for (int row = gw; row < NX; row += NGW) {
        const CRow cr = cn;
        const int nr = row + NGW;
        if (nr < NX) crow_load(F, nr, tsn, cn);
        if (nr + NGW < NX) tsn = TS[nr + NGW];
        f32x4 v[4];
        crow_combine(F, cr, modp(F, 1, row >> 12, 5), v);
        const float rstd = row_rstd(v);
#pragma unroll
        for (int j = 0; j < 4; ++j) {
            const int c0 = 4 * F.lane + 256 * j;
            const f32x4 g = *(const f32x4*)(A.in[I_FG] + c0);
            *(f32x4*)(A.out + (size_t)row * D + c0) = (v[j] * rstd) * g;
        }
    }
}

__global__ void __launch_bounds__(NTHREADS) fwd_kernel(Args args) {
    extern __shared__ __attribute__((aligned(16))) unsigned char smem[];
    Frame F;
    F.lds = (LAS char*)smem;
    F.tid = threadIdx.x; F.lane = F.tid & 63; F.wave = __builtin_amdgcn_readfirstlane(F.tid >> 6);
    F.G = gridDim.x; { const int bx = blockIdx.x; F.vcu = (F.G % 8 == 0) ? (bx % 8) * (F.G / 8) + bx / 8 : bx; }
    F.a = &args; F.ws = args.ws;
    volatile LAS unsigned* xbw = (volatile LAS unsigned*)(F.lds + LDS_XB);
    if (F.tid < 4) xbw[F.tid] = 0u;
    __syncthreads();
    XcdBarrier bar; bar.bar = (unsigned*)(F.ws + WS_CTL); bar.x = 0; bar.st = xbw;
    const int lo = args.ph_lo, hi = args.ph_hi;
    const bool multi = (hi - lo) > 1;
    if (multi) bar = xcd_barrier_post((unsigned*)(F.ws + WS_CTL), xbw);
#ifdef PROBE_PHASE
    unsigned long long pt0 = 0, pt1 = 0;
#define RUN_PHASE(k, call) do { if (lo <= (k) && (k) < hi) { if ((k) == PROBE_PHASE) pt0 = __builtin_amdgcn_s_memrealtime(); call; if ((k) + 1 < hi) xcd_barrier(bar); if ((k) == PROBE_PHASE) pt1 = __builtin_amdgcn_s_memrealtime(); } } while (0)
#else
#define RUN_PHASE(k, call) do { if (lo <= (k) && (k) < hi) { call; if ((k) + 1 < hi) xcd_barrier(bar); } } while (0)
#endif
    RUN_PHASE(0, phase_convert(F));
    RUN_PHASE(1, phase_prep0(F));
    RUN_PHASE(2, phase_gemm_in(F));
    RUN_PHASE(3, phase_scan(F));
    RUN_PHASE(4, (phase_combine_h(F), xcd_barrier(bar), phase_gemm_out0(F)));
    RUN_PHASE(5, phase_route<0>(F));
    RUN_PHASE(6, phase_slots<0>(F));
    RUN_PHASE(7, phase_moe_up<0>(F));
    RUN_PHASE(8, phase_moe_down<0>(F));
    RUN_PHASE(9, phase_combine0(F));
    RUN_PHASE(10, phase_qkv(F));
    RUN_PHASE(11, phase_attn(F));
    RUN_PHASE(12, phase_gemm_wo(F));
    RUN_PHASE(13, phase_route<1>(F));
    RUN_PHASE(14, phase_slots<1>(F));
    RUN_PHASE(15, phase_moe_up<1>(F));
    RUN_PHASE(16, phase_moe_down<1>(F));
    RUN_PHASE(17, phase_final(F));
#undef RUN_PHASE
#ifdef PROBE_PHASE
    xcd_barrier(bar);
    if (blockIdx.x == 0 && F.tid == 0) args.out[0] = 40.0f + floorf((float)(pt1 - pt0) * 0.001f + 0.5f);
#endif
}

extern "C" void kernel_launch(void* const* d_in, const int* in_sizes, int n_in, void* d_out, int out_size, void* d_ws, size_t ws_size, hipStream_t stream) {
    static int grid = 0;
    if (grid == 0) {
        if (n_in != 27 || out_size != NX * D || ws_size < WS_END) { fprintf(stderr, "kernel_launch: unexpected shapes (n_in %d out %d ws %zu)\n", n_in, out_size, ws_size); grid = -1; return; }
        int dev = 0, cus = 0;
        if (hipGetDevice(&dev) != hipSuccess || hipDeviceGetAttribute(&cus, hipDeviceAttributeMultiprocessorCount, dev) != hipSuccess) { grid = -1; return; }
        if (hipFuncSetAttribute((const void*)fwd_kernel, hipFuncAttributeMaxDynamicSharedMemorySize, LDS_BYTES) != hipSuccess) { fprintf(stderr, "kernel_launch: hipFuncSetAttribute failed\n"); grid = -1; return; }
        (void)hipGetLastError();
        grid = cus < 256 ? cus : 256;
    }
    if (grid < 0) return;
    (void)hipMemsetAsync((char*)d_ws + WS_CTL, 0, CTL_ZERO_BYTES, stream);
    Args a{};
    for (int i = 0; i < 27; ++i) a.in[i] = (const float*)d_in[i];
    a.out = (float*)d_out; a.ws = (unsigned char*)d_ws;
    if (MK_N_LAUNCHES == 1) {
        a.ph_lo = 0; a.ph_hi = NPHASES;
        hipLaunchKernelGGL(fwd_kernel, dim3(grid), dim3(NTHREADS), LDS_BYTES, stream, a);
    } else {
        if (DBG_NPH == 0) { a.ph_lo = 0; a.ph_hi = 0; hipLaunchKernelGGL(fwd_kernel, dim3(grid), dim3(NTHREADS), LDS_BYTES, stream, a); }
        for (int p = 0; p < DBG_NPH; ++p) { a.ph_lo = p; a.ph_hi = p + 1; hipLaunchKernelGGL(fwd_kernel, dim3(grid), dim3(NTHREADS), LDS_BYTES, stream, a); }
    }
}
```

```cpp
#include <hip/hip_runtime.h>
#include <cstdio>
#include <cstdint>

#ifndef MK_N_LAUNCHES
#define MK_N_LAUNCHES 1
#endif

#ifndef DBG_NPH
#define DBG_NPH 18
#endif
#define LAS __attribute__((address_space(3)))
typedef unsigned short bf16;
typedef short bf16x8 __attribute__((ext_vector_type(8)));
typedef float f32x4 __attribute__((ext_vector_type(4)));
typedef float f32x16 __attribute__((ext_vector_type(16)));
typedef unsigned u32x4 __attribute__((ext_vector_type(4)));
typedef unsigned u32x2 __attribute__((ext_vector_type(2)));
typedef float f32x2 __attribute__((ext_vector_type(2)));

constexpr int D = 1024, NB = 4, S = 4096, CL = 256;
constexpr int NX = NB * S, NC = NB * CL, NTOK = NX + NC;
constexpr int NEXP = 32, DEXP = 512;
constexpr int NWAVES = 8, NTHREADS = 512;
constexpr int KEYS = S + CL;
constexpr float EPS = 1e-6f;
constexpr int PMAX = 43008;
constexpr int NPHASES = 18;
constexpr float QSCALE = 0.125f * 1.4426950408889634f;

constexpr size_t MiB = 1u << 20;
constexpr size_t WS_CTL = 0, CTL_ZERO_BYTES = 64 * 1024;
constexpr size_t WS_MOD = 1 * MiB;
constexpr size_t WS_SEL = 2 * MiB;
constexpr size_t WS_WT = WS_SEL + 256 * 1024;
constexpr size_t WS_LRANK = WS_WT + 256 * 1024;
constexpr size_t WS_TOKSLOT = WS_LRANK + 256 * 1024;
constexpr size_t WS_BLKCNT = WS_TOKSLOT + 256 * 1024;
constexpr size_t WS_PSTART = WS_BLKCNT + 64 * 1024;
constexpr size_t WS_SLOTTOK = 3 * MiB + 512 * 1024;
constexpr size_t WS_SLOTW = WS_SLOTTOK + 256 * 1024;
constexpr size_t WS_WIN = 4 * MiB;
constexpr size_t WS_WOUT = 8 * MiB;
constexpr size_t WS_GATE = 10 * MiB;
constexpr size_t WS_WQKV = 11 * MiB;
constexpr size_t WS_WO = 17 * MiB;
constexpr size_t WS_WUP = 20 * MiB;
constexpr size_t WS_WDN = 148 * MiB;
constexpr size_t WS_XA = 212 * MiB;
constexpr size_t WS_H = 280 * MiB;
constexpr size_t WS_R = 314 * MiB;
constexpr size_t WS_YG = WS_R, WS_U = WS_R + 34 * MiB, WS_HF = WS_R + 68 * MiB, WS_HB = WS_R + 102 * MiB;
constexpr size_t WS_G = WS_R, WS_Y = WS_R + 42 * MiB;
constexpr size_t WS_Q = WS_R, WS_K = WS_R + 32 * MiB, WS_VT = WS_R + 66 * MiB, WS_AO = WS_R + 100 * MiB;
constexpr size_t WS_DELTA = 450 * MiB;
constexpr size_t WS_END = 482 * MiB;
static_assert(WS_Y + (size_t)PMAX * 1024 * 2 <= WS_END && WS_HB + 34 * MiB <= WS_END && WS_AO + 32 * MiB <= WS_END, "ws map");
static_assert(WS_K + (size_t)NB * 8 * 2 * KEYS * 64 * 2 <= WS_VT && WS_VT + (size_t)NB * 8 * 128 * KEYS * 2 <= WS_AO, "attn map");

constexpr int LDS_BYTES = 163840;
constexpr int LDS_XB = LDS_BYTES - 64;
constexpr int LDS_AUX = 147456;

__device__ __forceinline__ unsigned f2bf(float f) { unsigned u = __builtin_bit_cast(unsigned, f); return (u + 0x7fffu + ((u >> 16) & 1u)) >> 16; }
#ifndef L1_FP8
#define L1_FP8 1
#endif
typedef int i32x8 __attribute__((ext_vector_type(8)));
__device__ __forceinline__ unsigned pk4_fp8(float a, float b, float c, float d) { int w = 0; w = __builtin_amdgcn_cvt_pk_fp8_f32(a, b, w, false); w = __builtin_amdgcn_cvt_pk_fp8_f32(c, d, w, true); return (unsigned)w; }
constexpr int FP8_SCALE_ONE = 0x7f7f7f7f, FP8_SCALE_W = 0x7a7a7a7a  , FP8_SCALE_G = 0x7c7c7c7c  ;
typedef __bf16 bf16x2_t __attribute__((ext_vector_type(2)));
__device__ __forceinline__ unsigned pk2(float lo, float hi) { const f32x2 v = {lo, hi}; const bf16x2_t b = __builtin_convertvector(v, bf16x2_t); return __builtin_bit_cast(unsigned, b); }
__device__ __forceinline__ float bflo(unsigned w) { return __builtin_bit_cast(float, w << 16); }
__device__ __forceinline__ float bfhi(unsigned w) { return __builtin_bit_cast(float, w & 0xffff0000u); }
__device__ __forceinline__ float wave_sum(float v) {
#pragma unroll
    for (int o = 1; o < 64; o <<= 1) v += __shfl_xor(v, o);
    return v;
}
__device__ __forceinline__ float sigmoidf_(float x) { return 1.0f / (1.0f + __expf(-x)); }
#define LDS_WAIT() asm volatile("s_waitcnt lgkmcnt(0)" ::: "memory")

#define XB_TMO      128
#define XB_XCNT(j)  (256  + 64 * (j))
#define XB_XSUB(j)  (1280 + 64 * (j))
#define XB_XGEN(j)  (2304 + 64 * (j))
#define XB_TOP      3328
#define XB_TOPGEN   3392
#define XCD_BAR_WORDS 3456
#define XB_SPIN_CAP (1u << 18)
__device__ __forceinline__ unsigned xb_ld(unsigned* p)              { return __hip_atomic_load(p, __ATOMIC_RELAXED, __HIP_MEMORY_SCOPE_AGENT); }
__device__ __forceinline__ unsigned xb_add(unsigned* p, unsigned v) { return __hip_atomic_fetch_add(p, v, __ATOMIC_RELAXED, __HIP_MEMORY_SCOPE_AGENT); }
__device__ __forceinline__ unsigned xb_xcc_id() { return (unsigned)__builtin_amdgcn_s_getreg((3 << 11) | 20) & 0xFu; }
#define XB_SPIN(cond, bar) do { unsigned _sp = 0; while (cond) { __builtin_amdgcn_s_sleep(1); \
    if ((++_sp & 255u) == 0u) { if (xb_ld(&(bar)[XB_TMO])) break; if (_sp > XB_SPIN_CAP) { atomicAdd(&(bar)[XB_TMO], 1u); break; } } } } while (0)
struct XcdBarrier { unsigned* bar; unsigned x; volatile LAS unsigned* st; };
__device__ __forceinline__ XcdBarrier xcd_barrier_post(unsigned* bar, volatile LAS unsigned* st) {
    XcdBarrier b; b.bar = bar; b.x = xb_xcc_id(); b.st = st;
    if (threadIdx.x == 0) (void)xb_add(&bar[XB_XCNT(b.x)], 1u);
    return b;
}
__device__ __forceinline__ void xcd_barrier_complete(unsigned* bar, unsigned x, unsigned& nloc, unsigned& nx) {
    const unsigned G = gridDim.x * gridDim.y * gridDim.z;
    unsigned sum, cnt, mine, sp = 0u;
    for (;;) {
        sum = 0u; cnt = 0u; mine = 0u;
#pragma unroll
        for (unsigned j = 0; j < 16; ++j) { const unsigned c = xb_ld(&bar[XB_XCNT(j)]); sum += c; cnt += (c > 0u) ? 1u : 0u; mine = (j == x) ? c : mine; }
        if (sum == G) break;
        __builtin_amdgcn_s_sleep(1);
        if ((++sp & 255u) == 0u) { if (xb_ld(&bar[XB_TMO])) break; if (sp > XB_SPIN_CAP) { atomicAdd(&bar[XB_TMO], 1u); break; } }
    }
    nloc = mine > 0u ? mine : 1u; nx = cnt > 0u ? cnt : 1u;
}
__device__ __forceinline__ void xcd_barrier(const XcdBarrier& b) {
    asm volatile("s_waitcnt vmcnt(0)" ::: "memory");
    __syncthreads();
    if (threadIdx.x == 0) {
        unsigned* bar = b.bar;
        __builtin_amdgcn_s_waitcnt(0);
        unsigned nloc = b.st[0], nx = b.st[1];
        if (nloc == 0u) { xcd_barrier_complete(bar, b.x, nloc, nx); b.st[0] = nloc; b.st[1] = nx; }
        const unsigned old = xb_add(&bar[XB_XSUB(b.x)], 1u);
        const unsigned gen = old / nloc;
        if (old + 1u == (gen + 1u) * nloc) {
            __builtin_amdgcn_fence(__ATOMIC_RELEASE, "agent");
            asm volatile("s_waitcnt vmcnt(0)" ::: "memory");
            const unsigned og = xb_add(&bar[XB_TOP], 1u);
            const unsigned tg = og / nx;
            if (og + 1u == (tg + 1u) * nx) xb_add(&bar[XB_TOPGEN], 1u);
            else XB_SPIN(xb_ld(&bar[XB_TOPGEN]) == tg, bar);
            __builtin_amdgcn_fence(__ATOMIC_ACQUIRE, "agent");
            xb_add(&bar[XB_XGEN(b.x)], 1u);
            asm volatile("s_waitcnt vmcnt(0)" ::: "memory");
        } else {
            XB_SPIN(xb_ld(&bar[XB_XGEN(b.x)]) == gen, bar);
            __builtin_amdgcn_fence(__ATOMIC_ACQUIRE, "agent");
            asm volatile("s_waitcnt vmcnt(0)" ::: "memory");
        }
    }
    __syncthreads();
}

struct Args { const float* in[27]; float* out; unsigned char* ws; int ph_lo, ph_hi; };
enum { I_X = 0, I_C, I_CTX, I_CCTX, I_WMOD, I_BMOD, I_N1G, I_N2G, I_WIN, I_CONVW, I_CONVB, I_GAW, I_GAB, I_GXW, I_GXB, I_LAM, I_WOUT,
       I_WQKV, I_DALAM, I_SUBLN, I_WO, I_RW, I_RB, I_MG, I_MU, I_MD, I_FG };

struct Frame {
    LAS char* lds;
    int tid, lane, wave, vcu, G;
    const Args* a;
    unsigned char* ws;
};

__device__ __forceinline__ const float* modp(const Frame& F, int l, int c, int k) { return (const float*)(F.ws + WS_MOD) + (size_t)(l * 5 + c) * 6144 + k * 1024; }
__device__ __forceinline__ int cond_of(int row) { return row < NX ? (row >> 12) : 4; }

__device__ __forceinline__ int moe_up_row(int n) { return ((n >> 7) << 8) + (((n >> 5) & 3) << 6) + (((n >> 4) & 1) << 5) + (n & 15); }

struct TDesc { const float* W; bf16* WT; int N, ldT, mode, k0, n0; };
__device__ __forceinline__ void tr_load(const TDesc& t, int lane, f32x4 (&rg)[8]) {
    const float* p = t.W + (size_t)(t.k0 + (lane >> 3)) * t.N + t.n0 + 4 * (lane & 7);
#pragma unroll
    for (int i = 0; i < 8; ++i) rg[i] = *(const f32x4*)(p + (size_t)(8 * i) * t.N);
}
__device__ __forceinline__ void tr_finish(const TDesc& t, int lane, const f32x4 (&rg)[8], LAS float* scr) {
#pragma unroll
    for (int i = 0; i < 8; ++i) { LAS float* d = scr + ((lane >> 3) + 8 * i) * 33 + 4 * (lane & 7); d[0] = rg[i].x; d[1] = rg[i].y; d[2] = rg[i].z; d[3] = rg[i].w; }
    LDS_WAIT();
    const int c = lane & 7;
#pragma unroll
    for (int j = 0; j < 4; ++j) {
        const int n = (lane >> 3) + 8 * j; const LAS float* s = scr + (8 * c) * 33 + n;
        u32x4 o; o.x = pk2(s[0 * 33], s[1 * 33]); o.y = pk2(s[2 * 33], s[3 * 33]); o.z = pk2(s[4 * 33], s[5 * 33]); o.w = pk2(s[6 * 33], s[7 * 33]);
        const int nn = t.n0 + n;
        const int drow = (t.mode == 0) ? nn : (moe_up_row(nn) + (t.mode == 2 ? 16 : 0));
        *(u32x4*)(t.WT + (size_t)drow * t.ldT + t.k0 + 8 * c) = o;
    }
    LDS_WAIT();
}

__device__ __forceinline__ void phase_convert(Frame& F) {
    const Args& A = *F.a;
    LAS float* scr = (LAS float*)(F.lds + F.wave * 8448);
    LAS float* sil = (LAS float*)(F.lds + 69632);
    for (int i = F.tid; i < 5 * 1024; i += NTHREADS) { const int c = i >> 10, k = i & 1023; const float v = (c < 4) ? A.in[I_C][c * 1024 + k] : A.in[I_CCTX][k]; sil[i] = v / (1.0f + __expf(-v)); }
    __syncthreads();
    const int gw = F.vcu * NWAVES + F.wave, NGW = F.G * NWAVES;
    constexpr int N_MOD = 192, N_WIN = 16 * 64, N_WOUT = 16 * 32, N_WQKV = 16 * 96, N_WO = 16 * 32, N_GATE = 32 * 8, N_MOE = 64 * 256;
    {
        LAS float* red = (LAS float*)(F.lds + 90112);
        for (int item = F.vcu; item < N_MOD; item += F.G) {
            const int l = item / 96, col = (item % 96) * 64 + F.lane;
            const float* wp = A.in[I_WMOD] + ((size_t)l * 1024 + F.wave * 128) * 6144 + col;
            float acc[5] = {0.f, 0.f, 0.f, 0.f, 0.f};
#pragma unroll 4
            for (int k = 0; k < 128; k += 4) {
                const float w0 = wp[(size_t)k * 6144], w1 = wp[(size_t)(k + 1) * 6144], w2 = wp[(size_t)(k + 2) * 6144], w3 = wp[(size_t)(k + 3) * 6144];
#pragma unroll
                for (int c = 0; c < 5; ++c) { const f32x4 s4 = *(const LAS f32x4*)(sil + c * 1024 + F.wave * 128 + k); acc[c] += s4.x * w0 + s4.y * w1 + s4.z * w2 + s4.w * w3; }
            }
#pragma unroll
            for (int c = 0; c < 5; ++c) red[(F.wave * 5 + c) * 64 + F.lane] = acc[c];
            __syncthreads();
            if (F.tid < 320) {
                const int c = F.tid >> 6, ln = F.tid & 63;
                float s = A.in[I_BMOD][l * 6144 + (item % 96) * 64 + ln];
#pragma unroll
                for (int w2 = 0; w2 < 8; ++w2) s += red[(w2 * 5 + c) * 64 + ln];
                ((float*)(F.ws + WS_MOD))[(size_t)(l * 5 + c) * 6144 + (item % 96) * 64 + ln] = s;
            }
            __syncthreads();
        }
    }
    auto decode = [&](int r) -> TDesc {
        TDesc t; t.mode = 0;
        int item;
        if (r < N_WIN) { t.W = A.in[I_WIN]; t.N = 2048; t.WT = (bf16*)(F.ws + WS_WIN); t.ldT = 1024; item = r; }
        else if ((r -= N_WIN) < N_WOUT) { t.W = A.in[I_WOUT]; t.N = 1024; t.WT = (bf16*)(F.ws + WS_WOUT); t.ldT = 1024; item = r; }
        else {
            r -= N_WOUT;
            const int m = r >> 3, d = m >> 4, g = (m >> 3) & 1, n = m & 7;
            t.W = (g == 0 ? A.in[I_GAW] : A.in[I_GXW]) + (size_t)(d * 8 + n) * 128 * 128; t.N = 128;
            t.WT = (bf16*)(F.ws + WS_GATE) + (size_t)m * 128 * 128; t.ldT = 128; item = r & 7;
        }
        const int nblk = t.N >> 5; t.k0 = 64 * (item / nblk); t.n0 = 32 * (item % nblk);
        return t;
    };
    constexpr int NTR0 = N_WIN + N_WOUT + N_GATE;
    for (int it = gw; it < NTR0; it += NGW) {
        const TDesc cur = decode(it); f32x4 rg[8]; tr_load(cur, F.lane, rg);
        tr_finish(cur, F.lane, rg, scr);
    }
}

constexpr int ND_WQKV = 32 * 96, ND_WO = 32 * 32, ND_MOEL = 32 * 512;
constexpr int ND_SCAN = ND_WQKV + ND_WO + 3 * ND_MOEL;
constexpr int ND_ATTN = 3 * ND_MOEL;
__device__ __forceinline__ TDesc decode_moe(const Frame& F, int r, int layer) {
    const Args& A = *F.a;
    TDesc t; t.mode = 0; int item;
    if (r < ND_MOEL) { const int le = layer * 32 + (r >> 9); t.W = A.in[I_MG] + (size_t)le * 1024 * 512; t.N = 512; t.WT = (bf16*)(F.ws + WS_WUP) + (size_t)le * 1024 * 1024; t.ldT = 1024; t.mode = 1; item = r & 511; }
    else if ((r -= ND_MOEL) < ND_MOEL) { const int le = layer * 32 + (r >> 9); t.W = A.in[I_MU] + (size_t)le * 1024 * 512; t.N = 512; t.WT = (bf16*)(F.ws + WS_WUP) + (size_t)le * 1024 * 1024; t.ldT = 1024; t.mode = 2; item = r & 511; }
    else { r -= ND_MOEL; const int le = layer * 32 + (r >> 9); t.W = A.in[I_MD] + (size_t)le * 512 * 1024; t.N = 1024; t.WT = (bf16*)(F.ws + WS_WDN) + (size_t)le * 1024 * 512; t.ldT = 512; item = r & 511; }
    const int nblk = t.N >> 5; t.k0 = 32 * (item / nblk); t.n0 = 32 * (item % nblk);
    return t;
}
__device__ __forceinline__ TDesc decode_deferred(const Frame& F, int r) {
    const Args& A = *F.a;
    if (r >= ND_WQKV + ND_WO) return decode_moe(F, r - (ND_WQKV + ND_WO), 0);
    TDesc t; t.mode = 0; int item;
    if (r < ND_WQKV) { t.W = A.in[I_WQKV]; t.N = 3072; t.WT = (bf16*)(F.ws + WS_WQKV); t.ldT = 1024; item = r; }
    else { r -= ND_WQKV; t.W = A.in[I_WO]; t.N = 1024; t.WT = (bf16*)(F.ws + WS_WO); t.ldT = 1024; item = r; }
    const int nblk = t.N >> 5; t.k0 = 32 * (item / nblk); t.n0 = 32 * (item % nblk);
    return t;
}
__device__ __forceinline__ void tr3_dma(const TDesc& t, int lane, LAS char* buf) {
    const float* p = t.W + (size_t)(t.k0 + (lane >> 3)) * t.N + t.n0;
#pragma unroll
    for (int i = 0; i < 4; ++i)
        __builtin_amdgcn_global_load_lds((const unsigned*)(p + (size_t)(8 * i) * t.N + 4 * ((lane & 7) ^ i)), (LAS unsigned*)(buf + i * 1024), 16, 0, 0);
}
__device__ __forceinline__ void tr3_finish(const TDesc& t, int lane, const LAS char* buf) {
    const int c = lane & 3;
#pragma unroll
    for (int j = 0; j < 2; ++j) {
        const int n = (lane >> 2) + 16 * j;
        const LAS char* s = buf + (8 * c) * 128 + (((n >> 2) ^ c) << 4) + (n & 3) * 4;
        float x[8];
#pragma unroll
        for (int i = 0; i < 8; ++i) x[i] = *(const LAS float*)(s + i * 128);
        u32x4 o; o.x = pk2(x[0], x[1]); o.y = pk2(x[2], x[3]); o.z = pk2(x[4], x[5]); o.w = pk2(x[6], x[7]);
        const int nn = t.n0 + n;
        const int drow = (t.mode == 0) ? nn : (moe_up_row(nn) + (t.mode == 2 ? 16 : 0));
        *(u32x4*)(t.WT + (size_t)drow * t.ldT + t.k0 + 8 * c) = o;
    }
}
__device__ __forceinline__ void tr3_finish_fp8(const TDesc& t, int lane, const LAS char* buf) {
    const int c = lane & 1, n = lane >> 1;
    float x[16];
#pragma unroll
    for (int i = 0; i < 16; ++i) { const int r = 16 * c + i; x[i] = 32.0f * *(const LAS float*)(buf + r * 128 + (((n >> 2) ^ (r >> 3)) << 4) + (n & 3) * 4); }
    u32x4 o; o.x = pk4_fp8(x[0], x[1], x[2], x[3]); o.y = pk4_fp8(x[4], x[5], x[6], x[7]); o.z = pk4_fp8(x[8], x[9], x[10], x[11]); o.w = pk4_fp8(x[12], x[13], x[14], x[15]);
    const int nn = t.n0 + n;
    const int drow = (t.mode == 0) ? nn : (moe_up_row(nn) + (t.mode == 2 ? 16 : 0));
    *(u32x4*)((unsigned char*)t.WT + (size_t)drow * t.ldT + t.k0 + 16 * c) = o;
}
__device__ __forceinline__ TDesc decode_moe8(const Frame& F, int r) {
    const Args& A = *F.a;
    TDesc t; t.mode = 0; int item;
    unsigned char* up8 = F.ws + WS_WUP + (size_t)64 * MiB; unsigned char* dn8 = F.ws + WS_WDN + (size_t)32 * MiB;
    if (r < ND_MOEL) { const int e = r >> 9; t.W = A.in[I_MG] + (size_t)(32 + e) * 1024 * 512; t.N = 512; t.WT = (bf16*)(up8 + (size_t)e * 1024 * 1024); t.ldT = 1024; t.mode = 1; item = r & 511; }
    else if ((r -= ND_MOEL) < ND_MOEL) { const int e = r >> 9; t.W = A.in[I_MU] + (size_t)(32 + e) * 1024 * 512; t.N = 512; t.WT = (bf16*)(up8 + (size_t)e * 1024 * 1024); t.ldT = 1024; t.mode = 2; item = r & 511; }
    else { r -= ND_MOEL; const int e = r >> 9; t.W = A.in[I_MD] + (size_t)(32 + e) * 512 * 1024; t.N = 1024; t.WT = (bf16*)(dn8 + (size_t)e * 1024 * 512); t.ldT = 512; item = r & 511; }
    const int nblk = t.N >> 5; t.k0 = 32 * (item / nblk); t.n0 = 32 * (item % nblk);
    return t;
}
__device__ __forceinline__ void tr2_load(const TDesc& t, int lane, f32x4 (&rg)[4]) {
    const float* p = t.W + (size_t)(t.k0 + (lane >> 3)) * t.N + t.n0 + 4 * (lane & 7);
#pragma unroll
    for (int i = 0; i < 4; ++i) rg[i] = *(const f32x4*)(p + (size_t)(8 * i) * t.N);
}
__device__ __forceinline__ void tr2_finish(const TDesc& t, int lane, const f32x4 (&rg)[4], LAS float* scr  ) {
#pragma unroll
    for (int i = 0; i < 4; ++i) { LAS float* d = scr + ((lane >> 3) + 8 * i) * 33 + 4 * (lane & 7); d[0] = rg[i].x; d[1] = rg[i].y; d[2] = rg[i].z; d[3] = rg[i].w; }
    LDS_WAIT();
    const int c = lane & 3;
#pragma unroll
    for (int j = 0; j < 2; ++j) {
        const int n = (lane >> 2) + 16 * j; const LAS float* s = scr + (8 * c) * 33 + n;
        u32x4 o; o.x = pk2(s[0 * 33], s[1 * 33]); o.y = pk2(s[2 * 33], s[3 * 33]); o.z = pk2(s[4 * 33], s[5 * 33]); o.w = pk2(s[6 * 33], s[7 * 33]);
        const int nn = t.n0 + n;
        const int drow = (t.mode == 0) ? nn : (moe_up_row(nn) + (t.mode == 2 ? 16 : 0));
        *(u32x4*)(t.WT + (size_t)drow * t.ldT + t.k0 + 8 * c) = o;
    }
    LDS_WAIT();
}

__device__ __forceinline__ float row_rstd(const f32x4 (&v)[4]) {
    float s = 0.f;
#pragma unroll
    for (int j = 0; j < 4; ++j) s += (v[j].x * v[j].x + v[j].y * v[j].y) + (v[j].z * v[j].z + v[j].w * v[j].w);
    return rsqrtf(wave_sum(s) * (1.0f / D) + EPS);
}
__device__ __forceinline__ void row_modulate_store8(f32x4 (&v)[4], float rstd, const float* g, const float* sc, const float* sh, unsigned char* dst, int lane) {
#pragma unroll
    for (int j = 0; j < 4; ++j) {
        const int c0 = 4 * lane + 256 * j;
        const f32x4 gg = *(const f32x4*)(g + c0), s1 = *(const f32x4*)(sc + c0), s0 = *(const f32x4*)(sh + c0);
        v[j] = (v[j] * rstd) * gg * (1.0f + s1) + s0;
        *(unsigned*)(dst + c0) = pk4_fp8(v[j].x, v[j].y, v[j].z, v[j].w);
    }
}
__device__ __forceinline__ void row_modulate_store(f32x4 (&v)[4], float rstd, const float* g, const float* sc, const float* sh, bf16* dst, int lane) {
#pragma unroll
    for (int j = 0; j < 4; ++j) {
        const int c0 = 4 * lane + 256 * j;
        const f32x4 gg = *(const f32x4*)(g + c0), s1 = *(const f32x4*)(sc + c0), s0 = *(const f32x4*)(sh + c0);
        v[j] = (v[j] * rstd) * gg * (1.0f + s1) + s0;
        u32x2 o; o.x = pk2(v[j].x, v[j].y); o.y = pk2(v[j].z, v[j].w);
        *(u32x2*)(dst + c0) = o;
    }
}

__device__ __forceinline__ void load_row4(const float* src, int lane, f32x4 (&v)[4]) {
#pragma unroll
    for (int j = 0; j < 4; ++j) v[j] = *(const f32x4*)(src + 4 * lane + 256 * j);
}
__device__ __forceinline__ void phase_prep0(Frame& F) {
    const Args& A = *F.a;
    const int gw = F.vcu * NWAVES + F.wave, NGW = F.G * NWAVES;
    bf16* H = (bf16*)(F.ws + WS_H);
    f32x4 vn[4];
    if (gw < NTOK) load_row4(gw < NX ? A.in[I_X] + (size_t)gw * D : A.in[I_CTX] + (size_t)(gw - NX) * D, F.lane, vn);
    for (int row = gw; row < NTOK; row += NGW) {
        const int c = cond_of(row);
        f32x4 v[4];
#pragma unroll
        for (int j = 0; j < 4; ++j) v[j] = vn[j];
        const int nr = row + NGW;
        if (nr < NTOK) load_row4(nr < NX ? A.in[I_X] + (size_t)nr * D : A.in[I_CTX] + (size_t)(nr - NX) * D, F.lane, vn);
        const float rstd = row_rstd(v);
        row_modulate_store(v, rstd, A.in[I_N1G], modp(F, 0, c, 1), modp(F, 0, c, 0), H + (size_t)row * D, F.lane);
    }
}

constexpr int GEMM_STAGE = 49152;
__device__ __forceinline__ int swz128(int row, int chunk) { return row * 128 + ((chunk ^ ((row >> 1) & 7)) << 4); }
__device__ __forceinline__ int dma_kc(int tid) { return ((tid & 7) ^ ((tid >> 4) & 7)) * 8; }

struct ALDense {
    static constexpr bool DMA = true;
    const bf16* p0; const bf16* p1;
    __device__ __forceinline__ const bf16* ptr(int i) const { return i ? p1 : p0; }
    __device__ __forceinline__ void init(const bf16* A, int lda, int m0, int r0, int r1, int kc) { p0 = A + (size_t)(m0 + r0) * lda + kc; p1 = A + (size_t)(m0 + r1) * lda + kc; }
    __device__ __forceinline__ u32x4 load(int i, int k0) const { return *(const u32x4*)((i ? p1 : p0) + k0); }
};
struct ALGather {
    static constexpr bool DMA = true;
    const bf16* p0; const bf16* p1;
    __device__ __forceinline__ const bf16* ptr(int i) const { return i ? p1 : p0; }
    __device__ __forceinline__ void init(const bf16* A, int lda, const int* idx, int m0, int r0, int r1, int kc) { p0 = A + (size_t)idx[m0 + r0] * lda + kc; p1 = A + (size_t)idx[m0 + r1] * lda + kc; }
    __device__ __forceinline__ u32x4 load(int i, int k0) const { return *(const u32x4*)((i ? p1 : p0) + k0); }
};
struct ALCombine {
    static constexpr bool DMA = false;
    size_t o0, o1; const bf16 *hf, *hb, *yg;
    __device__ __forceinline__ const bf16* ptr(int) const { return nullptr; }
    __device__ __forceinline__ void init(const bf16* hf_, const bf16* hb_, const bf16* yg_, int m0, int r0, int r1, int kc) { hf = hf_; hb = hb_; yg = yg_; o0 = (size_t)(m0 + r0) * D + kc; o1 = (size_t)(m0 + r1) * D + kc; }
    __device__ __forceinline__ u32x4 load(int i, int k0) const {
        const size_t o = (i ? o1 : o0) + k0;
        const u32x4 a = *(const u32x4*)(hf + o), b = *(const u32x4*)(hb + o), y = *(const u32x4*)(yg + o);
        u32x4 r;
#pragma unroll
        for (int q = 0; q < 4; ++q) r[q] = pk2((bflo(a[q]) + bflo(b[q])) * bflo(y[q]), (bfhi(a[q]) + bfhi(b[q])) * bfhi(y[q]));
        return r;
    }
};

template <class AL>
__device__ __forceinline__ void gemm_prefetch(const Frame& F, const AL& al, const bf16* __restrict__ Bt, int K) {
    const int tid = F.tid, sr = tid >> 3, sc = (tid & 7) ^ ((sr >> 1) & 7), wl = F.wave * 1024;
    const bf16* bp = Bt + (size_t)sr * K + sc * 8;
    const size_t bstep = (size_t)64 * K;
    LAS char* lds = F.lds;
    __builtin_amdgcn_global_load_lds((const unsigned*)(al.ptr(0)), (LAS unsigned*)(lds + wl), 16, 0, 0);
    __builtin_amdgcn_global_load_lds((const unsigned*)(al.ptr(1)), (LAS unsigned*)(lds + 8192 + wl), 16, 0, 0);
#pragma unroll
    for (int i = 0; i < 4; ++i)
        __builtin_amdgcn_global_load_lds((const unsigned*)(bp + i * bstep), (LAS unsigned*)(lds + 16384 + i * 8192 + wl), 16, 0, 0);
}
template <bool SWAP, class AL, bool PRE = false>
__device__ __forceinline__ void gemm_tile(const Frame& F, const AL& al, const bf16* __restrict__ Bt  , int K, f32x4 (&acc)[4][4]) {
    const int tid = F.tid, lane = F.lane, wid = F.wave, wr = wid >> 2, wc = wid & 3, fr = lane & 15, fq = lane >> 4;
    const int sr = tid >> 3;
    const int sc = AL::DMA ? ((tid & 7) ^ ((sr >> 1) & 7)) : (tid & 7);
    LAS char* lds = F.lds;
    const bf16* bp = Bt + (size_t)sr * K + sc * 8;
    const size_t bstep = (size_t)64 * K;
    int wa[2], wb[4];
#pragma unroll
    for (int i = 0; i < 2; ++i) wa[i] = swz128(sr + 64 * i, sc);
#pragma unroll
    for (int i = 0; i < 4; ++i) wb[i] = 16384 + swz128(sr + 64 * i, sc);
    const int key = (fr >> 1) & 7;
    const int ra = (wr * 64 + fr) * 128, rb = 16384 + (wc * 64 + fr) * 128;
#pragma unroll
    for (int mi = 0; mi < 4; ++mi)
#pragma unroll
        for (int ni = 0; ni < 4; ++ni) acc[mi][ni] = (f32x4){0.f, 0.f, 0.f, 0.f};
    u32x4 ga[2], gb[4];
    const int wl = wid * 1024;
#define GT_DMA(stage_, k_) do { \
        __builtin_amdgcn_global_load_lds((const unsigned*)(al.ptr(0) + (k_)), (LAS unsigned*)(lds + (stage_) + wl), 16, 0, 0); \
        __builtin_amdgcn_global_load_lds((const unsigned*)(al.ptr(1) + (k_)), (LAS unsigned*)(lds + (stage_) + 8192 + wl), 16, 0, 0); \
        _Pragma("unroll") for (int i_ = 0; i_ < 4; ++i_) \
            __builtin_amdgcn_global_load_lds((const unsigned*)(bp + i_ * bstep + (k_)), (LAS unsigned*)(lds + (stage_) + 16384 + i_ * 8192 + wl), 16, 0, 0); } while (0)
    if constexpr (AL::DMA) { if constexpr (!PRE) { GT_DMA(0, 0); } }
    else {
        ga[0] = al.load(0, 0); ga[1] = al.load(1, 0);
#pragma unroll
        for (int i = 0; i < 4; ++i) gb[i] = *(const u32x4*)(bp + i * bstep);
#pragma unroll
        for (int i = 0; i < 2; ++i) *(LAS u32x4*)(lds + wa[i]) = ga[i];
#pragma unroll
        for (int i = 0; i < 4; ++i) *(LAS u32x4*)(lds + wb[i]) = gb[i];
    }
    __syncthreads();
    const int nk = K / 64;
    for (int kt = 0; kt < nk; ++kt) {
        const int cur = (kt & 1) * GEMM_STAGE, nxt = GEMM_STAGE - cur;
        if (kt + 1 < nk) {
            const int k1 = (kt + 1) * 64;
            if constexpr (AL::DMA) { GT_DMA(nxt, k1); }
            else {
                ga[0] = al.load(0, k1); ga[1] = al.load(1, k1);
#pragma unroll
                for (int i = 0; i < 4; ++i) gb[i] = *(const u32x4*)(bp + i * bstep + k1);
            }
        }
        {
            bf16x8 af[2][4], bfr[2][4];
#pragma unroll
            for (int ks = 0; ks < 2; ++ks) {
                const int co = ((ks * 4 + fq) ^ key) << 4;
#pragma unroll
                for (int mi = 0; mi < 4; ++mi) af[ks][mi] = *(const LAS bf16x8*)(lds + cur + ra + mi * 2048 + co);
#pragma unroll
                for (int ni = 0; ni < 4; ++ni) bfr[ks][ni] = *(const LAS bf16x8*)(lds + cur + rb + ni * 2048 + co);
            }
            __builtin_amdgcn_sched_barrier(0);
#pragma unroll
            for (int ks = 0; ks < 2; ++ks)
#pragma unroll
                for (int mi = 0; mi < 4; ++mi)
#pragma unroll
                    for (int ni = 0; ni < 4; ++ni)
                        acc[mi][ni] = SWAP ? __builtin_amdgcn_mfma_f32_16x16x32_bf16(bfr[ks][ni], af[ks][mi], acc[mi][ni], 0, 0, 0)
                                           : __builtin_amdgcn_mfma_f32_16x16x32_bf16(af[ks][mi], bfr[ks][ni], acc[mi][ni], 0, 0, 0);
            __builtin_amdgcn_sched_barrier(0);
        }
        if constexpr (!AL::DMA) {
            if (kt + 1 < nk) {
#pragma unroll
                for (int i = 0; i < 2; ++i) *(LAS u32x4*)(lds + nxt + wa[i]) = ga[i];
#pragma unroll
                for (int i = 0; i < 4; ++i) *(LAS u32x4*)(lds + nxt + wb[i]) = gb[i];
            }
        }
        __syncthreads();
    }
#undef GT_DMA
}

#define G3_WAIT_BAR(N) asm volatile("s_waitcnt vmcnt(" #N ") lgkmcnt(0)\n\ts_barrier" ::: "memory")
template <class AL>
__device__ __forceinline__ void gemm3_issue(const Frame& F, const AL& al, const bf16* bp, size_t bstep, int stage_off, int k) {
    LAS char* lds = F.lds; const int wl = F.wave * 1024;
    __builtin_amdgcn_global_load_lds((const unsigned*)(al.ptr(0) + k), (LAS unsigned*)(lds + stage_off + wl), 16, 0, 0);
    __builtin_amdgcn_global_load_lds((const unsigned*)(al.ptr(1) + k), (LAS unsigned*)(lds + stage_off + 8192 + wl), 16, 0, 0);
#pragma unroll
    for (int i = 0; i < 4; ++i)
        __builtin_amdgcn_global_load_lds((const unsigned*)(bp + i * bstep + k), (LAS unsigned*)(lds + stage_off + 16384 + i * 8192 + wl), 16, 0, 0);
}
template <class AL>
__device__ __forceinline__ void gemm3_prefetch(const Frame& F, const AL& al, const bf16* __restrict__ Bt, int K) {
    const int tid = F.tid, sr = tid >> 3, sc = (tid & 7) ^ ((sr >> 1) & 7);
    const bf16* bp = Bt + (size_t)sr * K + sc * 8;
    gemm3_issue(F, al, bp, (size_t)64 * K, 0, 0);
    gemm3_issue(F, al, bp, (size_t)64 * K, GEMM_STAGE, 64);
}
template <bool SWAP, int EPI_ST, class AL>
__device__ __forceinline__ void gemm3_tile(const Frame& F, const AL& al, const bf16* __restrict__ Bt, int K, f32x4 (&acc)[4][4], bool first_unit) {
    static_assert(EPI_ST == 8 || EPI_ST == 16, "EPI_ST");
    const int tid = F.tid, lane = F.lane, wid = F.wave, wr = wid >> 2, wc = wid & 3, fr = lane & 15, fq = lane >> 4;
    const int sr = tid >> 3, sc = (tid & 7) ^ ((sr >> 1) & 7);
    LAS char* lds = F.lds;
    const bf16* bp = Bt + (size_t)sr * K + sc * 8;
    const size_t bstep = (size_t)64 * K;
    const int key = (fr >> 1) & 7;
    const int ra = (wr * 64 + fr) * 128, rb = 16384 + (wc * 64 + fr) * 128;
#pragma unroll
    for (int mi = 0; mi < 4; ++mi)
#pragma unroll
        for (int ni = 0; ni < 4; ++ni) acc[mi][ni] = (f32x4){0.f, 0.f, 0.f, 0.f};
    const int nk = K / 64;
    int cur = 0, nx2 = 2 * GEMM_STAGE;
    const int wl = wid * 1024;
#pragma unroll 1
    for (int kt = 0; kt < nk; ++kt) {
        if (kt + 1 >= nk) G3_WAIT_BAR(0);
        else if (kt >= 2 || first_unit) G3_WAIT_BAR(6);
        else if (kt == 0) { if constexpr (EPI_ST == 8) G3_WAIT_BAR(8); else G3_WAIT_BAR(16); }
        else { if constexpr (EPI_ST == 8) G3_WAIT_BAR(14); else G3_WAIT_BAR(22); }
        const bool more = kt + 2 < nk;
        const int k2 = (kt + 2) * 64;
#pragma unroll
        for (int ks = 0; ks < 2; ++ks) {
            const int co = ((ks * 4 + fq) ^ key) << 4;
            bf16x8 af[4], bfr[4];
#pragma unroll
            for (int mi = 0; mi < 4; ++mi) af[mi] = *(const LAS bf16x8*)(lds + cur + ra + mi * 2048 + co);
#pragma unroll
            for (int ni = 0; ni < 4; ++ni) bfr[ni] = *(const LAS bf16x8*)(lds + cur + rb + ni * 2048 + co);
#pragma unroll
            for (int mi = 0; mi < 4; ++mi) {
                if (more && mi < 3) {
                    const int g = ks * 3 + mi;
                    if (g < 2) __builtin_amdgcn_global_load_lds((const unsigned*)(al.ptr(g) + k2), (LAS unsigned*)(lds + nx2 + g * 8192 + wl), 16, 0, 0);
                    else __builtin_amdgcn_global_load_lds((const unsigned*)(bp + (g - 2) * bstep + k2), (LAS unsigned*)(lds + nx2 + 16384 + (g - 2) * 8192 + wl), 16, 0, 0);
                }
#pragma unroll
                for (int ni = 0; ni < 4; ++ni)
                    acc[mi][ni] = SWAP ? __builtin_amdgcn_mfma_f32_16x16x32_bf16(bfr[ni], af[mi], acc[mi][ni], 0, 0, 0)
                                       : __builtin_amdgcn_mfma_f32_16x16x32_bf16(af[mi], bfr[ni], acc[mi][ni], 0, 0, 0);
            }
        }
        nx2 = cur; cur = (cur == 2 * GEMM_STAGE) ? 0 : cur + GEMM_STAGE;
    }
    G3_WAIT_BAR(0);
}

template <int EPI_ST, class AL>
__device__ __forceinline__ void gemm3_tile8(const Frame& F, const AL& al, const bf16* __restrict__ Bt, int K2, f32x4 (&acc)[4][4], bool first_unit, int sc_w, int sc_a) {
    static_assert(EPI_ST == 8 || EPI_ST == 16, "EPI_ST");
    const int tid = F.tid, lane = F.lane, wid = F.wave, wr = wid >> 2, wc = wid & 3, fr = lane & 15, fq = lane >> 4;
    const int sr = tid >> 3, sc = (tid & 7) ^ ((sr >> 1) & 7);
    LAS char* lds = F.lds;
    const bf16* bp = Bt + (size_t)sr * K2 + sc * 8;
    const size_t bstep = (size_t)64 * K2;
    const int key = (fr >> 1) & 7;
    const int ra = (wr * 64 + fr) * 128, rb = 16384 + (wc * 64 + fr) * 128;
    const int c0 = ((2 * fq) ^ key) << 4, c1 = ((2 * fq + 1) ^ key) << 4;
#pragma unroll
    for (int mi = 0; mi < 4; ++mi)
#pragma unroll
        for (int ni = 0; ni < 4; ++ni) acc[mi][ni] = (f32x4){0.f, 0.f, 0.f, 0.f};
    const int nk = K2 / 64;
    int cur = 0, nx2 = 2 * GEMM_STAGE;
    const int wl = wid * 1024;
#pragma unroll 1
    for (int kt = 0; kt < nk; ++kt) {
        if (kt + 1 >= nk) G3_WAIT_BAR(0);
        else if (kt >= 2 || first_unit) G3_WAIT_BAR(6);
        else if (kt == 0) { if constexpr (EPI_ST == 8) G3_WAIT_BAR(8); else G3_WAIT_BAR(16); }
        else { if constexpr (EPI_ST == 8) G3_WAIT_BAR(14); else G3_WAIT_BAR(22); }
        const bool more = kt + 2 < nk;
        const int k2 = (kt + 2) * 64;
        i32x8 af[4], bfr[4];
#pragma unroll
        for (int mi = 0; mi < 4; ++mi) {
            const u32x4 lo = *(const LAS u32x4*)(lds + cur + ra + mi * 2048 + c0), hi = *(const LAS u32x4*)(lds + cur + ra + mi * 2048 + c1);
            af[mi] = (i32x8){(int)lo.x, (int)lo.y, (int)lo.z, (int)lo.w, (int)hi.x, (int)hi.y, (int)hi.z, (int)hi.w};
        }
#pragma unroll
        for (int ni = 0; ni < 4; ++ni) {
            const u32x4 lo = *(const LAS u32x4*)(lds + cur + rb + ni * 2048 + c0), hi = *(const LAS u32x4*)(lds + cur + rb + ni * 2048 + c1);
            bfr[ni] = (i32x8){(int)lo.x, (int)lo.y, (int)lo.z, (int)lo.w, (int)hi.x, (int)hi.y, (int)hi.z, (int)hi.w};
        }
#define G8_PIECE(g_) do { if ((g_) < 2) __builtin_amdgcn_global_load_lds((const unsigned*)(al.ptr(g_) + k2), (LAS unsigned*)(lds + nx2 + (g_) * 8192 + wl), 16, 0, 0); \
            else __builtin_amdgcn_global_load_lds((const unsigned*)(bp + ((g_) - 2) * bstep + k2), (LAS unsigned*)(lds + nx2 + 16384 + ((g_) - 2) * 8192 + wl), 16, 0, 0); } while (0)
#define G8_MMA(mi_) do { _Pragma("unroll") for (int ni = 0; ni < 4; ++ni) \
            acc[mi_][ni] = __builtin_amdgcn_mfma_scale_f32_16x16x128_f8f6f4(bfr[ni], af[mi_], acc[mi_][ni], 0, 0, 0, sc_w, 0, sc_a); } while (0)
        if (more) { G8_PIECE(0); G8_PIECE(1); }
        G8_MMA(0);
        if (more) { G8_PIECE(2); G8_PIECE(3); }
        G8_MMA(1);
        if (more) { G8_PIECE(4); }
        G8_MMA(2);
        if (more) { G8_PIECE(5); }
        G8_MMA(3);
#undef G8_PIECE
#undef G8_MMA
        nx2 = cur; cur = (cur == 2 * GEMM_STAGE) ? 0 : cur + GEMM_STAGE;
    }
    G3_WAIT_BAR(0);
}

struct Ring { int cur, nx2; };
template <class AL>
__device__ __forceinline__ void ring_start(const Frame& F, Ring& R, const AL& al, const bf16* __restrict__ Bt, int K2) {
    const int tid = F.tid, sr = tid >> 3, sc = (tid & 7) ^ ((sr >> 1) & 7);
    const bf16* bp = Bt + (size_t)sr * K2 + sc * 8;
    gemm3_issue(F, al, bp, (size_t)64 * K2, 0, 0);
    gemm3_issue(F, al, bp, (size_t)64 * K2, GEMM_STAGE, 64);
    R.cur = 0; R.nx2 = 2 * GEMM_STAGE;
}
template <bool F8, int EPI_ST, class AL>
__device__ __forceinline__ void gemm3_unit(const Frame& F, Ring& R, const AL& al, const bf16* __restrict__ Bt, const AL& alN, const bf16* __restrict__ BtN, bool hasN,
                                           int K2, f32x4 (&acc)[4][4], bool first_unit, int sc_w = 0, int sc_a = 0) {
    static_assert(EPI_ST == 8 || EPI_ST == 16, "EPI_ST");
    const int tid = F.tid, lane = F.lane, wid = F.wave, wr = wid >> 2, wc = wid & 3, fr = lane & 15, fq = lane >> 4;
    const int sr = tid >> 3, sc = (tid & 7) ^ ((sr >> 1) & 7);
    LAS char* lds = F.lds;
    const bf16* bp = Bt + (size_t)sr * K2 + sc * 8;
    const bf16* bpN = BtN + (size_t)sr * K2 + sc * 8;
    const size_t bstep = (size_t)64 * K2;
    const int key = (fr >> 1) & 7;
    const int ra = (wr * 64 + fr) * 128, rb = 16384 + (wc * 64 + fr) * 128;
#pragma unroll
    for (int mi = 0; mi < 4; ++mi)
#pragma unroll
        for (int ni = 0; ni < 4; ++ni) acc[mi][ni] = (f32x4){0.f, 0.f, 0.f, 0.f};
    const int nk = K2 / 64;
    int cur = R.cur, nx2 = R.nx2;
    const int wl = wid * 1024;
#pragma unroll 1
    for (int kt = 0; kt < nk; ++kt) {
        const bool later = (kt + 1 < nk) || hasN;
        if (!later) G3_WAIT_BAR(0);
        else if (kt >= 2 || first_unit) G3_WAIT_BAR(6);
        else { if constexpr (EPI_ST == 8) G3_WAIT_BAR(14); else G3_WAIT_BAR(22); }
        const bool own = kt + 2 < nk, more = own || hasN;
        const bf16* pa0 = own ? al.ptr(0) : alN.ptr(0); const bf16* pa1 = own ? al.ptr(1) : alN.ptr(1); const bf16* pb = own ? bp : bpN;
        const int k2 = (own ? kt + 2 : kt + 2 - nk) * 64;
#define G3_PIECE(g_) do { if ((g_) == 0) __builtin_amdgcn_global_load_lds((const unsigned*)(pa0 + k2), (LAS unsigned*)(lds + nx2 + wl), 16, 0, 0); \
            else if ((g_) == 1) __builtin_amdgcn_global_load_lds((const unsigned*)(pa1 + k2), (LAS unsigned*)(lds + nx2 + 8192 + wl), 16, 0, 0); \
            else __builtin_amdgcn_global_load_lds((const unsigned*)(pb + ((g_) - 2) * bstep + k2), (LAS unsigned*)(lds + nx2 + 16384 + ((g_) - 2) * 8192 + wl), 16, 0, 0); } while (0)
        if constexpr (F8) {
            const int c0 = ((2 * fq) ^ key) << 4, c1 = ((2 * fq + 1) ^ key) << 4;
            i32x8 af[4], bfr[4];
#pragma unroll
            for (int mi = 0; mi < 4; ++mi) {
                const u32x4 lo = *(const LAS u32x4*)(lds + cur + ra + mi * 2048 + c0), hi = *(const LAS u32x4*)(lds + cur + ra + mi * 2048 + c1);
                af[mi] = (i32x8){(int)lo.x, (int)lo.y, (int)lo.z, (int)lo.w, (int)hi.x, (int)hi.y, (int)hi.z, (int)hi.w};
            }
#pragma unroll
            for (int ni = 0; ni < 4; ++ni) {
                const u32x4 lo = *(const LAS u32x4*)(lds + cur + rb + ni * 2048 + c0), hi = *(const LAS u32x4*)(lds + cur + rb + ni * 2048 + c1);
                bfr[ni] = (i32x8){(int)lo.x, (int)lo.y, (int)lo.z, (int)lo.w, (int)hi.x, (int)hi.y, (int)hi.z, (int)hi.w};
            }
#define G8_MMA(mi_) do { _Pragma("unroll") for (int ni = 0; ni < 4; ++ni) \
                acc[mi_][ni] = __builtin_amdgcn_mfma_scale_f32_16x16x128_f8f6f4(bfr[ni], af[mi_], acc[mi_][ni], 0, 0, 0, sc_w, 0, sc_a); } while (0)
            if (more) { G3_PIECE(0); G3_PIECE(1); }
            G8_MMA(0);
            if (more) { G3_PIECE(2); G3_PIECE(3); }
            G8_MMA(1);
            if (more) { G3_PIECE(4); }
            G8_MMA(2);
            if (more) { G3_PIECE(5); }
            G8_MMA(3);
#undef G8_MMA
        } else {
#pragma unroll
            for (int ks = 0; ks < 2; ++ks) {
                const int co = ((ks * 4 + fq) ^ key) << 4;
                bf16x8 af[4], bfr[4];
#pragma unroll
                for (int mi = 0; mi < 4; ++mi) af[mi] = *(const LAS bf16x8*)(lds + cur + ra + mi * 2048 + co);
#pragma unroll
                for (int ni = 0; ni < 4; ++ni) bfr[ni] = *(const LAS bf16x8*)(lds + cur + rb + ni * 2048 + co);
#pragma unroll
                for (int mi = 0; mi < 4; ++mi) {
                    if (more && mi < 3) { if (ks == 0) { if (mi == 0) G3_PIECE(0); else if (mi == 1) G3_PIECE(1); else G3_PIECE(2); } else { if (mi == 0) G3_PIECE(3); else if (mi == 1) G3_PIECE(4); else G3_PIECE(5); } }
#pragma unroll
                    for (int ni = 0; ni < 4; ++ni) acc[mi][ni] = __builtin_amdgcn_mfma_f32_16x16x32_bf16(bfr[ni], af[mi], acc[mi][ni], 0, 0, 0);
                }
            }
        }
#undef G3_PIECE
        nx2 = cur; cur = (cur == 2 * GEMM_STAGE) ? 0 : cur + GEMM_STAGE;
    }
    R.cur = cur; R.nx2 = nx2;
}


__device__ __forceinline__ float gelu_tanh(float x) {
    const float z = 0.7978845608028654f * (x + 0.044715f * x * x * x);
    const float t = 1.0f - 2.0f / (1.0f + __expf(2.0f * z));
    return 0.5f * x * (1.0f + t);
}
namespace pg8 {
#define PG8_LAS __attribute__((address_space(3)))
typedef unsigned short bf16_t;
typedef short bf16x8 __attribute__((ext_vector_type(8)));
typedef float f32x4 __attribute__((ext_vector_type(4)));
typedef unsigned u32x4 __attribute__((ext_vector_type(4)));
constexpr int BM = 256, BK = 64, HALF = 128, HTB = HALF * BK * 2  , STAGE_BYTES = 8 * HTB, NXCD = 8, WGM = 8;

__host__ __device__ __forceinline__ int lds_byte(int r, int c) { const int st = (r >> 4) * 2 + (c >> 5), rr = r & 15, cc = c & 31, ob = rr * 64 + cc * 2; return st * 1024 + (ob ^ (((ob >> 9) & 1) << 5)); }
__host__ __device__ __forceinline__ void stage_rc(int b, int& R, int& C) { const int st = b / 1024, sb = b % 1024, swz = sb ^ (((sb >> 9) & 1) << 5); R = (st >> 1) * 16 + swz / 64; C = (st & 1) * 32 + (swz % 64) / 2; }
__host__ __device__ __forceinline__ int perm32(int rho) { const int n = rho >> 4, i = rho & 15; return 8 * (i >> 2) + 4 * n + (i & 3); }

struct Unit { int pm, pn; };
struct Gemm { const bf16_t* A; const bf16_t* Bt; int M, N, K; };

struct StaticOrder {
    int nM, nN, nwg, G, c;
    __host__ __device__ void init(int M, int N, int G_, int c_) { nM = M / BM; nN = N / BM; nwg = nM * nN; G = G_; c = c_; }
    __host__ __device__ bool next(int i, Unit& u) const {
        const long L = (long)i * G + c; if (L >= nwg) return false;
        int wgid = (int)L; { const int q = nwg / NXCD, r = nwg % NXCD, xcd = wgid % NXCD, off = wgid / NXCD; wgid = (xcd < r ? xcd * (q + 1) : r * (q + 1) + (xcd - r) * q) + off; }
        const int nig = WGM * nN, gid = wgid / nig, fm = gid * WGM, gsz = (nM - fm) < WGM ? (nM - fm) : WGM;
        u.pm = fm + ((wgid % nig) % gsz); u.pn = (wgid % nig) / gsz; return true;
    }
    __device__ __forceinline__ void a_ready(const Unit&) const {}
    __device__ __forceinline__ void done(const Unit&) const {}
};
__device__ __forceinline__ unsigned cvt_pk_bf16(float lo, float hi) { unsigned r; asm volatile("v_cvt_pk_bf16_f32 %0, %1, %2" : "=v"(r) : "v"(lo), "v"(hi)); return r; }
typedef float f32x2 __attribute__((ext_vector_type(2)));
template <class Epi, class Sched, bool ALIGN_EPI = false, bool SP2 = false>
__device__ __forceinline__ void gemm_phase(PG8_LAS unsigned char* lds, const Gemm g, const Sched& S, const Epi& E) {
    const int tid = threadIdx.x, wid = __builtin_amdgcn_readfirstlane(tid >> 6), lane = tid & 63, wr = wid >> 2, wc = wid & 3, fr = lane & 15, fq = lane >> 4;
    const int K = g.K, nt = K / BK;
    unsigned voffA[2], voffB[2];
#pragma unroll
    for (int i = 0; i < 2; ++i) { int R, C; stage_rc(tid * 16 + i * 8192, R, C); const int Rb = Epi::PERM ? ((R & ~31) + perm32(R & 31)) : R;
        voffA[i] = (unsigned)(R * K + C) * 2u; voffB[i] = (unsigned)(Rb * K + C) * 2u; }
    const size_t kstep = (size_t)(BK * 2);
    const size_t hstep = (size_t)HALF * K * 2;
    const size_t tstep = 2 * hstep;
    const unsigned ldsw = (unsigned)wid * 1024u;
    const int aoff = lds_byte(wr * 64 + fr, fq * 8), boff = lds_byte(wc * 32 + fr, fq * 8);
#define PG8_SA(b, h) (((b) * 2 + (h)) * HTB)
#define PG8_SB(b, h) ((4 + (b) * 2 + (h)) * HTB)
#define PG8_STAGE(bufoff, gbase, voff) do { _Pragma("unroll") for (int _i = 0; _i < 2; ++_i) \
        __builtin_amdgcn_global_load_lds((const unsigned*)((const char*)(gbase) + (voff)[_i]), (PG8_LAS unsigned*)(lds + (bufoff) + ldsw + _i * 8192), 16, 0, 0); } while (0)
#define PG8_LDA(dst, b, h) do { _Pragma("unroll") for (int m = 0; m < 4; ++m) _Pragma("unroll") for (int k = 0; k < 2; ++k) dst[m][k] = *(const PG8_LAS bf16x8*)(lds + PG8_SA(b, h) + aoff + m * 2048 + k * 1024); } while (0)
#define PG8_LDB(dst, b, h) do { _Pragma("unroll") for (int n = 0; n < 2; ++n) _Pragma("unroll") for (int k = 0; k < 2; ++k) dst[n][k] = *(const PG8_LAS bf16x8*)(lds + PG8_SB(b, h) + boff + n * 2048 + k * 1024); } while (0)
#define PG8_MMA(ai, bj, At, Bt) do { __builtin_amdgcn_s_setprio(1); _Pragma("unroll") for (int m = 0; m < 4; ++m) _Pragma("unroll") for (int n = 0; n < 2; ++n) _Pragma("unroll") for (int k = 0; k < 2; ++k) \
        acc[ai][bj][m][n] = __builtin_amdgcn_mfma_f32_16x16x32_bf16(Bt[n][k], At[m][k], acc[ai][bj][m][n], 0, 0, 0); __builtin_amdgcn_s_setprio(0); } while (0)
#define PG8_WAIT_V(n) asm volatile("s_waitcnt vmcnt(" #n ")" ::: "memory")
#define PG8_WAIT_L(n) asm volatile("s_waitcnt lgkmcnt(" #n ")" ::: "memory")
#define PG8_BAR __builtin_amdgcn_s_barrier()
#define PG8_SCHED __builtin_amdgcn_sched_barrier(0)
    Unit cur, nxt; int ui = 0;
    if (!S.next(0, cur)) return;
    f32x4 acc[2][2][4][2];
#pragma unroll
    for (int a = 0; a < 2; ++a)
#pragma unroll
        for (int b = 0; b < 2; ++b)
#pragma unroll
            for (int m = 0; m < 4; ++m)
#pragma unroll
                for (int n = 0; n < 2; ++n) acc[a][b][m][n] = (f32x4){0.f, 0.f, 0.f, 0.f};
    bf16x8 At[4][2], B0[2][2], B1[2][2];
    const char* cA = (const char*)g.A + (size_t)cur.pm * tstep; const char* cB = (const char*)g.Bt + (size_t)cur.pn * tstep;
    S.a_ready(cur);
    if constexpr (SP2) {
        PG8_STAGE(PG8_SB(0, 0), cB, voffB); PG8_STAGE(PG8_SB(0, 1), cB + hstep, voffB); PG8_STAGE(PG8_SA(0, 0), cA, voffA); PG8_STAGE(PG8_SA(0, 1), cA + hstep, voffA);
        if (wr == 1) PG8_BAR;
        PG8_WAIT_V(2); PG8_BAR;
        PG8_STAGE(PG8_SB(1, 0), cB + kstep, voffB); PG8_STAGE(PG8_SA(1, 0), cA + kstep, voffA); PG8_STAGE(PG8_SB(1, 1), cB + hstep + kstep, voffB);
        PG8_WAIT_V(6); PG8_BAR;
    } else {
        PG8_STAGE(PG8_SB(0, 0), cB, voffB); PG8_STAGE(PG8_SA(0, 0), cA, voffA); PG8_STAGE(PG8_SB(0, 1), cB + hstep, voffB); PG8_STAGE(PG8_SA(0, 1), cA + hstep, voffA);
        if (wr == 1) PG8_BAR;
        PG8_WAIT_V(4); PG8_BAR;
        PG8_STAGE(PG8_SB(1, 0), cB + kstep, voffB); PG8_STAGE(PG8_SA(1, 0), cA + kstep, voffA); PG8_STAGE(PG8_SB(1, 1), cB + hstep + kstep, voffB);
        PG8_WAIT_V(6); PG8_BAR;
    }
    for (;;) {
        const bool has_next = S.next(ui + 1, nxt);
        const char* nA = has_next ? (const char*)g.A + (size_t)nxt.pm * tstep : cA; const char* nB = has_next ? (const char*)g.Bt + (size_t)nxt.pn * tstep : cB;
        for (int t = 0; t < nt; t += 2) {
            const bool last = (t == nt - 2);
            const char* a1 = cA + (size_t)(t + 1) * kstep;
            const char* a2 = last ? nA : cA + (size_t)(t + 2) * kstep; const char* b2 = last ? nB : cB + (size_t)(t + 2) * kstep;
            const char* a3 = a2 + kstep; const char* b3 = b2 + kstep;
            if (last && has_next) S.a_ready(nxt);
            if constexpr (SP2) {
            PG8_LDB(B0, 0, 0); PG8_LDB(B1, 0, 1); PG8_SCHED; PG8_LDA(At, 0, 0); PG8_STAGE(PG8_SA(1, 1), a1 + hstep, voffA);
            PG8_WAIT_V(8); PG8_WAIT_L(0); PG8_BAR; PG8_MMA(0, 0, At, B0); PG8_MMA(0, 1, At, B1); PG8_BAR; PG8_SCHED;
            PG8_LDA(At, 0, 1); PG8_STAGE(PG8_SB(0, 0), b2, voffB); PG8_STAGE(PG8_SB(0, 1), b2 + hstep, voffB); PG8_STAGE(PG8_SA(0, 0), a2, voffA);
            PG8_WAIT_V(8); PG8_WAIT_L(0); PG8_BAR; PG8_MMA(1, 0, At, B0); PG8_MMA(1, 1, At, B1); PG8_BAR; PG8_SCHED;
            PG8_LDB(B0, 1, 0); PG8_LDB(B1, 1, 1); PG8_SCHED; PG8_LDA(At, 1, 0); PG8_STAGE(PG8_SA(0, 1), a2 + hstep, voffA);
            PG8_WAIT_V(8); PG8_WAIT_L(0); PG8_BAR; PG8_MMA(0, 0, At, B0); PG8_MMA(0, 1, At, B1); PG8_BAR; PG8_SCHED;
            PG8_LDA(At, 1, 1); PG8_STAGE(PG8_SB(1, 0), b3, voffB); PG8_STAGE(PG8_SB(1, 1), b3 + hstep, voffB); PG8_STAGE(PG8_SA(1, 0), a3, voffA);
            PG8_WAIT_V(8); PG8_WAIT_L(0); PG8_BAR; PG8_MMA(1, 0, At, B0); PG8_MMA(1, 1, At, B1); PG8_BAR; PG8_SCHED;
            } else {
            PG8_LDB(B0, 0, 0); PG8_SCHED; PG8_LDA(At, 0, 0); PG8_STAGE(PG8_SA(1, 1), a1 + hstep, voffA);
            PG8_WAIT_L(8); PG8_BAR; PG8_WAIT_L(0); PG8_MMA(0, 0, At, B0); PG8_BAR; PG8_SCHED;
            PG8_LDB(B1, 0, 1); PG8_STAGE(PG8_SB(0, 0), b2, voffB);
            PG8_BAR; PG8_WAIT_L(0); PG8_MMA(0, 1, At, B1); PG8_BAR;
            PG8_LDA(At, 0, 1); PG8_STAGE(PG8_SA(0, 0), a2, voffA);
            PG8_BAR; PG8_WAIT_L(0); PG8_MMA(1, 0, At, B0); PG8_BAR; PG8_SCHED;
            PG8_STAGE(PG8_SB(0, 1), b2 + hstep, voffB);
            PG8_WAIT_V(6); PG8_BAR; PG8_MMA(1, 1, At, B1); PG8_BAR;
            PG8_LDB(B0, 1, 0); PG8_SCHED; PG8_LDA(At, 1, 0); PG8_STAGE(PG8_SA(0, 1), a2 + hstep, voffA);
            PG8_WAIT_L(8); PG8_BAR; PG8_WAIT_L(0); PG8_MMA(0, 0, At, B0); PG8_BAR; PG8_SCHED;
            PG8_LDB(B1, 1, 1); PG8_STAGE(PG8_SB(1, 0), b3, voffB);
            PG8_BAR; PG8_WAIT_L(0); PG8_MMA(0, 1, At, B1); PG8_BAR;
            PG8_LDA(At, 1, 1); PG8_STAGE(PG8_SA(1, 0), a3, voffA);
            PG8_BAR; PG8_WAIT_L(0); PG8_MMA(1, 0, At, B0); PG8_BAR; PG8_SCHED;
            PG8_STAGE(PG8_SB(1, 1), b3 + hstep, voffB);
            PG8_WAIT_V(6); PG8_BAR; PG8_MMA(1, 1, At, B1); PG8_BAR;
            }
        }
        if constexpr (ALIGN_EPI) { if (wr == 0) PG8_BAR; }
        if constexpr (!Epi::AFTER_DRAIN) { E(acc, cur, wr, wc, fr, fq); S.done(cur); }
        if (!has_next) break;
#pragma unroll
        for (int a = 0; a < 2; ++a)
#pragma unroll
            for (int b = 0; b < 2; ++b)
#pragma unroll
                for (int m = 0; m < 4; ++m)
#pragma unroll
                    for (int n = 0; n < 2; ++n) acc[a][b][m][n] = (f32x4){0.f, 0.f, 0.f, 0.f};
        cur = nxt; cA = nA; cB = nB; ++ui;
        if constexpr (ALIGN_EPI) { if (wr == 1) PG8_BAR; }
    }
    PG8_WAIT_V(0);
    if constexpr (!ALIGN_EPI) { if (wr == 0) PG8_BAR; }
    PG8_BAR;
    if constexpr (Epi::AFTER_DRAIN) { E.fused(acc, cur, wr, wc, fr, fq, lds, wid, lane); S.done(cur); }
#undef PG8_SA
#undef PG8_SB
#undef PG8_STAGE
#undef PG8_LDA
#undef PG8_LDB
#undef PG8_MMA
#undef PG8_WAIT_V
#undef PG8_WAIT_L
#undef PG8_BAR
#undef PG8_SCHED
}
}

namespace pg8 {
struct EpiScaleBf16 {
    static constexpr bool PERM = true, AFTER_DRAIN = false;
    bf16_t* O; int ldc; const float* scale_base; int scale_stride;
    __device__ __forceinline__ void operator()(const f32x4 (&acc)[2][2][4][2], const Unit& u, int wr, int wc, int fr, int fq) const {
        const int row0 = u.pm * BM + wr * 64 + fr, col0 = u.pn * BM + wc * 32 + 8 * fq;
        const float* sc = scale_base + (size_t)((u.pm * BM) >> 12) * scale_stride;
        f32x4 sv[2][2];
#pragma unroll
        for (int bj = 0; bj < 2; ++bj)
#pragma unroll
            for (int n = 0; n < 2; ++n) sv[bj][n] = *(const f32x4*)(sc + col0 + bj * HALF + 4 * n);
#pragma unroll
        for (int ai = 0; ai < 2; ++ai)
#pragma unroll
            for (int m = 0; m < 4; ++m) { bf16_t* rowp = O + (size_t)(row0 + ai * HALF + m * 16) * ldc + col0;
#pragma unroll
                for (int bj = 0; bj < 2; ++bj) { const f32x4 v0 = acc[ai][bj][m][0] * sv[bj][0], v1 = acc[ai][bj][m][1] * sv[bj][1];
                    u32x4 w; w.x = cvt_pk_bf16(v0[0], v0[1]); w.y = cvt_pk_bf16(v0[2], v0[3]); w.z = cvt_pk_bf16(v1[0], v1[1]); w.w = cvt_pk_bf16(v1[2], v1[3]);
                    *(u32x4*)(rowp + bj * HALF) = w; } }
    }
};
struct EpiIn {
    static constexpr bool PERM = true, AFTER_DRAIN = false;
    bf16_t* YG; bf16_t* U;
    __device__ __forceinline__ void operator()(const f32x4 (&acc)[2][2][4][2], const Unit& u, int wr, int wc, int fr, int fq) const {
        const bool isy = u.pn < 4;
        bf16_t* base = isy ? YG : U;
        const int row0 = u.pm * BM + wr * 64 + fr, col0 = (u.pn & 3) * BM + wc * 32 + 8 * fq;
#pragma unroll
        for (int ai = 0; ai < 2; ++ai)
#pragma unroll
            for (int m = 0; m < 4; ++m) { bf16_t* rowp = base + (size_t)(row0 + ai * HALF + m * 16) * 1024 + col0;
#pragma unroll
                for (int bj = 0; bj < 2; ++bj) { f32x4 v0 = acc[ai][bj][m][0], v1 = acc[ai][bj][m][1];
                    if (isy) { v0 = (f32x4){::gelu_tanh(v0[0]), ::gelu_tanh(v0[1]), ::gelu_tanh(v0[2]), ::gelu_tanh(v0[3])}; v1 = (f32x4){::gelu_tanh(v1[0]), ::gelu_tanh(v1[1]), ::gelu_tanh(v1[2]), ::gelu_tanh(v1[3])}; }
                    u32x4 w; w.x = cvt_pk_bf16(v0[0], v0[1]); w.y = cvt_pk_bf16(v0[2], v0[3]); w.z = cvt_pk_bf16(v1[0], v1[1]); w.w = cvt_pk_bf16(v1[2], v1[3]);
                    *(u32x4*)(rowp + bj * HALF) = w; } }
    }
};
struct EpiQKV {
    static constexpr bool PERM = false, AFTER_DRAIN = false;
    bf16_t* Q; bf16_t* Kb; bf16_t* VT; const PG8_LAS float* cs;
    __device__ __forceinline__ void operator()(const f32x4 (&acc)[2][2][4][2], const Unit& u, int wr, int wc, int fr, int fq) const {
        const int region = u.pn >> 2, pq = u.pn & 3;
        const bool isctx = u.pm >= NX / BM;
#pragma unroll
        for (int ai = 0; ai < 2; ++ai)
#pragma unroll
            for (int m = 0; m < 4; ++m) {
                const int row = u.pm * BM + ai * HALF + wr * 64 + m * 16 + fr;
                int b, pos;
                if (!isctx) { b = row >> 12; pos = row & 4095; } else { b = (row - NX) >> 8; pos = S + ((row - NX) & 255); }
                if (region < 2) {
                    const int p = (wc & 1) ? (pos & 63) : (pos >> 6);
                    const float scl = region == 0 ? QSCALE : 1.0f;
#pragma unroll
                    for (int bj = 0; bj < 2; ++bj) {
                        const int hi2 = 4 * pq + 2 * bj + (wc >> 1);
                        bf16_t* dst = region == 0 ? Q + ((size_t)(b * 16 + hi2) * S + pos) * 64 : Kb + ((size_t)(b * 16 + hi2) * KEYS + pos) * 64;
#pragma unroll
                        for (int n = 0; n < 2; ++n) {
                            f32x4 o = acc[ai][bj][m][n];
                            if (!isctx) {
                                const f32x4 pv = acc[ai][bj][m][n ^ 1];
#pragma unroll
                                for (int i = 0; i < 4; ++i) { const float c_ = cs[(p * 16 + fq * 4 + i) * 2], s_ = cs[(p * 16 + fq * 4 + i) * 2 + 1]; o[i] = o[i] * c_ + (n ? pv[i] : -pv[i]) * s_; }
                            }
                            typedef unsigned u32x2_ __attribute__((ext_vector_type(2)));
                            u32x2_ w; w.x = cvt_pk_bf16(o[0] * scl, o[1] * scl); w.y = cvt_pk_bf16(o[2] * scl, o[3] * scl);
                            *(u32x2_*)(dst + (wc & 1) * 32 + n * 16 + fq * 4) = w;
                        }
                    }
                } else {
                    const int ppos = (pos & ~12) | ((pos & 4) << 1) | ((pos & 8) >> 1);
#pragma unroll
                    for (int bj = 0; bj < 2; ++bj)
#pragma unroll
                        for (int n = 0; n < 2; ++n) {
                            const int h = 2 * pq + bj, vd = 32 * wc + 16 * n + 4 * fq;
                            bf16_t* vp = VT + ((size_t)(b * 8 + h) * 128 + vd) * KEYS + ppos;
                            const f32x4 v = acc[ai][bj][m][n];
                            const unsigned p01 = cvt_pk_bf16(v[0], v[1]), p23 = cvt_pk_bf16(v[2], v[3]);
                            vp[0] = (bf16_t)(p01 & 0xffffu); vp[KEYS] = (bf16_t)(p01 >> 16); vp[2 * KEYS] = (bf16_t)(p23 & 0xffffu); vp[3 * KEYS] = (bf16_t)(p23 >> 16);
                        }
                }
            }
    }
};
struct QkvOrder {
    StaticOrder so; int G, c;
    __host__ __device__ void init(int G_, int c_) { so.init(NX, 3 * D, G_, c_); G = G_; c = c_; }
    __host__ __device__ bool next(int i, Unit& u) const {
        if (so.next(i, u)) return true;
        const long L = (long)i * G + c - so.nwg;
        if (L < 0 || L >= 32) return false;
        u.pm = NX / BM + (int)(L >> 3); u.pn = 4 + (int)(L & 7); return true;
    }
    __device__ __forceinline__ void a_ready(const Unit&) const {}
    __device__ __forceinline__ void done(const Unit&) const {}
};
}

__device__ __forceinline__ void phase_gemm_in(Frame& F) {
    pg8::Gemm g{(const pg8::bf16_t*)(F.ws + WS_H), (const pg8::bf16_t*)(F.ws + WS_WIN), NTOK, 2 * D, D};
    pg8::StaticOrder S; S.init(NTOK, 2 * D, F.G, (int)blockIdx.x);
    pg8::EpiIn E{(pg8::bf16_t*)(F.ws + WS_YG), (pg8::bf16_t*)(F.ws + WS_U)};
    pg8::gemm_phase<pg8::EpiIn, pg8::StaticOrder, true, true>((PG8_LAS unsigned char*)F.lds, g, S, E);
}

__device__ __forceinline__ float neg_expm1(float x) {
    const float p = 1.0f + x * (0.5f + x * (0.16666667f + x * (0.041666668f + x * (0.0083333338f + x * 0.0013888889f))));
    const float ser = -x * p, big = 1.0f - __expf(x);
    return x > -0.5f ? ser : big;
}
__device__ __forceinline__ void phase_scan(Frame& F) {
    const Args& A = *F.a;
    const int wi = F.vcu;
    if (wi >= 256) return;
    const int b = wi >> 6, n = (wi >> 3) & 7, d = (wi >> 2) & 1, q = wi & 3;
    const int tid = F.tid, lane = F.lane, w = F.wave, fr = lane & 15, fq = lane >> 4;
    LAS char* RAW = F.lds;
    LAS char* AT = F.lds + 33792;
    LAS float* AGG = (LAS float*)(F.lds + 66560);
    LAS float* CIN = (LAS float*)(F.lds + 74752);
    const bf16* U = (const bf16*)(F.ws + WS_U);
    bf16* HO = (bf16*)(F.ws + (d ? WS_HB : WS_HF));
    const int chbase = n * 128, och = chbase + q * 32;
    const bf16* GT = (const bf16*)(F.ws + WS_GATE);
    LAS char* BT = F.lds + 81920;
#pragma unroll
    for (int i = 0; i < 2; ++i) {
        const int idx = tid + 512 * i, jrow = idx >> 4, c = idx & 15, nb = jrow >> 4, f2 = jrow & 15;
        *(LAS u32x4*)(BT + jrow * 256 + ((c ^ f2) << 4)) = *(const u32x4*)(GT + ((size_t)(((d * 2 + (nb >> 1)) * 8 + n) * 128 + q * 32 + (nb & 1) * 16 + f2)) * 128 + c * 8);
    }
    float ba[2], bi[2], sp8[2];
#pragma unroll
    for (int h = 0; h < 2; ++h) {
        const int ch = och + h * 16 + fr;
        ba[h] = A.in[I_GAB][d * 1024 + ch]; bi[h] = A.in[I_GXB][d * 1024 + ch];
        sp8[h] = 8.0f * log1pf(expf(-A.in[I_LAM][d * 1024 + ch]));
    }
    const int c8 = tid & 15, r0 = tid >> 4;
    LAS float* CW = (LAS float*)(F.lds + 78848);
    (void)CW;
    float cw[4][8], cb[8];
#pragma unroll
    for (int k = 0; k < 4; ++k) {
        const f32x4 a0 = *(const f32x4*)(A.in[I_CONVW] + k * 1024 + chbase + c8 * 8), a1 = *(const f32x4*)(A.in[I_CONVW] + k * 1024 + chbase + c8 * 8 + 4);
        cw[k][0] = a0.x; cw[k][1] = a0.y; cw[k][2] = a0.z; cw[k][3] = a0.w; cw[k][4] = a1.x; cw[k][5] = a1.y; cw[k][6] = a1.z; cw[k][7] = a1.w;
    }
    { const f32x4 a0 = *(const f32x4*)(A.in[I_CONVB] + chbase + c8 * 8), a1 = *(const f32x4*)(A.in[I_CONVB] + chbase + c8 * 8 + 4);
      cb[0] = a0.x; cb[1] = a0.y; cb[2] = a0.z; cb[3] = a0.w; cb[4] = a1.x; cb[5] = a1.y; cb[6] = a1.z; cb[7] = a1.w; }

    float hcar = 0.f;
    u32x4 pre[5];
    LAS float* cscr = (LAS float*)(F.lds + 98304 + w * 4224);
    const int cgw = F.vcu * NWAVES + w, CNGW = F.G * NWAVES;
    int cit = cgw;
    TDesc cd2; f32x4 crg2[4]; bool chas2 = false;
    for (int step = 0; step < 34; ++step) {
        TDesc cd; f32x4 crg[4]; const bool chas = cit < ND_SCAN;
        if (chas) { cd = decode_deferred(F, cit); tr2_load(cd, lane, crg); cit += CNGW; }
        int segbase, seglen, tile;
        if (step < 2) { segbase = NX + b * CL; seglen = CL; tile = d ? (1 - step) : step; }
        else { segbase = b * S; seglen = S; tile = d ? (33 - step) : (step - 2); }
        const int t0 = tile * 128;
        if (step == 0) {
#pragma unroll
            for (int i = 0; i < 5; ++i) {
                const int idx = tid + 512 * i; const int row = idx >> 4, c = idx & 15; const int t = t0 - 2 + row;
                u32x4 v = (u32x4){0u, 0u, 0u, 0u};
                if (idx < 2112 && t >= 0 && t < seglen) v = *(const u32x4*)(U + (size_t)(segbase + t) * D + chbase + c * 8);
                pre[i] = v;
            }
        }
#pragma unroll
        for (int i = 0; i < 5; ++i) { const int idx = tid + 512 * i; if (idx < 2112) *(LAS u32x4*)(RAW + idx * 16) = pre[i]; }
        __syncthreads();
        if (step + 1 < 34) {
            const int s1 = step + 1; int sb1, sl1, tl1;
            if (s1 < 2) { sb1 = NX + b * CL; sl1 = CL; tl1 = d ? (1 - s1) : s1; }
            else { sb1 = b * S; sl1 = S; tl1 = d ? (33 - s1) : (s1 - 2); }
            const int t1 = tl1 * 128;
#pragma unroll
            for (int i = 0; i < 5; ++i) {
                const int idx = tid + 512 * i; const int row = idx >> 4, c = idx & 15; const int t = t1 - 2 + row;
                u32x4 v = (u32x4){0u, 0u, 0u, 0u};
                if (idx < 2112 && t >= 0 && t < sl1) v = *(const u32x4*)(U + (size_t)(sb1 + t) * D + chbase + c * 8);
                pre[i] = v;
            }
        }
#pragma unroll
        for (int i = 0; i < 4; ++i) {
            const int r = r0 + 32 * i;
            float o[8];
#pragma unroll
            for (int j = 0; j < 8; ++j) o[j] = cb[j];
#pragma unroll
            for (int k = 0; k < 4; ++k) {
                const u32x4 x = *(const LAS u32x4*)(RAW + (r + k) * 256 + c8 * 16);
#pragma unroll
                for (int p = 0; p < 4; ++p) { o[2 * p] += cw[k][2 * p] * bflo(x[p]); o[2 * p + 1] += cw[k][2 * p + 1] * bfhi(x[p]); }
            }
            u32x4 ov; ov.x = pk2(o[0], o[1]); ov.y = pk2(o[2], o[3]); ov.z = pk2(o[4], o[5]); ov.w = pk2(o[6], o[7]);
            *(LAS u32x4*)(AT + r * 256 + ((c8 ^ (r & 15)) << 4)) = ov;
        }
        __syncthreads();
        f32x4 acc[4];
#pragma unroll
        for (int nb = 0; nb < 4; ++nb) acc[nb] = (f32x4){0.f, 0.f, 0.f, 0.f};
#pragma unroll
        for (int ks = 0; ks < 4; ++ks) {
            const int row = 16 * w + fr;
            const bf16x8 af = *(const LAS bf16x8*)(AT + row * 256 + (((4 * ks + fq) ^ fr) << 4));
#pragma unroll
            for (int nb = 0; nb < 4; ++nb) {
                const bf16x8 bq = *(const LAS bf16x8*)(BT + (nb * 16 + fr) * 256 + (((4 * ks + fq) ^ fr) << 4));
                acc[nb] = __builtin_amdgcn_mfma_f32_16x16x32_bf16(af, bq, acc[nb], 0, 0, 0);
            }
        }
        float av[2][4], bv[2][4];
#pragma unroll
        for (int h = 0; h < 2; ++h) {
            const int col = q * 32 + h * 16 + fr, chunk = col >> 3, within = col & 7;
#pragma unroll
            for (int reg = 0; reg < 4; ++reg) {
                const int tr = 16 * w + 4 * fq + reg;
                const float r_ = __builtin_amdgcn_rcpf(1.0f + __builtin_amdgcn_exp2f(-1.4426950408889634f * (acc[h][reg] + ba[h])));
                const float i_ = __builtin_amdgcn_rcpf(1.0f + __builtin_amdgcn_exp2f(-1.4426950408889634f * (acc[2 + h][reg] + bi[h])));
                const float la = -sp8[h] * r_;
                const float a_ = __builtin_amdgcn_exp2f(1.4426950408889634f * la);
                const unsigned short ub = *(const LAS unsigned short*)(AT + tr * 256 + ((chunk ^ (tr & 15)) << 4) + within * 2);
                const float uval = __builtin_bit_cast(float, (unsigned)ub << 16);
                av[h][reg] = a_;
                bv[h][reg] = __builtin_amdgcn_sqrtf(neg_expm1(2.0f * la)) * (i_ * uval);
            }
        }
        const int g = 4 * w + fq;
#pragma unroll
        for (int h = 0; h < 2; ++h) {
            float P = 1.f, Hh = 0.f;
#pragma unroll
            for (int s = 0; s < 4; ++s) { const int reg = d ? (3 - s) : s; Hh = av[h][reg] * Hh + bv[h][reg]; P *= av[h][reg]; }
            AGG[(g * 32 + h * 16 + fr) * 2 + 0] = P; AGG[(g * 32 + h * 16 + fr) * 2 + 1] = Hh;
        }
        if (chas2) tr2_finish(cd2, lane, crg2, cscr);
        chas2 = cit < ND_SCAN;
        if (chas2) { cd2 = decode_deferred(F, cit); tr2_load(cd2, lane, crg2); cit += CNGW; }
        __syncthreads();
        if (tid < 32) {
            f32x2 ag[32];
#pragma unroll
            for (int gi = 0; gi < 32; ++gi) ag[gi] = *(const LAS f32x2*)(AGG + (gi * 32 + tid) * 2);
            float hh = hcar;
            if (d == 0) {
#pragma unroll
                for (int gi = 0; gi < 32; ++gi) { CIN[gi * 32 + tid] = hh; hh = ag[gi].x * hh + ag[gi].y; }
            } else {
#pragma unroll
                for (int gi = 31; gi >= 0; --gi) { CIN[gi * 32 + tid] = hh; hh = ag[gi].x * hh + ag[gi].y; }
            }
            hcar = hh;
        }
        __syncthreads();
#pragma unroll
        for (int h = 0; h < 2; ++h) {
            float hh = CIN[g * 32 + h * 16 + fr];
            float outv[4];
#pragma unroll
            for (int s = 0; s < 4; ++s) { const int reg = d ? (3 - s) : s; hh = av[h][reg] * hh + bv[h][reg]; outv[reg] = hh; }
#pragma unroll
            for (int reg = 0; reg < 4; ++reg) {
                const int tr = 16 * w + 4 * fq + reg;
                HO[(size_t)(segbase + t0 + tr) * D + och + h * 16 + fr] = (bf16)f2bf(outv[reg]);
            }
        }
        if (chas) tr2_finish(cd, lane, crg, cscr);
    }
    if (chas2) tr2_finish(cd2, lane, crg2, cscr);
}

__device__ __forceinline__ void phase_combine_h(Frame& F) {
    const u32x4* hf = (const u32x4*)(F.ws + WS_HF); const u32x4* hb = (const u32x4*)(F.ws + WS_HB); const u32x4* yg = (const u32x4*)(F.ws + WS_YG);
    u32x4* hc = (u32x4*)(F.ws + WS_U);
    constexpr int NCH = NTOK * (D / 8);
    const int stride = F.G * NTHREADS;
    for (int i = F.vcu * NTHREADS + F.tid; i < NCH; i += 4 * stride) {
        u32x4 a[4], b[4], y[4];
#pragma unroll
        for (int j = 0; j < 4; ++j) { const int idx = i + j * stride; if (idx < NCH) { a[j] = hf[idx]; b[j] = hb[idx]; y[j] = yg[idx]; } }
#pragma unroll
        for (int j = 0; j < 4; ++j) {
            const int idx = i + j * stride;
            if (idx < NCH) {
                u32x4 r;
#pragma unroll
                for (int q = 0; q < 4; ++q) r[q] = pk2((bflo(a[j][q]) + bflo(b[j][q])) * bflo(y[j][q]), (bfhi(a[j][q]) + bfhi(b[j][q])) * bfhi(y[j][q]));
                hc[idx] = r;
            }
        }
    }
}
__device__ __forceinline__ void phase_gemm_out0(Frame& F) {
    const Args& A = *F.a;
    const bf16* W = (const bf16*)(F.ws + WS_WOUT);
    const bf16* HC = (const bf16*)(F.ws + WS_U);
    float* XA = (float*)(F.ws + WS_XA);
    const int wr = F.wave >> 2, wc = F.wave & 3, fr = F.lane & 15, fq = F.lane >> 4;
    constexpr int NTN = 4, NUNITS = (NTOK / 128) * NTN;
    ALDense al, alN; const bf16* Bp = W; const bf16* BpN = W; Ring R;
    if (F.vcu < NUNITS) { al.init(HC, D, (F.vcu / NTN) * 128, F.tid >> 3, (F.tid >> 3) + 64, dma_kc(F.tid)); Bp = W + (size_t)((F.vcu % NTN) * 256) * D; ring_start(F, R, al, Bp, D); }
    for (int u = F.vcu; u < NUNITS; u += F.G) {
        const int mt = u / NTN, nt = u % NTN, m0 = mt * 128, n0 = nt * 256;
        const int un = u + F.G; const bool hasN = un < NUNITS;
        alN = al; BpN = Bp;
        if (hasN) { alN.init(HC, D, (un / NTN) * 128, F.tid >> 3, (F.tid >> 3) + 64, dma_kc(F.tid)); BpN = W + (size_t)((un % NTN) * 256) * D; }
        f32x4 acc[4][4];
        gemm3_unit<false, 16>(F, R, al, Bp, alN, BpN, hasN, D, acc, u == F.vcu);
        al = alN; Bp = BpN;
        {
            const float* gate = modp(F, 0, cond_of(m0), 2);
            const float* srcb = m0 < NX ? A.in[I_X] + (size_t)m0 * D : A.in[I_CTX] + (size_t)(m0 - NX) * D;
            f32x4 sres[4][4], gt[4];
#pragma unroll
            for (int ni = 0; ni < 4; ++ni) gt[ni] = *(const f32x4*)(gate + n0 + wc * 64 + ni * 16 + fq * 4);
#pragma unroll
            for (int mi = 0; mi < 4; ++mi)
#pragma unroll
                for (int ni = 0; ni < 4; ++ni) sres[mi][ni] = *(const f32x4*)(srcb + (size_t)(wr * 64 + mi * 16 + fr) * D + n0 + wc * 64 + ni * 16 + fq * 4);
#pragma unroll
            for (int mi = 0; mi < 4; ++mi)
#pragma unroll
                for (int ni = 0; ni < 4; ++ni) *(f32x4*)(XA + (size_t)(m0 + wr * 64 + mi * 16 + fr) * D + n0 + wc * 64 + ni * 16 + fq * 4) = sres[mi][ni] + gt[ni] * acc[mi][ni];
        }
    }
}

__device__ __forceinline__ void route_select(const Frame& F, float (&acc)[32], float rbias, int row, LAS int* selL, int li) {
    const int lane = F.lane;
#define BFLY(S, HALF) { const bool up = (lane >> (S)) & 1; _Pragma("unroll") for (int i = 0; i < (HALF); ++i) { \
        const float keep = up ? acc[i + (HALF)] : acc[i]; const float send = up ? acc[i] : acc[i + (HALF)]; acc[i] = keep + __shfl_xor(send, 1 << (S)); } }
    BFLY(0, 16) BFLY(1, 8) BFLY(2, 4) BFLY(3, 2) BFLY(4, 1)
#undef BFLY
    const float tot = acc[0] + __shfl_xor(acc[0], 32);
    const int e = lane & 31;
    const float logit = __shfl(tot, (int)(__builtin_bitreverse32((unsigned)e) >> 27));
    const float sc = 1.0f / (1.0f + expf(-logit));
    const float ss = sc + rbias;
    float m1 = ss;
#pragma unroll
    for (int o = 1; o < 8; o <<= 1) m1 = fmaxf(m1, __shfl_xor(m1, o));
    int i1 = (ss == m1) ? e : 64;
#pragma unroll
    for (int o = 1; o < 8; o <<= 1) i1 = min(i1, __shfl_xor(i1, o));
    const float s2 = (e == i1) ? -INFINITY : ss;
    float m2 = s2;
#pragma unroll
    for (int o = 1; o < 8; o <<= 1) m2 = fmaxf(m2, __shfl_xor(m2, o));
    int i2 = (s2 == m2 && e != i1) ? e : 64;
#pragma unroll
    for (int o = 1; o < 8; o <<= 1) i2 = min(i2, __shfl_xor(i2, o));
    const float gs = m1 + m2;
    float gbest = gs;
    gbest = fmaxf(gbest, __shfl_xor(gbest, 8)); gbest = fmaxf(gbest, __shfl_xor(gbest, 16));
    int gsel = (gs == gbest) ? (e >> 3) : 64;
    gsel = min(gsel, __shfl_xor(gsel, 8)); gsel = min(gsel, __shfl_xor(gsel, 16));
    const int e0 = __shfl(i1, gsel * 8) & 31, e1 = __shfl(i2, gsel * 8) & 31;
    const float w0 = __shfl(sc, e0), w1 = __shfl(sc, e1);
    if (lane == 0) {
        const float inv = 1.0f / (w0 + w1);
        selL[li * 2] = e0; selL[li * 2 + 1] = e1;
        ((float2*)(F.ws + WS_WT))[row] = make_float2(w0 * inv, w1 * inv);
        ((int2*)(F.ws + WS_SEL))[row] = make_int2(e0, e1);
    }
}

template <int LAYER>
__device__ __forceinline__ void phase_route(Frame& F) {
    const Args& A = *F.a;
    constexpr int NT = LAYER == 0 ? NTOK : NX;
    constexpr int PER = NT / 256;
    LAS char* RW = F.lds;
    LAS int* selL = (LAS int*)(F.lds + LDS_AUX);
    LAS int* rankL = selL + 2 * 68;
    const int tid = F.tid, lane = F.lane;
    {
        f32x4 t[16];
#pragma unroll
        for (int i = 0; i < 16; ++i) { const int idx = tid + 512 * i; t[i] = *(const f32x4*)(A.in[I_RW] + (size_t)(idx >> 3) * 32 + (idx & 7) * 4); }
#pragma unroll
        for (int i = 0; i < 16; ++i) {
            const int idx = tid + 512 * i, k = idx >> 3, e4 = idx & 7;
            const int rho = (((k >> 8) * 4 + (k & 3)) << 6) + ((k >> 2) & 63);
            *(LAS f32x4*)(RW + rho * 128 + ((e4 ^ ((rho >> 1) & 7)) << 4)) = t[i];
        }
    }
    __syncthreads();
    const int blk = F.vcu;
    if (blk < 256) {
        const float* XA = (const float*)(F.ws + WS_XA);
        bf16* H = (bf16*)(F.ws + WS_H);
        const float rbias = A.in[I_RB][lane & 31];
        f32x4 na[4], nb[4];
        load_row4(XA + (size_t)(blk * PER + 2 * F.wave) * D, lane, na); load_row4(XA + (size_t)(blk * PER + 2 * F.wave + 1) * D, lane, nb);
        for (int pi = F.wave; pi < PER / 2; pi += NWAVES) {
            const int li = 2 * pi, row = blk * PER + li;
            const int c = cond_of(row);
            f32x4 va[4], vb[4];
#pragma unroll
            for (int j = 0; j < 4; ++j) { va[j] = na[j]; vb[j] = nb[j]; }
            if constexpr (LAYER == 1) {
                const bf16* dl = (const bf16*)(F.ws + WS_DELTA) + (size_t)row * D;
#pragma unroll
                for (int j = 0; j < 4; ++j) {
                    const u32x2 d0 = *(const u32x2*)(dl + 4 * lane + 256 * j), d1 = *(const u32x2*)(dl + D + 4 * lane + 256 * j);
                    va[j] += (f32x4){bflo(d0.x), bfhi(d0.x), bflo(d0.y), bfhi(d0.y)}; vb[j] += (f32x4){bflo(d1.x), bfhi(d1.x), bflo(d1.y), bfhi(d1.y)};
                }
            }
            if (pi + NWAVES < PER / 2) { load_row4(XA + (size_t)(row + 2 * NWAVES) * D, lane, na); load_row4(XA + (size_t)(row + 2 * NWAVES + 1) * D, lane, nb); }
            const float ra = row_rstd(va), rb = row_rstd(vb);
            if constexpr (LAYER == 1 && L1_FP8) {
                row_modulate_store8(va, ra, A.in[I_N2G] + LAYER * D, modp(F, LAYER, c, 4), modp(F, LAYER, c, 3), (unsigned char*)H + (size_t)row * D, lane);
                row_modulate_store8(vb, rb, A.in[I_N2G] + LAYER * D, modp(F, LAYER, c, 4), modp(F, LAYER, c, 3), (unsigned char*)H + (size_t)(row + 1) * D, lane);
            } else {
                row_modulate_store(va, ra, A.in[I_N2G] + LAYER * D, modp(F, LAYER, c, 4), modp(F, LAYER, c, 3), H + (size_t)row * D, lane);
                row_modulate_store(vb, rb, A.in[I_N2G] + LAYER * D, modp(F, LAYER, c, 4), modp(F, LAYER, c, 3), H + (size_t)(row + 1) * D, lane);
            }
            float acca[32], accb[32];
#pragma unroll
            for (int e = 0; e < 32; ++e) { acca[e] = 0.f; accb[e] = 0.f; }
#pragma unroll 1
            for (int jc = 0; jc < 16; ++jc) {
                const int j = jc >> 2, cc = jc & 3;
                f32x4 ha4 = va[0], hb4 = vb[0];
                if (j == 1) { ha4 = va[1]; hb4 = vb[1]; }
                if (j == 2) { ha4 = va[2]; hb4 = vb[2]; }
                if (j == 3) { ha4 = va[3]; hb4 = vb[3]; }
                float ha = ha4.x, hb = hb4.x;
                if (cc == 1) { ha = ha4.y; hb = hb4.y; }
                if (cc == 2) { ha = ha4.z; hb = hb4.z; }
                if (cc == 3) { ha = ha4.w; hb = hb4.w; }
                const int rho = jc * 64 + lane;
                const LAS char* rp = RW + rho * 128; const int key = (rho >> 1) & 7;
                f32x4 w8[8];
#pragma unroll
                for (int e4 = 0; e4 < 8; ++e4) w8[e4] = *(const LAS f32x4*)(rp + ((e4 ^ key) << 4));
#pragma unroll
                for (int e4 = 0; e4 < 8; ++e4) {
                    acca[e4 * 4 + 0] += ha * w8[e4].x; acca[e4 * 4 + 1] += ha * w8[e4].y; acca[e4 * 4 + 2] += ha * w8[e4].z; acca[e4 * 4 + 3] += ha * w8[e4].w;
                    accb[e4 * 4 + 0] += hb * w8[e4].x; accb[e4 * 4 + 1] += hb * w8[e4].y; accb[e4 * 4 + 2] += hb * w8[e4].z; accb[e4 * 4 + 3] += hb * w8[e4].w;
                }
            }
            route_select(F, acca, rbias, row, selL, li);
            route_select(F, accb, rbias, row + 1, selL, li + 1);
        }
        __syncthreads();
        if (tid < 32) {
            int cnt = 0;
            for (int i = 0; i < 2 * PER; ++i) { if (selL[i] == tid) { rankL[i] = cnt; ++cnt; } }
            ((int*)(F.ws + WS_BLKCNT))[blk * 32 + tid] = cnt;
        }
        __syncthreads();
        for (int i = tid; i < PER; i += NTHREADS) ((int2*)(F.ws + WS_LRANK))[blk * PER + i] = make_int2(rankL[2 * i], rankL[2 * i + 1]);
    }
}

template <int LAYER>
__device__ __forceinline__ void phase_slots(Frame& F) {
    constexpr int NT = LAYER == 0 ? NTOK : NX;
    constexpr int PER = NT / 256;
    LAS int* part = (LAS int*)F.lds;
    LAS int* tot = part + 1024;
    LAS int* base = tot + 32;
    LAS int* pst = base + 32;
    const int tid = F.tid, blk = F.vcu;
    const int* bc = (const int*)(F.ws + WS_BLKCNT);
    {
        const int e = tid & 31, p = tid >> 5;
        int st = 0, sb = 0;
        for (int b2 = p; b2 < 256; b2 += 16) { const int c = bc[b2 * 32 + e]; st += c; sb += (b2 < blk) ? c : 0; }
        part[p * 32 + e] = st; part[512 + p * 32 + e] = sb;
    }
    __syncthreads();
    if (tid < 32) { int st = 0, sb = 0; for (int p = 0; p < 16; ++p) { st += part[p * 32 + tid]; sb += part[512 + p * 32 + tid]; } tot[tid] = st; base[tid] = sb; }
    __syncthreads();
    if (tid == 0) { int s = 0; for (int e = 0; e < 32; ++e) { pst[e] = s; s += (tot[e] + 127) & ~127; } pst[32] = s; }
    __syncthreads();
    int* slot_tok = (int*)(F.ws + WS_SLOTTOK); float* slot_w = (float*)(F.ws + WS_SLOTW);
    if (blk == 0 && tid < 33) ((int*)(F.ws + WS_PSTART))[tid] = pst[tid];
    if (blk < 256) {
        for (int i = tid; i < PER; i += NTHREADS) {
            const int t = blk * PER + i;
            const int2 se = ((const int2*)(F.ws + WS_SEL))[t]; const int2 lr = ((const int2*)(F.ws + WS_LRANK))[t]; const float2 wt = ((const float2*)(F.ws + WS_WT))[t];
            const int s0 = pst[se.x] + base[se.x] + lr.x, s1 = pst[se.y] + base[se.y] + lr.y;
            slot_tok[s0] = t; slot_w[s0] = wt.x; slot_tok[s1] = t; slot_w[s1] = wt.y;
            ((int2*)(F.ws + WS_TOKSLOT))[t] = make_int2(s0, s1);
        }
    }
    if (blk < 32) {
        const int lo = pst[blk] + tot[blk], hi = pst[blk + 1];
        for (int s = lo + tid; s < hi; s += NTHREADS) { slot_tok[s] = 0; slot_w[s] = 0.f; }
    }
}

template <int LAYER>
__device__ __forceinline__ void phase_moe_up(Frame& F) {
    constexpr bool F8 = (LAYER == 1) && L1_FP8;
    constexpr int KA = F8 ? D / 2 : D;
    LAS int* pst = (LAS int*)(F.lds + LDS_AUX);
    if (F.tid < 33) pst[F.tid] = ((const int*)(F.ws + WS_PSTART))[F.tid];
    __syncthreads();
    const int ntiles = pst[32] >> 7, nunits = ntiles * 4;
    const bf16* H = (const bf16*)(F.ws + WS_H);
    const bf16* W = F8 ? (const bf16*)(F.ws + WS_WUP + (size_t)64 * MiB) : (const bf16*)(F.ws + WS_WUP) + (size_t)LAYER * 32 * 1024 * 1024;
    const int* slot_tok = (const int*)(F.ws + WS_SLOTTOK); const float* slot_w = (const float*)(F.ws + WS_SLOTW);
    bf16* G = (bf16*)(F.ws + WS_G);
    const int wr = F.wave >> 2, wc = F.wave & 3, fr = F.lane & 15, fq = F.lane >> 4;
    LAS int* tix = pst + 64;
    for (int i = F.tid; i < 8 * 128; i += NTHREADS) { const int uu = F.vcu + (i >> 7) * F.G; tix[i] = (uu < nunits) ? slot_tok[(uu >> 2) * 128 + (i & 127)] : 0; }
    __syncthreads();
    ALGather al, alN; const bf16* Bp = W; const bf16* BpN = W; Ring R;
#define MOE_SETUP(uu, ui, al_, Bp_) do { const int m0_ = ((uu) >> 2) * 128; int e_ = 0; \
        for (int x = 1; x < 32; ++x) e_ = (pst[x] <= m0_) ? x : e_; \
        al_.p0 = H + (size_t)tix[(ui) * 128 + (F.tid >> 3)] * KA + dma_kc(F.tid); al_.p1 = H + (size_t)tix[(ui) * 128 + (F.tid >> 3) + 64] * KA + dma_kc(F.tid); \
        Bp_ = W + ((size_t)e_ * 1024 + ((uu) & 3) * 256) * KA; } while (0)
    if (F.vcu < nunits) { MOE_SETUP(F.vcu, 0, al, Bp); ring_start(F, R, al, Bp, KA); }
    int ui = 0;
    for (int u = F.vcu; u < nunits; u += F.G, ++ui) {
        const int mt = u >> 2, j = u & 3, m0 = mt * 128;
        const int un = u + F.G; const bool hasN = un < nunits;
        alN = al; BpN = Bp;
        if (hasN) MOE_SETUP(un, ui + 1, alN, BpN);
        f32x4 acc[4][4];
        if constexpr (F8) gemm3_unit<true, 8>(F, R, al, Bp, alN, BpN, hasN, KA, acc, u == F.vcu, FP8_SCALE_W, FP8_SCALE_ONE);
        else gemm3_unit<false, 8>(F, R, al, Bp, alN, BpN, hasN, KA, acc, u == F.vcu);
        al = alN; Bp = BpN;
#pragma unroll
        for (int mi = 0; mi < 4; ++mi) {
            const int row = m0 + wr * 64 + mi * 16 + fr;
            const float wgt = slot_w[row];
#pragma unroll
            for (int p = 0; p < 2; ++p) {
                const f32x4 g = acc[mi][2 * p], uu = acc[mi][2 * p + 1];
                float o[4];
#pragma unroll
                for (int c = 0; c < 4; ++c) o[c] = g[c] / (1.0f + __expf(-g[c])) * uu[c] * wgt;
                if constexpr (F8) {
#pragma unroll
                    for (int c = 0; c < 4; ++c) o[c] = fminf(fmaxf(o[c] * 8.0f, -448.0f), 448.0f);
                    *(unsigned*)((unsigned char*)G + (size_t)row * DEXP + j * 128 + wc * 32 + p * 16 + fq * 4) = pk4_fp8(o[0], o[1], o[2], o[3]);
                } else {
                    u32x2 ov; ov.x = pk2(o[0], o[1]); ov.y = pk2(o[2], o[3]);
                    *(u32x2*)(G + (size_t)row * DEXP + j * 128 + wc * 32 + p * 16 + fq * 4) = ov;
                }
            }
        }
    }
}

template <int LAYER>
__device__ __forceinline__ void phase_moe_down(Frame& F) {
    constexpr bool F8 = (LAYER == 1) && L1_FP8;
    constexpr int KA = F8 ? DEXP / 2 : DEXP;
    LAS int* pst = (LAS int*)(F.lds + LDS_AUX);
    if (F.tid < 33) pst[F.tid] = ((const int*)(F.ws + WS_PSTART))[F.tid];
    __syncthreads();
    const int ntiles = pst[32] >> 7, nunits = ntiles * 4;
    const bf16* G = (const bf16*)(F.ws + WS_G);
    const bf16* W = F8 ? (const bf16*)(F.ws + WS_WDN + (size_t)32 * MiB) : (const bf16*)(F.ws + WS_WDN) + (size_t)LAYER * 32 * 1024 * 512;
    bf16* Y = (bf16*)(F.ws + WS_Y);
    const int wr = F.wave >> 2, wc = F.wave & 3, fr = F.lane & 15, fq = F.lane >> 4;
    ALDense al, alN; const bf16* Bp = W; const bf16* BpN = W; Ring R;
#define MOED_SETUP(uu, al_, Bp_) do { const int m0_ = ((uu) >> 2) * 128; int e_ = 0; \
        for (int x = 1; x < 32; ++x) e_ = (pst[x] <= m0_) ? x : e_; \
        al_.init(G, KA, m0_, F.tid >> 3, (F.tid >> 3) + 64, dma_kc(F.tid)); Bp_ = W + ((size_t)e_ * 1024 + ((uu) & 3) * 256) * KA; } while (0)
    if (F.vcu < nunits) { MOED_SETUP(F.vcu, al, Bp); ring_start(F, R, al, Bp, KA); }
    for (int u = F.vcu; u < nunits; u += F.G) {
        const int mt = u >> 2, j = u & 3, m0 = mt * 128, n0 = j * 256;
        const int un = u + F.G; const bool hasN = un < nunits;
        alN = al; BpN = Bp;
        if (hasN) MOED_SETUP(un, alN, BpN);
        f32x4 acc[4][4];
        if constexpr (F8) gemm3_unit<true, 16>(F, R, al, Bp, alN, BpN, hasN, KA, acc, u == F.vcu, FP8_SCALE_W, FP8_SCALE_G);
        else gemm3_unit<false, 16>(F, R, al, Bp, alN, BpN, hasN, KA, acc, u == F.vcu);
        al = alN; Bp = BpN;
#pragma unroll
        for (int mi = 0; mi < 4; ++mi) {
            const int row = m0 + wr * 64 + mi * 16 + fr;
#pragma unroll
            for (int ni = 0; ni < 4; ++ni) {
                const f32x4 v = acc[mi][ni];
                u32x2 o; o.x = pk2(v.x, v.y); o.y = pk2(v.z, v.w);
                *(u32x2*)(Y + (size_t)row * D + n0 + wc * 64 + ni * 16 + fq * 4) = o;
            }
        }
    }
}

struct CRow { f32x4 x[4]; u32x2 y0[4], y1[4]; };
__device__ __forceinline__ void crow_load(const Frame& F, int row, int2 ts, CRow& r) {
    const float* XA = (const float*)(F.ws + WS_XA); const bf16* Y = (const bf16*)(F.ws + WS_Y);
#pragma unroll
    for (int j = 0; j < 4; ++j) {
        const int c0 = 4 * F.lane + 256 * j;
        r.x[j] = *(const f32x4*)(XA + (size_t)row * D + c0);
        r.y0[j] = *(const u32x2*)(Y + (size_t)ts.x * D + c0); r.y1[j] = *(const u32x2*)(Y + (size_t)ts.y * D + c0);
    }
}
__device__ __forceinline__ void crow_combine(const Frame& F, const CRow& r, const float* gate, f32x4 (&v)[4]) {
#pragma unroll
    for (int j = 0; j < 4; ++j) {
        const int c0 = 4 * F.lane + 256 * j;
        const f32x4 gt = *(const f32x4*)(gate + c0);
        f32x4 y; y.x = bflo(r.y0[j].x) + bflo(r.y1[j].x); y.y = bfhi(r.y0[j].x) + bfhi(r.y1[j].x); y.z = bflo(r.y0[j].y) + bflo(r.y1[j].y); y.w = bfhi(r.y0[j].y) + bfhi(r.y1[j].y);
        v[j] = r.x[j] + gt * y;
    }
}

__device__ __forceinline__ void phase_combine0(Frame& F) {
    const Args& A = *F.a;
    const int gw = F.vcu * NWAVES + F.wave, NGW = F.G * NWAVES;
    float* XA = (float*)(F.ws + WS_XA); bf16* H = (bf16*)(F.ws + WS_H);
    const int2* TS = (const int2*)(F.ws + WS_TOKSLOT);
    CRow cn; int2 tsn = make_int2(0, 0);
    if (gw < NTOK) crow_load(F, gw, TS[gw], cn);
    if (gw + NGW < NTOK) tsn = TS[gw + NGW];
    for (int row = gw; row < NTOK; row += NGW) {
        const int c = cond_of(row);
        const CRow cr = cn;
        const int nr = row + NGW;
        if (nr < NTOK) crow_load(F, nr, tsn, cn);
        if (nr + NGW < NTOK) tsn = TS[nr + NGW];
        f32x4 v[4];
        crow_combine(F, cr, modp(F, 0, c, 5), v);
#pragma unroll
        for (int j = 0; j < 4; ++j) *(f32x4*)(XA + (size_t)row * D + 4 * F.lane + 256 * j) = v[j];
        const float rstd = row_rstd(v);
        row_modulate_store(v, rstd, A.in[I_N1G] + D, modp(F, 1, c, 1), modp(F, 1, c, 0), H + (size_t)row * D, F.lane);
    }
}

__device__ __forceinline__ void phase_qkv(Frame& F) {
    LAS float* CS = (LAS float*)(F.lds + LDS_AUX);
    for (int i = F.tid; i < 1024; i += NTHREADS) {
        const int p = i >> 4, f = i & 15;
        const float inv = 1.0f / powf(10000.0f, (float)f / 16.0f);
        const float ang = (float)p * inv;
        const double rev = (double)ang * 0.15915494309189535;
        const float fr_ = (float)(rev - floor(rev));
        CS[i * 2] = __builtin_amdgcn_cosf(fr_); CS[i * 2 + 1] = __builtin_amdgcn_sinf(fr_);
    }
    __syncthreads();
    pg8::Gemm g{(const pg8::bf16_t*)(F.ws + WS_H), (const pg8::bf16_t*)(F.ws + WS_WQKV), NTOK, 3 * D, D};
    pg8::QkvOrder S; S.init(F.G, (int)blockIdx.x);
    pg8::EpiQKV E{(pg8::bf16_t*)(F.ws + WS_Q), (pg8::bf16_t*)(F.ws + WS_K), (pg8::bf16_t*)(F.ws + WS_VT), (const PG8_LAS float*)CS};
    pg8::gemm_phase<pg8::EpiQKV, pg8::QkvOrder, true, true>((PG8_LAS unsigned char*)F.lds, g, S, E);
}

constexpr int ATT_STAGE = 32768;
__device__ __forceinline__ int crow(int r, int hi) { return (r & 3) + 8 * (r >> 2) + 4 * hi; }
__device__ __forceinline__ void phase_attn(Frame& F) {
    const Args& A = *F.a;
    const int tid = F.tid, lane = F.lane, w = F.wave, r32 = lane & 31, hi = lane >> 5;
    const int mp = w >> 2, wq = w & 3;
    LAS char* lds = F.lds;
    float lam;
    { const float* dl = A.in[I_DALAM]; const float s1 = wave_sum(dl[lane] * dl[64 + lane]), s2 = wave_sum(dl[128 + lane] * dl[192 + lane]);
      lam = expf(s1) - expf(s2) + (0.8f - 0.6f * expf(-0.3f)); }
    const float oscale = 1.0f - (0.8f - 0.6f * expf(-0.3f));
    const bf16* Q = (const bf16*)(F.ws + WS_Q); const bf16* Kb = (const bf16*)(F.ws + WS_K); const bf16* VT = (const bf16*)(F.ws + WS_VT);
    bf16* AO = (bf16*)(F.ws + WS_AO);
    constexpr int NUNITS = NB * 8 * (S / 128), NTILES = KEYS / 64;
    LAS char* cbuf = lds + 65536 + w * 4096;
    const int cgw = F.vcu * NWAVES + w, CNGW = F.G * NWAVES;
    int cit = cgw; bool chas = cit < ND_ATTN;
    if (chas) { const TDesc cd = L1_FP8 ? decode_moe8(F, cit) : decode_moe(F, cit, 1); tr3_dma(cd, lane, cbuf); }
    for (int u = F.vcu; u < NUNITS; u += F.G) {
        const int bh = u >> 5, qb = u & 31, q0 = qb * 128;
        const bf16* Kg[2]; Kg[0] = Kb + (size_t)(bh * 2 + 0) * KEYS * 64; Kg[1] = Kb + (size_t)(bh * 2 + 1) * KEYS * 64;
        const bf16* Vg = VT + (size_t)bh * 128 * KEYS;
        LAS char* qlds = lds + 98304 + w * 4096;
        { const bf16* qp = Q + ((size_t)(bh * 2 + mp) * S + q0 + wq * 32 + r32) * 64 + hi * 8;
#pragma unroll
          for (int ks = 0; ks < 4; ++ks) __builtin_amdgcn_global_load_lds((const unsigned*)(qp + ks * 16), (LAS unsigned*)(qlds + ks * 1024), 16, 0, 0); }
        f32x16 o[4];
#pragma unroll
        for (int vb = 0; vb < 4; ++vb)
#pragma unroll
            for (int r = 0; r < 16; ++r) o[vb][r] = 0.f;
        float mrun = 0.f, lrun = 0.f;
        const int drow = w * 8 + (lane >> 3), dch = ((lane & 7) ^ ((drow >> 1) & 7)) * 8;
        const bf16* gk0 = Kg[0] + (size_t)drow * 64 + dch; const bf16* gk1 = Kg[1] + (size_t)drow * 64 + dch;
        const bf16* gv0 = Vg + (size_t)drow * KEYS + dch; const bf16* gv1 = Vg + (size_t)(64 + drow) * KEYS + dch;
#define ATT_DMA(t_, st_) do { LAS char* sb_ = lds + (st_) * ATT_STAGE + w * 1024; \
            __builtin_amdgcn_global_load_lds((const unsigned*)(gk0 + (size_t)(t_) * 64 * 64), (LAS unsigned*)(sb_), 16, 0, 0); \
            __builtin_amdgcn_global_load_lds((const unsigned*)(gk1 + (size_t)(t_) * 64 * 64), (LAS unsigned*)(sb_ + 8192), 16, 0, 0); \
            __builtin_amdgcn_global_load_lds((const unsigned*)(gv0 + (t_) * 64), (LAS unsigned*)(sb_ + 16384), 16, 0, 0); \
            __builtin_amdgcn_global_load_lds((const unsigned*)(gv1 + (t_) * 64), (LAS unsigned*)(sb_ + 16384 + 8192), 16, 0, 0); } while (0)
        ATT_DMA(0, 0);
        __syncthreads();
        for (int t = 0; t < NTILES; ++t) {
            const int st = t & 1;
            if (t + 1 < NTILES) ATT_DMA(t + 1, st ^ 1);
            const LAS char* Kt = lds + st * ATT_STAGE + mp * 8192;
            const LAS char* Vt = lds + st * ATT_STAGE + 16384;
            f32x16 s0, s1;
            { const float nm = -mrun;
#pragma unroll
              for (int r = 0; r < 16; ++r) { s0[r] = nm; s1[r] = nm; } }
            bf16x8 kf[8], qf[4];
#pragma unroll
            for (int ks = 0; ks < 4; ++ks) qf[ks] = *(const LAS bf16x8*)(qlds + ks * 1024 + lane * 16);
#pragma unroll
            for (int ks = 0; ks < 4; ++ks) {
                kf[2 * ks] = *(const LAS bf16x8*)(Kt + swz128(r32, 2 * ks + hi));
                kf[2 * ks + 1] = *(const LAS bf16x8*)(Kt + swz128(32 + r32, 2 * ks + hi));
            }
            u32x4 vf[2][4];
#define VLOAD(dst, vb_) do { const int vrow_ = (vb_) * 32 + r32; _Pragma("unroll") for (int kk_ = 0; kk_ < 4; ++kk_) \
                dst[kk_] = *(const LAS u32x4*)(Vt + swz128(vrow_, 2 * kk_ + hi)); } while (0)
            VLOAD(vf[0], 0);
            __builtin_amdgcn_sched_barrier(0);

#pragma unroll
            for (int ks = 0; ks < 4; ++ks) {
                s0 = __builtin_amdgcn_mfma_f32_32x32x16_bf16(kf[2 * ks], qf[ks], s0, 0, 0, 0);
                s1 = __builtin_amdgcn_mfma_f32_32x32x16_bf16(kf[2 * ks + 1], qf[ks], s1, 0, 0, 0);
            }

            float mx = fmaxf(s0[0], s1[0]);
#pragma unroll
            for (int r = 1; r < 16; ++r) mx = fmaxf(mx, fmaxf(s0[r], s1[r]));
            { const auto rr = __builtin_amdgcn_permlane32_swap(__builtin_bit_cast(unsigned, mx), __builtin_bit_cast(unsigned, mx), false, false);
              mx = fmaxf(__builtin_bit_cast(float, rr[0]), __builtin_bit_cast(float, rr[1])); }
            if (t == 0 || __any(mx > 8.0f)) {
                const float dl = (t == 0) ? mx : fmaxf(mx, 0.f);
                mrun += dl;
#pragma unroll
                for (int r = 0; r < 16; ++r) { s0[r] -= dl; s1[r] -= dl; }
                if (t > 0) {
                    const float f = __builtin_amdgcn_exp2f(-dl);
                    lrun *= f;
#pragma unroll
                    for (int vb = 0; vb < 4; ++vb)
#pragma unroll
                        for (int r = 0; r < 16; ++r) o[vb][r] *= f;
                }
            }
            float psum = 0.f;
#pragma unroll
            for (int r = 0; r < 16; ++r) { s0[r] = __builtin_amdgcn_exp2f(s0[r]); s1[r] = __builtin_amdgcn_exp2f(s1[r]); psum += s0[r] + s1[r]; }
            lrun += psum;
            bf16x8 pf[4];
#pragma unroll
            for (int s = 0; s < 2; ++s) {
                u32x4 a, b2;
                a.x = pk2(s0[8 * s + 0], s0[8 * s + 1]); a.y = pk2(s0[8 * s + 2], s0[8 * s + 3]); a.z = pk2(s0[8 * s + 4], s0[8 * s + 5]); a.w = pk2(s0[8 * s + 6], s0[8 * s + 7]);
                b2.x = pk2(s1[8 * s + 0], s1[8 * s + 1]); b2.y = pk2(s1[8 * s + 2], s1[8 * s + 3]); b2.z = pk2(s1[8 * s + 4], s1[8 * s + 5]); b2.w = pk2(s1[8 * s + 6], s1[8 * s + 7]);
                pf[s] = __builtin_bit_cast(bf16x8, a); pf[2 + s] = __builtin_bit_cast(bf16x8, b2);
            }
#pragma unroll
            for (int vb = 0; vb < 4; ++vb) {
                if (vb + 1 < 4) VLOAD(vf[(vb + 1) & 1], vb + 1);
                __builtin_amdgcn_sched_barrier(0);

#pragma unroll
                for (int kk = 0; kk < 4; ++kk)
                    o[vb] = __builtin_amdgcn_mfma_f32_32x32x16_bf16(__builtin_bit_cast(bf16x8, vf[vb & 1][kk]), pf[kk], o[vb], 0, 0, 0);

            }
#undef VLOAD
            __syncthreads();
            if ((t % 11) == 5 && chas) {
                asm volatile("s_waitcnt vmcnt(0)" ::: "memory");
                { if (L1_FP8) { const TDesc cd = decode_moe8(F, cit); tr3_finish_fp8(cd, lane, cbuf); } else { const TDesc cd = decode_moe(F, cit, 1); tr3_finish(cd, lane, cbuf); } }
                LDS_WAIT();
                cit += CNGW; chas = cit < ND_ATTN;
                if (chas) { const TDesc cd = L1_FP8 ? decode_moe8(F, cit) : decode_moe(F, cit, 1); tr3_dma(cd, lane, cbuf); }
            }
        }
#undef ATT_DMA
        lrun += __shfl_xor(lrun, 32);
        const float linv = 1.0f / lrun;
        LAS float* XO = (LAS float*)lds;
        if (mp == 1) {
#pragma unroll
            for (int vb = 0; vb < 4; ++vb)
#pragma unroll
                for (int r = 0; r < 16; ++r) XO[(wq * 64 + vb * 16 + r) * 64 + lane] = o[vb][r] * linv;
        }
        __syncthreads();
        if (mp == 0) {
            float ssq = 0.f;
#pragma unroll
            for (int vb = 0; vb < 4; ++vb)
#pragma unroll
                for (int r = 0; r < 16; ++r) { const float v = o[vb][r] * linv - lam * XO[(wq * 64 + vb * 16 + r) * 64 + lane]; o[vb][r] = v; ssq += v * v; }
            ssq += __shfl_xor(ssq, 32);
            const float rstd = rsqrtf(ssq * (1.0f / 128.0f) + EPS) * oscale;
            const int b = bh >> 3, h = bh & 7;
            bf16* dst = AO + (size_t)(b * S + q0 + wq * 32 + r32) * D + h * 128;
            const float* sg = A.in[I_SUBLN];
#pragma unroll
            for (int vb = 0; vb < 4; ++vb)
#pragma unroll
                for (int rq = 0; rq < 4; ++rq) {
                    const int v0 = vb * 32 + 8 * rq + 4 * hi;
                    const f32x4 g4 = *(const f32x4*)(sg + v0);
                    u32x2 ov; ov.x = pk2(o[vb][4 * rq] * rstd * g4.x, o[vb][4 * rq + 1] * rstd * g4.y); ov.y = pk2(o[vb][4 * rq + 2] * rstd * g4.z, o[vb][4 * rq + 3] * rstd * g4.w);
                    *(u32x2*)(dst + v0) = ov;
                }
        }
        __syncthreads();
    }
    while (chas) {
        asm volatile("s_waitcnt vmcnt(0)" ::: "memory");
        { if (L1_FP8) { const TDesc cd = decode_moe8(F, cit); tr3_finish_fp8(cd, lane, cbuf); } else { const TDesc cd = decode_moe(F, cit, 1); tr3_finish(cd, lane, cbuf); } }
        LDS_WAIT();
        cit += CNGW; chas = cit < ND_ATTN;
        if (chas) { const TDesc cd = L1_FP8 ? decode_moe8(F, cit) : decode_moe(F, cit, 1); tr3_dma(cd, lane, cbuf); }
    }
}

__device__ __forceinline__ void phase_gemm_wo(Frame& F) {
    pg8::Gemm g{(const pg8::bf16_t*)(F.ws + WS_AO), (const pg8::bf16_t*)(F.ws + WS_WO), NX, D, D};
    pg8::StaticOrder S; S.init(NX, D, F.G, (int)blockIdx.x);
    pg8::EpiScaleBf16 E{(pg8::bf16_t*)(F.ws + WS_DELTA), D, modp(F, 1, 0, 2), 6144};
    pg8::gemm_phase<pg8::EpiScaleBf16, pg8::StaticOrder, true, true>((PG8_LAS unsigned char*)F.lds, g, S, E);
}

__device__ __forceinline__ void phase_final(Frame& F) {
    const Args& A = *F.a;
    const int gw = F.vcu * NWAVES + F.wave, NGW = F.G * NWAVES;
    const int2* TS = (const int2*)(F.ws + WS_TOKSLOT);
    CRow cn; int2 tsn = make_int2(0, 0);
    if (gw < NX) crow_load(F, gw, TS[gw], cn);
    if (gw + NGW < NX) tsn = TS[gw + NGW];
    for (int row = gw; row < NX; row += NGW) {
        const CRow cr = cn;
        const int nr = row + NGW;
        if (nr < NX) crow_load(F, nr, tsn, cn);
        if (nr + NGW < NX) tsn = TS[nr + NGW];
        f32x4 v[4];
        crow_combine(F, cr, modp(F, 1, row >> 12, 5), v);
        { const bf16* dl = (const bf16*)(F.ws + WS_DELTA) + (size_t)row * D;
#pragma unroll
          for (int j = 0; j < 4; ++j) { const u32x2 d0 = *(const u32x2*)(dl + 4 * F.lane + 256 * j); v[j] += (f32x4){bflo(d0.x), bfhi(d0.x), bflo(d0.y), bfhi(d0.y)}; } }
        const float rstd = row_rstd(v);
#pragma unroll
        for (int j = 0; j < 4; ++j) {
            const int c0 = 4 * F.lane + 256 * j;
            const f32x4 g = *(const f32x4*)(A.in[I_FG] + c0);
            *(f32x4*)(A.out + (size_t)row * D + c0) = (v[j] * rstd) * g;
        }
    }
}

__global__ void __launch_bounds__(NTHREADS) fwd_kernel(Args args) {
    extern __shared__ __attribute__((aligned(16))) unsigned char smem[];
    Frame F;
    F.lds = (LAS char*)smem;
    F.tid = threadIdx.x; F.lane = F.tid & 63; F.wave = __builtin_amdgcn_readfirstlane(F.tid >> 6);
    F.G = gridDim.x; { const int bx = blockIdx.x; F.vcu = (F.G % 8 == 0) ? (bx % 8) * (F.G / 8) + bx / 8 : bx; }
    F.a = &args; F.ws = args.ws;
    volatile LAS unsigned* xbw = (volatile LAS unsigned*)(F.lds + LDS_XB);
    if (F.tid < 4) xbw[F.tid] = 0u;
    __syncthreads();
    XcdBarrier bar; bar.bar = (unsigned*)(F.ws + WS_CTL); bar.x = 0; bar.st = xbw;
    const int lo = args.ph_lo, hi = args.ph_hi;
    const bool multi = (hi - lo) > 1;
    if (multi) bar = xcd_barrier_post((unsigned*)(F.ws + WS_CTL), xbw);
#ifdef PROBE_PHASE
    unsigned long long pt0 = 0, pt1 = 0;
#define RUN_PHASE(k, call) do { if (lo <= (k) && (k) < hi) { if ((k) == PROBE_PHASE) pt0 = __builtin_amdgcn_s_memrealtime(); call; if ((k) + 1 < hi) xcd_barrier(bar); if ((k) == PROBE_PHASE) pt1 = __builtin_amdgcn_s_memrealtime(); } } while (0)
#else
#define RUN_PHASE(k, call) do { if (lo <= (k) && (k) < hi) { call; if ((k) + 1 < hi) xcd_barrier(bar); } } while (0)
#endif
    RUN_PHASE(0, phase_convert(F));
    RUN_PHASE(1, phase_prep0(F));
    RUN_PHASE(2, phase_gemm_in(F));
    RUN_PHASE(3, phase_scan(F));
    RUN_PHASE(4, (phase_combine_h(F), xcd_barrier(bar), phase_gemm_out0(F)));
    RUN_PHASE(5, phase_route<0>(F));
    RUN_PHASE(6, phase_slots<0>(F));
    RUN_PHASE(7, phase_moe_up<0>(F));
    RUN_PHASE(8, phase_moe_down<0>(F));
    RUN_PHASE(9, phase_combine0(F));
    RUN_PHASE(10, phase_qkv(F));
    RUN_PHASE(11, phase_attn(F));
    RUN_PHASE(12, phase_gemm_wo(F));
    RUN_PHASE(13, phase_route<1>(F));
    RUN_PHASE(14, phase_slots<1>(F));
    RUN_PHASE(15, phase_moe_up<1>(F));
    RUN_PHASE(16, phase_moe_down<1>(F));
    RUN_PHASE(17, phase_final(F));
#undef RUN_PHASE
#ifdef PROBE_PHASE
    xcd_barrier(bar);
    if (blockIdx.x == 0 && F.tid == 0) args.out[0] = 40.0f + floorf((float)(pt1 - pt0) * 0.001f + 0.5f);
#endif
}

extern "C" void kernel_launch(void* const* d_in, const int* in_sizes, int n_in, void* d_out, int out_size, void* d_ws, size_t ws_size, hipStream_t stream) {
    static int grid = 0;
    if (grid == 0) {
        if (n_in != 27 || out_size != NX * D || ws_size < WS_END) { fprintf(stderr, "kernel_launch: unexpected shapes (n_in %d out %d ws %zu)\n", n_in, out_size, ws_size); grid = -1; return; }
        int dev = 0, cus = 0;
        if (hipGetDevice(&dev) != hipSuccess || hipDeviceGetAttribute(&cus, hipDeviceAttributeMultiprocessorCount, dev) != hipSuccess) { grid = -1; return; }
        if (hipFuncSetAttribute((const void*)fwd_kernel, hipFuncAttributeMaxDynamicSharedMemorySize, LDS_BYTES) != hipSuccess) { fprintf(stderr, "kernel_launch: hipFuncSetAttribute failed\n"); grid = -1; return; }
        (void)hipGetLastError();
        grid = cus < 256 ? cus : 256;
    }
    if (grid < 0) return;
    (void)hipMemsetAsync((char*)d_ws + WS_CTL, 0, CTL_ZERO_BYTES, stream);
    Args a{};
    for (int i = 0; i < 27; ++i) a.in[i] = (const float*)d_in[i];
    a.out = (float*)d_out; a.ws = (unsigned char*)d_ws;
    if (MK_N_LAUNCHES == 1) {
        a.ph_lo = 0; a.ph_hi = NPHASES;
        hipLaunchKernelGGL(fwd_kernel, dim3(grid), dim3(NTHREADS), LDS_BYTES, stream, a);
    } else {
        if (DBG_NPH == 0) { a.ph_lo = 0; a.ph_hi = 0; hipLaunchKernelGGL(fwd_kernel, dim3(grid), dim3(NTHREADS), LDS_BYTES, stream, a); }
        for (int p = 0; p < DBG_NPH; ++p) { a.ph_lo = p; a.ph_hi = p + 1; hipLaunchKernelGGL(fwd_kernel, dim3(grid), dim3(NTHREADS), LDS_BYTES, stream, a); }
    }
}
```

```cpp
#include <hip/hip_runtime.h>
#include <cstdio>
#include <cstdint>

#ifndef MK_N_LAUNCHES
#define MK_N_LAUNCHES 1
#endif

#ifndef DBG_NPH
#define DBG_NPH 18
#endif
#define LAS __attribute__((address_space(3)))
typedef unsigned short bf16;
typedef short bf16x8 __attribute__((ext_vector_type(8)));
typedef float f32x4 __attribute__((ext_vector_type(4)));
typedef float f32x16 __attribute__((ext_vector_type(16)));
typedef unsigned u32x4 __attribute__((ext_vector_type(4)));
typedef unsigned u32x2 __attribute__((ext_vector_type(2)));
typedef float f32x2 __attribute__((ext_vector_type(2)));

constexpr int D = 1024, NB = 4, S = 4096, CL = 256;
constexpr int NX = NB * S, NC = NB * CL, NTOK = NX + NC;
constexpr int NEXP = 32, DEXP = 512;
constexpr int NWAVES = 8, NTHREADS = 512;
constexpr int KEYS = S + CL;
constexpr float EPS = 1e-6f;
constexpr int PMAX = 43008;
constexpr int NPHASES = 18;
constexpr float QSCALE = 0.125f * 1.4426950408889634f;

constexpr size_t MiB = 1u << 20;
constexpr size_t WS_CTL = 0, CTL_ZERO_BYTES = 64 * 1024;
constexpr size_t WS_MOD = 1 * MiB;
constexpr size_t WS_SEL = 2 * MiB;
constexpr size_t WS_WT = WS_SEL + 256 * 1024;
constexpr size_t WS_LRANK = WS_WT + 256 * 1024;
constexpr size_t WS_TOKSLOT = WS_LRANK + 256 * 1024;
constexpr size_t WS_BLKCNT = WS_TOKSLOT + 256 * 1024;
constexpr size_t WS_PSTART = WS_BLKCNT + 64 * 1024;
constexpr size_t WS_SLOTTOK = 3 * MiB + 512 * 1024;
constexpr size_t WS_SLOTW = WS_SLOTTOK + 256 * 1024;
constexpr size_t WS_WIN = 4 * MiB;
constexpr size_t WS_WOUT = 8 * MiB;
constexpr size_t WS_GATE = 10 * MiB;
constexpr size_t WS_WQKV = 11 * MiB;
constexpr size_t WS_WO = 17 * MiB;
constexpr size_t WS_WUP = 20 * MiB;
constexpr size_t WS_WDN = 148 * MiB;
constexpr size_t WS_XA = 212 * MiB;
constexpr size_t WS_H = 280 * MiB;
constexpr size_t WS_R = 314 * MiB;
constexpr size_t WS_YG = WS_R, WS_U = WS_R + 34 * MiB, WS_HF = WS_R + 68 * MiB, WS_HB = WS_R + 102 * MiB;
constexpr size_t WS_G = WS_R, WS_Y = WS_R + 42 * MiB;
constexpr size_t WS_Q = WS_R, WS_K = WS_R + 32 * MiB, WS_VT = WS_R + 66 * MiB, WS_AO = WS_R + 100 * MiB;
constexpr size_t WS_DELTA = 450 * MiB;
constexpr size_t WS_END = 482 * MiB;
static_assert(WS_Y + (size_t)PMAX * 1024 * 2 <= WS_END && WS_HB + 34 * MiB <= WS_END && WS_AO + 32 * MiB <= WS_END, "ws map");
static_assert(WS_K + (size_t)NB * 8 * 2 * KEYS * 64 * 2 <= WS_VT && WS_VT + (size_t)NB * 8 * 128 * KEYS * 2 <= WS_AO, "attn map");

constexpr int LDS_BYTES = 163840;
constexpr int LDS_XB = LDS_BYTES - 64;
constexpr int LDS_AUX = 147456;

__device__ __forceinline__ unsigned f2bf(float f) { unsigned u = __builtin_bit_cast(unsigned, f); return (u + 0x7fffu + ((u >> 16) & 1u)) >> 16; }
#ifndef L1_FP8
#define L1_FP8 1
#endif
typedef int i32x8 __attribute__((ext_vector_type(8)));
__device__ __forceinline__ unsigned pk4_fp8(float a, float b, float c, float d) { int w = 0; w = __builtin_amdgcn_cvt_pk_fp8_f32(a, b, w, false); w = __builtin_amdgcn_cvt_pk_fp8_f32(c, d, w, true); return (unsigned)w; }
constexpr int FP8_SCALE_ONE = 0x7f7f7f7f, FP8_SCALE_W = 0x7a7a7a7a  , FP8_SCALE_G = 0x7c7c7c7c  ;
typedef __bf16 bf16x2_t __attribute__((ext_vector_type(2)));
__device__ __forceinline__ unsigned pk2(float lo, float hi) { const f32x2 v = {lo, hi}; const bf16x2_t b = __builtin_convertvector(v, bf16x2_t); return __builtin_bit_cast(unsigned, b); }
__device__ __forceinline__ float bflo(unsigned w) { return __builtin_bit_cast(float, w << 16); }
__device__ __forceinline__ float bfhi(unsigned w) { return __builtin_bit_cast(float, w & 0xffff0000u); }
__device__ __forceinline__ float wave_sum(float v) {
#pragma unroll
    for (int o = 1; o < 64; o <<= 1) v += __shfl_xor(v, o);
    return v;
}
__device__ __forceinline__ float sigmoidf_(float x) { return 1.0f / (1.0f + __expf(-x)); }
#define LDS_WAIT() asm volatile("s_waitcnt lgkmcnt(0)" ::: "memory")

#define XB_TMO      128
#define XB_XCNT(j)  (256  + 64 * (j))
#define XB_XSUB(j)  (1280 + 64 * (j))
#define XB_XGEN(j)  (2304 + 64 * (j))
#define XB_TOP      3328
#define XB_TOPGEN   3392
#define XCD_BAR_WORDS 3456
#define XB_SPIN_CAP (1u << 18)
__device__ __forceinline__ unsigned xb_ld(unsigned* p)              { return __hip_atomic_load(p, __ATOMIC_RELAXED, __HIP_MEMORY_SCOPE_AGENT); }
__device__ __forceinline__ unsigned xb_add(unsigned* p, unsigned v) { return __hip_atomic_fetch_add(p, v, __ATOMIC_RELAXED, __HIP_MEMORY_SCOPE_AGENT); }
__device__ __forceinline__ unsigned xb_xcc_id() { return (unsigned)__builtin_amdgcn_s_getreg((3 << 11) | 20) & 0xFu; }
#define XB_SPIN(cond, bar) do { unsigned _sp = 0; while (cond) { __builtin_amdgcn_s_sleep(1); \
    if ((++_sp & 255u) == 0u) { if (xb_ld(&(bar)[XB_TMO])) break; if (_sp > XB_SPIN_CAP) { atomicAdd(&(bar)[XB_TMO], 1u); break; } } } } while (0)
struct XcdBarrier { unsigned* bar; unsigned x; volatile LAS unsigned* st; };
__device__ __forceinline__ XcdBarrier xcd_barrier_post(unsigned* bar, volatile LAS unsigned* st) {
    XcdBarrier b; b.bar = bar; b.x = xb_xcc_id(); b.st = st;
    if (threadIdx.x == 0) (void)xb_add(&bar[XB_XCNT(b.x)], 1u);
    return b;
}
__device__ __forceinline__ void xcd_barrier_complete(unsigned* bar, unsigned x, unsigned& nloc, unsigned& nx) {
    const unsigned G = gridDim.x * gridDim.y * gridDim.z;
    unsigned sum, cnt, mine, sp = 0u;
    for (;;) {
        sum = 0u; cnt = 0u; mine = 0u;
#pragma unroll
        for (unsigned j = 0; j < 16; ++j) { const unsigned c = xb_ld(&bar[XB_XCNT(j)]); sum += c; cnt += (c > 0u) ? 1u : 0u; mine = (j == x) ? c : mine; }
        if (sum == G) break;
        __builtin_amdgcn_s_sleep(1);
        if ((++sp & 255u) == 0u) { if (xb_ld(&bar[XB_TMO])) break; if (sp > XB_SPIN_CAP) { atomicAdd(&bar[XB_TMO], 1u); break; } }
    }
    nloc = mine > 0u ? mine : 1u; nx = cnt > 0u ? cnt : 1u;
}
__device__ __forceinline__ void xcd_barrier(const XcdBarrier& b) {
    asm volatile("s_waitcnt vmcnt(0)" ::: "memory");
    __syncthreads();
    if (threadIdx.x == 0) {
        unsigned* bar = b.bar;
        __builtin_amdgcn_s_waitcnt(0);
        unsigned nloc = b.st[0], nx = b.st[1];
        if (nloc == 0u) { xcd_barrier_complete(bar, b.x, nloc, nx); b.st[0] = nloc; b.st[1] = nx; }
        const unsigned old = xb_add(&bar[XB_XSUB(b.x)], 1u);
        const unsigned gen = old / nloc;
        if (old + 1u == (gen + 1u) * nloc) {
            __builtin_amdgcn_fence(__ATOMIC_RELEASE, "agent");
            asm volatile("s_waitcnt vmcnt(0)" ::: "memory");
            const unsigned og = xb_add(&bar[XB_TOP], 1u);
            const unsigned tg = og / nx;
            if (og + 1u == (tg + 1u) * nx) xb_add(&bar[XB_TOPGEN], 1u);
            else XB_SPIN(xb_ld(&bar[XB_TOPGEN]) == tg, bar);
            __builtin_amdgcn_fence(__ATOMIC_ACQUIRE, "agent");
            xb_add(&bar[XB_XGEN(b.x)], 1u);
            asm volatile("s_waitcnt vmcnt(0)" ::: "memory");
        } else {
            XB_SPIN(xb_ld(&bar[XB_XGEN(b.x)]) == gen, bar);
            __builtin_amdgcn_fence(__ATOMIC_ACQUIRE, "agent");
            asm volatile("s_waitcnt vmcnt(0)" ::: "memory");
        }
    }
    __syncthreads();
}

struct Args { const float* in[27]; float* out; unsigned char* ws; int ph_lo, ph_hi; };
enum { I_X = 0, I_C, I_CTX, I_CCTX, I_WMOD, I_BMOD, I_N1G, I_N2G, I_WIN, I_CONVW, I_CONVB, I_GAW, I_GAB, I_GXW, I_GXB, I_LAM, I_WOUT,
       I_WQKV, I_DALAM, I_SUBLN, I_WO, I_RW, I_RB, I_MG, I_MU, I_MD, I_FG };

struct Frame {
    LAS char* lds;
    int tid, lane, wave, vcu, G;
    const Args* a;
    unsigned char* ws;
};

__device__ __forceinline__ const float* modp(const Frame& F, int l, int c, int k) { return (const float*)(F.ws + WS_MOD) + (size_t)(l * 5 + c) * 6144 + k * 1024; }
__device__ __forceinline__ int cond_of(int row) { return row < NX ? (row >> 12) : 4; }

__device__ __forceinline__ int moe_up_row(int n) { return ((n >> 7) << 8) + (((n >> 5) & 3) << 6) + (((n >> 4) & 1) << 5) + (n & 15); }

struct TDesc { const float* W; bf16* WT; int N, ldT, mode, k0, n0; };
__device__ __forceinline__ void tr_load(const TDesc& t, int lane, f32x4 (&rg)[8]) {
    const float* p = t.W + (size_t)(t.k0 + (lane >> 3)) * t.N + t.n0 + 4 * (lane & 7);
#pragma unroll
    for (int i = 0; i < 8; ++i) rg[i] = *(const f32x4*)(p + (size_t)(8 * i) * t.N);
}
__device__ __forceinline__ void tr_finish(const TDesc& t, int lane, const f32x4 (&rg)[8], LAS float* scr) {
#pragma unroll
    for (int i = 0; i < 8; ++i) { LAS float* d = scr + ((lane >> 3) + 8 * i) * 33 + 4 * (lane & 7); d[0] = rg[i].x; d[1] = rg[i].y; d[2] = rg[i].z; d[3] = rg[i].w; }
    LDS_WAIT();
    const int c = lane & 7;
#pragma unroll
    for (int j = 0; j < 4; ++j) {
        const int n = (lane >> 3) + 8 * j; const LAS float* s = scr + (8 * c) * 33 + n;
        u32x4 o; o.x = pk2(s[0 * 33], s[1 * 33]); o.y = pk2(s[2 * 33], s[3 * 33]); o.z = pk2(s[4 * 33], s[5 * 33]); o.w = pk2(s[6 * 33], s[7 * 33]);
        const int nn = t.n0 + n;
        const int drow = (t.mode == 0) ? nn : (moe_up_row(nn) + (t.mode == 2 ? 16 : 0));
        *(u32x4*)(t.WT + (size_t)drow * t.ldT + t.k0 + 8 * c) = o;
    }
    LDS_WAIT();
}

__device__ __forceinline__ void phase_convert(Frame& F) {
    const Args& A = *F.a;
    LAS float* scr = (LAS float*)(F.lds + F.wave * 8448);
    LAS float* sil = (LAS float*)(F.lds + 69632);
    for (int i = F.tid; i < 5 * 1024; i += NTHREADS) { const int c = i >> 10, k = i & 1023; const float v = (c < 4) ? A.in[I_C][c * 1024 + k] : A.in[I_CCTX][k]; sil[i] = v / (1.0f + __expf(-v)); }
    __syncthreads();
    const int gw = F.vcu * NWAVES + F.wave, NGW = F.G * NWAVES;
    constexpr int N_MOD = 192, N_WIN = 16 * 64, N_WOUT = 16 * 32, N_WQKV = 16 * 96, N_WO = 16 * 32, N_GATE = 32 * 8, N_MOE = 64 * 256;
    {
        LAS float* red = (LAS float*)(F.lds + 90112);
        for (int item = F.vcu; item < N_MOD; item += F.G) {
            const int l = item / 96, col = (item % 96) * 64 + F.lane;
            const float* wp = A.in[I_WMOD] + ((size_t)l * 1024 + F.wave * 128) * 6144 + col;
            float acc[5] = {0.f, 0.f, 0.f, 0.f, 0.f};
#pragma unroll 4
            for (int k = 0; k < 128; k += 4) {
                const float w0 = wp[(size_t)k * 6144], w1 = wp[(size_t)(k + 1) * 6144], w2 = wp[(size_t)(k + 2) * 6144], w3 = wp[(size_t)(k + 3) * 6144];
#pragma unroll
                for (int c = 0; c < 5; ++c) { const f32x4 s4 = *(const LAS f32x4*)(sil + c * 1024 + F.wave * 128 + k); acc[c] += s4.x * w0 + s4.y * w1 + s4.z * w2 + s4.w * w3; }
            }
#pragma unroll
            for (int c = 0; c < 5; ++c) red[(F.wave * 5 + c) * 64 + F.lane] = acc[c];
            __syncthreads();
            if (F.tid < 320) {
                const int c = F.tid >> 6, ln = F.tid & 63;
                float s = A.in[I_BMOD][l * 6144 + (item % 96) * 64 + ln];
#pragma unroll
                for (int w2 = 0; w2 < 8; ++w2) s += red[(w2 * 5 + c) * 64 + ln];
                ((float*)(F.ws + WS_MOD))[(size_t)(l * 5 + c) * 6144 + (item % 96) * 64 + ln] = s;
            }
            __syncthreads();
        }
    }
    auto decode = [&](int r) -> TDesc {
        TDesc t; t.mode = 0;
        int item;
        if (r < N_WIN) { t.W = A.in[I_WIN]; t.N = 2048; t.WT = (bf16*)(F.ws + WS_WIN); t.ldT = 1024; item = r; }
        else if ((r -= N_WIN) < N_WOUT) { t.W = A.in[I_WOUT]; t.N = 1024; t.WT = (bf16*)(F.ws + WS_WOUT); t.ldT = 1024; item = r; }
        else {
            r -= N_WOUT;
            const int m = r >> 3, d = m >> 4, g = (m >> 3) & 1, n = m & 7;
            t.W = (g == 0 ? A.in[I_GAW] : A.in[I_GXW]) + (size_t)(d * 8 + n) * 128 * 128; t.N = 128;
            t.WT = (bf16*)(F.ws + WS_GATE) + (size_t)m * 128 * 128; t.ldT = 128; item = r & 7;
        }
        const int nblk = t.N >> 5; t.k0 = 64 * (item / nblk); t.n0 = 32 * (item % nblk);
        return t;
    };
    constexpr int NTR0 = N_WIN + N_WOUT + N_GATE;
    for (int it = gw; it < NTR0; it += NGW) {
        const TDesc cur = decode(it); f32x4 rg[8]; tr_load(cur, F.lane, rg);
        tr_finish(cur, F.lane, rg, scr);
    }
}

constexpr int ND_WQKV = 32 * 96, ND_WO = 32 * 32, ND_MOEL = 32 * 512;
constexpr int ND_SCAN = ND_WQKV + ND_WO + 3 * ND_MOEL;
constexpr int ND_ATTN = 3 * ND_MOEL;
__device__ __forceinline__ TDesc decode_moe(const Frame& F, int r, int layer) {
    const Args& A = *F.a;
    TDesc t; t.mode = 0; int item;
    if (r < ND_MOEL) { const int le = layer * 32 + (r >> 9); t.W = A.in[I_MG] + (size_t)le * 1024 * 512; t.N = 512; t.WT = (bf16*)(F.ws + WS_WUP) + (size_t)le * 1024 * 1024; t.ldT = 1024; t.mode = 1; item = r & 511; }
    else if ((r -= ND_MOEL) < ND_MOEL) { const int le = layer * 32 + (r >> 9); t.W = A.in[I_MU] + (size_t)le * 1024 * 512; t.N = 512; t.WT = (bf16*)(F.ws + WS_WUP) + (size_t)le * 1024 * 1024; t.ldT = 1024; t.mode = 2; item = r & 511; }
    else { r -= ND_MOEL; const int le = layer * 32 + (r >> 9); t.W = A.in[I_MD] + (size_t)le * 512 * 1024; t.N = 1024; t.WT = (bf16*)(F.ws + WS_WDN) + (size_t)le * 1024 * 512; t.ldT = 512; item = r & 511; }
    const int nblk = t.N >> 5; t.k0 = 32 * (item / nblk); t.n0 = 32 * (item % nblk);
    return t;
}
__device__ __forceinline__ TDesc decode_deferred(const Frame& F, int r) {
    const Args& A = *F.a;
    if (r >= ND_WQKV + ND_WO) return decode_moe(F, r - (ND_WQKV + ND_WO), 0);
    TDesc t; t.mode = 0; int item;
    if (r < ND_WQKV) { t.W = A.in[I_WQKV]; t.N = 3072; t.WT = (bf16*)(F.ws + WS_WQKV); t.ldT = 1024; item = r; }
    else { r -= ND_WQKV; t.W = A.in[I_WO]; t.N = 1024; t.WT = (bf16*)(F.ws + WS_WO); t.ldT = 1024; item = r; }
    const int nblk = t.N >> 5; t.k0 = 32 * (item / nblk); t.n0 = 32 * (item % nblk);
    return t;
}
__device__ __forceinline__ void tr3_dma(const TDesc& t, int lane, LAS char* buf) {
    const float* p = t.W + (size_t)(t.k0 + (lane >> 3)) * t.N + t.n0;
#pragma unroll
    for (int i = 0; i < 4; ++i)
        __builtin_amdgcn_global_load_lds((const unsigned*)(p + (size_t)(8 * i) * t.N + 4 * ((lane & 7) ^ i)), (LAS unsigned*)(buf + i * 1024), 16, 0, 0);
}
__device__ __forceinline__ void tr3_finish(const TDesc& t, int lane, const LAS char* buf) {
    const int c = lane & 3;
#pragma unroll
    for (int j = 0; j < 2; ++j) {
        const int n = (lane >> 2) + 16 * j;
        const LAS char* s = buf + (8 * c) * 128 + (((n >> 2) ^ c) << 4) + (n & 3) * 4;
        float x[8];
#pragma unroll
        for (int i = 0; i < 8; ++i) x[i] = *(const LAS float*)(s + i * 128);
        u32x4 o; o.x = pk2(x[0], x[1]); o.y = pk2(x[2], x[3]); o.z = pk2(x[4], x[5]); o.w = pk2(x[6], x[7]);
        const int nn = t.n0 + n;
        const int drow = (t.mode == 0) ? nn : (moe_up_row(nn) + (t.mode == 2 ? 16 : 0));
        *(u32x4*)(t.WT + (size_t)drow * t.ldT + t.k0 + 8 * c) = o;
    }
}
__device__ __forceinline__ void tr3_finish_fp8(const TDesc& t, int lane, const LAS char* buf) {
    const int c = lane & 1, n = lane >> 1;
    float x[16];
#pragma unroll
    for (int i = 0; i < 16; ++i) { const int r = 16 * c + i; x[i] = 32.0f * *(const LAS float*)(buf + r * 128 + (((n >> 2) ^ (r >> 3)) << 4) + (n & 3) * 4); }
    u32x4 o; o.x = pk4_fp8(x[0], x[1], x[2], x[3]); o.y = pk4_fp8(x[4], x[5], x[6], x[7]); o.z = pk4_fp8(x[8], x[9], x[10], x[11]); o.w = pk4_fp8(x[12], x[13], x[14], x[15]);
    const int nn = t.n0 + n;
    const int drow = (t.mode == 0) ? nn : (moe_up_row(nn) + (t.mode == 2 ? 16 : 0));
    *(u32x4*)((unsigned char*)t.WT + (size_t)drow * t.ldT + t.k0 + 16 * c) = o;
}
__device__ __forceinline__ TDesc decode_moe8(const Frame& F, int r) {
    const Args& A = *F.a;
    TDesc t; t.mode = 0; int item;
    unsigned char* up8 = F.ws + WS_WUP + (size_t)64 * MiB; unsigned char* dn8 = F.ws + WS_WDN + (size_t)32 * MiB;
    if (r < ND_MOEL) { const int e = r >> 9; t.W = A.in[I_MG] + (size_t)(32 + e) * 1024 * 512; t.N = 512; t.WT = (bf16*)(up8 + (size_t)e * 1024 * 1024); t.ldT = 1024; t.mode = 1; item = r & 511; }
    else if ((r -= ND_MOEL) < ND_MOEL) { const int e = r >> 9; t.W = A.in[I_MU] + (size_t)(32 + e) * 1024 * 512; t.N = 512; t.WT = (bf16*)(up8 + (size_t)e * 1024 * 1024); t.ldT = 1024; t.mode = 2; item = r & 511; }
    else { r -= ND_MOEL; const int e = r >> 9; t.W = A.in[I_MD] + (size_t)(32 + e) * 512 * 1024; t.N = 1024; t.WT = (bf16*)(dn8 + (size_t)e * 1024 * 512); t.ldT = 512; item = r & 511; }
    const int nblk = t.N >> 5; t.k0 = 32 * (item / nblk); t.n0 = 32 * (item % nblk);
    return t;
}
__device__ __forceinline__ void tr2_load(const TDesc& t, int lane, f32x4 (&rg)[4]) {
    const float* p = t.W + (size_t)(t.k0 + (lane >> 3)) * t.N + t.n0 + 4 * (lane & 7);
#pragma unroll
    for (int i = 0; i < 4; ++i) rg[i] = *(const f32x4*)(p + (size_t)(8 * i) * t.N);
}
__device__ __forceinline__ void tr2_finish(const TDesc& t, int lane, const f32x4 (&rg)[4], LAS float* scr  ) {
#pragma unroll
    for (int i = 0; i < 4; ++i) { LAS float* d = scr + ((lane >> 3) + 8 * i) * 33 + 4 * (lane & 7); d[0] = rg[i].x; d[1] = rg[i].y; d[2] = rg[i].z; d[3] = rg[i].w; }
    LDS_WAIT();
    const int c = lane & 3;
#pragma unroll
    for (int j = 0; j < 2; ++j) {
        const int n = (lane >> 2) + 16 * j; const LAS float* s = scr + (8 * c) * 33 + n;
        u32x4 o; o.x = pk2(s[0 * 33], s[1 * 33]); o.y = pk2(s[2 * 33], s[3 * 33]); o.z = pk2(s[4 * 33], s[5 * 33]); o.w = pk2(s[6 * 33], s[7 * 33]);
        const int nn = t.n0 + n;
        const int drow = (t.mode == 0) ? nn : (moe_up_row(nn) + (t.mode == 2 ? 16 : 0));
        *(u32x4*)(t.WT + (size_t)drow * t.ldT + t.k0 + 8 * c) = o;
    }
    LDS_WAIT();
}

constexpr int ND_TAILW = (256 - 32) * NWAVES;
constexpr int ND_A = ND_TAILW * 10, ND_B = ND_A + ND_TAILW * 7;
__device__ __forceinline__ void tail_convert(Frame& F, int tw, int first, int last) {
    LAS float* scr = (LAS float*)(F.lds + F.wave * 4224);
    int it = first + tw;
    if (it >= last) return;
    TDesc c0 = decode_deferred(F, it); f32x4 r0[4]; tr2_load(c0, F.lane, r0);
    for (;;) {
        const int n1 = it + ND_TAILW; const bool m1 = n1 < last;
        TDesc c1 = c0; f32x4 r1[4];
        if (m1) { c1 = decode_deferred(F, n1); tr2_load(c1, F.lane, r1); }
        tr2_finish(c0, F.lane, r0, scr);
        if (!m1) break;
        c0 = c1; it = n1;
#pragma unroll
        for (int i = 0; i < 4; ++i) r0[i] = r1[i];
    }
}

__device__ __forceinline__ float row_rstd(const f32x4 (&v)[4]) {
    float s = 0.f;
#pragma unroll
    for (int j = 0; j < 4; ++j) s += (v[j].x * v[j].x + v[j].y * v[j].y) + (v[j].z * v[j].z + v[j].w * v[j].w);
    return rsqrtf(wave_sum(s) * (1.0f / D) + EPS);
}
__device__ __forceinline__ void row_modulate_store8(f32x4 (&v)[4], float rstd, const float* g, const float* sc, const float* sh, unsigned char* dst, int lane) {
#pragma unroll
    for (int j = 0; j < 4; ++j) {
        const int c0 = 4 * lane + 256 * j;
        const f32x4 gg = *(const f32x4*)(g + c0), s1 = *(const f32x4*)(sc + c0), s0 = *(const f32x4*)(sh + c0);
        v[j] = (v[j] * rstd) * gg * (1.0f + s1) + s0;
        *(unsigned*)(dst + c0) = pk4_fp8(v[j].x, v[j].y, v[j].z, v[j].w);
    }
}
__device__ __forceinline__ void row_modulate_store(f32x4 (&v)[4], float rstd, const float* g, const float* sc, const float* sh, bf16* dst, int lane) {
#pragma unroll
    for (int j = 0; j < 4; ++j) {
        const int c0 = 4 * lane + 256 * j;
        const f32x4 gg = *(const f32x4*)(g + c0), s1 = *(const f32x4*)(sc + c0), s0 = *(const f32x4*)(sh + c0);
        v[j] = (v[j] * rstd) * gg * (1.0f + s1) + s0;
        u32x2 o; o.x = pk2(v[j].x, v[j].y); o.y = pk2(v[j].z, v[j].w);
        *(u32x2*)(dst + c0) = o;
    }
}

__device__ __forceinline__ void load_row4(const float* src, int lane, f32x4 (&v)[4]) {
#pragma unroll
    for (int j = 0; j < 4; ++j) v[j] = *(const f32x4*)(src + 4 * lane + 256 * j);
}
__device__ __forceinline__ void phase_prep0(Frame& F) {
    const Args& A = *F.a;
    const int gw = F.vcu * NWAVES + F.wave, NGW = F.G * NWAVES;
    bf16* H = (bf16*)(F.ws + WS_H);
    f32x4 vn[4];
    if (gw < NTOK) load_row4(gw < NX ? A.in[I_X] + (size_t)gw * D : A.in[I_CTX] + (size_t)(gw - NX) * D, F.lane, vn);
    for (int row = gw; row < NTOK; row += NGW) {
        const int c = cond_of(row);
        f32x4 v[4];
#pragma unroll
        for (int j = 0; j < 4; ++j) v[j] = vn[j];
        const int nr = row + NGW;
        if (nr < NTOK) load_row4(nr < NX ? A.in[I_X] + (size_t)nr * D : A.in[I_CTX] + (size_t)(nr - NX) * D, F.lane, vn);
        const float rstd = row_rstd(v);
        row_modulate_store(v, rstd, A.in[I_N1G], modp(F, 0, c, 1), modp(F, 0, c, 0), H + (size_t)row * D, F.lane);
    }
}

constexpr int GEMM_STAGE = 49152;
__device__ __forceinline__ int swz128(int row, int chunk) { return row * 128 + ((chunk ^ ((row >> 1) & 7)) << 4); }
__device__ __forceinline__ int dma_kc(int tid) { return ((tid & 7) ^ ((tid >> 4) & 7)) * 8; }

struct ALDense {
    static constexpr bool DMA = true;
    const bf16* p0; const bf16* p1;
    __device__ __forceinline__ const bf16* ptr(int i) const { return i ? p1 : p0; }
    __device__ __forceinline__ void init(const bf16* A, int lda, int m0, int r0, int r1, int kc) { p0 = A + (size_t)(m0 + r0) * lda + kc; p1 = A + (size_t)(m0 + r1) * lda + kc; }
    __device__ __forceinline__ u32x4 load(int i, int k0) const { return *(const u32x4*)((i ? p1 : p0) + k0); }
};
struct ALGather {
    static constexpr bool DMA = true;
    const bf16* p0; const bf16* p1;
    __device__ __forceinline__ const bf16* ptr(int i) const { return i ? p1 : p0; }
    __device__ __forceinline__ void init(const bf16* A, int lda, const int* idx, int m0, int r0, int r1, int kc) { p0 = A + (size_t)idx[m0 + r0] * lda + kc; p1 = A + (size_t)idx[m0 + r1] * lda + kc; }
    __device__ __forceinline__ u32x4 load(int i, int k0) const { return *(const u32x4*)((i ? p1 : p0) + k0); }
};
struct ALCombine {
    static constexpr bool DMA = false;
    size_t o0, o1; const bf16 *hf, *hb, *yg;
    __device__ __forceinline__ const bf16* ptr(int) const { return nullptr; }
    __device__ __forceinline__ void init(const bf16* hf_, const bf16* hb_, const bf16* yg_, int m0, int r0, int r1, int kc) { hf = hf_; hb = hb_; yg = yg_; o0 = (size_t)(m0 + r0) * D + kc; o1 = (size_t)(m0 + r1) * D + kc; }
    __device__ __forceinline__ u32x4 load(int i, int k0) const {
        const size_t o = (i ? o1 : o0) + k0;
        const u32x4 a = *(const u32x4*)(hf + o), b = *(const u32x4*)(hb + o), y = *(const u32x4*)(yg + o);
        u32x4 r;
#pragma unroll
        for (int q = 0; q < 4; ++q) r[q] = pk2((bflo(a[q]) + bflo(b[q])) * bflo(y[q]), (bfhi(a[q]) + bfhi(b[q])) * bfhi(y[q]));
        return r;
    }
};

template <class AL>
__device__ __forceinline__ void gemm_prefetch(const Frame& F, const AL& al, const bf16* __restrict__ Bt, int K) {
    const int tid = F.tid, sr = tid >> 3, sc = (tid & 7) ^ ((sr >> 1) & 7), wl = F.wave * 1024;
    const bf16* bp = Bt + (size_t)sr * K + sc * 8;
    const size_t bstep = (size_t)64 * K;
    LAS char* lds = F.lds;
    __builtin_amdgcn_global_load_lds((const unsigned*)(al.ptr(0)), (LAS unsigned*)(lds + wl), 16, 0, 0);
    __builtin_amdgcn_global_load_lds((const unsigned*)(al.ptr(1)), (LAS unsigned*)(lds + 8192 + wl), 16, 0, 0);
#pragma unroll
    for (int i = 0; i < 4; ++i)
        __builtin_amdgcn_global_load_lds((const unsigned*)(bp + i * bstep), (LAS unsigned*)(lds + 16384 + i * 8192 + wl), 16, 0, 0);
}
template <bool SWAP, class AL, bool PRE = false>
__device__ __forceinline__ void gemm_tile(const Frame& F, const AL& al, const bf16* __restrict__ Bt  , int K, f32x4 (&acc)[4][4]) {
    const int tid = F.tid, lane = F.lane, wid = F.wave, wr = wid >> 2, wc = wid & 3, fr = lane & 15, fq = lane >> 4;
    const int sr = tid >> 3;
    const int sc = AL::DMA ? ((tid & 7) ^ ((sr >> 1) & 7)) : (tid & 7);
    LAS char* lds = F.lds;
    const bf16* bp = Bt + (size_t)sr * K + sc * 8;
    const size_t bstep = (size_t)64 * K;
    int wa[2], wb[4];
#pragma unroll
    for (int i = 0; i < 2; ++i) wa[i] = swz128(sr + 64 * i, sc);
#pragma unroll
    for (int i = 0; i < 4; ++i) wb[i] = 16384 + swz128(sr + 64 * i, sc);
    const int key = (fr >> 1) & 7;
    const int ra = (wr * 64 + fr) * 128, rb = 16384 + (wc * 64 + fr) * 128;
#pragma unroll
    for (int mi = 0; mi < 4; ++mi)
#pragma unroll
        for (int ni = 0; ni < 4; ++ni) acc[mi][ni] = (f32x4){0.f, 0.f, 0.f, 0.f};
    u32x4 ga[2], gb[4];
    const int wl = wid * 1024;
#define GT_DMA(stage_, k_) do { \
        __builtin_amdgcn_global_load_lds((const unsigned*)(al.ptr(0) + (k_)), (LAS unsigned*)(lds + (stage_) + wl), 16, 0, 0); \
        __builtin_amdgcn_global_load_lds((const unsigned*)(al.ptr(1) + (k_)), (LAS unsigned*)(lds + (stage_) + 8192 + wl), 16, 0, 0); \
        _Pragma("unroll") for (int i_ = 0; i_ < 4; ++i_) \
            __builtin_amdgcn_global_load_lds((const unsigned*)(bp + i_ * bstep + (k_)), (LAS unsigned*)(lds + (stage_) + 16384 + i_ * 8192 + wl), 16, 0, 0); } while (0)
    if constexpr (AL::DMA) { if constexpr (!PRE) { GT_DMA(0, 0); } }
    else {
        ga[0] = al.load(0, 0); ga[1] = al.load(1, 0);
#pragma unroll
        for (int i = 0; i < 4; ++i) gb[i] = *(const u32x4*)(bp + i * bstep);
#pragma unroll
        for (int i = 0; i < 2; ++i) *(LAS u32x4*)(lds + wa[i]) = ga[i];
#pragma unroll
        for (int i = 0; i < 4; ++i) *(LAS u32x4*)(lds + wb[i]) = gb[i];
    }
    __syncthreads();
    const int nk = K / 64;
    for (int kt = 0; kt < nk; ++kt) {
        const int cur = (kt & 1) * GEMM_STAGE, nxt = GEMM_STAGE - cur;
        if (kt + 1 < nk) {
            const int k1 = (kt + 1) * 64;
            if constexpr (AL::DMA) { GT_DMA(nxt, k1); }
            else {
                ga[0] = al.load(0, k1); ga[1] = al.load(1, k1);
#pragma unroll
                for (int i = 0; i < 4; ++i) gb[i] = *(const u32x4*)(bp + i * bstep + k1);
            }
        }
        {
            bf16x8 af[2][4], bfr[2][4];
#pragma unroll
            for (int ks = 0; ks < 2; ++ks) {
                const int co = ((ks * 4 + fq) ^ key) << 4;
#pragma unroll
                for (int mi = 0; mi < 4; ++mi) af[ks][mi] = *(const LAS bf16x8*)(lds + cur + ra + mi * 2048 + co);
#pragma unroll
                for (int ni = 0; ni < 4; ++ni) bfr[ks][ni] = *(const LAS bf16x8*)(lds + cur + rb + ni * 2048 + co);
            }
            __builtin_amdgcn_sched_barrier(0);
#pragma unroll
            for (int ks = 0; ks < 2; ++ks)
#pragma unroll
                for (int mi = 0; mi < 4; ++mi)
#pragma unroll
                    for (int ni = 0; ni < 4; ++ni)
                        acc[mi][ni] = SWAP ? __builtin_amdgcn_mfma_f32_16x16x32_bf16(bfr[ks][ni], af[ks][mi], acc[mi][ni], 0, 0, 0)
                                           : __builtin_amdgcn_mfma_f32_16x16x32_bf16(af[ks][mi], bfr[ks][ni], acc[mi][ni], 0, 0, 0);
            __builtin_amdgcn_sched_barrier(0);
        }
        if constexpr (!AL::DMA) {
            if (kt + 1 < nk) {
#pragma unroll
                for (int i = 0; i < 2; ++i) *(LAS u32x4*)(lds + nxt + wa[i]) = ga[i];
#pragma unroll
                for (int i = 0; i < 4; ++i) *(LAS u32x4*)(lds + nxt + wb[i]) = gb[i];
            }
        }
        __syncthreads();
    }
#undef GT_DMA
}

#define G3_WAIT_BAR(N) asm volatile("s_waitcnt vmcnt(" #N ") lgkmcnt(0)\n\ts_barrier" ::: "memory")
template <class AL>
__device__ __forceinline__ void gemm3_issue(const Frame& F, const AL& al, const bf16* bp, size_t bstep, int stage_off, int k) {
    LAS char* lds = F.lds; const int wl = F.wave * 1024;
    __builtin_amdgcn_global_load_lds((const unsigned*)(al.ptr(0) + k), (LAS unsigned*)(lds + stage_off + wl), 16, 0, 0);
    __builtin_amdgcn_global_load_lds((const unsigned*)(al.ptr(1) + k), (LAS unsigned*)(lds + stage_off + 8192 + wl), 16, 0, 0);
#pragma unroll
    for (int i = 0; i < 4; ++i)
        __builtin_amdgcn_global_load_lds((const unsigned*)(bp + i * bstep + k), (LAS unsigned*)(lds + stage_off + 16384 + i * 8192 + wl), 16, 0, 0);
}
template <class AL>
__device__ __forceinline__ void gemm3_prefetch(const Frame& F, const AL& al, const bf16* __restrict__ Bt, int K) {
    const int tid = F.tid, sr = tid >> 3, sc = (tid & 7) ^ ((sr >> 1) & 7);
    const bf16* bp = Bt + (size_t)sr * K + sc * 8;
    gemm3_issue(F, al, bp, (size_t)64 * K, 0, 0);
    gemm3_issue(F, al, bp, (size_t)64 * K, GEMM_STAGE, 64);
}
template <bool SWAP, int EPI_ST, class AL>
__device__ __forceinline__ void gemm3_tile(const Frame& F, const AL& al, const bf16* __restrict__ Bt, int K, f32x4 (&acc)[4][4], bool first_unit) {
    static_assert(EPI_ST == 8 || EPI_ST == 16, "EPI_ST");
    const int tid = F.tid, lane = F.lane, wid = F.wave, wr = wid >> 2, wc = wid & 3, fr = lane & 15, fq = lane >> 4;
    const int sr = tid >> 3, sc = (tid & 7) ^ ((sr >> 1) & 7);
    LAS char* lds = F.lds;
    const bf16* bp = Bt + (size_t)sr * K + sc * 8;
    const size_t bstep = (size_t)64 * K;
    const int key = (fr >> 1) & 7;
    const int ra = (wr * 64 + fr) * 128, rb = 16384 + (wc * 64 + fr) * 128;
#pragma unroll
    for (int mi = 0; mi < 4; ++mi)
#pragma unroll
        for (int ni = 0; ni < 4; ++ni) acc[mi][ni] = (f32x4){0.f, 0.f, 0.f, 0.f};
    const int nk = K / 64;
    int cur = 0, nx2 = 2 * GEMM_STAGE;
    const int wl = wid * 1024;
#pragma unroll 1
    for (int kt = 0; kt < nk; ++kt) {
        if (kt + 1 >= nk) G3_WAIT_BAR(0);
        else if (kt >= 2 || first_unit) G3_WAIT_BAR(6);
        else if (kt == 0) { if constexpr (EPI_ST == 8) G3_WAIT_BAR(8); else G3_WAIT_BAR(16); }
        else { if constexpr (EPI_ST == 8) G3_WAIT_BAR(14); else G3_WAIT_BAR(22); }
        const bool more = kt + 2 < nk;
        const int k2 = (kt + 2) * 64;
#pragma unroll
        for (int ks = 0; ks < 2; ++ks) {
            const int co = ((ks * 4 + fq) ^ key) << 4;
            bf16x8 af[4], bfr[4];
#pragma unroll
            for (int mi = 0; mi < 4; ++mi) af[mi] = *(const LAS bf16x8*)(lds + cur + ra + mi * 2048 + co);
#pragma unroll
            for (int ni = 0; ni < 4; ++ni) bfr[ni] = *(const LAS bf16x8*)(lds + cur + rb + ni * 2048 + co);
#pragma unroll
            for (int mi = 0; mi < 4; ++mi) {
                if (more && mi < 3) {
                    const int g = ks * 3 + mi;
                    if (g < 2) __builtin_amdgcn_global_load_lds((const unsigned*)(al.ptr(g) + k2), (LAS unsigned*)(lds + nx2 + g * 8192 + wl), 16, 0, 0);
                    else __builtin_amdgcn_global_load_lds((const unsigned*)(bp + (g - 2) * bstep + k2), (LAS unsigned*)(lds + nx2 + 16384 + (g - 2) * 8192 + wl), 16, 0, 0);
                }
#pragma unroll
                for (int ni = 0; ni < 4; ++ni)
                    acc[mi][ni] = SWAP ? __builtin_amdgcn_mfma_f32_16x16x32_bf16(bfr[ni], af[mi], acc[mi][ni], 0, 0, 0)
                                       : __builtin_amdgcn_mfma_f32_16x16x32_bf16(af[mi], bfr[ni], acc[mi][ni], 0, 0, 0);
            }
        }
        nx2 = cur; cur = (cur == 2 * GEMM_STAGE) ? 0 : cur + GEMM_STAGE;
    }
    G3_WAIT_BAR(0);
}

template <int EPI_ST, class AL>
__device__ __forceinline__ void gemm3_tile8(const Frame& F, const AL& al, const bf16* __restrict__ Bt, int K2, f32x4 (&acc)[4][4], bool first_unit, int sc_w, int sc_a) {
    static_assert(EPI_ST == 8 || EPI_ST == 16, "EPI_ST");
    const int tid = F.tid, lane = F.lane, wid = F.wave, wr = wid >> 2, wc = wid & 3, fr = lane & 15, fq = lane >> 4;
    const int sr = tid >> 3, sc = (tid & 7) ^ ((sr >> 1) & 7);
    LAS char* lds = F.lds;
    const bf16* bp = Bt + (size_t)sr * K2 + sc * 8;
    const size_t bstep = (size_t)64 * K2;
    const int key = (fr >> 1) & 7;
    const int ra = (wr * 64 + fr) * 128, rb = 16384 + (wc * 64 + fr) * 128;
    const int c0 = ((2 * fq) ^ key) << 4, c1 = ((2 * fq + 1) ^ key) << 4;
#pragma unroll
    for (int mi = 0; mi < 4; ++mi)
#pragma unroll
        for (int ni = 0; ni < 4; ++ni) acc[mi][ni] = (f32x4){0.f, 0.f, 0.f, 0.f};
    const int nk = K2 / 64;
    int cur = 0, nx2 = 2 * GEMM_STAGE;
    const int wl = wid * 1024;
#pragma unroll 1
    for (int kt = 0; kt < nk; ++kt) {
        if (kt + 1 >= nk) G3_WAIT_BAR(0);
        else if (kt >= 2 || first_unit) G3_WAIT_BAR(6);
        else if (kt == 0) { if constexpr (EPI_ST == 8) G3_WAIT_BAR(8); else G3_WAIT_BAR(16); }
        else { if constexpr (EPI_ST == 8) G3_WAIT_BAR(14); else G3_WAIT_BAR(22); }
        const bool more = kt + 2 < nk;
        const int k2 = (kt + 2) * 64;
        i32x8 af[4], bfr[4];
#pragma unroll
        for (int mi = 0; mi < 4; ++mi) {
            const u32x4 lo = *(const LAS u32x4*)(lds + cur + ra + mi * 2048 + c0), hi = *(const LAS u32x4*)(lds + cur + ra + mi * 2048 + c1);
            af[mi] = (i32x8){(int)lo.x, (int)lo.y, (int)lo.z, (int)lo.w, (int)hi.x, (int)hi.y, (int)hi.z, (int)hi.w};
        }
#pragma unroll
        for (int ni = 0; ni < 4; ++ni) {
            const u32x4 lo = *(const LAS u32x4*)(lds + cur + rb + ni * 2048 + c0), hi = *(const LAS u32x4*)(lds + cur + rb + ni * 2048 + c1);
            bfr[ni] = (i32x8){(int)lo.x, (int)lo.y, (int)lo.z, (int)lo.w, (int)hi.x, (int)hi.y, (int)hi.z, (int)hi.w};
        }
#define G8_PIECE(g_) do { if ((g_) < 2) __builtin_amdgcn_global_load_lds((const unsigned*)(al.ptr(g_) + k2), (LAS unsigned*)(lds + nx2 + (g_) * 8192 + wl), 16, 0, 0); \
            else __builtin_amdgcn_global_load_lds((const unsigned*)(bp + ((g_) - 2) * bstep + k2), (LAS unsigned*)(lds + nx2 + 16384 + ((g_) - 2) * 8192 + wl), 16, 0, 0); } while (0)
#define G8_MMA(mi_) do { _Pragma("unroll") for (int ni = 0; ni < 4; ++ni) \
            acc[mi_][ni] = __builtin_amdgcn_mfma_scale_f32_16x16x128_f8f6f4(bfr[ni], af[mi_], acc[mi_][ni], 0, 0, 0, sc_w, 0, sc_a); } while (0)
        if (more) { G8_PIECE(0); G8_PIECE(1); }
        G8_MMA(0);
        if (more) { G8_PIECE(2); G8_PIECE(3); }
        G8_MMA(1);
        if (more) { G8_PIECE(4); }
        G8_MMA(2);
        if (more) { G8_PIECE(5); }
        G8_MMA(3);
#undef G8_PIECE
#undef G8_MMA
        nx2 = cur; cur = (cur == 2 * GEMM_STAGE) ? 0 : cur + GEMM_STAGE;
    }
    G3_WAIT_BAR(0);
}

struct Ring { int cur, nx2; };
template <class AL>
__device__ __forceinline__ void ring_start(const Frame& F, Ring& R, const AL& al, const bf16* __restrict__ Bt, int K2) {
    const int tid = F.tid, sr = tid >> 3, sc = (tid & 7) ^ ((sr >> 1) & 7);
    const bf16* bp = Bt + (size_t)sr * K2 + sc * 8;
    gemm3_issue(F, al, bp, (size_t)64 * K2, 0, 0);
    gemm3_issue(F, al, bp, (size_t)64 * K2, GEMM_STAGE, 64);
    R.cur = 0; R.nx2 = 2 * GEMM_STAGE;
}
template <bool F8, int EPI_ST, class AL>
__device__ __forceinline__ void gemm3_unit(const Frame& F, Ring& R, const AL& al, const bf16* __restrict__ Bt, const AL& alN, const bf16* __restrict__ BtN, bool hasN,
                                           int K2, f32x4 (&acc)[4][4], bool first_unit, int sc_w = 0, int sc_a = 0) {
    static_assert(EPI_ST == 8 || EPI_ST == 16, "EPI_ST");
    const int tid = F.tid, lane = F.lane, wid = F.wave, wr = wid >> 2, wc = wid & 3, fr = lane & 15, fq = lane >> 4;
    const int sr = tid >> 3, sc = (tid & 7) ^ ((sr >> 1) & 7);
    LAS char* lds = F.lds;
    const bf16* bp = Bt + (size_t)sr * K2 + sc * 8;
    const bf16* bpN = BtN + (size_t)sr * K2 + sc * 8;
    const size_t bstep = (size_t)64 * K2;
    const int key = (fr >> 1) & 7;
    const int ra = (wr * 64 + fr) * 128, rb = 16384 + (wc * 64 + fr) * 128;
#pragma unroll
    for (int mi = 0; mi < 4; ++mi)
#pragma unroll
        for (int ni = 0; ni < 4; ++ni) acc[mi][ni] = (f32x4){0.f, 0.f, 0.f, 0.f};
    const int nk = K2 / 64;
    int cur = R.cur, nx2 = R.nx2;
    const int wl = wid * 1024;
#pragma unroll 1
    for (int kt = 0; kt < nk; ++kt) {
        const bool later = (kt + 1 < nk) || hasN;
        if (!later) G3_WAIT_BAR(0);
        else if (kt >= 2 || first_unit) G3_WAIT_BAR(6);
        else { if constexpr (EPI_ST == 8) G3_WAIT_BAR(14); else G3_WAIT_BAR(22); }
        const bool own = kt + 2 < nk, more = own || hasN;
        const bf16* pa0 = own ? al.ptr(0) : alN.ptr(0); const bf16* pa1 = own ? al.ptr(1) : alN.ptr(1); const bf16* pb = own ? bp : bpN;
        const int k2 = (own ? kt + 2 : kt + 2 - nk) * 64;
#define G3_PIECE(g_) do { if ((g_) == 0) __builtin_amdgcn_global_load_lds((const unsigned*)(pa0 + k2), (LAS unsigned*)(lds + nx2 + wl), 16, 0, 0); \
            else if ((g_) == 1) __builtin_amdgcn_global_load_lds((const unsigned*)(pa1 + k2), (LAS unsigned*)(lds + nx2 + 8192 + wl), 16, 0, 0); \
            else __builtin_amdgcn_global_load_lds((const unsigned*)(pb + ((g_) - 2) * bstep + k2), (LAS unsigned*)(lds + nx2 + 16384 + ((g_) - 2) * 8192 + wl), 16, 0, 0); } while (0)
        if constexpr (F8) {
            const int c0 = ((2 * fq) ^ key) << 4, c1 = ((2 * fq + 1) ^ key) << 4;
            i32x8 af[4], bfr[4];
#pragma unroll
            for (int mi = 0; mi < 4; ++mi) {
                const u32x4 lo = *(const LAS u32x4*)(lds + cur + ra + mi * 2048 + c0), hi = *(const LAS u32x4*)(lds + cur + ra + mi * 2048 + c1);
                af[mi] = (i32x8){(int)lo.x, (int)lo.y, (int)lo.z, (int)lo.w, (int)hi.x, (int)hi.y, (int)hi.z, (int)hi.w};
            }
#pragma unroll
            for (int ni = 0; ni < 4; ++ni) {
                const u32x4 lo = *(const LAS u32x4*)(lds + cur + rb + ni * 2048 + c0), hi = *(const LAS u32x4*)(lds + cur + rb + ni * 2048 + c1);
                bfr[ni] = (i32x8){(int)lo.x, (int)lo.y, (int)lo.z, (int)lo.w, (int)hi.x, (int)hi.y, (int)hi.z, (int)hi.w};
            }
#define G8_MMA(mi_) do { _Pragma("unroll") for (int ni = 0; ni < 4; ++ni) \
                acc[mi_][ni] = __builtin_amdgcn_mfma_scale_f32_16x16x128_f8f6f4(bfr[ni], af[mi_], acc[mi_][ni], 0, 0, 0, sc_w, 0, sc_a); } while (0)
            if (more) { G3_PIECE(0); G3_PIECE(1); }
            G8_MMA(0);
            if (more) { G3_PIECE(2); G3_PIECE(3); }
            G8_MMA(1);
            if (more) { G3_PIECE(4); }
            G8_MMA(2);
            if (more) { G3_PIECE(5); }
            G8_MMA(3);
#undef G8_MMA
        } else {
#pragma unroll
            for (int ks = 0; ks < 2; ++ks) {
                const int co = ((ks * 4 + fq) ^ key) << 4;
                bf16x8 af[4], bfr[4];
#pragma unroll
                for (int mi = 0; mi < 4; ++mi) af[mi] = *(const LAS bf16x8*)(lds + cur + ra + mi * 2048 + co);
#pragma unroll
                for (int ni = 0; ni < 4; ++ni) bfr[ni] = *(const LAS bf16x8*)(lds + cur + rb + ni * 2048 + co);
#pragma unroll
                for (int mi = 0; mi < 4; ++mi) {
                    if (more && mi < 3) { if (ks == 0) { if (mi == 0) G3_PIECE(0); else if (mi == 1) G3_PIECE(1); else G3_PIECE(2); } else { if (mi == 0) G3_PIECE(3); else if (mi == 1) G3_PIECE(4); else G3_PIECE(5); } }
#pragma unroll
                    for (int ni = 0; ni < 4; ++ni) acc[mi][ni] = __builtin_amdgcn_mfma_f32_16x16x32_bf16(bfr[ni], af[mi], acc[mi][ni], 0, 0, 0);
                }
            }
        }
#undef G3_PIECE
        nx2 = cur; cur = (cur == 2 * GEMM_STAGE) ? 0 : cur + GEMM_STAGE;
    }
    R.cur = cur; R.nx2 = nx2;
}


__device__ __forceinline__ float gelu_tanh(float x) {
    const float z = 0.7978845608028654f * (x + 0.044715f * x * x * x);
    const float t = 1.0f - 2.0f / (1.0f + __expf(2.0f * z));
    return 0.5f * x * (1.0f + t);
}
namespace pg8 {
#define PG8_LAS __attribute__((address_space(3)))
typedef unsigned short bf16_t;
typedef short bf16x8 __attribute__((ext_vector_type(8)));
typedef float f32x4 __attribute__((ext_vector_type(4)));
typedef unsigned u32x4 __attribute__((ext_vector_type(4)));
constexpr int BM = 256, BK = 64, HALF = 128, HTB = HALF * BK * 2  , STAGE_BYTES = 8 * HTB, NXCD = 8, WGM = 8;

__host__ __device__ __forceinline__ int lds_byte(int r, int c) { const int st = (r >> 4) * 2 + (c >> 5), rr = r & 15, cc = c & 31, ob = rr * 64 + cc * 2; return st * 1024 + (ob ^ (((ob >> 9) & 1) << 5)); }
__host__ __device__ __forceinline__ void stage_rc(int b, int& R, int& C) { const int st = b / 1024, sb = b % 1024, swz = sb ^ (((sb >> 9) & 1) << 5); R = (st >> 1) * 16 + swz / 64; C = (st & 1) * 32 + (swz % 64) / 2; }
__host__ __device__ __forceinline__ int perm32(int rho) { const int n = rho >> 4, i = rho & 15; return 8 * (i >> 2) + 4 * n + (i & 3); }

struct Unit { int pm, pn; };
struct Gemm { const bf16_t* A; const bf16_t* Bt; int M, N, K; };

struct StaticOrder {
    int nM, nN, nwg, G, c;
    __host__ __device__ void init(int M, int N, int G_, int c_) { nM = M / BM; nN = N / BM; nwg = nM * nN; G = G_; c = c_; }
    __host__ __device__ bool next(int i, Unit& u) const {
        const long L = (long)i * G + c; if (L >= nwg) return false;
        int wgid = (int)L; { const int q = nwg / NXCD, r = nwg % NXCD, xcd = wgid % NXCD, off = wgid / NXCD; wgid = (xcd < r ? xcd * (q + 1) : r * (q + 1) + (xcd - r) * q) + off; }
        const int nig = WGM * nN, gid = wgid / nig, fm = gid * WGM, gsz = (nM - fm) < WGM ? (nM - fm) : WGM;
        u.pm = fm + ((wgid % nig) % gsz); u.pn = (wgid % nig) / gsz; return true;
    }
    __device__ __forceinline__ void a_ready(const Unit&) const {}
    __device__ __forceinline__ void done(const Unit&) const {}
};
__device__ __forceinline__ unsigned cvt_pk_bf16(float lo, float hi) { unsigned r; asm volatile("v_cvt_pk_bf16_f32 %0, %1, %2" : "=v"(r) : "v"(lo), "v"(hi)); return r; }
typedef float f32x2 __attribute__((ext_vector_type(2)));
template <class Epi, class Sched, bool ALIGN_EPI = false, bool SP2 = false>
__device__ __forceinline__ void gemm_phase(PG8_LAS unsigned char* lds, const Gemm g, const Sched& S, const Epi& E) {
    const int tid = threadIdx.x, wid = __builtin_amdgcn_readfirstlane(tid >> 6), lane = tid & 63, wr = wid >> 2, wc = wid & 3, fr = lane & 15, fq = lane >> 4;
    const int K = g.K, nt = K / BK;
    unsigned voffA[2], voffB[2];
#pragma unroll
    for (int i = 0; i < 2; ++i) { int R, C; stage_rc(tid * 16 + i * 8192, R, C); const int Rb = Epi::PERM ? ((R & ~31) + perm32(R & 31)) : R;
        voffA[i] = (unsigned)(R * K + C) * 2u; voffB[i] = (unsigned)(Rb * K + C) * 2u; }
    const size_t kstep = (size_t)(BK * 2);
    const size_t hstep = (size_t)HALF * K * 2;
    const size_t tstep = 2 * hstep;
    const unsigned ldsw = (unsigned)wid * 1024u;
    const int aoff = lds_byte(wr * 64 + fr, fq * 8), boff = lds_byte(wc * 32 + fr, fq * 8);
#define PG8_SA(b, h) (((b) * 2 + (h)) * HTB)
#define PG8_SB(b, h) ((4 + (b) * 2 + (h)) * HTB)
#define PG8_STAGE(bufoff, gbase, voff) do { _Pragma("unroll") for (int _i = 0; _i < 2; ++_i) \
        __builtin_amdgcn_global_load_lds((const unsigned*)((const char*)(gbase) + (voff)[_i]), (PG8_LAS unsigned*)(lds + (bufoff) + ldsw + _i * 8192), 16, 0, 0); } while (0)
#define PG8_LDA(dst, b, h) do { _Pragma("unroll") for (int m = 0; m < 4; ++m) _Pragma("unroll") for (int k = 0; k < 2; ++k) dst[m][k] = *(const PG8_LAS bf16x8*)(lds + PG8_SA(b, h) + aoff + m * 2048 + k * 1024); } while (0)
#define PG8_LDB(dst, b, h) do { _Pragma("unroll") for (int n = 0; n < 2; ++n) _Pragma("unroll") for (int k = 0; k < 2; ++k) dst[n][k] = *(const PG8_LAS bf16x8*)(lds + PG8_SB(b, h) + boff + n * 2048 + k * 1024); } while (0)
#define PG8_MMA(ai, bj, At, Bt) do { __builtin_amdgcn_s_setprio(1); _Pragma("unroll") for (int m = 0; m < 4; ++m) _Pragma("unroll") for (int n = 0; n < 2; ++n) _Pragma("unroll") for (int k = 0; k < 2; ++k) \
        acc[ai][bj][m][n] = __builtin_amdgcn_mfma_f32_16x16x32_bf16(Bt[n][k], At[m][k], acc[ai][bj][m][n], 0, 0, 0); __builtin_amdgcn_s_setprio(0); } while (0)
#define PG8_WAIT_V(n) asm volatile("s_waitcnt vmcnt(" #n ")" ::: "memory")
#define PG8_WAIT_L(n) asm volatile("s_waitcnt lgkmcnt(" #n ")" ::: "memory")
#define PG8_BAR __builtin_amdgcn_s_barrier()
#define PG8_SCHED __builtin_amdgcn_sched_barrier(0)
    Unit cur, nxt; int ui = 0;
    if (!S.next(0, cur)) return;
    f32x4 acc[2][2][4][2];
#pragma unroll
    for (int a = 0; a < 2; ++a)
#pragma unroll
        for (int b = 0; b < 2; ++b)
#pragma unroll
            for (int m = 0; m < 4; ++m)
#pragma unroll
                for (int n = 0; n < 2; ++n) acc[a][b][m][n] = (f32x4){0.f, 0.f, 0.f, 0.f};
    bf16x8 At[4][2], B0[2][2], B1[2][2];
    const char* cA = (const char*)g.A + (size_t)cur.pm * tstep; const char* cB = (const char*)g.Bt + (size_t)cur.pn * tstep;
    S.a_ready(cur);
    if constexpr (SP2) {
        PG8_STAGE(PG8_SB(0, 0), cB, voffB); PG8_STAGE(PG8_SB(0, 1), cB + hstep, voffB); PG8_STAGE(PG8_SA(0, 0), cA, voffA); PG8_STAGE(PG8_SA(0, 1), cA + hstep, voffA);
        if (wr == 1) PG8_BAR;
        PG8_WAIT_V(2); PG8_BAR;
        PG8_STAGE(PG8_SB(1, 0), cB + kstep, voffB); PG8_STAGE(PG8_SA(1, 0), cA + kstep, voffA); PG8_STAGE(PG8_SB(1, 1), cB + hstep + kstep, voffB);
        PG8_WAIT_V(6); PG8_BAR;
    } else {
        PG8_STAGE(PG8_SB(0, 0), cB, voffB); PG8_STAGE(PG8_SA(0, 0), cA, voffA); PG8_STAGE(PG8_SB(0, 1), cB + hstep, voffB); PG8_STAGE(PG8_SA(0, 1), cA + hstep, voffA);
        if (wr == 1) PG8_BAR;
        PG8_WAIT_V(4); PG8_BAR;
        PG8_STAGE(PG8_SB(1, 0), cB + kstep, voffB); PG8_STAGE(PG8_SA(1, 0), cA + kstep, voffA); PG8_STAGE(PG8_SB(1, 1), cB + hstep + kstep, voffB);
        PG8_WAIT_V(6); PG8_BAR;
    }
    for (;;) {
        const bool has_next = S.next(ui + 1, nxt);
        const char* nA = has_next ? (const char*)g.A + (size_t)nxt.pm * tstep : cA; const char* nB = has_next ? (const char*)g.Bt + (size_t)nxt.pn * tstep : cB;
        for (int t = 0; t < nt; t += 2) {
            const bool last = (t == nt - 2);
            const char* a1 = cA + (size_t)(t + 1) * kstep;
            const char* a2 = last ? nA : cA + (size_t)(t + 2) * kstep; const char* b2 = last ? nB : cB + (size_t)(t + 2) * kstep;
            const char* a3 = a2 + kstep; const char* b3 = b2 + kstep;
            if (last && has_next) S.a_ready(nxt);
            if constexpr (SP2) {
            PG8_LDB(B0, 0, 0); PG8_LDB(B1, 0, 1); PG8_SCHED; PG8_LDA(At, 0, 0); PG8_STAGE(PG8_SA(1, 1), a1 + hstep, voffA);
            PG8_WAIT_V(8); PG8_WAIT_L(0); PG8_BAR; PG8_MMA(0, 0, At, B0); PG8_MMA(0, 1, At, B1); PG8_BAR; PG8_SCHED;
            PG8_LDA(At, 0, 1); PG8_STAGE(PG8_SB(0, 0), b2, voffB); PG8_STAGE(PG8_SB(0, 1), b2 + hstep, voffB); PG8_STAGE(PG8_SA(0, 0), a2, voffA);
            PG8_WAIT_V(8); PG8_WAIT_L(0); PG8_BAR; PG8_MMA(1, 0, At, B0); PG8_MMA(1, 1, At, B1); PG8_BAR; PG8_SCHED;
            PG8_LDB(B0, 1, 0); PG8_LDB(B1, 1, 1); PG8_SCHED; PG8_LDA(At, 1, 0); PG8_STAGE(PG8_SA(0, 1), a2 + hstep, voffA);
            PG8_WAIT_V(8); PG8_WAIT_L(0); PG8_BAR; PG8_MMA(0, 0, At, B0); PG8_MMA(0, 1, At, B1); PG8_BAR; PG8_SCHED;
            PG8_LDA(At, 1, 1); PG8_STAGE(PG8_SB(1, 0), b3, voffB); PG8_STAGE(PG8_SB(1, 1), b3 + hstep, voffB); PG8_STAGE(PG8_SA(1, 0), a3, voffA);
            PG8_WAIT_V(8); PG8_WAIT_L(0); PG8_BAR; PG8_MMA(1, 0, At, B0); PG8_MMA(1, 1, At, B1); PG8_BAR; PG8_SCHED;
            } else {
            PG8_LDB(B0, 0, 0); PG8_SCHED; PG8_LDA(At, 0, 0); PG8_STAGE(PG8_SA(1, 1), a1 + hstep, voffA);
            PG8_WAIT_L(8); PG8_BAR; PG8_WAIT_L(0); PG8_MMA(0, 0, At, B0); PG8_BAR; PG8_SCHED;
            PG8_LDB(B1, 0, 1); PG8_STAGE(PG8_SB(0, 0), b2, voffB);
            PG8_BAR; PG8_WAIT_L(0); PG8_MMA(0, 1, At, B1); PG8_BAR;
            PG8_LDA(At, 0, 1); PG8_STAGE(PG8_SA(0, 0), a2, voffA);
            PG8_BAR; PG8_WAIT_L(0); PG8_MMA(1, 0, At, B0); PG8_BAR; PG8_SCHED;
            PG8_STAGE(PG8_SB(0, 1), b2 + hstep, voffB);
            PG8_WAIT_V(6); PG8_BAR; PG8_MMA(1, 1, At, B1); PG8_BAR;
            PG8_LDB(B0, 1, 0); PG8_SCHED; PG8_LDA(At, 1, 0); PG8_STAGE(PG8_SA(0, 1), a2 + hstep, voffA);
            PG8_WAIT_L(8); PG8_BAR; PG8_WAIT_L(0); PG8_MMA(0, 0, At, B0); PG8_BAR; PG8_SCHED;
            PG8_LDB(B1, 1, 1); PG8_STAGE(PG8_SB(1, 0), b3, voffB);
            PG8_BAR; PG8_WAIT_L(0); PG8_MMA(0, 1, At, B1); PG8_BAR;
            PG8_LDA(At, 1, 1); PG8_STAGE(PG8_SA(1, 0), a3, voffA);
            PG8_BAR; PG8_WAIT_L(0); PG8_MMA(1, 0, At, B0); PG8_BAR; PG8_SCHED;
            PG8_STAGE(PG8_SB(1, 1), b3 + hstep, voffB);
            PG8_WAIT_V(6); PG8_BAR; PG8_MMA(1, 1, At, B1); PG8_BAR;
            }
        }
        if constexpr (ALIGN_EPI) { if (wr == 0) PG8_BAR; }
        if constexpr (!Epi::AFTER_DRAIN) { E(acc, cur, wr, wc, fr, fq); S.done(cur); }
        if (!has_next) break;
#pragma unroll
        for (int a = 0; a < 2; ++a)
#pragma unroll
            for (int b = 0; b < 2; ++b)
#pragma unroll
                for (int m = 0; m < 4; ++m)
#pragma unroll
                    for (int n = 0; n < 2; ++n) acc[a][b][m][n] = (f32x4){0.f, 0.f, 0.f, 0.f};
        cur = nxt; cA = nA; cB = nB; ++ui;
        if constexpr (ALIGN_EPI) { if (wr == 1) PG8_BAR; }
    }
    PG8_WAIT_V(0);
    if constexpr (!ALIGN_EPI) { if (wr == 0) PG8_BAR; }
    PG8_BAR;
    if constexpr (Epi::AFTER_DRAIN) { E.fused(acc, cur, wr, wc, fr, fq, lds, wid, lane); S.done(cur); }
#undef PG8_SA
#undef PG8_SB
#undef PG8_STAGE
#undef PG8_LDA
#undef PG8_LDB
#undef PG8_MMA
#undef PG8_WAIT_V
#undef PG8_WAIT_L
#undef PG8_BAR
#undef PG8_SCHED
}
}

namespace pg8 {
struct EpiScaleBf16 {
    static constexpr bool PERM = true, AFTER_DRAIN = false;
    bf16_t* O; int ldc; const float* scale_base; int scale_stride;
    __device__ __forceinline__ void operator()(const f32x4 (&acc)[2][2][4][2], const Unit& u, int wr, int wc, int fr, int fq) const {
        const int row0 = u.pm * BM + wr * 64 + fr, col0 = u.pn * BM + wc * 32 + 8 * fq;
        const float* sc = scale_base + (size_t)((u.pm * BM) >> 12) * scale_stride;
        f32x4 sv[2][2];
#pragma unroll
        for (int bj = 0; bj < 2; ++bj)
#pragma unroll
            for (int n = 0; n < 2; ++n) sv[bj][n] = *(const f32x4*)(sc + col0 + bj * HALF + 4 * n);
#pragma unroll
        for (int ai = 0; ai < 2; ++ai)
#pragma unroll
            for (int m = 0; m < 4; ++m) { bf16_t* rowp = O + (size_t)(row0 + ai * HALF + m * 16) * ldc + col0;
#pragma unroll
                for (int bj = 0; bj < 2; ++bj) { const f32x4 v0 = acc[ai][bj][m][0] * sv[bj][0], v1 = acc[ai][bj][m][1] * sv[bj][1];
                    u32x4 w; w.x = cvt_pk_bf16(v0[0], v0[1]); w.y = cvt_pk_bf16(v0[2], v0[3]); w.z = cvt_pk_bf16(v1[0], v1[1]); w.w = cvt_pk_bf16(v1[2], v1[3]);
                    *(u32x4*)(rowp + bj * HALF) = w; } }
    }
};
struct EpiIn {
    static constexpr bool PERM = true, AFTER_DRAIN = false;
    bf16_t* YG; bf16_t* U;
    __device__ __forceinline__ void operator()(const f32x4 (&acc)[2][2][4][2], const Unit& u, int wr, int wc, int fr, int fq) const {
        const bool isy = u.pn < 4;
        bf16_t* base = isy ? YG : U;
        const int row0 = u.pm * BM + wr * 64 + fr, col0 = (u.pn & 3) * BM + wc * 32 + 8 * fq;
#pragma unroll
        for (int ai = 0; ai < 2; ++ai)
#pragma unroll
            for (int m = 0; m < 4; ++m) { bf16_t* rowp = base + (size_t)(row0 + ai * HALF + m * 16) * 1024 + col0;
#pragma unroll
                for (int bj = 0; bj < 2; ++bj) { f32x4 v0 = acc[ai][bj][m][0], v1 = acc[ai][bj][m][1];
                    if (isy) { v0 = (f32x4){::gelu_tanh(v0[0]), ::gelu_tanh(v0[1]), ::gelu_tanh(v0[2]), ::gelu_tanh(v0[3])}; v1 = (f32x4){::gelu_tanh(v1[0]), ::gelu_tanh(v1[1]), ::gelu_tanh(v1[2]), ::gelu_tanh(v1[3])}; }
                    u32x4 w; w.x = cvt_pk_bf16(v0[0], v0[1]); w.y = cvt_pk_bf16(v0[2], v0[3]); w.z = cvt_pk_bf16(v1[0], v1[1]); w.w = cvt_pk_bf16(v1[2], v1[3]);
                    *(u32x4*)(rowp + bj * HALF) = w; } }
    }
};
struct EpiQKV {
    static constexpr bool PERM = false, AFTER_DRAIN = false;
    bf16_t* Q; bf16_t* Kb; bf16_t* VT; const PG8_LAS float* cs;
    __device__ __forceinline__ void operator()(const f32x4 (&acc)[2][2][4][2], const Unit& u, int wr, int wc, int fr, int fq) const {
        const int region = u.pn >> 2, pq = u.pn & 3;
        const bool isctx = u.pm >= NX / BM;
#pragma unroll
        for (int ai = 0; ai < 2; ++ai)
#pragma unroll
            for (int m = 0; m < 4; ++m) {
                const int row = u.pm * BM + ai * HALF + wr * 64 + m * 16 + fr;
                int b, pos;
                if (!isctx) { b = row >> 12; pos = row & 4095; } else { b = (row - NX) >> 8; pos = S + ((row - NX) & 255); }
                if (region < 2) {
                    const int p = (wc & 1) ? (pos & 63) : (pos >> 6);
                    const float scl = region == 0 ? QSCALE : 1.0f;
#pragma unroll
                    for (int bj = 0; bj < 2; ++bj) {
                        const int hi2 = 4 * pq + 2 * bj + (wc >> 1);
                        bf16_t* dst = region == 0 ? Q + ((size_t)(b * 16 + hi2) * S + pos) * 64 : Kb + ((size_t)(b * 16 + hi2) * KEYS + pos) * 64;
#pragma unroll
                        for (int n = 0; n < 2; ++n) {
                            f32x4 o = acc[ai][bj][m][n];
                            if (!isctx) {
                                const f32x4 pv = acc[ai][bj][m][n ^ 1];
#pragma unroll
                                for (int i = 0; i < 4; ++i) { const float c_ = cs[(p * 16 + fq * 4 + i) * 2], s_ = cs[(p * 16 + fq * 4 + i) * 2 + 1]; o[i] = o[i] * c_ + (n ? pv[i] : -pv[i]) * s_; }
                            }
                            typedef unsigned u32x2_ __attribute__((ext_vector_type(2)));
                            u32x2_ w; w.x = cvt_pk_bf16(o[0] * scl, o[1] * scl); w.y = cvt_pk_bf16(o[2] * scl, o[3] * scl);
                            *(u32x2_*)(dst + (wc & 1) * 32 + n * 16 + fq * 4) = w;
                        }
                    }
                } else {
                    const int ppos = (pos & ~12) | ((pos & 4) << 1) | ((pos & 8) >> 1);
#pragma unroll
                    for (int bj = 0; bj < 2; ++bj)
#pragma unroll
                        for (int n = 0; n < 2; ++n) {
                            const int h = 2 * pq + bj, vd = 32 * wc + 16 * n + 4 * fq;
                            bf16_t* vp = VT + ((size_t)(b * 8 + h) * 128 + vd) * KEYS + ppos;
                            const f32x4 v = acc[ai][bj][m][n];
                            const unsigned p01 = cvt_pk_bf16(v[0], v[1]), p23 = cvt_pk_bf16(v[2], v[3]);
                            vp[0] = (bf16_t)(p01 & 0xffffu); vp[KEYS] = (bf16_t)(p01 >> 16); vp[2 * KEYS] = (bf16_t)(p23 & 0xffffu); vp[3 * KEYS] = (bf16_t)(p23 >> 16);
                        }
                }
            }
    }
};
struct QkvOrder {
    StaticOrder so; int G, c;
    __host__ __device__ void init(int G_, int c_) { so.init(NX, 3 * D, G_, c_); G = G_; c = c_; }
    __host__ __device__ bool next(int i, Unit& u) const {
        if (so.next(i, u)) return true;
        const long L = (long)i * G + c - so.nwg;
        if (L < 0 || L >= 32) return false;
        u.pm = NX / BM + (int)(L >> 3); u.pn = 4 + (int)(L & 7); return true;
    }
    __device__ __forceinline__ void a_ready(const Unit&) const {}
    __device__ __forceinline__ void done(const Unit&) const {}
};
}

__device__ __forceinline__ void phase_gemm_in(Frame& F) {
    pg8::Gemm g{(const pg8::bf16_t*)(F.ws + WS_H), (const pg8::bf16_t*)(F.ws + WS_WIN), NTOK, 2 * D, D};
    pg8::StaticOrder S; S.init(NTOK, 2 * D, F.G, (int)blockIdx.x);
    pg8::EpiIn E{(pg8::bf16_t*)(F.ws + WS_YG), (pg8::bf16_t*)(F.ws + WS_U)};
    pg8::gemm_phase<pg8::EpiIn, pg8::StaticOrder, true, true>((PG8_LAS unsigned char*)F.lds, g, S, E);
    if (blockIdx.x >= 32) tail_convert(F, ((int)blockIdx.x - 32) * NWAVES + F.wave, 0, ND_A);
}

__device__ __forceinline__ float neg_expm1(float x) {
    const float p = 1.0f + x * (0.5f + x * (0.16666667f + x * (0.041666668f + x * (0.0083333338f + x * 0.0013888889f))));
    const float ser = -x * p, big = 1.0f - __expf(x);
    return x > -0.5f ? ser : big;
}
__device__ __forceinline__ void phase_scan(Frame& F) {
    const Args& A = *F.a;
    const int wi = F.vcu;
    if (wi >= 256) return;
    const int b = wi >> 6, n = (wi >> 3) & 7, d = (wi >> 2) & 1, q = wi & 3;
    const int tid = F.tid, lane = F.lane, w = F.wave, fr = lane & 15, fq = lane >> 4;
    LAS char* RAW = F.lds;
    LAS char* AT = F.lds + 33792;
    LAS float* AGG = (LAS float*)(F.lds + 66560);
    LAS float* CIN = (LAS float*)(F.lds + 74752);
    const bf16* U = (const bf16*)(F.ws + WS_U);
    bf16* HO = (bf16*)(F.ws + (d ? WS_HB : WS_HF));
    const int chbase = n * 128, och = chbase + q * 32;
    const bf16* GT = (const bf16*)(F.ws + WS_GATE);
    LAS char* BT = F.lds + 81920;
#pragma unroll
    for (int i = 0; i < 2; ++i) {
        const int idx = tid + 512 * i, jrow = idx >> 4, c = idx & 15, nb = jrow >> 4, f2 = jrow & 15;
        *(LAS u32x4*)(BT + jrow * 256 + ((c ^ f2) << 4)) = *(const u32x4*)(GT + ((size_t)(((d * 2 + (nb >> 1)) * 8 + n) * 128 + q * 32 + (nb & 1) * 16 + f2)) * 128 + c * 8);
    }
    float ba[2], bi[2], sp8[2];
#pragma unroll
    for (int h = 0; h < 2; ++h) {
        const int ch = och + h * 16 + fr;
        ba[h] = A.in[I_GAB][d * 1024 + ch]; bi[h] = A.in[I_GXB][d * 1024 + ch];
        sp8[h] = 8.0f * log1pf(expf(-A.in[I_LAM][d * 1024 + ch]));
    }
    const int c8 = tid & 15, r0 = tid >> 4;
    LAS float* CW = (LAS float*)(F.lds + 78848);
    (void)CW;
    float cw[4][8], cb[8];
#pragma unroll
    for (int k = 0; k < 4; ++k) {
        const f32x4 a0 = *(const f32x4*)(A.in[I_CONVW] + k * 1024 + chbase + c8 * 8), a1 = *(const f32x4*)(A.in[I_CONVW] + k * 1024 + chbase + c8 * 8 + 4);
        cw[k][0] = a0.x; cw[k][1] = a0.y; cw[k][2] = a0.z; cw[k][3] = a0.w; cw[k][4] = a1.x; cw[k][5] = a1.y; cw[k][6] = a1.z; cw[k][7] = a1.w;
    }
    { const f32x4 a0 = *(const f32x4*)(A.in[I_CONVB] + chbase + c8 * 8), a1 = *(const f32x4*)(A.in[I_CONVB] + chbase + c8 * 8 + 4);
      cb[0] = a0.x; cb[1] = a0.y; cb[2] = a0.z; cb[3] = a0.w; cb[4] = a1.x; cb[5] = a1.y; cb[6] = a1.z; cb[7] = a1.w; }

    float hcar = 0.f;
    u32x4 pre[5];
    LAS float* cscr = (LAS float*)(F.lds + 98304 + w * 4224);
    const int cgw = F.vcu * NWAVES + w, CNGW = F.G * NWAVES;
    int cit = ND_B + cgw;
    TDesc cd2; f32x4 crg2[4]; bool chas2 = false;
    for (int step = 0; step < 34; ++step) {
        TDesc cd; f32x4 crg[4]; const bool chas = cit < ND_SCAN;
        if (chas) { cd = decode_deferred(F, cit); tr2_load(cd, lane, crg); cit += CNGW; }
        int segbase, seglen, tile;
        if (step < 2) { segbase = NX + b * CL; seglen = CL; tile = d ? (1 - step) : step; }
        else { segbase = b * S; seglen = S; tile = d ? (33 - step) : (step - 2); }
        const int t0 = tile * 128;
        if (step == 0) {
#pragma unroll
            for (int i = 0; i < 5; ++i) {
                const int idx = tid + 512 * i; const int row = idx >> 4, c = idx & 15; const int t = t0 - 2 + row;
                u32x4 v = (u32x4){0u, 0u, 0u, 0u};
                if (idx < 2112 && t >= 0 && t < seglen) v = *(const u32x4*)(U + (size_t)(segbase + t) * D + chbase + c * 8);
                pre[i] = v;
            }
        }
#pragma unroll
        for (int i = 0; i < 5; ++i) { const int idx = tid + 512 * i; if (idx < 2112) *(LAS u32x4*)(RAW + idx * 16) = pre[i]; }
        __syncthreads();
        if (step + 1 < 34) {
            const int s1 = step + 1; int sb1, sl1, tl1;
            if (s1 < 2) { sb1 = NX + b * CL; sl1 = CL; tl1 = d ? (1 - s1) : s1; }
            else { sb1 = b * S; sl1 = S; tl1 = d ? (33 - s1) : (s1 - 2); }
            const int t1 = tl1 * 128;
#pragma unroll
            for (int i = 0; i < 5; ++i) {
                const int idx = tid + 512 * i; const int row = idx >> 4, c = idx & 15; const int t = t1 - 2 + row;
                u32x4 v = (u32x4){0u, 0u, 0u, 0u};
                if (idx < 2112 && t >= 0 && t < sl1) v = *(const u32x4*)(U + (size_t)(sb1 + t) * D + chbase + c * 8);
                pre[i] = v;
            }
        }
#pragma unroll
        for (int i = 0; i < 4; ++i) {
            const int r = r0 + 32 * i;
            float o[8];
#pragma unroll
            for (int j = 0; j < 8; ++j) o[j] = cb[j];
#pragma unroll
            for (int k = 0; k < 4; ++k) {
                const u32x4 x = *(const LAS u32x4*)(RAW + (r + k) * 256 + c8 * 16);
#pragma unroll
                for (int p = 0; p < 4; ++p) { o[2 * p] += cw[k][2 * p] * bflo(x[p]); o[2 * p + 1] += cw[k][2 * p + 1] * bfhi(x[p]); }
            }
            u32x4 ov; ov.x = pk2(o[0], o[1]); ov.y = pk2(o[2], o[3]); ov.z = pk2(o[4], o[5]); ov.w = pk2(o[6], o[7]);
            *(LAS u32x4*)(AT + r * 256 + ((c8 ^ (r & 15)) << 4)) = ov;
        }
        __syncthreads();
        f32x4 acc[4];
#pragma unroll
        for (int nb = 0; nb < 4; ++nb) acc[nb] = (f32x4){0.f, 0.f, 0.f, 0.f};
#pragma unroll
        for (int ks = 0; ks < 4; ++ks) {
            const int row = 16 * w + fr;
            const bf16x8 af = *(const LAS bf16x8*)(AT + row * 256 + (((4 * ks + fq) ^ fr) << 4));
#pragma unroll
            for (int nb = 0; nb < 4; ++nb) {
                const bf16x8 bq = *(const LAS bf16x8*)(BT + (nb * 16 + fr) * 256 + (((4 * ks + fq) ^ fr) << 4));
                acc[nb] = __builtin_amdgcn_mfma_f32_16x16x32_bf16(af, bq, acc[nb], 0, 0, 0);
            }
        }
        float av[2][4], bv[2][4];
#pragma unroll
        for (int h = 0; h < 2; ++h) {
            const int col = q * 32 + h * 16 + fr, chunk = col >> 3, within = col & 7;
#pragma unroll
            for (int reg = 0; reg < 4; ++reg) {
                const int tr = 16 * w + 4 * fq + reg;
                const float r_ = __builtin_amdgcn_rcpf(1.0f + __builtin_amdgcn_exp2f(-1.4426950408889634f * (acc[h][reg] + ba[h])));
                const float i_ = __builtin_amdgcn_rcpf(1.0f + __builtin_amdgcn_exp2f(-1.4426950408889634f * (acc[2 + h][reg] + bi[h])));
                const float la = -sp8[h] * r_;
                const float a_ = __builtin_amdgcn_exp2f(1.4426950408889634f * la);
                const unsigned short ub = *(const LAS unsigned short*)(AT + tr * 256 + ((chunk ^ (tr & 15)) << 4) + within * 2);
                const float uval = __builtin_bit_cast(float, (unsigned)ub << 16);
                av[h][reg] = a_;
                bv[h][reg] = __builtin_amdgcn_sqrtf(neg_expm1(2.0f * la)) * (i_ * uval);
            }
        }
        const int g = 4 * w + fq;
#pragma unroll
        for (int h = 0; h < 2; ++h) {
            float P = 1.f, Hh = 0.f;
#pragma unroll
            for (int s = 0; s < 4; ++s) { const int reg = d ? (3 - s) : s; Hh = av[h][reg] * Hh + bv[h][reg]; P *= av[h][reg]; }
            AGG[(g * 32 + h * 16 + fr) * 2 + 0] = P; AGG[(g * 32 + h * 16 + fr) * 2 + 1] = Hh;
        }
        if (chas2) tr2_finish(cd2, lane, crg2, cscr);
        chas2 = cit < ND_SCAN;
        if (chas2) { cd2 = decode_deferred(F, cit); tr2_load(cd2, lane, crg2); cit += CNGW; }
        __syncthreads();
        if (tid < 32) {
            f32x2 ag[32];
#pragma unroll
            for (int gi = 0; gi < 32; ++gi) ag[gi] = *(const LAS f32x2*)(AGG + (gi * 32 + tid) * 2);
            float hh = hcar;
            if (d == 0) {
#pragma unroll
                for (int gi = 0; gi < 32; ++gi) { CIN[gi * 32 + tid] = hh; hh = ag[gi].x * hh + ag[gi].y; }
            } else {
#pragma unroll
                for (int gi = 31; gi >= 0; --gi) { CIN[gi * 32 + tid] = hh; hh = ag[gi].x * hh + ag[gi].y; }
            }
            hcar = hh;
        }
        __syncthreads();
#pragma unroll
        for (int h = 0; h < 2; ++h) {
            float hh = CIN[g * 32 + h * 16 + fr];
            float outv[4];
#pragma unroll
            for (int s = 0; s < 4; ++s) { const int reg = d ? (3 - s) : s; hh = av[h][reg] * hh + bv[h][reg]; outv[reg] = hh; }
#pragma unroll
            for (int reg = 0; reg < 4; ++reg) {
                const int tr = 16 * w + 4 * fq + reg;
                HO[(size_t)(segbase + t0 + tr) * D + och + h * 16 + fr] = (bf16)f2bf(outv[reg]);
            }
        }
        if (chas) tr2_finish(cd, lane, crg, cscr);
    }
    if (chas2) tr2_finish(cd2, lane, crg2, cscr);
}

__device__ __forceinline__ void phase_combine_h(Frame& F) {
    const u32x4* hf = (const u32x4*)(F.ws + WS_HF); const u32x4* hb = (const u32x4*)(F.ws + WS_HB); const u32x4* yg = (const u32x4*)(F.ws + WS_YG);
    u32x4* hc = (u32x4*)(F.ws + WS_U);
    constexpr int NCH = NTOK * (D / 8);
    const int stride = F.G * NTHREADS;
    for (int i = F.vcu * NTHREADS + F.tid; i < NCH; i += 4 * stride) {
        u32x4 a[4], b[4], y[4];
#pragma unroll
        for (int j = 0; j < 4; ++j) { const int idx = i + j * stride; if (idx < NCH) { a[j] = hf[idx]; b[j] = hb[idx]; y[j] = yg[idx]; } }
#pragma unroll
        for (int j = 0; j < 4; ++j) {
            const int idx = i + j * stride;
            if (idx < NCH) {
                u32x4 r;
#pragma unroll
                for (int q = 0; q < 4; ++q) r[q] = pk2((bflo(a[j][q]) + bflo(b[j][q])) * bflo(y[j][q]), (bfhi(a[j][q]) + bfhi(b[j][q])) * bfhi(y[j][q]));
                hc[idx] = r;
            }
        }
    }
}
__device__ __forceinline__ void phase_gemm_out0(Frame& F) {
    const Args& A = *F.a;
    const bf16* W = (const bf16*)(F.ws + WS_WOUT);
    const bf16* HC = (const bf16*)(F.ws + WS_U);
    float* XA = (float*)(F.ws + WS_XA);
    const int wr = F.wave >> 2, wc = F.wave & 3, fr = F.lane & 15, fq = F.lane >> 4;
    constexpr int NTN = 4, NUNITS = (NTOK / 128) * NTN;
    ALDense al, alN; const bf16* Bp = W; const bf16* BpN = W; Ring R;
    if (F.vcu < NUNITS) { al.init(HC, D, (F.vcu / NTN) * 128, F.tid >> 3, (F.tid >> 3) + 64, dma_kc(F.tid)); Bp = W + (size_t)((F.vcu % NTN) * 256) * D; ring_start(F, R, al, Bp, D); }
    for (int u = F.vcu; u < NUNITS; u += F.G) {
        const int mt = u / NTN, nt = u % NTN, m0 = mt * 128, n0 = nt * 256;
        const int un = u + F.G; const bool hasN = un < NUNITS;
        alN = al; BpN = Bp;
        if (hasN) { alN.init(HC, D, (un / NTN) * 128, F.tid >> 3, (F.tid >> 3) + 64, dma_kc(F.tid)); BpN = W + (size_t)((un % NTN) * 256) * D; }
        f32x4 acc[4][4];
        gemm3_unit<false, 16>(F, R, al, Bp, alN, BpN, hasN, D, acc, u == F.vcu);
        al = alN; Bp = BpN;
        {
            const float* gate = modp(F, 0, cond_of(m0), 2);
            const float* srcb = m0 < NX ? A.in[I_X] + (size_t)m0 * D : A.in[I_CTX] + (size_t)(m0 - NX) * D;
            f32x4 sres[4][4], gt[4];
#pragma unroll
            for (int ni = 0; ni < 4; ++ni) gt[ni] = *(const f32x4*)(gate + n0 + wc * 64 + ni * 16 + fq * 4);
#pragma unroll
            for (int mi = 0; mi < 4; ++mi)
#pragma unroll
                for (int ni = 0; ni < 4; ++ni) sres[mi][ni] = *(const f32x4*)(srcb + (size_t)(wr * 64 + mi * 16 + fr) * D + n0 + wc * 64 + ni * 16 + fq * 4);
#pragma unroll
            for (int mi = 0; mi < 4; ++mi)
#pragma unroll
                for (int ni = 0; ni < 4; ++ni) *(f32x4*)(XA + (size_t)(m0 + wr * 64 + mi * 16 + fr) * D + n0 + wc * 64 + ni * 16 + fq * 4) = sres[mi][ni] + gt[ni] * acc[mi][ni];
        }
    }
    __syncthreads();
    if (F.vcu >= 32) tail_convert(F, (F.vcu - 32) * NWAVES + F.wave, ND_A, ND_B);
}

__device__ __forceinline__ void route_select(const Frame& F, float (&acc)[32], float rbias, int row, LAS int* selL, int li) {
    const int lane = F.lane;
#define BFLY(S, HALF) { const bool up = (lane >> (S)) & 1; _Pragma("unroll") for (int i = 0; i < (HALF); ++i) { \
        const float keep = up ? acc[i + (HALF)] : acc[i]; const float send = up ? acc[i] : acc[i + (HALF)]; acc[i] = keep + __shfl_xor(send, 1 << (S)); } }
    BFLY(0, 16) BFLY(1, 8) BFLY(2, 4) BFLY(3, 2) BFLY(4, 1)
#undef BFLY
    const float tot = acc[0] + __shfl_xor(acc[0], 32);
    const int e = lane & 31;
    const float logit = __shfl(tot, (int)(__builtin_bitreverse32((unsigned)e) >> 27));
    const float sc = 1.0f / (1.0f + expf(-logit));
    const float ss = sc + rbias;
    float m1 = ss;
#pragma unroll
    for (int o = 1; o < 8; o <<= 1) m1 = fmaxf(m1, __shfl_xor(m1, o));
    int i1 = (ss == m1) ? e : 64;
#pragma unroll
    for (int o = 1; o < 8; o <<= 1) i1 = min(i1, __shfl_xor(i1, o));
    const float s2 = (e == i1) ? -INFINITY : ss;
    float m2 = s2;
#pragma unroll
    for (int o = 1; o < 8; o <<= 1) m2 = fmaxf(m2, __shfl_xor(m2, o));
    int i2 = (s2 == m2 && e != i1) ? e : 64;
#pragma unroll
    for (int o = 1; o < 8; o <<= 1) i2 = min(i2, __shfl_xor(i2, o));
    const float gs = m1 + m2;
    float gbest = gs;
    gbest = fmaxf(gbest, __shfl_xor(gbest, 8)); gbest = fmaxf(gbest, __shfl_xor(gbest, 16));
    int gsel = (gs == gbest) ? (e >> 3) : 64;
    gsel = min(gsel, __shfl_xor(gsel, 8)); gsel = min(gsel, __shfl_xor(gsel, 16));
    const int e0 = __shfl(i1, gsel * 8) & 31, e1 = __shfl(i2, gsel * 8) & 31;
    const float w0 = __shfl(sc, e0), w1 = __shfl(sc, e1);
    if (lane == 0) {
        const float inv = 1.0f / (w0 + w1);
        selL[li * 2] = e0; selL[li * 2 + 1] = e1;
        ((float2*)(F.ws + WS_WT))[row] = make_float2(w0 * inv, w1 * inv);
        ((int2*)(F.ws + WS_SEL))[row] = make_int2(e0, e1);
    }
}

template <int LAYER>
__device__ __forceinline__ void phase_route(Frame& F) {
    const Args& A = *F.a;
    constexpr int NT = LAYER == 0 ? NTOK : NX;
    constexpr int PER = NT / 256;
    LAS char* RW = F.lds;
    LAS int* selL = (LAS int*)(F.lds + LDS_AUX);
    LAS int* rankL = selL + 2 * 68;
    const int tid = F.tid, lane = F.lane;
    {
        f32x4 t[16];
#pragma unroll
        for (int i = 0; i < 16; ++i) { const int idx = tid + 512 * i; t[i] = *(const f32x4*)(A.in[I_RW] + (size_t)(idx >> 3) * 32 + (idx & 7) * 4); }
#pragma unroll
        for (int i = 0; i < 16; ++i) {
            const int idx = tid + 512 * i, k = idx >> 3, e4 = idx & 7;
            const int rho = (((k >> 8) * 4 + (k & 3)) << 6) + ((k >> 2) & 63);
            *(LAS f32x4*)(RW + rho * 128 + ((e4 ^ ((rho >> 1) & 7)) << 4)) = t[i];
        }
    }
    __syncthreads();
    const int blk = F.vcu;
    if (blk < 256) {
        const float* XA = (const float*)(F.ws + WS_XA);
        bf16* H = (bf16*)(F.ws + WS_H);
        const float rbias = A.in[I_RB][lane & 31];
        f32x4 na[4], nb[4];
        load_row4(XA + (size_t)(blk * PER + 2 * F.wave) * D, lane, na); load_row4(XA + (size_t)(blk * PER + 2 * F.wave + 1) * D, lane, nb);
        for (int pi = F.wave; pi < PER / 2; pi += NWAVES) {
            const int li = 2 * pi, row = blk * PER + li;
            const int c = cond_of(row);
            f32x4 va[4], vb[4];
#pragma unroll
            for (int j = 0; j < 4; ++j) { va[j] = na[j]; vb[j] = nb[j]; }
            if constexpr (LAYER == 1) {
                const bf16* dl = (const bf16*)(F.ws + WS_DELTA) + (size_t)row * D;
#pragma unroll
                for (int j = 0; j < 4; ++j) {
                    const u32x2 d0 = *(const u32x2*)(dl + 4 * lane + 256 * j), d1 = *(const u32x2*)(dl + D + 4 * lane + 256 * j);
                    va[j] += (f32x4){bflo(d0.x), bfhi(d0.x), bflo(d0.y), bfhi(d0.y)}; vb[j] += (f32x4){bflo(d1.x), bfhi(d1.x), bflo(d1.y), bfhi(d1.y)};
                }
            }
            if (pi + NWAVES < PER / 2) { load_row4(XA + (size_t)(row + 2 * NWAVES) * D, lane, na); load_row4(XA + (size_t)(row + 2 * NWAVES + 1) * D, lane, nb); }
            const float ra = row_rstd(va), rb = row_rstd(vb);
            if constexpr (LAYER == 1 && L1_FP8) {
                row_modulate_store8(va, ra, A.in[I_N2G] + LAYER * D, modp(F, LAYER, c, 4), modp(F, LAYER, c, 3), (unsigned char*)H + (size_t)row * D, lane);
                row_modulate_store8(vb, rb, A.in[I_N2G] + LAYER * D, modp(F, LAYER, c, 4), modp(F, LAYER, c, 3), (unsigned char*)H + (size_t)(row + 1) * D, lane);
            } else {
                row_modulate_store(va, ra, A.in[I_N2G] + LAYER * D, modp(F, LAYER, c, 4), modp(F, LAYER, c, 3), H + (size_t)row * D, lane);
                row_modulate_store(vb, rb, A.in[I_N2G] + LAYER * D, modp(F, LAYER, c, 4), modp(F, LAYER, c, 3), H + (size_t)(row + 1) * D, lane);
            }
            float acca[32], accb[32];
#pragma unroll
            for (int e = 0; e < 32; ++e) { acca[e] = 0.f; accb[e] = 0.f; }
#pragma unroll 1
            for (int jc = 0; jc < 16; ++jc) {
                const int j = jc >> 2, cc = jc & 3;
                f32x4 ha4 = va[0], hb4 = vb[0];
                if (j == 1) { ha4 = va[1]; hb4 = vb[1]; }
                if (j == 2) { ha4 = va[2]; hb4 = vb[2]; }
                if (j == 3) { ha4 = va[3]; hb4 = vb[3]; }
                float ha = ha4.x, hb = hb4.x;
                if (cc == 1) { ha = ha4.y; hb = hb4.y; }
                if (cc == 2) { ha = ha4.z; hb = hb4.z; }
                if (cc == 3) { ha = ha4.w; hb = hb4.w; }
                const int rho = jc * 64 + lane;
                const LAS char* rp = RW + rho * 128; const int key = (rho >> 1) & 7;
                f32x4 w8[8];
#pragma unroll
                for (int e4 = 0; e4 < 8; ++e4) w8[e4] = *(const LAS f32x4*)(rp + ((e4 ^ key) << 4));
#pragma unroll
                for (int e4 = 0; e4 < 8; ++e4) {
                    acca[e4 * 4 + 0] += ha * w8[e4].x; acca[e4 * 4 + 1] += ha * w8[e4].y; acca[e4 * 4 + 2] += ha * w8[e4].z; acca[e4 * 4 + 3] += ha * w8[e4].w;
                    accb[e4 * 4 + 0] += hb * w8[e4].x; accb[e4 * 4 + 1] += hb * w8[e4].y; accb[e4 * 4 + 2] += hb * w8[e4].z; accb[e4 * 4 + 3] += hb * w8[e4].w;
                }
            }
            route_select(F, acca, rbias, row, selL, li);
            route_select(F, accb, rbias, row + 1, selL, li + 1);
        }
        __syncthreads();
        if (tid < 32) {
            int cnt = 0;
            for (int i = 0; i < 2 * PER; ++i) { if (selL[i] == tid) { rankL[i] = cnt; ++cnt; } }
            ((int*)(F.ws + WS_BLKCNT))[blk * 32 + tid] = cnt;
        }
        __syncthreads();
        for (int i = tid; i < PER; i += NTHREADS) ((int2*)(F.ws + WS_LRANK))[blk * PER + i] = make_int2(rankL[2 * i], rankL[2 * i + 1]);
    }
}

template <int LAYER>
__device__ __forceinline__ void phase_slots(Frame& F) {
    constexpr int NT = LAYER == 0 ? NTOK : NX;
    constexpr int PER = NT / 256;
    LAS int* part = (LAS int*)F.lds;
    LAS int* tot = part + 1024;
    LAS int* base = tot + 32;
    LAS int* pst = base + 32;
    const int tid = F.tid, blk = F.vcu;
    const int* bc = (const int*)(F.ws + WS_BLKCNT);
    {
        const int e = tid & 31, p = tid >> 5;
        int st = 0, sb = 0;
        for (int b2 = p; b2 < 256; b2 += 16) { const int c = bc[b2 * 32 + e]; st += c; sb += (b2 < blk) ? c : 0; }
        part[p * 32 + e] = st; part[512 + p * 32 + e] = sb;
    }
    __syncthreads();
    if (tid < 32) { int st = 0, sb = 0; for (int p = 0; p < 16; ++p) { st += part[p * 32 + tid]; sb += part[512 + p * 32 + tid]; } tot[tid] = st; base[tid] = sb; }
    __syncthreads();
    if (tid == 0) { int s = 0; for (int e = 0; e < 32; ++e) { pst[e] = s; s += (tot[e] + 127) & ~127; } pst[32] = s; }
    __syncthreads();
    int* slot_tok = (int*)(F.ws + WS_SLOTTOK); float* slot_w = (float*)(F.ws + WS_SLOTW);
    if (blk == 0 && tid < 33) ((int*)(F.ws + WS_PSTART))[tid] = pst[tid];
    if (blk < 256) {
        for (int i = tid; i < PER; i += NTHREADS) {
            const int t = blk * PER + i;
            const int2 se = ((const int2*)(F.ws + WS_SEL))[t]; const int2 lr = ((const int2*)(F.ws + WS_LRANK))[t]; const float2 wt = ((const float2*)(F.ws + WS_WT))[t];
            const int s0 = pst[se.x] + base[se.x] + lr.x, s1 = pst[se.y] + base[se.y] + lr.y;
            slot_tok[s0] = t; slot_w[s0] = wt.x; slot_tok[s1] = t; slot_w[s1] = wt.y;
            ((int2*)(F.ws + WS_TOKSLOT))[t] = make_int2(s0, s1);
        }
    }
    if (blk < 32) {
        const int lo = pst[blk] + tot[blk], hi = pst[blk + 1];
        for (int s = lo + tid; s < hi; s += NTHREADS) { slot_tok[s] = 0; slot_w[s] = 0.f; }
    }
}

template <int LAYER>
__device__ __forceinline__ void phase_moe_up(Frame& F) {
    constexpr bool F8 = (LAYER == 1) && L1_FP8;
    constexpr int KA = F8 ? D / 2 : D;
    LAS int* pst = (LAS int*)(F.lds + LDS_AUX);
    if (F.tid < 33) pst[F.tid] = ((const int*)(F.ws + WS_PSTART))[F.tid];
    __syncthreads();
    const int ntiles = pst[32] >> 7, nunits = ntiles * 4;
    const bf16* H = (const bf16*)(F.ws + WS_H);
    const bf16* W = F8 ? (const bf16*)(F.ws + WS_WUP + (size_t)64 * MiB) : (const bf16*)(F.ws + WS_WUP) + (size_t)LAYER * 32 * 1024 * 1024;
    const int* slot_tok = (const int*)(F.ws + WS_SLOTTOK); const float* slot_w = (const float*)(F.ws + WS_SLOTW);
    bf16* G = (bf16*)(F.ws + WS_G);
    const int wr = F.wave >> 2, wc = F.wave & 3, fr = F.lane & 15, fq = F.lane >> 4;
    LAS int* tix = pst + 64;
    for (int i = F.tid; i < 8 * 128; i += NTHREADS) { const int uu = F.vcu + (i >> 7) * F.G; tix[i] = (uu < nunits) ? slot_tok[(uu >> 2) * 128 + (i & 127)] : 0; }
    __syncthreads();
    ALGather al, alN; const bf16* Bp = W; const bf16* BpN = W; Ring R;
#define MOE_SETUP(uu, ui, al_, Bp_) do { const int m0_ = ((uu) >> 2) * 128; int e_ = 0; \
        for (int x = 1; x < 32; ++x) e_ = (pst[x] <= m0_) ? x : e_; \
        al_.p0 = H + (size_t)tix[(ui) * 128 + (F.tid >> 3)] * KA + dma_kc(F.tid); al_.p1 = H + (size_t)tix[(ui) * 128 + (F.tid >> 3) + 64] * KA + dma_kc(F.tid); \
        Bp_ = W + ((size_t)e_ * 1024 + ((uu) & 3) * 256) * KA; } while (0)
    if (F.vcu < nunits) { MOE_SETUP(F.vcu, 0, al, Bp); ring_start(F, R, al, Bp, KA); }
    int ui = 0;
    for (int u = F.vcu; u < nunits; u += F.G, ++ui) {
        const int mt = u >> 2, j = u & 3, m0 = mt * 128;
        const int un = u + F.G; const bool hasN = un < nunits;
        alN = al; BpN = Bp;
        if (hasN) MOE_SETUP(un, ui + 1, alN, BpN);
        f32x4 acc[4][4];
        if constexpr (F8) gemm3_unit<true, 8>(F, R, al, Bp, alN, BpN, hasN, KA, acc, u == F.vcu, FP8_SCALE_W, FP8_SCALE_ONE);
        else gemm3_unit<false, 8>(F, R, al, Bp, alN, BpN, hasN, KA, acc, u == F.vcu);
        al = alN; Bp = BpN;
#pragma unroll
        for (int mi = 0; mi < 4; ++mi) {
            const int row = m0 + wr * 64 + mi * 16 + fr;
            const float wgt = slot_w[row];
#pragma unroll
            for (int p = 0; p < 2; ++p) {
                const f32x4 g = acc[mi][2 * p], uu = acc[mi][2 * p + 1];
                float o[4];
#pragma unroll
                for (int c = 0; c < 4; ++c) o[c] = g[c] / (1.0f + __expf(-g[c])) * uu[c] * wgt;
                if constexpr (F8) {
#pragma unroll
                    for (int c = 0; c < 4; ++c) o[c] = fminf(fmaxf(o[c] * 8.0f, -448.0f), 448.0f);
                    *(unsigned*)((unsigned char*)G + (size_t)row * DEXP + j * 128 + wc * 32 + p * 16 + fq * 4) = pk4_fp8(o[0], o[1], o[2], o[3]);
                } else {
                    u32x2 ov; ov.x = pk2(o[0], o[1]); ov.y = pk2(o[2], o[3]);
                    *(u32x2*)(G + (size_t)row * DEXP + j * 128 + wc * 32 + p * 16 + fq * 4) = ov;
                }
            }
        }
    }
}

template <int LAYER>
__device__ __forceinline__ void phase_moe_down(Frame& F) {
    constexpr bool F8 = (LAYER == 1) && L1_FP8;
    constexpr int KA = F8 ? DEXP / 2 : DEXP;
    LAS int* pst = (LAS int*)(F.lds + LDS_AUX);
    if (F.tid < 33) pst[F.tid] = ((const int*)(F.ws + WS_PSTART))[F.tid];
    __syncthreads();
    const int ntiles = pst[32] >> 7, nunits = ntiles * 4;
    const bf16* G = (const bf16*)(F.ws + WS_G);
    const bf16* W = F8 ? (const bf16*)(F.ws + WS_WDN + (size_t)32 * MiB) : (const bf16*)(F.ws + WS_WDN) + (size_t)LAYER * 32 * 1024 * 512;
    bf16* Y = (bf16*)(F.ws + WS_Y);
    const int wr = F.wave >> 2, wc = F.wave & 3, fr = F.lane & 15, fq = F.lane >> 4;
    ALDense al, alN; const bf16* Bp = W; const bf16* BpN = W; Ring R;
#define MOED_SETUP(uu, al_, Bp_) do { const int m0_ = ((uu) >> 2) * 128; int e_ = 0; \
        for (int x = 1; x < 32; ++x) e_ = (pst[x] <= m0_) ? x : e_; \
        al_.init(G, KA, m0_, F.tid >> 3, (F.tid >> 3) + 64, dma_kc(F.tid)); Bp_ = W + ((size_t)e_ * 1024 + ((uu) & 3) * 256) * KA; } while (0)
    if (F.vcu < nunits) { MOED_SETUP(F.vcu, al, Bp); ring_start(F, R, al, Bp, KA); }
    for (int u = F.vcu; u < nunits; u += F.G) {
        const int mt = u >> 2, j = u & 3, m0 = mt * 128, n0 = j * 256;
        const int un = u + F.G; const bool hasN = un < nunits;
        alN = al; BpN = Bp;
        if (hasN) MOED_SETUP(un, alN, BpN);
        f32x4 acc[4][4];
        if constexpr (F8) gemm3_unit<true, 16>(F, R, al, Bp, alN, BpN, hasN, KA, acc, u == F.vcu, FP8_SCALE_W, FP8_SCALE_G);
        else gemm3_unit<false, 16>(F, R, al, Bp, alN, BpN, hasN, KA, acc, u == F.vcu);
        al = alN; Bp = BpN;
#pragma unroll
        for (int mi = 0; mi < 4; ++mi) {
            const int row = m0 + wr * 64 + mi * 16 + fr;
#pragma unroll
            for (int ni = 0; ni < 4; ++ni) {
                const f32x4 v = acc[mi][ni];
                u32x2 o; o.x = pk2(v.x, v.y); o.y = pk2(v.z, v.w);
                *(u32x2*)(Y + (size_t)row * D + n0 + wc * 64 + ni * 16 + fq * 4) = o;
            }
        }
    }
}

struct CRow { f32x4 x[4]; u32x2 y0[4], y1[4]; };
__device__ __forceinline__ void crow_load(const Frame& F, int row, int2 ts, CRow& r) {
    const float* XA = (const float*)(F.ws + WS_XA); const bf16* Y = (const bf16*)(F.ws + WS_Y);
#pragma unroll
    for (int j = 0; j < 4; ++j) {
        const int c0 = 4 * F.lane + 256 * j;
        r.x[j] = *(const f32x4*)(XA + (size_t)row * D + c0);
        r.y0[j] = *(const u32x2*)(Y + (size_t)ts.x * D + c0); r.y1[j] = *(const u32x2*)(Y + (size_t)ts.y * D + c0);
    }
}
__device__ __forceinline__ void crow_combine(const Frame& F, const CRow& r, const float* gate, f32x4 (&v)[4]) {
#pragma unroll
    for (int j = 0; j < 4; ++j) {
        const int c0 = 4 * F.lane + 256 * j;
        const f32x4 gt = *(const f32x4*)(gate + c0);
        f32x4 y; y.x = bflo(r.y0[j].x) + bflo(r.y1[j].x); y.y = bfhi(r.y0[j].x) + bfhi(r.y1[j].x); y.z = bflo(r.y0[j].y) + bflo(r.y1[j].y); y.w = bfhi(r.y0[j].y) + bfhi(r.y1[j].y);
        v[j] = r.x[j] + gt * y;
    }
}

__device__ __forceinline__ void phase_combine0(Frame& F) {
    const Args& A = *F.a;
    const int gw = F.vcu * NWAVES + F.wave, NGW = F.G * NWAVES;
    float* XA = (float*)(F.ws + WS_XA); bf16* H = (bf16*)(F.ws + WS_H);
    const int2* TS = (const int2*)(F.ws + WS_TOKSLOT);
    CRow cn; int2 tsn = make_int2(0, 0);
    if (gw < NTOK) crow_load(F, gw, TS[gw], cn);
    if (gw + NGW < NTOK) tsn = TS[gw + NGW];
    for (int row = gw; row < NTOK; row += NGW) {
        const int c = cond_of(row);
        const CRow cr = cn;
        const int nr = row + NGW;
        if (nr < NTOK) crow_load(F, nr, tsn, cn);
        if (nr + NGW < NTOK) tsn = TS[nr + NGW];
        f32x4 v[4];
        crow_combine(F, cr, modp(F, 0, c, 5), v);
#pragma unroll
        for (int j = 0; j < 4; ++j) *(f32x4*)(XA + (size_t)row * D + 4 * F.lane + 256 * j) = v[j];
        const float rstd = row_rstd(v);
        row_modulate_store(v, rstd, A.in[I_N1G] + D, modp(F, 1, c, 1), modp(F, 1, c, 0), H + (size_t)row * D, F.lane);
    }
}

__device__ __forceinline__ void phase_qkv(Frame& F) {
    LAS float* CS = (LAS float*)(F.lds + LDS_AUX);
    for (int i = F.tid; i < 1024; i += NTHREADS) {
        const int p = i >> 4, f = i & 15;
        const float inv = 1.0f / powf(10000.0f, (float)f / 16.0f);
        const float ang = (float)p * inv;
        const double rev = (double)ang * 0.15915494309189535;
        const float fr_ = (float)(rev - floor(rev));
        CS[i * 2] = __builtin_amdgcn_cosf(fr_); CS[i * 2 + 1] = __builtin_amdgcn_sinf(fr_);
    }
    __syncthreads();
    pg8::Gemm g{(const pg8::bf16_t*)(F.ws + WS_H), (const pg8::bf16_t*)(F.ws + WS_WQKV), NTOK, 3 * D, D};
    pg8::QkvOrder S; S.init(F.G, (int)blockIdx.x);
    pg8::EpiQKV E{(pg8::bf16_t*)(F.ws + WS_Q), (pg8::bf16_t*)(F.ws + WS_K), (pg8::bf16_t*)(F.ws + WS_VT), (const PG8_LAS float*)CS};
    pg8::gemm_phase<pg8::EpiQKV, pg8::QkvOrder, true, true>((PG8_LAS unsigned char*)F.lds, g, S, E);
}

constexpr int ATT_STAGE = 32768;
__device__ __forceinline__ int crow(int r, int hi) { return (r & 3) + 8 * (r >> 2) + 4 * hi; }
__device__ __forceinline__ void phase_attn(Frame& F) {
    const Args& A = *F.a;
    const int tid = F.tid, lane = F.lane, w = F.wave, r32 = lane & 31, hi = lane >> 5;
    const int mp = w >> 2, wq = w & 3;
    LAS char* lds = F.lds;
    float lam;
    { const float* dl = A.in[I_DALAM]; const float s1 = wave_sum(dl[lane] * dl[64 + lane]), s2 = wave_sum(dl[128 + lane] * dl[192 + lane]);
      lam = expf(s1) - expf(s2) + (0.8f - 0.6f * expf(-0.3f)); }
    const float oscale = 1.0f - (0.8f - 0.6f * expf(-0.3f));
    const bf16* Q = (const bf16*)(F.ws + WS_Q); const bf16* Kb = (const bf16*)(F.ws + WS_K); const bf16* VT = (const bf16*)(F.ws + WS_VT);
    bf16* AO = (bf16*)(F.ws + WS_AO);
    constexpr int NUNITS = NB * 8 * (S / 128), NTILES = KEYS / 64;
    LAS char* cbuf = lds + 65536 + w * 4096;
    const int cgw = F.vcu * NWAVES + w, CNGW = F.G * NWAVES;
    int cit = cgw; bool chas = cit < ND_ATTN;
    if (chas) { const TDesc cd = L1_FP8 ? decode_moe8(F, cit) : decode_moe(F, cit, 1); tr3_dma(cd, lane, cbuf); }
    for (int u = F.vcu; u < NUNITS; u += F.G) {
        const int bh = u >> 5, qb = u & 31, q0 = qb * 128;
        const bf16* Kg[2]; Kg[0] = Kb + (size_t)(bh * 2 + 0) * KEYS * 64; Kg[1] = Kb + (size_t)(bh * 2 + 1) * KEYS * 64;
        const bf16* Vg = VT + (size_t)bh * 128 * KEYS;
        LAS char* qlds = lds + 98304 + w * 4096;
        { const bf16* qp = Q + ((size_t)(bh * 2 + mp) * S + q0 + wq * 32 + r32) * 64 + hi * 8;
#pragma unroll
          for (int ks = 0; ks < 4; ++ks) __builtin_amdgcn_global_load_lds((const unsigned*)(qp + ks * 16), (LAS unsigned*)(qlds + ks * 1024), 16, 0, 0); }
        f32x16 o[4];
#pragma unroll
        for (int vb = 0; vb < 4; ++vb)
#pragma unroll
            for (int r = 0; r < 16; ++r) o[vb][r] = 0.f;
        float mrun = 0.f, lrun = 0.f;
        const int drow = w * 8 + (lane >> 3), dch = ((lane & 7) ^ ((drow >> 1) & 7)) * 8;
        const bf16* gk0 = Kg[0] + (size_t)drow * 64 + dch; const bf16* gk1 = Kg[1] + (size_t)drow * 64 + dch;
        const bf16* gv0 = Vg + (size_t)drow * KEYS + dch; const bf16* gv1 = Vg + (size_t)(64 + drow) * KEYS + dch;
#define ATT_DMA(t_, st_) do { LAS char* sb_ = lds + (st_) * ATT_STAGE + w * 1024; \
            __builtin_amdgcn_global_load_lds((const unsigned*)(gk0 + (size_t)(t_) * 64 * 64), (LAS unsigned*)(sb_), 16, 0, 0); \
            __builtin_amdgcn_global_load_lds((const unsigned*)(gk1 + (size_t)(t_) * 64 * 64), (LAS unsigned*)(sb_ + 8192), 16, 0, 0); \
            __builtin_amdgcn_global_load_lds((const unsigned*)(gv0 + (t_) * 64), (LAS unsigned*)(sb_ + 16384), 16, 0, 0); \
            __builtin_amdgcn_global_load_lds((const unsigned*)(gv1 + (t_) * 64), (LAS unsigned*)(sb_ + 16384 + 8192), 16, 0, 0); } while (0)
        ATT_DMA(0, 0);
        __syncthreads();
        for (int t = 0; t < NTILES; ++t) {
            const int st = t & 1;
            if (t + 1 < NTILES) ATT_DMA(t + 1, st ^ 1);
            const LAS char* Kt = lds + st * ATT_STAGE + mp * 8192;
            const LAS char* Vt = lds + st * ATT_STAGE + 16384;
            f32x16 s0, s1;
            { const float nm = -mrun;
#pragma unroll
              for (int r = 0; r < 16; ++r) { s0[r] = nm; s1[r] = nm; } }
            bf16x8 kf[8], qf[4];
#pragma unroll
            for (int ks = 0; ks < 4; ++ks) qf[ks] = *(const LAS bf16x8*)(qlds + ks * 1024 + lane * 16);
#pragma unroll
            for (int ks = 0; ks < 4; ++ks) {
                kf[2 * ks] = *(const LAS bf16x8*)(Kt + swz128(r32, 2 * ks + hi));
                kf[2 * ks + 1] = *(const LAS bf16x8*)(Kt + swz128(32 + r32, 2 * ks + hi));
            }
            u32x4 vf[2][4];
#define VLOAD(dst, vb_) do { const int vrow_ = (vb_) * 32 + r32; _Pragma("unroll") for (int kk_ = 0; kk_ < 4; ++kk_) \
                dst[kk_] = *(const LAS u32x4*)(Vt + swz128(vrow_, 2 * kk_ + hi)); } while (0)
            VLOAD(vf[0], 0);
            __builtin_amdgcn_sched_barrier(0);

#pragma unroll
            for (int ks = 0; ks < 4; ++ks) {
                s0 = __builtin_amdgcn_mfma_f32_32x32x16_bf16(kf[2 * ks], qf[ks], s0, 0, 0, 0);
                s1 = __builtin_amdgcn_mfma_f32_32x32x16_bf16(kf[2 * ks + 1], qf[ks], s1, 0, 0, 0);
            }

            float mx = fmaxf(s0[0], s1[0]);
#pragma unroll
            for (int r = 1; r < 16; ++r) mx = fmaxf(mx, fmaxf(s0[r], s1[r]));
            { const auto rr = __builtin_amdgcn_permlane32_swap(__builtin_bit_cast(unsigned, mx), __builtin_bit_cast(unsigned, mx), false, false);
              mx = fmaxf(__builtin_bit_cast(float, rr[0]), __builtin_bit_cast(float, rr[1])); }
            if (t == 0 || __any(mx > 8.0f)) {
                const float dl = (t == 0) ? mx : fmaxf(mx, 0.f);
                mrun += dl;
#pragma unroll
                for (int r = 0; r < 16; ++r) { s0[r] -= dl; s1[r] -= dl; }
                if (t > 0) {
                    const float f = __builtin_amdgcn_exp2f(-dl);
                    lrun *= f;
#pragma unroll
                    for (int vb = 0; vb < 4; ++vb)
#pragma unroll
                        for (int r = 0; r < 16; ++r) o[vb][r] *= f;
                }
            }
            float psum = 0.f;
#pragma unroll
            for (int r = 0; r < 16; ++r) { s0[r] = __builtin_amdgcn_exp2f(s0[r]); s1[r] = __builtin_amdgcn_exp2f(s1[r]); psum += s0[r] + s1[r]; }
            lrun += psum;
            bf16x8 pf[4];
#pragma unroll
            for (int s = 0; s < 2; ++s) {
                u32x4 a, b2;
                a.x = pk2(s0[8 * s + 0], s0[8 * s + 1]); a.y = pk2(s0[8 * s + 2], s0[8 * s + 3]); a.z = pk2(s0[8 * s + 4], s0[8 * s + 5]); a.w = pk2(s0[8 * s + 6], s0[8 * s + 7]);
                b2.x = pk2(s1[8 * s + 0], s1[8 * s + 1]); b2.y = pk2(s1[8 * s + 2], s1[8 * s + 3]); b2.z = pk2(s1[8 * s + 4], s1[8 * s + 5]); b2.w = pk2(s1[8 * s + 6], s1[8 * s + 7]);
                pf[s] = __builtin_bit_cast(bf16x8, a); pf[2 + s] = __builtin_bit_cast(bf16x8, b2);
            }
#pragma unroll
            for (int vb = 0; vb < 4; ++vb) {
                if (vb + 1 < 4) VLOAD(vf[(vb + 1) & 1], vb + 1);
                __builtin_amdgcn_sched_barrier(0);

#pragma unroll
                for (int kk = 0; kk < 4; ++kk)
                    o[vb] = __builtin_amdgcn_mfma_f32_32x32x16_bf16(__builtin_bit_cast(bf16x8, vf[vb & 1][kk]), pf[kk], o[vb], 0, 0, 0);

            }
#undef VLOAD
            __syncthreads();
            if ((t % 11) == 5 && chas) {
                asm volatile("s_waitcnt vmcnt(0)" ::: "memory");
                { if (L1_FP8) { const TDesc cd = decode_moe8(F, cit); tr3_finish_fp8(cd, lane, cbuf); } else { const TDesc cd = decode_moe(F, cit, 1); tr3_finish(cd, lane, cbuf); } }
                LDS_WAIT();
                cit += CNGW; chas = cit < ND_ATTN;
                if (chas) { const TDesc cd = L1_FP8 ? decode_moe8(F, cit) : decode_moe(F, cit, 1); tr3_dma(cd, lane, cbuf); }
            }
        }
#undef ATT_DMA
        lrun += __shfl_xor(lrun, 32);
        const float linv = 1.0f / lrun;
        LAS float* XO = (LAS float*)lds;
        if (mp == 1) {
#pragma unroll
            for (int vb = 0; vb < 4; ++vb)
#pragma unroll
                for (int r = 0; r < 16; ++r) XO[(wq * 64 + vb * 16 + r) * 64 + lane] = o[vb][r] * linv;
        }
        __syncthreads();
        if (mp == 0) {
            float ssq = 0.f;
#pragma unroll
            for (int vb = 0; vb < 4; ++vb)
#pragma unroll
                for (int r = 0; r < 16; ++r) { const float v = o[vb][r] * linv - lam * XO[(wq * 64 + vb * 16 + r) * 64 + lane]; o[vb][r] = v; ssq += v * v; }
            ssq += __shfl_xor(ssq, 32);
            const float rstd = rsqrtf(ssq * (1.0f / 128.0f) + EPS) * oscale;
            const int b = bh >> 3, h = bh & 7;
            bf16* dst = AO + (size_t)(b * S + q0 + wq * 32 + r32) * D + h * 128;
            const float* sg = A.in[I_SUBLN];
#pragma unroll
            for (int vb = 0; vb < 4; ++vb)
#pragma unroll
                for (int rq = 0; rq < 4; ++rq) {
                    const int v0 = vb * 32 + 8 * rq + 4 * hi;
                    const f32x4 g4 = *(const f32x4*)(sg + v0);
                    u32x2 ov; ov.x = pk2(o[vb][4 * rq] * rstd * g4.x, o[vb][4 * rq + 1] * rstd * g4.y); ov.y = pk2(o[vb][4 * rq + 2] * rstd * g4.z, o[vb][4 * rq + 3] * rstd * g4.w);
                    *(u32x2*)(dst + v0) = ov;
                }
        }
        __syncthreads();
    }
    while (chas) {
        asm volatile("s_waitcnt vmcnt(0)" ::: "memory");
        { if (L1_FP8) { const TDesc cd = decode_moe8(F, cit); tr3_finish_fp8(cd, lane, cbuf); } else { const TDesc cd = decode_moe(F, cit, 1); tr3_finish(cd, lane, cbuf); } }
        LDS_WAIT();
        cit += CNGW; chas = cit < ND_ATTN;
        if (chas) { const TDesc cd = L1_FP8 ? decode_moe8(F, cit) : decode_moe(F, cit, 1); tr3_dma(cd, lane, cbuf); }
    }
}

__device__ __forceinline__ void phase_gemm_wo(Frame& F) {
    pg8::Gemm g{(const pg8::bf16_t*)(F.ws + WS_AO), (const pg8::bf16_t*)(F.ws + WS_WO), NX, D, D};
    pg8::StaticOrder S; S.init(NX, D, F.G, (int)blockIdx.x);
    pg8::EpiScaleBf16 E{(pg8::bf16_t*)(F.ws + WS_DELTA), D, modp(F, 1, 0, 2), 6144};
    pg8::gemm_phase<pg8::EpiScaleBf16, pg8::StaticOrder, true, true>((PG8_LAS unsigned char*)F.lds, g, S, E);
}

__device__ __forceinline__ void phase_final(Frame& F) {
    const Args& A = *F.a;
    const int gw = F.vcu * NWAVES + F.wave, NGW = F.G * NWAVES;
    const int2* TS = (const int2*)(F.ws + WS_TOKSLOT);
    CRow cn; int2 tsn = make_int2(0, 0);
    if (gw < NX) crow_load(F, gw, TS[gw], cn);
    if (gw + NGW < NX) tsn = TS[gw + NGW];
    for (int row = gw; row < NX; row += NGW) {
        const CRow cr = cn;
        const int nr = row + NGW;
        if (nr < NX) crow_load(F, nr, tsn, cn);
        if (nr + NGW < NX) tsn = TS[nr + NGW];
        f32x4 v[4];
        crow_combine(F, cr, modp(F, 1, row >> 12, 5), v);
        { const bf16* dl = (const bf16*)(F.ws + WS_DELTA) + (size_t)row * D;
#pragma unroll
          for (int j = 0; j < 4; ++j) { const u32x2 d0 = *(const u32x2*)(dl + 4 * F.lane + 256 * j); v[j] += (f32x4){bflo(d0.x), bfhi(d0.x), bflo(d0.y), bfhi(d0.y)}; } }
        const float rstd = row_rstd(v);
#pragma unroll
        for (int j = 0; j < 4; ++j) {
            const int c0 = 4 * F.lane + 256 * j;
            const f32x4 g = *(const f32x4*)(A.in[I_FG] + c0);
            *(f32x4*)(A.out + (size_t)row * D + c0) = (v[j] * rstd) * g;
        }
    }
}

__global__ void __launch_bounds__(NTHREADS) fwd_kernel(Args args) {
    extern __shared__ __attribute__((aligned(16))) unsigned char smem[];
    Frame F;
    F.lds = (LAS char*)smem;
    F.tid = threadIdx.x; F.lane = F.tid & 63; F.wave = __builtin_amdgcn_readfirstlane(F.tid >> 6);
    F.G = gridDim.x; { const int bx = blockIdx.x; F.vcu = (F.G % 8 == 0) ? (bx % 8) * (F.G / 8) + bx / 8 : bx; }
    F.a = &args; F.ws = args.ws;
    volatile LAS unsigned* xbw = (volatile LAS unsigned*)(F.lds + LDS_XB);
    if (F.tid < 4) xbw[F.tid] = 0u;
    __syncthreads();
    XcdBarrier bar; bar.bar = (unsigned*)(F.ws + WS_CTL); bar.x = 0; bar.st = xbw;
    const int lo = args.ph_lo, hi = args.ph_hi;
    const bool multi = (hi - lo) > 1;
    if (multi) bar = xcd_barrier_post((unsigned*)(F.ws + WS_CTL), xbw);
#ifdef PROBE_PHASE
    unsigned long long pt0 = 0, pt1 = 0;
#define RUN_PHASE(k, call) do { if (lo <= (k) && (k) < hi) { if ((k) == PROBE_PHASE) pt0 = __builtin_amdgcn_s_memrealtime(); call; if ((k) + 1 < hi) xcd_barrier(bar); if ((k) == PROBE_PHASE) pt1 = __builtin_amdgcn_s_memrealtime(); } } while (0)
#else
#define RUN_PHASE(k, call) do { if (lo <= (k) && (k) < hi) { call; if ((k) + 1 < hi) xcd_barrier(bar); } } while (0)
#endif
    RUN_PHASE(0, phase_convert(F));
    RUN_PHASE(1, phase_prep0(F));
    RUN_PHASE(2, phase_gemm_in(F));
    RUN_PHASE(3, phase_scan(F));
    RUN_PHASE(4, (phase_combine_h(F), xcd_barrier(bar), phase_gemm_out0(F)));
    RUN_PHASE(5, phase_route<0>(F));
    RUN_PHASE(6, phase_slots<0>(F));
    RUN_PHASE(7, phase_moe_up<0>(F));
    RUN_PHASE(8, phase_moe_down<0>(F));
    RUN_PHASE(9, phase_combine0(F));
    RUN_PHASE(10, phase_qkv(F));
    RUN_PHASE(11, phase_attn(F));
    RUN_PHASE(12, phase_gemm_wo(F));
    RUN_PHASE(13, phase_route<1>(F));
    RUN_PHASE(14, phase_slots<1>(F));
    RUN_PHASE(15, phase_moe_up<1>(F));
    RUN_PHASE(16, phase_moe_down<1>(F));
    RUN_PHASE(17, phase_final(F));
#undef RUN_PHASE
#ifdef PROBE_PHASE
    xcd_barrier(bar);
    if (blockIdx.x == 0 && F.tid == 0) args.out[0] = 40.0f + floorf((float)(pt1 - pt0) * 0.001f + 0.5f);
#endif
}

extern "C" void kernel_launch(void* const* d_in, const int* in_sizes, int n_in, void* d_out, int out_size, void* d_ws, size_t ws_size, hipStream_t stream) {
    static int grid = 0;
    if (grid == 0) {
        if (n_in != 27 || out_size != NX * D || ws_size < WS_END) { fprintf(stderr, "kernel_launch: unexpected shapes (n_in %d out %d ws %zu)\n", n_in, out_size, ws_size); grid = -1; return; }
        int dev = 0, cus = 0;
        if (hipGetDevice(&dev) != hipSuccess || hipDeviceGetAttribute(&cus, hipDeviceAttributeMultiprocessorCount, dev) != hipSuccess) { grid = -1; return; }
        if (hipFuncSetAttribute((const void*)fwd_kernel, hipFuncAttributeMaxDynamicSharedMemorySize, LDS_BYTES) != hipSuccess) { fprintf(stderr, "kernel_launch: hipFuncSetAttribute failed\n"); grid = -1; return; }
        (void)hipGetLastError();
        grid = cus < 256 ? cus : 256;
    }
    if (grid < 0) return;
    (void)hipMemsetAsync((char*)d_ws + WS_CTL, 0, CTL_ZERO_BYTES, stream);
    Args a{};
    for (int i = 0; i < 27; ++i) a.in[i] = (const float*)d_in[i];
    a.out = (float*)d_out; a.ws = (unsigned char*)d_ws;
    if (MK_N_LAUNCHES == 1) {
        a.ph_lo = 0; a.ph_hi = NPHASES;
        hipLaunchKernelGGL(fwd_kernel, dim3(grid), dim3(NTHREADS), LDS_BYTES, stream, a);
    } else {
        if (DBG_NPH == 0) { a.ph_lo = 0; a.ph_hi = 0; hipLaunchKernelGGL(fwd_kernel, dim3(grid), dim3(NTHREADS), LDS_BYTES, stream, a); }
        for (int p = 0; p < DBG_NPH; ++p) { a.ph_lo = p; a.ph_hi = p + 1; hipLaunchKernelGGL(fwd_kernel, dim3(grid), dim3(NTHREADS), LDS_BYTES, stream, a); }
    }
}
```

```cpp
#include <hip/hip_runtime.h>
#include <cstdio>
#include <cstdint>

#ifndef MK_N_LAUNCHES
#define MK_N_LAUNCHES 1
#endif

#ifndef DBG_NPH
#define DBG_NPH 18
#endif
#define LAS __attribute__((address_space(3)))
typedef unsigned short bf16;
typedef short bf16x8 __attribute__((ext_vector_type(8)));
typedef float f32x4 __attribute__((ext_vector_type(4)));
typedef float f32x16 __attribute__((ext_vector_type(16)));
typedef unsigned u32x4 __attribute__((ext_vector_type(4)));
typedef unsigned u32x2 __attribute__((ext_vector_type(2)));
typedef float f32x2 __attribute__((ext_vector_type(2)));

constexpr int D = 1024, NB = 4, S = 4096, CL = 256;
constexpr int NX = NB * S, NC = NB * CL, NTOK = NX + NC;
constexpr int NEXP = 32, DEXP = 512;
constexpr int NWAVES = 8, NTHREADS = 512;
constexpr int KEYS = S + CL;
constexpr float EPS = 1e-6f;
constexpr int PMAX = 43008;
constexpr int NPHASES = 18;
constexpr float QSCALE = 0.125f * 1.4426950408889634f;

constexpr size_t MiB = 1u << 20;
constexpr size_t WS_CTL = 0, CTL_ZERO_BYTES = 64 * 1024;
constexpr size_t WS_MOD = 1 * MiB;
constexpr size_t WS_SEL = 2 * MiB;
constexpr size_t WS_WT = WS_SEL + 256 * 1024;
constexpr size_t WS_LRANK = WS_WT + 256 * 1024;
constexpr size_t WS_TOKSLOT = WS_LRANK + 256 * 1024;
constexpr size_t WS_BLKCNT = WS_TOKSLOT + 256 * 1024;
constexpr size_t WS_PSTART = WS_BLKCNT + 64 * 1024;
constexpr size_t WS_SLOTTOK = 3 * MiB + 512 * 1024;
constexpr size_t WS_SLOTW = WS_SLOTTOK + 256 * 1024;
constexpr size_t WS_WIN = 4 * MiB;
constexpr size_t WS_WOUT = 8 * MiB;
constexpr size_t WS_GATE = 10 * MiB;
constexpr size_t WS_WQKV = 11 * MiB;
constexpr size_t WS_WO = 17 * MiB;
constexpr size_t WS_WUP = 20 * MiB;
constexpr size_t WS_WDN = 148 * MiB;
constexpr size_t WS_XA = 212 * MiB;
constexpr size_t WS_H = 280 * MiB;
constexpr size_t WS_R = 314 * MiB;
constexpr size_t WS_YG = WS_R, WS_U = WS_R + 34 * MiB, WS_HF = WS_R + 68 * MiB, WS_HB = WS_R + 102 * MiB;
constexpr size_t WS_G = WS_R, WS_Y = WS_R + 42 * MiB;
constexpr size_t WS_Q = WS_R, WS_K = WS_R + 32 * MiB, WS_VT = WS_R + 66 * MiB, WS_AO = WS_R + 100 * MiB;
constexpr size_t WS_DELTA = 450 * MiB;
constexpr size_t WS_END = 482 * MiB;
static_assert(WS_Y + (size_t)PMAX * 1024 * 2 <= WS_END && WS_HB + 34 * MiB <= WS_END && WS_AO + 32 * MiB <= WS_END, "ws map");
static_assert(WS_K + (size_t)NB * 8 * 2 * KEYS * 64 * 2 <= WS_VT && WS_VT + (size_t)NB * 8 * 128 * KEYS * 2 <= WS_AO, "attn map");

constexpr int LDS_BYTES = 163840;
constexpr int LDS_XB = LDS_BYTES - 64;
constexpr int LDS_AUX = 147456;

__device__ __forceinline__ unsigned f2bf(float f) { unsigned u = __builtin_bit_cast(unsigned, f); return (u + 0x7fffu + ((u >> 16) & 1u)) >> 16; }
#ifndef L1_FP8
#define L1_FP8 1
#endif
typedef int i32x8 __attribute__((ext_vector_type(8)));
__device__ __forceinline__ unsigned pk4_fp8(float a, float b, float c, float d) { int w = 0; w = __builtin_amdgcn_cvt_pk_fp8_f32(a, b, w, false); w = __builtin_amdgcn_cvt_pk_fp8_f32(c, d, w, true); return (unsigned)w; }
constexpr int FP8_SCALE_ONE = 0x7f7f7f7f, FP8_SCALE_W = 0x7a7a7a7a  , FP8_SCALE_G = 0x7c7c7c7c  ;
typedef __bf16 bf16x2_t __attribute__((ext_vector_type(2)));
__device__ __forceinline__ unsigned pk2(float lo, float hi) { const f32x2 v = {lo, hi}; const bf16x2_t b = __builtin_convertvector(v, bf16x2_t); return __builtin_bit_cast(unsigned, b); }
__device__ __forceinline__ float bflo(unsigned w) { return __builtin_bit_cast(float, w << 16); }
__device__ __forceinline__ float bfhi(unsigned w) { return __builtin_bit_cast(float, w & 0xffff0000u); }
__device__ __forceinline__ float wave_sum(float v) {
#pragma unroll
    for (int o = 1; o < 64; o <<= 1) v += __shfl_xor(v, o);
    return v;
}
__device__ __forceinline__ float sigmoidf_(float x) { return 1.0f / (1.0f + __expf(-x)); }
#define LDS_WAIT() asm volatile("s_waitcnt lgkmcnt(0)" ::: "memory")

#define XB_TMO      128
#define XB_XCNT(j)  (256  + 64 * (j))
#define XB_XSUB(j)  (1280 + 64 * (j))
#define XB_XGEN(j)  (2304 + 64 * (j))
#define XB_TOP      3328
#define XB_TOPGEN   3392
#define XCD_BAR_WORDS 3456
#define XB_SPIN_CAP (1u << 18)
__device__ __forceinline__ unsigned xb_ld(unsigned* p)              { return __hip_atomic_load(p, __ATOMIC_RELAXED, __HIP_MEMORY_SCOPE_AGENT); }
__device__ __forceinline__ unsigned xb_add(unsigned* p, unsigned v) { return __hip_atomic_fetch_add(p, v, __ATOMIC_RELAXED, __HIP_MEMORY_SCOPE_AGENT); }
__device__ __forceinline__ unsigned xb_xcc_id() { return (unsigned)__builtin_amdgcn_s_getreg((3 << 11) | 20) & 0xFu; }
#define XB_SPIN(cond, bar) do { unsigned _sp = 0; while (cond) { __builtin_amdgcn_s_sleep(1); \
    if ((++_sp & 255u) == 0u) { if (xb_ld(&(bar)[XB_TMO])) break; if (_sp > XB_SPIN_CAP) { atomicAdd(&(bar)[XB_TMO], 1u); break; } } } } while (0)
struct XcdBarrier { unsigned* bar; unsigned x; volatile LAS unsigned* st; };
__device__ __forceinline__ XcdBarrier xcd_barrier_post(unsigned* bar, volatile LAS unsigned* st) {
    XcdBarrier b; b.bar = bar; b.x = xb_xcc_id(); b.st = st;
    if (threadIdx.x == 0) (void)xb_add(&bar[XB_XCNT(b.x)], 1u);
    return b;
}
__device__ __forceinline__ void xcd_barrier_complete(unsigned* bar, unsigned x, unsigned& nloc, unsigned& nx) {
    const unsigned G = gridDim.x * gridDim.y * gridDim.z;
    unsigned sum, cnt, mine, sp = 0u;
    for (;;) {
        sum = 0u; cnt = 0u; mine = 0u;
#pragma unroll
        for (unsigned j = 0; j < 16; ++j) { const unsigned c = xb_ld(&bar[XB_XCNT(j)]); sum += c; cnt += (c > 0u) ? 1u : 0u; mine = (j == x) ? c : mine; }
        if (sum == G) break;
        __builtin_amdgcn_s_sleep(1);
        if ((++sp & 255u) == 0u) { if (xb_ld(&bar[XB_TMO])) break; if (sp > XB_SPIN_CAP) { atomicAdd(&bar[XB_TMO], 1u); break; } }
    }
    nloc = mine > 0u ? mine : 1u; nx = cnt > 0u ? cnt : 1u;
}
__device__ __forceinline__ void xcd_barrier(const XcdBarrier& b) {
    asm volatile("s_waitcnt vmcnt(0)" ::: "memory");
    __syncthreads();
    if (threadIdx.x == 0) {
        unsigned* bar = b.bar;
        __builtin_amdgcn_s_waitcnt(0);
        unsigned nloc = b.st[0], nx = b.st[1];
        if (nloc == 0u) { xcd_barrier_complete(bar, b.x, nloc, nx); b.st[0] = nloc; b.st[1] = nx; }
        const unsigned old = xb_add(&bar[XB_XSUB(b.x)], 1u);
        const unsigned gen = old / nloc;
        if (old + 1u == (gen + 1u) * nloc) {
            __builtin_amdgcn_fence(__ATOMIC_RELEASE, "agent");
            asm volatile("s_waitcnt vmcnt(0)" ::: "memory");
            const unsigned og = xb_add(&bar[XB_TOP], 1u);
            const unsigned tg = og / nx;
            if (og + 1u == (tg + 1u) * nx) xb_add(&bar[XB_TOPGEN], 1u);
            else XB_SPIN(xb_ld(&bar[XB_TOPGEN]) == tg, bar);
            __builtin_amdgcn_fence(__ATOMIC_ACQUIRE, "agent");
            xb_add(&bar[XB_XGEN(b.x)], 1u);
            asm volatile("s_waitcnt vmcnt(0)" ::: "memory");
        } else {
            XB_SPIN(xb_ld(&bar[XB_XGEN(b.x)]) == gen, bar);
            __builtin_amdgcn_fence(__ATOMIC_ACQUIRE, "agent");
            asm volatile("s_waitcnt vmcnt(0)" ::: "memory");
        }
    }
    __syncthreads();
}

struct Args { const float* in[27]; float* out; unsigned char* ws; int ph_lo, ph_hi; };
enum { I_X = 0, I_C, I_CTX, I_CCTX, I_WMOD, I_BMOD, I_N1G, I_N2G, I_WIN, I_CONVW, I_CONVB, I_GAW, I_GAB, I_GXW, I_GXB, I_LAM, I_WOUT,
       I_WQKV, I_DALAM, I_SUBLN, I_WO, I_RW, I_RB, I_MG, I_MU, I_MD, I_FG };

struct Frame {
    LAS char* lds;
    int tid, lane, wave, vcu, G;
    const Args* a;
    unsigned char* ws;
};

__device__ __forceinline__ const float* modp(const Frame& F, int l, int c, int k) { return (const float*)(F.ws + WS_MOD) + (size_t)(l * 5 + c) * 6144 + k * 1024; }
__device__ __forceinline__ int cond_of(int row) { return row < NX ? (row >> 12) : 4; }

__device__ __forceinline__ int moe_up_row(int n) { return ((n >> 7) << 8) + (((n >> 5) & 3) << 6) + (((n >> 4) & 1) << 5) + (n & 15); }

struct TDesc { const float* W; bf16* WT; int N, ldT, mode, k0, n0; };
__device__ __forceinline__ void tr_load(const TDesc& t, int lane, f32x4 (&rg)[8]) {
    const float* p = t.W + (size_t)(t.k0 + (lane >> 3)) * t.N + t.n0 + 4 * (lane & 7);
#pragma unroll
    for (int i = 0; i < 8; ++i) rg[i] = *(const f32x4*)(p + (size_t)(8 * i) * t.N);
}
__device__ __forceinline__ void tr_finish(const TDesc& t, int lane, const f32x4 (&rg)[8], LAS float* scr) {
#pragma unroll
    for (int i = 0; i < 8; ++i) { LAS float* d = scr + ((lane >> 3) + 8 * i) * 33 + 4 * (lane & 7); d[0] = rg[i].x; d[1] = rg[i].y; d[2] = rg[i].z; d[3] = rg[i].w; }
    LDS_WAIT();
    const int c = lane & 7;
#pragma unroll
    for (int j = 0; j < 4; ++j) {
        const int n = (lane >> 3) + 8 * j; const LAS float* s = scr + (8 * c) * 33 + n;
        u32x4 o; o.x = pk2(s[0 * 33], s[1 * 33]); o.y = pk2(s[2 * 33], s[3 * 33]); o.z = pk2(s[4 * 33], s[5 * 33]); o.w = pk2(s[6 * 33], s[7 * 33]);
        const int nn = t.n0 + n;
        const int drow = (t.mode == 0) ? nn : (moe_up_row(nn) + (t.mode == 2 ? 16 : 0));
        *(u32x4*)(t.WT + (size_t)drow * t.ldT + t.k0 + 8 * c) = o;
    }
    LDS_WAIT();
}

__device__ __forceinline__ void phase_convert(Frame& F) {
    const Args& A = *F.a;
    LAS float* scr = (LAS float*)(F.lds + F.wave * 8448);
    LAS float* sil = (LAS float*)(F.lds + 69632);
    for (int i = F.tid; i < 5 * 1024; i += NTHREADS) { const int c = i >> 10, k = i & 1023; const float v = (c < 4) ? A.in[I_C][c * 1024 + k] : A.in[I_CCTX][k]; sil[i] = v / (1.0f + __expf(-v)); }
    __syncthreads();
    const int gw = F.vcu * NWAVES + F.wave, NGW = F.G * NWAVES;
    constexpr int N_MOD = 192, N_WIN = 16 * 64, N_WOUT = 16 * 32, N_WQKV = 16 * 96, N_WO = 16 * 32, N_GATE = 32 * 8, N_MOE = 64 * 256;
    {
        LAS float* red = (LAS float*)(F.lds + 90112);
        for (int item = F.vcu; item < N_MOD; item += F.G) {
            const int l = item / 96, col = (item % 96) * 64 + F.lane;
            const float* wp = A.in[I_WMOD] + ((size_t)l * 1024 + F.wave * 128) * 6144 + col;
            float acc[5] = {0.f, 0.f, 0.f, 0.f, 0.f};
#pragma unroll 4
            for (int k = 0; k < 128; k += 4) {
                const float w0 = wp[(size_t)k * 6144], w1 = wp[(size_t)(k + 1) * 6144], w2 = wp[(size_t)(k + 2) * 6144], w3 = wp[(size_t)(k + 3) * 6144];
#pragma unroll
                for (int c = 0; c < 5; ++c) { const f32x4 s4 = *(const LAS f32x4*)(sil + c * 1024 + F.wave * 128 + k); acc[c] += s4.x * w0 + s4.y * w1 + s4.z * w2 + s4.w * w3; }
            }
#pragma unroll
            for (int c = 0; c < 5; ++c) red[(F.wave * 5 + c) * 64 + F.lane] = acc[c];
            __syncthreads();
            if (F.tid < 320) {
                const int c = F.tid >> 6, ln = F.tid & 63;
                float s = A.in[I_BMOD][l * 6144 + (item % 96) * 64 + ln];
#pragma unroll
                for (int w2 = 0; w2 < 8; ++w2) s += red[(w2 * 5 + c) * 64 + ln];
                ((float*)(F.ws + WS_MOD))[(size_t)(l * 5 + c) * 6144 + (item % 96) * 64 + ln] = s;
            }
            __syncthreads();
        }
    }
}

__device__ __forceinline__ void early_convert(Frame& F) {
    const Args& A = *F.a;
    LAS float* scr = (LAS float*)(F.lds + F.wave * 8448);
    const int gw = F.vcu * NWAVES + F.wave, NGW = F.G * NWAVES;
    constexpr int N_WIN = 16 * 64, N_WOUT = 16 * 32, N_GATE = 32 * 8;
    auto decode = [&](int r) -> TDesc {
        TDesc t; t.mode = 0;
        int item;
        if (r < N_WIN) { t.W = A.in[I_WIN]; t.N = 2048; t.WT = (bf16*)(F.ws + WS_WIN); t.ldT = 1024; item = r; }
        else if ((r -= N_WIN) < N_WOUT) { t.W = A.in[I_WOUT]; t.N = 1024; t.WT = (bf16*)(F.ws + WS_WOUT); t.ldT = 1024; item = r; }
        else {
            r -= N_WOUT;
            const int m = r >> 3, d = m >> 4, g = (m >> 3) & 1, n = m & 7;
            t.W = (g == 0 ? A.in[I_GAW] : A.in[I_GXW]) + (size_t)(d * 8 + n) * 128 * 128; t.N = 128;
            t.WT = (bf16*)(F.ws + WS_GATE) + (size_t)m * 128 * 128; t.ldT = 128; item = r & 7;
        }
        const int nblk = t.N >> 5; t.k0 = 64 * (item / nblk); t.n0 = 32 * (item % nblk);
        return t;
    };
    constexpr int NTR0 = N_WIN + N_WOUT + N_GATE;
    for (int it = gw; it < NTR0; it += NGW) {
        const TDesc cur = decode(it); f32x4 rg[8]; tr_load(cur, F.lane, rg);
        tr_finish(cur, F.lane, rg, scr);
    }
}

constexpr int ND_WQKV = 32 * 96, ND_WO = 32 * 32, ND_MOEL = 32 * 512;
constexpr int ND_SCAN = ND_WQKV + ND_WO + 3 * ND_MOEL;
constexpr int ND_ATTN = 3 * ND_MOEL;
__device__ __forceinline__ TDesc decode_moe(const Frame& F, int r, int layer) {
    const Args& A = *F.a;
    TDesc t; t.mode = 0; int item;
    if (r < ND_MOEL) { const int le = layer * 32 + (r >> 9); t.W = A.in[I_MG] + (size_t)le * 1024 * 512; t.N = 512; t.WT = (bf16*)(F.ws + WS_WUP) + (size_t)le * 1024 * 1024; t.ldT = 1024; t.mode = 1; item = r & 511; }
    else if ((r -= ND_MOEL) < ND_MOEL) { const int le = layer * 32 + (r >> 9); t.W = A.in[I_MU] + (size_t)le * 1024 * 512; t.N = 512; t.WT = (bf16*)(F.ws + WS_WUP) + (size_t)le * 1024 * 1024; t.ldT = 1024; t.mode = 2; item = r & 511; }
    else { r -= ND_MOEL; const int le = layer * 32 + (r >> 9); t.W = A.in[I_MD] + (size_t)le * 512 * 1024; t.N = 1024; t.WT = (bf16*)(F.ws + WS_WDN) + (size_t)le * 1024 * 512; t.ldT = 512; item = r & 511; }
    const int nblk = t.N >> 5; t.k0 = 32 * (item / nblk); t.n0 = 32 * (item % nblk);
    return t;
}
__device__ __forceinline__ TDesc decode_deferred(const Frame& F, int r) {
    const Args& A = *F.a;
    if (r >= ND_WQKV + ND_WO) return decode_moe(F, r - (ND_WQKV + ND_WO), 0);
    TDesc t; t.mode = 0; int item;
    if (r < ND_WQKV) { t.W = A.in[I_WQKV]; t.N = 3072; t.WT = (bf16*)(F.ws + WS_WQKV); t.ldT = 1024; item = r; }
    else { r -= ND_WQKV; t.W = A.in[I_WO]; t.N = 1024; t.WT = (bf16*)(F.ws + WS_WO); t.ldT = 1024; item = r; }
    const int nblk = t.N >> 5; t.k0 = 32 * (item / nblk); t.n0 = 32 * (item % nblk);
    return t;
}
__device__ __forceinline__ void tr3_dma(const TDesc& t, int lane, LAS char* buf) {
    const float* p = t.W + (size_t)(t.k0 + (lane >> 3)) * t.N + t.n0;
#pragma unroll
    for (int i = 0; i < 4; ++i)
        __builtin_amdgcn_global_load_lds((const unsigned*)(p + (size_t)(8 * i) * t.N + 4 * ((lane & 7) ^ i)), (LAS unsigned*)(buf + i * 1024), 16, 0, 0);
}
__device__ __forceinline__ void tr3_finish(const TDesc& t, int lane, const LAS char* buf) {
    const int c = lane & 3;
#pragma unroll
    for (int j = 0; j < 2; ++j) {
        const int n = (lane >> 2) + 16 * j;
        const LAS char* s = buf + (8 * c) * 128 + (((n >> 2) ^ c) << 4) + (n & 3) * 4;
        float x[8];
#pragma unroll
        for (int i = 0; i < 8; ++i) x[i] = *(const LAS float*)(s + i * 128);
        u32x4 o; o.x = pk2(x[0], x[1]); o.y = pk2(x[2], x[3]); o.z = pk2(x[4], x[5]); o.w = pk2(x[6], x[7]);
        const int nn = t.n0 + n;
        const int drow = (t.mode == 0) ? nn : (moe_up_row(nn) + (t.mode == 2 ? 16 : 0));
        *(u32x4*)(t.WT + (size_t)drow * t.ldT + t.k0 + 8 * c) = o;
    }
}
__device__ __forceinline__ void tr3_finish_fp8(const TDesc& t, int lane, const LAS char* buf) {
    const int c = lane & 1, n = lane >> 1;
    float x[16];
#pragma unroll
    for (int i = 0; i < 16; ++i) { const int r = 16 * c + i; x[i] = 32.0f * *(const LAS float*)(buf + r * 128 + (((n >> 2) ^ (r >> 3)) << 4) + (n & 3) * 4); }
    u32x4 o; o.x = pk4_fp8(x[0], x[1], x[2], x[3]); o.y = pk4_fp8(x[4], x[5], x[6], x[7]); o.z = pk4_fp8(x[8], x[9], x[10], x[11]); o.w = pk4_fp8(x[12], x[13], x[14], x[15]);
    const int nn = t.n0 + n;
    const int drow = (t.mode == 0) ? nn : (moe_up_row(nn) + (t.mode == 2 ? 16 : 0));
    *(u32x4*)((unsigned char*)t.WT + (size_t)drow * t.ldT + t.k0 + 16 * c) = o;
}
__device__ __forceinline__ TDesc decode_moe8(const Frame& F, int r) {
    const Args& A = *F.a;
    TDesc t; t.mode = 0; int item;
    unsigned char* up8 = F.ws + WS_WUP + (size_t)64 * MiB; unsigned char* dn8 = F.ws + WS_WDN + (size_t)32 * MiB;
    if (r < ND_MOEL) { const int e = r >> 9; t.W = A.in[I_MG] + (size_t)(32 + e) * 1024 * 512; t.N = 512; t.WT = (bf16*)(up8 + (size_t)e * 1024 * 1024); t.ldT = 1024; t.mode = 1; item = r & 511; }
    else if ((r -= ND_MOEL) < ND_MOEL) { const int e = r >> 9; t.W = A.in[I_MU] + (size_t)(32 + e) * 1024 * 512; t.N = 512; t.WT = (bf16*)(up8 + (size_t)e * 1024 * 1024); t.ldT = 1024; t.mode = 2; item = r & 511; }
    else { r -= ND_MOEL; const int e = r >> 9; t.W = A.in[I_MD] + (size_t)(32 + e) * 512 * 1024; t.N = 1024; t.WT = (bf16*)(dn8 + (size_t)e * 1024 * 512); t.ldT = 512; item = r & 511; }
    const int nblk = t.N >> 5; t.k0 = 32 * (item / nblk); t.n0 = 32 * (item % nblk);
    return t;
}
__device__ __forceinline__ void tr2_load(const TDesc& t, int lane, f32x4 (&rg)[4]) {
    const float* p = t.W + (size_t)(t.k0 + (lane >> 3)) * t.N + t.n0 + 4 * (lane & 7);
#pragma unroll
    for (int i = 0; i < 4; ++i) rg[i] = *(const f32x4*)(p + (size_t)(8 * i) * t.N);
}
__device__ __forceinline__ void tr2_finish(const TDesc& t, int lane, const f32x4 (&rg)[4], LAS float* scr  ) {
#pragma unroll
    for (int i = 0; i < 4; ++i) { LAS float* d = scr + ((lane >> 3) + 8 * i) * 33 + 4 * (lane & 7); d[0] = rg[i].x; d[1] = rg[i].y; d[2] = rg[i].z; d[3] = rg[i].w; }
    LDS_WAIT();
    const int c = lane & 3;
#pragma unroll
    for (int j = 0; j < 2; ++j) {
        const int n = (lane >> 2) + 16 * j; const LAS float* s = scr + (8 * c) * 33 + n;
        u32x4 o; o.x = pk2(s[0 * 33], s[1 * 33]); o.y = pk2(s[2 * 33], s[3 * 33]); o.z = pk2(s[4 * 33], s[5 * 33]); o.w = pk2(s[6 * 33], s[7 * 33]);
        const int nn = t.n0 + n;
        const int drow = (t.mode == 0) ? nn : (moe_up_row(nn) + (t.mode == 2 ? 16 : 0));
        *(u32x4*)(t.WT + (size_t)drow * t.ldT + t.k0 + 8 * c) = o;
    }
    LDS_WAIT();
}

constexpr int ND_TAILW = (256 - 32) * NWAVES;
constexpr int ND_A = ND_TAILW * 10, ND_B = ND_A + ND_TAILW * 7;
__device__ __forceinline__ void tail_convert(Frame& F, int tw, int first, int last) {
    LAS float* scr = (LAS float*)(F.lds + F.wave * 4224);
    int it = first + tw;
    if (it >= last) return;
    TDesc c0 = decode_deferred(F, it); f32x4 r0[4]; tr2_load(c0, F.lane, r0);
    for (;;) {
        const int n1 = it + ND_TAILW; const bool m1 = n1 < last;
        TDesc c1 = c0; f32x4 r1[4];
        if (m1) { c1 = decode_deferred(F, n1); tr2_load(c1, F.lane, r1); }
        tr2_finish(c0, F.lane, r0, scr);
        if (!m1) break;
        c0 = c1; it = n1;
#pragma unroll
        for (int i = 0; i < 4; ++i) r0[i] = r1[i];
    }
}

__device__ __forceinline__ float row_rstd(const f32x4 (&v)[4]) {
    float s = 0.f;
#pragma unroll
    for (int j = 0; j < 4; ++j) s += (v[j].x * v[j].x + v[j].y * v[j].y) + (v[j].z * v[j].z + v[j].w * v[j].w);
    return rsqrtf(wave_sum(s) * (1.0f / D) + EPS);
}
__device__ __forceinline__ void row_modulate_store8(f32x4 (&v)[4], float rstd, const float* g, const float* sc, const float* sh, unsigned char* dst, int lane) {
#pragma unroll
    for (int j = 0; j < 4; ++j) {
        const int c0 = 4 * lane + 256 * j;
        const f32x4 gg = *(const f32x4*)(g + c0), s1 = *(const f32x4*)(sc + c0), s0 = *(const f32x4*)(sh + c0);
        v[j] = (v[j] * rstd) * gg * (1.0f + s1) + s0;
        *(unsigned*)(dst + c0) = pk4_fp8(v[j].x, v[j].y, v[j].z, v[j].w);
    }
}
__device__ __forceinline__ void row_modulate_store(f32x4 (&v)[4], float rstd, const float* g, const float* sc, const float* sh, bf16* dst, int lane) {
#pragma unroll
    for (int j = 0; j < 4; ++j) {
        const int c0 = 4 * lane + 256 * j;
        const f32x4 gg = *(const f32x4*)(g + c0), s1 = *(const f32x4*)(sc + c0), s0 = *(const f32x4*)(sh + c0);
        v[j] = (v[j] * rstd) * gg * (1.0f + s1) + s0;
        u32x2 o; o.x = pk2(v[j].x, v[j].y); o.y = pk2(v[j].z, v[j].w);
        *(u32x2*)(dst + c0) = o;
    }
}

__device__ __forceinline__ void load_row4(const float* src, int lane, f32x4 (&v)[4]) {
#pragma unroll
    for (int j = 0; j < 4; ++j) v[j] = *(const f32x4*)(src + 4 * lane + 256 * j);
}
__device__ __forceinline__ void phase_prep0(Frame& F) {
    const Args& A = *F.a;
    const int gw = F.vcu * NWAVES + F.wave, NGW = F.G * NWAVES;
    bf16* H = (bf16*)(F.ws + WS_H);
    f32x4 vn[4];
    if (gw < NTOK) load_row4(gw < NX ? A.in[I_X] + (size_t)gw * D : A.in[I_CTX] + (size_t)(gw - NX) * D, F.lane, vn);
    for (int row = gw; row < NTOK; row += NGW) {
        const int c = cond_of(row);
        f32x4 v[4];
#pragma unroll
        for (int j = 0; j < 4; ++j) v[j] = vn[j];
        const int nr = row + NGW;
        if (nr < NTOK) load_row4(nr < NX ? A.in[I_X] + (size_t)nr * D : A.in[I_CTX] + (size_t)(nr - NX) * D, F.lane, vn);
        const float rstd = row_rstd(v);
        row_modulate_store(v, rstd, A.in[I_N1G], modp(F, 0, c, 1), modp(F, 0, c, 0), H + (size_t)row * D, F.lane);
    }
    early_convert(F);
}

constexpr int GEMM_STAGE = 49152;
__device__ __forceinline__ int swz128(int row, int chunk) { return row * 128 + ((chunk ^ ((row >> 1) & 7)) << 4); }
__device__ __forceinline__ int dma_kc(int tid) { return ((tid & 7) ^ ((tid >> 4) & 7)) * 8; }

struct ALDense {
    static constexpr bool DMA = true;
    const bf16* p0; const bf16* p1;
    __device__ __forceinline__ const bf16* ptr(int i) const { return i ? p1 : p0; }
    __device__ __forceinline__ void init(const bf16* A, int lda, int m0, int r0, int r1, int kc) { p0 = A + (size_t)(m0 + r0) * lda + kc; p1 = A + (size_t)(m0 + r1) * lda + kc; }
    __device__ __forceinline__ u32x4 load(int i, int k0) const { return *(const u32x4*)((i ? p1 : p0) + k0); }
};
struct ALGather {
    static constexpr bool DMA = true;
    const bf16* p0; const bf16* p1;
    __device__ __forceinline__ const bf16* ptr(int i) const { return i ? p1 : p0; }
    __device__ __forceinline__ void init(const bf16* A, int lda, const int* idx, int m0, int r0, int r1, int kc) { p0 = A + (size_t)idx[m0 + r0] * lda + kc; p1 = A + (size_t)idx[m0 + r1] * lda + kc; }
    __device__ __forceinline__ u32x4 load(int i, int k0) const { return *(const u32x4*)((i ? p1 : p0) + k0); }
};
struct ALCombine {
    static constexpr bool DMA = false;
    size_t o0, o1; const bf16 *hf, *hb, *yg;
    __device__ __forceinline__ const bf16* ptr(int) const { return nullptr; }
    __device__ __forceinline__ void init(const bf16* hf_, const bf16* hb_, const bf16* yg_, int m0, int r0, int r1, int kc) { hf = hf_; hb = hb_; yg = yg_; o0 = (size_t)(m0 + r0) * D + kc; o1 = (size_t)(m0 + r1) * D + kc; }
    __device__ __forceinline__ u32x4 load(int i, int k0) const {
        const size_t o = (i ? o1 : o0) + k0;
        const u32x4 a = *(const u32x4*)(hf + o), b = *(const u32x4*)(hb + o), y = *(const u32x4*)(yg + o);
        u32x4 r;
#pragma unroll
        for (int q = 0; q < 4; ++q) r[q] = pk2((bflo(a[q]) + bflo(b[q])) * bflo(y[q]), (bfhi(a[q]) + bfhi(b[q])) * bfhi(y[q]));
        return r;
    }
};

template <class AL>
__device__ __forceinline__ void gemm_prefetch(const Frame& F, const AL& al, const bf16* __restrict__ Bt, int K) {
    const int tid = F.tid, sr = tid >> 3, sc = (tid & 7) ^ ((sr >> 1) & 7), wl = F.wave * 1024;
    const bf16* bp = Bt + (size_t)sr * K + sc * 8;
    const size_t bstep = (size_t)64 * K;
    LAS char* lds = F.lds;
    __builtin_amdgcn_global_load_lds((const unsigned*)(al.ptr(0)), (LAS unsigned*)(lds + wl), 16, 0, 0);
    __builtin_amdgcn_global_load_lds((const unsigned*)(al.ptr(1)), (LAS unsigned*)(lds + 8192 + wl), 16, 0, 0);
#pragma unroll
    for (int i = 0; i < 4; ++i)
        __builtin_amdgcn_global_load_lds((const unsigned*)(bp + i * bstep), (LAS unsigned*)(lds + 16384 + i * 8192 + wl), 16, 0, 0);
}
template <bool SWAP, class AL, bool PRE = false>
__device__ __forceinline__ void gemm_tile(const Frame& F, const AL& al, const bf16* __restrict__ Bt  , int K, f32x4 (&acc)[4][4]) {
    const int tid = F.tid, lane = F.lane, wid = F.wave, wr = wid >> 2, wc = wid & 3, fr = lane & 15, fq = lane >> 4;
    const int sr = tid >> 3;
    const int sc = AL::DMA ? ((tid & 7) ^ ((sr >> 1) & 7)) : (tid & 7);
    LAS char* lds = F.lds;
    const bf16* bp = Bt + (size_t)sr * K + sc * 8;
    const size_t bstep = (size_t)64 * K;
    int wa[2], wb[4];
#pragma unroll
    for (int i = 0; i < 2; ++i) wa[i] = swz128(sr + 64 * i, sc);
#pragma unroll
    for (int i = 0; i < 4; ++i) wb[i] = 16384 + swz128(sr + 64 * i, sc);
    const int key = (fr >> 1) & 7;
    const int ra = (wr * 64 + fr) * 128, rb = 16384 + (wc * 64 + fr) * 128;
#pragma unroll
    for (int mi = 0; mi < 4; ++mi)
#pragma unroll
        for (int ni = 0; ni < 4; ++ni) acc[mi][ni] = (f32x4){0.f, 0.f, 0.f, 0.f};
    u32x4 ga[2], gb[4];
    const int wl = wid * 1024;
#define GT_DMA(stage_, k_) do { \
        __builtin_amdgcn_global_load_lds((const unsigned*)(al.ptr(0) + (k_)), (LAS unsigned*)(lds + (stage_) + wl), 16, 0, 0); \
        __builtin_amdgcn_global_load_lds((const unsigned*)(al.ptr(1) + (k_)), (LAS unsigned*)(lds + (stage_) + 8192 + wl), 16, 0, 0); \
        _Pragma("unroll") for (int i_ = 0; i_ < 4; ++i_) \
            __builtin_amdgcn_global_load_lds((const unsigned*)(bp + i_ * bstep + (k_)), (LAS unsigned*)(lds + (stage_) + 16384 + i_ * 8192 + wl), 16, 0, 0); } while (0)
    if constexpr (AL::DMA) { if constexpr (!PRE) { GT_DMA(0, 0); } }
    else {
        ga[0] = al.load(0, 0); ga[1] = al.load(1, 0);
#pragma unroll
        for (int i = 0; i < 4; ++i) gb[i] = *(const u32x4*)(bp + i * bstep);
#pragma unroll
        for (int i = 0; i < 2; ++i) *(LAS u32x4*)(lds + wa[i]) = ga[i];
#pragma unroll
        for (int i = 0; i < 4; ++i) *(LAS u32x4*)(lds + wb[i]) = gb[i];
    }
    __syncthreads();
    const int nk = K / 64;
    for (int kt = 0; kt < nk; ++kt) {
        const int cur = (kt & 1) * GEMM_STAGE, nxt = GEMM_STAGE - cur;
        if (kt + 1 < nk) {
            const int k1 = (kt + 1) * 64;
            if constexpr (AL::DMA) { GT_DMA(nxt, k1); }
            else {
                ga[0] = al.load(0, k1); ga[1] = al.load(1, k1);
#pragma unroll
                for (int i = 0; i < 4; ++i) gb[i] = *(const u32x4*)(bp + i * bstep + k1);
            }
        }
        {
            bf16x8 af[2][4], bfr[2][4];
#pragma unroll
            for (int ks = 0; ks < 2; ++ks) {
                const int co = ((ks * 4 + fq) ^ key) << 4;
#pragma unroll
                for (int mi = 0; mi < 4; ++mi) af[ks][mi] = *(const LAS bf16x8*)(lds + cur + ra + mi * 2048 + co);
#pragma unroll
                for (int ni = 0; ni < 4; ++ni) bfr[ks][ni] = *(const LAS bf16x8*)(lds + cur + rb + ni * 2048 + co);
            }
            __builtin_amdgcn_sched_barrier(0);
#pragma unroll
            for (int ks = 0; ks < 2; ++ks)
#pragma unroll
                for (int mi = 0; mi < 4; ++mi)
#pragma unroll
                    for (int ni = 0; ni < 4; ++ni)
                        acc[mi][ni] = SWAP ? __builtin_amdgcn_mfma_f32_16x16x32_bf16(bfr[ks][ni], af[ks][mi], acc[mi][ni], 0, 0, 0)
                                           : __builtin_amdgcn_mfma_f32_16x16x32_bf16(af[ks][mi], bfr[ks][ni], acc[mi][ni], 0, 0, 0);
            __builtin_amdgcn_sched_barrier(0);
        }
        if constexpr (!AL::DMA) {
            if (kt + 1 < nk) {
#pragma unroll
                for (int i = 0; i < 2; ++i) *(LAS u32x4*)(lds + nxt + wa[i]) = ga[i];
#pragma unroll
                for (int i = 0; i < 4; ++i) *(LAS u32x4*)(lds + nxt + wb[i]) = gb[i];
            }
        }
        __syncthreads();
    }
#undef GT_DMA
}

#define G3_WAIT_BAR(N) asm volatile("s_waitcnt vmcnt(" #N ") lgkmcnt(0)\n\ts_barrier" ::: "memory")
template <class AL>
__device__ __forceinline__ void gemm3_issue(const Frame& F, const AL& al, const bf16* bp, size_t bstep, int stage_off, int k) {
    LAS char* lds = F.lds; const int wl = F.wave * 1024;
    __builtin_amdgcn_global_load_lds((const unsigned*)(al.ptr(0) + k), (LAS unsigned*)(lds + stage_off + wl), 16, 0, 0);
    __builtin_amdgcn_global_load_lds((const unsigned*)(al.ptr(1) + k), (LAS unsigned*)(lds + stage_off + 8192 + wl), 16, 0, 0);
#pragma unroll
    for (int i = 0; i < 4; ++i)
        __builtin_amdgcn_global_load_lds((const unsigned*)(bp + i * bstep + k), (LAS unsigned*)(lds + stage_off + 16384 + i * 8192 + wl), 16, 0, 0);
}
template <class AL>
__device__ __forceinline__ void gemm3_prefetch(const Frame& F, const AL& al, const bf16* __restrict__ Bt, int K) {
    const int tid = F.tid, sr = tid >> 3, sc = (tid & 7) ^ ((sr >> 1) & 7);
    const bf16* bp = Bt + (size_t)sr * K + sc * 8;
    gemm3_issue(F, al, bp, (size_t)64 * K, 0, 0);
    gemm3_issue(F, al, bp, (size_t)64 * K, GEMM_STAGE, 64);
}
template <bool SWAP, int EPI_ST, class AL>
__device__ __forceinline__ void gemm3_tile(const Frame& F, const AL& al, const bf16* __restrict__ Bt, int K, f32x4 (&acc)[4][4], bool first_unit) {
    static_assert(EPI_ST == 8 || EPI_ST == 16, "EPI_ST");
    const int tid = F.tid, lane = F.lane, wid = F.wave, wr = wid >> 2, wc = wid & 3, fr = lane & 15, fq = lane >> 4;
    const int sr = tid >> 3, sc = (tid & 7) ^ ((sr >> 1) & 7);
    LAS char* lds = F.lds;
    const bf16* bp = Bt + (size_t)sr * K + sc * 8;
    const size_t bstep = (size_t)64 * K;
    const int key = (fr >> 1) & 7;
    const int ra = (wr * 64 + fr) * 128, rb = 16384 + (wc * 64 + fr) * 128;
#pragma unroll
    for (int mi = 0; mi < 4; ++mi)
#pragma unroll
        for (int ni = 0; ni < 4; ++ni) acc[mi][ni] = (f32x4){0.f, 0.f, 0.f, 0.f};
    const int nk = K / 64;
    int cur = 0, nx2 = 2 * GEMM_STAGE;
    const int wl = wid * 1024;
#pragma unroll 1
    for (int kt = 0; kt < nk; ++kt) {
        if (kt + 1 >= nk) G3_WAIT_BAR(0);
        else if (kt >= 2 || first_unit) G3_WAIT_BAR(6);
        else if (kt == 0) { if constexpr (EPI_ST == 8) G3_WAIT_BAR(8); else G3_WAIT_BAR(16); }
        else { if constexpr (EPI_ST == 8) G3_WAIT_BAR(14); else G3_WAIT_BAR(22); }
        const bool more = kt + 2 < nk;
        const int k2 = (kt + 2) * 64;
#pragma unroll
        for (int ks = 0; ks < 2; ++ks) {
            const int co = ((ks * 4 + fq) ^ key) << 4;
            bf16x8 af[4], bfr[4];
#pragma unroll
            for (int mi = 0; mi < 4; ++mi) af[mi] = *(const LAS bf16x8*)(lds + cur + ra + mi * 2048 + co);
#pragma unroll
            for (int ni = 0; ni < 4; ++ni) bfr[ni] = *(const LAS bf16x8*)(lds + cur + rb + ni * 2048 + co);
#pragma unroll
            for (int mi = 0; mi < 4; ++mi) {
                if (more && mi < 3) {
                    const int g = ks * 3 + mi;
                    if (g < 2) __builtin_amdgcn_global_load_lds((const unsigned*)(al.ptr(g) + k2), (LAS unsigned*)(lds + nx2 + g * 8192 + wl), 16, 0, 0);
                    else __builtin_amdgcn_global_load_lds((const unsigned*)(bp + (g - 2) * bstep + k2), (LAS unsigned*)(lds + nx2 + 16384 + (g - 2) * 8192 + wl), 16, 0, 0);
                }
#pragma unroll
                for (int ni = 0; ni < 4; ++ni)
                    acc[mi][ni] = SWAP ? __builtin_amdgcn_mfma_f32_16x16x32_bf16(bfr[ni], af[mi], acc[mi][ni], 0, 0, 0)
                                       : __builtin_amdgcn_mfma_f32_16x16x32_bf16(af[mi], bfr[ni], acc[mi][ni], 0, 0, 0);
            }
        }
        nx2 = cur; cur = (cur == 2 * GEMM_STAGE) ? 0 : cur + GEMM_STAGE;
    }
    G3_WAIT_BAR(0);
}

template <int EPI_ST, class AL>
__device__ __forceinline__ void gemm3_tile8(const Frame& F, const AL& al, const bf16* __restrict__ Bt, int K2, f32x4 (&acc)[4][4], bool first_unit, int sc_w, int sc_a) {
    static_assert(EPI_ST == 8 || EPI_ST == 16, "EPI_ST");
    const int tid = F.tid, lane = F.lane, wid = F.wave, wr = wid >> 2, wc = wid & 3, fr = lane & 15, fq = lane >> 4;
    const int sr = tid >> 3, sc = (tid & 7) ^ ((sr >> 1) & 7);
    LAS char* lds = F.lds;
    const bf16* bp = Bt + (size_t)sr * K2 + sc * 8;
    const size_t bstep = (size_t)64 * K2;
    const int key = (fr >> 1) & 7;
    const int ra = (wr * 64 + fr) * 128, rb = 16384 + (wc * 64 + fr) * 128;
    const int c0 = ((2 * fq) ^ key) << 4, c1 = ((2 * fq + 1) ^ key) << 4;
#pragma unroll
    for (int mi = 0; mi < 4; ++mi)
#pragma unroll
        for (int ni = 0; ni < 4; ++ni) acc[mi][ni] = (f32x4){0.f, 0.f, 0.f, 0.f};
    const int nk = K2 / 64;
    int cur = 0, nx2 = 2 * GEMM_STAGE;
    const int wl = wid * 1024;
#pragma unroll 1
    for (int kt = 0; kt < nk; ++kt) {
        if (kt + 1 >= nk) G3_WAIT_BAR(0);
        else if (kt >= 2 || first_unit) G3_WAIT_BAR(6);
        else if (kt == 0) { if constexpr (EPI_ST == 8) G3_WAIT_BAR(8); else G3_WAIT_BAR(16); }
        else { if constexpr (EPI_ST == 8) G3_WAIT_BAR(14); else G3_WAIT_BAR(22); }
        const bool more = kt + 2 < nk;
        const int k2 = (kt + 2) * 64;
        i32x8 af[4], bfr[4];
#pragma unroll
        for (int mi = 0; mi < 4; ++mi) {
            const u32x4 lo = *(const LAS u32x4*)(lds + cur + ra + mi * 2048 + c0), hi = *(const LAS u32x4*)(lds + cur + ra + mi * 2048 + c1);
            af[mi] = (i32x8){(int)lo.x, (int)lo.y, (int)lo.z, (int)lo.w, (int)hi.x, (int)hi.y, (int)hi.z, (int)hi.w};
        }
#pragma unroll
        for (int ni = 0; ni < 4; ++ni) {
            const u32x4 lo = *(const LAS u32x4*)(lds + cur + rb + ni * 2048 + c0), hi = *(const LAS u32x4*)(lds + cur + rb + ni * 2048 + c1);
            bfr[ni] = (i32x8){(int)lo.x, (int)lo.y, (int)lo.z, (int)lo.w, (int)hi.x, (int)hi.y, (int)hi.z, (int)hi.w};
        }
#define G8_PIECE(g_) do { if ((g_) < 2) __builtin_amdgcn_global_load_lds((const unsigned*)(al.ptr(g_) + k2), (LAS unsigned*)(lds + nx2 + (g_) * 8192 + wl), 16, 0, 0); \
            else __builtin_amdgcn_global_load_lds((const unsigned*)(bp + ((g_) - 2) * bstep + k2), (LAS unsigned*)(lds + nx2 + 16384 + ((g_) - 2) * 8192 + wl), 16, 0, 0); } while (0)
#define G8_MMA(mi_) do { _Pragma("unroll") for (int ni = 0; ni < 4; ++ni) \
            acc[mi_][ni] = __builtin_amdgcn_mfma_scale_f32_16x16x128_f8f6f4(bfr[ni], af[mi_], acc[mi_][ni], 0, 0, 0, sc_w, 0, sc_a); } while (0)
        if (more) { G8_PIECE(0); G8_PIECE(1); }
        G8_MMA(0);
        if (more) { G8_PIECE(2); G8_PIECE(3); }
        G8_MMA(1);
        if (more) { G8_PIECE(4); }
        G8_MMA(2);
        if (more) { G8_PIECE(5); }
        G8_MMA(3);
#undef G8_PIECE
#undef G8_MMA
        nx2 = cur; cur = (cur == 2 * GEMM_STAGE) ? 0 : cur + GEMM_STAGE;
    }
    G3_WAIT_BAR(0);
}

struct Ring { int cur, nx2; };
template <class AL>
__device__ __forceinline__ void ring_start(const Frame& F, Ring& R, const AL& al, const bf16* __restrict__ Bt, int K2) {
    const int tid = F.tid, sr = tid >> 3, sc = (tid & 7) ^ ((sr >> 1) & 7);
    const bf16* bp = Bt + (size_t)sr * K2 + sc * 8;
    gemm3_issue(F, al, bp, (size_t)64 * K2, 0, 0);
    gemm3_issue(F, al, bp, (size_t)64 * K2, GEMM_STAGE, 64);
    R.cur = 0; R.nx2 = 2 * GEMM_STAGE;
}
template <bool F8, int EPI_ST, class AL>
__device__ __forceinline__ void gemm3_unit(const Frame& F, Ring& R, const AL& al, const bf16* __restrict__ Bt, const AL& alN, const bf16* __restrict__ BtN, bool hasN,
                                           int K2, f32x4 (&acc)[4][4], bool first_unit, int sc_w = 0, int sc_a = 0) {
    static_assert(EPI_ST == 8 || EPI_ST == 16, "EPI_ST");
    const int tid = F.tid, lane = F.lane, wid = F.wave, wr = wid >> 2, wc = wid & 3, fr = lane & 15, fq = lane >> 4;
    const int sr = tid >> 3, sc = (tid & 7) ^ ((sr >> 1) & 7);
    LAS char* lds = F.lds;
    const bf16* bp = Bt + (size_t)sr * K2 + sc * 8;
    const bf16* bpN = BtN + (size_t)sr * K2 + sc * 8;
    const size_t bstep = (size_t)64 * K2;
    const int key = (fr >> 1) & 7;
    const int ra = (wr * 64 + fr) * 128, rb = 16384 + (wc * 64 + fr) * 128;
#pragma unroll
    for (int mi = 0; mi < 4; ++mi)
#pragma unroll
        for (int ni = 0; ni < 4; ++ni) acc[mi][ni] = (f32x4){0.f, 0.f, 0.f, 0.f};
    const int nk = K2 / 64;
    int cur = R.cur, nx2 = R.nx2;
    const int wl = wid * 1024;
#pragma unroll 1
    for (int kt = 0; kt < nk; ++kt) {
        const bool later = (kt + 1 < nk) || hasN;
        if (!later) G3_WAIT_BAR(0);
        else if (kt >= 2 || first_unit) G3_WAIT_BAR(6);
        else { if constexpr (EPI_ST == 8) G3_WAIT_BAR(14); else G3_WAIT_BAR(22); }
        const bool own = kt + 2 < nk, more = own || hasN;
        const bf16* pa0 = own ? al.ptr(0) : alN.ptr(0); const bf16* pa1 = own ? al.ptr(1) : alN.ptr(1); const bf16* pb = own ? bp : bpN;
        const int k2 = (own ? kt + 2 : kt + 2 - nk) * 64;
#define G3_PIECE(g_) do { if ((g_) == 0) __builtin_amdgcn_global_load_lds((const unsigned*)(pa0 + k2), (LAS unsigned*)(lds + nx2 + wl), 16, 0, 0); \
            else if ((g_) == 1) __builtin_amdgcn_global_load_lds((const unsigned*)(pa1 + k2), (LAS unsigned*)(lds + nx2 + 8192 + wl), 16, 0, 0); \
            else __builtin_amdgcn_global_load_lds((const unsigned*)(pb + ((g_) - 2) * bstep + k2), (LAS unsigned*)(lds + nx2 + 16384 + ((g_) - 2) * 8192 + wl), 16, 0, 0); } while (0)
        if constexpr (F8) {
            const int c0 = ((2 * fq) ^ key) << 4, c1 = ((2 * fq + 1) ^ key) << 4;
            i32x8 af[4], bfr[4];
#pragma unroll
            for (int mi = 0; mi < 4; ++mi) {
                const u32x4 lo = *(const LAS u32x4*)(lds + cur + ra + mi * 2048 + c0), hi = *(const LAS u32x4*)(lds + cur + ra + mi * 2048 + c1);
                af[mi] = (i32x8){(int)lo.x, (int)lo.y, (int)lo.z, (int)lo.w, (int)hi.x, (int)hi.y, (int)hi.z, (int)hi.w};
            }
#pragma unroll
            for (int ni = 0; ni < 4; ++ni) {
                const u32x4 lo = *(const LAS u32x4*)(lds + cur + rb + ni * 2048 + c0), hi = *(const LAS u32x4*)(lds + cur + rb + ni * 2048 + c1);
                bfr[ni] = (i32x8){(int)lo.x, (int)lo.y, (int)lo.z, (int)lo.w, (int)hi.x, (int)hi.y, (int)hi.z, (int)hi.w};
            }
#define G8_MMA(mi_) do { _Pragma("unroll") for (int ni = 0; ni < 4; ++ni) \
                acc[mi_][ni] = __builtin_amdgcn_mfma_scale_f32_16x16x128_f8f6f4(bfr[ni], af[mi_], acc[mi_][ni], 0, 0, 0, sc_w, 0, sc_a); } while (0)
            if (more) { G3_PIECE(0); G3_PIECE(1); }
            G8_MMA(0);
            if (more) { G3_PIECE(2); G3_PIECE(3); }
            G8_MMA(1);
            if (more) { G3_PIECE(4); }
            G8_MMA(2);
            if (more) { G3_PIECE(5); }
            G8_MMA(3);
#undef G8_MMA
        } else {
#pragma unroll
            for (int ks = 0; ks < 2; ++ks) {
                const int co = ((ks * 4 + fq) ^ key) << 4;
                bf16x8 af[4], bfr[4];
#pragma unroll
                for (int mi = 0; mi < 4; ++mi) af[mi] = *(const LAS bf16x8*)(lds + cur + ra + mi * 2048 + co);
#pragma unroll
                for (int ni = 0; ni < 4; ++ni) bfr[ni] = *(const LAS bf16x8*)(lds + cur + rb + ni * 2048 + co);
#pragma unroll
                for (int mi = 0; mi < 4; ++mi) {
                    if (more && mi < 3) { if (ks == 0) { if (mi == 0) G3_PIECE(0); else if (mi == 1) G3_PIECE(1); else G3_PIECE(2); } else { if (mi == 0) G3_PIECE(3); else if (mi == 1) G3_PIECE(4); else G3_PIECE(5); } }
#pragma unroll
                    for (int ni = 0; ni < 4; ++ni) acc[mi][ni] = __builtin_amdgcn_mfma_f32_16x16x32_bf16(bfr[ni], af[mi], acc[mi][ni], 0, 0, 0);
                }
            }
        }
#undef G3_PIECE
        nx2 = cur; cur = (cur == 2 * GEMM_STAGE) ? 0 : cur + GEMM_STAGE;
    }
    R.cur = cur; R.nx2 = nx2;
}


template <class AL>
__device__ __forceinline__ void ringn_start(const Frame& F, Ring& R, const AL& al, const bf16* __restrict__ Bt, int K2) {
    const int tid = F.tid, sr = tid >> 3, sc = (tid & 7) ^ ((sr >> 1) & 7), wl = F.wave * 1024;
    const bf16* bp = Bt + (size_t)sr * K2 + sc * 8;
    const size_t bstep = (size_t)64 * K2;
    LAS char* lds = F.lds;
#pragma unroll
    for (int t = 0; t < 2; ++t) {
        __builtin_amdgcn_global_load_lds((const unsigned*)(al.ptr(0) + t * 64), (LAS unsigned*)(lds + t * GEMM_STAGE + wl), 16, 0, 0);
        __builtin_amdgcn_global_load_lds((const unsigned*)(al.ptr(1) + t * 64), (LAS unsigned*)(lds + t * GEMM_STAGE + 8192 + wl), 16, 0, 0);
        __builtin_amdgcn_global_load_lds((const unsigned*)(bp + t * 64), (LAS unsigned*)(lds + t * GEMM_STAGE + 16384 + wl), 16, 0, 0);
        __builtin_amdgcn_global_load_lds((const unsigned*)(bp + bstep + t * 64), (LAS unsigned*)(lds + t * GEMM_STAGE + 16384 + 8192 + wl), 16, 0, 0);
    }
    R.cur = 0; R.nx2 = 2 * GEMM_STAGE;
}
template <int EPI_ST, class AL>
__device__ __forceinline__ void gemm3n_unit(const Frame& F, Ring& R, const AL& al, const bf16* __restrict__ Bt, const AL& alN, const bf16* __restrict__ BtN, bool hasN,
                                            int K2, f32x4 (&acc)[4][2], bool first_unit) {
    static_assert(EPI_ST == 16, "EPI_ST");
    const int tid = F.tid, lane = F.lane, wid = F.wave, wr = wid >> 2, wc = wid & 3, fr = lane & 15, fq = lane >> 4;
    const int sr = tid >> 3, sc = (tid & 7) ^ ((sr >> 1) & 7);
    LAS char* lds = F.lds;
    const bf16* bp = Bt + (size_t)sr * K2 + sc * 8;
    const bf16* bpN = BtN + (size_t)sr * K2 + sc * 8;
    const size_t bstep = (size_t)64 * K2;
    const int key = (fr >> 1) & 7;
    const int ra = (wr * 64 + fr) * 128, rb = 16384 + (wc * 32 + fr) * 128;
#pragma unroll
    for (int mi = 0; mi < 4; ++mi)
#pragma unroll
        for (int ni = 0; ni < 2; ++ni) acc[mi][ni] = (f32x4){0.f, 0.f, 0.f, 0.f};
    const int nk = K2 / 64;
    int cur = R.cur, nx2 = R.nx2;
    const int wl = wid * 1024;
#pragma unroll 1
    for (int kt = 0; kt < nk; ++kt) {
        const bool later = (kt + 1 < nk) || hasN;
        if (!later) G3_WAIT_BAR(0);
        else if (kt >= 2 || first_unit) G3_WAIT_BAR(4);
        else G3_WAIT_BAR(20);
        const bool own = kt + 2 < nk, more = own || hasN;
        const bf16* pa0 = own ? al.ptr(0) : alN.ptr(0); const bf16* pa1 = own ? al.ptr(1) : alN.ptr(1); const bf16* pb = own ? bp : bpN;
        const int k2 = (own ? kt + 2 : kt + 2 - nk) * 64;
#define G3N_PIECE(g_) do { if ((g_) == 0) __builtin_amdgcn_global_load_lds((const unsigned*)(pa0 + k2), (LAS unsigned*)(lds + nx2 + wl), 16, 0, 0); \
            else if ((g_) == 1) __builtin_amdgcn_global_load_lds((const unsigned*)(pa1 + k2), (LAS unsigned*)(lds + nx2 + 8192 + wl), 16, 0, 0); \
            else __builtin_amdgcn_global_load_lds((const unsigned*)(pb + ((g_) - 2) * bstep + k2), (LAS unsigned*)(lds + nx2 + 16384 + ((g_) - 2) * 8192 + wl), 16, 0, 0); } while (0)
#pragma unroll
        for (int ks = 0; ks < 2; ++ks) {
            const int co = ((ks * 4 + fq) ^ key) << 4;
            bf16x8 af[4], bfr[2];
#pragma unroll
            for (int mi = 0; mi < 4; ++mi) af[mi] = *(const LAS bf16x8*)(lds + cur + ra + mi * 2048 + co);
#pragma unroll
            for (int ni = 0; ni < 2; ++ni) bfr[ni] = *(const LAS bf16x8*)(lds + cur + rb + ni * 2048 + co);
#pragma unroll
            for (int mi = 0; mi < 4; ++mi) {
                if (more && (mi & 1) == 0) { if (ks == 0) { if (mi == 0) G3N_PIECE(0); else G3N_PIECE(1); } else { if (mi == 0) G3N_PIECE(2); else G3N_PIECE(3); } }
#pragma unroll
                for (int ni = 0; ni < 2; ++ni) acc[mi][ni] = __builtin_amdgcn_mfma_f32_16x16x32_bf16(bfr[ni], af[mi], acc[mi][ni], 0, 0, 0);
            }
        }
#undef G3N_PIECE
        nx2 = cur; cur = (cur == 2 * GEMM_STAGE) ? 0 : cur + GEMM_STAGE;
    }
    R.cur = cur; R.nx2 = nx2;
}

__device__ __forceinline__ float gelu_tanh(float x) {
    const float z = 0.7978845608028654f * (x + 0.044715f * x * x * x);
    const float t = 1.0f - 2.0f / (1.0f + __expf(2.0f * z));
    return 0.5f * x * (1.0f + t);
}
namespace pg8 {
#define PG8_LAS __attribute__((address_space(3)))
typedef unsigned short bf16_t;
typedef short bf16x8 __attribute__((ext_vector_type(8)));
typedef float f32x4 __attribute__((ext_vector_type(4)));
typedef unsigned u32x4 __attribute__((ext_vector_type(4)));
constexpr int BM = 256, BK = 64, HALF = 128, HTB = HALF * BK * 2  , STAGE_BYTES = 8 * HTB, NXCD = 8, WGM = 8;

__host__ __device__ __forceinline__ int lds_byte(int r, int c) { const int st = (r >> 4) * 2 + (c >> 5), rr = r & 15, cc = c & 31, ob = rr * 64 + cc * 2; return st * 1024 + (ob ^ (((ob >> 9) & 1) << 5)); }
__host__ __device__ __forceinline__ void stage_rc(int b, int& R, int& C) { const int st = b / 1024, sb = b % 1024, swz = sb ^ (((sb >> 9) & 1) << 5); R = (st >> 1) * 16 + swz / 64; C = (st & 1) * 32 + (swz % 64) / 2; }
__host__ __device__ __forceinline__ int perm32(int rho) { const int n = rho >> 4, i = rho & 15; return 8 * (i >> 2) + 4 * n + (i & 3); }

struct Unit { int pm, pn; };
struct Gemm { const bf16_t* A; const bf16_t* Bt; int M, N, K; };

struct StaticOrder {
    int nM, nN, nwg, G, c;
    __host__ __device__ void init(int M, int N, int G_, int c_) { nM = M / BM; nN = N / BM; nwg = nM * nN; G = G_; c = c_; }
    __host__ __device__ bool next(int i, Unit& u) const {
        const long L = (long)i * G + c; if (L >= nwg) return false;
        int wgid = (int)L; { const int q = nwg / NXCD, r = nwg % NXCD, xcd = wgid % NXCD, off = wgid / NXCD; wgid = (xcd < r ? xcd * (q + 1) : r * (q + 1) + (xcd - r) * q) + off; }
        const int nig = WGM * nN, gid = wgid / nig, fm = gid * WGM, gsz = (nM - fm) < WGM ? (nM - fm) : WGM;
        u.pm = fm + ((wgid % nig) % gsz); u.pn = (wgid % nig) / gsz; return true;
    }
    __device__ __forceinline__ void a_ready(const Unit&) const {}
    __device__ __forceinline__ void done(const Unit&) const {}
};
__device__ __forceinline__ unsigned cvt_pk_bf16(float lo, float hi) { unsigned r; asm volatile("v_cvt_pk_bf16_f32 %0, %1, %2" : "=v"(r) : "v"(lo), "v"(hi)); return r; }
typedef float f32x2 __attribute__((ext_vector_type(2)));
template <class Epi, class Sched, bool ALIGN_EPI = false, bool SP2 = false>
__device__ __forceinline__ void gemm_phase(PG8_LAS unsigned char* lds, const Gemm g, const Sched& S, const Epi& E) {
    const int tid = threadIdx.x, wid = __builtin_amdgcn_readfirstlane(tid >> 6), lane = tid & 63, wr = wid >> 2, wc = wid & 3, fr = lane & 15, fq = lane >> 4;
    const int K = g.K, nt = K / BK;
    unsigned voffA[2], voffB[2];
#pragma unroll
    for (int i = 0; i < 2; ++i) { int R, C; stage_rc(tid * 16 + i * 8192, R, C); const int Rb = Epi::PERM ? ((R & ~31) + perm32(R & 31)) : R;
        voffA[i] = (unsigned)(R * K + C) * 2u; voffB[i] = (unsigned)(Rb * K + C) * 2u; }
    const size_t kstep = (size_t)(BK * 2);
    const size_t hstep = (size_t)HALF * K * 2;
    const size_t tstep = 2 * hstep;
    const unsigned ldsw = (unsigned)wid * 1024u;
    const int aoff = lds_byte(wr * 64 + fr, fq * 8), boff = lds_byte(wc * 32 + fr, fq * 8);
#define PG8_SA(b, h) (((b) * 2 + (h)) * HTB)
#define PG8_SB(b, h) ((4 + (b) * 2 + (h)) * HTB)
#define PG8_STAGE(bufoff, gbase, voff) do { _Pragma("unroll") for (int _i = 0; _i < 2; ++_i) \
        __builtin_amdgcn_global_load_lds((const unsigned*)((const char*)(gbase) + (voff)[_i]), (PG8_LAS unsigned*)(lds + (bufoff) + ldsw + _i * 8192), 16, 0, 0); } while (0)
#define PG8_LDA(dst, b, h) do { _Pragma("unroll") for (int m = 0; m < 4; ++m) _Pragma("unroll") for (int k = 0; k < 2; ++k) dst[m][k] = *(const PG8_LAS bf16x8*)(lds + PG8_SA(b, h) + aoff + m * 2048 + k * 1024); } while (0)
#define PG8_LDB(dst, b, h) do { _Pragma("unroll") for (int n = 0; n < 2; ++n) _Pragma("unroll") for (int k = 0; k < 2; ++k) dst[n][k] = *(const PG8_LAS bf16x8*)(lds + PG8_SB(b, h) + boff + n * 2048 + k * 1024); } while (0)
#define PG8_MMA(ai, bj, At, Bt) do { __builtin_amdgcn_s_setprio(1); _Pragma("unroll") for (int m = 0; m < 4; ++m) _Pragma("unroll") for (int n = 0; n < 2; ++n) _Pragma("unroll") for (int k = 0; k < 2; ++k) \
        acc[ai][bj][m][n] = __builtin_amdgcn_mfma_f32_16x16x32_bf16(Bt[n][k], At[m][k], acc[ai][bj][m][n], 0, 0, 0); __builtin_amdgcn_s_setprio(0); } while (0)
#define PG8_WAIT_V(n) asm volatile("s_waitcnt vmcnt(" #n ")" ::: "memory")
#define PG8_WAIT_L(n) asm volatile("s_waitcnt lgkmcnt(" #n ")" ::: "memory")
#define PG8_BAR __builtin_amdgcn_s_barrier()
#define PG8_SCHED __builtin_amdgcn_sched_barrier(0)
    Unit cur, nxt; int ui = 0;
    if (!S.next(0, cur)) return;
    f32x4 acc[2][2][4][2];
#pragma unroll
    for (int a = 0; a < 2; ++a)
#pragma unroll
        for (int b = 0; b < 2; ++b)
#pragma unroll
            for (int m = 0; m < 4; ++m)
#pragma unroll
                for (int n = 0; n < 2; ++n) acc[a][b][m][n] = (f32x4){0.f, 0.f, 0.f, 0.f};
    bf16x8 At[4][2], B0[2][2], B1[2][2];
    const char* cA = (const char*)g.A + (size_t)cur.pm * tstep; const char* cB = (const char*)g.Bt + (size_t)cur.pn * tstep;
    S.a_ready(cur);
    if constexpr (SP2) {
        PG8_STAGE(PG8_SB(0, 0), cB, voffB); PG8_STAGE(PG8_SB(0, 1), cB + hstep, voffB); PG8_STAGE(PG8_SA(0, 0), cA, voffA); PG8_STAGE(PG8_SA(0, 1), cA + hstep, voffA);
        if (wr == 1) PG8_BAR;
        PG8_WAIT_V(2); PG8_BAR;
        PG8_STAGE(PG8_SB(1, 0), cB + kstep, voffB); PG8_STAGE(PG8_SA(1, 0), cA + kstep, voffA); PG8_STAGE(PG8_SB(1, 1), cB + hstep + kstep, voffB);
        PG8_WAIT_V(6); PG8_BAR;
    } else {
        PG8_STAGE(PG8_SB(0, 0), cB, voffB); PG8_STAGE(PG8_SA(0, 0), cA, voffA); PG8_STAGE(PG8_SB(0, 1), cB + hstep, voffB); PG8_STAGE(PG8_SA(0, 1), cA + hstep, voffA);
        if (wr == 1) PG8_BAR;
        PG8_WAIT_V(4); PG8_BAR;
        PG8_STAGE(PG8_SB(1, 0), cB + kstep, voffB); PG8_STAGE(PG8_SA(1, 0), cA + kstep, voffA); PG8_STAGE(PG8_SB(1, 1), cB + hstep + kstep, voffB);
        PG8_WAIT_V(6); PG8_BAR;
    }
    for (;;) {
        const bool has_next = S.next(ui + 1, nxt);
        const char* nA = has_next ? (const char*)g.A + (size_t)nxt.pm * tstep : cA; const char* nB = has_next ? (const char*)g.Bt + (size_t)nxt.pn * tstep : cB;
        for (int t = 0; t < nt; t += 2) {
            const bool last = (t == nt - 2);
            const char* a1 = cA + (size_t)(t + 1) * kstep;
            const char* a2 = last ? nA : cA + (size_t)(t + 2) * kstep; const char* b2 = last ? nB : cB + (size_t)(t + 2) * kstep;
            const char* a3 = a2 + kstep; const char* b3 = b2 + kstep;
            if (last && has_next) S.a_ready(nxt);
            if constexpr (SP2) {
            PG8_LDB(B0, 0, 0); PG8_LDB(B1, 0, 1); PG8_SCHED; PG8_LDA(At, 0, 0); PG8_STAGE(PG8_SA(1, 1), a1 + hstep, voffA);
            PG8_WAIT_V(8); PG8_WAIT_L(0); PG8_BAR; PG8_MMA(0, 0, At, B0); PG8_MMA(0, 1, At, B1); PG8_BAR; PG8_SCHED;
            PG8_LDA(At, 0, 1); PG8_STAGE(PG8_SB(0, 0), b2, voffB); PG8_STAGE(PG8_SB(0, 1), b2 + hstep, voffB); PG8_STAGE(PG8_SA(0, 0), a2, voffA);
            PG8_WAIT_V(8); PG8_WAIT_L(0); PG8_BAR; PG8_MMA(1, 0, At, B0); PG8_MMA(1, 1, At, B1); PG8_BAR; PG8_SCHED;
            PG8_LDB(B0, 1, 0); PG8_LDB(B1, 1, 1); PG8_SCHED; PG8_LDA(At, 1, 0); PG8_STAGE(PG8_SA(0, 1), a2 + hstep, voffA);
            PG8_WAIT_V(8); PG8_WAIT_L(0); PG8_BAR; PG8_MMA(0, 0, At, B0); PG8_MMA(0, 1, At, B1); PG8_BAR; PG8_SCHED;
            PG8_LDA(At, 1, 1); PG8_STAGE(PG8_SB(1, 0), b3, voffB); PG8_STAGE(PG8_SB(1, 1), b3 + hstep, voffB); PG8_STAGE(PG8_SA(1, 0), a3, voffA);
            PG8_WAIT_V(8); PG8_WAIT_L(0); PG8_BAR; PG8_MMA(1, 0, At, B0); PG8_MMA(1, 1, At, B1); PG8_BAR; PG8_SCHED;
            } else {
            PG8_LDB(B0, 0, 0); PG8_SCHED; PG8_LDA(At, 0, 0); PG8_STAGE(PG8_SA(1, 1), a1 + hstep, voffA);
            PG8_WAIT_L(8); PG8_BAR; PG8_WAIT_L(0); PG8_MMA(0, 0, At, B0); PG8_BAR; PG8_SCHED;
            PG8_LDB(B1, 0, 1); PG8_STAGE(PG8_SB(0, 0), b2, voffB);
            PG8_BAR; PG8_WAIT_L(0); PG8_MMA(0, 1, At, B1); PG8_BAR;
            PG8_LDA(At, 0, 1); PG8_STAGE(PG8_SA(0, 0), a2, voffA);
            PG8_BAR; PG8_WAIT_L(0); PG8_MMA(1, 0, At, B0); PG8_BAR; PG8_SCHED;
            PG8_STAGE(PG8_SB(0, 1), b2 + hstep, voffB);
            PG8_WAIT_V(6); PG8_BAR; PG8_MMA(1, 1, At, B1); PG8_BAR;
            PG8_LDB(B0, 1, 0); PG8_SCHED; PG8_LDA(At, 1, 0); PG8_STAGE(PG8_SA(0, 1), a2 + hstep, voffA);
            PG8_WAIT_L(8); PG8_BAR; PG8_WAIT_L(0); PG8_MMA(0, 0, At, B0); PG8_BAR; PG8_SCHED;
            PG8_LDB(B1, 1, 1); PG8_STAGE(PG8_SB(1, 0), b3, voffB);
            PG8_BAR; PG8_WAIT_L(0); PG8_MMA(0, 1, At, B1); PG8_BAR;
            PG8_LDA(At, 1, 1); PG8_STAGE(PG8_SA(1, 0), a3, voffA);
            PG8_BAR; PG8_WAIT_L(0); PG8_MMA(1, 0, At, B0); PG8_BAR; PG8_SCHED;
            PG8_STAGE(PG8_SB(1, 1), b3 + hstep, voffB);
            PG8_WAIT_V(6); PG8_BAR; PG8_MMA(1, 1, At, B1); PG8_BAR;
            }
        }
        if constexpr (ALIGN_EPI) { if (wr == 0) PG8_BAR; }
        if constexpr (!Epi::AFTER_DRAIN) { E(acc, cur, wr, wc, fr, fq); S.done(cur); }
        if (!has_next) break;
#pragma unroll
        for (int a = 0; a < 2; ++a)
#pragma unroll
            for (int b = 0; b < 2; ++b)
#pragma unroll
                for (int m = 0; m < 4; ++m)
#pragma unroll
                    for (int n = 0; n < 2; ++n) acc[a][b][m][n] = (f32x4){0.f, 0.f, 0.f, 0.f};
        cur = nxt; cA = nA; cB = nB; ++ui;
        if constexpr (ALIGN_EPI) { if (wr == 1) PG8_BAR; }
    }
    PG8_WAIT_V(0);
    if constexpr (!ALIGN_EPI) { if (wr == 0) PG8_BAR; }
    PG8_BAR;
    if constexpr (Epi::AFTER_DRAIN) { E.fused(acc, cur, wr, wc, fr, fq, lds, wid, lane); S.done(cur); }
#undef PG8_SA
#undef PG8_SB
#undef PG8_STAGE
#undef PG8_LDA
#undef PG8_LDB
#undef PG8_MMA
#undef PG8_WAIT_V
#undef PG8_WAIT_L
#undef PG8_BAR
#undef PG8_SCHED
}
}

namespace pg8 {
struct EpiScaleBf16 {
    static constexpr bool PERM = true, AFTER_DRAIN = false;
    bf16_t* O; int ldc; const float* scale_base; int scale_stride;
    __device__ __forceinline__ void operator()(const f32x4 (&acc)[2][2][4][2], const Unit& u, int wr, int wc, int fr, int fq) const {
        const int row0 = u.pm * BM + wr * 64 + fr, col0 = u.pn * BM + wc * 32 + 8 * fq;
        const float* sc = scale_base + (size_t)((u.pm * BM) >> 12) * scale_stride;
        f32x4 sv[2][2];
#pragma unroll
        for (int bj = 0; bj < 2; ++bj)
#pragma unroll
            for (int n = 0; n < 2; ++n) sv[bj][n] = *(const f32x4*)(sc + col0 + bj * HALF + 4 * n);
#pragma unroll
        for (int ai = 0; ai < 2; ++ai)
#pragma unroll
            for (int m = 0; m < 4; ++m) { bf16_t* rowp = O + (size_t)(row0 + ai * HALF + m * 16) * ldc + col0;
#pragma unroll
                for (int bj = 0; bj < 2; ++bj) { const f32x4 v0 = acc[ai][bj][m][0] * sv[bj][0], v1 = acc[ai][bj][m][1] * sv[bj][1];
                    u32x4 w; w.x = cvt_pk_bf16(v0[0], v0[1]); w.y = cvt_pk_bf16(v0[2], v0[3]); w.z = cvt_pk_bf16(v1[0], v1[1]); w.w = cvt_pk_bf16(v1[2], v1[3]);
                    *(u32x4*)(rowp + bj * HALF) = w; } }
    }
};
struct EpiIn {
    static constexpr bool PERM = true, AFTER_DRAIN = false;
    bf16_t* YG; bf16_t* U;
    __device__ __forceinline__ void operator()(const f32x4 (&acc)[2][2][4][2], const Unit& u, int wr, int wc, int fr, int fq) const {
        const bool isy = u.pn < 4;
        bf16_t* base = isy ? YG : U;
        const int row0 = u.pm * BM + wr * 64 + fr, col0 = (u.pn & 3) * BM + wc * 32 + 8 * fq;
#pragma unroll
        for (int ai = 0; ai < 2; ++ai)
#pragma unroll
            for (int m = 0; m < 4; ++m) { bf16_t* rowp = base + (size_t)(row0 + ai * HALF + m * 16) * 1024 + col0;
#pragma unroll
                for (int bj = 0; bj < 2; ++bj) { f32x4 v0 = acc[ai][bj][m][0], v1 = acc[ai][bj][m][1];
                    if (isy) { v0 = (f32x4){::gelu_tanh(v0[0]), ::gelu_tanh(v0[1]), ::gelu_tanh(v0[2]), ::gelu_tanh(v0[3])}; v1 = (f32x4){::gelu_tanh(v1[0]), ::gelu_tanh(v1[1]), ::gelu_tanh(v1[2]), ::gelu_tanh(v1[3])}; }
                    u32x4 w; w.x = cvt_pk_bf16(v0[0], v0[1]); w.y = cvt_pk_bf16(v0[2], v0[3]); w.z = cvt_pk_bf16(v1[0], v1[1]); w.w = cvt_pk_bf16(v1[2], v1[3]);
                    *(u32x4*)(rowp + bj * HALF) = w; } }
    }
};
struct EpiQKV {
    static constexpr bool PERM = false, AFTER_DRAIN = false;
    bf16_t* Q; bf16_t* Kb; bf16_t* VT; const PG8_LAS float* cs;
    __device__ __forceinline__ void operator()(const f32x4 (&acc)[2][2][4][2], const Unit& u, int wr, int wc, int fr, int fq) const {
        const int region = u.pn >> 2, pq = u.pn & 3;
        const bool isctx = u.pm >= NX / BM;
#pragma unroll
        for (int ai = 0; ai < 2; ++ai)
#pragma unroll
            for (int m = 0; m < 4; ++m) {
                const int row = u.pm * BM + ai * HALF + wr * 64 + m * 16 + fr;
                int b, pos;
                if (!isctx) { b = row >> 12; pos = row & 4095; } else { b = (row - NX) >> 8; pos = S + ((row - NX) & 255); }
                if (region < 2) {
                    const int p = (wc & 1) ? (pos & 63) : (pos >> 6);
                    const float scl = region == 0 ? QSCALE : 1.0f;
#pragma unroll
                    for (int bj = 0; bj < 2; ++bj) {
                        const int hi2 = 4 * pq + 2 * bj + (wc >> 1);
                        bf16_t* dst = region == 0 ? Q + ((size_t)(b * 16 + hi2) * S + pos) * 64 : Kb + ((size_t)(b * 16 + hi2) * KEYS + pos) * 64;
#pragma unroll
                        for (int n = 0; n < 2; ++n) {
                            f32x4 o = acc[ai][bj][m][n];
                            if (!isctx) {
                                const f32x4 pv = acc[ai][bj][m][n ^ 1];
#pragma unroll
                                for (int i = 0; i < 4; ++i) { const float c_ = cs[(p * 16 + fq * 4 + i) * 2], s_ = cs[(p * 16 + fq * 4 + i) * 2 + 1]; o[i] = o[i] * c_ + (n ? pv[i] : -pv[i]) * s_; }
                            }
                            typedef unsigned u32x2_ __attribute__((ext_vector_type(2)));
                            u32x2_ w; w.x = cvt_pk_bf16(o[0] * scl, o[1] * scl); w.y = cvt_pk_bf16(o[2] * scl, o[3] * scl);
                            *(u32x2_*)(dst + (wc & 1) * 32 + n * 16 + fq * 4) = w;
                        }
                    }
                } else {
                    const int ppos = (pos & ~12) | ((pos & 4) << 1) | ((pos & 8) >> 1);
#pragma unroll
                    for (int bj = 0; bj < 2; ++bj)
#pragma unroll
                        for (int n = 0; n < 2; ++n) {
                            const int h = 2 * pq + bj, vd = 32 * wc + 16 * n + 4 * fq;
                            bf16_t* vp = VT + ((size_t)(b * 8 + h) * 128 + vd) * KEYS + ppos;
                            const f32x4 v = acc[ai][bj][m][n];
                            const unsigned p01 = cvt_pk_bf16(v[0], v[1]), p23 = cvt_pk_bf16(v[2], v[3]);
                            vp[0] = (bf16_t)(p01 & 0xffffu); vp[KEYS] = (bf16_t)(p01 >> 16); vp[2 * KEYS] = (bf16_t)(p23 & 0xffffu); vp[3 * KEYS] = (bf16_t)(p23 >> 16);
                        }
                }
            }
    }
};
struct QkvOrder {
    StaticOrder so; int G, c;
    __host__ __device__ void init(int G_, int c_) { so.init(NX, 3 * D, G_, c_); G = G_; c = c_; }
    __host__ __device__ bool next(int i, Unit& u) const { return so.next(i, u); }
    __device__ __forceinline__ void a_ready(const Unit&) const {}
    __device__ __forceinline__ void done(const Unit&) const {}
};
struct MoeOrder {
    int G, c, nunits; const PG8_LAS int* pst;
    __device__ __forceinline__ bool next(int i, Unit& u) const {
        const int L = i * G + c; if (L >= nunits) return false;
        const int pm = L >> 2, m0 = pm * BM; int e = 0;
        for (int x = 1; x < 32; ++x) e = (pst[x] <= m0) ? x : e;
        u.pm = pm; u.pn = e * 4 + (L & 3); return true;
    }
    __device__ __forceinline__ void a_ready(const Unit&) const {}
    __device__ __forceinline__ void done(const Unit&) const {}
};
struct EpiY {
    static constexpr bool PERM = true, AFTER_DRAIN = false;
    bf16_t* Y;
    __device__ __forceinline__ void operator()(const f32x4 (&acc)[2][2][4][2], const Unit& u, int wr, int wc, int fr, int fq) const {
        const int row0 = u.pm * BM + wr * 64 + fr, col0 = (u.pn & 3) * BM + wc * 32 + 8 * fq;
#pragma unroll
        for (int ai = 0; ai < 2; ++ai)
#pragma unroll
            for (int m = 0; m < 4; ++m) { bf16_t* rowp = Y + (size_t)(row0 + ai * HALF + m * 16) * 1024 + col0;
#pragma unroll
                for (int bj = 0; bj < 2; ++bj) { const f32x4 v0 = acc[ai][bj][m][0], v1 = acc[ai][bj][m][1];
                    u32x4 w; w.x = cvt_pk_bf16(v0[0], v0[1]); w.y = cvt_pk_bf16(v0[2], v0[3]); w.z = cvt_pk_bf16(v1[0], v1[1]); w.w = cvt_pk_bf16(v1[2], v1[3]);
                    *(u32x4*)(rowp + bj * HALF) = w; } }
    }
};
}

__device__ __forceinline__ void phase_gemm_in(Frame& F) {
    pg8::Gemm g{(const pg8::bf16_t*)(F.ws + WS_H), (const pg8::bf16_t*)(F.ws + WS_WIN), NTOK, 2 * D, D};
    pg8::StaticOrder S; S.init(NTOK, 2 * D, F.G, (int)blockIdx.x);
    pg8::EpiIn E{(pg8::bf16_t*)(F.ws + WS_YG), (pg8::bf16_t*)(F.ws + WS_U)};
    pg8::gemm_phase<pg8::EpiIn, pg8::StaticOrder, true, true>((PG8_LAS unsigned char*)F.lds, g, S, E);
    if (blockIdx.x >= 32) tail_convert(F, ((int)blockIdx.x - 32) * NWAVES + F.wave, 0, ND_A);
}

__device__ __forceinline__ float neg_expm1(float x) {
    const float p = 1.0f + x * (0.5f + x * (0.16666667f + x * (0.041666668f + x * (0.0083333338f + x * 0.0013888889f))));
    const float ser = -x * p, big = 1.0f - __expf(x);
    return x > -0.5f ? ser : big;
}
__device__ __forceinline__ void phase_scan(Frame& F) {
    const Args& A = *F.a;
    const int wi = F.vcu;
    if (wi >= 256) return;
    const int b = wi >> 6, n = (wi >> 3) & 7, d = (wi >> 2) & 1, q = wi & 3;
    const int tid = F.tid, lane = F.lane, w = F.wave, fr = lane & 15, fq = lane >> 4;
    LAS char* RAW = F.lds;
    LAS char* AT = F.lds + 33792;
    LAS float* AGG = (LAS float*)(F.lds + 66560);
    LAS float* CIN = (LAS float*)(F.lds + 74752);
    const bf16* U = (const bf16*)(F.ws + WS_U);
    bf16* HO = (bf16*)(F.ws + (d ? WS_HB : WS_HF));
    const int chbase = n * 128, och = chbase + q * 32;
    const bf16* GT = (const bf16*)(F.ws + WS_GATE);
    LAS char* BT = F.lds + 81920;
#pragma unroll
    for (int i = 0; i < 2; ++i) {
        const int idx = tid + 512 * i, jrow = idx >> 4, c = idx & 15, nb = jrow >> 4, f2 = jrow & 15;
        *(LAS u32x4*)(BT + jrow * 256 + ((c ^ f2) << 4)) = *(const u32x4*)(GT + ((size_t)(((d * 2 + (nb >> 1)) * 8 + n) * 128 + q * 32 + (nb & 1) * 16 + f2)) * 128 + c * 8);
    }
    float ba[2], bi[2], sp8[2];
#pragma unroll
    for (int h = 0; h < 2; ++h) {
        const int ch = och + h * 16 + fr;
        ba[h] = A.in[I_GAB][d * 1024 + ch]; bi[h] = A.in[I_GXB][d * 1024 + ch];
        sp8[h] = 8.0f * log1pf(expf(-A.in[I_LAM][d * 1024 + ch]));
    }
    const int c8 = tid & 15, r0 = tid >> 4;
    LAS float* CW = (LAS float*)(F.lds + 78848);
    (void)CW;
    float cw[4][8], cb[8];
#pragma unroll
    for (int k = 0; k < 4; ++k) {
        const f32x4 a0 = *(const f32x4*)(A.in[I_CONVW] + k * 1024 + chbase + c8 * 8), a1 = *(const f32x4*)(A.in[I_CONVW] + k * 1024 + chbase + c8 * 8 + 4);
        cw[k][0] = a0.x; cw[k][1] = a0.y; cw[k][2] = a0.z; cw[k][3] = a0.w; cw[k][4] = a1.x; cw[k][5] = a1.y; cw[k][6] = a1.z; cw[k][7] = a1.w;
    }
    { const f32x4 a0 = *(const f32x4*)(A.in[I_CONVB] + chbase + c8 * 8), a1 = *(const f32x4*)(A.in[I_CONVB] + chbase + c8 * 8 + 4);
      cb[0] = a0.x; cb[1] = a0.y; cb[2] = a0.z; cb[3] = a0.w; cb[4] = a1.x; cb[5] = a1.y; cb[6] = a1.z; cb[7] = a1.w; }

    float hcar = 0.f;
    u32x4 pre[5];
    LAS float* cscr = (LAS float*)(F.lds + 98304 + w * 4224);
    const int cgw = F.vcu * NWAVES + w, CNGW = F.G * NWAVES;
    int cit = ND_B + cgw;
    TDesc cd2; f32x4 crg2[4]; bool chas2 = false;
    for (int step = 0; step < 34; ++step) {
        TDesc cd; f32x4 crg[4]; const bool chas = cit < ND_SCAN;
        if (chas) { cd = decode_deferred(F, cit); tr2_load(cd, lane, crg); cit += CNGW; }
        int segbase, seglen, tile;
        if (step < 2) { segbase = NX + b * CL; seglen = CL; tile = d ? (1 - step) : step; }
        else { segbase = b * S; seglen = S; tile = d ? (33 - step) : (step - 2); }
        const int t0 = tile * 128;
        if (step == 0) {
#pragma unroll
            for (int i = 0; i < 5; ++i) {
                const int idx = tid + 512 * i; const int row = idx >> 4, c = idx & 15; const int t = t0 - 2 + row;
                u32x4 v = (u32x4){0u, 0u, 0u, 0u};
                if (idx < 2112 && t >= 0 && t < seglen) v = *(const u32x4*)(U + (size_t)(segbase + t) * D + chbase + c * 8);
                pre[i] = v;
            }
        }
#pragma unroll
        for (int i = 0; i < 5; ++i) { const int idx = tid + 512 * i; if (idx < 2112) *(LAS u32x4*)(RAW + idx * 16) = pre[i]; }
        __syncthreads();
        if (step + 1 < 34) {
            const int s1 = step + 1; int sb1, sl1, tl1;
            if (s1 < 2) { sb1 = NX + b * CL; sl1 = CL; tl1 = d ? (1 - s1) : s1; }
            else { sb1 = b * S; sl1 = S; tl1 = d ? (33 - s1) : (s1 - 2); }
            const int t1 = tl1 * 128;
#pragma unroll
            for (int i = 0; i < 5; ++i) {
                const int idx = tid + 512 * i; const int row = idx >> 4, c = idx & 15; const int t = t1 - 2 + row;
                u32x4 v = (u32x4){0u, 0u, 0u, 0u};
                if (idx < 2112 && t >= 0 && t < sl1) v = *(const u32x4*)(U + (size_t)(sb1 + t) * D + chbase + c * 8);
                pre[i] = v;
            }
        }
#pragma unroll
        for (int i = 0; i < 4; ++i) {
            const int r = r0 + 32 * i;
            float o[8];
#pragma unroll
            for (int j = 0; j < 8; ++j) o[j] = cb[j];
#pragma unroll
            for (int k = 0; k < 4; ++k) {
                const u32x4 x = *(const LAS u32x4*)(RAW + (r + k) * 256 + c8 * 16);
#pragma unroll
                for (int p = 0; p < 4; ++p) { o[2 * p] += cw[k][2 * p] * bflo(x[p]); o[2 * p + 1] += cw[k][2 * p + 1] * bfhi(x[p]); }
            }
            u32x4 ov; ov.x = pk2(o[0], o[1]); ov.y = pk2(o[2], o[3]); ov.z = pk2(o[4], o[5]); ov.w = pk2(o[6], o[7]);
            *(LAS u32x4*)(AT + r * 256 + ((c8 ^ (r & 15)) << 4)) = ov;
        }
        __syncthreads();
        f32x4 acc[4];
#pragma unroll
        for (int nb = 0; nb < 4; ++nb) acc[nb] = (f32x4){0.f, 0.f, 0.f, 0.f};
#pragma unroll
        for (int ks = 0; ks < 4; ++ks) {
            const int row = 16 * w + fr;
            const bf16x8 af = *(const LAS bf16x8*)(AT + row * 256 + (((4 * ks + fq) ^ fr) << 4));
#pragma unroll
            for (int nb = 0; nb < 4; ++nb) {
                const bf16x8 bq = *(const LAS bf16x8*)(BT + (nb * 16 + fr) * 256 + (((4 * ks + fq) ^ fr) << 4));
                acc[nb] = __builtin_amdgcn_mfma_f32_16x16x32_bf16(af, bq, acc[nb], 0, 0, 0);
            }
        }
        float av[2][4], bv[2][4];
#pragma unroll
        for (int h = 0; h < 2; ++h) {
            const int col = q * 32 + h * 16 + fr, chunk = col >> 3, within = col & 7;
#pragma unroll
            for (int reg = 0; reg < 4; ++reg) {
                const int tr = 16 * w + 4 * fq + reg;
                const float r_ = __builtin_amdgcn_rcpf(1.0f + __builtin_amdgcn_exp2f(-1.4426950408889634f * (acc[h][reg] + ba[h])));
                const float i_ = __builtin_amdgcn_rcpf(1.0f + __builtin_amdgcn_exp2f(-1.4426950408889634f * (acc[2 + h][reg] + bi[h])));
                const float la = -sp8[h] * r_;
                const float a_ = __builtin_amdgcn_exp2f(1.4426950408889634f * la);
                const unsigned short ub = *(const LAS unsigned short*)(AT + tr * 256 + ((chunk ^ (tr & 15)) << 4) + within * 2);
                const float uval = __builtin_bit_cast(float, (unsigned)ub << 16);
                av[h][reg] = a_;
                bv[h][reg] = __builtin_amdgcn_sqrtf(neg_expm1(2.0f * la)) * (i_ * uval);
            }
        }
        const int g = 4 * w + fq;
#pragma unroll
        for (int h = 0; h < 2; ++h) {
            float P = 1.f, Hh = 0.f;
#pragma unroll
            for (int s = 0; s < 4; ++s) { const int reg = d ? (3 - s) : s; Hh = av[h][reg] * Hh + bv[h][reg]; P *= av[h][reg]; }
            AGG[(g * 32 + h * 16 + fr) * 2 + 0] = P; AGG[(g * 32 + h * 16 + fr) * 2 + 1] = Hh;
        }
        if (chas2) tr2_finish(cd2, lane, crg2, cscr);
        chas2 = cit < ND_SCAN;
        if (chas2) { cd2 = decode_deferred(F, cit); tr2_load(cd2, lane, crg2); cit += CNGW; }
        __syncthreads();
        if (tid < 32) {
            f32x2 ag[32];
#pragma unroll
            for (int gi = 0; gi < 32; ++gi) ag[gi] = *(const LAS f32x2*)(AGG + (gi * 32 + tid) * 2);
            float hh = hcar;
            if (d == 0) {
#pragma unroll
                for (int gi = 0; gi < 32; ++gi) { CIN[gi * 32 + tid] = hh; hh = ag[gi].x * hh + ag[gi].y; }
            } else {
#pragma unroll
                for (int gi = 31; gi >= 0; --gi) { CIN[gi * 32 + tid] = hh; hh = ag[gi].x * hh + ag[gi].y; }
            }
            hcar = hh;
        }
        __syncthreads();
#pragma unroll
        for (int h = 0; h < 2; ++h) {
            float hh = CIN[g * 32 + h * 16 + fr];
            float outv[4];
#pragma unroll
            for (int s = 0; s < 4; ++s) { const int reg = d ? (3 - s) : s; hh = av[h][reg] * hh + bv[h][reg]; outv[reg] = hh; }
#pragma unroll
            for (int reg = 0; reg < 4; ++reg) {
                const int tr = 16 * w + 4 * fq + reg;
                HO[(size_t)(segbase + t0 + tr) * D + och + h * 16 + fr] = (bf16)f2bf(outv[reg]);
            }
        }
        if (chas) tr2_finish(cd, lane, crg, cscr);
    }
    if (chas2) tr2_finish(cd2, lane, crg2, cscr);
}

__device__ __forceinline__ void phase_combine_h(Frame& F) {
    const u32x4* hf = (const u32x4*)(F.ws + WS_HF); const u32x4* hb = (const u32x4*)(F.ws + WS_HB); const u32x4* yg = (const u32x4*)(F.ws + WS_YG);
    u32x4* hc = (u32x4*)(F.ws + WS_U);
    constexpr int NCH = NTOK * (D / 8);
    const int stride = F.G * NTHREADS;
    for (int i = F.vcu * NTHREADS + F.tid; i < NCH; i += 4 * stride) {
        u32x4 a[4], b[4], y[4];
#pragma unroll
        for (int j = 0; j < 4; ++j) { const int idx = i + j * stride; if (idx < NCH) { a[j] = hf[idx]; b[j] = hb[idx]; y[j] = yg[idx]; } }
#pragma unroll
        for (int j = 0; j < 4; ++j) {
            const int idx = i + j * stride;
            if (idx < NCH) {
                u32x4 r;
#pragma unroll
                for (int q = 0; q < 4; ++q) r[q] = pk2((bflo(a[j][q]) + bflo(b[j][q])) * bflo(y[j][q]), (bfhi(a[j][q]) + bfhi(b[j][q])) * bfhi(y[j][q]));
                hc[idx] = r;
            }
        }
    }
}
__device__ __forceinline__ void phase_gemm_out0(Frame& F) {
    const Args& A = *F.a;
    const bf16* W = (const bf16*)(F.ws + WS_WOUT);
    const bf16* HC = (const bf16*)(F.ws + WS_U);
    float* XA = (float*)(F.ws + WS_XA);
    const int wr = F.wave >> 2, wc = F.wave & 3, fr = F.lane & 15, fq = F.lane >> 4;
    constexpr int NTN = 4, NUNITS = (NTOK / 128) * NTN;
    ALDense al, alN; const bf16* Bp = W; const bf16* BpN = W; Ring R;
    if (F.vcu < NUNITS) { al.init(HC, D, (F.vcu / NTN) * 128, F.tid >> 3, (F.tid >> 3) + 64, dma_kc(F.tid)); Bp = W + (size_t)((F.vcu % NTN) * 256) * D; ring_start(F, R, al, Bp, D); }
    for (int u = F.vcu; u < NUNITS; u += F.G) {
        const int mt = u / NTN, nt = u % NTN, m0 = mt * 128, n0 = nt * 256;
        const int un = u + F.G; const bool hasN = un < NUNITS;
        alN = al; BpN = Bp;
        if (hasN) { alN.init(HC, D, (un / NTN) * 128, F.tid >> 3, (F.tid >> 3) + 64, dma_kc(F.tid)); BpN = W + (size_t)((un % NTN) * 256) * D; }
        f32x4 acc[4][4];
        gemm3_unit<false, 16>(F, R, al, Bp, alN, BpN, hasN, D, acc, u == F.vcu);
        al = alN; Bp = BpN;
        {
            const float* gate = modp(F, 0, cond_of(m0), 2);
            const float* srcb = m0 < NX ? A.in[I_X] + (size_t)m0 * D : A.in[I_CTX] + (size_t)(m0 - NX) * D;
            f32x4 sres[4][4], gt[4];
#pragma unroll
            for (int ni = 0; ni < 4; ++ni) gt[ni] = *(const f32x4*)(gate + n0 + wc * 64 + ni * 16 + fq * 4);
#pragma unroll
            for (int mi = 0; mi < 4; ++mi)
#pragma unroll
                for (int ni = 0; ni < 4; ++ni) sres[mi][ni] = *(const f32x4*)(srcb + (size_t)(wr * 64 + mi * 16 + fr) * D + n0 + wc * 64 + ni * 16 + fq * 4);
#pragma unroll
            for (int mi = 0; mi < 4; ++mi)
#pragma unroll
                for (int ni = 0; ni < 4; ++ni) *(f32x4*)(XA + (size_t)(m0 + wr * 64 + mi * 16 + fr) * D + n0 + wc * 64 + ni * 16 + fq * 4) = sres[mi][ni] + gt[ni] * acc[mi][ni];
        }
    }
    __syncthreads();
    if (F.vcu >= 32) tail_convert(F, (F.vcu - 32) * NWAVES + F.wave, ND_A, ND_B);
}

__device__ __forceinline__ void route_select(const Frame& F, float (&acc)[32], float rbias, int row, LAS int* selL, int li) {
    const int lane = F.lane;
#define BFLY(S, HALF) { const bool up = (lane >> (S)) & 1; _Pragma("unroll") for (int i = 0; i < (HALF); ++i) { \
        const float keep = up ? acc[i + (HALF)] : acc[i]; const float send = up ? acc[i] : acc[i + (HALF)]; acc[i] = keep + __shfl_xor(send, 1 << (S)); } }
    BFLY(0, 16) BFLY(1, 8) BFLY(2, 4) BFLY(3, 2) BFLY(4, 1)
#undef BFLY
    const float tot = acc[0] + __shfl_xor(acc[0], 32);
    const int e = lane & 31;
    const float logit = __shfl(tot, (int)(__builtin_bitreverse32((unsigned)e) >> 27));
    const float sc = 1.0f / (1.0f + expf(-logit));
    const float ss = sc + rbias;
    float m1 = ss;
#pragma unroll
    for (int o = 1; o < 8; o <<= 1) m1 = fmaxf(m1, __shfl_xor(m1, o));
    int i1 = (ss == m1) ? e : 64;
#pragma unroll
    for (int o = 1; o < 8; o <<= 1) i1 = min(i1, __shfl_xor(i1, o));
    const float s2 = (e == i1) ? -INFINITY : ss;
    float m2 = s2;
#pragma unroll
    for (int o = 1; o < 8; o <<= 1) m2 = fmaxf(m2, __shfl_xor(m2, o));
    int i2 = (s2 == m2 && e != i1) ? e : 64;
#pragma unroll
    for (int o = 1; o < 8; o <<= 1) i2 = min(i2, __shfl_xor(i2, o));
    const float gs = m1 + m2;
    float gbest = gs;
    gbest = fmaxf(gbest, __shfl_xor(gbest, 8)); gbest = fmaxf(gbest, __shfl_xor(gbest, 16));
    int gsel = (gs == gbest) ? (e >> 3) : 64;
    gsel = min(gsel, __shfl_xor(gsel, 8)); gsel = min(gsel, __shfl_xor(gsel, 16));
    const int e0 = __shfl(i1, gsel * 8) & 31, e1 = __shfl(i2, gsel * 8) & 31;
    const float w0 = __shfl(sc, e0), w1 = __shfl(sc, e1);
    if (lane == 0) {
        const float inv = 1.0f / (w0 + w1);
        LAS int* cntL = selL + 4 * 68; LAS int* rankL = selL + 2 * 68;
        selL[li * 2] = e0; selL[li * 2 + 1] = e1;
        rankL[li * 2] = __hip_atomic_fetch_add(cntL + e0, 1, __ATOMIC_RELAXED, __HIP_MEMORY_SCOPE_WORKGROUP);
        rankL[li * 2 + 1] = __hip_atomic_fetch_add(cntL + e1, 1, __ATOMIC_RELAXED, __HIP_MEMORY_SCOPE_WORKGROUP);
        ((float2*)(F.ws + WS_WT))[row] = make_float2(w0 * inv, w1 * inv);
        ((int2*)(F.ws + WS_SEL))[row] = make_int2(e0, e1);
    }
}

template <int LAYER>
__device__ __forceinline__ void phase_route(Frame& F) {
    const Args& A = *F.a;
    constexpr int NT = LAYER == 0 ? NTOK : NX;
    constexpr int PER = NT / 256;
    LAS char* RW = F.lds;
    LAS int* selL = (LAS int*)(F.lds + LDS_AUX);
    LAS int* rankL = selL + 2 * 68;
    const int tid = F.tid, lane = F.lane;
    if (tid < 32) (selL + 4 * 68)[tid] = 0;
    {
        f32x4 t[16];
#pragma unroll
        for (int i = 0; i < 16; ++i) { const int idx = tid + 512 * i; t[i] = *(const f32x4*)(A.in[I_RW] + (size_t)(idx >> 3) * 32 + (idx & 7) * 4); }
#pragma unroll
        for (int i = 0; i < 16; ++i) {
            const int idx = tid + 512 * i, k = idx >> 3, e4 = idx & 7;
            const int rho = (((k >> 8) * 4 + (k & 3)) << 6) + ((k >> 2) & 63);
            *(LAS f32x4*)(RW + rho * 128 + ((e4 ^ ((rho >> 1) & 7)) << 4)) = t[i];
        }
    }
    __syncthreads();
    const int blk = F.vcu;
    if (blk < 256) {
        const float* XA = (const float*)(F.ws + WS_XA);
        bf16* H = (bf16*)(F.ws + WS_H);
        const float rbias = A.in[I_RB][lane & 31];
        f32x4 na[4], nb[4];
        load_row4(XA + (size_t)(blk * PER + 2 * F.wave) * D, lane, na); load_row4(XA + (size_t)(blk * PER + 2 * F.wave + 1) * D, lane, nb);
        for (int pi = F.wave; pi < PER / 2; pi += NWAVES) {
            const int li = 2 * pi, row = blk * PER + li;
            const int c = cond_of(row);
            f32x4 va[4], vb[4];
#pragma unroll
            for (int j = 0; j < 4; ++j) { va[j] = na[j]; vb[j] = nb[j]; }
            if constexpr (LAYER == 1) {
                const bf16* dl = (const bf16*)(F.ws + WS_DELTA) + (size_t)row * D;
#pragma unroll
                for (int j = 0; j < 4; ++j) {
                    const u32x2 d0 = *(const u32x2*)(dl + 4 * lane + 256 * j), d1 = *(const u32x2*)(dl + D + 4 * lane + 256 * j);
                    va[j] += (f32x4){bflo(d0.x), bfhi(d0.x), bflo(d0.y), bfhi(d0.y)}; vb[j] += (f32x4){bflo(d1.x), bfhi(d1.x), bflo(d1.y), bfhi(d1.y)};
                }
            }
            if (pi + NWAVES < PER / 2) { load_row4(XA + (size_t)(row + 2 * NWAVES) * D, lane, na); load_row4(XA + (size_t)(row + 2 * NWAVES + 1) * D, lane, nb); }
            const float ra = row_rstd(va), rb = row_rstd(vb);
            if constexpr (LAYER == 1 && L1_FP8) {
                row_modulate_store8(va, ra, A.in[I_N2G] + LAYER * D, modp(F, LAYER, c, 4), modp(F, LAYER, c, 3), (unsigned char*)H + (size_t)row * D, lane);
                row_modulate_store8(vb, rb, A.in[I_N2G] + LAYER * D, modp(F, LAYER, c, 4), modp(F, LAYER, c, 3), (unsigned char*)H + (size_t)(row + 1) * D, lane);
            } else {
                row_modulate_store(va, ra, A.in[I_N2G] + LAYER * D, modp(F, LAYER, c, 4), modp(F, LAYER, c, 3), H + (size_t)row * D, lane);
                row_modulate_store(vb, rb, A.in[I_N2G] + LAYER * D, modp(F, LAYER, c, 4), modp(F, LAYER, c, 3), H + (size_t)(row + 1) * D, lane);
            }
            float acca[32], accb[32];
#pragma unroll
            for (int e = 0; e < 32; ++e) { acca[e] = 0.f; accb[e] = 0.f; }
#pragma unroll 1
            for (int jc = 0; jc < 16; ++jc) {
                const int j = jc >> 2, cc = jc & 3;
                f32x4 ha4 = va[0], hb4 = vb[0];
                if (j == 1) { ha4 = va[1]; hb4 = vb[1]; }
                if (j == 2) { ha4 = va[2]; hb4 = vb[2]; }
                if (j == 3) { ha4 = va[3]; hb4 = vb[3]; }
                float ha = ha4.x, hb = hb4.x;
                if (cc == 1) { ha = ha4.y; hb = hb4.y; }
                if (cc == 2) { ha = ha4.z; hb = hb4.z; }
                if (cc == 3) { ha = ha4.w; hb = hb4.w; }
                const int rho = jc * 64 + lane;
                const LAS char* rp = RW + rho * 128; const int key = (rho >> 1) & 7;
                f32x4 w8[8];
#pragma unroll
                for (int e4 = 0; e4 < 8; ++e4) w8[e4] = *(const LAS f32x4*)(rp + ((e4 ^ key) << 4));
#pragma unroll
                for (int e4 = 0; e4 < 8; ++e4) {
                    acca[e4 * 4 + 0] += ha * w8[e4].x; acca[e4 * 4 + 1] += ha * w8[e4].y; acca[e4 * 4 + 2] += ha * w8[e4].z; acca[e4 * 4 + 3] += ha * w8[e4].w;
                    accb[e4 * 4 + 0] += hb * w8[e4].x; accb[e4 * 4 + 1] += hb * w8[e4].y; accb[e4 * 4 + 2] += hb * w8[e4].z; accb[e4 * 4 + 3] += hb * w8[e4].w;
                }
            }
            route_select(F, acca, rbias, row, selL, li);
            route_select(F, accb, rbias, row + 1, selL, li + 1);
        }
        __syncthreads();
        if (tid < 32) ((int*)(F.ws + WS_BLKCNT))[blk * 32 + tid] = (selL + 4 * 68)[tid];
        __syncthreads();
        for (int i = tid; i < PER; i += NTHREADS) ((int2*)(F.ws + WS_LRANK))[blk * PER + i] = make_int2(rankL[2 * i], rankL[2 * i + 1]);
    }
}

template <int LAYER>
__device__ __forceinline__ void phase_slots(Frame& F) {
    constexpr int NT = LAYER == 0 ? NTOK : NX;
    constexpr int PER = NT / 256;
    LAS int* part = (LAS int*)F.lds;
    LAS int* tot = part + 1024;
    LAS int* base = tot + 32;
    LAS int* pst = base + 32;
    const int tid = F.tid, blk = F.vcu;
    const int* bc = (const int*)(F.ws + WS_BLKCNT);
    {
        const int e = tid & 31, p = tid >> 5;
        int st = 0, sb = 0;
        for (int b2 = p; b2 < 256; b2 += 16) { const int c = bc[b2 * 32 + e]; st += c; sb += (b2 < blk) ? c : 0; }
        part[p * 32 + e] = st; part[512 + p * 32 + e] = sb;
    }
    __syncthreads();
    if (tid < 32) { int st = 0, sb = 0; for (int p = 0; p < 16; ++p) { st += part[p * 32 + tid]; sb += part[512 + p * 32 + tid]; } tot[tid] = st; base[tid] = sb; }
    __syncthreads();
    constexpr int PADM = (LAYER == 0) ? 255 : 127;
    if (tid == 0) { int s = 0; for (int e = 0; e < 32; ++e) { pst[e] = s; s += (tot[e] + PADM) & ~PADM; } pst[32] = s; }
    __syncthreads();
    int* slot_tok = (int*)(F.ws + WS_SLOTTOK); float* slot_w = (float*)(F.ws + WS_SLOTW);
    if (blk == 0 && tid < 33) ((int*)(F.ws + WS_PSTART))[tid] = pst[tid];
    if (blk < 256) {
        for (int i = tid; i < PER; i += NTHREADS) {
            const int t = blk * PER + i;
            const int2 se = ((const int2*)(F.ws + WS_SEL))[t]; const int2 lr = ((const int2*)(F.ws + WS_LRANK))[t]; const float2 wt = ((const float2*)(F.ws + WS_WT))[t];
            const int s0 = pst[se.x] + base[se.x] + lr.x, s1 = pst[se.y] + base[se.y] + lr.y;
            slot_tok[s0] = t; slot_w[s0] = wt.x; slot_tok[s1] = t; slot_w[s1] = wt.y;
            ((int2*)(F.ws + WS_TOKSLOT))[t] = make_int2(s0, s1);
        }
    }
    if (blk < 32) {
        const int lo = pst[blk] + tot[blk], hi = pst[blk + 1];
        for (int s = lo + tid; s < hi; s += NTHREADS) { slot_tok[s] = 0; slot_w[s] = 0.f; }
    }
}

template <int LAYER>
__device__ __forceinline__ void phase_moe_up(Frame& F) {
    constexpr bool F8 = (LAYER == 1) && L1_FP8;
    constexpr int KA = F8 ? D / 2 : D;
    LAS int* pst = (LAS int*)(F.lds + LDS_AUX);
    if (F.tid < 33) pst[F.tid] = ((const int*)(F.ws + WS_PSTART))[F.tid];
    __syncthreads();
    const int ntiles = pst[32] >> 7, nunits = ntiles * 4;
    const bf16* H = (const bf16*)(F.ws + WS_H);
    const bf16* W = F8 ? (const bf16*)(F.ws + WS_WUP + (size_t)64 * MiB) : (const bf16*)(F.ws + WS_WUP) + (size_t)LAYER * 32 * 1024 * 1024;
    const int* slot_tok = (const int*)(F.ws + WS_SLOTTOK); const float* slot_w = (const float*)(F.ws + WS_SLOTW);
    bf16* G = (bf16*)(F.ws + WS_G);
    const int wr = F.wave >> 2, wc = F.wave & 3, fr = F.lane & 15, fq = F.lane >> 4;
    LAS int* tix = pst + 64;
    for (int i = F.tid; i < 8 * 128; i += NTHREADS) { const int uu = F.vcu + (i >> 7) * F.G; tix[i] = (uu < nunits) ? slot_tok[(uu >> 2) * 128 + (i & 127)] : 0; }
    __syncthreads();
    ALGather al, alN; const bf16* Bp = W; const bf16* BpN = W; Ring R;
#define MOE_SETUP(uu, ui, al_, Bp_) do { const int m0_ = ((uu) >> 2) * 128; int e_ = 0; \
        for (int x = 1; x < 32; ++x) e_ = (pst[x] <= m0_) ? x : e_; \
        al_.p0 = H + (size_t)tix[(ui) * 128 + (F.tid >> 3)] * KA + dma_kc(F.tid); al_.p1 = H + (size_t)tix[(ui) * 128 + (F.tid >> 3) + 64] * KA + dma_kc(F.tid); \
        Bp_ = W + ((size_t)e_ * 1024 + ((uu) & 3) * 256) * KA; } while (0)
    if (F.vcu < nunits) { MOE_SETUP(F.vcu, 0, al, Bp); ring_start(F, R, al, Bp, KA); }
    int ui = 0;
    for (int u = F.vcu; u < nunits; u += F.G, ++ui) {
        const int mt = u >> 2, j = u & 3, m0 = mt * 128;
        const int un = u + F.G; const bool hasN = un < nunits;
        alN = al; BpN = Bp;
        if (hasN) MOE_SETUP(un, ui + 1, alN, BpN);
        f32x4 acc[4][4];
        if constexpr (F8) gemm3_unit<true, 8>(F, R, al, Bp, alN, BpN, hasN, KA, acc, u == F.vcu, FP8_SCALE_W, FP8_SCALE_ONE);
        else gemm3_unit<false, 8>(F, R, al, Bp, alN, BpN, hasN, KA, acc, u == F.vcu);
        al = alN; Bp = BpN;
#pragma unroll
        for (int mi = 0; mi < 4; ++mi) {
            const int row = m0 + wr * 64 + mi * 16 + fr;
            const float wgt = slot_w[row];
#pragma unroll
            for (int p = 0; p < 2; ++p) {
                const f32x4 g = acc[mi][2 * p], uu = acc[mi][2 * p + 1];
                float o[4];
#pragma unroll
                for (int c = 0; c < 4; ++c) o[c] = g[c] / (1.0f + __expf(-g[c])) * uu[c] * wgt;
                if constexpr (F8) {
#pragma unroll
                    for (int c = 0; c < 4; ++c) o[c] = fminf(fmaxf(o[c] * 8.0f, -448.0f), 448.0f);
                    *(unsigned*)((unsigned char*)G + (size_t)row * DEXP + j * 128 + wc * 32 + p * 16 + fq * 4) = pk4_fp8(o[0], o[1], o[2], o[3]);
                } else {
                    u32x2 ov; ov.x = pk2(o[0], o[1]); ov.y = pk2(o[2], o[3]);
                    *(u32x2*)(G + (size_t)row * DEXP + j * 128 + wc * 32 + p * 16 + fq * 4) = ov;
                }
            }
        }
    }
}

template <int LAYER>
__device__ __forceinline__ void phase_moe_down(Frame& F) {
    constexpr bool F8 = (LAYER == 1) && L1_FP8;
    constexpr int KA = F8 ? DEXP / 2 : DEXP;
    LAS int* pst = (LAS int*)(F.lds + LDS_AUX);
    if (F.tid < 33) pst[F.tid] = ((const int*)(F.ws + WS_PSTART))[F.tid];
    __syncthreads();
    const int ntiles = pst[32] >> 7, nunits = ntiles * 4;
    const bf16* G = (const bf16*)(F.ws + WS_G);
    const bf16* W = F8 ? (const bf16*)(F.ws + WS_WDN + (size_t)32 * MiB) : (const bf16*)(F.ws + WS_WDN) + (size_t)LAYER * 32 * 1024 * 512;
    bf16* Y = (bf16*)(F.ws + WS_Y);
    if constexpr (LAYER == 0) {
        pg8::Gemm g{(const pg8::bf16_t*)G, (const pg8::bf16_t*)W, PMAX, 32 * 1024, DEXP};
        pg8::MoeOrder S{F.G, F.vcu, (pst[32] >> 8) * 4, (const PG8_LAS int*)pst};
        pg8::EpiY E{(pg8::bf16_t*)Y};
        pg8::gemm_phase<pg8::EpiY, pg8::MoeOrder, true, true>((PG8_LAS unsigned char*)F.lds, g, S, E);
        return;
    }
    const int wr = F.wave >> 2, wc = F.wave & 3, fr = F.lane & 15, fq = F.lane >> 4;
    ALDense al, alN; const bf16* Bp = W; const bf16* BpN = W; Ring R;
#define MOED_SETUP(uu, al_, Bp_) do { const int m0_ = ((uu) >> 2) * 128; int e_ = 0; \
        for (int x = 1; x < 32; ++x) e_ = (pst[x] <= m0_) ? x : e_; \
        al_.init(G, KA, m0_, F.tid >> 3, (F.tid >> 3) + 64, dma_kc(F.tid)); Bp_ = W + ((size_t)e_ * 1024 + ((uu) & 3) * 256) * KA; } while (0)
    if (F.vcu < nunits) { MOED_SETUP(F.vcu, al, Bp); ring_start(F, R, al, Bp, KA); }
    for (int u = F.vcu; u < nunits; u += F.G) {
        const int mt = u >> 2, j = u & 3, m0 = mt * 128, n0 = j * 256;
        const int un = u + F.G; const bool hasN = un < nunits;
        alN = al; BpN = Bp;
        if (hasN) MOED_SETUP(un, alN, BpN);
        f32x4 acc[4][4];
        if constexpr (F8) gemm3_unit<true, 16>(F, R, al, Bp, alN, BpN, hasN, KA, acc, u == F.vcu, FP8_SCALE_W, FP8_SCALE_G);
        else gemm3_unit<false, 16>(F, R, al, Bp, alN, BpN, hasN, KA, acc, u == F.vcu);
        al = alN; Bp = BpN;
#pragma unroll
        for (int mi = 0; mi < 4; ++mi) {
            const int row = m0 + wr * 64 + mi * 16 + fr;
#pragma unroll
            for (int ni = 0; ni < 4; ++ni) {
                const f32x4 v = acc[mi][ni];
                u32x2 o; o.x = pk2(v.x, v.y); o.y = pk2(v.z, v.w);
                *(u32x2*)(Y + (size_t)row * D + n0 + wc * 64 + ni * 16 + fq * 4) = o;
            }
        }
    }
}

struct CRow { f32x4 x[4]; u32x2 y0[4], y1[4]; };
__device__ __forceinline__ void crow_load(const Frame& F, int row, int2 ts, CRow& r) {
    const float* XA = (const float*)(F.ws + WS_XA); const bf16* Y = (const bf16*)(F.ws + WS_Y);
#pragma unroll
    for (int j = 0; j < 4; ++j) {
        const int c0 = 4 * F.lane + 256 * j;
        r.x[j] = *(const f32x4*)(XA + (size_t)row * D + c0);
        r.y0[j] = *(const u32x2*)(Y + (size_t)ts.x * D + c0); r.y1[j] = *(const u32x2*)(Y + (size_t)ts.y * D + c0);
    }
}
__device__ __forceinline__ void crow_combine(const Frame& F, const CRow& r, const float* gate, f32x4 (&v)[4]) {
#pragma unroll
    for (int j = 0; j < 4; ++j) {
        const int c0 = 4 * F.lane + 256 * j;
        const f32x4 gt = *(const f32x4*)(gate + c0);
        f32x4 y; y.x = bflo(r.y0[j].x) + bflo(r.y1[j].x); y.y = bfhi(r.y0[j].x) + bfhi(r.y1[j].x); y.z = bflo(r.y0[j].y) + bflo(r.y1[j].y); y.w = bfhi(r.y0[j].y) + bfhi(r.y1[j].y);
        v[j] = r.x[j] + gt * y;
    }
}

__device__ __forceinline__ void phase_combine0(Frame& F) {
    const Args& A = *F.a;
    const int gw = F.vcu * NWAVES + F.wave, NGW = F.G * NWAVES;
    float* XA = (float*)(F.ws + WS_XA); bf16* H = (bf16*)(F.ws + WS_H);
    const int2* TS = (const int2*)(F.ws + WS_TOKSLOT);
    CRow cn; int2 tsn = make_int2(0, 0);
    if (gw < NTOK) crow_load(F, gw, TS[gw], cn);
    if (gw + NGW < NTOK) tsn = TS[gw + NGW];
    for (int row = gw; row < NTOK; row += NGW) {
        const int c = cond_of(row);
        const CRow cr = cn;
        const int nr = row + NGW;
        if (nr < NTOK) crow_load(F, nr, tsn, cn);
        if (nr + NGW < NTOK) tsn = TS[nr + NGW];
        f32x4 v[4];
        crow_combine(F, cr, modp(F, 0, c, 5), v);
#pragma unroll
        for (int j = 0; j < 4; ++j) *(f32x4*)(XA + (size_t)row * D + 4 * F.lane + 256 * j) = v[j];
        const float rstd = row_rstd(v);
        row_modulate_store(v, rstd, A.in[I_N1G] + D, modp(F, 1, c, 1), modp(F, 1, c, 0), H + (size_t)row * D, F.lane);
    }
}

__device__ __forceinline__ void phase_qkv(Frame& F) {
    LAS float* CS = (LAS float*)(F.lds + LDS_AUX);
    for (int i = F.tid; i < 1024; i += NTHREADS) {
        const int p = i >> 4, f = i & 15;
        const float inv = 1.0f / powf(10000.0f, (float)f / 16.0f);
        const float ang = (float)p * inv;
        const double rev = (double)ang * 0.15915494309189535;
        const float fr_ = (float)(rev - floor(rev));
        CS[i * 2] = __builtin_amdgcn_cosf(fr_); CS[i * 2 + 1] = __builtin_amdgcn_sinf(fr_);
    }
    __syncthreads();
    pg8::Gemm g{(const pg8::bf16_t*)(F.ws + WS_H), (const pg8::bf16_t*)(F.ws + WS_WQKV), NX, 3 * D, D};
    pg8::QkvOrder S; S.init(F.G, (int)blockIdx.x);
    pg8::EpiQKV E{(pg8::bf16_t*)(F.ws + WS_Q), (pg8::bf16_t*)(F.ws + WS_K), (pg8::bf16_t*)(F.ws + WS_VT), (const PG8_LAS float*)CS};
    pg8::gemm_phase<pg8::EpiQKV, pg8::QkvOrder, true, true>((PG8_LAS unsigned char*)F.lds, g, S, E);
    {
        const bf16* H = (const bf16*)(F.ws + WS_H); const bf16* W = (const bf16*)(F.ws + WS_WQKV);
        bf16* Kb = (bf16*)(F.ws + WS_K); bf16* VT = (bf16*)(F.ws + WS_VT);
        const int wr = F.wave >> 2, wc = F.wave & 3, fr = F.lane & 15, fq = F.lane >> 4;
        constexpr int NCU = (NC / 128) * 16;
        ALDense al, alN; const bf16* Bp = W; const bf16* BpN = W; Ring R;
#define QC_SETUP(vv, al_, Bp_) do { al_.init(H, D, NX + ((vv) >> 4) * 128, F.tid >> 3, (F.tid >> 3) + 64, dma_kc(F.tid)); Bp_ = W + (size_t)(1024 + ((vv) & 15) * 128) * D; } while (0)
        if (F.vcu < NCU) { QC_SETUP(F.vcu, al, Bp); ringn_start(F, R, al, Bp, D); }
        for (int v = F.vcu; v < NCU; v += F.G) {
            const int mt = v >> 4, nt = v & 15, m0 = NX + mt * 128;
            const int vn = v + F.G; const bool hasN = vn < NCU;
            alN = al; BpN = Bp;
            if (hasN) QC_SETUP(vn, alN, BpN);
            f32x4 acc[4][2];
            gemm3n_unit<16>(F, R, al, Bp, alN, BpN, hasN, D, acc, v == F.vcu);
            al = alN; Bp = BpN;
#pragma unroll
            for (int mi = 0; mi < 4; ++mi) {
                const int row = m0 + wr * 64 + mi * 16 + fr;
                const int b = (row - NX) >> 8, pos = ::S + ((row - NX) & 255);
                if (nt < 8) {
                    const int hi2 = nt * 2 + (wc >> 1);
                    bf16* dst = Kb + ((size_t)(b * 16 + hi2) * KEYS + pos) * 64 + (wc & 1) * 32;
#pragma unroll
                    for (int ni = 0; ni < 2; ++ni) { const f32x4 o = acc[mi][ni]; u32x2 ov; ov.x = pk2(o.x, o.y); ov.y = pk2(o.z, o.w); *(u32x2*)(dst + ni * 16 + fq * 4) = ov; }
                } else {
                    const int ppos = (pos & ~12) | ((pos & 4) << 1) | ((pos & 8) >> 1);
#pragma unroll
                    for (int ni = 0; ni < 2; ++ni) {
                        const int vd = wc * 32 + ni * 16 + fq * 4;
                        bf16* vp = VT + ((size_t)(b * 8 + (nt - 8)) * 128 + vd) * KEYS + ppos;
                        const f32x4 o = acc[mi][ni];
                        const unsigned p01 = pk2(o.x, o.y), p23 = pk2(o.z, o.w);
                        vp[0] = (bf16)(p01 & 0xffffu); vp[KEYS] = (bf16)(p01 >> 16); vp[2 * KEYS] = (bf16)(p23 & 0xffffu); vp[3 * KEYS] = (bf16)(p23 >> 16);
                    }
                }
            }
        }
#undef QC_SETUP
    }
}

constexpr int ATT_STAGE = 32768;
__device__ __forceinline__ int crow(int r, int hi) { return (r & 3) + 8 * (r >> 2) + 4 * hi; }
__device__ __forceinline__ void phase_attn(Frame& F) {
    const Args& A = *F.a;
    const int tid = F.tid, lane = F.lane, w = F.wave, r32 = lane & 31, hi = lane >> 5;
    const int mp = w >> 2, wq = w & 3;
    LAS char* lds = F.lds;
    float lam;
    { const float* dl = A.in[I_DALAM]; const float s1 = wave_sum(dl[lane] * dl[64 + lane]), s2 = wave_sum(dl[128 + lane] * dl[192 + lane]);
      lam = expf(s1) - expf(s2) + (0.8f - 0.6f * expf(-0.3f)); }
    const float oscale = 1.0f - (0.8f - 0.6f * expf(-0.3f));
    const bf16* Q = (const bf16*)(F.ws + WS_Q); const bf16* Kb = (const bf16*)(F.ws + WS_K); const bf16* VT = (const bf16*)(F.ws + WS_VT);
    bf16* AO = (bf16*)(F.ws + WS_AO);
    constexpr int NUNITS = NB * 8 * (S / 128), NTILES = KEYS / 64;
    LAS char* cbuf = lds + 65536 + w * 4096;
    const int cgw = F.vcu * NWAVES + w, CNGW = F.G * NWAVES;
    int cit = cgw; bool chas = cit < ND_ATTN;
    if (chas) { const TDesc cd = L1_FP8 ? decode_moe8(F, cit) : decode_moe(F, cit, 1); tr3_dma(cd, lane, cbuf); }
    for (int u = F.vcu; u < NUNITS; u += F.G) {
        const int bh = u >> 5, qb = u & 31, q0 = qb * 128;
        const bf16* Kg[2]; Kg[0] = Kb + (size_t)(bh * 2 + 0) * KEYS * 64; Kg[1] = Kb + (size_t)(bh * 2 + 1) * KEYS * 64;
        const bf16* Vg = VT + (size_t)bh * 128 * KEYS;
        LAS char* qlds = lds + 98304 + w * 4096;
        { const bf16* qp = Q + ((size_t)(bh * 2 + mp) * S + q0 + wq * 32 + r32) * 64 + hi * 8;
#pragma unroll
          for (int ks = 0; ks < 4; ++ks) __builtin_amdgcn_global_load_lds((const unsigned*)(qp + ks * 16), (LAS unsigned*)(qlds + ks * 1024), 16, 0, 0); }
        f32x16 o[4];
#pragma unroll
        for (int vb = 0; vb < 4; ++vb)
#pragma unroll
            for (int r = 0; r < 16; ++r) o[vb][r] = 0.f;
        float mrun = 0.f, lrun = 0.f;
        const int drow = w * 8 + (lane >> 3), dch = ((lane & 7) ^ ((drow >> 1) & 7)) * 8;
        const bf16* gk0 = Kg[0] + (size_t)drow * 64 + dch; const bf16* gk1 = Kg[1] + (size_t)drow * 64 + dch;
        const bf16* gv0 = Vg + (size_t)drow * KEYS + dch; const bf16* gv1 = Vg + (size_t)(64 + drow) * KEYS + dch;
#define ATT_DMA(t_, st_) do { LAS char* sb_ = lds + (st_) * ATT_STAGE + w * 1024; \
            __builtin_amdgcn_global_load_lds((const unsigned*)(gk0 + (size_t)(t_) * 64 * 64), (LAS unsigned*)(sb_), 16, 0, 0); \
            __builtin_amdgcn_global_load_lds((const unsigned*)(gk1 + (size_t)(t_) * 64 * 64), (LAS unsigned*)(sb_ + 8192), 16, 0, 0); \
            __builtin_amdgcn_global_load_lds((const unsigned*)(gv0 + (t_) * 64), (LAS unsigned*)(sb_ + 16384), 16, 0, 0); \
            __builtin_amdgcn_global_load_lds((const unsigned*)(gv1 + (t_) * 64), (LAS unsigned*)(sb_ + 16384 + 8192), 16, 0, 0); } while (0)
        ATT_DMA(0, 0);
        __syncthreads();
        for (int t = 0; t < NTILES; ++t) {
            const int st = t & 1;
            if (t + 1 < NTILES) ATT_DMA(t + 1, st ^ 1);
            const LAS char* Kt = lds + st * ATT_STAGE + mp * 8192;
            const LAS char* Vt = lds + st * ATT_STAGE + 16384;
            f32x16 s0, s1;
            { const float nm = -mrun;
#pragma unroll
              for (int r = 0; r < 16; ++r) { s0[r] = nm; s1[r] = nm; } }
            bf16x8 kf[8], qf[4];
#pragma unroll
            for (int ks = 0; ks < 4; ++ks) qf[ks] = *(const LAS bf16x8*)(qlds + ks * 1024 + lane * 16);
#pragma unroll
            for (int ks = 0; ks < 4; ++ks) {
                kf[2 * ks] = *(const LAS bf16x8*)(Kt + swz128(r32, 2 * ks + hi));
                kf[2 * ks + 1] = *(const LAS bf16x8*)(Kt + swz128(32 + r32, 2 * ks + hi));
            }
            u32x4 vf[2][4];
#define VLOAD(dst, vb_) do { const int vrow_ = (vb_) * 32 + r32; _Pragma("unroll") for (int kk_ = 0; kk_ < 4; ++kk_) \
                dst[kk_] = *(const LAS u32x4*)(Vt + swz128(vrow_, 2 * kk_ + hi)); } while (0)
            VLOAD(vf[0], 0);
            __builtin_amdgcn_sched_barrier(0);

#pragma unroll
            for (int ks = 0; ks < 4; ++ks) {
                s0 = __builtin_amdgcn_mfma_f32_32x32x16_bf16(kf[2 * ks], qf[ks], s0, 0, 0, 0);
                s1 = __builtin_amdgcn_mfma_f32_32x32x16_bf16(kf[2 * ks + 1], qf[ks], s1, 0, 0, 0);
            }

            float mx = fmaxf(s0[0], s1[0]);
#pragma unroll
            for (int r = 1; r < 16; ++r) mx = fmaxf(mx, fmaxf(s0[r], s1[r]));
            { const auto rr = __builtin_amdgcn_permlane32_swap(__builtin_bit_cast(unsigned, mx), __builtin_bit_cast(unsigned, mx), false, false);
              mx = fmaxf(__builtin_bit_cast(float, rr[0]), __builtin_bit_cast(float, rr[1])); }
            if (t == 0 || __any(mx > 8.0f)) {
                const float dl = (t == 0) ? mx : fmaxf(mx, 0.f);
                mrun += dl;
#pragma unroll
                for (int r = 0; r < 16; ++r) { s0[r] -= dl; s1[r] -= dl; }
                if (t > 0) {
                    const float f = __builtin_amdgcn_exp2f(-dl);
                    lrun *= f;
#pragma unroll
                    for (int vb = 0; vb < 4; ++vb)
#pragma unroll
                        for (int r = 0; r < 16; ++r) o[vb][r] *= f;
                }
            }
            float psum = 0.f;
#pragma unroll
            for (int r = 0; r < 16; ++r) { s0[r] = __builtin_amdgcn_exp2f(s0[r]); s1[r] = __builtin_amdgcn_exp2f(s1[r]); psum += s0[r] + s1[r]; }
            lrun += psum;
            bf16x8 pf[4];
#pragma unroll
            for (int s = 0; s < 2; ++s) {
                u32x4 a, b2;
                a.x = pk2(s0[8 * s + 0], s0[8 * s + 1]); a.y = pk2(s0[8 * s + 2], s0[8 * s + 3]); a.z = pk2(s0[8 * s + 4], s0[8 * s + 5]); a.w = pk2(s0[8 * s + 6], s0[8 * s + 7]);
                b2.x = pk2(s1[8 * s + 0], s1[8 * s + 1]); b2.y = pk2(s1[8 * s + 2], s1[8 * s + 3]); b2.z = pk2(s1[8 * s + 4], s1[8 * s + 5]); b2.w = pk2(s1[8 * s + 6], s1[8 * s + 7]);
                pf[s] = __builtin_bit_cast(bf16x8, a); pf[2 + s] = __builtin_bit_cast(bf16x8, b2);
            }
#pragma unroll
            for (int vb = 0; vb < 4; ++vb) {
                if (vb + 1 < 4) VLOAD(vf[(vb + 1) & 1], vb + 1);
                __builtin_amdgcn_sched_barrier(0);

#pragma unroll
                for (int kk = 0; kk < 4; ++kk)
                    o[vb] = __builtin_amdgcn_mfma_f32_32x32x16_bf16(__builtin_bit_cast(bf16x8, vf[vb & 1][kk]), pf[kk], o[vb], 0, 0, 0);

            }
#undef VLOAD
            __syncthreads();
            if ((t % 11) == 5 && chas) {
                asm volatile("s_waitcnt vmcnt(0)" ::: "memory");
                { if (L1_FP8) { const TDesc cd = decode_moe8(F, cit); tr3_finish_fp8(cd, lane, cbuf); } else { const TDesc cd = decode_moe(F, cit, 1); tr3_finish(cd, lane, cbuf); } }
                LDS_WAIT();
                cit += CNGW; chas = cit < ND_ATTN;
                if (chas) { const TDesc cd = L1_FP8 ? decode_moe8(F, cit) : decode_moe(F, cit, 1); tr3_dma(cd, lane, cbuf); }
            }
        }
#undef ATT_DMA
        lrun += __shfl_xor(lrun, 32);
        const float linv = 1.0f / lrun;
        LAS float* XO = (LAS float*)lds;
        if (mp == 1) {
#pragma unroll
            for (int vb = 0; vb < 4; ++vb)
#pragma unroll
                for (int r = 0; r < 16; ++r) XO[(wq * 64 + vb * 16 + r) * 64 + lane] = o[vb][r] * linv;
        }
        __syncthreads();
        if (mp == 0) {
            float ssq = 0.f;
#pragma unroll
            for (int vb = 0; vb < 4; ++vb)
#pragma unroll
                for (int r = 0; r < 16; ++r) { const float v = o[vb][r] * linv - lam * XO[(wq * 64 + vb * 16 + r) * 64 + lane]; o[vb][r] = v; ssq += v * v; }
            ssq += __shfl_xor(ssq, 32);
            const float rstd = rsqrtf(ssq * (1.0f / 128.0f) + EPS) * oscale;
            const int b = bh >> 3, h = bh & 7;
            bf16* dst = AO + (size_t)(b * S + q0 + wq * 32 + r32) * D + h * 128;
            const float* sg = A.in[I_SUBLN];
#pragma unroll
            for (int vb = 0; vb < 4; ++vb)
#pragma unroll
                for (int rq = 0; rq < 4; ++rq) {
                    const int v0 = vb * 32 + 8 * rq + 4 * hi;
                    const f32x4 g4 = *(const f32x4*)(sg + v0);
                    u32x2 ov; ov.x = pk2(o[vb][4 * rq] * rstd * g4.x, o[vb][4 * rq + 1] * rstd * g4.y); ov.y = pk2(o[vb][4 * rq + 2] * rstd * g4.z, o[vb][4 * rq + 3] * rstd * g4.w);
                    *(u32x2*)(dst + v0) = ov;
                }
        }
        __syncthreads();
    }
    while (chas) {
        asm volatile("s_waitcnt vmcnt(0)" ::: "memory");
        { if (L1_FP8) { const TDesc cd = decode_moe8(F, cit); tr3_finish_fp8(cd, lane, cbuf); } else { const TDesc cd = decode_moe(F, cit, 1); tr3_finish(cd, lane, cbuf); } }
        LDS_WAIT();
        cit += CNGW; chas = cit < ND_ATTN;
        if (chas) { const TDesc cd = L1_FP8 ? decode_moe8(F, cit) : decode_moe(F, cit, 1); tr3_dma(cd, lane, cbuf); }
    }
}

__device__ __forceinline__ void phase_gemm_wo(Frame& F) {
    pg8::Gemm g{(const pg8::bf16_t*)(F.ws + WS_AO), (const pg8::bf16_t*)(F.ws + WS_WO), NX, D, D};
    pg8::StaticOrder S; S.init(NX, D, F.G, (int)blockIdx.x);
    pg8::EpiScaleBf16 E{(pg8::bf16_t*)(F.ws + WS_DELTA), D, modp(F, 1, 0, 2), 6144};
    pg8::gemm_phase<pg8::EpiScaleBf16, pg8::StaticOrder, true, true>((PG8_LAS unsigned char*)F.lds, g, S, E);
}

__device__ __forceinline__ void phase_final(Frame& F) {
    const Args& A = *F.a;
    const int gw = F.vcu * NWAVES + F.wave, NGW = F.G * NWAVES;
    const int2* TS = (const int2*)(F.ws + WS_TOKSLOT);
    CRow cn; int2 tsn = make_int2(0, 0);
    if (gw < NX) crow_load(F, gw, TS[gw], cn);
    if (gw + NGW < NX) tsn = TS[gw + NGW];
    for (int row = gw; row < NX; row += NGW) {
        const CRow cr = cn;
        const int nr = row + NGW;
        if (nr < NX) crow_load(F, nr, tsn, cn);
        if (nr + NGW < NX) tsn = TS[nr + NGW];
        f32x4 v[4];
        crow_combine(F, cr, modp(F, 1, row >> 12, 5), v);
        { const bf16* dl = (const bf16*)(F.ws + WS_DELTA) + (size_t)row * D;
#pragma unroll
          for (int j = 0; j < 4; ++j) { const u32x2 d0 = *(const u32x2*)(dl + 4 * F.lane + 256 * j); v[j] += (f32x4){bflo(d0.x), bfhi(d0.x), bflo(d0.y), bfhi(d0.y)}; } }
        const float rstd = row_rstd(v);
#pragma unroll
        for (int j = 0; j < 4; ++j) {
            const int c0 = 4 * F.lane + 256 * j;
            const f32x4 g = *(const f32x4*)(A.in[I_FG] + c0);
            *(f32x4*)(A.out + (size_t)row * D + c0) = (v[j] * rstd) * g;
        }
    }
}

__global__ void __launch_bounds__(NTHREADS) fwd_kernel(Args args) {
    extern __shared__ __attribute__((aligned(16))) unsigned char smem[];
    Frame F;
    F.lds = (LAS char*)smem;
    F.tid = threadIdx.x; F.lane = F.tid & 63; F.wave = __builtin_amdgcn_readfirstlane(F.tid >> 6);
    F.G = gridDim.x; { const int bx = blockIdx.x; F.vcu = (F.G % 8 == 0) ? (bx % 8) * (F.G / 8) + bx / 8 : bx; }
    F.a = &args; F.ws = args.ws;
    volatile LAS unsigned* xbw = (volatile LAS unsigned*)(F.lds + LDS_XB);
    if (F.tid < 4) xbw[F.tid] = 0u;
    __syncthreads();
    XcdBarrier bar; bar.bar = (unsigned*)(F.ws + WS_CTL); bar.x = 0; bar.st = xbw;
    const int lo = args.ph_lo, hi = args.ph_hi;
    const bool multi = (hi - lo) > 1;
    if (multi) bar = xcd_barrier_post((unsigned*)(F.ws + WS_CTL), xbw);
#ifdef PROBE_PHASE
    unsigned long long pt0 = 0, pt1 = 0;
#define RUN_PHASE(k, call) do { if (lo <= (k) && (k) < hi) { if ((k) == PROBE_PHASE) pt0 = __builtin_amdgcn_s_memrealtime(); call; if ((k) + 1 < hi) xcd_barrier(bar); if ((k) == PROBE_PHASE) pt1 = __builtin_amdgcn_s_memrealtime(); } } while (0)
#else
#define RUN_PHASE(k, call) do { if (lo <= (k) && (k) < hi) { call; if ((k) + 1 < hi) xcd_barrier(bar); } } while (0)
#endif
    RUN_PHASE(0, phase_convert(F));
    RUN_PHASE(1, phase_prep0(F));
    RUN_PHASE(2, phase_gemm_in(F));
    RUN_PHASE(3, phase_scan(F));
    RUN_PHASE(4, (phase_combine_h(F), xcd_barrier(bar), phase_gemm_out0(F)));
    RUN_PHASE(5, phase_route<0>(F));
    RUN_PHASE(6, phase_slots<0>(F));
    RUN_PHASE(7, phase_moe_up<0>(F));
    RUN_PHASE(8, phase_moe_down<0>(F));
    RUN_PHASE(9, phase_combine0(F));
    RUN_PHASE(10, phase_qkv(F));
    RUN_PHASE(11, phase_attn(F));
    RUN_PHASE(12, phase_gemm_wo(F));
    RUN_PHASE(13, phase_route<1>(F));
    RUN_PHASE(14, phase_slots<1>(F));
    RUN_PHASE(15, phase_moe_up<1>(F));
    RUN_PHASE(16, phase_moe_down<1>(F));
    RUN_PHASE(17, phase_final(F));
#undef RUN_PHASE
#ifdef PROBE_PHASE
    xcd_barrier(bar);
    if (blockIdx.x == 0 && F.tid == 0) args.out[0] = 40.0f + floorf((float)(pt1 - pt0) * 0.001f + 0.5f);
#endif
}

extern "C" void kernel_launch(void* const* d_in, const int* in_sizes, int n_in, void* d_out, int out_size, void* d_ws, size_t ws_size, hipStream_t stream) {
    static int grid = 0;
    if (grid == 0) {
        if (n_in != 27 || out_size != NX * D || ws_size < WS_END) { fprintf(stderr, "kernel_launch: unexpected shapes (n_in %d out %d ws %zu)\n", n_in, out_size, ws_size); grid = -1; return; }
        int dev = 0, cus = 0;
        if (hipGetDevice(&dev) != hipSuccess || hipDeviceGetAttribute(&cus, hipDeviceAttributeMultiprocessorCount, dev) != hipSuccess) { grid = -1; return; }
        if (hipFuncSetAttribute((const void*)fwd_kernel, hipFuncAttributeMaxDynamicSharedMemorySize, LDS_BYTES) != hipSuccess) { fprintf(stderr, "kernel_launch: hipFuncSetAttribute failed\n"); grid = -1; return; }
        (void)hipGetLastError();
        grid = cus < 256 ? cus : 256;
    }
    if (grid < 0) return;
    (void)hipMemsetAsync((char*)d_ws + WS_CTL, 0, CTL_ZERO_BYTES, stream);
    Args a{};
    for (int i = 0; i < 27; ++i) a.in[i] = (const float*)d_in[i];
    a.out = (float*)d_out; a.ws = (unsigned char*)d_ws;
    if (MK_N_LAUNCHES == 1) {
        a.ph_lo = 0; a.ph_hi = NPHASES;
        hipLaunchKernelGGL(fwd_kernel, dim3(grid), dim3(NTHREADS), LDS_BYTES, stream, a);
    } else {
        if (DBG_NPH == 0) { a.ph_lo = 0; a.ph_hi = 0; hipLaunchKernelGGL(fwd_kernel, dim3(grid), dim3(NTHREADS), LDS_BYTES, stream, a); }
        for (int p = 0; p < DBG_NPH; ++p) { a.ph_lo = p; a.ph_hi = p + 1; hipLaunchKernelGGL(fwd_kernel, dim3(grid), dim3(NTHREADS), LDS_BYTES, stream, a); }
    }
}
```

```cpp
#include <hip/hip_runtime.h>
#include <cstdio>
#include <cstdint>

#ifndef MK_N_LAUNCHES
#define MK_N_LAUNCHES 1
#endif

#ifndef DBG_NPH
#define DBG_NPH 18
#endif
#define LAS __attribute__((address_space(3)))
typedef unsigned short bf16;
typedef short bf16x8 __attribute__((ext_vector_type(8)));
typedef float f32x4 __attribute__((ext_vector_type(4)));
typedef float f32x16 __attribute__((ext_vector_type(16)));
typedef unsigned u32x4 __attribute__((ext_vector_type(4)));
typedef unsigned u32x2 __attribute__((ext_vector_type(2)));
typedef float f32x2 __attribute__((ext_vector_type(2)));

constexpr int D = 1024, NB = 4, S = 4096, CL = 256;
constexpr int NX = NB * S, NC = NB * CL, NTOK = NX + NC;
constexpr int NEXP = 32, DEXP = 512;
constexpr int NWAVES = 8, NTHREADS = 512;
constexpr int KEYS = S + CL;
constexpr float EPS = 1e-6f;
constexpr int PMAX = 43008;
constexpr int NPHASES = 18;
constexpr float QSCALE = 0.125f * 1.4426950408889634f;

constexpr size_t MiB = 1u << 20;
constexpr size_t WS_CTL = 0, CTL_ZERO_BYTES = 64 * 1024;
constexpr size_t WS_MOD = 1 * MiB;
constexpr size_t WS_SEL = 2 * MiB;
constexpr size_t WS_WT = WS_SEL + 256 * 1024;
constexpr size_t WS_LRANK = WS_WT + 256 * 1024;
constexpr size_t WS_TOKSLOT = WS_LRANK + 256 * 1024;
constexpr size_t WS_BLKCNT = WS_TOKSLOT + 256 * 1024;
constexpr size_t WS_PSTART = WS_BLKCNT + 64 * 1024;
constexpr size_t WS_SLOTTOK = 3 * MiB + 512 * 1024;
constexpr size_t WS_SLOTW = WS_SLOTTOK + 256 * 1024;
constexpr size_t WS_WIN = 4 * MiB;
constexpr size_t WS_WOUT = 8 * MiB;
constexpr size_t WS_GATE = 10 * MiB;
constexpr size_t WS_WQKV = 11 * MiB;
constexpr size_t WS_WO = 17 * MiB;
constexpr size_t WS_WUP = 20 * MiB;
constexpr size_t WS_WDN = 148 * MiB;
constexpr size_t WS_XA = 212 * MiB;
constexpr size_t WS_H = 280 * MiB;
constexpr size_t WS_R = 314 * MiB;
constexpr size_t WS_YG = WS_R, WS_U = WS_R + 34 * MiB, WS_HF = WS_R + 68 * MiB, WS_HB = WS_R + 102 * MiB;
constexpr size_t WS_G = WS_R, WS_Y = WS_R + 42 * MiB;
constexpr size_t WS_Q = WS_R, WS_K = WS_R + 32 * MiB, WS_VT = WS_R + 66 * MiB, WS_AO = WS_R + 100 * MiB;
constexpr size_t WS_DELTA = 450 * MiB;
constexpr size_t WS_END = 482 * MiB;
static_assert(WS_Y + (size_t)PMAX * 1024 * 2 <= WS_END && WS_HB + 34 * MiB <= WS_END && WS_AO + 32 * MiB <= WS_END, "ws map");
static_assert(WS_K + (size_t)NB * 8 * 2 * KEYS * 64 * 2 <= WS_VT && WS_VT + (size_t)NB * 8 * 128 * KEYS * 2 <= WS_AO, "attn map");

constexpr int LDS_BYTES = 163840;
constexpr int LDS_XB = LDS_BYTES - 64;
constexpr int LDS_AUX = 147456;

__device__ __forceinline__ unsigned f2bf(float f) { unsigned u = __builtin_bit_cast(unsigned, f); return (u + 0x7fffu + ((u >> 16) & 1u)) >> 16; }
#ifndef L0_FP8
#define L0_FP8 1
#endif
#ifndef L1_FP8
#define L1_FP8 1
#endif
typedef int i32x8 __attribute__((ext_vector_type(8)));
__device__ __forceinline__ unsigned pk4_fp8(float a, float b, float c, float d) { int w = 0; w = __builtin_amdgcn_cvt_pk_fp8_f32(a, b, w, false); w = __builtin_amdgcn_cvt_pk_fp8_f32(c, d, w, true); return (unsigned)w; }
constexpr int FP8_SCALE_ONE = 0x7f7f7f7f, FP8_SCALE_W = 0x7a7a7a7a  , FP8_SCALE_G = 0x7c7c7c7c  ;
typedef __bf16 bf16x2_t __attribute__((ext_vector_type(2)));
__device__ __forceinline__ unsigned pk2(float lo, float hi) { const f32x2 v = {lo, hi}; const bf16x2_t b = __builtin_convertvector(v, bf16x2_t); return __builtin_bit_cast(unsigned, b); }
__device__ __forceinline__ float bflo(unsigned w) { return __builtin_bit_cast(float, w << 16); }
__device__ __forceinline__ float bfhi(unsigned w) { return __builtin_bit_cast(float, w & 0xffff0000u); }
__device__ __forceinline__ float wave_sum(float v) {
#pragma unroll
    for (int o = 1; o < 64; o <<= 1) v += __shfl_xor(v, o);
    return v;
}
__device__ __forceinline__ float sigmoidf_(float x) { return 1.0f / (1.0f + __expf(-x)); }
#define LDS_WAIT() asm volatile("s_waitcnt lgkmcnt(0)" ::: "memory")

#define XB_TMO      128
#define XB_XCNT(j)  (256  + 64 * (j))
#define XB_XSUB(j)  (1280 + 64 * (j))
#define XB_XGEN(j)  (2304 + 64 * (j))
#define XB_TOP      3328
#define XB_TOPGEN   3392
#define XCD_BAR_WORDS 3456
#define XB_SPIN_CAP (1u << 18)
__device__ __forceinline__ unsigned xb_ld(unsigned* p)              { return __hip_atomic_load(p, __ATOMIC_RELAXED, __HIP_MEMORY_SCOPE_AGENT); }
__device__ __forceinline__ unsigned xb_add(unsigned* p, unsigned v) { return __hip_atomic_fetch_add(p, v, __ATOMIC_RELAXED, __HIP_MEMORY_SCOPE_AGENT); }
__device__ __forceinline__ unsigned xb_xcc_id() { return (unsigned)__builtin_amdgcn_s_getreg((3 << 11) | 20) & 0xFu; }
#define XB_SPIN(cond, bar) do { unsigned _sp = 0; while (cond) { __builtin_amdgcn_s_sleep(1); \
    if ((++_sp & 255u) == 0u) { if (xb_ld(&(bar)[XB_TMO])) break; if (_sp > XB_SPIN_CAP) { atomicAdd(&(bar)[XB_TMO], 1u); break; } } } } while (0)
struct XcdBarrier { unsigned* bar; unsigned x; volatile LAS unsigned* st; };
__device__ __forceinline__ XcdBarrier xcd_barrier_post(unsigned* bar, volatile LAS unsigned* st) {
    XcdBarrier b; b.bar = bar; b.x = xb_xcc_id(); b.st = st;
    if (threadIdx.x == 0) (void)xb_add(&bar[XB_XCNT(b.x)], 1u);
    return b;
}
__device__ __forceinline__ void xcd_barrier_complete(unsigned* bar, unsigned x, unsigned& nloc, unsigned& nx) {
    const unsigned G = gridDim.x * gridDim.y * gridDim.z;
    unsigned sum, cnt, mine, sp = 0u;
    for (;;) {
        sum = 0u; cnt = 0u; mine = 0u;
#pragma unroll
        for (unsigned j = 0; j < 16; ++j) { const unsigned c = xb_ld(&bar[XB_XCNT(j)]); sum += c; cnt += (c > 0u) ? 1u : 0u; mine = (j == x) ? c : mine; }
        if (sum == G) break;
        __builtin_amdgcn_s_sleep(1);
        if ((++sp & 255u) == 0u) { if (xb_ld(&bar[XB_TMO])) break; if (sp > XB_SPIN_CAP) { atomicAdd(&bar[XB_TMO], 1u); break; } }
    }
    nloc = mine > 0u ? mine : 1u; nx = cnt > 0u ? cnt : 1u;
}
__device__ __forceinline__ void xcd_barrier(const XcdBarrier& b) {
    asm volatile("s_waitcnt vmcnt(0)" ::: "memory");
    __syncthreads();
    if (threadIdx.x == 0) {
        unsigned* bar = b.bar;
        __builtin_amdgcn_s_waitcnt(0);
        unsigned nloc = b.st[0], nx = b.st[1];
        if (nloc == 0u) { xcd_barrier_complete(bar, b.x, nloc, nx); b.st[0] = nloc; b.st[1] = nx; }
        const unsigned old = xb_add(&bar[XB_XSUB(b.x)], 1u);
        const unsigned gen = old / nloc;
        if (old + 1u == (gen + 1u) * nloc) {
            __builtin_amdgcn_fence(__ATOMIC_RELEASE, "agent");
            asm volatile("s_waitcnt vmcnt(0)" ::: "memory");
            const unsigned og = xb_add(&bar[XB_TOP], 1u);
            const unsigned tg = og / nx;
            if (og + 1u == (tg + 1u) * nx) xb_add(&bar[XB_TOPGEN], 1u);
            else XB_SPIN(xb_ld(&bar[XB_TOPGEN]) == tg, bar);
            __builtin_amdgcn_fence(__ATOMIC_ACQUIRE, "agent");
            xb_add(&bar[XB_XGEN(b.x)], 1u);
            asm volatile("s_waitcnt vmcnt(0)" ::: "memory");
        } else {
            XB_SPIN(xb_ld(&bar[XB_XGEN(b.x)]) == gen, bar);
            __builtin_amdgcn_fence(__ATOMIC_ACQUIRE, "agent");
            asm volatile("s_waitcnt vmcnt(0)" ::: "memory");
        }
    }
    __syncthreads();
}

struct Args { const float* in[27]; float* out; unsigned char* ws; int ph_lo, ph_hi; };
enum { I_X = 0, I_C, I_CTX, I_CCTX, I_WMOD, I_BMOD, I_N1G, I_N2G, I_WIN, I_CONVW, I_CONVB, I_GAW, I_GAB, I_GXW, I_GXB, I_LAM, I_WOUT,
       I_WQKV, I_DALAM, I_SUBLN, I_WO, I_RW, I_RB, I_MG, I_MU, I_MD, I_FG };

struct Frame {
    LAS char* lds;
    int tid, lane, wave, vcu, G;
    const Args* a;
    unsigned char* ws;
};

__device__ __forceinline__ const float* modp(const Frame& F, int l, int c, int k) { return (const float*)(F.ws + WS_MOD) + (size_t)(l * 5 + c) * 6144 + k * 1024; }
__device__ __forceinline__ int cond_of(int row) { return row < NX ? (row >> 12) : 4; }

__device__ __forceinline__ int moe_up_row(int n) { return ((n >> 7) << 8) + (((n >> 5) & 3) << 6) + (((n >> 4) & 1) << 5) + (n & 15); }

struct TDesc { const float* W; bf16* WT; int N, ldT, mode, k0, n0, f8; };
__device__ __forceinline__ void tr_load(const TDesc& t, int lane, f32x4 (&rg)[8]) {
    const float* p = t.W + (size_t)(t.k0 + (lane >> 3)) * t.N + t.n0 + 4 * (lane & 7);
#pragma unroll
    for (int i = 0; i < 8; ++i) rg[i] = *(const f32x4*)(p + (size_t)(8 * i) * t.N);
}
__device__ __forceinline__ void tr_finish(const TDesc& t, int lane, const f32x4 (&rg)[8], LAS float* scr) {
#pragma unroll
    for (int i = 0; i < 8; ++i) { LAS float* d = scr + ((lane >> 3) + 8 * i) * 33 + 4 * (lane & 7); d[0] = rg[i].x; d[1] = rg[i].y; d[2] = rg[i].z; d[3] = rg[i].w; }
    LDS_WAIT();
    const int c = lane & 7;
#pragma unroll
    for (int j = 0; j < 4; ++j) {
        const int n = (lane >> 3) + 8 * j; const LAS float* s = scr + (8 * c) * 33 + n;
        u32x4 o; o.x = pk2(s[0 * 33], s[1 * 33]); o.y = pk2(s[2 * 33], s[3 * 33]); o.z = pk2(s[4 * 33], s[5 * 33]); o.w = pk2(s[6 * 33], s[7 * 33]);
        const int nn = t.n0 + n;
        const int drow = (t.mode == 0) ? nn : (moe_up_row(nn) + (t.mode == 2 ? 16 : 0));
        *(u32x4*)(t.WT + (size_t)drow * t.ldT + t.k0 + 8 * c) = o;
    }
    LDS_WAIT();
}

__device__ __forceinline__ void phase_convert(Frame& F) {
    const Args& A = *F.a;
    LAS float* scr = (LAS float*)(F.lds + F.wave * 8448);
    LAS float* sil = (LAS float*)(F.lds + 69632);
    for (int i = F.tid; i < 5 * 1024; i += NTHREADS) { const int c = i >> 10, k = i & 1023; const float v = (c < 4) ? A.in[I_C][c * 1024 + k] : A.in[I_CCTX][k]; sil[i] = v / (1.0f + __expf(-v)); }
    __syncthreads();
    const int gw = F.vcu * NWAVES + F.wave, NGW = F.G * NWAVES;
    constexpr int N_MOD = 192, N_WIN = 16 * 64, N_WOUT = 16 * 32, N_WQKV = 16 * 96, N_WO = 16 * 32, N_GATE = 32 * 8, N_MOE = 64 * 256;
    {
        LAS float* red = (LAS float*)(F.lds + 90112);
        for (int item = F.vcu; item < N_MOD; item += F.G) {
            const int l = item / 96, col = (item % 96) * 64 + F.lane;
            const float* wp = A.in[I_WMOD] + ((size_t)l * 1024 + F.wave * 128) * 6144 + col;
            float acc[5] = {0.f, 0.f, 0.f, 0.f, 0.f};
#pragma unroll 4
            for (int k = 0; k < 128; k += 4) {
                const float w0 = wp[(size_t)k * 6144], w1 = wp[(size_t)(k + 1) * 6144], w2 = wp[(size_t)(k + 2) * 6144], w3 = wp[(size_t)(k + 3) * 6144];
#pragma unroll
                for (int c = 0; c < 5; ++c) { const f32x4 s4 = *(const LAS f32x4*)(sil + c * 1024 + F.wave * 128 + k); acc[c] += s4.x * w0 + s4.y * w1 + s4.z * w2 + s4.w * w3; }
            }
#pragma unroll
            for (int c = 0; c < 5; ++c) red[(F.wave * 5 + c) * 64 + F.lane] = acc[c];
            __syncthreads();
            if (F.tid < 320) {
                const int c = F.tid >> 6, ln = F.tid & 63;
                float s = A.in[I_BMOD][l * 6144 + (item % 96) * 64 + ln];
#pragma unroll
                for (int w2 = 0; w2 < 8; ++w2) s += red[(w2 * 5 + c) * 64 + ln];
                ((float*)(F.ws + WS_MOD))[(size_t)(l * 5 + c) * 6144 + (item % 96) * 64 + ln] = s;
            }
            __syncthreads();
        }
    }
}

__device__ __forceinline__ void early_convert(Frame& F) {
    const Args& A = *F.a;
    LAS float* scr = (LAS float*)(F.lds + F.wave * 8448);
    const int gw = F.vcu * NWAVES + F.wave, NGW = F.G * NWAVES;
    constexpr int N_WIN = 16 * 64, N_WOUT = 16 * 32, N_GATE = 32 * 8;
    auto decode = [&](int r) -> TDesc {
        TDesc t; t.mode = 0; t.f8 = 0;
        int item;
        if (r < N_WIN) { t.W = A.in[I_WIN]; t.N = 2048; t.WT = (bf16*)(F.ws + WS_WIN); t.ldT = 1024; item = r; }
        else if ((r -= N_WIN) < N_WOUT) { t.W = A.in[I_WOUT]; t.N = 1024; t.WT = (bf16*)(F.ws + WS_WOUT); t.ldT = 1024; item = r; }
        else {
            r -= N_WOUT;
            const int m = r >> 3, d = m >> 4, g = (m >> 3) & 1, n = m & 7;
            t.W = (g == 0 ? A.in[I_GAW] : A.in[I_GXW]) + (size_t)(d * 8 + n) * 128 * 128; t.N = 128;
            t.WT = (bf16*)(F.ws + WS_GATE) + (size_t)m * 128 * 128; t.ldT = 128; item = r & 7;
        }
        const int nblk = t.N >> 5; t.k0 = 64 * (item / nblk); t.n0 = 32 * (item % nblk);
        return t;
    };
    constexpr int NTR0 = N_WIN + N_WOUT + N_GATE;
    for (int it = gw; it < NTR0; it += NGW) {
        const TDesc cur = decode(it); f32x4 rg[8]; tr_load(cur, F.lane, rg);
        tr_finish(cur, F.lane, rg, scr);
    }
}

constexpr int ND_WQKV = 32 * 96, ND_WO = 32 * 32, ND_MOEL = 32 * 512;
constexpr int ND_SCAN = ND_WQKV + ND_WO + 3 * ND_MOEL;
constexpr int ND_ATTN = 3 * ND_MOEL;
__device__ __forceinline__ TDesc decode_moe(const Frame& F, int r, int layer) {
    const Args& A = *F.a;
    TDesc t; t.mode = 0; t.f8 = 0; int item;
    if (r < ND_MOEL) { const int le = layer * 32 + (r >> 9); t.W = A.in[I_MG] + (size_t)le * 1024 * 512; t.N = 512; t.WT = (bf16*)(F.ws + WS_WUP) + (size_t)le * 1024 * 1024; t.ldT = 1024; t.mode = 1; item = r & 511; }
    else if ((r -= ND_MOEL) < ND_MOEL) { const int le = layer * 32 + (r >> 9); t.W = A.in[I_MU] + (size_t)le * 1024 * 512; t.N = 512; t.WT = (bf16*)(F.ws + WS_WUP) + (size_t)le * 1024 * 1024; t.ldT = 1024; t.mode = 2; item = r & 511; }
    else { r -= ND_MOEL; const int le = layer * 32 + (r >> 9); t.W = A.in[I_MD] + (size_t)le * 512 * 1024; t.N = 1024; t.WT = (bf16*)(F.ws + WS_WDN) + (size_t)le * 1024 * 512; t.ldT = 512; item = r & 511; }
    if (L0_FP8 && layer == 0) {
        const size_t eoff = (size_t)((t.WT - (bf16*)(F.ws + (t.mode ? WS_WUP : WS_WDN))) / (t.mode ? 1024 * 1024 : 1024 * 512));
        t.WT = (bf16*)(F.ws + (t.mode ? WS_WUP : WS_WDN) + eoff * (t.mode ? 1024 * 1024 : 1024 * 512));
        t.f8 = 1;
    }
    const int nblk = t.N >> 5; t.k0 = 32 * (item / nblk); t.n0 = 32 * (item % nblk);
    return t;
}
__device__ __forceinline__ TDesc decode_deferred(const Frame& F, int r) {
    const Args& A = *F.a;
    if (r >= ND_WQKV + ND_WO) return decode_moe(F, r - (ND_WQKV + ND_WO), 0);
    TDesc t; t.mode = 0; t.f8 = 0; int item;
    if (r < ND_WQKV) { t.W = A.in[I_WQKV]; t.N = 3072; t.WT = (bf16*)(F.ws + WS_WQKV); t.ldT = 1024; item = r; }
    else { r -= ND_WQKV; t.W = A.in[I_WO]; t.N = 1024; t.WT = (bf16*)(F.ws + WS_WO); t.ldT = 1024; item = r; }
    const int nblk = t.N >> 5; t.k0 = 32 * (item / nblk); t.n0 = 32 * (item % nblk);
    return t;
}
__device__ __forceinline__ void tr3_dma(const TDesc& t, int lane, LAS char* buf) {
    const float* p = t.W + (size_t)(t.k0 + (lane >> 3)) * t.N + t.n0;
#pragma unroll
    for (int i = 0; i < 4; ++i)
        __builtin_amdgcn_global_load_lds((const unsigned*)(p + (size_t)(8 * i) * t.N + 4 * ((lane & 7) ^ i)), (LAS unsigned*)(buf + i * 1024), 16, 0, 0);
}
__device__ __forceinline__ void tr3_finish(const TDesc& t, int lane, const LAS char* buf) {
    const int c = lane & 3;
#pragma unroll
    for (int j = 0; j < 2; ++j) {
        const int n = (lane >> 2) + 16 * j;
        const LAS char* s = buf + (8 * c) * 128 + (((n >> 2) ^ c) << 4) + (n & 3) * 4;
        float x[8];
#pragma unroll
        for (int i = 0; i < 8; ++i) x[i] = *(const LAS float*)(s + i * 128);
        u32x4 o; o.x = pk2(x[0], x[1]); o.y = pk2(x[2], x[3]); o.z = pk2(x[4], x[5]); o.w = pk2(x[6], x[7]);
        const int nn = t.n0 + n;
        const int drow = (t.mode == 0) ? nn : (moe_up_row(nn) + (t.mode == 2 ? 16 : 0));
        *(u32x4*)(t.WT + (size_t)drow * t.ldT + t.k0 + 8 * c) = o;
    }
}
__device__ __forceinline__ void tr3_finish_fp8(const TDesc& t, int lane, const LAS char* buf) {
    const int c = lane & 1, n = lane >> 1;
    float x[16];
#pragma unroll
    for (int i = 0; i < 16; ++i) { const int r = 16 * c + i; x[i] = 32.0f * *(const LAS float*)(buf + r * 128 + (((n >> 2) ^ (r >> 3)) << 4) + (n & 3) * 4); }
    u32x4 o; o.x = pk4_fp8(x[0], x[1], x[2], x[3]); o.y = pk4_fp8(x[4], x[5], x[6], x[7]); o.z = pk4_fp8(x[8], x[9], x[10], x[11]); o.w = pk4_fp8(x[12], x[13], x[14], x[15]);
    const int nn = t.n0 + n;
    const int drow = (t.mode == 0) ? nn : (moe_up_row(nn) + (t.mode == 2 ? 16 : 0));
    *(u32x4*)((unsigned char*)t.WT + (size_t)drow * t.ldT + t.k0 + 16 * c) = o;
}
__device__ __forceinline__ TDesc decode_moe8(const Frame& F, int r) {
    const Args& A = *F.a;
    TDesc t; t.mode = 0; t.f8 = 0; int item;
    unsigned char* up8 = F.ws + WS_WUP + (size_t)64 * MiB; unsigned char* dn8 = F.ws + WS_WDN + (size_t)32 * MiB;
    if (r < ND_MOEL) { const int e = r >> 9; t.W = A.in[I_MG] + (size_t)(32 + e) * 1024 * 512; t.N = 512; t.WT = (bf16*)(up8 + (size_t)e * 1024 * 1024); t.ldT = 1024; t.mode = 1; item = r & 511; }
    else if ((r -= ND_MOEL) < ND_MOEL) { const int e = r >> 9; t.W = A.in[I_MU] + (size_t)(32 + e) * 1024 * 512; t.N = 512; t.WT = (bf16*)(up8 + (size_t)e * 1024 * 1024); t.ldT = 1024; t.mode = 2; item = r & 511; }
    else { r -= ND_MOEL; const int e = r >> 9; t.W = A.in[I_MD] + (size_t)(32 + e) * 512 * 1024; t.N = 1024; t.WT = (bf16*)(dn8 + (size_t)e * 1024 * 512); t.ldT = 512; item = r & 511; }
    const int nblk = t.N >> 5; t.k0 = 32 * (item / nblk); t.n0 = 32 * (item % nblk);
    return t;
}
__device__ __forceinline__ void tr2_load(const TDesc& t, int lane, f32x4 (&rg)[4]) {
    const float* p = t.W + (size_t)(t.k0 + (lane >> 3)) * t.N + t.n0 + 4 * (lane & 7);
#pragma unroll
    for (int i = 0; i < 4; ++i) rg[i] = *(const f32x4*)(p + (size_t)(8 * i) * t.N);
}
__device__ __forceinline__ void tr2_finish(const TDesc& t, int lane, const f32x4 (&rg)[4], LAS float* scr  ) {
#pragma unroll
    for (int i = 0; i < 4; ++i) { LAS float* d = scr + ((lane >> 3) + 8 * i) * 33 + 4 * (lane & 7); d[0] = rg[i].x; d[1] = rg[i].y; d[2] = rg[i].z; d[3] = rg[i].w; }
    LDS_WAIT();
    if (t.f8) {
        const int c = lane & 1, n = lane >> 1;
        float x[16];
#pragma unroll
        for (int i = 0; i < 16; ++i) x[i] = 32.0f * scr[(16 * c + i) * 33 + n];
        u32x4 o; o.x = pk4_fp8(x[0], x[1], x[2], x[3]); o.y = pk4_fp8(x[4], x[5], x[6], x[7]); o.z = pk4_fp8(x[8], x[9], x[10], x[11]); o.w = pk4_fp8(x[12], x[13], x[14], x[15]);
        const int nn = t.n0 + n;
        const int drow = (t.mode == 0) ? nn : (moe_up_row(nn) + (t.mode == 2 ? 16 : 0));
        *(u32x4*)((unsigned char*)t.WT + (size_t)drow * t.ldT + t.k0 + 16 * c) = o;
        LDS_WAIT();
        return;
    }
    const int c = lane & 3;
#pragma unroll
    for (int j = 0; j < 2; ++j) {
        const int n = (lane >> 2) + 16 * j; const LAS float* s = scr + (8 * c) * 33 + n;
        u32x4 o; o.x = pk2(s[0 * 33], s[1 * 33]); o.y = pk2(s[2 * 33], s[3 * 33]); o.z = pk2(s[4 * 33], s[5 * 33]); o.w = pk2(s[6 * 33], s[7 * 33]);
        const int nn = t.n0 + n;
        const int drow = (t.mode == 0) ? nn : (moe_up_row(nn) + (t.mode == 2 ? 16 : 0));
        *(u32x4*)(t.WT + (size_t)drow * t.ldT + t.k0 + 8 * c) = o;
    }
    LDS_WAIT();
}

constexpr int ND_TAILW = (256 - 32) * NWAVES;
constexpr int ND_A = ND_TAILW * 10, ND_B = ND_A + ND_TAILW * 7;
__device__ __forceinline__ void tail_convert(Frame& F, int tw, int first, int last) {
    LAS float* scr = (LAS float*)(F.lds + F.wave * 4224);
    int it = first + tw;
    if (it >= last) return;
    TDesc c0 = decode_deferred(F, it); f32x4 r0[4]; tr2_load(c0, F.lane, r0);
    for (;;) {
        const int n1 = it + ND_TAILW; const bool m1 = n1 < last;
        TDesc c1 = c0; f32x4 r1[4];
        if (m1) { c1 = decode_deferred(F, n1); tr2_load(c1, F.lane, r1); }
        tr2_finish(c0, F.lane, r0, scr);
        if (!m1) break;
        c0 = c1; it = n1;
#pragma unroll
        for (int i = 0; i < 4; ++i) r0[i] = r1[i];
    }
}

__device__ __forceinline__ float row_rstd(const f32x4 (&v)[4]) {
    float s = 0.f;
#pragma unroll
    for (int j = 0; j < 4; ++j) s += (v[j].x * v[j].x + v[j].y * v[j].y) + (v[j].z * v[j].z + v[j].w * v[j].w);
    return rsqrtf(wave_sum(s) * (1.0f / D) + EPS);
}
__device__ __forceinline__ void row_modulate_store8(f32x4 (&v)[4], float rstd, const float* g, const float* sc, const float* sh, unsigned char* dst, int lane) {
#pragma unroll
    for (int j = 0; j < 4; ++j) {
        const int c0 = 4 * lane + 256 * j;
        const f32x4 gg = *(const f32x4*)(g + c0), s1 = *(const f32x4*)(sc + c0), s0 = *(const f32x4*)(sh + c0);
        v[j] = (v[j] * rstd) * gg * (1.0f + s1) + s0;
        *(unsigned*)(dst + c0) = pk4_fp8(v[j].x, v[j].y, v[j].z, v[j].w);
    }
}
__device__ __forceinline__ void row_modulate_store(f32x4 (&v)[4], float rstd, const float* g, const float* sc, const float* sh, bf16* dst, int lane) {
#pragma unroll
    for (int j = 0; j < 4; ++j) {
        const int c0 = 4 * lane + 256 * j;
        const f32x4 gg = *(const f32x4*)(g + c0), s1 = *(const f32x4*)(sc + c0), s0 = *(const f32x4*)(sh + c0);
        v[j] = (v[j] * rstd) * gg * (1.0f + s1) + s0;
        u32x2 o; o.x = pk2(v[j].x, v[j].y); o.y = pk2(v[j].z, v[j].w);
        *(u32x2*)(dst + c0) = o;
    }
}

__device__ __forceinline__ void load_row4(const float* src, int lane, f32x4 (&v)[4]) {
#pragma unroll
    for (int j = 0; j < 4; ++j) v[j] = *(const f32x4*)(src + 4 * lane + 256 * j);
}
__device__ __forceinline__ void phase_prep0(Frame& F) {
    const Args& A = *F.a;
    const int gw = F.vcu * NWAVES + F.wave, NGW = F.G * NWAVES;
    bf16* H = (bf16*)(F.ws + WS_H);
    f32x4 vn[4];
    if (gw < NTOK) load_row4(gw < NX ? A.in[I_X] + (size_t)gw * D : A.in[I_CTX] + (size_t)(gw - NX) * D, F.lane, vn);
    for (int row = gw; row < NTOK; row += NGW) {
        const int c = cond_of(row);
        f32x4 v[4];
#pragma unroll
        for (int j = 0; j < 4; ++j) v[j] = vn[j];
        const int nr = row + NGW;
        if (nr < NTOK) load_row4(nr < NX ? A.in[I_X] + (size_t)nr * D : A.in[I_CTX] + (size_t)(nr - NX) * D, F.lane, vn);
        const float rstd = row_rstd(v);
        row_modulate_store(v, rstd, A.in[I_N1G], modp(F, 0, c, 1), modp(F, 0, c, 0), H + (size_t)row * D, F.lane);
    }
    early_convert(F);
}

constexpr int GEMM_STAGE = 49152;
__device__ __forceinline__ int swz128(int row, int chunk) { return row * 128 + ((chunk ^ ((row >> 1) & 7)) << 4); }
__device__ __forceinline__ int dma_kc(int tid) { return ((tid & 7) ^ ((tid >> 4) & 7)) * 8; }

struct ALDense {
    static constexpr bool DMA = true;
    const bf16* p0; const bf16* p1;
    __device__ __forceinline__ const bf16* ptr(int i) const { return i ? p1 : p0; }
    __device__ __forceinline__ void init(const bf16* A, int lda, int m0, int r0, int r1, int kc) { p0 = A + (size_t)(m0 + r0) * lda + kc; p1 = A + (size_t)(m0 + r1) * lda + kc; }
    __device__ __forceinline__ u32x4 load(int i, int k0) const { return *(const u32x4*)((i ? p1 : p0) + k0); }
};
struct ALGather {
    static constexpr bool DMA = true;
    const bf16* p0; const bf16* p1;
    __device__ __forceinline__ const bf16* ptr(int i) const { return i ? p1 : p0; }
    __device__ __forceinline__ void init(const bf16* A, int lda, const int* idx, int m0, int r0, int r1, int kc) { p0 = A + (size_t)idx[m0 + r0] * lda + kc; p1 = A + (size_t)idx[m0 + r1] * lda + kc; }
    __device__ __forceinline__ u32x4 load(int i, int k0) const { return *(const u32x4*)((i ? p1 : p0) + k0); }
};
struct ALCombine {
    static constexpr bool DMA = false;
    size_t o0, o1; const bf16 *hf, *hb, *yg;
    __device__ __forceinline__ const bf16* ptr(int) const { return nullptr; }
    __device__ __forceinline__ void init(const bf16* hf_, const bf16* hb_, const bf16* yg_, int m0, int r0, int r1, int kc) { hf = hf_; hb = hb_; yg = yg_; o0 = (size_t)(m0 + r0) * D + kc; o1 = (size_t)(m0 + r1) * D + kc; }
    __device__ __forceinline__ u32x4 load(int i, int k0) const {
        const size_t o = (i ? o1 : o0) + k0;
        const u32x4 a = *(const u32x4*)(hf + o), b = *(const u32x4*)(hb + o), y = *(const u32x4*)(yg + o);
        u32x4 r;
#pragma unroll
        for (int q = 0; q < 4; ++q) r[q] = pk2((bflo(a[q]) + bflo(b[q])) * bflo(y[q]), (bfhi(a[q]) + bfhi(b[q])) * bfhi(y[q]));
        return r;
    }
};

template <class AL>
__device__ __forceinline__ void gemm_prefetch(const Frame& F, const AL& al, const bf16* __restrict__ Bt, int K) {
    const int tid = F.tid, sr = tid >> 3, sc = (tid & 7) ^ ((sr >> 1) & 7), wl = F.wave * 1024;
    const bf16* bp = Bt + (size_t)sr * K + sc * 8;
    const size_t bstep = (size_t)64 * K;
    LAS char* lds = F.lds;
    __builtin_amdgcn_global_load_lds((const unsigned*)(al.ptr(0)), (LAS unsigned*)(lds + wl), 16, 0, 0);
    __builtin_amdgcn_global_load_lds((const unsigned*)(al.ptr(1)), (LAS unsigned*)(lds + 8192 + wl), 16, 0, 0);
#pragma unroll
    for (int i = 0; i < 4; ++i)
        __builtin_amdgcn_global_load_lds((const unsigned*)(bp + i * bstep), (LAS unsigned*)(lds + 16384 + i * 8192 + wl), 16, 0, 0);
}
template <bool SWAP, class AL, bool PRE = false>
__device__ __forceinline__ void gemm_tile(const Frame& F, const AL& al, const bf16* __restrict__ Bt  , int K, f32x4 (&acc)[4][4]) {
    const int tid = F.tid, lane = F.lane, wid = F.wave, wr = wid >> 2, wc = wid & 3, fr = lane & 15, fq = lane >> 4;
    const int sr = tid >> 3;
    const int sc = AL::DMA ? ((tid & 7) ^ ((sr >> 1) & 7)) : (tid & 7);
    LAS char* lds = F.lds;
    const bf16* bp = Bt + (size_t)sr * K + sc * 8;
    const size_t bstep = (size_t)64 * K;
    int wa[2], wb[4];
#pragma unroll
    for (int i = 0; i < 2; ++i) wa[i] = swz128(sr + 64 * i, sc);
#pragma unroll
    for (int i = 0; i < 4; ++i) wb[i] = 16384 + swz128(sr + 64 * i, sc);
    const int key = (fr >> 1) & 7;
    const int ra = (wr * 64 + fr) * 128, rb = 16384 + (wc * 64 + fr) * 128;
#pragma unroll
    for (int mi = 0; mi < 4; ++mi)
#pragma unroll
        for (int ni = 0; ni < 4; ++ni) acc[mi][ni] = (f32x4){0.f, 0.f, 0.f, 0.f};
    u32x4 ga[2], gb[4];
    const int wl = wid * 1024;
#define GT_DMA(stage_, k_) do { \
        __builtin_amdgcn_global_load_lds((const unsigned*)(al.ptr(0) + (k_)), (LAS unsigned*)(lds + (stage_) + wl), 16, 0, 0); \
        __builtin_amdgcn_global_load_lds((const unsigned*)(al.ptr(1) + (k_)), (LAS unsigned*)(lds + (stage_) + 8192 + wl), 16, 0, 0); \
        _Pragma("unroll") for (int i_ = 0; i_ < 4; ++i_) \
            __builtin_amdgcn_global_load_lds((const unsigned*)(bp + i_ * bstep + (k_)), (LAS unsigned*)(lds + (stage_) + 16384 + i_ * 8192 + wl), 16, 0, 0); } while (0)
    if constexpr (AL::DMA) { if constexpr (!PRE) { GT_DMA(0, 0); } }
    else {
        ga[0] = al.load(0, 0); ga[1] = al.load(1, 0);
#pragma unroll
        for (int i = 0; i < 4; ++i) gb[i] = *(const u32x4*)(bp + i * bstep);
#pragma unroll
        for (int i = 0; i < 2; ++i) *(LAS u32x4*)(lds + wa[i]) = ga[i];
#pragma unroll
        for (int i = 0; i < 4; ++i) *(LAS u32x4*)(lds + wb[i]) = gb[i];
    }
    __syncthreads();
    const int nk = K / 64;
    for (int kt = 0; kt < nk; ++kt) {
        const int cur = (kt & 1) * GEMM_STAGE, nxt = GEMM_STAGE - cur;
        if (kt + 1 < nk) {
            const int k1 = (kt + 1) * 64;
            if constexpr (AL::DMA) { GT_DMA(nxt, k1); }
            else {
                ga[0] = al.load(0, k1); ga[1] = al.load(1, k1);
#pragma unroll
                for (int i = 0; i < 4; ++i) gb[i] = *(const u32x4*)(bp + i * bstep + k1);
            }
        }
        {
            bf16x8 af[2][4], bfr[2][4];
#pragma unroll
            for (int ks = 0; ks < 2; ++ks) {
                const int co = ((ks * 4 + fq) ^ key) << 4;
#pragma unroll
                for (int mi = 0; mi < 4; ++mi) af[ks][mi] = *(const LAS bf16x8*)(lds + cur + ra + mi * 2048 + co);
#pragma unroll
                for (int ni = 0; ni < 4; ++ni) bfr[ks][ni] = *(const LAS bf16x8*)(lds + cur + rb + ni * 2048 + co);
            }
            __builtin_amdgcn_sched_barrier(0);
#pragma unroll
            for (int ks = 0; ks < 2; ++ks)
#pragma unroll
                for (int mi = 0; mi < 4; ++mi)
#pragma unroll
                    for (int ni = 0; ni < 4; ++ni)
                        acc[mi][ni] = SWAP ? __builtin_amdgcn_mfma_f32_16x16x32_bf16(bfr[ks][ni], af[ks][mi], acc[mi][ni], 0, 0, 0)
                                           : __builtin_amdgcn_mfma_f32_16x16x32_bf16(af[ks][mi], bfr[ks][ni], acc[mi][ni], 0, 0, 0);
            __builtin_amdgcn_sched_barrier(0);
        }
        if constexpr (!AL::DMA) {
            if (kt + 1 < nk) {
#pragma unroll
                for (int i = 0; i < 2; ++i) *(LAS u32x4*)(lds + nxt + wa[i]) = ga[i];
#pragma unroll
                for (int i = 0; i < 4; ++i) *(LAS u32x4*)(lds + nxt + wb[i]) = gb[i];
            }
        }
        __syncthreads();
    }
#undef GT_DMA
}

#define G3_WAIT_BAR(N) asm volatile("s_waitcnt vmcnt(" #N ") lgkmcnt(0)\n\ts_barrier" ::: "memory")
template <class AL>
__device__ __forceinline__ void gemm3_issue(const Frame& F, const AL& al, const bf16* bp, size_t bstep, int stage_off, int k) {
    LAS char* lds = F.lds; const int wl = F.wave * 1024;
    __builtin_amdgcn_global_load_lds((const unsigned*)(al.ptr(0) + k), (LAS unsigned*)(lds + stage_off + wl), 16, 0, 0);
    __builtin_amdgcn_global_load_lds((const unsigned*)(al.ptr(1) + k), (LAS unsigned*)(lds + stage_off + 8192 + wl), 16, 0, 0);
#pragma unroll
    for (int i = 0; i < 4; ++i)
        __builtin_amdgcn_global_load_lds((const unsigned*)(bp + i * bstep + k), (LAS unsigned*)(lds + stage_off + 16384 + i * 8192 + wl), 16, 0, 0);
}
template <class AL>
__device__ __forceinline__ void gemm3_prefetch(const Frame& F, const AL& al, const bf16* __restrict__ Bt, int K) {
    const int tid = F.tid, sr = tid >> 3, sc = (tid & 7) ^ ((sr >> 1) & 7);
    const bf16* bp = Bt + (size_t)sr * K + sc * 8;
    gemm3_issue(F, al, bp, (size_t)64 * K, 0, 0);
    gemm3_issue(F, al, bp, (size_t)64 * K, GEMM_STAGE, 64);
}
template <bool SWAP, int EPI_ST, class AL>
__device__ __forceinline__ void gemm3_tile(const Frame& F, const AL& al, const bf16* __restrict__ Bt, int K, f32x4 (&acc)[4][4], bool first_unit) {
    static_assert(EPI_ST == 8 || EPI_ST == 16, "EPI_ST");
    const int tid = F.tid, lane = F.lane, wid = F.wave, wr = wid >> 2, wc = wid & 3, fr = lane & 15, fq = lane >> 4;
    const int sr = tid >> 3, sc = (tid & 7) ^ ((sr >> 1) & 7);
    LAS char* lds = F.lds;
    const bf16* bp = Bt + (size_t)sr * K + sc * 8;
    const size_t bstep = (size_t)64 * K;
    const int key = (fr >> 1) & 7;
    const int ra = (wr * 64 + fr) * 128, rb = 16384 + (wc * 64 + fr) * 128;
#pragma unroll
    for (int mi = 0; mi < 4; ++mi)
#pragma unroll
        for (int ni = 0; ni < 4; ++ni) acc[mi][ni] = (f32x4){0.f, 0.f, 0.f, 0.f};
    const int nk = K / 64;
    int cur = 0, nx2 = 2 * GEMM_STAGE;
    const int wl = wid * 1024;
#pragma unroll 1
    for (int kt = 0; kt < nk; ++kt) {
        if (kt + 1 >= nk) G3_WAIT_BAR(0);
        else if (kt >= 2 || first_unit) G3_WAIT_BAR(6);
        else if (kt == 0) { if constexpr (EPI_ST == 8) G3_WAIT_BAR(8); else G3_WAIT_BAR(16); }
        else { if constexpr (EPI_ST == 8) G3_WAIT_BAR(14); else G3_WAIT_BAR(22); }
        const bool more = kt + 2 < nk;
        const int k2 = (kt + 2) * 64;
#pragma unroll
        for (int ks = 0; ks < 2; ++ks) {
            const int co = ((ks * 4 + fq) ^ key) << 4;
            bf16x8 af[4], bfr[4];
#pragma unroll
            for (int mi = 0; mi < 4; ++mi) af[mi] = *(const LAS bf16x8*)(lds + cur + ra + mi * 2048 + co);
#pragma unroll
            for (int ni = 0; ni < 4; ++ni) bfr[ni] = *(const LAS bf16x8*)(lds + cur + rb + ni * 2048 + co);
#pragma unroll
            for (int mi = 0; mi < 4; ++mi) {
                if (more && mi < 3) {
                    const int g = ks * 3 + mi;
                    if (g < 2) __builtin_amdgcn_global_load_lds((const unsigned*)(al.ptr(g) + k2), (LAS unsigned*)(lds + nx2 + g * 8192 + wl), 16, 0, 0);
                    else __builtin_amdgcn_global_load_lds((const unsigned*)(bp + (g - 2) * bstep + k2), (LAS unsigned*)(lds + nx2 + 16384 + (g - 2) * 8192 + wl), 16, 0, 0);
                }
#pragma unroll
                for (int ni = 0; ni < 4; ++ni)
                    acc[mi][ni] = SWAP ? __builtin_amdgcn_mfma_f32_16x16x32_bf16(bfr[ni], af[mi], acc[mi][ni], 0, 0, 0)
                                       : __builtin_amdgcn_mfma_f32_16x16x32_bf16(af[mi], bfr[ni], acc[mi][ni], 0, 0, 0);
            }
        }
        nx2 = cur; cur = (cur == 2 * GEMM_STAGE) ? 0 : cur + GEMM_STAGE;
    }
    G3_WAIT_BAR(0);
}

template <int EPI_ST, class AL>
__device__ __forceinline__ void gemm3_tile8(const Frame& F, const AL& al, const bf16* __restrict__ Bt, int K2, f32x4 (&acc)[4][4], bool first_unit, int sc_w, int sc_a) {
    static_assert(EPI_ST == 8 || EPI_ST == 16, "EPI_ST");
    const int tid = F.tid, lane = F.lane, wid = F.wave, wr = wid >> 2, wc = wid & 3, fr = lane & 15, fq = lane >> 4;
    const int sr = tid >> 3, sc = (tid & 7) ^ ((sr >> 1) & 7);
    LAS char* lds = F.lds;
    const bf16* bp = Bt + (size_t)sr * K2 + sc * 8;
    const size_t bstep = (size_t)64 * K2;
    const int key = (fr >> 1) & 7;
    const int ra = (wr * 64 + fr) * 128, rb = 16384 + (wc * 64 + fr) * 128;
    const int c0 = ((2 * fq) ^ key) << 4, c1 = ((2 * fq + 1) ^ key) << 4;
#pragma unroll
    for (int mi = 0; mi < 4; ++mi)
#pragma unroll
        for (int ni = 0; ni < 4; ++ni) acc[mi][ni] = (f32x4){0.f, 0.f, 0.f, 0.f};
    const int nk = K2 / 64;
    int cur = 0, nx2 = 2 * GEMM_STAGE;
    const int wl = wid * 1024;
#pragma unroll 1
    for (int kt = 0; kt < nk; ++kt) {
        if (kt + 1 >= nk) G3_WAIT_BAR(0);
        else if (kt >= 2 || first_unit) G3_WAIT_BAR(6);
        else if (kt == 0) { if constexpr (EPI_ST == 8) G3_WAIT_BAR(8); else G3_WAIT_BAR(16); }
        else { if constexpr (EPI_ST == 8) G3_WAIT_BAR(14); else G3_WAIT_BAR(22); }
        const bool more = kt + 2 < nk;
        const int k2 = (kt + 2) * 64;
        i32x8 af[4], bfr[4];
#pragma unroll
        for (int mi = 0; mi < 4; ++mi) {
            const u32x4 lo = *(const LAS u32x4*)(lds + cur + ra + mi * 2048 + c0), hi = *(const LAS u32x4*)(lds + cur + ra + mi * 2048 + c1);
            af[mi] = (i32x8){(int)lo.x, (int)lo.y, (int)lo.z, (int)lo.w, (int)hi.x, (int)hi.y, (int)hi.z, (int)hi.w};
        }
#pragma unroll
        for (int ni = 0; ni < 4; ++ni) {
            const u32x4 lo = *(const LAS u32x4*)(lds + cur + rb + ni * 2048 + c0), hi = *(const LAS u32x4*)(lds + cur + rb + ni * 2048 + c1);
            bfr[ni] = (i32x8){(int)lo.x, (int)lo.y, (int)lo.z, (int)lo.w, (int)hi.x, (int)hi.y, (int)hi.z, (int)hi.w};
        }
#define G8_PIECE(g_) do { if ((g_) < 2) __builtin_amdgcn_global_load_lds((const unsigned*)(al.ptr(g_) + k2), (LAS unsigned*)(lds + nx2 + (g_) * 8192 + wl), 16, 0, 0); \
            else __builtin_amdgcn_global_load_lds((const unsigned*)(bp + ((g_) - 2) * bstep + k2), (LAS unsigned*)(lds + nx2 + 16384 + ((g_) - 2) * 8192 + wl), 16, 0, 0); } while (0)
#define G8_MMA(mi_) do { _Pragma("unroll") for (int ni = 0; ni < 4; ++ni) \
            acc[mi_][ni] = __builtin_amdgcn_mfma_scale_f32_16x16x128_f8f6f4(bfr[ni], af[mi_], acc[mi_][ni], 0, 0, 0, sc_w, 0, sc_a); } while (0)
        if (more) { G8_PIECE(0); G8_PIECE(1); }
        G8_MMA(0);
        if (more) { G8_PIECE(2); G8_PIECE(3); }
        G8_MMA(1);
        if (more) { G8_PIECE(4); }
        G8_MMA(2);
        if (more) { G8_PIECE(5); }
        G8_MMA(3);
#undef G8_PIECE
#undef G8_MMA
        nx2 = cur; cur = (cur == 2 * GEMM_STAGE) ? 0 : cur + GEMM_STAGE;
    }
    G3_WAIT_BAR(0);
}

struct Ring { int cur, nx2; };
template <class AL>
__device__ __forceinline__ void ring_start(const Frame& F, Ring& R, const AL& al, const bf16* __restrict__ Bt, int K2) {
    const int tid = F.tid, sr = tid >> 3, sc = (tid & 7) ^ ((sr >> 1) & 7);
    const bf16* bp = Bt + (size_t)sr * K2 + sc * 8;
    gemm3_issue(F, al, bp, (size_t)64 * K2, 0, 0);
    gemm3_issue(F, al, bp, (size_t)64 * K2, GEMM_STAGE, 64);
    R.cur = 0; R.nx2 = 2 * GEMM_STAGE;
}
template <bool F8, int EPI_ST, class AL>
__device__ __forceinline__ void gemm3_unit(const Frame& F, Ring& R, const AL& al, const bf16* __restrict__ Bt, const AL& alN, const bf16* __restrict__ BtN, bool hasN,
                                           int K2, f32x4 (&acc)[4][4], bool first_unit, int sc_w = 0, int sc_a = 0) {
    static_assert(EPI_ST == 8 || EPI_ST == 16, "EPI_ST");
    const int tid = F.tid, lane = F.lane, wid = F.wave, wr = wid >> 2, wc = wid & 3, fr = lane & 15, fq = lane >> 4;
    const int sr = tid >> 3, sc = (tid & 7) ^ ((sr >> 1) & 7);
    LAS char* lds = F.lds;
    const bf16* bp = Bt + (size_t)sr * K2 + sc * 8;
    const bf16* bpN = BtN + (size_t)sr * K2 + sc * 8;
    const size_t bstep = (size_t)64 * K2;
    const int key = (fr >> 1) & 7;
    const int ra = (wr * 64 + fr) * 128, rb = 16384 + (wc * 64 + fr) * 128;
#pragma unroll
    for (int mi = 0; mi < 4; ++mi)
#pragma unroll
        for (int ni = 0; ni < 4; ++ni) acc[mi][ni] = (f32x4){0.f, 0.f, 0.f, 0.f};
    const int nk = K2 / 64;
    int cur = R.cur, nx2 = R.nx2;
    const int wl = wid * 1024;
#pragma unroll 1
    for (int kt = 0; kt < nk; ++kt) {
        const bool later = (kt + 1 < nk) || hasN;
        if (!later) G3_WAIT_BAR(0);
        else if (kt >= 2 || first_unit) G3_WAIT_BAR(6);
        else { if constexpr (EPI_ST == 8) G3_WAIT_BAR(14); else G3_WAIT_BAR(22); }
        const bool own = kt + 2 < nk, more = own || hasN;
        const bf16* pa0 = own ? al.ptr(0) : alN.ptr(0); const bf16* pa1 = own ? al.ptr(1) : alN.ptr(1); const bf16* pb = own ? bp : bpN;
        const int k2 = (own ? kt + 2 : kt + 2 - nk) * 64;
#define G3_PIECE(g_) do { if ((g_) == 0) __builtin_amdgcn_global_load_lds((const unsigned*)(pa0 + k2), (LAS unsigned*)(lds + nx2 + wl), 16, 0, 0); \
            else if ((g_) == 1) __builtin_amdgcn_global_load_lds((const unsigned*)(pa1 + k2), (LAS unsigned*)(lds + nx2 + 8192 + wl), 16, 0, 0); \
            else __builtin_amdgcn_global_load_lds((const unsigned*)(pb + ((g_) - 2) * bstep + k2), (LAS unsigned*)(lds + nx2 + 16384 + ((g_) - 2) * 8192 + wl), 16, 0, 0); } while (0)
        if constexpr (F8) {
            const int c0 = ((2 * fq) ^ key) << 4, c1 = ((2 * fq + 1) ^ key) << 4;
            i32x8 af[4], bfr[4];
#pragma unroll
            for (int mi = 0; mi < 4; ++mi) {
                const u32x4 lo = *(const LAS u32x4*)(lds + cur + ra + mi * 2048 + c0), hi = *(const LAS u32x4*)(lds + cur + ra + mi * 2048 + c1);
                af[mi] = (i32x8){(int)lo.x, (int)lo.y, (int)lo.z, (int)lo.w, (int)hi.x, (int)hi.y, (int)hi.z, (int)hi.w};
            }
#pragma unroll
            for (int ni = 0; ni < 4; ++ni) {
                const u32x4 lo = *(const LAS u32x4*)(lds + cur + rb + ni * 2048 + c0), hi = *(const LAS u32x4*)(lds + cur + rb + ni * 2048 + c1);
                bfr[ni] = (i32x8){(int)lo.x, (int)lo.y, (int)lo.z, (int)lo.w, (int)hi.x, (int)hi.y, (int)hi.z, (int)hi.w};
            }
#define G8_MMA(mi_) do { _Pragma("unroll") for (int ni = 0; ni < 4; ++ni) \
                acc[mi_][ni] = __builtin_amdgcn_mfma_scale_f32_16x16x128_f8f6f4(bfr[ni], af[mi_], acc[mi_][ni], 0, 0, 0, sc_w, 0, sc_a); } while (0)
            if (more) { G3_PIECE(0); G3_PIECE(1); }
            G8_MMA(0);
            if (more) { G3_PIECE(2); G3_PIECE(3); }
            G8_MMA(1);
            if (more) { G3_PIECE(4); }
            G8_MMA(2);
            if (more) { G3_PIECE(5); }
            G8_MMA(3);
#undef G8_MMA
        } else {
#pragma unroll
            for (int ks = 0; ks < 2; ++ks) {
                const int co = ((ks * 4 + fq) ^ key) << 4;
                bf16x8 af[4], bfr[4];
#pragma unroll
                for (int mi = 0; mi < 4; ++mi) af[mi] = *(const LAS bf16x8*)(lds + cur + ra + mi * 2048 + co);
#pragma unroll
                for (int ni = 0; ni < 4; ++ni) bfr[ni] = *(const LAS bf16x8*)(lds + cur + rb + ni * 2048 + co);
#pragma unroll
                for (int mi = 0; mi < 4; ++mi) {
                    if (more && mi < 3) { if (ks == 0) { if (mi == 0) G3_PIECE(0); else if (mi == 1) G3_PIECE(1); else G3_PIECE(2); } else { if (mi == 0) G3_PIECE(3); else if (mi == 1) G3_PIECE(4); else G3_PIECE(5); } }
#pragma unroll
                    for (int ni = 0; ni < 4; ++ni) acc[mi][ni] = __builtin_amdgcn_mfma_f32_16x16x32_bf16(bfr[ni], af[mi], acc[mi][ni], 0, 0, 0);
                }
            }
        }
#undef G3_PIECE
        nx2 = cur; cur = (cur == 2 * GEMM_STAGE) ? 0 : cur + GEMM_STAGE;
    }
    R.cur = cur; R.nx2 = nx2;
}


template <class AL>
__device__ __forceinline__ void ringn_start(const Frame& F, Ring& R, const AL& al, const bf16* __restrict__ Bt, int K2) {
    const int tid = F.tid, sr = tid >> 3, sc = (tid & 7) ^ ((sr >> 1) & 7), wl = F.wave * 1024;
    const bf16* bp = Bt + (size_t)sr * K2 + sc * 8;
    const size_t bstep = (size_t)64 * K2;
    LAS char* lds = F.lds;
#pragma unroll
    for (int t = 0; t < 2; ++t) {
        __builtin_amdgcn_global_load_lds((const unsigned*)(al.ptr(0) + t * 64), (LAS unsigned*)(lds + t * GEMM_STAGE + wl), 16, 0, 0);
        __builtin_amdgcn_global_load_lds((const unsigned*)(al.ptr(1) + t * 64), (LAS unsigned*)(lds + t * GEMM_STAGE + 8192 + wl), 16, 0, 0);
        __builtin_amdgcn_global_load_lds((const unsigned*)(bp + t * 64), (LAS unsigned*)(lds + t * GEMM_STAGE + 16384 + wl), 16, 0, 0);
        __builtin_amdgcn_global_load_lds((const unsigned*)(bp + bstep + t * 64), (LAS unsigned*)(lds + t * GEMM_STAGE + 16384 + 8192 + wl), 16, 0, 0);
    }
    R.cur = 0; R.nx2 = 2 * GEMM_STAGE;
}
template <int EPI_ST, class AL>
__device__ __forceinline__ void gemm3n_unit(const Frame& F, Ring& R, const AL& al, const bf16* __restrict__ Bt, const AL& alN, const bf16* __restrict__ BtN, bool hasN,
                                            int K2, f32x4 (&acc)[4][2], bool first_unit) {
    static_assert(EPI_ST == 16, "EPI_ST");
    const int tid = F.tid, lane = F.lane, wid = F.wave, wr = wid >> 2, wc = wid & 3, fr = lane & 15, fq = lane >> 4;
    const int sr = tid >> 3, sc = (tid & 7) ^ ((sr >> 1) & 7);
    LAS char* lds = F.lds;
    const bf16* bp = Bt + (size_t)sr * K2 + sc * 8;
    const bf16* bpN = BtN + (size_t)sr * K2 + sc * 8;
    const size_t bstep = (size_t)64 * K2;
    const int key = (fr >> 1) & 7;
    const int ra = (wr * 64 + fr) * 128, rb = 16384 + (wc * 32 + fr) * 128;
#pragma unroll
    for (int mi = 0; mi < 4; ++mi)
#pragma unroll
        for (int ni = 0; ni < 2; ++ni) acc[mi][ni] = (f32x4){0.f, 0.f, 0.f, 0.f};
    const int nk = K2 / 64;
    int cur = R.cur, nx2 = R.nx2;
    const int wl = wid * 1024;
#pragma unroll 1
    for (int kt = 0; kt < nk; ++kt) {
        const bool later = (kt + 1 < nk) || hasN;
        if (!later) G3_WAIT_BAR(0);
        else if (kt >= 2 || first_unit) G3_WAIT_BAR(4);
        else G3_WAIT_BAR(20);
        const bool own = kt + 2 < nk, more = own || hasN;
        const bf16* pa0 = own ? al.ptr(0) : alN.ptr(0); const bf16* pa1 = own ? al.ptr(1) : alN.ptr(1); const bf16* pb = own ? bp : bpN;
        const int k2 = (own ? kt + 2 : kt + 2 - nk) * 64;
#define G3N_PIECE(g_) do { if ((g_) == 0) __builtin_amdgcn_global_load_lds((const unsigned*)(pa0 + k2), (LAS unsigned*)(lds + nx2 + wl), 16, 0, 0); \
            else if ((g_) == 1) __builtin_amdgcn_global_load_lds((const unsigned*)(pa1 + k2), (LAS unsigned*)(lds + nx2 + 8192 + wl), 16, 0, 0); \
            else __builtin_amdgcn_global_load_lds((const unsigned*)(pb + ((g_) - 2) * bstep + k2), (LAS unsigned*)(lds + nx2 + 16384 + ((g_) - 2) * 8192 + wl), 16, 0, 0); } while (0)
#pragma unroll
        for (int ks = 0; ks < 2; ++ks) {
            const int co = ((ks * 4 + fq) ^ key) << 4;
            bf16x8 af[4], bfr[2];
#pragma unroll
            for (int mi = 0; mi < 4; ++mi) af[mi] = *(const LAS bf16x8*)(lds + cur + ra + mi * 2048 + co);
#pragma unroll
            for (int ni = 0; ni < 2; ++ni) bfr[ni] = *(const LAS bf16x8*)(lds + cur + rb + ni * 2048 + co);
#pragma unroll
            for (int mi = 0; mi < 4; ++mi) {
                if (more && (mi & 1) == 0) { if (ks == 0) { if (mi == 0) G3N_PIECE(0); else G3N_PIECE(1); } else { if (mi == 0) G3N_PIECE(2); else G3N_PIECE(3); } }
#pragma unroll
                for (int ni = 0; ni < 2; ++ni) acc[mi][ni] = __builtin_amdgcn_mfma_f32_16x16x32_bf16(bfr[ni], af[mi], acc[mi][ni], 0, 0, 0);
            }
        }
#undef G3N_PIECE
        nx2 = cur; cur = (cur == 2 * GEMM_STAGE) ? 0 : cur + GEMM_STAGE;
    }
    R.cur = cur; R.nx2 = nx2;
}

__device__ __forceinline__ float gelu_tanh(float x) {
    const float z = 0.7978845608028654f * (x + 0.044715f * x * x * x);
    const float t = 1.0f - 2.0f / (1.0f + __expf(2.0f * z));
    return 0.5f * x * (1.0f + t);
}
namespace pg8 {
#define PG8_LAS __attribute__((address_space(3)))
typedef unsigned short bf16_t;
typedef short bf16x8 __attribute__((ext_vector_type(8)));
typedef float f32x4 __attribute__((ext_vector_type(4)));
typedef unsigned u32x4 __attribute__((ext_vector_type(4)));
constexpr int BM = 256, BK = 64, HALF = 128, HTB = HALF * BK * 2  , STAGE_BYTES = 8 * HTB, NXCD = 8, WGM = 8;

__host__ __device__ __forceinline__ int lds_byte(int r, int c) { const int st = (r >> 4) * 2 + (c >> 5), rr = r & 15, cc = c & 31, ob = rr * 64 + cc * 2; return st * 1024 + (ob ^ (((ob >> 9) & 1) << 5)); }
__host__ __device__ __forceinline__ void stage_rc(int b, int& R, int& C) { const int st = b / 1024, sb = b % 1024, swz = sb ^ (((sb >> 9) & 1) << 5); R = (st >> 1) * 16 + swz / 64; C = (st & 1) * 32 + (swz % 64) / 2; }
__host__ __device__ __forceinline__ int perm32(int rho) { const int n = rho >> 4, i = rho & 15; return 8 * (i >> 2) + 4 * n + (i & 3); }

struct Unit { int pm, pn; };
struct Gemm { const bf16_t* A; const bf16_t* Bt; int M, N, K; };

struct StaticOrder {
    int nM, nN, nwg, G, c;
    __host__ __device__ void init(int M, int N, int G_, int c_) { nM = M / BM; nN = N / BM; nwg = nM * nN; G = G_; c = c_; }
    __host__ __device__ bool next(int i, Unit& u) const {
        const long L = (long)i * G + c; if (L >= nwg) return false;
        int wgid = (int)L; { const int q = nwg / NXCD, r = nwg % NXCD, xcd = wgid % NXCD, off = wgid / NXCD; wgid = (xcd < r ? xcd * (q + 1) : r * (q + 1) + (xcd - r) * q) + off; }
        const int nig = WGM * nN, gid = wgid / nig, fm = gid * WGM, gsz = (nM - fm) < WGM ? (nM - fm) : WGM;
        u.pm = fm + ((wgid % nig) % gsz); u.pn = (wgid % nig) / gsz; return true;
    }
    __device__ __forceinline__ void a_ready(const Unit&) const {}
    __device__ __forceinline__ void done(const Unit&) const {}
};
__device__ __forceinline__ unsigned cvt_pk_bf16(float lo, float hi) { unsigned r; asm volatile("v_cvt_pk_bf16_f32 %0, %1, %2" : "=v"(r) : "v"(lo), "v"(hi)); return r; }
typedef float f32x2 __attribute__((ext_vector_type(2)));
template <class Epi, class Sched, bool ALIGN_EPI = false, bool SP2 = false>
__device__ __forceinline__ void gemm_phase(PG8_LAS unsigned char* lds, const Gemm g, const Sched& S, const Epi& E) {
    const int tid = threadIdx.x, wid = __builtin_amdgcn_readfirstlane(tid >> 6), lane = tid & 63, wr = wid >> 2, wc = wid & 3, fr = lane & 15, fq = lane >> 4;
    const int K = g.K, nt = K / BK;
    unsigned voffA[2], voffB[2];
#pragma unroll
    for (int i = 0; i < 2; ++i) { int R, C; stage_rc(tid * 16 + i * 8192, R, C); const int Rb = Epi::PERM ? ((R & ~31) + perm32(R & 31)) : R;
        voffA[i] = (unsigned)(R * K + C) * 2u; voffB[i] = (unsigned)(Rb * K + C) * 2u; }
    const size_t kstep = (size_t)(BK * 2);
    const size_t hstep = (size_t)HALF * K * 2;
    const size_t tstep = 2 * hstep;
    const unsigned ldsw = (unsigned)wid * 1024u;
    const int aoff = lds_byte(wr * 64 + fr, fq * 8), boff = lds_byte(wc * 32 + fr, fq * 8);
#define PG8_SA(b, h) (((b) * 2 + (h)) * HTB)
#define PG8_SB(b, h) ((4 + (b) * 2 + (h)) * HTB)
#define PG8_STAGE(bufoff, gbase, voff) do { _Pragma("unroll") for (int _i = 0; _i < 2; ++_i) \
        __builtin_amdgcn_global_load_lds((const unsigned*)((const char*)(gbase) + (voff)[_i]), (PG8_LAS unsigned*)(lds + (bufoff) + ldsw + _i * 8192), 16, 0, 0); } while (0)
#define PG8_LDA(dst, b, h) do { _Pragma("unroll") for (int m = 0; m < 4; ++m) _Pragma("unroll") for (int k = 0; k < 2; ++k) dst[m][k] = *(const PG8_LAS bf16x8*)(lds + PG8_SA(b, h) + aoff + m * 2048 + k * 1024); } while (0)
#define PG8_LDB(dst, b, h) do { _Pragma("unroll") for (int n = 0; n < 2; ++n) _Pragma("unroll") for (int k = 0; k < 2; ++k) dst[n][k] = *(const PG8_LAS bf16x8*)(lds + PG8_SB(b, h) + boff + n * 2048 + k * 1024); } while (0)
#define PG8_MMA(ai, bj, At, Bt) do { __builtin_amdgcn_s_setprio(1); _Pragma("unroll") for (int m = 0; m < 4; ++m) _Pragma("unroll") for (int n = 0; n < 2; ++n) _Pragma("unroll") for (int k = 0; k < 2; ++k) \
        acc[ai][bj][m][n] = __builtin_amdgcn_mfma_f32_16x16x32_bf16(Bt[n][k], At[m][k], acc[ai][bj][m][n], 0, 0, 0); __builtin_amdgcn_s_setprio(0); } while (0)
#define PG8_WAIT_V(n) asm volatile("s_waitcnt vmcnt(" #n ")" ::: "memory")
#define PG8_WAIT_L(n) asm volatile("s_waitcnt lgkmcnt(" #n ")" ::: "memory")
#define PG8_BAR __builtin_amdgcn_s_barrier()
#define PG8_SCHED __builtin_amdgcn_sched_barrier(0)
    Unit cur, nxt; int ui = 0;
    if (!S.next(0, cur)) return;
    f32x4 acc[2][2][4][2];
#pragma unroll
    for (int a = 0; a < 2; ++a)
#pragma unroll
        for (int b = 0; b < 2; ++b)
#pragma unroll
            for (int m = 0; m < 4; ++m)
#pragma unroll
                for (int n = 0; n < 2; ++n) acc[a][b][m][n] = (f32x4){0.f, 0.f, 0.f, 0.f};
    bf16x8 At[4][2], B0[2][2], B1[2][2];
    const char* cA = (const char*)g.A + (size_t)cur.pm * tstep; const char* cB = (const char*)g.Bt + (size_t)cur.pn * tstep;
    S.a_ready(cur);
    if constexpr (SP2) {
        PG8_STAGE(PG8_SB(0, 0), cB, voffB); PG8_STAGE(PG8_SB(0, 1), cB + hstep, voffB); PG8_STAGE(PG8_SA(0, 0), cA, voffA); PG8_STAGE(PG8_SA(0, 1), cA + hstep, voffA);
        if (wr == 1) PG8_BAR;
        PG8_WAIT_V(2); PG8_BAR;
        PG8_STAGE(PG8_SB(1, 0), cB + kstep, voffB); PG8_STAGE(PG8_SA(1, 0), cA + kstep, voffA); PG8_STAGE(PG8_SB(1, 1), cB + hstep + kstep, voffB);
        PG8_WAIT_V(6); PG8_BAR;
    } else {
        PG8_STAGE(PG8_SB(0, 0), cB, voffB); PG8_STAGE(PG8_SA(0, 0), cA, voffA); PG8_STAGE(PG8_SB(0, 1), cB + hstep, voffB); PG8_STAGE(PG8_SA(0, 1), cA + hstep, voffA);
        if (wr == 1) PG8_BAR;
        PG8_WAIT_V(4); PG8_BAR;
        PG8_STAGE(PG8_SB(1, 0), cB + kstep, voffB); PG8_STAGE(PG8_SA(1, 0), cA + kstep, voffA); PG8_STAGE(PG8_SB(1, 1), cB + hstep + kstep, voffB);
        PG8_WAIT_V(6); PG8_BAR;
    }
    for (;;) {
        const bool has_next = S.next(ui + 1, nxt);
        const char* nA = has_next ? (const char*)g.A + (size_t)nxt.pm * tstep : cA; const char* nB = has_next ? (const char*)g.Bt + (size_t)nxt.pn * tstep : cB;
        for (int t = 0; t < nt; t += 2) {
            const bool last = (t == nt - 2);
            const char* a1 = cA + (size_t)(t + 1) * kstep;
            const char* a2 = last ? nA : cA + (size_t)(t + 2) * kstep; const char* b2 = last ? nB : cB + (size_t)(t + 2) * kstep;
            const char* a3 = a2 + kstep; const char* b3 = b2 + kstep;
            if (last && has_next) S.a_ready(nxt);
            if constexpr (SP2) {
            PG8_LDB(B0, 0, 0); PG8_LDB(B1, 0, 1); PG8_SCHED; PG8_LDA(At, 0, 0); PG8_STAGE(PG8_SA(1, 1), a1 + hstep, voffA);
            PG8_WAIT_V(8); PG8_WAIT_L(0); PG8_BAR; PG8_MMA(0, 0, At, B0); PG8_MMA(0, 1, At, B1); PG8_BAR; PG8_SCHED;
            PG8_LDA(At, 0, 1); PG8_STAGE(PG8_SB(0, 0), b2, voffB); PG8_STAGE(PG8_SB(0, 1), b2 + hstep, voffB); PG8_STAGE(PG8_SA(0, 0), a2, voffA);
            PG8_WAIT_V(8); PG8_WAIT_L(0); PG8_BAR; PG8_MMA(1, 0, At, B0); PG8_MMA(1, 1, At, B1); PG8_BAR; PG8_SCHED;
            PG8_LDB(B0, 1, 0); PG8_LDB(B1, 1, 1); PG8_SCHED; PG8_LDA(At, 1, 0); PG8_STAGE(PG8_SA(0, 1), a2 + hstep, voffA);
            PG8_WAIT_V(8); PG8_WAIT_L(0); PG8_BAR; PG8_MMA(0, 0, At, B0); PG8_MMA(0, 1, At, B1); PG8_BAR; PG8_SCHED;
            PG8_LDA(At, 1, 1); PG8_STAGE(PG8_SB(1, 0), b3, voffB); PG8_STAGE(PG8_SB(1, 1), b3 + hstep, voffB); PG8_STAGE(PG8_SA(1, 0), a3, voffA);
            PG8_WAIT_V(8); PG8_WAIT_L(0); PG8_BAR; PG8_MMA(1, 0, At, B0); PG8_MMA(1, 1, At, B1); PG8_BAR; PG8_SCHED;
            } else {
            PG8_LDB(B0, 0, 0); PG8_SCHED; PG8_LDA(At, 0, 0); PG8_STAGE(PG8_SA(1, 1), a1 + hstep, voffA);
            PG8_WAIT_L(8); PG8_BAR; PG8_WAIT_L(0); PG8_MMA(0, 0, At, B0); PG8_BAR; PG8_SCHED;
            PG8_LDB(B1, 0, 1); PG8_STAGE(PG8_SB(0, 0), b2, voffB);
            PG8_BAR; PG8_WAIT_L(0); PG8_MMA(0, 1, At, B1); PG8_BAR;
            PG8_LDA(At, 0, 1); PG8_STAGE(PG8_SA(0, 0), a2, voffA);
            PG8_BAR; PG8_WAIT_L(0); PG8_MMA(1, 0, At, B0); PG8_BAR; PG8_SCHED;
            PG8_STAGE(PG8_SB(0, 1), b2 + hstep, voffB);
            PG8_WAIT_V(6); PG8_BAR; PG8_MMA(1, 1, At, B1); PG8_BAR;
            PG8_LDB(B0, 1, 0); PG8_SCHED; PG8_LDA(At, 1, 0); PG8_STAGE(PG8_SA(0, 1), a2 + hstep, voffA);
            PG8_WAIT_L(8); PG8_BAR; PG8_WAIT_L(0); PG8_MMA(0, 0, At, B0); PG8_BAR; PG8_SCHED;
            PG8_LDB(B1, 1, 1); PG8_STAGE(PG8_SB(1, 0), b3, voffB);
            PG8_BAR; PG8_WAIT_L(0); PG8_MMA(0, 1, At, B1); PG8_BAR;
            PG8_LDA(At, 1, 1); PG8_STAGE(PG8_SA(1, 0), a3, voffA);
            PG8_BAR; PG8_WAIT_L(0); PG8_MMA(1, 0, At, B0); PG8_BAR; PG8_SCHED;
            PG8_STAGE(PG8_SB(1, 1), b3 + hstep, voffB);
            PG8_WAIT_V(6); PG8_BAR; PG8_MMA(1, 1, At, B1); PG8_BAR;
            }
        }
        if constexpr (ALIGN_EPI) { if (wr == 0) PG8_BAR; }
        if constexpr (!Epi::AFTER_DRAIN) { E(acc, cur, wr, wc, fr, fq); S.done(cur); }
        if (!has_next) break;
#pragma unroll
        for (int a = 0; a < 2; ++a)
#pragma unroll
            for (int b = 0; b < 2; ++b)
#pragma unroll
                for (int m = 0; m < 4; ++m)
#pragma unroll
                    for (int n = 0; n < 2; ++n) acc[a][b][m][n] = (f32x4){0.f, 0.f, 0.f, 0.f};
        cur = nxt; cA = nA; cB = nB; ++ui;
        if constexpr (ALIGN_EPI) { if (wr == 1) PG8_BAR; }
    }
    PG8_WAIT_V(0);
    if constexpr (!ALIGN_EPI) { if (wr == 0) PG8_BAR; }
    PG8_BAR;
    if constexpr (Epi::AFTER_DRAIN) { E.fused(acc, cur, wr, wc, fr, fq, lds, wid, lane); S.done(cur); }
#undef PG8_SA
#undef PG8_SB
#undef PG8_STAGE
#undef PG8_LDA
#undef PG8_LDB
#undef PG8_MMA
#undef PG8_WAIT_V
#undef PG8_WAIT_L
#undef PG8_BAR
#undef PG8_SCHED
}
}

namespace pg8 {
struct EpiScaleBf16 {
    static constexpr bool PERM = true, AFTER_DRAIN = false;
    bf16_t* O; int ldc; const float* scale_base; int scale_stride;
    __device__ __forceinline__ void operator()(const f32x4 (&acc)[2][2][4][2], const Unit& u, int wr, int wc, int fr, int fq) const {
        const int row0 = u.pm * BM + wr * 64 + fr, col0 = u.pn * BM + wc * 32 + 8 * fq;
        const float* sc = scale_base + (size_t)((u.pm * BM) >> 12) * scale_stride;
        f32x4 sv[2][2];
#pragma unroll
        for (int bj = 0; bj < 2; ++bj)
#pragma unroll
            for (int n = 0; n < 2; ++n) sv[bj][n] = *(const f32x4*)(sc + col0 + bj * HALF + 4 * n);
#pragma unroll
        for (int ai = 0; ai < 2; ++ai)
#pragma unroll
            for (int m = 0; m < 4; ++m) { bf16_t* rowp = O + (size_t)(row0 + ai * HALF + m * 16) * ldc + col0;
#pragma unroll
                for (int bj = 0; bj < 2; ++bj) { const f32x4 v0 = acc[ai][bj][m][0] * sv[bj][0], v1 = acc[ai][bj][m][1] * sv[bj][1];
                    u32x4 w; w.x = cvt_pk_bf16(v0[0], v0[1]); w.y = cvt_pk_bf16(v0[2], v0[3]); w.z = cvt_pk_bf16(v1[0], v1[1]); w.w = cvt_pk_bf16(v1[2], v1[3]);
                    *(u32x4*)(rowp + bj * HALF) = w; } }
    }
};
struct EpiIn {
    static constexpr bool PERM = true, AFTER_DRAIN = false;
    bf16_t* YG; bf16_t* U;
    __device__ __forceinline__ void operator()(const f32x4 (&acc)[2][2][4][2], const Unit& u, int wr, int wc, int fr, int fq) const {
        const bool isy = u.pn < 4;
        bf16_t* base = isy ? YG : U;
        const int row0 = u.pm * BM + wr * 64 + fr, col0 = (u.pn & 3) * BM + wc * 32 + 8 * fq;
#pragma unroll
        for (int ai = 0; ai < 2; ++ai)
#pragma unroll
            for (int m = 0; m < 4; ++m) { bf16_t* rowp = base + (size_t)(row0 + ai * HALF + m * 16) * 1024 + col0;
#pragma unroll
                for (int bj = 0; bj < 2; ++bj) { f32x4 v0 = acc[ai][bj][m][0], v1 = acc[ai][bj][m][1];
                    if (isy) { v0 = (f32x4){::gelu_tanh(v0[0]), ::gelu_tanh(v0[1]), ::gelu_tanh(v0[2]), ::gelu_tanh(v0[3])}; v1 = (f32x4){::gelu_tanh(v1[0]), ::gelu_tanh(v1[1]), ::gelu_tanh(v1[2]), ::gelu_tanh(v1[3])}; }
                    u32x4 w; w.x = cvt_pk_bf16(v0[0], v0[1]); w.y = cvt_pk_bf16(v0[2], v0[3]); w.z = cvt_pk_bf16(v1[0], v1[1]); w.w = cvt_pk_bf16(v1[2], v1[3]);
                    *(u32x4*)(rowp + bj * HALF) = w; } }
    }
};
struct EpiQKV {
    static constexpr bool PERM = false, AFTER_DRAIN = false;
    bf16_t* Q; bf16_t* Kb; bf16_t* VT; const PG8_LAS float* cs;
    __device__ __forceinline__ void operator()(const f32x4 (&acc)[2][2][4][2], const Unit& u, int wr, int wc, int fr, int fq) const {
        const int region = u.pn >> 2, pq = u.pn & 3;
        const bool isctx = u.pm >= NX / BM;
#pragma unroll
        for (int ai = 0; ai < 2; ++ai)
#pragma unroll
            for (int m = 0; m < 4; ++m) {
                const int row = u.pm * BM + ai * HALF + wr * 64 + m * 16 + fr;
                int b, pos;
                if (!isctx) { b = row >> 12; pos = row & 4095; } else { b = (row - NX) >> 8; pos = S + ((row - NX) & 255); }
                if (region < 2) {
                    const int p = (wc & 1) ? (pos & 63) : (pos >> 6);
                    const float scl = region == 0 ? QSCALE : 1.0f;
#pragma unroll
                    for (int bj = 0; bj < 2; ++bj) {
                        const int hi2 = 4 * pq + 2 * bj + (wc >> 1);
                        bf16_t* dst = region == 0 ? Q + ((size_t)(b * 16 + hi2) * S + pos) * 64 : Kb + ((size_t)(b * 16 + hi2) * KEYS + pos) * 64;
#pragma unroll
                        for (int n = 0; n < 2; ++n) {
                            f32x4 o = acc[ai][bj][m][n];
                            if (!isctx) {
                                const f32x4 pv = acc[ai][bj][m][n ^ 1];
#pragma unroll
                                for (int i = 0; i < 4; ++i) { const float c_ = cs[(p * 16 + fq * 4 + i) * 2], s_ = cs[(p * 16 + fq * 4 + i) * 2 + 1]; o[i] = o[i] * c_ + (n ? pv[i] : -pv[i]) * s_; }
                            }
                            typedef unsigned u32x2_ __attribute__((ext_vector_type(2)));
                            u32x2_ w; w.x = cvt_pk_bf16(o[0] * scl, o[1] * scl); w.y = cvt_pk_bf16(o[2] * scl, o[3] * scl);
                            *(u32x2_*)(dst + (wc & 1) * 32 + n * 16 + fq * 4) = w;
                        }
                    }
                } else {
                    const int ppos = (pos & ~12) | ((pos & 4) << 1) | ((pos & 8) >> 1);
#pragma unroll
                    for (int bj = 0; bj < 2; ++bj)
#pragma unroll
                        for (int n = 0; n < 2; ++n) {
                            const int h = 2 * pq + bj, vd = 32 * wc + 16 * n + 4 * fq;
                            bf16_t* vp = VT + ((size_t)(b * 8 + h) * 128 + vd) * KEYS + ppos;
                            const f32x4 v = acc[ai][bj][m][n];
                            const unsigned p01 = cvt_pk_bf16(v[0], v[1]), p23 = cvt_pk_bf16(v[2], v[3]);
                            vp[0] = (bf16_t)(p01 & 0xffffu); vp[KEYS] = (bf16_t)(p01 >> 16); vp[2 * KEYS] = (bf16_t)(p23 & 0xffffu); vp[3 * KEYS] = (bf16_t)(p23 >> 16);
                        }
                }
            }
    }
};
struct QkvOrder {
    StaticOrder so; int G, c;
    __host__ __device__ void init(int G_, int c_) { so.init(NX, 3 * D, G_, c_); G = G_; c = c_; }
    __host__ __device__ bool next(int i, Unit& u) const { return so.next(i, u); }
    __device__ __forceinline__ void a_ready(const Unit&) const {}
    __device__ __forceinline__ void done(const Unit&) const {}
};
struct MoeOrder {
    int G, c, nunits; const PG8_LAS int* pst;
    __device__ __forceinline__ bool next(int i, Unit& u) const {
        const int L = i * G + c; if (L >= nunits) return false;
        const int pm = L >> 2, m0 = pm * BM; int e = 0;
        for (int x = 1; x < 32; ++x) e = (pst[x] <= m0) ? x : e;
        u.pm = pm; u.pn = e * 4 + (L & 3); return true;
    }
    __device__ __forceinline__ void a_ready(const Unit&) const {}
    __device__ __forceinline__ void done(const Unit&) const {}
};
struct EpiY {
    static constexpr bool PERM = true, AFTER_DRAIN = false;
    bf16_t* Y;
    __device__ __forceinline__ void operator()(const f32x4 (&acc)[2][2][4][2], const Unit& u, int wr, int wc, int fr, int fq) const {
        const int row0 = u.pm * BM + wr * 64 + fr, col0 = (u.pn & 3) * BM + wc * 32 + 8 * fq;
#pragma unroll
        for (int ai = 0; ai < 2; ++ai)
#pragma unroll
            for (int m = 0; m < 4; ++m) { bf16_t* rowp = Y + (size_t)(row0 + ai * HALF + m * 16) * 1024 + col0;
#pragma unroll
                for (int bj = 0; bj < 2; ++bj) { const f32x4 v0 = acc[ai][bj][m][0], v1 = acc[ai][bj][m][1];
                    u32x4 w; w.x = cvt_pk_bf16(v0[0], v0[1]); w.y = cvt_pk_bf16(v0[2], v0[3]); w.z = cvt_pk_bf16(v1[0], v1[1]); w.w = cvt_pk_bf16(v1[2], v1[3]);
                    *(u32x4*)(rowp + bj * HALF) = w; } }
    }
};
}

__device__ __forceinline__ void phase_gemm_in(Frame& F) {
    pg8::Gemm g{(const pg8::bf16_t*)(F.ws + WS_H), (const pg8::bf16_t*)(F.ws + WS_WIN), NTOK, 2 * D, D};
    pg8::StaticOrder S; S.init(NTOK, 2 * D, F.G, (int)blockIdx.x);
    pg8::EpiIn E{(pg8::bf16_t*)(F.ws + WS_YG), (pg8::bf16_t*)(F.ws + WS_U)};
    pg8::gemm_phase<pg8::EpiIn, pg8::StaticOrder, true, true>((PG8_LAS unsigned char*)F.lds, g, S, E);
    if (blockIdx.x >= 32) tail_convert(F, ((int)blockIdx.x - 32) * NWAVES + F.wave, 0, ND_A);
}

__device__ __forceinline__ float neg_expm1(float x) {
    const float p = 1.0f + x * (0.5f + x * (0.16666667f + x * (0.041666668f + x * (0.0083333338f + x * 0.0013888889f))));
    const float ser = -x * p, big = 1.0f - __expf(x);
    return x > -0.5f ? ser : big;
}
__device__ __forceinline__ void phase_scan(Frame& F) {
    const Args& A = *F.a;
    const int wi = F.vcu;
    if (wi >= 256) return;
    const int b = wi >> 6, n = (wi >> 3) & 7, d = (wi >> 2) & 1, q = wi & 3;
    const int tid = F.tid, lane = F.lane, w = F.wave, fr = lane & 15, fq = lane >> 4;
    LAS char* RAW = F.lds;
    LAS char* AT = F.lds + 33792;
    LAS float* AGG = (LAS float*)(F.lds + 66560);
    LAS float* CIN = (LAS float*)(F.lds + 74752);
    const bf16* U = (const bf16*)(F.ws + WS_U);
    bf16* HO = (bf16*)(F.ws + (d ? WS_HB : WS_HF));
    const int chbase = n * 128, och = chbase + q * 32;
    const bf16* GT = (const bf16*)(F.ws + WS_GATE);
    LAS char* BT = F.lds + 81920;
#pragma unroll
    for (int i = 0; i < 2; ++i) {
        const int idx = tid + 512 * i, jrow = idx >> 4, c = idx & 15, nb = jrow >> 4, f2 = jrow & 15;
        *(LAS u32x4*)(BT + jrow * 256 + ((c ^ f2) << 4)) = *(const u32x4*)(GT + ((size_t)(((d * 2 + (nb >> 1)) * 8 + n) * 128 + q * 32 + (nb & 1) * 16 + f2)) * 128 + c * 8);
    }
    float ba[2], bi[2], sp8[2];
#pragma unroll
    for (int h = 0; h < 2; ++h) {
        const int ch = och + h * 16 + fr;
        ba[h] = A.in[I_GAB][d * 1024 + ch]; bi[h] = A.in[I_GXB][d * 1024 + ch];
        sp8[h] = 8.0f * log1pf(expf(-A.in[I_LAM][d * 1024 + ch]));
    }
    const int c8 = tid & 15, r0 = tid >> 4;
    LAS float* CW = (LAS float*)(F.lds + 78848);
    (void)CW;
    float cw[4][8], cb[8];
#pragma unroll
    for (int k = 0; k < 4; ++k) {
        const f32x4 a0 = *(const f32x4*)(A.in[I_CONVW] + k * 1024 + chbase + c8 * 8), a1 = *(const f32x4*)(A.in[I_CONVW] + k * 1024 + chbase + c8 * 8 + 4);
        cw[k][0] = a0.x; cw[k][1] = a0.y; cw[k][2] = a0.z; cw[k][3] = a0.w; cw[k][4] = a1.x; cw[k][5] = a1.y; cw[k][6] = a1.z; cw[k][7] = a1.w;
    }
    { const f32x4 a0 = *(const f32x4*)(A.in[I_CONVB] + chbase + c8 * 8), a1 = *(const f32x4*)(A.in[I_CONVB] + chbase + c8 * 8 + 4);
      cb[0] = a0.x; cb[1] = a0.y; cb[2] = a0.z; cb[3] = a0.w; cb[4] = a1.x; cb[5] = a1.y; cb[6] = a1.z; cb[7] = a1.w; }

    float hcar = 0.f;
    u32x4 pre[5];
    LAS float* cscr = (LAS float*)(F.lds + 98304 + w * 4224);
    const int cgw = F.vcu * NWAVES + w, CNGW = F.G * NWAVES;
    int cit = ND_B + cgw;
    TDesc cd2; f32x4 crg2[4]; bool chas2 = false;
    for (int step = 0; step < 34; ++step) {
        TDesc cd; f32x4 crg[4]; const bool chas = cit < ND_SCAN;
        if (chas) { cd = decode_deferred(F, cit); tr2_load(cd, lane, crg); cit += CNGW; }
        int segbase, seglen, tile;
        if (step < 2) { segbase = NX + b * CL; seglen = CL; tile = d ? (1 - step) : step; }
        else { segbase = b * S; seglen = S; tile = d ? (33 - step) : (step - 2); }
        const int t0 = tile * 128;
        if (step == 0) {
#pragma unroll
            for (int i = 0; i < 5; ++i) {
                const int idx = tid + 512 * i; const int row = idx >> 4, c = idx & 15; const int t = t0 - 2 + row;
                u32x4 v = (u32x4){0u, 0u, 0u, 0u};
                if (idx < 2112 && t >= 0 && t < seglen) v = *(const u32x4*)(U + (size_t)(segbase + t) * D + chbase + c * 8);
                pre[i] = v;
            }
        }
#pragma unroll
        for (int i = 0; i < 5; ++i) { const int idx = tid + 512 * i; if (idx < 2112) *(LAS u32x4*)(RAW + idx * 16) = pre[i]; }
        __syncthreads();
        if (step + 1 < 34) {
            const int s1 = step + 1; int sb1, sl1, tl1;
            if (s1 < 2) { sb1 = NX + b * CL; sl1 = CL; tl1 = d ? (1 - s1) : s1; }
            else { sb1 = b * S; sl1 = S; tl1 = d ? (33 - s1) : (s1 - 2); }
            const int t1 = tl1 * 128;
#pragma unroll
            for (int i = 0; i < 5; ++i) {
                const int idx = tid + 512 * i; const int row = idx >> 4, c = idx & 15; const int t = t1 - 2 + row;
                u32x4 v = (u32x4){0u, 0u, 0u, 0u};
                if (idx < 2112 && t >= 0 && t < sl1) v = *(const u32x4*)(U + (size_t)(sb1 + t) * D + chbase + c * 8);
                pre[i] = v;
            }
        }
#pragma unroll
        for (int i = 0; i < 4; ++i) {
            const int r = r0 + 32 * i;
            float o[8];
#pragma unroll
            for (int j = 0; j < 8; ++j) o[j] = cb[j];
#pragma unroll
            for (int k = 0; k < 4; ++k) {
                const u32x4 x = *(const LAS u32x4*)(RAW + (r + k) * 256 + c8 * 16);
#pragma unroll
                for (int p = 0; p < 4; ++p) { o[2 * p] += cw[k][2 * p] * bflo(x[p]); o[2 * p + 1] += cw[k][2 * p + 1] * bfhi(x[p]); }
            }
            u32x4 ov; ov.x = pk2(o[0], o[1]); ov.y = pk2(o[2], o[3]); ov.z = pk2(o[4], o[5]); ov.w = pk2(o[6], o[7]);
            *(LAS u32x4*)(AT + r * 256 + ((c8 ^ (r & 15)) << 4)) = ov;
        }
        __syncthreads();
        f32x4 acc[4];
#pragma unroll
        for (int nb = 0; nb < 4; ++nb) acc[nb] = (f32x4){0.f, 0.f, 0.f, 0.f};
#pragma unroll
        for (int ks = 0; ks < 4; ++ks) {
            const int row = 16 * w + fr;
            const bf16x8 af = *(const LAS bf16x8*)(AT + row * 256 + (((4 * ks + fq) ^ fr) << 4));
#pragma unroll
            for (int nb = 0; nb < 4; ++nb) {
                const bf16x8 bq = *(const LAS bf16x8*)(BT + (nb * 16 + fr) * 256 + (((4 * ks + fq) ^ fr) << 4));
                acc[nb] = __builtin_amdgcn_mfma_f32_16x16x32_bf16(af, bq, acc[nb], 0, 0, 0);
            }
        }
        float av[2][4], bv[2][4];
#pragma unroll
        for (int h = 0; h < 2; ++h) {
            const int col = q * 32 + h * 16 + fr, chunk = col >> 3, within = col & 7;
#pragma unroll
            for (int reg = 0; reg < 4; ++reg) {
                const int tr = 16 * w + 4 * fq + reg;
                const float r_ = __builtin_amdgcn_rcpf(1.0f + __builtin_amdgcn_exp2f(-1.4426950408889634f * (acc[h][reg] + ba[h])));
                const float i_ = __builtin_amdgcn_rcpf(1.0f + __builtin_amdgcn_exp2f(-1.4426950408889634f * (acc[2 + h][reg] + bi[h])));
                const float la = -sp8[h] * r_;
                const float a_ = __builtin_amdgcn_exp2f(1.4426950408889634f * la);
                const unsigned short ub = *(const LAS unsigned short*)(AT + tr * 256 + ((chunk ^ (tr & 15)) << 4) + within * 2);
                const float uval = __builtin_bit_cast(float, (unsigned)ub << 16);
                av[h][reg] = a_;
                bv[h][reg] = __builtin_amdgcn_sqrtf(neg_expm1(2.0f * la)) * (i_ * uval);
            }
        }
        const int g = 4 * w + fq;
#pragma unroll
        for (int h = 0; h < 2; ++h) {
            float P = 1.f, Hh = 0.f;
#pragma unroll
            for (int s = 0; s < 4; ++s) { const int reg = d ? (3 - s) : s; Hh = av[h][reg] * Hh + bv[h][reg]; P *= av[h][reg]; }
            AGG[(g * 32 + h * 16 + fr) * 2 + 0] = P; AGG[(g * 32 + h * 16 + fr) * 2 + 1] = Hh;
        }
        if (chas2) tr2_finish(cd2, lane, crg2, cscr);
        chas2 = cit < ND_SCAN;
        if (chas2) { cd2 = decode_deferred(F, cit); tr2_load(cd2, lane, crg2); cit += CNGW; }
        __syncthreads();
        if (tid < 32) {
            f32x2 ag[32];
#pragma unroll
            for (int gi = 0; gi < 32; ++gi) ag[gi] = *(const LAS f32x2*)(AGG + (gi * 32 + tid) * 2);
            float hh = hcar;
            if (d == 0) {
#pragma unroll
                for (int gi = 0; gi < 32; ++gi) { CIN[gi * 32 + tid] = hh; hh = ag[gi].x * hh + ag[gi].y; }
            } else {
#pragma unroll
                for (int gi = 31; gi >= 0; --gi) { CIN[gi * 32 + tid] = hh; hh = ag[gi].x * hh + ag[gi].y; }
            }
            hcar = hh;
        }
        __syncthreads();
#pragma unroll
        for (int h = 0; h < 2; ++h) {
            float hh = CIN[g * 32 + h * 16 + fr];
            float outv[4];
#pragma unroll
            for (int s = 0; s < 4; ++s) { const int reg = d ? (3 - s) : s; hh = av[h][reg] * hh + bv[h][reg]; outv[reg] = hh; }
#pragma unroll
            for (int reg = 0; reg < 4; ++reg) {
                const int tr = 16 * w + 4 * fq + reg;
                HO[(size_t)(segbase + t0 + tr) * D + och + h * 16 + fr] = (bf16)f2bf(outv[reg]);
            }
        }
        if (chas) tr2_finish(cd, lane, crg, cscr);
    }
    if (chas2) tr2_finish(cd2, lane, crg2, cscr);
}

__device__ __forceinline__ void phase_combine_h(Frame& F) {
    const u32x4* hf = (const u32x4*)(F.ws + WS_HF); const u32x4* hb = (const u32x4*)(F.ws + WS_HB); const u32x4* yg = (const u32x4*)(F.ws + WS_YG);
    u32x4* hc = (u32x4*)(F.ws + WS_U);
    constexpr int NCH = NTOK * (D / 8);
    const int stride = F.G * NTHREADS;
    for (int i = F.vcu * NTHREADS + F.tid; i < NCH; i += 4 * stride) {
        u32x4 a[4], b[4], y[4];
#pragma unroll
        for (int j = 0; j < 4; ++j) { const int idx = i + j * stride; if (idx < NCH) { a[j] = hf[idx]; b[j] = hb[idx]; y[j] = yg[idx]; } }
#pragma unroll
        for (int j = 0; j < 4; ++j) {
            const int idx = i + j * stride;
            if (idx < NCH) {
                u32x4 r;
#pragma unroll
                for (int q = 0; q < 4; ++q) r[q] = pk2((bflo(a[j][q]) + bflo(b[j][q])) * bflo(y[j][q]), (bfhi(a[j][q]) + bfhi(b[j][q])) * bfhi(y[j][q]));
                hc[idx] = r;
            }
        }
    }
}
__device__ __forceinline__ void phase_gemm_out0(Frame& F) {
    const Args& A = *F.a;
    const bf16* W = (const bf16*)(F.ws + WS_WOUT);
    const bf16* HC = (const bf16*)(F.ws + WS_U);
    float* XA = (float*)(F.ws + WS_XA);
    const int wr = F.wave >> 2, wc = F.wave & 3, fr = F.lane & 15, fq = F.lane >> 4;
    constexpr int NTN = 4, NUNITS = (NTOK / 128) * NTN;
    ALDense al, alN; const bf16* Bp = W; const bf16* BpN = W; Ring R;
    if (F.vcu < NUNITS) { al.init(HC, D, (F.vcu / NTN) * 128, F.tid >> 3, (F.tid >> 3) + 64, dma_kc(F.tid)); Bp = W + (size_t)((F.vcu % NTN) * 256) * D; ring_start(F, R, al, Bp, D); }
    for (int u = F.vcu; u < NUNITS; u += F.G) {
        const int mt = u / NTN, nt = u % NTN, m0 = mt * 128, n0 = nt * 256;
        const int un = u + F.G; const bool hasN = un < NUNITS;
        alN = al; BpN = Bp;
        if (hasN) { alN.init(HC, D, (un / NTN) * 128, F.tid >> 3, (F.tid >> 3) + 64, dma_kc(F.tid)); BpN = W + (size_t)((un % NTN) * 256) * D; }
        f32x4 acc[4][4];
        gemm3_unit<false, 16>(F, R, al, Bp, alN, BpN, hasN, D, acc, u == F.vcu);
        al = alN; Bp = BpN;
        {
            const float* gate = modp(F, 0, cond_of(m0), 2);
            const float* srcb = m0 < NX ? A.in[I_X] + (size_t)m0 * D : A.in[I_CTX] + (size_t)(m0 - NX) * D;
            f32x4 sres[4][4], gt[4];
#pragma unroll
            for (int ni = 0; ni < 4; ++ni) gt[ni] = *(const f32x4*)(gate + n0 + wc * 64 + ni * 16 + fq * 4);
#pragma unroll
            for (int mi = 0; mi < 4; ++mi)
#pragma unroll
                for (int ni = 0; ni < 4; ++ni) sres[mi][ni] = *(const f32x4*)(srcb + (size_t)(wr * 64 + mi * 16 + fr) * D + n0 + wc * 64 + ni * 16 + fq * 4);
#pragma unroll
            for (int mi = 0; mi < 4; ++mi)
#pragma unroll
                for (int ni = 0; ni < 4; ++ni) *(f32x4*)(XA + (size_t)(m0 + wr * 64 + mi * 16 + fr) * D + n0 + wc * 64 + ni * 16 + fq * 4) = sres[mi][ni] + gt[ni] * acc[mi][ni];
        }
    }
    __syncthreads();
    if (F.vcu >= 32) tail_convert(F, (F.vcu - 32) * NWAVES + F.wave, ND_A, ND_B);
}

__device__ __forceinline__ void route_select(const Frame& F, float (&acc)[32], float rbias, int row, LAS int* selL, int li) {
    const int lane = F.lane;
#define BFLY(S, HALF) { const bool up = (lane >> (S)) & 1; _Pragma("unroll") for (int i = 0; i < (HALF); ++i) { \
        const float keep = up ? acc[i + (HALF)] : acc[i]; const float send = up ? acc[i] : acc[i + (HALF)]; acc[i] = keep + __shfl_xor(send, 1 << (S)); } }
    BFLY(0, 16) BFLY(1, 8) BFLY(2, 4) BFLY(3, 2) BFLY(4, 1)
#undef BFLY
    const float tot = acc[0] + __shfl_xor(acc[0], 32);
    const int e = lane & 31;
    const float logit = __shfl(tot, (int)(__builtin_bitreverse32((unsigned)e) >> 27));
    const float sc = 1.0f / (1.0f + expf(-logit));
    const float ss = sc + rbias;
    float m1 = ss;
#pragma unroll
    for (int o = 1; o < 8; o <<= 1) m1 = fmaxf(m1, __shfl_xor(m1, o));
    int i1 = (ss == m1) ? e : 64;
#pragma unroll
    for (int o = 1; o < 8; o <<= 1) i1 = min(i1, __shfl_xor(i1, o));
    const float s2 = (e == i1) ? -INFINITY : ss;
    float m2 = s2;
#pragma unroll
    for (int o = 1; o < 8; o <<= 1) m2 = fmaxf(m2, __shfl_xor(m2, o));
    int i2 = (s2 == m2 && e != i1) ? e : 64;
#pragma unroll
    for (int o = 1; o < 8; o <<= 1) i2 = min(i2, __shfl_xor(i2, o));
    const float gs = m1 + m2;
    float gbest = gs;
    gbest = fmaxf(gbest, __shfl_xor(gbest, 8)); gbest = fmaxf(gbest, __shfl_xor(gbest, 16));
    int gsel = (gs == gbest) ? (e >> 3) : 64;
    gsel = min(gsel, __shfl_xor(gsel, 8)); gsel = min(gsel, __shfl_xor(gsel, 16));
    const int e0 = __shfl(i1, gsel * 8) & 31, e1 = __shfl(i2, gsel * 8) & 31;
    const float w0 = __shfl(sc, e0), w1 = __shfl(sc, e1);
    if (lane == 0) {
        const float inv = 1.0f / (w0 + w1);
        LAS int* cntL = selL + 4 * 68; LAS int* rankL = selL + 2 * 68;
        selL[li * 2] = e0; selL[li * 2 + 1] = e1;
        rankL[li * 2] = __hip_atomic_fetch_add(cntL + e0, 1, __ATOMIC_RELAXED, __HIP_MEMORY_SCOPE_WORKGROUP);
        rankL[li * 2 + 1] = __hip_atomic_fetch_add(cntL + e1, 1, __ATOMIC_RELAXED, __HIP_MEMORY_SCOPE_WORKGROUP);
        ((float2*)(F.ws + WS_WT))[row] = make_float2(w0 * inv, w1 * inv);
        ((int2*)(F.ws + WS_SEL))[row] = make_int2(e0, e1);
    }
}

template <int LAYER>
__device__ __forceinline__ void phase_route(Frame& F) {
    const Args& A = *F.a;
    constexpr int NT = LAYER == 0 ? NTOK : NX;
    constexpr int PER = NT / 256;
    LAS char* RW = F.lds;
    LAS int* selL = (LAS int*)(F.lds + LDS_AUX);
    LAS int* rankL = selL + 2 * 68;
    const int tid = F.tid, lane = F.lane;
    if (tid < 32) (selL + 4 * 68)[tid] = 0;
    {
        f32x4 t[16];
#pragma unroll
        for (int i = 0; i < 16; ++i) { const int idx = tid + 512 * i; t[i] = *(const f32x4*)(A.in[I_RW] + (size_t)(idx >> 3) * 32 + (idx & 7) * 4); }
#pragma unroll
        for (int i = 0; i < 16; ++i) {
            const int idx = tid + 512 * i, k = idx >> 3, e4 = idx & 7;
            const int rho = (((k >> 8) * 4 + (k & 3)) << 6) + ((k >> 2) & 63);
            *(LAS f32x4*)(RW + rho * 128 + ((e4 ^ ((rho >> 1) & 7)) << 4)) = t[i];
        }
    }
    __syncthreads();
    const int blk = F.vcu;
    if (blk < 256) {
        const float* XA = (const float*)(F.ws + WS_XA);
        bf16* H = (bf16*)(F.ws + WS_H);
        const float rbias = A.in[I_RB][lane & 31];
        f32x4 na[4], nb[4];
        load_row4(XA + (size_t)(blk * PER + 2 * F.wave) * D, lane, na); load_row4(XA + (size_t)(blk * PER + 2 * F.wave + 1) * D, lane, nb);
        for (int pi = F.wave; pi < PER / 2; pi += NWAVES) {
            const int li = 2 * pi, row = blk * PER + li;
            const int c = cond_of(row);
            f32x4 va[4], vb[4];
#pragma unroll
            for (int j = 0; j < 4; ++j) { va[j] = na[j]; vb[j] = nb[j]; }
            if constexpr (LAYER == 1) {
                const bf16* dl = (const bf16*)(F.ws + WS_DELTA) + (size_t)row * D;
#pragma unroll
                for (int j = 0; j < 4; ++j) {
                    const u32x2 d0 = *(const u32x2*)(dl + 4 * lane + 256 * j), d1 = *(const u32x2*)(dl + D + 4 * lane + 256 * j);
                    va[j] += (f32x4){bflo(d0.x), bfhi(d0.x), bflo(d0.y), bfhi(d0.y)}; vb[j] += (f32x4){bflo(d1.x), bfhi(d1.x), bflo(d1.y), bfhi(d1.y)};
                }
            }
            if (pi + NWAVES < PER / 2) { load_row4(XA + (size_t)(row + 2 * NWAVES) * D, lane, na); load_row4(XA + (size_t)(row + 2 * NWAVES + 1) * D, lane, nb); }
            const float ra = row_rstd(va), rb = row_rstd(vb);
            if constexpr ((LAYER == 1 && L1_FP8) || (LAYER == 0 && L0_FP8)) {
                row_modulate_store8(va, ra, A.in[I_N2G] + LAYER * D, modp(F, LAYER, c, 4), modp(F, LAYER, c, 3), (unsigned char*)H + (size_t)row * D, lane);
                row_modulate_store8(vb, rb, A.in[I_N2G] + LAYER * D, modp(F, LAYER, c, 4), modp(F, LAYER, c, 3), (unsigned char*)H + (size_t)(row + 1) * D, lane);
            } else {
                row_modulate_store(va, ra, A.in[I_N2G] + LAYER * D, modp(F, LAYER, c, 4), modp(F, LAYER, c, 3), H + (size_t)row * D, lane);
                row_modulate_store(vb, rb, A.in[I_N2G] + LAYER * D, modp(F, LAYER, c, 4), modp(F, LAYER, c, 3), H + (size_t)(row + 1) * D, lane);
            }
            float acca[32], accb[32];
#pragma unroll
            for (int e = 0; e < 32; ++e) { acca[e] = 0.f; accb[e] = 0.f; }
#pragma unroll 1
            for (int jc = 0; jc < 16; ++jc) {
                const int j = jc >> 2, cc = jc & 3;
                f32x4 ha4 = va[0], hb4 = vb[0];
                if (j == 1) { ha4 = va[1]; hb4 = vb[1]; }
                if (j == 2) { ha4 = va[2]; hb4 = vb[2]; }
                if (j == 3) { ha4 = va[3]; hb4 = vb[3]; }
                float ha = ha4.x, hb = hb4.x;
                if (cc == 1) { ha = ha4.y; hb = hb4.y; }
                if (cc == 2) { ha = ha4.z; hb = hb4.z; }
                if (cc == 3) { ha = ha4.w; hb = hb4.w; }
                const int rho = jc * 64 + lane;
                const LAS char* rp = RW + rho * 128; const int key = (rho >> 1) & 7;
                f32x4 w8[8];
#pragma unroll
                for (int e4 = 0; e4 < 8; ++e4) w8[e4] = *(const LAS f32x4*)(rp + ((e4 ^ key) << 4));
#pragma unroll
                for (int e4 = 0; e4 < 8; ++e4) {
                    acca[e4 * 4 + 0] += ha * w8[e4].x; acca[e4 * 4 + 1] += ha * w8[e4].y; acca[e4 * 4 + 2] += ha * w8[e4].z; acca[e4 * 4 + 3] += ha * w8[e4].w;
                    accb[e4 * 4 + 0] += hb * w8[e4].x; accb[e4 * 4 + 1] += hb * w8[e4].y; accb[e4 * 4 + 2] += hb * w8[e4].z; accb[e4 * 4 + 3] += hb * w8[e4].w;
                }
            }
            route_select(F, acca, rbias, row, selL, li);
            route_select(F, accb, rbias, row + 1, selL, li + 1);
        }
        __syncthreads();
        if (tid < 32) ((int*)(F.ws + WS_BLKCNT))[blk * 32 + tid] = (selL + 4 * 68)[tid];
        __syncthreads();
        for (int i = tid; i < PER; i += NTHREADS) ((int2*)(F.ws + WS_LRANK))[blk * PER + i] = make_int2(rankL[2 * i], rankL[2 * i + 1]);
    }
}

template <int LAYER>
__device__ __forceinline__ void phase_slots(Frame& F) {
    constexpr int NT = LAYER == 0 ? NTOK : NX;
    constexpr int PER = NT / 256;
    LAS int* part = (LAS int*)F.lds;
    LAS int* tot = part + 1024;
    LAS int* base = tot + 32;
    LAS int* pst = base + 32;
    const int tid = F.tid, blk = F.vcu;
    const int* bc = (const int*)(F.ws + WS_BLKCNT);
    {
        const int e = tid & 31, p = tid >> 5;
        int st = 0, sb = 0;
        for (int b2 = p; b2 < 256; b2 += 16) { const int c = bc[b2 * 32 + e]; st += c; sb += (b2 < blk) ? c : 0; }
        part[p * 32 + e] = st; part[512 + p * 32 + e] = sb;
    }
    __syncthreads();
    if (tid < 32) { int st = 0, sb = 0; for (int p = 0; p < 16; ++p) { st += part[p * 32 + tid]; sb += part[512 + p * 32 + tid]; } tot[tid] = st; base[tid] = sb; }
    __syncthreads();
    constexpr int PADM = (LAYER == 0 && !L0_FP8) ? 255 : 127;
    if (tid == 0) { int s = 0; for (int e = 0; e < 32; ++e) { pst[e] = s; s += (tot[e] + PADM) & ~PADM; } pst[32] = s; }
    __syncthreads();
    int* slot_tok = (int*)(F.ws + WS_SLOTTOK); float* slot_w = (float*)(F.ws + WS_SLOTW);
    if (blk == 0 && tid < 33) ((int*)(F.ws + WS_PSTART))[tid] = pst[tid];
    if (blk < 256) {
        for (int i = tid; i < PER; i += NTHREADS) {
            const int t = blk * PER + i;
            const int2 se = ((const int2*)(F.ws + WS_SEL))[t]; const int2 lr = ((const int2*)(F.ws + WS_LRANK))[t]; const float2 wt = ((const float2*)(F.ws + WS_WT))[t];
            const int s0 = pst[se.x] + base[se.x] + lr.x, s1 = pst[se.y] + base[se.y] + lr.y;
            slot_tok[s0] = t; slot_w[s0] = wt.x; slot_tok[s1] = t; slot_w[s1] = wt.y;
            ((int2*)(F.ws + WS_TOKSLOT))[t] = make_int2(s0, s1);
        }
    }
    if (blk < 32) {
        const int lo = pst[blk] + tot[blk], hi = pst[blk + 1];
        for (int s = lo + tid; s < hi; s += NTHREADS) { slot_tok[s] = 0; slot_w[s] = 0.f; }
    }
}

template <int LAYER>
__device__ __forceinline__ void phase_moe_up(Frame& F) {
    constexpr bool F8 = (LAYER == 1 && L1_FP8) || (LAYER == 0 && L0_FP8);
    constexpr int KA = F8 ? D / 2 : D;
    LAS int* pst = (LAS int*)(F.lds + LDS_AUX);
    if (F.tid < 33) pst[F.tid] = ((const int*)(F.ws + WS_PSTART))[F.tid];
    __syncthreads();
    const int ntiles = pst[32] >> 7, nunits = ntiles * 4;
    const bf16* H = (const bf16*)(F.ws + WS_H);
    const bf16* W = F8 ? (const bf16*)(F.ws + WS_WUP + (size_t)LAYER * 64 * MiB) : (const bf16*)(F.ws + WS_WUP) + (size_t)LAYER * 32 * 1024 * 1024;
    const int* slot_tok = (const int*)(F.ws + WS_SLOTTOK); const float* slot_w = (const float*)(F.ws + WS_SLOTW);
    bf16* G = (bf16*)(F.ws + WS_G);
    const int wr = F.wave >> 2, wc = F.wave & 3, fr = F.lane & 15, fq = F.lane >> 4;
    LAS int* tix = pst + 64;
    for (int i = F.tid; i < 8 * 128; i += NTHREADS) { const int uu = F.vcu + (i >> 7) * F.G; tix[i] = (uu < nunits) ? slot_tok[(uu >> 2) * 128 + (i & 127)] : 0; }
    __syncthreads();
    ALGather al, alN; const bf16* Bp = W; const bf16* BpN = W; Ring R;
#define MOE_SETUP(uu, ui, al_, Bp_) do { const int m0_ = ((uu) >> 2) * 128; int e_ = 0; \
        for (int x = 1; x < 32; ++x) e_ = (pst[x] <= m0_) ? x : e_; \
        al_.p0 = H + (size_t)tix[(ui) * 128 + (F.tid >> 3)] * KA + dma_kc(F.tid); al_.p1 = H + (size_t)tix[(ui) * 128 + (F.tid >> 3) + 64] * KA + dma_kc(F.tid); \
        Bp_ = W + ((size_t)e_ * 1024 + ((uu) & 3) * 256) * KA; } while (0)
    if (F.vcu < nunits) { MOE_SETUP(F.vcu, 0, al, Bp); ring_start(F, R, al, Bp, KA); }
    int ui = 0;
    for (int u = F.vcu; u < nunits; u += F.G, ++ui) {
        const int mt = u >> 2, j = u & 3, m0 = mt * 128;
        const int un = u + F.G; const bool hasN = un < nunits;
        alN = al; BpN = Bp;
        if (hasN) MOE_SETUP(un, ui + 1, alN, BpN);
        f32x4 acc[4][4];
        if constexpr (F8) gemm3_unit<true, 8>(F, R, al, Bp, alN, BpN, hasN, KA, acc, u == F.vcu, FP8_SCALE_W, FP8_SCALE_ONE);
        else gemm3_unit<false, 8>(F, R, al, Bp, alN, BpN, hasN, KA, acc, u == F.vcu);
        al = alN; Bp = BpN;
#pragma unroll
        for (int mi = 0; mi < 4; ++mi) {
            const int row = m0 + wr * 64 + mi * 16 + fr;
            const float wgt = slot_w[row];
#pragma unroll
            for (int p = 0; p < 2; ++p) {
                const f32x4 g = acc[mi][2 * p], uu = acc[mi][2 * p + 1];
                float o[4];
#pragma unroll
                for (int c = 0; c < 4; ++c) o[c] = g[c] / (1.0f + __expf(-g[c])) * uu[c] * wgt;
                if constexpr (F8) {
#pragma unroll
                    for (int c = 0; c < 4; ++c) o[c] = fminf(fmaxf(o[c] * 8.0f, -448.0f), 448.0f);
                    *(unsigned*)((unsigned char*)G + (size_t)row * DEXP + j * 128 + wc * 32 + p * 16 + fq * 4) = pk4_fp8(o[0], o[1], o[2], o[3]);
                } else {
                    u32x2 ov; ov.x = pk2(o[0], o[1]); ov.y = pk2(o[2], o[3]);
                    *(u32x2*)(G + (size_t)row * DEXP + j * 128 + wc * 32 + p * 16 + fq * 4) = ov;
                }
            }
        }
    }
}

template <int LAYER>
__device__ __forceinline__ void phase_moe_down(Frame& F) {
    constexpr bool F8 = (LAYER == 1 && L1_FP8) || (LAYER == 0 && L0_FP8);
    constexpr int KA = F8 ? DEXP / 2 : DEXP;
    LAS int* pst = (LAS int*)(F.lds + LDS_AUX);
    if (F.tid < 33) pst[F.tid] = ((const int*)(F.ws + WS_PSTART))[F.tid];
    __syncthreads();
    const int ntiles = pst[32] >> 7, nunits = ntiles * 4;
    const bf16* G = (const bf16*)(F.ws + WS_G);
    const bf16* W = F8 ? (const bf16*)(F.ws + WS_WDN + (size_t)LAYER * 32 * MiB) : (const bf16*)(F.ws + WS_WDN) + (size_t)LAYER * 32 * 1024 * 512;
    bf16* Y = (bf16*)(F.ws + WS_Y);
    if constexpr (LAYER == 0 && !L0_FP8) {
        pg8::Gemm g{(const pg8::bf16_t*)G, (const pg8::bf16_t*)W, PMAX, 32 * 1024, DEXP};
        pg8::MoeOrder S{F.G, F.vcu, (pst[32] >> 8) * 4, (const PG8_LAS int*)pst};
        pg8::EpiY E{(pg8::bf16_t*)Y};
        pg8::gemm_phase<pg8::EpiY, pg8::MoeOrder, true, true>((PG8_LAS unsigned char*)F.lds, g, S, E);
        return;
    }
    const int wr = F.wave >> 2, wc = F.wave & 3, fr = F.lane & 15, fq = F.lane >> 4;
    ALDense al, alN; const bf16* Bp = W; const bf16* BpN = W; Ring R;
#define MOED_SETUP(uu, al_, Bp_) do { const int m0_ = ((uu) >> 2) * 128; int e_ = 0; \
        for (int x = 1; x < 32; ++x) e_ = (pst[x] <= m0_) ? x : e_; \
        al_.init(G, KA, m0_, F.tid >> 3, (F.tid >> 3) + 64, dma_kc(F.tid)); Bp_ = W + ((size_t)e_ * 1024 + ((uu) & 3) * 256) * KA; } while (0)
    if (F.vcu < nunits) { MOED_SETUP(F.vcu, al, Bp); ring_start(F, R, al, Bp, KA); }
    for (int u = F.vcu; u < nunits; u += F.G) {
        const int mt = u >> 2, j = u & 3, m0 = mt * 128, n0 = j * 256;
        const int un = u + F.G; const bool hasN = un < nunits;
        alN = al; BpN = Bp;
        if (hasN) MOED_SETUP(un, alN, BpN);
        f32x4 acc[4][4];
        if constexpr (F8) gemm3_unit<true, 16>(F, R, al, Bp, alN, BpN, hasN, KA, acc, u == F.vcu, FP8_SCALE_W, FP8_SCALE_G);
        else gemm3_unit<false, 16>(F, R, al, Bp, alN, BpN, hasN, KA, acc, u == F.vcu);
        al = alN; Bp = BpN;
#pragma unroll
        for (int mi = 0; mi < 4; ++mi) {
            const int row = m0 + wr * 64 + mi * 16 + fr;
#pragma unroll
            for (int ni = 0; ni < 4; ++ni) {
                const f32x4 v = acc[mi][ni];
                u32x2 o; o.x = pk2(v.x, v.y); o.y = pk2(v.z, v.w);
                *(u32x2*)(Y + (size_t)row * D + n0 + wc * 64 + ni * 16 + fq * 4) = o;
            }
        }
    }
}

struct CRow { f32x4 x[4]; u32x2 y0[4], y1[4]; };
__device__ __forceinline__ void crow_load(const Frame& F, int row, int2 ts, CRow& r) {
    const float* XA = (const float*)(F.ws + WS_XA); const bf16* Y = (const bf16*)(F.ws + WS_Y);
#pragma unroll
    for (int j = 0; j < 4; ++j) {
        const int c0 = 4 * F.lane + 256 * j;
        r.x[j] = *(const f32x4*)(XA + (size_t)row * D + c0);
        r.y0[j] = *(const u32x2*)(Y + (size_t)ts.x * D + c0); r.y1[j] = *(const u32x2*)(Y + (size_t)ts.y * D + c0);
    }
}
__device__ __forceinline__ void crow_combine(const Frame& F, const CRow& r, const float* gate, f32x4 (&v)[4]) {
#pragma unroll
    for (int j = 0; j < 4; ++j) {
        const int c0 = 4 * F.lane + 256 * j;
        const f32x4 gt = *(const f32x4*)(gate + c0);
        f32x4 y; y.x = bflo(r.y0[j].x) + bflo(r.y1[j].x); y.y = bfhi(r.y0[j].x) + bfhi(r.y1[j].x); y.z = bflo(r.y0[j].y) + bflo(r.y1[j].y); y.w = bfhi(r.y0[j].y) + bfhi(r.y1[j].y);
        v[j] = r.x[j] + gt * y;
    }
}

__device__ __forceinline__ void phase_combine0(Frame& F) {
    const Args& A = *F.a;
    const int gw = F.vcu * NWAVES + F.wave, NGW = F.G * NWAVES;
    float* XA = (float*)(F.ws + WS_XA); bf16* H = (bf16*)(F.ws + WS_H);
    const int2* TS = (const int2*)(F.ws + WS_TOKSLOT);
    CRow cn; int2 tsn = make_int2(0, 0);
    if (gw < NTOK) crow_load(F, gw, TS[gw], cn);
    if (gw + NGW < NTOK) tsn = TS[gw + NGW];
    for (int row = gw; row < NTOK; row += NGW) {
        const int c = cond_of(row);
        const CRow cr = cn;
        const int nr = row + NGW;
        if (nr < NTOK) crow_load(F, nr, tsn, cn);
        if (nr + NGW < NTOK) tsn = TS[nr + NGW];
        f32x4 v[4];
        crow_combine(F, cr, modp(F, 0, c, 5), v);
#pragma unroll
        for (int j = 0; j < 4; ++j) *(f32x4*)(XA + (size_t)row * D + 4 * F.lane + 256 * j) = v[j];
        const float rstd = row_rstd(v);
        row_modulate_store(v, rstd, A.in[I_N1G] + D, modp(F, 1, c, 1), modp(F, 1, c, 0), H + (size_t)row * D, F.lane);
    }
}

__device__ __forceinline__ void phase_qkv(Frame& F) {
    LAS float* CS = (LAS float*)(F.lds + LDS_AUX);
    for (int i = F.tid; i < 1024; i += NTHREADS) {
        const int p = i >> 4, f = i & 15;
        const float inv = 1.0f / powf(10000.0f, (float)f / 16.0f);
        const float ang = (float)p * inv;
        const double rev = (double)ang * 0.15915494309189535;
        const float fr_ = (float)(rev - floor(rev));
        CS[i * 2] = __builtin_amdgcn_cosf(fr_); CS[i * 2 + 1] = __builtin_amdgcn_sinf(fr_);
    }
    __syncthreads();
    pg8::Gemm g{(const pg8::bf16_t*)(F.ws + WS_H), (const pg8::bf16_t*)(F.ws + WS_WQKV), NX, 3 * D, D};
    pg8::QkvOrder S; S.init(F.G, (int)blockIdx.x);
    pg8::EpiQKV E{(pg8::bf16_t*)(F.ws + WS_Q), (pg8::bf16_t*)(F.ws + WS_K), (pg8::bf16_t*)(F.ws + WS_VT), (const PG8_LAS float*)CS};
    pg8::gemm_phase<pg8::EpiQKV, pg8::QkvOrder, true, true>((PG8_LAS unsigned char*)F.lds, g, S, E);
    {
        const bf16* H = (const bf16*)(F.ws + WS_H); const bf16* W = (const bf16*)(F.ws + WS_WQKV);
        bf16* Kb = (bf16*)(F.ws + WS_K); bf16* VT = (bf16*)(F.ws + WS_VT);
        const int wr = F.wave >> 2, wc = F.wave & 3, fr = F.lane & 15, fq = F.lane >> 4;
        constexpr int NCU = (NC / 128) * 16;
        ALDense al, alN; const bf16* Bp = W; const bf16* BpN = W; Ring R;
#define QC_SETUP(vv, al_, Bp_) do { al_.init(H, D, NX + ((vv) >> 4) * 128, F.tid >> 3, (F.tid >> 3) + 64, dma_kc(F.tid)); Bp_ = W + (size_t)(1024 + ((vv) & 15) * 128) * D; } while (0)
        if (F.vcu < NCU) { QC_SETUP(F.vcu, al, Bp); ringn_start(F, R, al, Bp, D); }
        for (int v = F.vcu; v < NCU; v += F.G) {
            const int mt = v >> 4, nt = v & 15, m0 = NX + mt * 128;
            const int vn = v + F.G; const bool hasN = vn < NCU;
            alN = al; BpN = Bp;
            if (hasN) QC_SETUP(vn, alN, BpN);
            f32x4 acc[4][2];
            gemm3n_unit<16>(F, R, al, Bp, alN, BpN, hasN, D, acc, v == F.vcu);
            al = alN; Bp = BpN;
#pragma unroll
            for (int mi = 0; mi < 4; ++mi) {
                const int row = m0 + wr * 64 + mi * 16 + fr;
                const int b = (row - NX) >> 8, pos = ::S + ((row - NX) & 255);
                if (nt < 8) {
                    const int hi2 = nt * 2 + (wc >> 1);
                    bf16* dst = Kb + ((size_t)(b * 16 + hi2) * KEYS + pos) * 64 + (wc & 1) * 32;
#pragma unroll
                    for (int ni = 0; ni < 2; ++ni) { const f32x4 o = acc[mi][ni]; u32x2 ov; ov.x = pk2(o.x, o.y); ov.y = pk2(o.z, o.w); *(u32x2*)(dst + ni * 16 + fq * 4) = ov; }
                } else {
                    const int ppos = (pos & ~12) | ((pos & 4) << 1) | ((pos & 8) >> 1);
#pragma unroll
                    for (int ni = 0; ni < 2; ++ni) {
                        const int vd = wc * 32 + ni * 16 + fq * 4;
                        bf16* vp = VT + ((size_t)(b * 8 + (nt - 8)) * 128 + vd) * KEYS + ppos;
                        const f32x4 o = acc[mi][ni];
                        const unsigned p01 = pk2(o.x, o.y), p23 = pk2(o.z, o.w);
                        vp[0] = (bf16)(p01 & 0xffffu); vp[KEYS] = (bf16)(p01 >> 16); vp[2 * KEYS] = (bf16)(p23 & 0xffffu); vp[3 * KEYS] = (bf16)(p23 >> 16);
                    }
                }
            }
        }
#undef QC_SETUP
    }
}

constexpr int ATT_STAGE = 32768;
__device__ __forceinline__ int crow(int r, int hi) { return (r & 3) + 8 * (r >> 2) + 4 * hi; }
__device__ __forceinline__ float max3f_(float a, float b, float c) { float r; asm("v_max3_f32 %0, %1, %2, %3" : "=v"(r) : "v"(a), "v"(b), "v"(c)); return r; }
__device__ __forceinline__ float max2f_(float a, float b) { float r; asm("v_max_f32_e32 %0, %1, %2" : "=v"(r) : "v"(a), "v"(b)); return r; }
__device__ __forceinline__ void phase_attn(Frame& F) {
    const Args& A = *F.a;
    const int tid = F.tid, lane = F.lane, w = F.wave, r32 = lane & 31, hi = lane >> 5;
    const int mp = w >> 2, wq = w & 3;
    LAS char* lds = F.lds;
    float lam;
    { const float* dl = A.in[I_DALAM]; const float s1 = wave_sum(dl[lane] * dl[64 + lane]), s2 = wave_sum(dl[128 + lane] * dl[192 + lane]);
      lam = expf(s1) - expf(s2) + (0.8f - 0.6f * expf(-0.3f)); }
    const float oscale = 1.0f - (0.8f - 0.6f * expf(-0.3f));
    const bf16* Q = (const bf16*)(F.ws + WS_Q); const bf16* Kb = (const bf16*)(F.ws + WS_K); const bf16* VT = (const bf16*)(F.ws + WS_VT);
    bf16* AO = (bf16*)(F.ws + WS_AO);
    constexpr int NUNITS = NB * 8 * (S / 128), NTILES = KEYS / 64;
    LAS char* cbuf = lds + 65536 + w * 4096;
    const int cgw = F.vcu * NWAVES + w, CNGW = F.G * NWAVES;
    int cit = cgw; bool chas = cit < ND_ATTN;
    if (chas) { const TDesc cd = L1_FP8 ? decode_moe8(F, cit) : decode_moe(F, cit, 1); tr3_dma(cd, lane, cbuf); }
    for (int u = F.vcu; u < NUNITS; u += F.G) {
        const int bh = u >> 5, qb = u & 31, q0 = qb * 128;
        const bf16* Kg[2]; Kg[0] = Kb + (size_t)(bh * 2 + 0) * KEYS * 64; Kg[1] = Kb + (size_t)(bh * 2 + 1) * KEYS * 64;
        const bf16* Vg = VT + (size_t)bh * 128 * KEYS;
        LAS char* qlds = lds + 98304 + w * 4096;
        { const bf16* qp = Q + ((size_t)(bh * 2 + mp) * S + q0 + wq * 32 + r32) * 64 + hi * 8;
#pragma unroll
          for (int ks = 0; ks < 4; ++ks) __builtin_amdgcn_global_load_lds((const unsigned*)(qp + ks * 16), (LAS unsigned*)(qlds + ks * 1024), 16, 0, 0); }
        f32x16 o[4];
#pragma unroll
        for (int vb = 0; vb < 4; ++vb)
#pragma unroll
            for (int r = 0; r < 16; ++r) o[vb][r] = 0.f;
        float mrun = 0.f, lrun = 0.f;
        const int drow = w * 8 + (lane >> 3), dch = ((lane & 7) ^ ((drow >> 1) & 7)) * 8;
        const bf16* gk0 = Kg[0] + (size_t)drow * 64 + dch; const bf16* gk1 = Kg[1] + (size_t)drow * 64 + dch;
        const bf16* gv0 = Vg + (size_t)drow * KEYS + dch; const bf16* gv1 = Vg + (size_t)(64 + drow) * KEYS + dch;
#define ATT_DMA(t_, st_) do { LAS char* sb_ = lds + (st_) * ATT_STAGE + w * 1024; \
            __builtin_amdgcn_global_load_lds((const unsigned*)(gk0 + (size_t)(t_) * 64 * 64), (LAS unsigned*)(sb_), 16, 0, 0); \
            __builtin_amdgcn_global_load_lds((const unsigned*)(gk1 + (size_t)(t_) * 64 * 64), (LAS unsigned*)(sb_ + 8192), 16, 0, 0); \
            __builtin_amdgcn_global_load_lds((const unsigned*)(gv0 + (t_) * 64), (LAS unsigned*)(sb_ + 16384), 16, 0, 0); \
            __builtin_amdgcn_global_load_lds((const unsigned*)(gv1 + (t_) * 64), (LAS unsigned*)(sb_ + 16384 + 8192), 16, 0, 0); } while (0)
        ATT_DMA(0, 0);
        __syncthreads();
        for (int t = 0; t < NTILES; ++t) {
            const int st = t & 1;
            if (t + 1 < NTILES) ATT_DMA(t + 1, st ^ 1);
            const LAS char* Kt = lds + st * ATT_STAGE + mp * 8192;
            const LAS char* Vt = lds + st * ATT_STAGE + 16384;
            f32x16 s0, s1;
            { const float nm = -mrun;
#pragma unroll
              for (int r = 0; r < 16; ++r) { s0[r] = nm; s1[r] = nm; } }
            bf16x8 kf[8], qf[4];
#pragma unroll
            for (int ks = 0; ks < 4; ++ks) qf[ks] = *(const LAS bf16x8*)(qlds + ks * 1024 + lane * 16);
#pragma unroll
            for (int ks = 0; ks < 4; ++ks) {
                kf[2 * ks] = *(const LAS bf16x8*)(Kt + swz128(r32, 2 * ks + hi));
                kf[2 * ks + 1] = *(const LAS bf16x8*)(Kt + swz128(32 + r32, 2 * ks + hi));
            }
            u32x4 vf[2][4];
#define VLOAD(dst, vb_) do { const int vrow_ = (vb_) * 32 + r32; _Pragma("unroll") for (int kk_ = 0; kk_ < 4; ++kk_) \
                dst[kk_] = *(const LAS u32x4*)(Vt + swz128(vrow_, 2 * kk_ + hi)); } while (0)
            VLOAD(vf[0], 0);
            __builtin_amdgcn_sched_barrier(0);

#pragma unroll
            for (int ks = 0; ks < 4; ++ks) {
                s0 = __builtin_amdgcn_mfma_f32_32x32x16_bf16(kf[2 * ks], qf[ks], s0, 0, 0, 0);
                s1 = __builtin_amdgcn_mfma_f32_32x32x16_bf16(kf[2 * ks + 1], qf[ks], s1, 0, 0, 0);
            }

            float mx;
            { float a_ = max3f_(s0[0], s0[1], s1[0]), b_ = max3f_(s0[2], s0[3], s1[1]); a_ = max3f_(a_, s1[2], s1[3]);
#pragma unroll
              for (int r = 4; r < 16; r += 4) { a_ = max3f_(a_, s0[r], s0[r + 1]); b_ = max3f_(b_, s0[r + 2], s0[r + 3]); a_ = max3f_(a_, s1[r], s1[r + 1]); b_ = max3f_(b_, s1[r + 2], s1[r + 3]); }
              mx = max2f_(a_, b_);
              const auto rr = __builtin_amdgcn_permlane32_swap(__builtin_bit_cast(unsigned, mx), __builtin_bit_cast(unsigned, mx), false, false);
              mx = max2f_(__builtin_bit_cast(float, rr[0]), __builtin_bit_cast(float, rr[1])); }
            if (t == 0 || __any(mx > 8.0f)) {
                const float dl = (t == 0) ? mx : fmaxf(mx, 0.f);
                mrun += dl;
#pragma unroll
                for (int r = 0; r < 16; ++r) { s0[r] -= dl; s1[r] -= dl; }
                if (t > 0) {
                    const float f = __builtin_amdgcn_exp2f(-dl);
                    lrun *= f;
#pragma unroll
                    for (int vb = 0; vb < 4; ++vb)
#pragma unroll
                        for (int r = 0; r < 16; ++r) o[vb][r] *= f;
                }
            }
            float psum = 0.f;
#pragma unroll
            for (int r = 0; r < 16; ++r) { s0[r] = __builtin_amdgcn_exp2f(s0[r]); s1[r] = __builtin_amdgcn_exp2f(s1[r]); psum += s0[r] + s1[r]; }
            lrun += psum;
            bf16x8 pf[4];
#pragma unroll
            for (int s = 0; s < 2; ++s) {
                u32x4 a, b2;
                a.x = pk2(s0[8 * s + 0], s0[8 * s + 1]); a.y = pk2(s0[8 * s + 2], s0[8 * s + 3]); a.z = pk2(s0[8 * s + 4], s0[8 * s + 5]); a.w = pk2(s0[8 * s + 6], s0[8 * s + 7]);
                b2.x = pk2(s1[8 * s + 0], s1[8 * s + 1]); b2.y = pk2(s1[8 * s + 2], s1[8 * s + 3]); b2.z = pk2(s1[8 * s + 4], s1[8 * s + 5]); b2.w = pk2(s1[8 * s + 6], s1[8 * s + 7]);
                pf[s] = __builtin_bit_cast(bf16x8, a); pf[2 + s] = __builtin_bit_cast(bf16x8, b2);
            }
#pragma unroll
            for (int vb = 0; vb < 4; ++vb) {
                if (vb + 1 < 4) VLOAD(vf[(vb + 1) & 1], vb + 1);
                __builtin_amdgcn_sched_barrier(0);

#pragma unroll
                for (int kk = 0; kk < 4; ++kk)
                    o[vb] = __builtin_amdgcn_mfma_f32_32x32x16_bf16(__builtin_bit_cast(bf16x8, vf[vb & 1][kk]), pf[kk], o[vb], 0, 0, 0);

            }
#undef VLOAD
            __syncthreads();
            if ((t % 11) == 5 && chas) {
                asm volatile("s_waitcnt vmcnt(0)" ::: "memory");
                { if (L1_FP8) { const TDesc cd = decode_moe8(F, cit); tr3_finish_fp8(cd, lane, cbuf); } else { const TDesc cd = decode_moe(F, cit, 1); tr3_finish(cd, lane, cbuf); } }
                LDS_WAIT();
                cit += CNGW; chas = cit < ND_ATTN;
                if (chas) { const TDesc cd = L1_FP8 ? decode_moe8(F, cit) : decode_moe(F, cit, 1); tr3_dma(cd, lane, cbuf); }
            }
        }
#undef ATT_DMA
        lrun += __shfl_xor(lrun, 32);
        const float linv = 1.0f / lrun;
        LAS float* XO = (LAS float*)lds;
        if (mp == 1) {
#pragma unroll
            for (int vb = 0; vb < 4; ++vb)
#pragma unroll
                for (int r = 0; r < 16; ++r) XO[(wq * 64 + vb * 16 + r) * 64 + lane] = o[vb][r] * linv;
        }
        __syncthreads();
        if (mp == 0) {
            float ssq = 0.f;
#pragma unroll
            for (int vb = 0; vb < 4; ++vb)
#pragma unroll
                for (int r = 0; r < 16; ++r) { const float v = o[vb][r] * linv - lam * XO[(wq * 64 + vb * 16 + r) * 64 + lane]; o[vb][r] = v; ssq += v * v; }
            ssq += __shfl_xor(ssq, 32);
            const float rstd = rsqrtf(ssq * (1.0f / 128.0f) + EPS) * oscale;
            const int b = bh >> 3, h = bh & 7;
            bf16* dst = AO + (size_t)(b * S + q0 + wq * 32 + r32) * D + h * 128;
            const float* sg = A.in[I_SUBLN];
#pragma unroll
            for (int vb = 0; vb < 4; ++vb)
#pragma unroll
                for (int rq = 0; rq < 4; ++rq) {
                    const int v0 = vb * 32 + 8 * rq + 4 * hi;
                    const f32x4 g4 = *(const f32x4*)(sg + v0);
                    u32x2 ov; ov.x = pk2(o[vb][4 * rq] * rstd * g4.x, o[vb][4 * rq + 1] * rstd * g4.y); ov.y = pk2(o[vb][4 * rq + 2] * rstd * g4.z, o[vb][4 * rq + 3] * rstd * g4.w);
                    *(u32x2*)(dst + v0) = ov;
                }
        }
        __syncthreads();
    }
    while (chas) {
        asm volatile("s_waitcnt vmcnt(0)" ::: "memory");
        { if (L1_FP8) { const TDesc cd = decode_moe8(F, cit); tr3_finish_fp8(cd, lane, cbuf); } else { const TDesc cd = decode_moe(F, cit, 1); tr3_finish(cd, lane, cbuf); } }
        LDS_WAIT();
        cit += CNGW; chas = cit < ND_ATTN;
        if (chas) { const TDesc cd = L1_FP8 ? decode_moe8(F, cit) : decode_moe(F, cit, 1); tr3_dma(cd, lane, cbuf); }
    }
}

__device__ __forceinline__ void phase_gemm_wo(Frame& F) {
    pg8::Gemm g{(const pg8::bf16_t*)(F.ws + WS_AO), (const pg8::bf16_t*)(F.ws + WS_WO), NX, D, D};
    pg8::StaticOrder S; S.init(NX, D, F.G, (int)blockIdx.x);
    pg8::EpiScaleBf16 E{(pg8::bf16_t*)(F.ws + WS_DELTA), D, modp(F, 1, 0, 2), 6144};
    pg8::gemm_phase<pg8::EpiScaleBf16, pg8::StaticOrder, true, true>((PG8_LAS unsigned char*)F.lds, g, S, E);
}

__device__ __forceinline__ void phase_final(Frame& F) {
    const Args& A = *F.a;
    const int gw = F.vcu * NWAVES + F.wave, NGW = F.G * NWAVES;
    const int2* TS = (const int2*)(F.ws + WS_TOKSLOT);
    CRow cn; int2 tsn = make_int2(0, 0);
    if (gw < NX) crow_load(F, gw, TS[gw], cn);
    if (gw + NGW < NX) tsn = TS[gw + NGW];
    for (int row = gw; row < NX; row += NGW) {
        const CRow cr = cn;
        const int nr = row + NGW;
        if (nr < NX) crow_load(F, nr, tsn, cn);
        if (nr + NGW < NX) tsn = TS[nr + NGW];
        f32x4 v[4];
        crow_combine(F, cr, modp(F, 1, row >> 12, 5), v);
        { const bf16* dl = (const bf16*)(F.ws + WS_DELTA) + (size_t)row * D;
#pragma unroll
          for (int j = 0; j < 4; ++j) { const u32x2 d0 = *(const u32x2*)(dl + 4 * F.lane + 256 * j); v[j] += (f32x4){bflo(d0.x), bfhi(d0.x), bflo(d0.y), bfhi(d0.y)}; } }
        const float rstd = row_rstd(v);
#pragma unroll
        for (int j = 0; j < 4; ++j) {
            const int c0 = 4 * F.lane + 256 * j;
            const f32x4 g = *(const f32x4*)(A.in[I_FG] + c0);
            *(f32x4*)(A.out + (size_t)row * D + c0) = (v[j] * rstd) * g;
        }
    }
}

__global__ void __launch_bounds__(NTHREADS) fwd_kernel(Args args) {
    extern __shared__ __attribute__((aligned(16))) unsigned char smem[];
    Frame F;
    F.lds = (LAS char*)smem;
    F.tid = threadIdx.x; F.lane = F.tid & 63; F.wave = __builtin_amdgcn_readfirstlane(F.tid >> 6);
    F.G = gridDim.x; { const int bx = blockIdx.x; F.vcu = (F.G % 8 == 0) ? (bx % 8) * (F.G / 8) + bx / 8 : bx; }
    F.a = &args; F.ws = args.ws;
    volatile LAS unsigned* xbw = (volatile LAS unsigned*)(F.lds + LDS_XB);
    if (F.tid < 4) xbw[F.tid] = 0u;
    __syncthreads();
    XcdBarrier bar; bar.bar = (unsigned*)(F.ws + WS_CTL); bar.x = 0; bar.st = xbw;
    const int lo = args.ph_lo, hi = args.ph_hi;
    const bool multi = (hi - lo) > 1;
    if (multi) bar = xcd_barrier_post((unsigned*)(F.ws + WS_CTL), xbw);
#ifdef PROBE_PHASE
    unsigned long long pt0 = 0, pt1 = 0;
#define RUN_PHASE(k, call) do { if (lo <= (k) && (k) < hi) { if ((k) == PROBE_PHASE) pt0 = __builtin_amdgcn_s_memrealtime(); call; if ((k) + 1 < hi) xcd_barrier(bar); if ((k) == PROBE_PHASE) pt1 = __builtin_amdgcn_s_memrealtime(); } } while (0)
#else
#define RUN_PHASE(k, call) do { if (lo <= (k) && (k) < hi) { call; if ((k) + 1 < hi) xcd_barrier(bar); } } while (0)
#endif
    RUN_PHASE(0, phase_convert(F));
    RUN_PHASE(1, phase_prep0(F));
    RUN_PHASE(2, phase_gemm_in(F));
    RUN_PHASE(3, phase_scan(F));
    RUN_PHASE(4, (phase_combine_h(F), xcd_barrier(bar), phase_gemm_out0(F)));
    RUN_PHASE(5, phase_route<0>(F));
    RUN_PHASE(6, phase_slots<0>(F));
    RUN_PHASE(7, phase_moe_up<0>(F));
    RUN_PHASE(8, phase_moe_down<0>(F));
    RUN_PHASE(9, phase_combine0(F));
    RUN_PHASE(10, phase_qkv(F));
    RUN_PHASE(11, phase_attn(F));
    RUN_PHASE(12, phase_gemm_wo(F));
    RUN_PHASE(13, phase_route<1>(F));
    RUN_PHASE(14, phase_slots<1>(F));
    RUN_PHASE(15, phase_moe_up<1>(F));
    RUN_PHASE(16, phase_moe_down<1>(F));
    RUN_PHASE(17, phase_final(F));
#undef RUN_PHASE
#ifdef PROBE_PHASE
    xcd_barrier(bar);
    if (blockIdx.x == 0 && F.tid == 0) args.out[0] = 40.0f + floorf((float)(pt1 - pt0) * 0.001f + 0.5f);
#endif
}

extern "C" void kernel_launch(void* const* d_in, const int* in_sizes, int n_in, void* d_out, int out_size, void* d_ws, size_t ws_size, hipStream_t stream) {
    static int grid = 0;
    if (grid == 0) {
        if (n_in != 27 || out_size != NX * D || ws_size < WS_END) { fprintf(stderr, "kernel_launch: unexpected shapes (n_in %d out %d ws %zu)\n", n_in, out_size, ws_size); grid = -1; return; }
        int dev = 0, cus = 0;
        if (hipGetDevice(&dev) != hipSuccess || hipDeviceGetAttribute(&cus, hipDeviceAttributeMultiprocessorCount, dev) != hipSuccess) { grid = -1; return; }
        if (hipFuncSetAttribute((const void*)fwd_kernel, hipFuncAttributeMaxDynamicSharedMemorySize, LDS_BYTES) != hipSuccess) { fprintf(stderr, "kernel_launch: hipFuncSetAttribute failed\n"); grid = -1; return; }
        (void)hipGetLastError();
        grid = cus < 256 ? cus : 256;
    }
    if (grid < 0) return;
    (void)hipMemsetAsync((char*)d_ws + WS_CTL, 0, CTL_ZERO_BYTES, stream);
    Args a{};
    for (int i = 0; i < 27; ++i) a.in[i] = (const float*)d_in[i];
    a.out = (float*)d_out; a.ws = (unsigned char*)d_ws;
    if (MK_N_LAUNCHES == 1) {
        a.ph_lo = 0; a.ph_hi = NPHASES;
        hipLaunchKernelGGL(fwd_kernel, dim3(grid), dim3(NTHREADS), LDS_BYTES, stream, a);
    } else {
        if (DBG_NPH == 0) { a.ph_lo = 0; a.ph_hi = 0; hipLaunchKernelGGL(fwd_kernel, dim3(grid), dim3(NTHREADS), LDS_BYTES, stream, a); }
        for (int p = 0; p < DBG_NPH; ++p) { a.ph_lo = p; a.ph_hi = p + 1; hipLaunchKernelGGL(fwd_kernel, dim3(grid), dim3(NTHREADS), LDS_BYTES, stream, a); }
    }
}
```

```cpp
#include <hip/hip_runtime.h>
#include <cstdio>
#include <cstdint>

#ifndef MK_N_LAUNCHES
#define MK_N_LAUNCHES 1
#endif

#ifndef DBG_NPH
#define DBG_NPH 18
#endif
#define LAS __attribute__((address_space(3)))
typedef unsigned short bf16;
typedef short bf16x8 __attribute__((ext_vector_type(8)));
typedef float f32x4 __attribute__((ext_vector_type(4)));
typedef float f32x16 __attribute__((ext_vector_type(16)));
typedef unsigned u32x4 __attribute__((ext_vector_type(4)));
typedef unsigned u32x2 __attribute__((ext_vector_type(2)));
typedef float f32x2 __attribute__((ext_vector_type(2)));

constexpr int D = 1024, NB = 4, S = 4096, CL = 256;
constexpr int NX = NB * S, NC = NB * CL, NTOK = NX + NC;
constexpr int NEXP = 32, DEXP = 512;
constexpr int NWAVES = 8, NTHREADS = 512;
constexpr int KEYS = S + CL;
constexpr float EPS = 1e-6f;
constexpr int PMAX = 43008;
constexpr int NPHASES = 18;
constexpr float QSCALE = 0.125f * 1.4426950408889634f;

constexpr size_t MiB = 1u << 20;
constexpr size_t WS_CTL = 0, CTL_ZERO_BYTES = 64 * 1024;
constexpr size_t WS_MOD = 1 * MiB;
constexpr size_t WS_SEL = 2 * MiB;
constexpr size_t WS_WT = WS_SEL + 256 * 1024;
constexpr size_t WS_LRANK = WS_WT + 256 * 1024;
constexpr size_t WS_TOKSLOT = WS_LRANK + 256 * 1024;
constexpr size_t WS_BLKCNT = WS_TOKSLOT + 256 * 1024;
constexpr size_t WS_PSTART = WS_BLKCNT + 64 * 1024;
constexpr size_t WS_SLOTTOK = 3 * MiB + 512 * 1024;
constexpr size_t WS_SLOTW = WS_SLOTTOK + 256 * 1024;
constexpr size_t WS_WIN = 4 * MiB;
constexpr size_t WS_WOUT = 8 * MiB;
constexpr size_t WS_GATE = 10 * MiB;
constexpr size_t WS_WQKV = 11 * MiB;
constexpr size_t WS_WO = 17 * MiB;
constexpr size_t WS_WUP = 20 * MiB;
constexpr size_t WS_WDN = 148 * MiB;
constexpr size_t WS_XA = 212 * MiB;
constexpr size_t WS_H = 280 * MiB;
constexpr size_t WS_R = 314 * MiB;
constexpr size_t WS_YG = WS_R, WS_U = WS_R + 34 * MiB, WS_HF = WS_R + 68 * MiB, WS_HB = WS_R + 102 * MiB;
constexpr size_t WS_G = WS_R, WS_Y = WS_R + 42 * MiB;
constexpr size_t WS_Q = WS_R, WS_K = WS_R + 32 * MiB, WS_VT = WS_R + 66 * MiB, WS_AO = WS_R + 100 * MiB;
constexpr size_t WS_DELTA = 450 * MiB;
constexpr size_t WS_UC = WS_DELTA;
constexpr size_t WS_POS = WS_LRANK;
constexpr size_t WS_TOKOF = 488 * MiB;
constexpr size_t WS_WOF = 491 * MiB;
constexpr size_t WS_GCNT = WS_CTL + 48 * 1024;
constexpr size_t WS_END = 494 * MiB;
static_assert(WS_Y + (size_t)PMAX * 1024 * 2 <= WS_END && WS_HB + 34 * MiB <= WS_END && WS_AO + 32 * MiB <= WS_END, "ws map");
static_assert(WS_K + (size_t)NB * 8 * 2 * KEYS * 64 * 2 <= WS_VT && WS_VT + (size_t)NB * 8 * 128 * KEYS * 2 <= WS_AO, "attn map");

constexpr int LDS_BYTES = 163840;
constexpr int LDS_XB = LDS_BYTES - 64;
constexpr int LDS_AUX = 147456;

__device__ __forceinline__ unsigned f2bf(float f) { unsigned u = __builtin_bit_cast(unsigned, f); return (u + 0x7fffu + ((u >> 16) & 1u)) >> 16; }
#ifndef L0_FP8
#define L0_FP8 1
#endif
#ifndef ATT_SKEW_SLEEP
#define ATT_SKEW_SLEEP 0
#endif
#ifndef XA_BF16
#define XA_BF16 1
#endif
#ifndef Y_FP8
#define Y_FP8 1
#endif
#ifndef L1_FP8
#define L1_FP8 1
#endif
typedef int i32x8 __attribute__((ext_vector_type(8)));
__device__ __forceinline__ unsigned pk4_fp8(float a, float b, float c, float d) { int w = 0; w = __builtin_amdgcn_cvt_pk_fp8_f32(a, b, w, false); w = __builtin_amdgcn_cvt_pk_fp8_f32(c, d, w, true); return (unsigned)w; }
constexpr int FP8_SCALE_ONE = 0x7f7f7f7f, FP8_SCALE_W = 0x7a7a7a7a  , FP8_SCALE_G = 0x7c7c7c7c  ;
typedef __bf16 bf16x2_t __attribute__((ext_vector_type(2)));
__device__ __forceinline__ unsigned pk2(float lo, float hi) { const f32x2 v = {lo, hi}; const bf16x2_t b = __builtin_convertvector(v, bf16x2_t); return __builtin_bit_cast(unsigned, b); }
__device__ __forceinline__ float bflo(unsigned w) { return __builtin_bit_cast(float, w << 16); }
__device__ __forceinline__ float bfhi(unsigned w) { return __builtin_bit_cast(float, w & 0xffff0000u); }
__device__ __forceinline__ float wave_sum(float v) {
#pragma unroll
    for (int o = 1; o < 64; o <<= 1) v += __shfl_xor(v, o);
    return v;
}
__device__ __forceinline__ float sigmoidf_(float x) { return 1.0f / (1.0f + __expf(-x)); }
#define LDS_WAIT() asm volatile("s_waitcnt lgkmcnt(0)" ::: "memory")

#define XB_TMO      128
#define XB_XCNT(j)  (256  + 64 * (j))
#define XB_XSUB(j)  (1280 + 64 * (j))
#define XB_XGEN(j)  (2304 + 64 * (j))
#define XB_TOP      3328
#define XB_TOPGEN   3392
#define XCD_BAR_WORDS 3456
#define XB_SPIN_CAP (1u << 18)
__device__ __forceinline__ unsigned xb_ld(unsigned* p)              { return __hip_atomic_load(p, __ATOMIC_RELAXED, __HIP_MEMORY_SCOPE_AGENT); }
__device__ __forceinline__ unsigned xb_add(unsigned* p, unsigned v) { return __hip_atomic_fetch_add(p, v, __ATOMIC_RELAXED, __HIP_MEMORY_SCOPE_AGENT); }
__device__ __forceinline__ unsigned xb_xcc_id() { return (unsigned)__builtin_amdgcn_s_getreg((3 << 11) | 20) & 0xFu; }
#define XB_SPIN(cond, bar) do { unsigned _sp = 0; while (cond) { __builtin_amdgcn_s_sleep(1); \
    if ((++_sp & 255u) == 0u) { if (xb_ld(&(bar)[XB_TMO])) break; if (_sp > XB_SPIN_CAP) { atomicAdd(&(bar)[XB_TMO], 1u); break; } } } } while (0)
struct XcdBarrier { unsigned* bar; unsigned x; volatile LAS unsigned* st; };
__device__ __forceinline__ XcdBarrier xcd_barrier_post(unsigned* bar, volatile LAS unsigned* st) {
    XcdBarrier b; b.bar = bar; b.x = xb_xcc_id(); b.st = st;
    if (threadIdx.x == 0) (void)xb_add(&bar[XB_XCNT(b.x)], 1u);
    return b;
}
__device__ __forceinline__ void xcd_barrier_complete(unsigned* bar, unsigned x, unsigned& nloc, unsigned& nx) {
    const unsigned G = gridDim.x * gridDim.y * gridDim.z;
    unsigned sum, cnt, mine, sp = 0u;
    for (;;) {
        sum = 0u; cnt = 0u; mine = 0u;
#pragma unroll
        for (unsigned j = 0; j < 16; ++j) { const unsigned c = xb_ld(&bar[XB_XCNT(j)]); sum += c; cnt += (c > 0u) ? 1u : 0u; mine = (j == x) ? c : mine; }
        if (sum == G) break;
        __builtin_amdgcn_s_sleep(1);
        if ((++sp & 255u) == 0u) { if (xb_ld(&bar[XB_TMO])) break; if (sp > XB_SPIN_CAP) { atomicAdd(&bar[XB_TMO], 1u); break; } }
    }
    nloc = mine > 0u ? mine : 1u; nx = cnt > 0u ? cnt : 1u;
}
__device__ __forceinline__ void xcd_barrier(const XcdBarrier& b) {
    asm volatile("s_waitcnt vmcnt(0)" ::: "memory");
    __syncthreads();
    if (threadIdx.x == 0) {
        unsigned* bar = b.bar;
        __builtin_amdgcn_s_waitcnt(0);
        unsigned nloc = b.st[0], nx = b.st[1];
        if (nloc == 0u) { xcd_barrier_complete(bar, b.x, nloc, nx); b.st[0] = nloc; b.st[1] = nx; }
        const unsigned old = xb_add(&bar[XB_XSUB(b.x)], 1u);
        const unsigned gen = old / nloc;
        if (old + 1u == (gen + 1u) * nloc) {
            __builtin_amdgcn_fence(__ATOMIC_RELEASE, "agent");
            asm volatile("s_waitcnt vmcnt(0)" ::: "memory");
            const unsigned og = xb_add(&bar[XB_TOP], 1u);
            const unsigned tg = og / nx;
            if (og + 1u == (tg + 1u) * nx) xb_add(&bar[XB_TOPGEN], 1u);
            else XB_SPIN(xb_ld(&bar[XB_TOPGEN]) == tg, bar);
            __builtin_amdgcn_fence(__ATOMIC_ACQUIRE, "agent");
            xb_add(&bar[XB_XGEN(b.x)], 1u);
            asm volatile("s_waitcnt vmcnt(0)" ::: "memory");
        } else {
            XB_SPIN(xb_ld(&bar[XB_XGEN(b.x)]) == gen, bar);
            asm volatile("s_waitcnt vmcnt(0)\n\tbuffer_inv sc0" ::: "memory");
            asm volatile("s_waitcnt vmcnt(0)" ::: "memory");
        }
    }
    __syncthreads();
}

struct Args { const float* in[27]; float* out; unsigned char* ws; int ph_lo, ph_hi; };
enum { I_X = 0, I_C, I_CTX, I_CCTX, I_WMOD, I_BMOD, I_N1G, I_N2G, I_WIN, I_CONVW, I_CONVB, I_GAW, I_GAB, I_GXW, I_GXB, I_LAM, I_WOUT,
       I_WQKV, I_DALAM, I_SUBLN, I_WO, I_RW, I_RB, I_MG, I_MU, I_MD, I_FG };

struct Frame {
    LAS char* lds;
    int tid, lane, wave, vcu, G;
    const Args* a;
    unsigned char* ws;
};

__device__ __forceinline__ const float* modp(const Frame& F, int l, int c, int k) { return (const float*)(F.ws + WS_MOD) + (size_t)(l * 5 + c) * 6144 + k * 1024; }
__device__ __forceinline__ int cond_of(int row) { return row < NX ? (row >> 12) : 4; }

__device__ __forceinline__ int moe_up_row(int n) { return ((n >> 4) << 5) + (n & 15); }

struct TDesc { const float* W; bf16* WT; int N, ldT, mode, k0, n0, f8; };
__device__ __forceinline__ void tr_load(const TDesc& t, int lane, f32x4 (&rg)[8]) {
    const float* p = t.W + (size_t)(t.k0 + (lane >> 3)) * t.N + t.n0 + 4 * (lane & 7);
#pragma unroll
    for (int i = 0; i < 8; ++i) rg[i] = __builtin_nontemporal_load((const f32x4*)(p + (size_t)(8 * i) * t.N));
}
__device__ __forceinline__ void tr_finish(const TDesc& t, int lane, const f32x4 (&rg)[8], LAS float* scr) {
#pragma unroll
    for (int i = 0; i < 8; ++i) { LAS float* d = scr + ((lane >> 3) + 8 * i) * 33 + 4 * (lane & 7); d[0] = rg[i].x; d[1] = rg[i].y; d[2] = rg[i].z; d[3] = rg[i].w; }
    LDS_WAIT();
    const int c = lane & 7;
#pragma unroll
    for (int j = 0; j < 4; ++j) {
        const int n = (lane >> 3) + 8 * j; const LAS float* s = scr + (8 * c) * 33 + n;
        u32x4 o; o.x = pk2(s[0 * 33], s[1 * 33]); o.y = pk2(s[2 * 33], s[3 * 33]); o.z = pk2(s[4 * 33], s[5 * 33]); o.w = pk2(s[6 * 33], s[7 * 33]);
        const int nn = t.n0 + n;
        const int drow = (t.mode == 0) ? nn : (moe_up_row(nn) + (t.mode == 2 ? 16 : 0));
        *(u32x4*)(t.WT + (size_t)drow * t.ldT + t.k0 + 8 * c) = o;
    }
    LDS_WAIT();
}

__device__ __forceinline__ void phase_convert(Frame& F) {
    const Args& A = *F.a;
    LAS float* scr = (LAS float*)(F.lds + F.wave * 8448);
    LAS float* sil = (LAS float*)(F.lds + 69632);
    for (int i = F.tid; i < 5 * 1024; i += NTHREADS) { const int c = i >> 10, k = i & 1023; const float v = (c < 4) ? A.in[I_C][c * 1024 + k] : A.in[I_CCTX][k]; sil[i] = v / (1.0f + __expf(-v)); }
    __syncthreads();
    const int gw = F.vcu * NWAVES + F.wave, NGW = F.G * NWAVES;
    constexpr int N_MOD = 192, N_WIN = 16 * 64, N_WOUT = 16 * 32, N_WQKV = 16 * 96, N_WO = 16 * 32, N_GATE = 32 * 8, N_MOE = 64 * 256;
    {
        LAS float* red = (LAS float*)(F.lds + 90112);
        for (int item = F.vcu; item < N_MOD; item += F.G) {
            const int l = item / 96, col = (item % 96) * 64 + F.lane;
            const float* wp = A.in[I_WMOD] + ((size_t)l * 1024 + F.wave * 128) * 6144 + col;
            float acc[5] = {0.f, 0.f, 0.f, 0.f, 0.f};
#pragma unroll 1
            for (int k = 0; k < 128; k += 32) {
                float wv[32];
#pragma unroll
                for (int i = 0; i < 32; ++i) wv[i] = __builtin_nontemporal_load(wp + (size_t)(k + i) * 6144);
#pragma unroll
                for (int i = 0; i < 32; i += 4)
#pragma unroll
                    for (int c = 0; c < 5; ++c) { const f32x4 s4 = *(const LAS f32x4*)(sil + c * 1024 + F.wave * 128 + k + i); acc[c] += s4.x * wv[i] + s4.y * wv[i + 1] + s4.z * wv[i + 2] + s4.w * wv[i + 3]; }
            }
#pragma unroll
            for (int c = 0; c < 5; ++c) red[(F.wave * 5 + c) * 64 + F.lane] = acc[c];
            __syncthreads();
            if (F.tid < 320) {
                const int c = F.tid >> 6, ln = F.tid & 63;
                float s = A.in[I_BMOD][l * 6144 + (item % 96) * 64 + ln];
#pragma unroll
                for (int w2 = 0; w2 < 8; ++w2) s += red[(w2 * 5 + c) * 64 + ln];
                ((float*)(F.ws + WS_MOD))[(size_t)(l * 5 + c) * 6144 + (item % 96) * 64 + ln] = s;
            }
            __syncthreads();
        }
    }
}

__device__ __forceinline__ void early_convert(Frame& F) {
    const Args& A = *F.a;
    LAS float* scr = (LAS float*)(F.lds + F.wave * 8448);
    const int gw = F.vcu * NWAVES + F.wave, NGW = F.G * NWAVES;
    constexpr int N_WIN = 16 * 64, N_WOUT = 16 * 32, N_GATE = 32 * 8;
    auto decode = [&](int r) -> TDesc {
        TDesc t; t.mode = 0; t.f8 = 0;
        int item;
        if (r < N_WIN) { t.W = A.in[I_WIN]; t.N = 2048; t.WT = (bf16*)(F.ws + WS_WIN); t.ldT = 1024; item = r; }
        else if ((r -= N_WIN) < N_WOUT) { t.W = A.in[I_WOUT]; t.N = 1024; t.WT = (bf16*)(F.ws + WS_WOUT); t.ldT = 1024; item = r; }
        else {
            r -= N_WOUT;
            const int m = r >> 3, d = m >> 4, g = (m >> 3) & 1, n = m & 7;
            t.W = (g == 0 ? A.in[I_GAW] : A.in[I_GXW]) + (size_t)(d * 8 + n) * 128 * 128; t.N = 128;
            t.WT = (bf16*)(F.ws + WS_GATE) + (size_t)m * 128 * 128; t.ldT = 128; item = r & 7;
        }
        const int nblk = t.N >> 5; t.k0 = 64 * (item / nblk); t.n0 = 32 * (item % nblk);
        return t;
    };
    constexpr int NTR0 = N_WIN + N_WOUT + N_GATE;
    for (int it = gw; it < NTR0; it += NGW) {
        const TDesc cur = decode(it); f32x4 rg[8]; tr_load(cur, F.lane, rg);
        tr_finish(cur, F.lane, rg, scr);
    }
}

constexpr int ND_WQKV = 32 * 96, ND_WO = 32 * 32, ND_MOEL = 32 * 512;
constexpr int ND_SCAN = ND_WQKV + ND_WO + 3 * ND_MOEL;
constexpr int ND_ATTN = 3 * ND_MOEL;
__device__ __forceinline__ TDesc decode_moe(const Frame& F, int r, int layer) {
    const Args& A = *F.a;
    TDesc t; t.mode = 0; t.f8 = 0; int item;
    if (r < ND_MOEL) { const int le = layer * 32 + (r >> 9); t.W = A.in[I_MG] + (size_t)le * 1024 * 512; t.N = 512; t.WT = (bf16*)(F.ws + WS_WUP) + (size_t)le * 1024 * 1024; t.ldT = 1024; t.mode = 1; item = r & 511; }
    else if ((r -= ND_MOEL) < ND_MOEL) { const int le = layer * 32 + (r >> 9); t.W = A.in[I_MU] + (size_t)le * 1024 * 512; t.N = 512; t.WT = (bf16*)(F.ws + WS_WUP) + (size_t)le * 1024 * 1024; t.ldT = 1024; t.mode = 2; item = r & 511; }
    else { r -= ND_MOEL; const int le = layer * 32 + (r >> 9); t.W = A.in[I_MD] + (size_t)le * 512 * 1024; t.N = 1024; t.WT = (bf16*)(F.ws + WS_WDN) + (size_t)le * 1024 * 512; t.ldT = 512; item = r & 511; }
    if (L0_FP8 && layer == 0) {
        const size_t eoff = (size_t)((t.WT - (bf16*)(F.ws + (t.mode ? WS_WUP : WS_WDN))) / (t.mode ? 1024 * 1024 : 1024 * 512));
        t.WT = (bf16*)(F.ws + (t.mode ? WS_WUP : WS_WDN) + eoff * (t.mode ? 1024 * 1024 : 1024 * 512));
        t.f8 = 1;
    }
    const int nblk = t.N >> 5; t.k0 = 32 * (item / nblk); t.n0 = 32 * (item % nblk);
    return t;
}
__device__ __forceinline__ TDesc decode_deferred(const Frame& F, int r) {
    const Args& A = *F.a;
    if (r >= ND_WQKV + ND_WO) return decode_moe(F, r - (ND_WQKV + ND_WO), 0);
    TDesc t; t.mode = 0; t.f8 = 0; int item;
    if (r < ND_WQKV) { t.W = A.in[I_WQKV]; t.N = 3072; t.WT = (bf16*)(F.ws + WS_WQKV); t.ldT = 1024; item = r; }
    else { r -= ND_WQKV; t.W = A.in[I_WO]; t.N = 1024; t.WT = (bf16*)(F.ws + WS_WO); t.ldT = 1024; item = r; }
    const int nblk = t.N >> 5; t.k0 = 32 * (item / nblk); t.n0 = 32 * (item % nblk);
    return t;
}
__device__ __forceinline__ void tr3_dma(const TDesc& t, int lane, LAS char* buf) {
    const float* p = t.W + (size_t)(t.k0 + (lane >> 3)) * t.N + t.n0;
#pragma unroll
    for (int i = 0; i < 4; ++i)
        __builtin_amdgcn_global_load_lds((const unsigned*)(p + (size_t)(8 * i) * t.N + 4 * ((lane & 7) ^ i)), (LAS unsigned*)(buf + i * 1024), 16, 0, 2  );
}
__device__ __forceinline__ void tr3_finish(const TDesc& t, int lane, const LAS char* buf) {
    const int c = lane & 3;
#pragma unroll
    for (int j = 0; j < 2; ++j) {
        const int n = (lane >> 2) + 16 * j;
        const LAS char* s = buf + (8 * c) * 128 + (((n >> 2) ^ c) << 4) + (n & 3) * 4;
        float x[8];
#pragma unroll
        for (int i = 0; i < 8; ++i) x[i] = *(const LAS float*)(s + i * 128);
        u32x4 o; o.x = pk2(x[0], x[1]); o.y = pk2(x[2], x[3]); o.z = pk2(x[4], x[5]); o.w = pk2(x[6], x[7]);
        const int nn = t.n0 + n;
        const int drow = (t.mode == 0) ? nn : (moe_up_row(nn) + (t.mode == 2 ? 16 : 0));
        *(u32x4*)(t.WT + (size_t)drow * t.ldT + t.k0 + 8 * c) = o;
    }
}
__device__ __forceinline__ void tr3_finish_fp8(const TDesc& t, int lane, const LAS char* buf) {
    const int c = lane & 1, n = lane >> 1;
    float x[16];
#pragma unroll
    for (int i = 0; i < 16; ++i) { const int r = 16 * c + i; x[i] = 32.0f * *(const LAS float*)(buf + r * 128 + (((n >> 2) ^ (r >> 3)) << 4) + (n & 3) * 4); }
    u32x4 o; o.x = pk4_fp8(x[0], x[1], x[2], x[3]); o.y = pk4_fp8(x[4], x[5], x[6], x[7]); o.z = pk4_fp8(x[8], x[9], x[10], x[11]); o.w = pk4_fp8(x[12], x[13], x[14], x[15]);
    const int nn = t.n0 + n;
    const int drow = (t.mode == 0) ? nn : (moe_up_row(nn) + (t.mode == 2 ? 16 : 0));
    __builtin_nontemporal_store(o, (u32x4*)((unsigned char*)t.WT + (size_t)drow * t.ldT + t.k0 + 16 * c));
}
__device__ __forceinline__ TDesc decode_moe8(const Frame& F, int r) {
    const Args& A = *F.a;
    TDesc t; t.mode = 0; t.f8 = 0; int item;
    unsigned char* up8 = F.ws + WS_WUP + (size_t)64 * MiB; unsigned char* dn8 = F.ws + WS_WDN + (size_t)32 * MiB;
    if (r < ND_MOEL) { const int e = r >> 9; t.W = A.in[I_MG] + (size_t)(32 + e) * 1024 * 512; t.N = 512; t.WT = (bf16*)(up8 + (size_t)e * 1024 * 1024); t.ldT = 1024; t.mode = 1; item = r & 511; }
    else if ((r -= ND_MOEL) < ND_MOEL) { const int e = r >> 9; t.W = A.in[I_MU] + (size_t)(32 + e) * 1024 * 512; t.N = 512; t.WT = (bf16*)(up8 + (size_t)e * 1024 * 1024); t.ldT = 1024; t.mode = 2; item = r & 511; }
    else { r -= ND_MOEL; const int e = r >> 9; t.W = A.in[I_MD] + (size_t)(32 + e) * 512 * 1024; t.N = 1024; t.WT = (bf16*)(dn8 + (size_t)e * 1024 * 512); t.ldT = 512; item = r & 511; }
    const int nblk = t.N >> 5; t.k0 = 32 * (item / nblk); t.n0 = 32 * (item % nblk);
    return t;
}
__device__ __forceinline__ void tr2_load(const TDesc& t, int lane, f32x4 (&rg)[4]) {
    const float* p = t.W + (size_t)(t.k0 + (lane >> 3)) * t.N + t.n0 + 4 * (lane & 7);
#pragma unroll
    for (int i = 0; i < 4; ++i) rg[i] = __builtin_nontemporal_load((const f32x4*)(p + (size_t)(8 * i) * t.N));
}
__device__ __forceinline__ void tr2_finish(const TDesc& t, int lane, const f32x4 (&rg)[4], LAS float* scr  ) {
#pragma unroll
    for (int i = 0; i < 4; ++i) { LAS float* d = scr + ((lane >> 3) + 8 * i) * 33 + 4 * (lane & 7); d[0] = rg[i].x; d[1] = rg[i].y; d[2] = rg[i].z; d[3] = rg[i].w; }
    LDS_WAIT();
    if (t.f8) {
        const int c = lane & 1, n = lane >> 1;
        float x[16];
#pragma unroll
        for (int i = 0; i < 16; ++i) x[i] = 32.0f * scr[(16 * c + i) * 33 + n];
        u32x4 o; o.x = pk4_fp8(x[0], x[1], x[2], x[3]); o.y = pk4_fp8(x[4], x[5], x[6], x[7]); o.z = pk4_fp8(x[8], x[9], x[10], x[11]); o.w = pk4_fp8(x[12], x[13], x[14], x[15]);
        const int nn = t.n0 + n;
        const int drow = (t.mode == 0) ? nn : (moe_up_row(nn) + (t.mode == 2 ? 16 : 0));
        __builtin_nontemporal_store(o, (u32x4*)((unsigned char*)t.WT + (size_t)drow * t.ldT + t.k0 + 16 * c));
        LDS_WAIT();
        return;
    }
    const int c = lane & 3;
#pragma unroll
    for (int j = 0; j < 2; ++j) {
        const int n = (lane >> 2) + 16 * j; const LAS float* s = scr + (8 * c) * 33 + n;
        u32x4 o; o.x = pk2(s[0 * 33], s[1 * 33]); o.y = pk2(s[2 * 33], s[3 * 33]); o.z = pk2(s[4 * 33], s[5 * 33]); o.w = pk2(s[6 * 33], s[7 * 33]);
        const int nn = t.n0 + n;
        const int drow = (t.mode == 0) ? nn : (moe_up_row(nn) + (t.mode == 2 ? 16 : 0));
        *(u32x4*)(t.WT + (size_t)drow * t.ldT + t.k0 + 8 * c) = o;
    }
    LDS_WAIT();
}

constexpr int ND_TAILW = (256 - 32) * NWAVES;
constexpr int ND_A = ND_WQKV + ND_WO, ND_B = ND_A;
__device__ __forceinline__ void tail_convert(Frame& F, int tw, int first, int last, int stride = ND_TAILW) {
    LAS float* scr = (LAS float*)(F.lds + F.wave * 4224);
    int it = first + tw;
    if (it >= last) return;
    TDesc c0 = decode_deferred(F, it); f32x4 r0[4]; tr2_load(c0, F.lane, r0);
    for (;;) {
        const int n1 = it + stride; const bool m1 = n1 < last;
        TDesc c1 = c0; f32x4 r1[4];
        if (m1) { c1 = decode_deferred(F, n1); tr2_load(c1, F.lane, r1); }
        tr2_finish(c0, F.lane, r0, scr);
        if (!m1) break;
        c0 = c1; it = n1;
#pragma unroll
        for (int i = 0; i < 4; ++i) r0[i] = r1[i];
    }
}

__device__ __forceinline__ float row_rstd(const f32x4 (&v)[4]) {
    float s = 0.f;
#pragma unroll
    for (int j = 0; j < 4; ++j) s += (v[j].x * v[j].x + v[j].y * v[j].y) + (v[j].z * v[j].z + v[j].w * v[j].w);
    return rsqrtf(wave_sum(s) * (1.0f / D) + EPS);
}
__device__ __forceinline__ void row_modulate_store8(f32x4 (&v)[4], float rstd, const float* g, const float* sc, const float* sh, unsigned char* dst, int lane) {
#pragma unroll
    for (int j = 0; j < 4; ++j) {
        const int c0 = 4 * lane + 256 * j;
        const f32x4 gg = *(const f32x4*)(g + c0), s1 = *(const f32x4*)(sc + c0), s0 = *(const f32x4*)(sh + c0);
        v[j] = (v[j] * rstd) * gg * (1.0f + s1) + s0;
        *(unsigned*)(dst + c0) = pk4_fp8(v[j].x, v[j].y, v[j].z, v[j].w);
    }
}
__device__ __forceinline__ void row_modulate_store(f32x4 (&v)[4], float rstd, const float* g, const float* sc, const float* sh, bf16* dst, int lane) {
#pragma unroll
    for (int j = 0; j < 4; ++j) {
        const int c0 = 4 * lane + 256 * j;
        const f32x4 gg = *(const f32x4*)(g + c0), s1 = *(const f32x4*)(sc + c0), s0 = *(const f32x4*)(sh + c0);
        v[j] = (v[j] * rstd) * gg * (1.0f + s1) + s0;
        u32x2 o; o.x = pk2(v[j].x, v[j].y); o.y = pk2(v[j].z, v[j].w);
        *(u32x2*)(dst + c0) = o;
    }
}

__device__ __forceinline__ void load_row4(const float* src, int lane, f32x4 (&v)[4]) {
#pragma unroll
    for (int j = 0; j < 4; ++j) v[j] = __builtin_nontemporal_load((const f32x4*)(src + 4 * lane + 256 * j));
}
struct XRow { u32x2 p[4]; };
__device__ __forceinline__ void xa_load(const unsigned char* ws, int row, int lane, XRow& r) {
    const bf16* src = (const bf16*)(ws + WS_XA) + (size_t)row * D;
#pragma unroll
    for (int j = 0; j < 4; ++j) r.p[j] = *(const u32x2*)(src + 4 * lane + 256 * j);
}
__device__ __forceinline__ void xa_expand(const XRow& r, f32x4 (&v)[4]) {
#pragma unroll
    for (int j = 0; j < 4; ++j) v[j] = (f32x4){bflo(r.p[j].x), bfhi(r.p[j].x), bflo(r.p[j].y), bfhi(r.p[j].y)};
}
__device__ __forceinline__ void xa_store(unsigned char* ws, int row, int lane, const f32x4 (&v)[4]) {
    bf16* dst = (bf16*)(ws + WS_XA) + (size_t)row * D;
#pragma unroll
    for (int j = 0; j < 4; ++j) { u32x2 o; o.x = pk2(v[j].x, v[j].y); o.y = pk2(v[j].z, v[j].w); *(u32x2*)(dst + 4 * lane + 256 * j) = o; }
}
__device__ __forceinline__ void phase_prep0(Frame& F) {
    const Args& A = *F.a;
    const int gw = F.vcu * NWAVES + F.wave, NGW = F.G * NWAVES, lane = F.lane;
    bf16* H = (bf16*)(F.ws + WS_H);
    const int r_lo = (int)((long)gw * NTOK / NGW), r_hi = (int)((long)(gw + 1) * NTOK / NGW);
    auto rowp = [&](int r) -> const float* { return r < NX ? A.in[I_X] + (size_t)r * D : A.in[I_CTX] + (size_t)(r - NX) * D; };
    f32x4 gg[4], gm[4], sh[4]; int ccur = -1;
#pragma unroll
    for (int j = 0; j < 4; ++j) gg[j] = *(const f32x4*)(A.in[I_N1G] + 4 * lane + 256 * j);
    auto finish = [&](int r, f32x4 (&v)[4]) {
        const int c = cond_of(r);
        if (c != ccur) {
            ccur = c;
#pragma unroll
            for (int j = 0; j < 4; ++j) { const int c0 = 4 * lane + 256 * j; gm[j] = gg[j] * (1.0f + *(const f32x4*)(modp(F, 0, c, 1) + c0)); sh[j] = *(const f32x4*)(modp(F, 0, c, 0) + c0); }
        }
        const float rstd = row_rstd(v);
#pragma unroll
        for (int j = 0; j < 4; ++j) {
            const f32x4 h = (v[j] * rstd) * gm[j] + sh[j];
            u32x2 o; o.x = pk2(h.x, h.y); o.y = pk2(h.z, h.w);
            *(u32x2*)(H + (size_t)r * D + 4 * lane + 256 * j) = o;
        }
    };
    f32x4 va[4], vb[4];
    if (r_lo < r_hi) load_row4(rowp(r_lo), lane, va);
    if (r_lo + 1 < r_hi) load_row4(rowp(r_lo + 1), lane, vb);
#pragma unroll 1
    for (int r = r_lo; r < r_hi; r += 2) {
        { f32x4 v[4];
#pragma unroll
          for (int j = 0; j < 4; ++j) v[j] = va[j];
          if (r + 2 < r_hi) load_row4(rowp(r + 2), lane, va);
          finish(r, v); }
        if (r + 1 < r_hi) {
            f32x4 v[4];
#pragma unroll
            for (int j = 0; j < 4; ++j) v[j] = vb[j];
            if (r + 3 < r_hi) load_row4(rowp(r + 3), lane, vb);
            finish(r + 1, v);
        }
    }
    early_convert(F);
}

constexpr int GEMM_STAGE = 49152;
__device__ __forceinline__ int swz128(int row, int chunk) { return row * 128 + ((chunk ^ ((row >> 1) & 7)) << 4); }
__device__ __forceinline__ int dma_kc(int tid) { return ((tid & 7) ^ ((tid >> 4) & 7)) * 8; }

struct ALDense {
    static constexpr bool DMA = true;
    const bf16* p0; const bf16* p1;
    __device__ __forceinline__ const bf16* ptr(int i) const { return i ? p1 : p0; }
    __device__ __forceinline__ void init(const bf16* A, int lda, int m0, int r0, int r1, int kc) { p0 = A + (size_t)(m0 + r0) * lda + kc; p1 = A + (size_t)(m0 + r1) * lda + kc; }
    __device__ __forceinline__ u32x4 load(int i, int k0) const { return *(const u32x4*)((i ? p1 : p0) + k0); }
};
struct ALGather {
    static constexpr bool DMA = true;
    const bf16* p0; const bf16* p1;
    __device__ __forceinline__ const bf16* ptr(int i) const { return i ? p1 : p0; }
    __device__ __forceinline__ void init(const bf16* A, int lda, const int* idx, int m0, int r0, int r1, int kc) { p0 = A + (size_t)idx[m0 + r0] * lda + kc; p1 = A + (size_t)idx[m0 + r1] * lda + kc; }
    __device__ __forceinline__ u32x4 load(int i, int k0) const { return *(const u32x4*)((i ? p1 : p0) + k0); }
};
struct ALCombine {
    static constexpr bool DMA = false;
    size_t o0, o1; const bf16 *hf, *hb, *yg;
    __device__ __forceinline__ const bf16* ptr(int) const { return nullptr; }
    __device__ __forceinline__ void init(const bf16* hf_, const bf16* hb_, const bf16* yg_, int m0, int r0, int r1, int kc) { hf = hf_; hb = hb_; yg = yg_; o0 = (size_t)(m0 + r0) * D + kc; o1 = (size_t)(m0 + r1) * D + kc; }
    __device__ __forceinline__ u32x4 load(int i, int k0) const {
        const size_t o = (i ? o1 : o0) + k0;
        const u32x4 a = *(const u32x4*)(hf + o), b = *(const u32x4*)(hb + o), y = *(const u32x4*)(yg + o);
        u32x4 r;
#pragma unroll
        for (int q = 0; q < 4; ++q) r[q] = pk2((bflo(a[q]) + bflo(b[q])) * bflo(y[q]), (bfhi(a[q]) + bfhi(b[q])) * bfhi(y[q]));
        return r;
    }
};

template <class AL>
__device__ __forceinline__ void gemm_prefetch(const Frame& F, const AL& al, const bf16* __restrict__ Bt, int K) {
    const int tid = F.tid, sr = tid >> 3, sc = (tid & 7) ^ ((sr >> 1) & 7), wl = F.wave * 1024;
    const bf16* bp = Bt + (size_t)sr * K + sc * 8;
    const size_t bstep = (size_t)64 * K;
    LAS char* lds = F.lds;
    __builtin_amdgcn_global_load_lds((const unsigned*)(al.ptr(0)), (LAS unsigned*)(lds + wl), 16, 0, 0);
    __builtin_amdgcn_global_load_lds((const unsigned*)(al.ptr(1)), (LAS unsigned*)(lds + 8192 + wl), 16, 0, 0);
#pragma unroll
    for (int i = 0; i < 4; ++i)
        __builtin_amdgcn_global_load_lds((const unsigned*)(bp + i * bstep), (LAS unsigned*)(lds + 16384 + i * 8192 + wl), 16, 0, 0);
}
template <bool SWAP, class AL, bool PRE = false>
__device__ __forceinline__ void gemm_tile(const Frame& F, const AL& al, const bf16* __restrict__ Bt  , int K, f32x4 (&acc)[4][4]) {
    const int tid = F.tid, lane = F.lane, wid = F.wave, wr = wid >> 2, wc = wid & 3, fr = lane & 15, fq = lane >> 4;
    const int sr = tid >> 3;
    const int sc = AL::DMA ? ((tid & 7) ^ ((sr >> 1) & 7)) : (tid & 7);
    LAS char* lds = F.lds;
    const bf16* bp = Bt + (size_t)sr * K + sc * 8;
    const size_t bstep = (size_t)64 * K;
    int wa[2], wb[4];
#pragma unroll
    for (int i = 0; i < 2; ++i) wa[i] = swz128(sr + 64 * i, sc);
#pragma unroll
    for (int i = 0; i < 4; ++i) wb[i] = 16384 + swz128(sr + 64 * i, sc);
    const int key = (fr >> 1) & 7;
    const int ra = (wr * 64 + fr) * 128, rb = 16384 + (wc * 64 + fr) * 128;
#pragma unroll
    for (int mi = 0; mi < 4; ++mi)
#pragma unroll
        for (int ni = 0; ni < 4; ++ni) acc[mi][ni] = (f32x4){0.f, 0.f, 0.f, 0.f};
    u32x4 ga[2], gb[4];
    const int wl = wid * 1024;
#define GT_DMA(stage_, k_) do { \
        __builtin_amdgcn_global_load_lds((const unsigned*)(al.ptr(0) + (k_)), (LAS unsigned*)(lds + (stage_) + wl), 16, 0, 0); \
        __builtin_amdgcn_global_load_lds((const unsigned*)(al.ptr(1) + (k_)), (LAS unsigned*)(lds + (stage_) + 8192 + wl), 16, 0, 0); \
        _Pragma("unroll") for (int i_ = 0; i_ < 4; ++i_) \
            __builtin_amdgcn_global_load_lds((const unsigned*)(bp + i_ * bstep + (k_)), (LAS unsigned*)(lds + (stage_) + 16384 + i_ * 8192 + wl), 16, 0, 0); } while (0)
    if constexpr (AL::DMA) { if constexpr (!PRE) { GT_DMA(0, 0); } }
    else {
        ga[0] = al.load(0, 0); ga[1] = al.load(1, 0);
#pragma unroll
        for (int i = 0; i < 4; ++i) gb[i] = *(const u32x4*)(bp + i * bstep);
#pragma unroll
        for (int i = 0; i < 2; ++i) *(LAS u32x4*)(lds + wa[i]) = ga[i];
#pragma unroll
        for (int i = 0; i < 4; ++i) *(LAS u32x4*)(lds + wb[i]) = gb[i];
    }
    __syncthreads();
    const int nk = K / 64;
    for (int kt = 0; kt < nk; ++kt) {
        const int cur = (kt & 1) * GEMM_STAGE, nxt = GEMM_STAGE - cur;
        if (kt + 1 < nk) {
            const int k1 = (kt + 1) * 64;
            if constexpr (AL::DMA) { GT_DMA(nxt, k1); }
            else {
                ga[0] = al.load(0, k1); ga[1] = al.load(1, k1);
#pragma unroll
                for (int i = 0; i < 4; ++i) gb[i] = *(const u32x4*)(bp + i * bstep + k1);
            }
        }
        {
            bf16x8 af[2][4], bfr[2][4];
#pragma unroll
            for (int ks = 0; ks < 2; ++ks) {
                const int co = ((ks * 4 + fq) ^ key) << 4;
#pragma unroll
                for (int mi = 0; mi < 4; ++mi) af[ks][mi] = *(const LAS bf16x8*)(lds + cur + ra + mi * 2048 + co);
#pragma unroll
                for (int ni = 0; ni < 4; ++ni) bfr[ks][ni] = *(const LAS bf16x8*)(lds + cur + rb + ni * 2048 + co);
            }
            __builtin_amdgcn_sched_barrier(0);
#pragma unroll
            for (int ks = 0; ks < 2; ++ks)
#pragma unroll
                for (int mi = 0; mi < 4; ++mi)
#pragma unroll
                    for (int ni = 0; ni < 4; ++ni)
                        acc[mi][ni] = SWAP ? __builtin_amdgcn_mfma_f32_16x16x32_bf16(bfr[ks][ni], af[ks][mi], acc[mi][ni], 0, 0, 0)
                                           : __builtin_amdgcn_mfma_f32_16x16x32_bf16(af[ks][mi], bfr[ks][ni], acc[mi][ni], 0, 0, 0);
            __builtin_amdgcn_sched_barrier(0);
        }
        if constexpr (!AL::DMA) {
            if (kt + 1 < nk) {
#pragma unroll
                for (int i = 0; i < 2; ++i) *(LAS u32x4*)(lds + nxt + wa[i]) = ga[i];
#pragma unroll
                for (int i = 0; i < 4; ++i) *(LAS u32x4*)(lds + nxt + wb[i]) = gb[i];
            }
        }
        __syncthreads();
    }
#undef GT_DMA
}

#define G3_WAIT_BAR(N) asm volatile("s_waitcnt vmcnt(" #N ") lgkmcnt(0)\n\ts_barrier" ::: "memory")
template <class AL>
__device__ __forceinline__ void gemm3_issue(const Frame& F, const AL& al, const bf16* bp, size_t bstep, int stage_off, int k) {
    LAS char* lds = F.lds; const int wl = F.wave * 1024;
    __builtin_amdgcn_global_load_lds((const unsigned*)(al.ptr(0) + k), (LAS unsigned*)(lds + stage_off + wl), 16, 0, 0);
    __builtin_amdgcn_global_load_lds((const unsigned*)(al.ptr(1) + k), (LAS unsigned*)(lds + stage_off + 8192 + wl), 16, 0, 0);
#pragma unroll
    for (int i = 0; i < 4; ++i)
        __builtin_amdgcn_global_load_lds((const unsigned*)(bp + i * bstep + k), (LAS unsigned*)(lds + stage_off + 16384 + i * 8192 + wl), 16, 0, 0);
}
template <class AL>
__device__ __forceinline__ void gemm3_prefetch(const Frame& F, const AL& al, const bf16* __restrict__ Bt, int K) {
    const int tid = F.tid, sr = tid >> 3, sc = (tid & 7) ^ ((sr >> 1) & 7);
    const bf16* bp = Bt + (size_t)sr * K + sc * 8;
    gemm3_issue(F, al, bp, (size_t)64 * K, 0, 0);
    gemm3_issue(F, al, bp, (size_t)64 * K, GEMM_STAGE, 64);
}
template <bool SWAP, int EPI_ST, class AL>
__device__ __forceinline__ void gemm3_tile(const Frame& F, const AL& al, const bf16* __restrict__ Bt, int K, f32x4 (&acc)[4][4], bool first_unit) {
    static_assert(EPI_ST == 8 || EPI_ST == 16, "EPI_ST");
    const int tid = F.tid, lane = F.lane, wid = F.wave, wr = wid >> 2, wc = wid & 3, fr = lane & 15, fq = lane >> 4;
    const int sr = tid >> 3, sc = (tid & 7) ^ ((sr >> 1) & 7);
    LAS char* lds = F.lds;
    const bf16* bp = Bt + (size_t)sr * K + sc * 8;
    const size_t bstep = (size_t)64 * K;
    const int key = (fr >> 1) & 7;
    const int ra = (wr * 64 + fr) * 128, rb = 16384 + (wc * 64 + fr) * 128;
#pragma unroll
    for (int mi = 0; mi < 4; ++mi)
#pragma unroll
        for (int ni = 0; ni < 4; ++ni) acc[mi][ni] = (f32x4){0.f, 0.f, 0.f, 0.f};
    const int nk = K / 64;
    int cur = 0, nx2 = 2 * GEMM_STAGE;
    const int wl = wid * 1024;
#pragma unroll 1
    for (int kt = 0; kt < nk; ++kt) {
        if (kt + 1 >= nk) G3_WAIT_BAR(0);
        else if (kt >= 2 || first_unit) G3_WAIT_BAR(6);
        else if (kt == 0) { if constexpr (EPI_ST == 8) G3_WAIT_BAR(8); else G3_WAIT_BAR(16); }
        else { if constexpr (EPI_ST == 8) G3_WAIT_BAR(14); else G3_WAIT_BAR(22); }
        const bool more = kt + 2 < nk;
        const int k2 = (kt + 2) * 64;
#pragma unroll
        for (int ks = 0; ks < 2; ++ks) {
            const int co = ((ks * 4 + fq) ^ key) << 4;
            bf16x8 af[4], bfr[4];
#pragma unroll
            for (int mi = 0; mi < 4; ++mi) af[mi] = *(const LAS bf16x8*)(lds + cur + ra + mi * 2048 + co);
#pragma unroll
            for (int ni = 0; ni < 4; ++ni) bfr[ni] = *(const LAS bf16x8*)(lds + cur + rb + ni * 2048 + co);
#pragma unroll
            for (int mi = 0; mi < 4; ++mi) {
                if (more && mi < 3) {
                    const int g = ks * 3 + mi;
                    if (g < 2) __builtin_amdgcn_global_load_lds((const unsigned*)(al.ptr(g) + k2), (LAS unsigned*)(lds + nx2 + g * 8192 + wl), 16, 0, 0);
                    else __builtin_amdgcn_global_load_lds((const unsigned*)(bp + (g - 2) * bstep + k2), (LAS unsigned*)(lds + nx2 + 16384 + (g - 2) * 8192 + wl), 16, 0, 0);
                }
#pragma unroll
                for (int ni = 0; ni < 4; ++ni)
                    acc[mi][ni] = SWAP ? __builtin_amdgcn_mfma_f32_16x16x32_bf16(bfr[ni], af[mi], acc[mi][ni], 0, 0, 0)
                                       : __builtin_amdgcn_mfma_f32_16x16x32_bf16(af[mi], bfr[ni], acc[mi][ni], 0, 0, 0);
            }
        }
        nx2 = cur; cur = (cur == 2 * GEMM_STAGE) ? 0 : cur + GEMM_STAGE;
    }
    G3_WAIT_BAR(0);
}

template <int EPI_ST, class AL>
__device__ __forceinline__ void gemm3_tile8(const Frame& F, const AL& al, const bf16* __restrict__ Bt, int K2, f32x4 (&acc)[4][4], bool first_unit, int sc_w, int sc_a) {
    static_assert(EPI_ST == 8 || EPI_ST == 16, "EPI_ST");
    const int tid = F.tid, lane = F.lane, wid = F.wave, wr = wid >> 2, wc = wid & 3, fr = lane & 15, fq = lane >> 4;
    const int sr = tid >> 3, sc = (tid & 7) ^ ((sr >> 1) & 7);
    LAS char* lds = F.lds;
    const bf16* bp = Bt + (size_t)sr * K2 + sc * 8;
    const size_t bstep = (size_t)64 * K2;
    const int key = (fr >> 1) & 7;
    const int ra = (wr * 64 + fr) * 128, rb = 16384 + (wc * 64 + fr) * 128;
    const int c0 = ((2 * fq) ^ key) << 4, c1 = ((2 * fq + 1) ^ key) << 4;
#pragma unroll
    for (int mi = 0; mi < 4; ++mi)
#pragma unroll
        for (int ni = 0; ni < 4; ++ni) acc[mi][ni] = (f32x4){0.f, 0.f, 0.f, 0.f};
    const int nk = K2 / 64;
    int cur = 0, nx2 = 2 * GEMM_STAGE;
    const int wl = wid * 1024;
#pragma unroll 1
    for (int kt = 0; kt < nk; ++kt) {
        if (kt + 1 >= nk) G3_WAIT_BAR(0);
        else if (kt >= 2 || first_unit) G3_WAIT_BAR(6);
        else if (kt == 0) { if constexpr (EPI_ST == 8) G3_WAIT_BAR(8); else G3_WAIT_BAR(16); }
        else { if constexpr (EPI_ST == 8) G3_WAIT_BAR(14); else G3_WAIT_BAR(22); }
        const bool more = kt + 2 < nk;
        const int k2 = (kt + 2) * 64;
        i32x8 af[4], bfr[4];
#pragma unroll
        for (int mi = 0; mi < 4; ++mi) {
            const u32x4 lo = *(const LAS u32x4*)(lds + cur + ra + mi * 2048 + c0), hi = *(const LAS u32x4*)(lds + cur + ra + mi * 2048 + c1);
            af[mi] = (i32x8){(int)lo.x, (int)lo.y, (int)lo.z, (int)lo.w, (int)hi.x, (int)hi.y, (int)hi.z, (int)hi.w};
        }
#pragma unroll
        for (int ni = 0; ni < 4; ++ni) {
            const u32x4 lo = *(const LAS u32x4*)(lds + cur + rb + ni * 2048 + c0), hi = *(const LAS u32x4*)(lds + cur + rb + ni * 2048 + c1);
            bfr[ni] = (i32x8){(int)lo.x, (int)lo.y, (int)lo.z, (int)lo.w, (int)hi.x, (int)hi.y, (int)hi.z, (int)hi.w};
        }
#define G8_PIECE(g_) do { if ((g_) < 2) __builtin_amdgcn_global_load_lds((const unsigned*)(al.ptr(g_) + k2), (LAS unsigned*)(lds + nx2 + (g_) * 8192 + wl), 16, 0, 0); \
            else __builtin_amdgcn_global_load_lds((const unsigned*)(bp + ((g_) - 2) * bstep + k2), (LAS unsigned*)(lds + nx2 + 16384 + ((g_) - 2) * 8192 + wl), 16, 0, 0); } while (0)
#define G8_MMA(mi_) do { _Pragma("unroll") for (int ni = 0; ni < 4; ++ni) \
            acc[mi_][ni] = __builtin_amdgcn_mfma_scale_f32_16x16x128_f8f6f4(bfr[ni], af[mi_], acc[mi_][ni], 0, 0, 0, sc_w, 0, sc_a); } while (0)
        if (more) { G8_PIECE(0); G8_PIECE(1); }
        G8_MMA(0);
        if (more) { G8_PIECE(2); G8_PIECE(3); }
        G8_MMA(1);
        if (more) { G8_PIECE(4); }
        G8_MMA(2);
        if (more) { G8_PIECE(5); }
        G8_MMA(3);
#undef G8_PIECE
#undef G8_MMA
        nx2 = cur; cur = (cur == 2 * GEMM_STAGE) ? 0 : cur + GEMM_STAGE;
    }
    G3_WAIT_BAR(0);
}

struct Ring { int cur, nx2; };
template <class AL>
__device__ __forceinline__ void ring_start(const Frame& F, Ring& R, const AL& al, const bf16* __restrict__ Bt, int K2) {
    const int tid = F.tid, sr = tid >> 3, sc = (tid & 7) ^ ((sr >> 1) & 7);
    const bf16* bp = Bt + (size_t)sr * K2 + sc * 8;
    gemm3_issue(F, al, bp, (size_t)64 * K2, 0, 0);
    gemm3_issue(F, al, bp, (size_t)64 * K2, GEMM_STAGE, 64);
    R.cur = 0; R.nx2 = 2 * GEMM_STAGE;
}
template <bool F8, int EPI_ST, class AL>
__device__ __forceinline__ void gemm3_unit(const Frame& F, Ring& R, const AL& al, const bf16* __restrict__ Bt, const AL& alN, const bf16* __restrict__ BtN, bool hasN,
                                           int K2, f32x4 (&acc)[4][4], bool first_unit, int sc_w = 0, int sc_a = 0) {
    static_assert(EPI_ST == 8 || EPI_ST == 16, "EPI_ST");
    const int tid = F.tid, lane = F.lane, wid = F.wave, wr = wid >> 2, wc = wid & 3, fr = lane & 15, fq = lane >> 4;
    const int sr = tid >> 3, sc = (tid & 7) ^ ((sr >> 1) & 7);
    LAS char* lds = F.lds;
    const bf16* bp = Bt + (size_t)sr * K2 + sc * 8;
    const bf16* bpN = BtN + (size_t)sr * K2 + sc * 8;
    const size_t bstep = (size_t)64 * K2;
    const int key = (fr >> 1) & 7;
    const int ra = (wr * 64 + fr) * 128, rb = 16384 + (wc * 64 + fr) * 128;
#pragma unroll
    for (int mi = 0; mi < 4; ++mi)
#pragma unroll
        for (int ni = 0; ni < 4; ++ni) acc[mi][ni] = (f32x4){0.f, 0.f, 0.f, 0.f};
    const int nk = K2 / 64;
    int cur = R.cur, nx2 = R.nx2;
    const int wl = wid * 1024;
#pragma unroll 1
    for (int kt = 0; kt < nk; ++kt) {
        const bool later = (kt + 1 < nk) || hasN;
        if (!later) G3_WAIT_BAR(0);
        else if (kt >= 2 || first_unit) G3_WAIT_BAR(6);
        else { if constexpr (EPI_ST == 8) G3_WAIT_BAR(14); else G3_WAIT_BAR(22); }
        const bool own = kt + 2 < nk, more = own || hasN;
        const bf16* pa0 = own ? al.ptr(0) : alN.ptr(0); const bf16* pa1 = own ? al.ptr(1) : alN.ptr(1); const bf16* pb = own ? bp : bpN;
        const int k2 = (own ? kt + 2 : kt + 2 - nk) * 64;
#define G3_PIECE(g_) do { if ((g_) == 0) __builtin_amdgcn_global_load_lds((const unsigned*)(pa0 + k2), (LAS unsigned*)(lds + nx2 + wl), 16, 0, 0); \
            else if ((g_) == 1) __builtin_amdgcn_global_load_lds((const unsigned*)(pa1 + k2), (LAS unsigned*)(lds + nx2 + 8192 + wl), 16, 0, 0); \
            else __builtin_amdgcn_global_load_lds((const unsigned*)(pb + ((g_) - 2) * bstep + k2), (LAS unsigned*)(lds + nx2 + 16384 + ((g_) - 2) * 8192 + wl), 16, 0, 0); } while (0)
        if constexpr (F8) {
            const int c0 = ((2 * fq) ^ key) << 4, c1 = ((2 * fq + 1) ^ key) << 4;
            i32x8 af[4], bfr[4];
#pragma unroll
            for (int mi = 0; mi < 4; ++mi) {
                const u32x4 lo = *(const LAS u32x4*)(lds + cur + ra + mi * 2048 + c0), hi = *(const LAS u32x4*)(lds + cur + ra + mi * 2048 + c1);
                af[mi] = (i32x8){(int)lo.x, (int)lo.y, (int)lo.z, (int)lo.w, (int)hi.x, (int)hi.y, (int)hi.z, (int)hi.w};
            }
#pragma unroll
            for (int ni = 0; ni < 4; ++ni) {
                const u32x4 lo = *(const LAS u32x4*)(lds + cur + rb + ni * 2048 + c0), hi = *(const LAS u32x4*)(lds + cur + rb + ni * 2048 + c1);
                bfr[ni] = (i32x8){(int)lo.x, (int)lo.y, (int)lo.z, (int)lo.w, (int)hi.x, (int)hi.y, (int)hi.z, (int)hi.w};
            }
#define G8_MMA(mi_) do { _Pragma("unroll") for (int ni = 0; ni < 4; ++ni) \
                acc[mi_][ni] = __builtin_amdgcn_mfma_scale_f32_16x16x128_f8f6f4(bfr[ni], af[mi_], acc[mi_][ni], 0, 0, 0, sc_w, 0, sc_a); } while (0)
            if (more) { G3_PIECE(0); G3_PIECE(1); }
            G8_MMA(0);
            if (more) { G3_PIECE(2); G3_PIECE(3); }
            G8_MMA(1);
            if (more) { G3_PIECE(4); }
            G8_MMA(2);
            if (more) { G3_PIECE(5); }
            G8_MMA(3);
#undef G8_MMA
        } else {
#pragma unroll
            for (int ks = 0; ks < 2; ++ks) {
                const int co = ((ks * 4 + fq) ^ key) << 4;
                bf16x8 af[4], bfr[4];
#pragma unroll
                for (int mi = 0; mi < 4; ++mi) af[mi] = *(const LAS bf16x8*)(lds + cur + ra + mi * 2048 + co);
#pragma unroll
                for (int ni = 0; ni < 4; ++ni) bfr[ni] = *(const LAS bf16x8*)(lds + cur + rb + ni * 2048 + co);
#pragma unroll
                for (int mi = 0; mi < 4; ++mi) {
                    if (more && mi < 3) { if (ks == 0) { if (mi == 0) G3_PIECE(0); else if (mi == 1) G3_PIECE(1); else G3_PIECE(2); } else { if (mi == 0) G3_PIECE(3); else if (mi == 1) G3_PIECE(4); else G3_PIECE(5); } }
#pragma unroll
                    for (int ni = 0; ni < 4; ++ni) acc[mi][ni] = __builtin_amdgcn_mfma_f32_16x16x32_bf16(bfr[ni], af[mi], acc[mi][ni], 0, 0, 0);
                }
            }
        }
#undef G3_PIECE
        nx2 = cur; cur = (cur == 2 * GEMM_STAGE) ? 0 : cur + GEMM_STAGE;
    }
    R.cur = cur; R.nx2 = nx2;
}


template <class AL>
__device__ __forceinline__ void ringn_start(const Frame& F, Ring& R, const AL& al, const bf16* __restrict__ Bt, int K2) {
    const int tid = F.tid, sr = tid >> 3, sc = (tid & 7) ^ ((sr >> 1) & 7), wl = F.wave * 1024;
    const bf16* bp = Bt + (size_t)sr * K2 + sc * 8;
    const size_t bstep = (size_t)64 * K2;
    LAS char* lds = F.lds;
#pragma unroll
    for (int t = 0; t < 2; ++t) {
        __builtin_amdgcn_global_load_lds((const unsigned*)(al.ptr(0) + t * 64), (LAS unsigned*)(lds + t * GEMM_STAGE + wl), 16, 0, 0);
        __builtin_amdgcn_global_load_lds((const unsigned*)(al.ptr(1) + t * 64), (LAS unsigned*)(lds + t * GEMM_STAGE + 8192 + wl), 16, 0, 0);
        __builtin_amdgcn_global_load_lds((const unsigned*)(bp + t * 64), (LAS unsigned*)(lds + t * GEMM_STAGE + 16384 + wl), 16, 0, 0);
        __builtin_amdgcn_global_load_lds((const unsigned*)(bp + bstep + t * 64), (LAS unsigned*)(lds + t * GEMM_STAGE + 16384 + 8192 + wl), 16, 0, 0);
    }
    R.cur = 0; R.nx2 = 2 * GEMM_STAGE;
}
template <int EPI_ST, class AL>
__device__ __forceinline__ void gemm3n_unit(const Frame& F, Ring& R, const AL& al, const bf16* __restrict__ Bt, const AL& alN, const bf16* __restrict__ BtN, bool hasN,
                                            int K2, f32x4 (&acc)[4][2], bool first_unit) {
    static_assert(EPI_ST == 16, "EPI_ST");
    const int tid = F.tid, lane = F.lane, wid = F.wave, wr = wid >> 2, wc = wid & 3, fr = lane & 15, fq = lane >> 4;
    const int sr = tid >> 3, sc = (tid & 7) ^ ((sr >> 1) & 7);
    LAS char* lds = F.lds;
    const bf16* bp = Bt + (size_t)sr * K2 + sc * 8;
    const bf16* bpN = BtN + (size_t)sr * K2 + sc * 8;
    const size_t bstep = (size_t)64 * K2;
    const int key = (fr >> 1) & 7;
    const int ra = (wr * 64 + fr) * 128, rb = 16384 + (wc * 32 + fr) * 128;
#pragma unroll
    for (int mi = 0; mi < 4; ++mi)
#pragma unroll
        for (int ni = 0; ni < 2; ++ni) acc[mi][ni] = (f32x4){0.f, 0.f, 0.f, 0.f};
    const int nk = K2 / 64;
    int cur = R.cur, nx2 = R.nx2;
    const int wl = wid * 1024;
#pragma unroll 1
    for (int kt = 0; kt < nk; ++kt) {
        const bool later = (kt + 1 < nk) || hasN;
        if (!later) G3_WAIT_BAR(0);
        else if (kt >= 2 || first_unit) G3_WAIT_BAR(4);
        else G3_WAIT_BAR(20);
        const bool own = kt + 2 < nk, more = own || hasN;
        const bf16* pa0 = own ? al.ptr(0) : alN.ptr(0); const bf16* pa1 = own ? al.ptr(1) : alN.ptr(1); const bf16* pb = own ? bp : bpN;
        const int k2 = (own ? kt + 2 : kt + 2 - nk) * 64;
#define G3N_PIECE(g_) do { if ((g_) == 0) __builtin_amdgcn_global_load_lds((const unsigned*)(pa0 + k2), (LAS unsigned*)(lds + nx2 + wl), 16, 0, 0); \
            else if ((g_) == 1) __builtin_amdgcn_global_load_lds((const unsigned*)(pa1 + k2), (LAS unsigned*)(lds + nx2 + 8192 + wl), 16, 0, 0); \
            else __builtin_amdgcn_global_load_lds((const unsigned*)(pb + ((g_) - 2) * bstep + k2), (LAS unsigned*)(lds + nx2 + 16384 + ((g_) - 2) * 8192 + wl), 16, 0, 0); } while (0)
#pragma unroll
        for (int ks = 0; ks < 2; ++ks) {
            const int co = ((ks * 4 + fq) ^ key) << 4;
            bf16x8 af[4], bfr[2];
#pragma unroll
            for (int mi = 0; mi < 4; ++mi) af[mi] = *(const LAS bf16x8*)(lds + cur + ra + mi * 2048 + co);
#pragma unroll
            for (int ni = 0; ni < 2; ++ni) bfr[ni] = *(const LAS bf16x8*)(lds + cur + rb + ni * 2048 + co);
#pragma unroll
            for (int mi = 0; mi < 4; ++mi) {
                if (more && (mi & 1) == 0) { if (ks == 0) { if (mi == 0) G3N_PIECE(0); else G3N_PIECE(1); } else { if (mi == 0) G3N_PIECE(2); else G3N_PIECE(3); } }
#pragma unroll
                for (int ni = 0; ni < 2; ++ni) acc[mi][ni] = __builtin_amdgcn_mfma_f32_16x16x32_bf16(bfr[ni], af[mi], acc[mi][ni], 0, 0, 0);
            }
        }
#undef G3N_PIECE
        nx2 = cur; cur = (cur == 2 * GEMM_STAGE) ? 0 : cur + GEMM_STAGE;
    }
    R.cur = cur; R.nx2 = nx2;
}

__device__ __forceinline__ float gelu_tanh(float x) {
    const float z = 0.7978845608028654f * (x + 0.044715f * x * x * x);
    return x * __builtin_amdgcn_rcpf(1.0f + __builtin_amdgcn_exp2f(-2.8853900817779268f * z));
}
namespace pg8 {
#define PG8_LAS __attribute__((address_space(3)))
typedef unsigned short bf16_t;
typedef short bf16x8 __attribute__((ext_vector_type(8)));
typedef float f32x4 __attribute__((ext_vector_type(4)));
typedef unsigned u32x4 __attribute__((ext_vector_type(4)));
typedef int i32x8_ __attribute__((ext_vector_type(8)));
constexpr int BM = 256, BK = 64, HALF = 128, HTB = HALF * BK * 2  , STAGE_BYTES = 8 * HTB, NXCD = 8, WGM = 8;

__host__ __device__ __forceinline__ int lds_byte(int r, int c) { const int st = (r >> 4) * 2 + (c >> 5), rr = r & 15, cc = c & 31, ob = rr * 64 + cc * 2; return st * 1024 + (ob ^ (((ob >> 9) & 1) << 5)); }
__host__ __device__ __forceinline__ void stage_rc(int b, int& R, int& C) { const int st = b / 1024, sb = b % 1024, swz = sb ^ (((sb >> 9) & 1) << 5); R = (st >> 1) * 16 + swz / 64; C = (st & 1) * 32 + (swz % 64) / 2; }
__host__ __device__ __forceinline__ int perm32(int rho) { const int n = rho >> 4, i = rho & 15; return 8 * (i >> 2) + 4 * n + (i & 3); }

struct Unit { int pm, pn; };
struct Gemm { const bf16_t* A; const bf16_t* Bt; int M, N, K; };

struct StaticOrder {
    int nM, nN, nwg, G, c;
    __host__ __device__ void init(int M, int N, int G_, int c_) { nM = M / BM; nN = N / BM; nwg = nM * nN; G = G_; c = c_; }
    __host__ __device__ bool next(int i, Unit& u) const {
        const long L = (long)i * G + c; if (L >= nwg) return false;
        int wgid = (int)L; { const int q = nwg / NXCD, r = nwg % NXCD, xcd = wgid % NXCD, off = wgid / NXCD; wgid = (xcd < r ? xcd * (q + 1) : r * (q + 1) + (xcd - r) * q) + off; }
        const int nig = WGM * nN, gid = wgid / nig, fm = gid * WGM, gsz = (nM - fm) < WGM ? (nM - fm) : WGM;
        u.pm = fm + ((wgid % nig) % gsz); u.pn = (wgid % nig) / gsz; return true;
    }
    __device__ __forceinline__ void a_ready(const Unit&) const {}
    __device__ __forceinline__ void done(const Unit&) const {}
};
__device__ __forceinline__ unsigned cvt_pk_bf16(float lo, float hi) { unsigned r; asm volatile("v_cvt_pk_bf16_f32 %0, %1, %2" : "=v"(r) : "v"(lo), "v"(hi)); return r; }
typedef float f32x2 __attribute__((ext_vector_type(2)));
template <class Epi, class Sched, bool ALIGN_EPI = false, bool SP2 = false, bool F8 = false, bool GATHER = false, bool HALFN = false>
__device__ __forceinline__ void gemm_phase(PG8_LAS unsigned char* lds, const Gemm g, const Sched& S, const Epi& E, int sc_w = 0, int sc_a = 0, const PG8_LAS int* tokL = nullptr) {
    static_assert(!GATHER || SP2, "gather is wired into the two-super-phase loop only");
    static_assert(!HALFN || SP2, "half-width units are wired into the two-super-phase loop only");
    const int tid = threadIdx.x, wid = __builtin_amdgcn_readfirstlane(tid >> 6), lane = tid & 63, wr = wid >> 2, wc = wid & 3, fr = lane & 15, fq = lane >> 4;
    const int K = g.K, nt = K / BK;
    unsigned voffA[2], voffB[2];
#pragma unroll
    for (int i = 0; i < 2; ++i) { int R, C; stage_rc(tid * 16 + i * 8192, R, C); const int Rb = Epi::PERM ? ((R & ~31) + perm32(R & 31)) : R;
        voffA[i] = (unsigned)(R * K + C) * 2u; voffB[i] = (unsigned)(Rb * K + C) * 2u; }
    int rowA4[2], colA2[2];
#pragma unroll
    for (int i = 0; i < 2; ++i) { int R, C; stage_rc(tid * 16 + i * 8192, R, C); rowA4[i] = R * 4; colA2[i] = C * 2; }
    const size_t kstep = (size_t)(BK * 2);
    const size_t hstep = (size_t)HALF * K * 2;
    const size_t tstep = 2 * hstep;
    const unsigned ldsw = (unsigned)wid * 1024u;
    const int aoff = lds_byte(wr * 64 + fr, fq * 8), boff = lds_byte(wc * 32 + fr, fq * 8);
#define PG8_SA(b, h) (((b) * 2 + (h)) * HTB)
#define PG8_SB(b, h) ((4 + (b) * 2 + (h)) * HTB)
#define PG8_STAGE(bufoff, gbase, voff) do { _Pragma("unroll") for (int _i = 0; _i < 2; ++_i) \
        __builtin_amdgcn_global_load_lds((const unsigned*)((const char*)(gbase) + (voff)[_i]), (PG8_LAS unsigned*)(lds + (bufoff) + ldsw + _i * 8192), 16, 0, 0); } while (0)
#define PG8_RD8(dst8_, addr_) do { const u32x4 lo_ = *(const PG8_LAS u32x4*)(addr_), hi_ = *(const PG8_LAS u32x4*)((addr_) + 1024); \
        dst8_ = (i32x8_){(int)lo_.x, (int)lo_.y, (int)lo_.z, (int)lo_.w, (int)hi_.x, (int)hi_.y, (int)hi_.z, (int)hi_.w}; } while (0)
#define PG8_STAGE_AG(bufoff, us_, h_, kt_) do { _Pragma("unroll") for (int _i = 0; _i < 2; ++_i) { \
        const int tk_ = *(const PG8_LAS int*)((const PG8_LAS char*)tokL + (us_) * 1024 + (h_) * 512 + rowA4[_i]); \
        __builtin_amdgcn_global_load_lds((const unsigned*)((const char*)g.A + (size_t)tk_ * (size_t)(K * 2) + (size_t)((kt_) * (BK * 2)) + colA2[_i]), (PG8_LAS unsigned*)(lds + (bufoff) + ldsw + _i * 8192), 16, 0, 0); } } while (0)
#define PG8_LDA(dst, b, h) do { if constexpr (F8) { _Pragma("unroll") for (int m = 0; m < 4; ++m) PG8_RD8(dst##8[m], lds + PG8_SA(b, h) + aoff + m * 2048); } \
        else { _Pragma("unroll") for (int m = 0; m < 4; ++m) _Pragma("unroll") for (int k = 0; k < 2; ++k) dst[m][k] = *(const PG8_LAS bf16x8*)(lds + PG8_SA(b, h) + aoff + m * 2048 + k * 1024); } } while (0)
#define PG8_LDB(dst, b, h) do { if constexpr (F8) { _Pragma("unroll") for (int n = 0; n < 2; ++n) PG8_RD8(dst##8[n], lds + PG8_SB(b, h) + boff + n * 2048); } \
        else { _Pragma("unroll") for (int n = 0; n < 2; ++n) _Pragma("unroll") for (int k = 0; k < 2; ++k) dst[n][k] = *(const PG8_LAS bf16x8*)(lds + PG8_SB(b, h) + boff + n * 2048 + k * 1024); } } while (0)
#define PG8_MMA(ai, bj, At, Bt) do { __builtin_amdgcn_s_setprio(1); \
        if constexpr (F8) { _Pragma("unroll") for (int m = 0; m < 4; ++m) _Pragma("unroll") for (int n = 0; n < 2; ++n) \
            asm volatile("v_mfma_scale_f32_16x16x128_f8f6f4 %0, %1, %2, %0, %3, %4 op_sel_hi:[0,0,0]" : "+v"(acc[ai][bj][m][n]) : "v"(Bt##8[n]), "v"(At##8[m]), "v"(sc_w), "v"(sc_a)); } \
        else { _Pragma("unroll") for (int m = 0; m < 4; ++m) _Pragma("unroll") for (int n = 0; n < 2; ++n) _Pragma("unroll") for (int k = 0; k < 2; ++k) \
            acc[ai][bj][m][n] = __builtin_amdgcn_mfma_f32_16x16x32_bf16(Bt[n][k], At[m][k], acc[ai][bj][m][n], 0, 0, 0); } \
        __builtin_amdgcn_s_setprio(0); } while (0)
#define PG8_WAIT_V(n) asm volatile("s_waitcnt vmcnt(" #n ")" ::: "memory")
#define PG8_WAIT_L(n) asm volatile("s_waitcnt lgkmcnt(" #n ")" ::: "memory")
#define PG8_BAR __builtin_amdgcn_s_barrier()
#define PG8_SCHED __builtin_amdgcn_sched_barrier(0)
    Unit cur, nxt; int ui = 0;
    if (!S.next(0, cur)) return;
    f32x4 acc[2][2][4][2];
#pragma unroll
    for (int a = 0; a < 2; ++a)
#pragma unroll
        for (int b = 0; b < 2; ++b)
#pragma unroll
            for (int m = 0; m < 4; ++m)
#pragma unroll
                for (int n = 0; n < 2; ++n) { acc[a][b][m][n] = (f32x4){0.f, 0.f, 0.f, 0.f}; if constexpr (F8) asm volatile("" : "+v"(acc[a][b][m][n])); }
    bf16x8 At[4][2], B0[2][2], B1[2][2];
    i32x8_ At8[4], B08[2], B18[2];
    const char* cA = (const char*)g.A + (size_t)cur.pm * tstep; const char* cB = (const char*)g.Bt + (size_t)cur.pn * (HALFN ? hstep : tstep);
    S.a_ready(cur);
    if constexpr (SP2) {
        PG8_STAGE(PG8_SB(0, 0), cB, voffB); if constexpr (!HALFN) PG8_STAGE(PG8_SB(0, 1), cB + hstep, voffB);
        if constexpr (GATHER) { PG8_STAGE_AG(PG8_SA(0, 0), 0, 0, 0); PG8_STAGE_AG(PG8_SA(0, 1), 0, 1, 0); } else { PG8_STAGE(PG8_SA(0, 0), cA, voffA); PG8_STAGE(PG8_SA(0, 1), cA + hstep, voffA); }
        if (wr == 1) PG8_BAR;
        PG8_WAIT_V(2); PG8_BAR;
        PG8_STAGE(PG8_SB(1, 0), cB + kstep, voffB);
        if constexpr (GATHER) PG8_STAGE_AG(PG8_SA(1, 0), 0, 0, 1); else PG8_STAGE(PG8_SA(1, 0), cA + kstep, voffA);
        if constexpr (!HALFN) PG8_STAGE(PG8_SB(1, 1), cB + hstep + kstep, voffB);
        if constexpr (HALFN) PG8_WAIT_V(4); else PG8_WAIT_V(6);
        PG8_BAR;
    } else {
        PG8_STAGE(PG8_SB(0, 0), cB, voffB); PG8_STAGE(PG8_SA(0, 0), cA, voffA); PG8_STAGE(PG8_SB(0, 1), cB + hstep, voffB); PG8_STAGE(PG8_SA(0, 1), cA + hstep, voffA);
        if (wr == 1) PG8_BAR;
        PG8_WAIT_V(4); PG8_BAR;
        PG8_STAGE(PG8_SB(1, 0), cB + kstep, voffB); PG8_STAGE(PG8_SA(1, 0), cA + kstep, voffA); PG8_STAGE(PG8_SB(1, 1), cB + hstep + kstep, voffB);
        PG8_WAIT_V(6); PG8_BAR;
    }
    for (;;) {
        const bool has_next = S.next(ui + 1, nxt);
        const char* nA = has_next ? (const char*)g.A + (size_t)nxt.pm * tstep : cA; const char* nB = has_next ? (const char*)g.Bt + (size_t)nxt.pn * (HALFN ? hstep : tstep) : cB;
#pragma unroll 1
        for (int t = 0; t < nt; t += 2) {
            const bool last = (t == nt - 2);
            const char* a1 = cA + (size_t)(t + 1) * kstep;
            const char* a2 = last ? nA : cA + (size_t)(t + 2) * kstep; const char* b2 = last ? nB : cB + (size_t)(t + 2) * kstep;
            const char* a3 = a2 + kstep; const char* b3 = b2 + kstep;
            if (last && has_next) S.a_ready(nxt);
            if constexpr (SP2) {
            const int us2 = (last && has_next) ? ui + 1 : ui, kt2 = last ? 0 : t + 2;
#define PG8_WV_LOOP() do { if constexpr (HALFN) PG8_WAIT_V(6); else PG8_WAIT_V(8); } while (0)
            PG8_LDB(B0, 0, 0); if constexpr (!HALFN) PG8_LDB(B1, 0, 1); PG8_SCHED; PG8_LDA(At, 0, 0);
            if constexpr (GATHER) PG8_STAGE_AG(PG8_SA(1, 1), ui, 1, t + 1); else PG8_STAGE(PG8_SA(1, 1), a1 + hstep, voffA);
            PG8_WV_LOOP(); PG8_WAIT_L(0); PG8_BAR; PG8_MMA(0, 0, At, B0); if constexpr (!HALFN) PG8_MMA(0, 1, At, B1); PG8_BAR; PG8_SCHED;
            PG8_LDA(At, 0, 1); PG8_STAGE(PG8_SB(0, 0), b2, voffB); if constexpr (!HALFN) PG8_STAGE(PG8_SB(0, 1), b2 + hstep, voffB);
            if constexpr (GATHER) PG8_STAGE_AG(PG8_SA(0, 0), us2, 0, kt2); else PG8_STAGE(PG8_SA(0, 0), a2, voffA);
            PG8_WV_LOOP(); PG8_WAIT_L(0); PG8_BAR; PG8_MMA(1, 0, At, B0); if constexpr (!HALFN) PG8_MMA(1, 1, At, B1); PG8_BAR; PG8_SCHED;
            PG8_LDB(B0, 1, 0); if constexpr (!HALFN) PG8_LDB(B1, 1, 1); PG8_SCHED; PG8_LDA(At, 1, 0);
            if constexpr (GATHER) PG8_STAGE_AG(PG8_SA(0, 1), us2, 1, kt2); else PG8_STAGE(PG8_SA(0, 1), a2 + hstep, voffA);
            PG8_WV_LOOP(); PG8_WAIT_L(0); PG8_BAR; PG8_MMA(0, 0, At, B0); if constexpr (!HALFN) PG8_MMA(0, 1, At, B1); PG8_BAR; PG8_SCHED;
            PG8_LDA(At, 1, 1); PG8_STAGE(PG8_SB(1, 0), b3, voffB); if constexpr (!HALFN) PG8_STAGE(PG8_SB(1, 1), b3 + hstep, voffB);
            if constexpr (GATHER) PG8_STAGE_AG(PG8_SA(1, 0), us2, 0, kt2 + 1); else PG8_STAGE(PG8_SA(1, 0), a3, voffA);
            PG8_WV_LOOP(); PG8_WAIT_L(0); PG8_BAR; PG8_MMA(1, 0, At, B0); if constexpr (!HALFN) PG8_MMA(1, 1, At, B1); PG8_BAR; PG8_SCHED;
#undef PG8_WV_LOOP
            } else {
            PG8_LDB(B0, 0, 0); PG8_SCHED; PG8_LDA(At, 0, 0); PG8_STAGE(PG8_SA(1, 1), a1 + hstep, voffA);
            PG8_WAIT_L(8); PG8_BAR; PG8_WAIT_L(0); PG8_MMA(0, 0, At, B0); PG8_BAR; PG8_SCHED;
            PG8_LDB(B1, 0, 1); PG8_STAGE(PG8_SB(0, 0), b2, voffB);
            PG8_BAR; PG8_WAIT_L(0); PG8_MMA(0, 1, At, B1); PG8_BAR;
            PG8_LDA(At, 0, 1); PG8_STAGE(PG8_SA(0, 0), a2, voffA);
            PG8_BAR; PG8_WAIT_L(0); PG8_MMA(1, 0, At, B0); PG8_BAR; PG8_SCHED;
            PG8_STAGE(PG8_SB(0, 1), b2 + hstep, voffB);
            PG8_WAIT_V(6); PG8_BAR; PG8_MMA(1, 1, At, B1); PG8_BAR;
            PG8_LDB(B0, 1, 0); PG8_SCHED; PG8_LDA(At, 1, 0); PG8_STAGE(PG8_SA(0, 1), a2 + hstep, voffA);
            PG8_WAIT_L(8); PG8_BAR; PG8_WAIT_L(0); PG8_MMA(0, 0, At, B0); PG8_BAR; PG8_SCHED;
            PG8_LDB(B1, 1, 1); PG8_STAGE(PG8_SB(1, 0), b3, voffB);
            PG8_BAR; PG8_WAIT_L(0); PG8_MMA(0, 1, At, B1); PG8_BAR;
            PG8_LDA(At, 1, 1); PG8_STAGE(PG8_SA(1, 0), a3, voffA);
            PG8_BAR; PG8_WAIT_L(0); PG8_MMA(1, 0, At, B0); PG8_BAR; PG8_SCHED;
            PG8_STAGE(PG8_SB(1, 1), b3 + hstep, voffB);
            PG8_WAIT_V(6); PG8_BAR; PG8_MMA(1, 1, At, B1); PG8_BAR;
            }
        }
        asm volatile("s_nop 7\n\ts_nop 7\n\ts_nop 7" ::: "memory");
        if constexpr (ALIGN_EPI) { if (wr == 0) PG8_BAR; }
        if constexpr (!Epi::AFTER_DRAIN) { E(acc, cur, wr, wc, fr, fq); S.done(cur); }
        if (!has_next) break;
#pragma unroll
        for (int a = 0; a < 2; ++a)
#pragma unroll
            for (int b = 0; b < 2; ++b)
#pragma unroll
                for (int m = 0; m < 4; ++m)
#pragma unroll
                    for (int n = 0; n < 2; ++n) { acc[a][b][m][n] = (f32x4){0.f, 0.f, 0.f, 0.f}; if constexpr (F8) asm volatile("" : "+v"(acc[a][b][m][n])); }
        cur = nxt; cA = nA; cB = nB; ++ui;
        if constexpr (ALIGN_EPI) { if (wr == 1) PG8_BAR; }
    }
    PG8_WAIT_V(0);
    if constexpr (!ALIGN_EPI) { if (wr == 0) PG8_BAR; }
    PG8_BAR;
    if constexpr (Epi::AFTER_DRAIN) { E.fused(acc, cur, wr, wc, fr, fq, lds, wid, lane); S.done(cur); }
#undef PG8_SA
#undef PG8_SB
#undef PG8_STAGE
#undef PG8_STAGE_AG
#undef PG8_LDA
#undef PG8_RD8
#undef PG8_LDB
#undef PG8_MMA
#undef PG8_WAIT_V
#undef PG8_WAIT_L
#undef PG8_BAR
#undef PG8_SCHED
}
}

namespace pg8 {
struct EpiScaleBf16 {
    static constexpr bool PERM = true, AFTER_DRAIN = false;
    bf16_t* O; int ldc; const float* scale_base; int scale_stride;
    __device__ __forceinline__ void operator()(const f32x4 (&acc)[2][2][4][2], const Unit& u, int wr, int wc, int fr, int fq) const {
        const int row0 = u.pm * BM + wr * 64 + fr, col0 = u.pn * BM + wc * 32 + 8 * fq;
        const float* sc = scale_base + (size_t)((u.pm * BM) >> 12) * scale_stride;
        f32x4 sv[2][2];
#pragma unroll
        for (int bj = 0; bj < 2; ++bj)
#pragma unroll
            for (int n = 0; n < 2; ++n) sv[bj][n] = *(const f32x4*)(sc + col0 + bj * HALF + 4 * n);
#pragma unroll
        for (int ai = 0; ai < 2; ++ai)
#pragma unroll
            for (int m = 0; m < 4; ++m) { bf16_t* rowp = O + (size_t)(row0 + ai * HALF + m * 16) * ldc + col0;
#pragma unroll
                for (int bj = 0; bj < 2; ++bj) { const f32x4 v0 = acc[ai][bj][m][0] * sv[bj][0], v1 = acc[ai][bj][m][1] * sv[bj][1];
                    u32x4 w; w.x = cvt_pk_bf16(v0[0], v0[1]); w.y = cvt_pk_bf16(v0[2], v0[3]); w.z = cvt_pk_bf16(v1[0], v1[1]); w.w = cvt_pk_bf16(v1[2], v1[3]);
                    *(u32x4*)(rowp + bj * HALF) = w; } }
    }
};
struct EpiIn {
    static constexpr bool PERM = true, AFTER_DRAIN = false;
    bf16_t* YG; bf16_t* U;
    __device__ __forceinline__ void operator()(const f32x4 (&acc)[2][2][4][2], const Unit& u, int wr, int wc, int fr, int fq) const {
        const bool isy = u.pn < 4;
        bf16_t* base = isy ? YG : U;
        const int row0 = u.pm * BM + wr * 64 + fr, col0 = (u.pn & 3) * BM + wc * 32 + 8 * fq;
#pragma unroll
        for (int ai = 0; ai < 2; ++ai)
#pragma unroll
            for (int m = 0; m < 4; ++m) { bf16_t* rowp = base + (size_t)(row0 + ai * HALF + m * 16) * 1024 + col0;
#pragma unroll
                for (int bj = 0; bj < 2; ++bj) { f32x4 v0 = acc[ai][bj][m][0], v1 = acc[ai][bj][m][1];
                    if (isy) { v0 = (f32x4){::gelu_tanh(v0[0]), ::gelu_tanh(v0[1]), ::gelu_tanh(v0[2]), ::gelu_tanh(v0[3])}; v1 = (f32x4){::gelu_tanh(v1[0]), ::gelu_tanh(v1[1]), ::gelu_tanh(v1[2]), ::gelu_tanh(v1[3])}; }
                    u32x4 w; w.x = cvt_pk_bf16(v0[0], v0[1]); w.y = cvt_pk_bf16(v0[2], v0[3]); w.z = cvt_pk_bf16(v1[0], v1[1]); w.w = cvt_pk_bf16(v1[2], v1[3]);
                    *(u32x4*)(rowp + bj * HALF) = w; } }
    }
};
struct EpiQKV {
    static constexpr bool PERM = false, AFTER_DRAIN = false;
    bf16_t* Q; bf16_t* Kb; bf16_t* VT; const PG8_LAS float* cs;
    __device__ __forceinline__ void operator()(const f32x4 (&acc)[2][2][4][2], const Unit& u, int wr, int wc, int fr, int fq) const {
        const int region = u.pn >> 2, pq = u.pn & 3;
        const bool isctx = u.pm >= NX / BM;
#pragma unroll
        for (int ai = 0; ai < 2; ++ai)
#pragma unroll
            for (int m = 0; m < 4; ++m) {
                const int row = u.pm * BM + ai * HALF + wr * 64 + m * 16 + fr;
                int b, pos;
                if (!isctx) { b = row >> 12; pos = row & 4095; } else { b = (row - NX) >> 8; pos = S + ((row - NX) & 255); }
                if (region < 2) {
                    const int p = (wc & 1) ? (pos & 63) : (pos >> 6);
                    const float scl = region == 0 ? QSCALE : 1.0f;
#pragma unroll
                    for (int bj = 0; bj < 2; ++bj) {
                        const int hi2 = 4 * pq + 2 * bj + (wc >> 1);
                        bf16_t* dst = region == 0 ? Q + ((size_t)(b * 16 + hi2) * S + pos) * 64 : Kb + ((size_t)(b * 16 + hi2) * KEYS + pos) * 64;
#pragma unroll
                        for (int n = 0; n < 2; ++n) {
                            f32x4 o = acc[ai][bj][m][n];
                            if (!isctx) {
                                const f32x4 pv = acc[ai][bj][m][n ^ 1];
#pragma unroll
                                for (int i = 0; i < 4; ++i) { const float c_ = cs[(p * 16 + fq * 4 + i) * 2], s_ = cs[(p * 16 + fq * 4 + i) * 2 + 1]; o[i] = o[i] * c_ + (n ? pv[i] : -pv[i]) * s_; }
                            }
                            typedef unsigned u32x2_ __attribute__((ext_vector_type(2)));
                            u32x2_ w; w.x = cvt_pk_bf16(o[0] * scl, o[1] * scl); w.y = cvt_pk_bf16(o[2] * scl, o[3] * scl);
                            *(u32x2_*)(dst + (wc & 1) * 32 + n * 16 + fq * 4) = w;
                        }
                    }
                } else {
                    const int ppos = (pos & ~12) | ((pos & 4) << 1) | ((pos & 8) >> 1);
#pragma unroll
                    for (int bj = 0; bj < 2; ++bj)
#pragma unroll
                        for (int n = 0; n < 2; ++n) {
                            const int h = 2 * pq + bj, vd = 32 * wc + 16 * n + 4 * fq;
                            bf16_t* vp = VT + ((size_t)(b * 8 + h) * 128 + vd) * KEYS + ppos;
                            const f32x4 v = acc[ai][bj][m][n];
                            const unsigned p01 = cvt_pk_bf16(v[0], v[1]), p23 = cvt_pk_bf16(v[2], v[3]);
                            vp[0] = (bf16_t)(p01 & 0xffffu); vp[KEYS] = (bf16_t)(p01 >> 16); vp[2 * KEYS] = (bf16_t)(p23 & 0xffffu); vp[3 * KEYS] = (bf16_t)(p23 >> 16);
                        }
                }
            }
    }
};
struct QkvOrder {
    StaticOrder so; int G, c;
    __host__ __device__ void init(int G_, int c_) { so.init(NX, 3 * D, G_, c_); G = G_; c = c_; }
    __host__ __device__ bool next(int i, Unit& u) const { return so.next(i, u); }
    __device__ __forceinline__ void a_ready(const Unit&) const {}
    __device__ __forceinline__ void done(const Unit&) const {}
};
struct MoeOrder {
    int G, c, nunits; const PG8_LAS int* pst;
    __device__ __forceinline__ bool next(int i, Unit& u) const {
        const int L = i * G + c; if (L >= nunits) return false;
        const int pm = L >> 2, m0 = pm * BM; int e = 0;
        for (int x = 1; x < 32; ++x) e = (pst[x] <= m0) ? x : e;
        u.pm = pm; u.pn = e * 4 + (L & 3); return true;
    }
    __device__ __forceinline__ void a_ready(const Unit&) const {}
    __device__ __forceinline__ void done(const Unit&) const {}
};
struct MoeHalfOrder {
    int G, c, hcount, base; const PG8_LAS int* pst;
    __device__ __forceinline__ bool next(int i, Unit& u) const {
        const int hL = i * G + c; if (hL >= hcount) return false;
        const int Lf = base + (hL >> 1), pm = Lf >> 2, m0 = pm * BM; int e = 0;
        for (int x = 1; x < 32; ++x) e = (pst[x] <= m0) ? x : e;
        u.pm = pm; u.pn = (e * 4 + (Lf & 3)) * 2 + (hL & 1); return true;
    }
    __device__ __forceinline__ void a_ready(const Unit&) const {}
    __device__ __forceinline__ void done(const Unit&) const {}
};
struct EpiRes {
    static constexpr bool PERM = true, AFTER_DRAIN = false;
    bf16_t* O; const float* X; const float* gate_base; int gate_stride;
    __device__ __forceinline__ void operator()(const f32x4 (&acc)[2][2][4][2], const Unit& u, int wr, int wc, int fr, int fq) const {
        const int row0 = u.pm * BM + wr * 64 + fr, col0 = u.pn * BM + wc * 32 + 8 * fq;
        const float* gt = gate_base + (size_t)((u.pm * BM) >> 12) * gate_stride;
        f32x4 gv[2][2];
#pragma unroll
        for (int bj = 0; bj < 2; ++bj)
#pragma unroll
            for (int n = 0; n < 2; ++n) gv[bj][n] = *(const f32x4*)(gt + col0 + bj * HALF + 4 * n);
#pragma unroll
        for (int ai = 0; ai < 2; ++ai)
#pragma unroll
            for (int m = 0; m < 4; ++m) {
                const size_t ro = (size_t)(row0 + ai * HALF + m * 16) * 1024 + col0;
                f32x4 xr[2][2];
#pragma unroll
                for (int bj = 0; bj < 2; ++bj)
#pragma unroll
                    for (int n = 0; n < 2; ++n) xr[bj][n] = __builtin_nontemporal_load((const f32x4*)(X + ro + bj * HALF + 4 * n));
#pragma unroll
                for (int bj = 0; bj < 2; ++bj) {
                    const f32x4 v0 = xr[bj][0] + gv[bj][0] * acc[ai][bj][m][0], v1 = xr[bj][1] + gv[bj][1] * acc[ai][bj][m][1];
                    u32x4 w; w.x = cvt_pk_bf16(v0[0], v0[1]); w.y = cvt_pk_bf16(v0[2], v0[3]); w.z = cvt_pk_bf16(v1[0], v1[1]); w.w = cvt_pk_bf16(v1[2], v1[3]);
                    *(u32x4*)(O + ro + bj * HALF) = w;
                }
            }
    }
};
struct EpiY {
    static constexpr bool PERM = true, AFTER_DRAIN = false;
    bf16_t* Y;
    __device__ __forceinline__ void operator()(const f32x4 (&acc)[2][2][4][2], const Unit& u, int wr, int wc, int fr, int fq) const {
        const int row0 = u.pm * BM + wr * 64 + fr, col0 = (u.pn & 3) * BM + wc * 32 + 8 * fq;
#pragma unroll
        for (int ai = 0; ai < 2; ++ai)
#pragma unroll
            for (int m = 0; m < 4; ++m) { bf16_t* rowp = Y + (size_t)(row0 + ai * HALF + m * 16) * 1024 + col0;
#pragma unroll
                for (int bj = 0; bj < 2; ++bj) { const f32x4 v0 = acc[ai][bj][m][0], v1 = acc[ai][bj][m][1];
                    if (Y_FP8) {
                        typedef unsigned u32x2_ __attribute__((ext_vector_type(2)));
                        u32x2_ w8;
                        w8.x = ::pk4_fp8(fminf(fmaxf(16.0f * v0[0], -448.f), 448.f), fminf(fmaxf(16.0f * v0[1], -448.f), 448.f), fminf(fmaxf(16.0f * v0[2], -448.f), 448.f), fminf(fmaxf(16.0f * v0[3], -448.f), 448.f));
                        w8.y = ::pk4_fp8(fminf(fmaxf(16.0f * v1[0], -448.f), 448.f), fminf(fmaxf(16.0f * v1[1], -448.f), 448.f), fminf(fmaxf(16.0f * v1[2], -448.f), 448.f), fminf(fmaxf(16.0f * v1[3], -448.f), 448.f));
                        *(u32x2_*)((unsigned char*)Y + (size_t)(row0 + ai * HALF + m * 16) * 1024 + col0 + bj * HALF) = w8;
                    } else {
                    u32x4 w; w.x = cvt_pk_bf16(v0[0], v0[1]); w.y = cvt_pk_bf16(v0[2], v0[3]); w.z = cvt_pk_bf16(v1[0], v1[1]); w.w = cvt_pk_bf16(v1[2], v1[3]);
                    *(u32x4*)(rowp + bj * HALF) = w; } } }
    }
};
struct EpiUp {
    static constexpr bool PERM = false, AFTER_DRAIN = false;
    unsigned char* G8; const PG8_LAS float* wgtL; int c, G;
    __device__ __forceinline__ void operator()(const f32x4 (&acc)[2][2][4][2], const Unit& u, int wr, int wc, int fr, int fq) const {
        const int row0 = u.pm * BM + wr * 64 + fr, col0 = (u.pn & 3) * 128 + wc * 16 + fq * 4;
        const PG8_LAS float* wrow = wgtL + (((u.pm * 4 + (u.pn & 3)) - c) / G) * 256 + wr * 64 + fr;
#pragma unroll
        for (int ai = 0; ai < 2; ++ai)
#pragma unroll
            for (int m = 0; m < 4; ++m) {
                const int row = row0 + ai * HALF + m * 16;
                const float wgt = wrow[ai * HALF + m * 16];
#pragma unroll
                for (int bj = 0; bj < 2; ++bj) {
                    const f32x4 gt = acc[ai][bj][m][0], up = acc[ai][bj][m][1];
                    float o[4];
#pragma unroll
                    for (int c = 0; c < 4; ++c) o[c] = fminf(fmaxf(gt[c] * __builtin_amdgcn_rcpf(1.0f + __builtin_amdgcn_exp2f(-1.4426950408889634f * gt[c])) * up[c] * wgt, -448.0f), 448.0f);
                    *(unsigned*)(G8 + (size_t)row * 512 + col0 + bj * 64) = ::pk4_fp8(o[0], o[1], o[2], o[3]);
                }
            }
    }
};
struct EpiUpH {
    static constexpr bool PERM = false, AFTER_DRAIN = false;
    unsigned char* G8; const PG8_LAS float* wgtL; int c, G, base;
    __device__ __forceinline__ void operator()(const f32x4 (&acc)[2][2][4][2], const Unit& u, int wr, int wc, int fr, int fq) const {
        const int jq = (u.pn >> 1) & 3, nh = u.pn & 1;
        const int row0 = u.pm * BM + wr * 64 + fr, col0 = jq * 128 + nh * 64 + wc * 16 + fq * 4;
        const int hL = ((u.pm * 4 + jq) - base) * 2 + nh;
        const PG8_LAS float* wrow = wgtL + ((hL - c) / G) * 256 + wr * 64 + fr;
#pragma unroll
        for (int ai = 0; ai < 2; ++ai)
#pragma unroll
            for (int m = 0; m < 4; ++m) {
                const int row = row0 + ai * HALF + m * 16;
                const float wgt = wrow[ai * HALF + m * 16];
                const f32x4 gt = acc[ai][0][m][0], up = acc[ai][0][m][1];
                float o[4];
#pragma unroll
                for (int cc = 0; cc < 4; ++cc) o[cc] = fminf(fmaxf(gt[cc] * __builtin_amdgcn_rcpf(1.0f + __builtin_amdgcn_exp2f(-1.4426950408889634f * gt[cc])) * up[cc] * wgt, -448.0f), 448.0f);
                *(unsigned*)(G8 + (size_t)row * 512 + col0) = ::pk4_fp8(o[0], o[1], o[2], o[3]);
            }
    }
};
}

__device__ __forceinline__ void phase_gemm_in(Frame& F) {
    const bf16* H = (const bf16*)(F.ws + WS_H); const bf16* W = (const bf16*)(F.ws + WS_WIN);
    {
        pg8::Gemm g{(const pg8::bf16_t*)H, (const pg8::bf16_t*)W, NX, 2 * D, D};
        pg8::StaticOrder S; S.init(NX, 2 * D, F.G, (int)blockIdx.x);
        pg8::EpiIn E{(pg8::bf16_t*)(F.ws + WS_YG), (pg8::bf16_t*)(F.ws + WS_U)};
        pg8::gemm_phase<pg8::EpiIn, pg8::StaticOrder, true, true>((PG8_LAS unsigned char*)F.lds, g, S, E);
    }
    constexpr int NCU = (NC / 128) * 16;
    if (F.vcu < NCU) {
        const int wr = F.wave >> 2, wc = F.wave & 3, fr = F.lane & 15, fq = F.lane >> 4;
        const int mt = F.vcu >> 4, nt = F.vcu & 15, m0 = NX + mt * 128, n0 = nt * 128;
        ALDense al; Ring R;
        al.init(H, D, m0, F.tid >> 3, (F.tid >> 3) + 64, dma_kc(F.tid));
        const bf16* Bp = W + (size_t)n0 * D;
        ringn_start(F, R, al, Bp, D);
        f32x4 acc[4][2];
        gemm3n_unit<16>(F, R, al, Bp, al, Bp, false, D, acc, true);
        const bool isy = n0 < D;
        bf16* base = (bf16*)(F.ws + (isy ? WS_YG : WS_U));
#pragma unroll
        for (int mi = 0; mi < 4; ++mi)
#pragma unroll
            for (int ni = 0; ni < 2; ++ni) {
                f32x4 v = acc[mi][ni];
                if (isy) v = (f32x4){gelu_tanh(v.x), gelu_tanh(v.y), gelu_tanh(v.z), gelu_tanh(v.w)};
                u32x2 o; o.x = pk2(v.x, v.y); o.y = pk2(v.z, v.w);
                *(u32x2*)(base + (size_t)(m0 + wr * 64 + mi * 16 + fr) * D + (n0 & (D - 1)) + wc * 32 + ni * 16 + fq * 4) = o;
            }
    }
    __syncthreads();
    tail_convert(F, F.vcu * NWAVES + F.wave, 0, ND_A, F.G * NWAVES);
}

__device__ __forceinline__ float neg_expm1(float x) {
    const float p = 1.0f + x * (0.5f + x * (0.16666667f + x * (0.041666668f + x * (0.0083333338f + x * 0.0013888889f))));
    const float ser = -x * p, big = 1.0f - __expf(x);
    return x > -0.5f ? ser : big;
}
__device__ __forceinline__ int seg_of(int row) { return row < NX ? (row >> 12) : 4 + ((row - NX) >> 8); }
__device__ __forceinline__ void phase_conv(Frame& F) {
    const Args& A = *F.a;
    const bf16* U = (const bf16*)(F.ws + WS_U);
    bf16* UC = (bf16*)(F.ws + WS_UC);
    const int c8 = F.tid & 127, grp = F.vcu * 4 + (F.tid >> 7);
    if (grp >= 1024) return;
    float cw[4][8], cb[8];
#pragma unroll
    for (int k = 0; k < 4; ++k) {
        const f32x4 a0 = *(const f32x4*)(A.in[I_CONVW] + k * 1024 + c8 * 8), a1 = *(const f32x4*)(A.in[I_CONVW] + k * 1024 + c8 * 8 + 4);
        cw[k][0] = a0.x; cw[k][1] = a0.y; cw[k][2] = a0.z; cw[k][3] = a0.w; cw[k][4] = a1.x; cw[k][5] = a1.y; cw[k][6] = a1.z; cw[k][7] = a1.w;
    }
    { const f32x4 a0 = *(const f32x4*)(A.in[I_CONVB] + c8 * 8), a1 = *(const f32x4*)(A.in[I_CONVB] + c8 * 8 + 4);
      cb[0] = a0.x; cb[1] = a0.y; cb[2] = a0.z; cb[3] = a0.w; cb[4] = a1.x; cb[5] = a1.y; cb[6] = a1.z; cb[7] = a1.w; }
    const int r0 = grp * 17;
    u32x4 x[4];
    auto ld = [&](int rr, int seg) -> u32x4 {
        u32x4 v = (u32x4){0u, 0u, 0u, 0u};
        if (rr >= 0 && rr < NTOK && seg_of(rr) == seg) v = *(const u32x4*)(U + (size_t)rr * D + c8 * 8);
        return v; };
#pragma unroll 1
    for (int i = 0; i < 17; ++i) {
        const int r = r0 + i, seg = seg_of(r);
#pragma unroll
        for (int j = 0; j < 4; ++j) x[j] = ld(r + j - 2, seg);
        float o[8];
#pragma unroll
        for (int j = 0; j < 8; ++j) o[j] = cb[j];
#pragma unroll
        for (int k = 0; k < 4; ++k)
#pragma unroll
            for (int p = 0; p < 4; ++p) { o[2 * p] += cw[k][2 * p] * bflo(x[k][p]); o[2 * p + 1] += cw[k][2 * p + 1] * bfhi(x[k][p]); }
        u32x4 ov; ov.x = pk2(o[0], o[1]); ov.y = pk2(o[2], o[3]); ov.z = pk2(o[4], o[5]); ov.w = pk2(o[6], o[7]);
        *(u32x4*)(UC + (size_t)r * D + c8 * 8) = ov;
    }
}

template <int V> struct IntC { static constexpr int value = V; };
__device__ __forceinline__ void phase_scan(Frame& F) {
    const Args& A = *F.a;
    const int wi = F.vcu;
    if (wi >= 256) return;
    const int b = wi >> 6, n = (wi >> 3) & 7, d = (wi >> 2) & 1, q = wi & 3;
    const int tid = F.tid, lane = F.lane, w = F.wave, fr = lane & 15, fq = lane >> 4;
    LAS float* AGG = (LAS float*)(F.lds + 66560);
    LAS float* CIN = (LAS float*)(F.lds + 74752);
    const bf16* UC = (const bf16*)(F.ws + WS_UC);
    bf16* HO = (bf16*)(F.ws + (d ? WS_HB : WS_HF));
    const int chbase = n * 128, och = chbase + q * 32;
    const bf16* GT = (const bf16*)(F.ws + WS_GATE);
    LAS char* BT = F.lds + 81920;
#pragma unroll
    for (int i = 0; i < 2; ++i) {
        const int idx = tid + 512 * i, jrow = idx >> 4, c = idx & 15, nb = jrow >> 4, f2 = jrow & 15;
        *(LAS u32x4*)(BT + jrow * 256 + ((c ^ f2) << 4)) = *(const u32x4*)(GT + ((size_t)(((d * 2 + (nb >> 1)) * 8 + n) * 128 + q * 32 + (nb & 1) * 16 + f2)) * 128 + c * 8);
    }
    float ba[2], bi[2], sp8[2];
#pragma unroll
    for (int h = 0; h < 2; ++h) {
        const int ch = och + h * 16 + fr;
        ba[h] = A.in[I_GAB][d * 1024 + ch]; bi[h] = A.in[I_GXB][d * 1024 + ch];
        sp8[h] = 8.0f * log1pf(expf(-A.in[I_LAM][d * 1024 + ch]));
    }
    auto tile_dma = [&](int step_) {
        int sb_, tl_;
        if (step_ < 2) { sb_ = NX + b * CL; tl_ = d ? (1 - step_) : step_; } else { sb_ = b * S; tl_ = d ? (33 - step_) : (step_ - 2); }
        LAS char* img = F.lds + (step_ & 1) * 32768;
#pragma unroll
        for (int i = 0; i < 4; ++i) {
            const int p = w * 4 + i, row = 4 * p + (lane >> 4), sc = (lane & 15) ^ (row & 15);
            __builtin_amdgcn_global_load_lds((const unsigned*)(UC + (size_t)(sb_ + tl_ * 128 + row) * D + chbase + sc * 8), (LAS unsigned*)(img + p * 1024), 16, 0, 0);
        }
    };
    float hcar = 0.f;
    tile_dma(0);
    LAS float* cscr = (LAS float*)(F.lds + 98304 + w * 4224);
    const int cgw = F.vcu * NWAVES + w, CNGW = F.G * NWAVES;
    int cit = ND_B + cgw;
    static_assert(ND_B >= ND_WQKV + ND_WO && L0_FP8, "every conversion inside the scan has an fp8 destination (one store): the counted wait below relies on it");
    bool cprev = false;
    const float* pMG = A.in[I_MG]; const float* pMU = A.in[I_MU]; const float* pMD = A.in[I_MD];
    auto decode_scan = [&](int r) -> TDesc {
        TDesc t; t.f8 = 1; int item; r -= ND_WQKV + ND_WO;
        if (r < ND_MOEL) { const int e = r >> 9; t.W = pMG + (size_t)e * 1024 * 512; t.N = 512; t.WT = (bf16*)(F.ws + WS_WUP + (size_t)e * 1024 * 1024); t.ldT = 1024; t.mode = 1; item = r & 511; }
        else if ((r -= ND_MOEL) < ND_MOEL) { const int e = r >> 9; t.W = pMU + (size_t)e * 1024 * 512; t.N = 512; t.WT = (bf16*)(F.ws + WS_WUP + (size_t)e * 1024 * 1024); t.ldT = 1024; t.mode = 2; item = r & 511; }
        else { r -= ND_MOEL; const int e = r >> 9; t.W = pMD + (size_t)e * 512 * 1024; t.N = 1024; t.WT = (bf16*)(F.ws + WS_WDN + (size_t)e * 1024 * 512); t.ldT = 512; t.mode = 0; item = r & 511; }
        const int nblk = t.N >> 5; t.k0 = 32 * (item / nblk); t.n0 = 32 * (item % nblk);
        return t; };
#define SC_BAR_LGKM() asm volatile("s_waitcnt lgkmcnt(0)\n\ts_barrier" ::: "memory")
    auto steps = [&](auto dconst) {
    constexpr int DD = decltype(dconst)::value;
    for (int step = 0; step < 34; ++step) {
        int segbase, tile;
        if (step < 2) { segbase = NX + b * CL; tile = DD ? (1 - step) : step; }
        else { segbase = b * S; tile = DD ? (33 - step) : (step - 2); }
        const int t0 = tile * 128;
        LAS char* AT = F.lds + (step & 1) * 32768;
        if (step == 0) asm volatile("s_waitcnt vmcnt(0) lgkmcnt(0)\n\ts_barrier" ::: "memory");
        else if (cprev) asm volatile("s_waitcnt vmcnt(5) lgkmcnt(0)\n\ts_barrier" ::: "memory");
        else asm volatile("s_waitcnt vmcnt(4) lgkmcnt(0)\n\ts_barrier" ::: "memory");
        if (step + 1 < 34) tile_dma(step + 1);
        TDesc cd; f32x4 crg[4]; const bool chas = cit < ND_SCAN;
        if (chas) { cd = decode_scan(cit); tr2_load(cd, lane, crg); cit += CNGW; }
        f32x4 acc[4];
#pragma unroll
        for (int nb = 0; nb < 4; ++nb) acc[nb] = (f32x4){0.f, 0.f, 0.f, 0.f};
#pragma unroll
        for (int ks = 0; ks < 4; ++ks) {
            const int row = 16 * w + fr;
            const bf16x8 af = *(const LAS bf16x8*)(AT + row * 256 + (((4 * ks + fq) ^ fr) << 4));
#pragma unroll
            for (int nb = 0; nb < 4; ++nb) {
                const bf16x8 bq = *(const LAS bf16x8*)(BT + (nb * 16 + fr) * 256 + (((4 * ks + fq) ^ fr) << 4));
                acc[nb] = __builtin_amdgcn_mfma_f32_16x16x32_bf16(af, bq, acc[nb], 0, 0, 0);
            }
        }
        float av[2][4], bv[2][4];
#pragma unroll
        for (int h = 0; h < 2; ++h) {
            const int col = q * 32 + h * 16 + fr, chunk = col >> 3, within = col & 7;
#pragma unroll
            for (int reg = 0; reg < 4; ++reg) {
                const int tr = 16 * w + 4 * fq + reg;
                const float r_ = __builtin_amdgcn_rcpf(1.0f + __builtin_amdgcn_exp2f(-1.4426950408889634f * (acc[h][reg] + ba[h])));
                const float i_ = __builtin_amdgcn_rcpf(1.0f + __builtin_amdgcn_exp2f(-1.4426950408889634f * (acc[2 + h][reg] + bi[h])));
                const float la = -sp8[h] * r_;
                const float a_ = __builtin_amdgcn_exp2f(1.4426950408889634f * la);
                const unsigned short ub = *(const LAS unsigned short*)(AT + tr * 256 + ((chunk ^ (tr & 15)) << 4) + within * 2);
                const float uval = __builtin_bit_cast(float, (unsigned)ub << 16);
                av[h][reg] = a_;
                bv[h][reg] = __builtin_amdgcn_sqrtf(neg_expm1(2.0f * la)) * (i_ * uval);
            }
        }
        const int g = 4 * w + fq;
#pragma unroll
        for (int h = 0; h < 2; ++h) {
            float P = 1.f, Hh = 0.f;
#pragma unroll
            for (int s = 0; s < 4; ++s) { const int reg = DD ? (3 - s) : s; Hh = av[h][reg] * Hh + bv[h][reg]; P *= av[h][reg]; }
            AGG[(g * 32 + h * 16 + fr) * 2 + 0] = P; AGG[(g * 32 + h * 16 + fr) * 2 + 1] = Hh;
        }
        SC_BAR_LGKM();
        {
            const int ch = 4 * w + (lane >> 4), sub = lane & 15;
            const int g0 = DD ? 31 - 2 * sub : 2 * sub, g1 = DD ? g0 - 1 : g0 + 1;
            const f32x2 A0 = *(const LAS f32x2*)(AGG + (g0 * 32 + ch) * 2), A1 = *(const LAS f32x2*)(AGG + (g1 * 32 + ch) * 2);
            float P = A0.x * A1.x, Hh = A1.x * A0.y + A1.y;
#define SC_DPP(v_, ctrl_, idv_) __builtin_bit_cast(float, __builtin_amdgcn_update_dpp(__builtin_bit_cast(int, (float)(idv_)), __builtin_bit_cast(int, (float)(v_)), ctrl_, 0xf, 0xf, false))
#define SC_STEP(ctrl_) { const float Ps = SC_DPP(P, ctrl_, 1.0f), Hs = SC_DPP(Hh, ctrl_, 0.0f); Hh = P * Hs + Hh; P = P * Ps; }
            SC_STEP(0x111) SC_STEP(0x112) SC_STEP(0x114) SC_STEP(0x118)
            const float Pex = SC_DPP(P, 0x111, 1.0f), Hex = SC_DPP(Hh, 0x111, 0.0f);
#undef SC_STEP
#undef SC_DPP
            const float hin0 = Pex * hcar + Hex, hin1 = A0.x * hin0 + A0.y;
            CIN[g0 * 32 + ch] = hin0; CIN[g1 * 32 + ch] = hin1;
            hcar = __shfl(P * hcar + Hh, (lane & 48) | 15);
        }
        SC_BAR_LGKM();
        if (chas) tr2_finish(cd, lane, crg, cscr);
        const bool odd = fr & 1;
        unsigned* hop = (unsigned*)(HO + (size_t)(segbase + t0 + 16 * w + 4 * fq + (odd ? 2 : 0)) * D + och + (fr & ~1));
#pragma unroll
        for (int h = 0; h < 2; ++h) {
            float hh = CIN[g * 32 + h * 16 + fr];
            float outv[4];
#pragma unroll
            for (int s = 0; s < 4; ++s) { const int reg = DD ? (3 - s) : s; hh = av[h][reg] * hh + bv[h][reg]; outv[reg] = hh; }
            const unsigned w01 = (unsigned)f2bf(outv[0]) | ((unsigned)f2bf(outv[1]) << 16), w23 = (unsigned)f2bf(outv[2]) | ((unsigned)f2bf(outv[3]) << 16);
            const unsigned own = odd ? w23 : w01, send = odd ? w01 : w23;
            const unsigned recv = (unsigned)__builtin_amdgcn_update_dpp(0, (int)send, 0xB1, 0xf, 0xf, false);
            const unsigned lo = odd ? recv : own, hi = odd ? own : recv;
            hop[h * 8] = (lo & 0xffffu) | (hi << 16);
            hop[D / 2 + h * 8] = (lo >> 16) | (hi & 0xffff0000u);
        }
        cprev = chas;
    }
    };
    if (d) steps(IntC<1>{}); else steps(IntC<0>{});
#undef SC_BAR_LGKM
}

__device__ __forceinline__ void phase_combine_h(Frame& F) {
    const u32x4* hf = (const u32x4*)(F.ws + WS_HF); const u32x4* hb = (const u32x4*)(F.ws + WS_HB); const u32x4* yg = (const u32x4*)(F.ws + WS_YG);
    u32x4* hc = (u32x4*)(F.ws + WS_U);
    constexpr int NCH = NTOK * (D / 8);
    const int stride = F.G * NTHREADS;
    for (int i = F.vcu * NTHREADS + F.tid; i < NCH; i += 4 * stride) {
        u32x4 a[4], b[4], y[4];
#pragma unroll
        for (int j = 0; j < 4; ++j) { const int idx = i + j * stride; if (idx < NCH) { a[j] = __builtin_nontemporal_load(hf + idx); b[j] = __builtin_nontemporal_load(hb + idx); y[j] = __builtin_nontemporal_load(yg + idx); } }
#pragma unroll
        for (int j = 0; j < 4; ++j) {
            const int idx = i + j * stride;
            if (idx < NCH) {
                u32x4 r;
#pragma unroll
                for (int q = 0; q < 4; ++q) r[q] = pk2((bflo(a[j][q]) + bflo(b[j][q])) * bflo(y[j][q]), (bfhi(a[j][q]) + bfhi(b[j][q])) * bfhi(y[j][q]));
                hc[idx] = r;
            }
        }
    }
}
__device__ __forceinline__ void phase_gemm_out0(Frame& F) {
    const Args& A = *F.a;
    const bf16* W = (const bf16*)(F.ws + WS_WOUT);
    const bf16* HC = (const bf16*)(F.ws + WS_U);
    bf16* XA = (bf16*)(F.ws + WS_XA);
    {
        pg8::Gemm g{(const pg8::bf16_t*)HC, (const pg8::bf16_t*)W, NX, D, D};
        pg8::StaticOrder S; S.init(NX, D, F.G, (int)blockIdx.x);
        pg8::EpiRes E{(pg8::bf16_t*)XA, A.in[I_X], modp(F, 0, 0, 2), 6144};
        pg8::gemm_phase<pg8::EpiRes, pg8::StaticOrder, true, true>((PG8_LAS unsigned char*)F.lds, g, S, E);
    }
    constexpr int NCU = (NC / 128) * 8;
    if (F.vcu < NCU) {
        const int wr = F.wave >> 2, wc = F.wave & 3, fr = F.lane & 15, fq = F.lane >> 4;
        const int mt = F.vcu >> 3, nt = F.vcu & 7, m0 = NX + mt * 128, n0 = nt * 128;
        ALDense al; Ring R;
        al.init(HC, D, m0, F.tid >> 3, (F.tid >> 3) + 64, dma_kc(F.tid));
        const bf16* Bp = W + (size_t)n0 * D;
        ringn_start(F, R, al, Bp, D);
        f32x4 acc[4][2];
        gemm3n_unit<16>(F, R, al, Bp, al, Bp, false, D, acc, true);
        const float* gate = modp(F, 0, 4, 2);
        const float* srcb = A.in[I_CTX] + (size_t)(m0 - NX) * D;
        f32x4 gt[2];
#pragma unroll
        for (int ni = 0; ni < 2; ++ni) gt[ni] = *(const f32x4*)(gate + n0 + wc * 32 + ni * 16 + fq * 4);
#pragma unroll
        for (int mi = 0; mi < 4; ++mi)
#pragma unroll
            for (int ni = 0; ni < 2; ++ni) {
                const size_t o = (size_t)(wr * 64 + mi * 16 + fr) * D + n0 + wc * 32 + ni * 16 + fq * 4;
                const f32x4 v = __builtin_nontemporal_load((const f32x4*)(srcb + o)) + gt[ni] * acc[mi][ni];
                u32x2 ov; ov.x = pk2(v.x, v.y); ov.y = pk2(v.z, v.w);
                *(u32x2*)(XA + (size_t)m0 * D + o) = ov;
            }
    }
    __syncthreads();
    if (ND_B > ND_A) tail_convert(F, F.vcu * NWAVES + F.wave, ND_A, ND_B, F.G * NWAVES);
}

#define split2(a_, b_, hi_, lo_) do { const unsigned h__ = pk2((a_), (b_)); (hi_) = h__; (lo_) = pk2((a_) - bflo(h__), (b_) - bfhi(h__)); } while (0)
__device__ __forceinline__ void route_select(const Frame& F, float logit, float rbias, int row, bool valid, LAS int* selL, int li) {
    const int lane = F.lane, e = lane & 31, hb = lane & 32;
    const float sc = 1.0f / (1.0f + expf(-logit));
    const float ss = sc + rbias;
    float m1 = ss;
#pragma unroll
    for (int o = 1; o < 8; o <<= 1) m1 = fmaxf(m1, __shfl_xor(m1, o));
    int i1 = (ss == m1) ? e : 64;
#pragma unroll
    for (int o = 1; o < 8; o <<= 1) i1 = min(i1, __shfl_xor(i1, o));
    const float s2 = (e == i1) ? -INFINITY : ss;
    float m2 = s2;
#pragma unroll
    for (int o = 1; o < 8; o <<= 1) m2 = fmaxf(m2, __shfl_xor(m2, o));
    int i2 = (s2 == m2 && e != i1) ? e : 64;
#pragma unroll
    for (int o = 1; o < 8; o <<= 1) i2 = min(i2, __shfl_xor(i2, o));
    const float gs = m1 + m2;
    float gbest = gs;
    gbest = fmaxf(gbest, __shfl_xor(gbest, 8)); gbest = fmaxf(gbest, __shfl_xor(gbest, 16));
    int gsel = (gs == gbest) ? (e >> 3) : 64;
    gsel = min(gsel, __shfl_xor(gsel, 8)); gsel = min(gsel, __shfl_xor(gsel, 16));
    const int e0 = __shfl(i1, hb + gsel * 8) & 31, e1 = __shfl(i2, hb + gsel * 8) & 31;
    const float w0 = __shfl(sc, hb + e0), w1 = __shfl(sc, hb + e1);
    if (e == 0 && valid) {
        const float inv = 1.0f / (w0 + w1);
        LAS int* cntL = selL + 4 * 68; LAS int* rankL = selL + 2 * 68;
        selL[li * 2] = e0; selL[li * 2 + 1] = e1;
        rankL[li * 2] = __hip_atomic_fetch_add(cntL + e0, 1, __ATOMIC_RELAXED, __HIP_MEMORY_SCOPE_WORKGROUP);
        rankL[li * 2 + 1] = __hip_atomic_fetch_add(cntL + e1, 1, __ATOMIC_RELAXED, __HIP_MEMORY_SCOPE_WORKGROUP);
        LAS float* wL = (LAS float*)(selL + 6 * 68);
        wL[li * 2] = w0 * inv; wL[li * 2 + 1] = w1 * inv;
        ((int2*)(F.ws + WS_SEL))[row] = make_int2(e0, e1);
    }
}

template <int LAYER>
__device__ __forceinline__ void phase_route(Frame& F) {
    const Args& A = *F.a;
    constexpr int NT = LAYER == 0 ? NTOK : NX;
    constexpr int PER = NT / 256;
    constexpr int NPAIR = PER / 2, NIT = (NPAIR + NWAVES - 1) / NWAVES;
    LAS char* AH = F.lds;
    LAS char* AL = F.lds + 32768;
    LAS float* PART = (LAS float*)(F.lds + 65536);
    LAS int* selL = (LAS int*)(F.lds + LDS_AUX);
    LAS int* rankL = selL + 2 * 68;
    const int tid = F.tid, lane = F.lane, w = F.wave, fr = lane & 15, fq = lane >> 4;
    if (tid < 32) (selL + 4 * 68)[tid] = 0;
    const int blk = F.vcu;
    XRow na, nb;
    xa_load(F.ws, blk * PER + 2 * w, lane, na); xa_load(F.ws, blk * PER + 2 * w + 1, lane, nb);
    u32x2 dna[4], dnb[4];
    if constexpr (LAYER == 1) {
        const bf16* dl = (const bf16*)(F.ws + WS_DELTA) + (size_t)(blk * PER + 2 * w) * D;
#pragma unroll
        for (int j = 0; j < 4; ++j) { dna[j] = *(const u32x2*)(dl + 4 * lane + 256 * j); dnb[j] = *(const u32x2*)(dl + D + 4 * lane + 256 * j); }
    }
    bf16x8 Bh[4][2], Bl[4][2];
    {
        const float* rw = A.in[I_RW] + (size_t)(128 * w + 8 * fq) * 32 + fr;
#pragma unroll
        for (int ks = 0; ks < 4; ++ks)
#pragma unroll
            for (int nb = 0; nb < 2; ++nb) {
                float x[8];
#pragma unroll
                for (int i = 0; i < 8; ++i) x[i] = rw[(size_t)(32 * ks + i) * 32 + nb * 16];
                u32x4 h, l;
                split2(x[0], x[1], h.x, l.x); split2(x[2], x[3], h.y, l.y); split2(x[4], x[5], h.z, l.z); split2(x[6], x[7], h.w, l.w);
                Bh[ks][nb] = __builtin_bit_cast(bf16x8, h); Bl[ks][nb] = __builtin_bit_cast(bf16x8, l);
            }
    }
    __syncthreads();
    if (blk < 256) {
        bf16* H = (bf16*)(F.ws + WS_H);
        const float rbias = A.in[I_RB][lane & 31];
        f32x4 gm[4], shv[4]; int ccur = -1;
#pragma unroll 1
        for (int it = 0; it < NIT; ++it) {
            const int pi = it * NWAVES + w; const bool valid = pi < NPAIR;
            const int li = 2 * pi, row = blk * PER + li;
            if (valid) {
                const int c = cond_of(row);
                if (c != ccur) {
                    ccur = c;
#pragma unroll
                    for (int j = 0; j < 4; ++j) {
                        const int c0 = 4 * lane + 256 * j;
                        gm[j] = *(const f32x4*)(A.in[I_N2G] + LAYER * D + c0) * (1.0f + *(const f32x4*)(modp(F, LAYER, c, 4) + c0)); shv[j] = *(const f32x4*)(modp(F, LAYER, c, 3) + c0);
                    }
                }
                f32x4 va[4], vb[4];
                xa_expand(na, va); xa_expand(nb, vb);
                if constexpr (LAYER == 1) {
#pragma unroll
                    for (int j = 0; j < 4; ++j) {
                        va[j] += (f32x4){bflo(dna[j].x), bfhi(dna[j].x), bflo(dna[j].y), bfhi(dna[j].y)}; vb[j] += (f32x4){bflo(dnb[j].x), bfhi(dnb[j].x), bflo(dnb[j].y), bfhi(dnb[j].y)};
                    }
                }
                if (pi + NWAVES < NPAIR) {
                    xa_load(F.ws, row + 2 * NWAVES, lane, na); xa_load(F.ws, row + 2 * NWAVES + 1, lane, nb);
                    if constexpr (LAYER == 1) {
                        const bf16* dl = (const bf16*)(F.ws + WS_DELTA) + (size_t)(row + 2 * NWAVES) * D;
#pragma unroll
                        for (int j = 0; j < 4; ++j) { dna[j] = *(const u32x2*)(dl + 4 * lane + 256 * j); dnb[j] = *(const u32x2*)(dl + D + 4 * lane + 256 * j); }
                    }
                }
                const float ra = row_rstd(va), rb = row_rstd(vb);
#pragma unroll
                for (int j = 0; j < 4; ++j) {
                    const int c0 = 4 * lane + 256 * j;
                    va[j] = (va[j] * ra) * gm[j] + shv[j]; vb[j] = (vb[j] * rb) * gm[j] + shv[j];
                    if constexpr ((LAYER == 1 && L1_FP8) || (LAYER == 0 && L0_FP8)) {
                        *(unsigned*)((unsigned char*)H + (size_t)row * D + c0) = pk4_fp8(va[j].x, va[j].y, va[j].z, va[j].w);
                        *(unsigned*)((unsigned char*)H + (size_t)(row + 1) * D + c0) = pk4_fp8(vb[j].x, vb[j].y, vb[j].z, vb[j].w);
                    } else {
                        u32x2 oa, ob; oa.x = pk2(va[j].x, va[j].y); oa.y = pk2(va[j].z, va[j].w); ob.x = pk2(vb[j].x, vb[j].y); ob.y = pk2(vb[j].z, vb[j].w);
                        *(u32x2*)(H + (size_t)row * D + c0) = oa; *(u32x2*)(H + (size_t)(row + 1) * D + c0) = ob;
                    }
                }
#pragma unroll
                for (int j = 0; j < 4; ++j) {
                    u32x2 ha, la, hb2, lb;
                    split2(va[j].x, va[j].y, ha.x, la.x); split2(va[j].z, va[j].w, ha.y, la.y);
                    split2(vb[j].x, vb[j].y, hb2.x, lb.x); split2(vb[j].z, vb[j].w, hb2.y, lb.y);
                    const int ch = (lane >> 1) + 32 * j, r0 = 2 * w, r1 = 2 * w + 1;
                    const int o0 = r0 * 2048 + ((ch ^ r0) << 4) + (lane & 1) * 8, o1 = r1 * 2048 + ((ch ^ r1) << 4) + (lane & 1) * 8;
                    *(LAS u32x2*)(AH + o0) = ha; *(LAS u32x2*)(AL + o0) = la; *(LAS u32x2*)(AH + o1) = hb2; *(LAS u32x2*)(AL + o1) = lb;
                }
            }
            __syncthreads();
            f32x4 acc[2];
            acc[0] = (f32x4){0.f, 0.f, 0.f, 0.f}; acc[1] = (f32x4){0.f, 0.f, 0.f, 0.f};
#pragma unroll
            for (int ks = 0; ks < 4; ++ks) {
                const int ch = 4 * (4 * w + ks) + fq, off = fr * 2048 + ((ch ^ fr) << 4);
                const bf16x8 ah = *(const LAS bf16x8*)(AH + off), al = *(const LAS bf16x8*)(AL + off);
#pragma unroll
                for (int q = 0; q < 2; ++q) {
                    acc[q] = __builtin_amdgcn_mfma_f32_16x16x32_bf16(ah, Bh[ks][q], acc[q], 0, 0, 0);
                    acc[q] = __builtin_amdgcn_mfma_f32_16x16x32_bf16(ah, Bl[ks][q], acc[q], 0, 0, 0);
                    acc[q] = __builtin_amdgcn_mfma_f32_16x16x32_bf16(al, Bh[ks][q], acc[q], 0, 0, 0);
                }
            }
#pragma unroll
            for (int q = 0; q < 2; ++q)
#pragma unroll
                for (int c = 0; c < 4; ++c) PART[(w * 16 + 4 * fq + c) * 32 + q * 16 + fr] = acc[q][c];
            __syncthreads();
            {
                const int hr = lane >> 5, e = lane & 31;
                float logit = 0.f;
#pragma unroll
                for (int w2 = 0; w2 < 8; ++w2) logit += PART[(w2 * 16 + 2 * w + hr) * 32 + e];
                route_select(F, logit, rbias, row + hr, valid, selL, li + hr);
            }
        }
        __syncthreads();
        LAS int* cntL = selL + 4 * 68; LAS int* baseL = selL + 5 * 68; LAS float* wL = (LAS float*)(selL + 6 * 68);
        if (tid < 32) baseL[tid] = __hip_atomic_fetch_add((int*)(F.ws + WS_GCNT) + LAYER * 32 + tid, cntL[tid], __ATOMIC_RELAXED, __HIP_MEMORY_SCOPE_AGENT);
        __syncthreads();
        for (int i = tid; i < PER; i += NTHREADS) {
            const int t = blk * PER + i, e0 = selL[2 * i], e1 = selL[2 * i + 1];
            const int p0 = baseL[e0] + rankL[2 * i], p1 = baseL[e1] + rankL[2 * i + 1];
            ((int2*)(F.ws + WS_POS))[t] = make_int2(p0, p1);
            ((int*)(F.ws + WS_TOKOF))[(size_t)e0 * NTOK + p0] = t; ((float*)(F.ws + WS_WOF))[(size_t)e0 * NTOK + p0] = wL[2 * i];
            ((int*)(F.ws + WS_TOKOF))[(size_t)e1 * NTOK + p1] = t; ((float*)(F.ws + WS_WOF))[(size_t)e1 * NTOK + p1] = wL[2 * i + 1];
        }
    }
}

__device__ __forceinline__ void load_pst(Frame& F, int layer, LAS int* pst) {
    if (F.tid < 64) {
        const int e = F.tid & 31;
        const int c = ((const int*)(F.ws + WS_GCNT))[layer * 32 + e];
        const int pad = (c + 255) & ~255;
        int inc = pad;
#pragma unroll
        for (int o = 1; o < 32; o <<= 1) { const int up = __shfl_up(inc, o); if (e >= o) inc += up; }
        if (F.tid < 32) { pst[e] = inc - pad; pst[40 + e] = c; if (e == 31) pst[32] = inc; }
    }
    __syncthreads();
}
template <int LAYER>
__device__ __forceinline__ void phase_moe_up(Frame& F) {
    static_assert(L0_FP8 && L1_FP8, "the up projection runs in fp8 on both layers");
    LAS int* pst = (LAS int*)(F.lds + LDS_AUX);
    load_pst(F, LAYER, pst);
    const int nunits = (pst[32] >> 8) * 4;
    const int nfull = nunits < 2 * F.G ? nunits : 2 * F.G, hbase = 2 * F.G, hcount = nunits > hbase ? 2 * (nunits - hbase) : 0;
    const int* tok_of = (const int*)(F.ws + WS_TOKOF); const float* w_of = (const float*)(F.ws + WS_WOF);
    LAS int* tokL = pst + 80;
    LAS float* wgtL = (LAS float*)(tokL + 3 * 256);
    LAS int* tokH = (LAS int*)(wgtL + 3 * 256);
    LAS float* wgtH = (LAS float*)(tokH + 2 * 256);
    for (int i = F.tid; i < 4 * 256; i += NTHREADS) {
        const int k = i >> 8, hf = k >> 1, ord = k & 1;
        int Lf = -1;
        if (!hf) { const int uu = F.vcu + ord * F.G; if (uu < nfull) Lf = uu; }
        else { const int hL = F.vcu + ord * F.G; if (hL < hcount) Lf = hbase + (hL >> 1); }
        int tk = 0; float wg = 0.f;
        if (Lf >= 0) {
            const int m0 = (Lf >> 2) * 256; int e = 0;
            for (int x = 1; x < 32; ++x) e = (pst[x] <= m0) ? x : e;
            const int pos = m0 + (i & 255) - pst[e];
            if (pos < pst[40 + e]) { tk = tok_of[(size_t)e * NTOK + pos]; wg = 8.0f * w_of[(size_t)e * NTOK + pos]; }
        }
        if (!hf) { tokL[ord * 256 + (i & 255)] = tk; wgtL[ord * 256 + (i & 255)] = wg; } else { tokH[ord * 256 + (i & 255)] = tk; wgtH[ord * 256 + (i & 255)] = wg; }
    }
    __syncthreads();
    pg8::Gemm g{(const pg8::bf16_t*)(F.ws + WS_H), (const pg8::bf16_t*)(F.ws + WS_WUP + (size_t)LAYER * 64 * MiB), PMAX, 32 * 1024, D / 2};
    {
        pg8::MoeOrder S{F.G, F.vcu, nfull, (const PG8_LAS int*)pst};
        pg8::EpiUp E{F.ws + WS_G, (const PG8_LAS float*)wgtL, F.vcu, F.G};
        pg8::gemm_phase<pg8::EpiUp, pg8::MoeOrder, true, true, true, true>((PG8_LAS unsigned char*)F.lds, g, S, E, FP8_SCALE_W, FP8_SCALE_ONE, (const PG8_LAS int*)tokL);
    }
    if (hcount > 0) {
        pg8::MoeHalfOrder S{F.G, F.vcu, hcount, hbase, (const PG8_LAS int*)pst};
        pg8::EpiUpH E{F.ws + WS_G, (const PG8_LAS float*)wgtH, F.vcu, F.G, hbase};
        pg8::gemm_phase<pg8::EpiUpH, pg8::MoeHalfOrder, true, true, true, true, true>((PG8_LAS unsigned char*)F.lds, g, S, E, FP8_SCALE_W, FP8_SCALE_ONE, (const PG8_LAS int*)tokH);
    }
}

template <int LAYER>
__device__ __forceinline__ void phase_moe_down(Frame& F) {
    constexpr bool F8 = (LAYER == 1 && L1_FP8) || (LAYER == 0 && L0_FP8);
    constexpr int KA = F8 ? DEXP / 2 : DEXP;
    LAS int* pst = (LAS int*)(F.lds + LDS_AUX);
    load_pst(F, LAYER, pst);
    const int ntiles = pst[32] >> 7, nunits = ntiles * 4;
    const bf16* G = (const bf16*)(F.ws + WS_G);
    const bf16* W = F8 ? (const bf16*)(F.ws + WS_WDN + (size_t)LAYER * 32 * MiB) : (const bf16*)(F.ws + WS_WDN) + (size_t)LAYER * 32 * 1024 * 512;
    bf16* Y = (bf16*)(F.ws + WS_Y);
    {
        pg8::Gemm g{(const pg8::bf16_t*)G, (const pg8::bf16_t*)W, PMAX, 32 * 1024, KA};
        pg8::MoeOrder S{F.G, F.vcu, (pst[32] >> 8) * 4, (const PG8_LAS int*)pst};
        pg8::EpiY E{(pg8::bf16_t*)Y};
        pg8::gemm_phase<pg8::EpiY, pg8::MoeOrder, true, true, F8>((PG8_LAS unsigned char*)F.lds, g, S, E, FP8_SCALE_W, FP8_SCALE_G);
        return;
    }
    const int wr = F.wave >> 2, wc = F.wave & 3, fr = F.lane & 15, fq = F.lane >> 4;
    ALDense al, alN; const bf16* Bp = W; const bf16* BpN = W; Ring R;
#define MOED_SETUP(uu, al_, Bp_) do { const int m0_ = ((uu) >> 2) * 128; int e_ = 0; \
        for (int x = 1; x < 32; ++x) e_ = (pst[x] <= m0_) ? x : e_; \
        al_.init(G, KA, m0_, F.tid >> 3, (F.tid >> 3) + 64, dma_kc(F.tid)); Bp_ = W + ((size_t)e_ * 1024 + ((uu) & 3) * 256) * KA; } while (0)
    if (F.vcu < nunits) { MOED_SETUP(F.vcu, al, Bp); ring_start(F, R, al, Bp, KA); }
    for (int u = F.vcu; u < nunits; u += F.G) {
        const int mt = u >> 2, j = u & 3, m0 = mt * 128, n0 = j * 256;
        const int un = u + F.G; const bool hasN = un < nunits;
        alN = al; BpN = Bp;
        if (hasN) MOED_SETUP(un, alN, BpN);
        f32x4 acc[4][4];
        if constexpr (F8) gemm3_unit<true, 16>(F, R, al, Bp, alN, BpN, hasN, KA, acc, u == F.vcu, FP8_SCALE_W, FP8_SCALE_G);
        else gemm3_unit<false, 16>(F, R, al, Bp, alN, BpN, hasN, KA, acc, u == F.vcu);
        al = alN; Bp = BpN;
#pragma unroll
        for (int mi = 0; mi < 4; ++mi) {
            const int row = m0 + wr * 64 + mi * 16 + fr;
#pragma unroll
            for (int ni = 0; ni < 4; ++ni) {
                const f32x4 v = acc[mi][ni];
                u32x2 o; o.x = pk2(v.x, v.y); o.y = pk2(v.z, v.w);
                *(u32x2*)(Y + (size_t)row * D + n0 + wc * 64 + ni * 16 + fq * 4) = o;
            }
        }
    }
}

struct CRow { XRow x; u32x2 y0[4], y1[4]; };
__device__ __forceinline__ void crow_load(const Frame& F, int row, int2 ts, CRow& r) {
    const bf16* Y = (const bf16*)(F.ws + WS_Y);
    { const bf16* src = (const bf16*)(F.ws + WS_XA) + (size_t)row * D;
#pragma unroll
      for (int j = 0; j < 4; ++j) r.x.p[j] = __builtin_nontemporal_load((const u32x2*)(src + 4 * F.lane + 256 * j)); }
#pragma unroll
    for (int j = 0; j < 4; ++j) {
        const int c0 = 4 * F.lane + 256 * j;
        if (Y_FP8) { r.y0[j].x = __builtin_nontemporal_load((const unsigned*)((const unsigned char*)Y + (size_t)ts.x * D + c0)); r.y1[j].x = __builtin_nontemporal_load((const unsigned*)((const unsigned char*)Y + (size_t)ts.y * D + c0)); }
        else { r.y0[j] = *(const u32x2*)(Y + (size_t)ts.x * D + c0); r.y1[j] = *(const u32x2*)(Y + (size_t)ts.y * D + c0); }
    }
}
__device__ __forceinline__ void crow_combine(const Frame& F, const CRow& r, const float* gate, f32x4 (&v)[4]) {
#pragma unroll
    for (int j = 0; j < 4; ++j) {
        const int c0 = 4 * F.lane + 256 * j;
        const f32x4 gt = *(const f32x4*)(gate + c0);
        f32x4 y;
        if (Y_FP8) {
            const f32x2 a0 = __builtin_amdgcn_cvt_pk_f32_fp8((int)r.y0[j].x, false), a1 = __builtin_amdgcn_cvt_pk_f32_fp8((int)r.y0[j].x, true);
            const f32x2 b0 = __builtin_amdgcn_cvt_pk_f32_fp8((int)r.y1[j].x, false), b1 = __builtin_amdgcn_cvt_pk_f32_fp8((int)r.y1[j].x, true);
            y.x = (a0.x + b0.x) * 0.0625f; y.y = (a0.y + b0.y) * 0.0625f; y.z = (a1.x + b1.x) * 0.0625f; y.w = (a1.y + b1.y) * 0.0625f;
        } else { y.x = bflo(r.y0[j].x) + bflo(r.y1[j].x); y.y = bfhi(r.y0[j].x) + bfhi(r.y1[j].x); y.z = bflo(r.y0[j].y) + bflo(r.y1[j].y); y.w = bfhi(r.y0[j].y) + bfhi(r.y1[j].y); }
        v[j] = (f32x4){bflo(r.x.p[j].x), bfhi(r.x.p[j].x), bflo(r.x.p[j].y), bfhi(r.x.p[j].y)} + gt * y;
    }
}

__device__ __forceinline__ void phase_combine0(Frame& F) {
    const Args& A = *F.a;
    const int gw = F.vcu * NWAVES + F.wave, NGW = F.G * NWAVES, lane = F.lane;
    bf16* H = (bf16*)(F.ws + WS_H);
    LAS int* pst = (LAS int*)(F.lds + LDS_AUX);
    load_pst(F, 0, pst);
    auto TS = [&](int t) -> int2 { const int2 se = ((const int2*)(F.ws + WS_SEL))[t], po = ((const int2*)(F.ws + WS_POS))[t]; return make_int2(pst[se.x] + po.x, pst[se.y] + po.y); };
    const int r_lo = (int)((long)gw * NTOK / NGW), r_hi = (int)((long)(gw + 1) * NTOK / NGW);
    f32x4 gg[4], g2[4], gm[4], sh[4]; int ccur = -1;
#pragma unroll
    for (int j = 0; j < 4; ++j) gg[j] = *(const f32x4*)(A.in[I_N1G] + D + 4 * lane + 256 * j);
    auto finish = [&](int r, const CRow& cr) {
        const int c = cond_of(r);
        if (c != ccur) {
            ccur = c;
#pragma unroll
            for (int j = 0; j < 4; ++j) { const int c0 = 4 * lane + 256 * j; g2[j] = *(const f32x4*)(modp(F, 0, c, 5) + c0); gm[j] = gg[j] * (1.0f + *(const f32x4*)(modp(F, 1, c, 1) + c0)); sh[j] = *(const f32x4*)(modp(F, 1, c, 0) + c0); }
        }
        f32x4 v[4];
#pragma unroll
        for (int j = 0; j < 4; ++j) {
            f32x4 y;
            if (Y_FP8) {
                const f32x2 a0 = __builtin_amdgcn_cvt_pk_f32_fp8((int)cr.y0[j].x, false), a1 = __builtin_amdgcn_cvt_pk_f32_fp8((int)cr.y0[j].x, true);
                const f32x2 b0 = __builtin_amdgcn_cvt_pk_f32_fp8((int)cr.y1[j].x, false), b1 = __builtin_amdgcn_cvt_pk_f32_fp8((int)cr.y1[j].x, true);
                y.x = (a0.x + b0.x) * 0.0625f; y.y = (a0.y + b0.y) * 0.0625f; y.z = (a1.x + b1.x) * 0.0625f; y.w = (a1.y + b1.y) * 0.0625f;
            } else { y.x = bflo(cr.y0[j].x) + bflo(cr.y1[j].x); y.y = bfhi(cr.y0[j].x) + bfhi(cr.y1[j].x); y.z = bflo(cr.y0[j].y) + bflo(cr.y1[j].y); y.w = bfhi(cr.y0[j].y) + bfhi(cr.y1[j].y); }
            v[j] = (f32x4){bflo(cr.x.p[j].x), bfhi(cr.x.p[j].x), bflo(cr.x.p[j].y), bfhi(cr.x.p[j].y)} + g2[j] * y;
        }
        xa_store(F.ws, r, lane, v);
        const float rstd = row_rstd(v);
#pragma unroll
        for (int j = 0; j < 4; ++j) {
            const f32x4 h = (v[j] * rstd) * gm[j] + sh[j];
            u32x2 o; o.x = pk2(h.x, h.y); o.y = pk2(h.z, h.w);
            *(u32x2*)(H + (size_t)r * D + 4 * lane + 256 * j) = o;
        }
    };
    CRow ca, cb; int2 tsa = make_int2(0, 0), tsb = make_int2(0, 0);
    if (r_lo < r_hi) crow_load(F, r_lo, TS(r_lo), ca);
    if (r_lo + 1 < r_hi) crow_load(F, r_lo + 1, TS(r_lo + 1), cb);
    if (r_lo + 2 < r_hi) tsa = TS(r_lo + 2);
    if (r_lo + 3 < r_hi) tsb = TS(r_lo + 3);
#pragma unroll 1
    for (int r = r_lo; r < r_hi; r += 2) {
        { const CRow cr = ca;
          if (r + 2 < r_hi) crow_load(F, r + 2, tsa, ca);
          if (r + 4 < r_hi) tsa = TS(r + 4);
          finish(r, cr); }
        if (r + 1 < r_hi) {
            const CRow cr = cb;
            if (r + 3 < r_hi) crow_load(F, r + 3, tsb, cb);
            if (r + 5 < r_hi) tsb = TS(r + 5);
            finish(r + 1, cr);
        }
    }
}

__device__ __forceinline__ void phase_qkv(Frame& F) {
    LAS float* CS = (LAS float*)(F.lds + LDS_AUX);
    for (int i = F.tid; i < 1024; i += NTHREADS) {
        const int p = i >> 4, f = i & 15;
        const float inv = 1.0f / powf(10000.0f, (float)f / 16.0f);
        const float ang = (float)p * inv;
        const double rev = (double)ang * 0.15915494309189535;
        const float fr_ = (float)(rev - floor(rev));
        CS[i * 2] = __builtin_amdgcn_cosf(fr_); CS[i * 2 + 1] = __builtin_amdgcn_sinf(fr_);
    }
    __syncthreads();
    pg8::Gemm g{(const pg8::bf16_t*)(F.ws + WS_H), (const pg8::bf16_t*)(F.ws + WS_WQKV), NX, 3 * D, D};
    pg8::QkvOrder S; S.init(F.G, (int)blockIdx.x);
    pg8::EpiQKV E{(pg8::bf16_t*)(F.ws + WS_Q), (pg8::bf16_t*)(F.ws + WS_K), (pg8::bf16_t*)(F.ws + WS_VT), (const PG8_LAS float*)CS};
    pg8::gemm_phase<pg8::EpiQKV, pg8::QkvOrder, true, true>((PG8_LAS unsigned char*)F.lds, g, S, E);
    {
        const bf16* H = (const bf16*)(F.ws + WS_H); const bf16* W = (const bf16*)(F.ws + WS_WQKV);
        bf16* Kb = (bf16*)(F.ws + WS_K); bf16* VT = (bf16*)(F.ws + WS_VT);
        const int wr = F.wave >> 2, wc = F.wave & 3, fr = F.lane & 15, fq = F.lane >> 4;
        constexpr int NCU = (NC / 128) * 16;
        ALDense al, alN; const bf16* Bp = W; const bf16* BpN = W; Ring R;
#define QC_SETUP(vv, al_, Bp_) do { al_.init(H, D, NX + ((vv) >> 4) * 128, F.tid >> 3, (F.tid >> 3) + 64, dma_kc(F.tid)); Bp_ = W + (size_t)(1024 + ((vv) & 15) * 128) * D; } while (0)
        if (F.vcu < NCU) { QC_SETUP(F.vcu, al, Bp); ringn_start(F, R, al, Bp, D); }
        for (int v = F.vcu; v < NCU; v += F.G) {
            const int mt = v >> 4, nt = v & 15, m0 = NX + mt * 128;
            const int vn = v + F.G; const bool hasN = vn < NCU;
            alN = al; BpN = Bp;
            if (hasN) QC_SETUP(vn, alN, BpN);
            f32x4 acc[4][2];
            gemm3n_unit<16>(F, R, al, Bp, alN, BpN, hasN, D, acc, v == F.vcu);
            al = alN; Bp = BpN;
#pragma unroll
            for (int mi = 0; mi < 4; ++mi) {
                const int row = m0 + wr * 64 + mi * 16 + fr;
                const int b = (row - NX) >> 8, pos = ::S + ((row - NX) & 255);
                if (nt < 8) {
                    const int hi2 = nt * 2 + (wc >> 1);
                    bf16* dst = Kb + ((size_t)(b * 16 + hi2) * KEYS + pos) * 64 + (wc & 1) * 32;
#pragma unroll
                    for (int ni = 0; ni < 2; ++ni) { const f32x4 o = acc[mi][ni]; u32x2 ov; ov.x = pk2(o.x, o.y); ov.y = pk2(o.z, o.w); *(u32x2*)(dst + ni * 16 + fq * 4) = ov; }
                } else {
                    const int ppos = (pos & ~12) | ((pos & 4) << 1) | ((pos & 8) >> 1);
#pragma unroll
                    for (int ni = 0; ni < 2; ++ni) {
                        const int vd = wc * 32 + ni * 16 + fq * 4;
                        bf16* vp = VT + ((size_t)(b * 8 + (nt - 8)) * 128 + vd) * KEYS + ppos;
                        const f32x4 o = acc[mi][ni];
                        const unsigned p01 = pk2(o.x, o.y), p23 = pk2(o.z, o.w);
                        vp[0] = (bf16)(p01 & 0xffffu); vp[KEYS] = (bf16)(p01 >> 16); vp[2 * KEYS] = (bf16)(p23 & 0xffffu); vp[3 * KEYS] = (bf16)(p23 >> 16);
                    }
                }
            }
        }
#undef QC_SETUP
    }
}

constexpr int ATT_STAGE = 32768;
__device__ __forceinline__ int crow(int r, int hi) { return (r & 3) + 8 * (r >> 2) + 4 * hi; }
__device__ __forceinline__ float max3f_(float a, float b, float c) { float r; asm("v_max3_f32 %0, %1, %2, %3" : "=v"(r) : "v"(a), "v"(b), "v"(c)); return r; }
__device__ __forceinline__ float max2f_(float a, float b) { float r; asm("v_max_f32_e32 %0, %1, %2" : "=v"(r) : "v"(a), "v"(b)); return r; }
__device__ __forceinline__ void phase_attn(Frame& F) {
    const Args& A = *F.a;
    const int tid = F.tid, lane = F.lane, w = F.wave, r32 = lane & 31, hi = lane >> 5;
    const int mp = w >> 2, wq = w & 3;
    LAS char* lds = F.lds;
    const bf16* Q = (const bf16*)(F.ws + WS_Q); const bf16* Kb = (const bf16*)(F.ws + WS_K); const bf16* VT = (const bf16*)(F.ws + WS_VT);
    bf16* AO = (bf16*)(F.ws + WS_AO);
    constexpr int NUNITS = NB * 8 * (S / 128), NTILES = KEYS / 64;
    LAS char* cbuf = lds + 65536 + w * 4096;
    const int cgw = F.vcu * NWAVES + w, CNGW = F.G * NWAVES;
    int cit = cgw; bool chas = cit < ND_ATTN;
    if (chas) { const TDesc cd = L1_FP8 ? decode_moe8(F, cit) : decode_moe(F, cit, 1); tr3_dma(cd, lane, cbuf); }
    for (int u = F.vcu; u < NUNITS; u += F.G) {
        const int bh = u >> 5, qb = u & 31, q0 = qb * 128;
        const bf16* Kg[2]; Kg[0] = Kb + (size_t)(bh * 2 + 0) * KEYS * 64; Kg[1] = Kb + (size_t)(bh * 2 + 1) * KEYS * 64;
        const bf16* Vg = VT + (size_t)bh * 128 * KEYS;
        bf16x8 qf[4];
        { const bf16* qp = Q + ((size_t)(bh * 2 + mp) * S + q0 + wq * 32 + r32) * 64 + hi * 8;
#pragma unroll
          for (int ks = 0; ks < 4; ++ks) qf[ks] = __builtin_nontemporal_load((const bf16x8*)(qp + ks * 16)); }
        f32x16 o[4];
#pragma unroll
        for (int vb = 0; vb < 4; ++vb)
#pragma unroll
            for (int r = 0; r < 16; ++r) o[vb][r] = 0.f;
        float mrun = 0.f, lrun = 0.f;
        int tfirst = 1; asm volatile("" : "+s"(tfirst));
        const int drow = w * 8 + (lane >> 3), dch = ((lane & 7) ^ ((drow >> 1) & 7)) * 8;
        const bf16* gk0 = Kg[0] + (size_t)drow * 64 + dch; const bf16* gk1 = Kg[1] + (size_t)drow * 64 + dch;
        const bf16* gv0 = Vg + (size_t)drow * KEYS + dch; const bf16* gv1 = Vg + (size_t)(64 + drow) * KEYS + dch;
#define ATT_DMA(t_, st_) do { LAS char* sb_ = lds + (st_) * ATT_STAGE + w * 1024; \
            __builtin_amdgcn_global_load_lds((const unsigned*)(gk0 + (size_t)(t_) * 64 * 64), (LAS unsigned*)(sb_), 16, 0, 0); \
            __builtin_amdgcn_global_load_lds((const unsigned*)(gk1 + (size_t)(t_) * 64 * 64), (LAS unsigned*)(sb_ + 8192), 16, 0, 0); \
            __builtin_amdgcn_global_load_lds((const unsigned*)(gv0 + (t_) * 64), (LAS unsigned*)(sb_ + 16384), 16, 0, 0); \
            __builtin_amdgcn_global_load_lds((const unsigned*)(gv1 + (t_) * 64), (LAS unsigned*)(sb_ + 16384 + 8192), 16, 0, 0); } while (0)
        ATT_DMA(0, 0);
        __syncthreads();
        for (int t = 0; t < NTILES; ++t) {
            const int st = t & 1;
            if (t + 1 < NTILES) ATT_DMA(t + 1, st ^ 1);
#if ATT_SKEW_SLEEP > 0
            if (mp == 1) __builtin_amdgcn_s_sleep(ATT_SKEW_SLEEP);
#endif
            const LAS char* Kt = lds + st * ATT_STAGE + mp * 8192;
            const LAS char* Vt = lds + st * ATT_STAGE + 16384;
            f32x16 s0, s1;
            { const float nm = -mrun;
#pragma unroll
              for (int r = 0; r < 16; ++r) { s0[r] = nm; s1[r] = nm; } }
            bf16x8 kf[8];
#pragma unroll
            for (int ks = 0; ks < 4; ++ks) {
                kf[2 * ks] = *(const LAS bf16x8*)(Kt + swz128(r32, 2 * ks + hi));
                kf[2 * ks + 1] = *(const LAS bf16x8*)(Kt + swz128(32 + r32, 2 * ks + hi));
            }
            u32x4 vf[2][4];
#define VLOAD(dst, vb_) do { const int vrow_ = (vb_) * 32 + r32; _Pragma("unroll") for (int kk_ = 0; kk_ < 4; ++kk_) \
                dst[kk_] = *(const LAS u32x4*)(Vt + swz128(vrow_, 2 * kk_ + hi)); } while (0)
            VLOAD(vf[0], 0);
            __builtin_amdgcn_sched_barrier(0);

#pragma unroll
            for (int ks = 0; ks < 4; ++ks) s0 = __builtin_amdgcn_mfma_f32_32x32x16_bf16(kf[2 * ks], qf[ks], s0, 0, 0, 0);
            asm volatile("" : "+v"(s0), "+v"(kf[1]));
#pragma unroll
            for (int ks = 0; ks < 4; ++ks) s1 = __builtin_amdgcn_mfma_f32_32x32x16_bf16(kf[2 * ks + 1], qf[ks], s1, 0, 0, 0);
            __builtin_amdgcn_sched_barrier(0);

            asm volatile("" : "+v"(s0), "+v"(s1));
            float mx;
            { float a_, b_;
#define MAX3V(d_, x_, y_, z_) asm volatile("v_max3_f32 %0, %1, %2, %3" : "=v"(d_) : "v"(x_), "v"(y_), "v"(z_))
              MAX3V(a_, s0[0], s0[1], s0[2]); MAX3V(b_, s0[3], s0[4], s0[5]);
              MAX3V(a_, a_, s0[6], s0[7]); MAX3V(b_, b_, s0[8], s0[9]);
              MAX3V(a_, a_, s0[10], s0[11]); MAX3V(b_, b_, s0[12], s0[13]);
              MAX3V(a_, a_, s0[14], s0[15]);
              asm volatile("s_nop 7\n\ts_nop 3" : "+v"(s1));
              MAX3V(b_, b_, s1[0], s1[1]); MAX3V(a_, a_, s1[2], s1[3]);
              MAX3V(b_, b_, s1[4], s1[5]); MAX3V(a_, a_, s1[6], s1[7]);
              MAX3V(b_, b_, s1[8], s1[9]); MAX3V(a_, a_, s1[10], s1[11]);
              MAX3V(b_, b_, s1[12], s1[13]); MAX3V(a_, a_, s1[14], s1[15]);
#undef MAX3V
              mx = max2f_(a_, b_);
              const auto rr = __builtin_amdgcn_permlane32_swap(__builtin_bit_cast(unsigned, mx), __builtin_bit_cast(unsigned, mx), false, false);
              mx = max2f_(__builtin_bit_cast(float, rr[0]), __builtin_bit_cast(float, rr[1])); }
            if (t == 0 || __any(mx > 8.0f)) {
                const float dl = (t == 0) ? mx : fmaxf(mx, 0.f);
                mrun += dl;
#pragma unroll
                for (int r = 0; r < 16; ++r) { s0[r] -= dl; s1[r] -= dl; }
                if (t > 0) {
                    const float f = __builtin_amdgcn_exp2f(-dl);
                    lrun *= f;
#pragma unroll
                    for (int vb = 0; vb < 4; ++vb)
#pragma unroll
                        for (int r = 0; r < 16; ++r) o[vb][r] *= f;
                }
            }
            float psum = 0.f;
#pragma unroll
            for (int r = 0; r < 16; ++r) { s0[r] = __builtin_amdgcn_exp2f(s0[r]); s1[r] = __builtin_amdgcn_exp2f(s1[r]); psum += s0[r] + s1[r]; }
            lrun += psum;
            bf16x8 pf[4];
#pragma unroll
            for (int s = 0; s < 2; ++s) {
                u32x4 a, b2;
                a.x = pk2(s0[8 * s + 0], s0[8 * s + 1]); a.y = pk2(s0[8 * s + 2], s0[8 * s + 3]); a.z = pk2(s0[8 * s + 4], s0[8 * s + 5]); a.w = pk2(s0[8 * s + 6], s0[8 * s + 7]);
                b2.x = pk2(s1[8 * s + 0], s1[8 * s + 1]); b2.y = pk2(s1[8 * s + 2], s1[8 * s + 3]); b2.z = pk2(s1[8 * s + 4], s1[8 * s + 5]); b2.w = pk2(s1[8 * s + 6], s1[8 * s + 7]);
                pf[s] = __builtin_bit_cast(bf16x8, a); pf[2 + s] = __builtin_bit_cast(bf16x8, b2);
            }
#pragma unroll
            for (int vb = 0; vb < 4; ++vb) {
                if (vb + 1 < 4) VLOAD(vf[(vb + 1) & 1], vb + 1);
                __builtin_amdgcn_sched_barrier(0);

#pragma unroll
                for (int kk = 0; kk < 4; ++kk)
                    o[vb] = __builtin_amdgcn_mfma_f32_32x32x16_bf16(__builtin_bit_cast(bf16x8, vf[vb & 1][kk]), pf[kk], o[vb], 0, 0, 0);

            }
#undef VLOAD
            tfirst = 0;
            __syncthreads();
            if ((t % 11) == 5 && chas) {
                asm volatile("s_waitcnt vmcnt(0)" ::: "memory");
                { if (L1_FP8) { const TDesc cd = decode_moe8(F, cit); tr3_finish_fp8(cd, lane, cbuf); } else { const TDesc cd = decode_moe(F, cit, 1); tr3_finish(cd, lane, cbuf); } }
                LDS_WAIT();
                cit += CNGW; chas = cit < ND_ATTN;
                if (chas) { const TDesc cd = L1_FP8 ? decode_moe8(F, cit) : decode_moe(F, cit, 1); tr3_dma(cd, lane, cbuf); }
            }
        }
#undef ATT_DMA
        lrun += __shfl_xor(lrun, 32);
        const float linv = 1.0f / lrun;
        LAS float* XO = (LAS float*)lds;
        if (mp == 1) {
#pragma unroll
            for (int vb = 0; vb < 4; ++vb)
#pragma unroll
                for (int r = 0; r < 16; ++r) XO[(wq * 64 + vb * 16 + r) * 64 + lane] = o[vb][r] * linv;
        }
        __syncthreads();
        if (mp == 0) {
            float lam;
            { const float* dl = A.in[I_DALAM]; const float s1 = wave_sum(dl[lane] * dl[64 + lane]), s2 = wave_sum(dl[128 + lane] * dl[192 + lane]);
              lam = expf(s1) - expf(s2) + (0.8f - 0.6f * expf(-0.3f)); }
            const float oscale = 1.0f - (0.8f - 0.6f * expf(-0.3f));
            float ssq = 0.f;
#pragma unroll
            for (int vb = 0; vb < 4; ++vb)
#pragma unroll
                for (int r = 0; r < 16; ++r) { const float v = o[vb][r] * linv - lam * XO[(wq * 64 + vb * 16 + r) * 64 + lane]; o[vb][r] = v; ssq += v * v; }
            ssq += __shfl_xor(ssq, 32);
            const float rstd = rsqrtf(ssq * (1.0f / 128.0f) + EPS) * oscale;
            const int b = bh >> 3, h = bh & 7;
            bf16* dst = AO + (size_t)(b * S + q0 + wq * 32 + r32) * D + h * 128;
            const float* sg = A.in[I_SUBLN];
#pragma unroll
            for (int vb = 0; vb < 4; ++vb)
#pragma unroll
                for (int rq = 0; rq < 4; ++rq) {
                    const int v0 = vb * 32 + 8 * rq + 4 * hi;
                    const f32x4 g4 = *(const f32x4*)(sg + v0);
                    u32x2 ov; ov.x = pk2(o[vb][4 * rq] * rstd * g4.x, o[vb][4 * rq + 1] * rstd * g4.y); ov.y = pk2(o[vb][4 * rq + 2] * rstd * g4.z, o[vb][4 * rq + 3] * rstd * g4.w);
                    *(u32x2*)(dst + v0) = ov;
                }
        }
        __syncthreads();
    }
    while (chas) {
        asm volatile("s_waitcnt vmcnt(0)" ::: "memory");
        { if (L1_FP8) { const TDesc cd = decode_moe8(F, cit); tr3_finish_fp8(cd, lane, cbuf); } else { const TDesc cd = decode_moe(F, cit, 1); tr3_finish(cd, lane, cbuf); } }
        LDS_WAIT();
        cit += CNGW; chas = cit < ND_ATTN;
        if (chas) { const TDesc cd = L1_FP8 ? decode_moe8(F, cit) : decode_moe(F, cit, 1); tr3_dma(cd, lane, cbuf); }
    }
}

__device__ __forceinline__ void phase_gemm_wo(Frame& F) {
    pg8::Gemm g{(const pg8::bf16_t*)(F.ws + WS_AO), (const pg8::bf16_t*)(F.ws + WS_WO), NX, D, D};
    pg8::StaticOrder S; S.init(NX, D, F.G, (int)blockIdx.x);
    pg8::EpiScaleBf16 E{(pg8::bf16_t*)(F.ws + WS_DELTA), D, modp(F, 1, 0, 2), 6144};
    pg8::gemm_phase<pg8::EpiScaleBf16, pg8::StaticOrder, true, true>((PG8_LAS unsigned char*)F.lds, g, S, E);
}

__device__ __forceinline__ void phase_final(Frame& F) {
    const Args& A = *F.a;
    const int gw = F.vcu * NWAVES + F.wave, NGW = F.G * NWAVES, lane = F.lane;
    LAS int* pst = (LAS int*)(F.lds + LDS_AUX);
    load_pst(F, 1, pst);
    auto TS = [&](int t) -> int2 { const int2 se = ((const int2*)(F.ws + WS_SEL))[t], po = ((const int2*)(F.ws + WS_POS))[t]; return make_int2(pst[se.x] + po.x, pst[se.y] + po.y); };
    const int r_lo = (int)((long)gw * NX / NGW), r_hi = (int)((long)(gw + 1) * NX / NGW);
    f32x4 fg[4], g2[4]; int ccur = -1;
#pragma unroll
    for (int j = 0; j < 4; ++j) fg[j] = *(const f32x4*)(A.in[I_FG] + 4 * lane + 256 * j);
    const bf16* DL = (const bf16*)(F.ws + WS_DELTA);
    auto dload = [&](int r, u32x2 (&d)[4]) {
#pragma unroll
        for (int j = 0; j < 4; ++j) d[j] = __builtin_nontemporal_load((const u32x2*)(DL + (size_t)r * D + 4 * lane + 256 * j)); };
    auto finish = [&](int r, const CRow& cr, const u32x2 (&d)[4]) {
        const int c = r >> 12;
        if (c != ccur) {
            ccur = c;
#pragma unroll
            for (int j = 0; j < 4; ++j) g2[j] = *(const f32x4*)(modp(F, 1, c, 5) + 4 * lane + 256 * j);
        }
        f32x4 v[4];
#pragma unroll
        for (int j = 0; j < 4; ++j) {
            f32x4 y;
            if (Y_FP8) {
                const f32x2 a0 = __builtin_amdgcn_cvt_pk_f32_fp8((int)cr.y0[j].x, false), a1 = __builtin_amdgcn_cvt_pk_f32_fp8((int)cr.y0[j].x, true);
                const f32x2 b0 = __builtin_amdgcn_cvt_pk_f32_fp8((int)cr.y1[j].x, false), b1 = __builtin_amdgcn_cvt_pk_f32_fp8((int)cr.y1[j].x, true);
                y.x = (a0.x + b0.x) * 0.0625f; y.y = (a0.y + b0.y) * 0.0625f; y.z = (a1.x + b1.x) * 0.0625f; y.w = (a1.y + b1.y) * 0.0625f;
            } else { y.x = bflo(cr.y0[j].x) + bflo(cr.y1[j].x); y.y = bfhi(cr.y0[j].x) + bfhi(cr.y1[j].x); y.z = bflo(cr.y0[j].y) + bflo(cr.y1[j].y); y.w = bfhi(cr.y0[j].y) + bfhi(cr.y1[j].y); }
            v[j] = (f32x4){bflo(cr.x.p[j].x), bfhi(cr.x.p[j].x), bflo(cr.x.p[j].y), bfhi(cr.x.p[j].y)} + g2[j] * y + (f32x4){bflo(d[j].x), bfhi(d[j].x), bflo(d[j].y), bfhi(d[j].y)};
        }
        const float rstd = row_rstd(v);
#pragma unroll
        for (int j = 0; j < 4; ++j) __builtin_nontemporal_store((v[j] * rstd) * fg[j], (f32x4*)(A.out + (size_t)r * D + 4 * lane + 256 * j));
    };
    CRow ca, cb; u32x2 da[4], db[4]; int2 tsa = make_int2(0, 0), tsb = make_int2(0, 0);
    if (r_lo < r_hi) { crow_load(F, r_lo, TS(r_lo), ca); dload(r_lo, da); }
    if (r_lo + 1 < r_hi) { crow_load(F, r_lo + 1, TS(r_lo + 1), cb); dload(r_lo + 1, db); }
    if (r_lo + 2 < r_hi) tsa = TS(r_lo + 2);
    if (r_lo + 3 < r_hi) tsb = TS(r_lo + 3);
#pragma unroll 1
    for (int r = r_lo; r < r_hi; r += 2) {
        { const CRow cr = ca; u32x2 d[4];
#pragma unroll
          for (int j = 0; j < 4; ++j) d[j] = da[j];
          if (r + 2 < r_hi) { crow_load(F, r + 2, tsa, ca); dload(r + 2, da); }
          if (r + 4 < r_hi) tsa = TS(r + 4);
          finish(r, cr, d); }
        if (r + 1 < r_hi) {
            const CRow cr = cb; u32x2 d[4];
#pragma unroll
            for (int j = 0; j < 4; ++j) d[j] = db[j];
            if (r + 3 < r_hi) { crow_load(F, r + 3, tsb, cb); dload(r + 3, db); }
            if (r + 5 < r_hi) tsb = TS(r + 5);
            finish(r + 1, cr, d);
        }
    }
}

__global__ void __launch_bounds__(NTHREADS) fwd_kernel(Args args) {
    extern __shared__ __attribute__((aligned(16))) unsigned char smem[];
    Frame F;
    F.lds = (LAS char*)smem;
    F.tid = threadIdx.x; F.lane = F.tid & 63; F.wave = __builtin_amdgcn_readfirstlane(F.tid >> 6);
    F.G = gridDim.x; { const int bx = blockIdx.x; F.vcu = (F.G % 8 == 0) ? (bx % 8) * (F.G / 8) + bx / 8 : bx; }
    F.a = &args; F.ws = args.ws;
    volatile LAS unsigned* xbw = (volatile LAS unsigned*)(F.lds + LDS_XB);
    if (F.tid < 4) xbw[F.tid] = 0u;
    __syncthreads();
    XcdBarrier bar; bar.bar = (unsigned*)(F.ws + WS_CTL); bar.x = 0; bar.st = xbw;
    const int lo = args.ph_lo, hi = args.ph_hi;
    const bool multi = (hi - lo) > 1;
    if (multi) bar = xcd_barrier_post((unsigned*)(F.ws + WS_CTL), xbw);
#ifdef PROBE_PHASE
    unsigned long long pt0 = 0, pt1 = 0;
#define RUN_PHASE(k, call) do { if (lo <= (k) && (k) < hi) { if ((k) == PROBE_PHASE) pt0 = __builtin_amdgcn_s_memrealtime(); call; if ((k) + 1 < hi) xcd_barrier(bar); if ((k) == PROBE_PHASE) pt1 = __builtin_amdgcn_s_memrealtime(); } } while (0)
#else
#define RUN_PHASE(k, call) do { if (lo <= (k) && (k) < hi) { { int t_ = threadIdx.x; asm volatile("" : "+v"(t_)); F.tid = t_; F.lane = t_ & 63; } call; if ((k) + 1 < hi) xcd_barrier(bar); } } while (0)
#endif
    RUN_PHASE(0, phase_convert(F));
    RUN_PHASE(1, phase_prep0(F));
    RUN_PHASE(2, phase_gemm_in(F));
    RUN_PHASE(3, (phase_conv(F), xcd_barrier(bar), phase_scan(F)));
    RUN_PHASE(4, (phase_combine_h(F), xcd_barrier(bar), phase_gemm_out0(F)));
    RUN_PHASE(5, phase_route<0>(F));
    RUN_PHASE(7, phase_moe_up<0>(F));
    RUN_PHASE(8, phase_moe_down<0>(F));
    RUN_PHASE(9, phase_combine0(F));
    RUN_PHASE(10, phase_qkv(F));
    RUN_PHASE(11, phase_attn(F));
    RUN_PHASE(12, phase_gemm_wo(F));
    RUN_PHASE(13, phase_route<1>(F));
    RUN_PHASE(15, phase_moe_up<1>(F));
    RUN_PHASE(16, phase_moe_down<1>(F));
    RUN_PHASE(17, phase_final(F));
#undef RUN_PHASE
#ifdef PROBE_PHASE
    xcd_barrier(bar);
    if (blockIdx.x == 0 && F.tid == 0) args.out[0] = 40.0f + floorf((float)(pt1 - pt0) * 0.001f + 0.5f);
#endif
}

extern "C" void kernel_launch(void* const* d_in, const int* in_sizes, int n_in, void* d_out, int out_size, void* d_ws, size_t ws_size, hipStream_t stream) {
    static int grid = 0;
    if (grid == 0) {
        if (n_in != 27 || out_size != NX * D || ws_size < WS_END) { fprintf(stderr, "kernel_launch: unexpected shapes (n_in %d out %d ws %zu)\n", n_in, out_size, ws_size); grid = -1; return; }
        int dev = 0, cus = 0;
        if (hipGetDevice(&dev) != hipSuccess || hipDeviceGetAttribute(&cus, hipDeviceAttributeMultiprocessorCount, dev) != hipSuccess) { grid = -1; return; }
        if (hipFuncSetAttribute((const void*)fwd_kernel, hipFuncAttributeMaxDynamicSharedMemorySize, LDS_BYTES) != hipSuccess) { fprintf(stderr, "kernel_launch: hipFuncSetAttribute failed\n"); grid = -1; return; }
        (void)hipGetLastError();
        grid = cus < 256 ? cus : 256;
    }
    if (grid < 0) return;
    (void)hipMemsetAsync((char*)d_ws + WS_CTL, 0, CTL_ZERO_BYTES, stream);
    Args a{};
    for (int i = 0; i < 27; ++i) a.in[i] = (const float*)d_in[i];
    a.out = (float*)d_out; a.ws = (unsigned char*)d_ws;
    if (MK_N_LAUNCHES == 1) {
        a.ph_lo = 0; a.ph_hi = NPHASES;
        hipLaunchKernelGGL(fwd_kernel, dim3(grid), dim3(NTHREADS), LDS_BYTES, stream, a);
    } else {
        if (DBG_NPH == 0) { a.ph_lo = 0; a.ph_hi = 0; hipLaunchKernelGGL(fwd_kernel, dim3(grid), dim3(NTHREADS), LDS_BYTES, stream, a); }
        for (int p = 0; p < DBG_NPH; ++p) { a.ph_lo = p; a.ph_hi = p + 1; hipLaunchKernelGGL(fwd_kernel, dim3(grid), dim3(NTHREADS), LDS_BYTES, stream, a); }
    }
}
```
